# Optimizing an MI355X kernel written in HIP

```python
import jax, jax.numpy as jnp
from jax import lax
import numpy as np

D_MODEL = 1024
BATCH = 16
SEQ = 256
DEPTH = 4
DEC_BATCH = 2
DEC_SEQ = 1024
PAST_LEN = 512

GRID_W = 64
HEAD_DIM = 64
H_RWKV = 4
H_NA = 4
H_GQA = 8
H_GQA_KV = 2
GQA_GROUP = H_GQA // H_GQA_KV
W_RWKV = H_RWKV * HEAD_DIM
W_NA = H_NA * HEAD_DIM
W_GQA = H_GQA * HEAD_DIM
W_GQA_KV = H_GQA_KV * HEAD_DIM
LORA_W = 64
LORA_A = 64
LORA_G = 128
SHORT_CONV = 3
RWKV_IN = 3 * W_RWKV + 2 * LORA_W + 2 * LORA_A + LORA_G
NA_IN = 3 * W_NA
GQA_IN = W_GQA + 2 * W_GQA_KV
D_IN = RWKV_IN + NA_IN + GQA_IN
NA_ROWS = 8
NA_COLS = 16
Q_BLOCK = 128
ROPE_BASE = 10000.0
ROPE_FREQ = HEAD_DIM // 4
D_FF = ((8 * D_MODEL + 3 * 256 - 1) // (3 * 256)) * 256
DEEPNORM_ALPHA = (2 * DEPTH) ** 0.25
DEEPNORM_BETA = (8 * DEPTH) ** -0.25
LN_EPS = 1e-5
RMS_EPS = 1e-6
GN_EPS = 64e-5
NEG_INF = -1e30

kernel_name = 'hybrid_rwkv7_natten_gqa_diffusion_step'


def _layer_norm(x, w, b):
    xf = x.astype(jnp.float32)
    mu = jnp.mean(xf, -1, keepdims=True)
    var = jnp.mean(jnp.square(xf - mu), -1, keepdims=True)
    return ((xf - mu) * lax.rsqrt(var + LN_EPS) * w + b).astype(x.dtype)


def _rms_norm(x, w):
    xf = x.astype(jnp.float32)
    return (xf * lax.rsqrt(jnp.mean(xf * xf, -1, keepdims=True) + RMS_EPS) * w).astype(x.dtype)


def _axial_rope(x):
    t = jnp.arange(x.shape[1])
    inv = ROPE_BASE ** (-jnp.arange(ROPE_FREQ, dtype=jnp.float32) / ROPE_FREQ)

    def rotate(xa, pos):
        ang = pos.astype(jnp.float32)[:, None] * inv
        cos, sin = jnp.cos(ang)[None, :, None, :], jnp.sin(ang)[None, :, None, :]
        x1 = xa[..., :ROPE_FREQ].astype(jnp.float32)
        x2 = xa[..., ROPE_FREQ:].astype(jnp.float32)
        return jnp.concatenate([x1 * cos - x2 * sin, x2 * cos + x1 * sin], -1)

    half = HEAD_DIM // 2
    out = jnp.concatenate([rotate(x[..., :half], t // GRID_W), rotate(x[..., half:], t % GRID_W)], -1)
    return out.astype(x.dtype)


def _blocked_attention(q, k, v):
    b, lq, hk, g, d = q.shape
    qb = jnp.moveaxis(q.reshape(b, lq // Q_BLOCK, Q_BLOCK, hk, g, d), 1, 0)

    def block(qi):
        s = jnp.einsum('bqhgd,bkhd->bhgqk', qi, k).astype(jnp.float32) * d ** -0.5
        p = jax.nn.softmax(s, axis=-1).astype(v.dtype)
        return jnp.einsum('bhgqk,bkhd->bqhgd', p, v)

    o = lax.map(block, qb)
    return jnp.moveaxis(o, 0, 1).reshape(b, lq, hk * g * d)


def _neighbourhood_attention(q, k, v, k_ctx, v_ctx, rpb):
    b, s, h, d = q.shape
    rows = s // GRID_W
    kh = min(NA_ROWS, rows)
    qg = q.reshape(b, rows, GRID_W, h, d)
    kg = k.reshape(b, rows, GRID_W, h, d)
    vg = v.reshape(b, rows, GRID_W, h, d)
    r = jnp.arange(rows)
    row_idx = jnp.clip(r - kh // 2, 0, rows - kh)[:, None] + jnp.arange(kh)[None, :]
    kb = jnp.take(kg, row_idx, axis=1)
    vb = jnp.take(vg, row_idx, axis=1)
    col = jnp.arange(GRID_W)
    c0 = jnp.clip(col - NA_COLS // 2, 0, GRID_W - NA_COLS)
    in_win = (col[None, :] >= c0[:, None]) & (col[None, :] < c0[:, None] + NA_COLS)
    dr = row_idx - r[:, None] + NA_ROWS - 1
    dc = jnp.clip(col[None, :] - col[:, None], 1 - NA_COLS, NA_COLS - 1) + NA_COLS - 1
    bias = rpb[:, dr[:, None, :, None], dc[None, :, None, :]].astype(jnp.float32)
    scale = d ** -0.5
    s_nb = jnp.einsum('brqhd,brjchd->bhrqjc', qg, kb).astype(jnp.float32) * scale + bias
    s_nb = jnp.where(in_win[:, None, :], s_nb, NEG_INF)
    s_ctx = jnp.einsum('brqhd,bkhd->bhrqk', qg, k_ctx).astype(jnp.float32) * scale
    n_nb = kh * GRID_W
    p = jax.nn.softmax(jnp.concatenate([s_nb.reshape(b, h, rows, GRID_W, n_nb), s_ctx], -1), axis=-1)
    p = p.astype(v.dtype)
    o = (jnp.einsum('bhrqjc,brjchd->brqhd', p[..., :n_nb].reshape(b, h, rows, GRID_W, kh, GRID_W), vb)
         + jnp.einsum('bhrqk,bkhd->brqhd', p[..., n_nb:], v_ctx))
    return o.reshape(b, s, h * d)


def _short_conv(x, w):
    n = x.shape[1]
    xp = jnp.pad(x, ((0, 0), (SHORT_CONV // 2, SHORT_CONV // 2), (0, 0)))
    return sum(xp[:, j:j + n] * w[j] for j in range(SHORT_CONV))


def _wkv_scan(s0, r, w, kk, a, k, v, reverse):
    def step(s, inp):
        r_t, w_t, kk_t, a_t, k_t, v_t = inp
        sk = jnp.einsum('bhvk,bhk->bhv', s, kk_t)
        s = (s * w_t[:, :, None, :] - sk[..., None] * (a_t * kk_t)[:, :, None, :]
             + v_t[..., None] * k_t[:, :, None, :])
        return s, jnp.einsum('bhvk,bhk->bhv', s, r_t)

    xs = tuple(jnp.moveaxis(t, 1, 0) for t in (r, w, kk, a, k, v))
    s_fin, o = lax.scan(step, s0, xs, reverse=reverse)
    return s_fin, jnp.moveaxis(o, 0, 1)


def _rwkv_mix(feat, s0_f, s0_b, p):
    conv, w0, w2, a0, a2, g2, k_k, k_a, r_k, lnx_w, lnx_b = p
    b, n, _ = feat.shape
    f = _short_conv(feat, conv).astype(jnp.float32)
    o1, o2, o3 = W_RWKV, 2 * W_RWKV, 3 * W_RWKV
    o4 = o3 + 2 * LORA_W
    o5 = o4 + 2 * LORA_A
    r, k, v = f[..., :o1], f[..., o1:o2], f[..., o2:o3]
    wd = f[..., o3:o4].reshape(b, n, 2, LORA_W)
    ad = f[..., o4:o5].reshape(b, n, 2, LORA_A)
    gd = f[..., o5:]
    log_w = -jax.nn.softplus(-(w0 + jnp.einsum('bndr,drc->bndc', jnp.tanh(wd), w2))) - 0.5
    decay = jnp.exp(-jnp.exp(log_w))
    a = jax.nn.sigmoid(a0 + jnp.einsum('bndr,drc->bndc', ad, a2))
    g = jax.nn.sigmoid(gd) @ g2
    heads = lambda t: t.reshape(t.shape[:-1] + (H_RWKV, HEAD_DIM))
    kk = heads(k * k_k)
    kk = kk / jnp.maximum(jnp.sqrt(jnp.sum(kk * kk, -1, keepdims=True)), 1e-12)
    k_dir = heads(k[:, :, None, :] * (1 + (a - 1) * k_a))
    decay, a = heads(decay), heads(a)
    r_h, v_h = heads(r), heads(v)
    s_f, o_f = _wkv_scan(s0_f.astype(jnp.float32), r_h, decay[:, :, 0], kk, a[:, :, 0], k_dir[:, :, 0], v_h, False)
    s_b, o_b = _wkv_scan(s0_b.astype(jnp.float32), r_h, decay[:, :, 1], kk, a[:, :, 1], k_dir[:, :, 1], v_h, True)
    o = o_f + o_b
    mu = jnp.mean(o, -1, keepdims=True)
    var = jnp.mean(jnp.square(o - mu), -1, keepdims=True)
    o = ((o - mu) * lax.rsqrt(var + GN_EPS)).reshape(b, n, W_RWKV) * lnx_w + lnx_b
    bonus = jnp.sum(r_h * (k_dir[:, :, 0] + k_dir[:, :, 1]) * r_k, -1, keepdims=True) * v_h
    y = (o + bonus.reshape(b, n, W_RWKV)) * g
    return y.astype(feat.dtype), s_f, s_b


def _layer(x, mod, shared, cached):
    (w_in, rwkv_p, rpb, q_norm, k_norm, w_out, ln1_w, ln1_b, w_ffn_in, w_ffn_out, ln2_w, ln2_b) = shared
    shift1, scale1, gate1, shift2, scale2, gate2 = jnp.split(mod, 6, axis=-1)
    b, n = x.shape[:2]
    proj = (x * (1 + scale1) + shift1) @ w_in
    f_rwkv = proj[..., :RWKV_IN]
    f_na = proj[..., RWKV_IN:RWKV_IN + NA_IN].reshape(b, n, 3, H_NA, HEAD_DIM)
    na_q, na_k, na_v = f_na[:, :, 0], f_na[:, :, 1], f_na[:, :, 2]
    f_g = proj[..., RWKV_IN + NA_IN:]
    g_q = _rms_norm(f_g[..., :W_GQA].reshape(b, n, H_GQA, HEAD_DIM), q_norm)
    g_k = _rms_norm(f_g[..., W_GQA:W_GQA + W_GQA_KV].reshape(b, n, H_GQA_KV, HEAD_DIM), k_norm)
    g_v = f_g[..., W_GQA + W_GQA_KV:].reshape(b, n, H_GQA_KV, HEAD_DIM)
    if cached is None:
        s0 = jnp.zeros((b, H_RWKV, HEAD_DIM, HEAD_DIM), jnp.float32)
        o_rwkv, s_f, s_b = _rwkv_mix(f_rwkv, s0, s0, rwkv_p)
        o_na = _blocked_attention(na_q[:, :, :, None], na_k, na_v)
        o_g = _blocked_attention(g_q.reshape(b, n, H_GQA_KV, GQA_GROUP, HEAD_DIM), g_k, g_v)
        ctx_tensors = (jnp.stack([s_f, s_b], 1).astype(x.dtype), na_k, na_v, g_k, g_v)
    else:
        s0_f, s0_b, na_k_ctx, na_v_ctx, g_k_ctx, g_v_ctx = cached
        o_rwkv, _, _ = _rwkv_mix(f_rwkv, s0_f, s0_b, rwkv_p)
        o_na = _neighbourhood_attention(na_q, na_k, na_v, na_k_ctx, na_v_ctx, rpb)
        g_q = _axial_rope(g_q)
        g_k = _axial_rope(g_k)
        keys = jnp.concatenate([g_k_ctx.astype(g_k.dtype), g_k], 1)
        vals = jnp.concatenate([g_v_ctx.astype(g_v.dtype), g_v], 1)
        o_g = _blocked_attention(g_q.reshape(b, n, H_GQA_KV, GQA_GROUP, HEAD_DIM), keys, vals)
        ctx_tensors = None
    mix = jnp.concatenate([o_rwkv, o_na, o_g], -1) @ w_out
    x = _layer_norm(DEEPNORM_ALPHA * x + gate1 * mix, ln1_w, ln1_b)
    gate, up = jnp.split((x * (1 + scale2) + shift2) @ w_ffn_in, 2, axis=-1)
    x = _layer_norm(DEEPNORM_ALPHA * x + gate2 * ((jax.nn.silu(gate) * up) @ w_ffn_out), ln2_w, ln2_b)
    return x, ctx_tensors


def setup_inputs(seed: int = 0) -> dict:
    key = jax.random.key(seed)
    ks = iter(jax.random.split(key, 40))
    nrm = lambda shape, s=1.0: s * jax.random.normal(next(ks), shape, jnp.float32)
    D = D_MODEL
    conv_base = jnp.asarray(np.array([0.25, 0.5, 0.25], np.float32))[None, :, None]
    return {
        'x_prompt': nrm((BATCH, SEQ, D)),
        'x_sample': nrm((DEC_BATCH, DEC_SEQ, D)),
        'state_rwkv': nrm((DEC_BATCH, DEPTH, 2, H_RWKV, HEAD_DIM, HEAD_DIM), 0.5),
        'cache_na_k': nrm((DEC_BATCH, DEPTH, PAST_LEN, H_NA, HEAD_DIM)),
        'cache_na_v': nrm((DEC_BATCH, DEPTH, PAST_LEN, H_NA, HEAD_DIM)),
        'cache_gqa_k': nrm((DEC_BATCH, DEPTH, PAST_LEN, H_GQA_KV, HEAD_DIM)),
        'cache_gqa_v': nrm((DEC_BATCH, DEPTH, PAST_LEN, H_GQA_KV, HEAD_DIM)),
        'c': nrm((DEC_BATCH, D)),
        'c_ctx': nrm((D,)),
        'w_mod': nrm((DEPTH, D, 6 * D), 0.5 * D ** -0.5),
        'b_mod': nrm((DEPTH, 6 * D), 0.02),
        'w_in': nrm((DEPTH, D, D_IN), D ** -0.5),
        'rwkv_conv': conv_base + nrm((DEPTH, SHORT_CONV, RWKV_IN), 0.1),
        'rwkv_w0': nrm((DEPTH, 2, W_RWKV), 0.5),
        'rwkv_w2': nrm((DEPTH, 2, LORA_W, W_RWKV), 0.5 * LORA_W ** -0.5),
        'rwkv_a0': nrm((DEPTH, 2, W_RWKV), 0.5),
        'rwkv_a2': nrm((DEPTH, 2, LORA_A, W_RWKV), 0.5 * LORA_A ** -0.5),
        'rwkv_g2': nrm((DEPTH, LORA_G, W_RWKV), LORA_G ** -0.5),
        'rwkv_k_k': 1.0 + nrm((DEPTH, W_RWKV), 0.1),
        'rwkv_k_a': 1.0 + nrm((DEPTH, W_RWKV), 0.1),
        'rwkv_r_k': nrm((DEPTH, H_RWKV, HEAD_DIM), 0.1),
        'rwkv_lnx_w': 1.0 + nrm((DEPTH, W_RWKV), 0.1),
        'rwkv_lnx_b': nrm((DEPTH, W_RWKV), 0.02),
        'na_rpb': nrm((DEPTH, H_NA, 2 * NA_ROWS - 1, 2 * NA_COLS - 1), 0.2),
        'gqa_q_norm': 1.0 + nrm((DEPTH, HEAD_DIM), 0.1),
        'gqa_k_norm': 1.0 + nrm((DEPTH, HEAD_DIM), 0.1),
        'w_out': nrm((DEPTH, D, D), DEEPNORM_BETA * D ** -0.5),
        'ln1_w': 1.0 + nrm((DEPTH, D), 0.1),
        'ln1_b': nrm((DEPTH, D), 0.02),
        'w_ffn_in': nrm((DEPTH, D, 2 * D_FF), D ** -0.5),
        'w_ffn_out': nrm((DEPTH, D_FF, D), DEEPNORM_BETA * D_FF ** -0.5),
        'ln2_w': 1.0 + nrm((DEPTH, D), 0.1),
        'ln2_b': nrm((DEPTH, D), 0.02),
    }


def reference(x_prompt, x_sample, state_rwkv, cache_na_k, cache_na_v, cache_gqa_k, cache_gqa_v, c, c_ctx,
              w_mod, b_mod, w_in, rwkv_conv, rwkv_w0, rwkv_w2, rwkv_a0, rwkv_a2, rwkv_g2, rwkv_k_k, rwkv_k_a,
              rwkv_r_k, rwkv_lnx_w, rwkv_lnx_b, na_rpb, gqa_q_norm, gqa_k_norm, w_out, ln1_w, ln1_b,
              w_ffn_in, w_ffn_out, ln2_w, ln2_b):
    y_prompt = x_prompt
    y_sample = x_sample
    st_rwkv, st_na_k, st_na_v, st_g_k, st_g_v = [], [], [], [], []
    for l in range(DEPTH):
        rwkv_p = (rwkv_conv[l], rwkv_w0[l], rwkv_w2[l], rwkv_a0[l], rwkv_a2[l], rwkv_g2[l],
                  rwkv_k_k[l], rwkv_k_a[l], rwkv_r_k[l], rwkv_lnx_w[l], rwkv_lnx_b[l])
        shared = (w_in[l], rwkv_p, na_rpb[l], gqa_q_norm[l], gqa_k_norm[l], w_out[l],
                  ln1_w[l], ln1_b[l], w_ffn_in[l], w_ffn_out[l], ln2_w[l], ln2_b[l])
        mod_ctx = jax.nn.silu(c_ctx) @ w_mod[l] + b_mod[l]
        y_prompt, ctx_t = _layer(y_prompt, mod_ctx, shared, None)
        st_rwkv.append(ctx_t[0])
        st_na_k.append(ctx_t[1])
        st_na_v.append(ctx_t[2])
        st_g_k.append(ctx_t[3])
        st_g_v.append(ctx_t[4])
        mod_lat = (jax.nn.silu(c) @ w_mod[l] + b_mod[l])[:, None, :]
        cached = (state_rwkv[:, l, 0], state_rwkv[:, l, 1], cache_na_k[:, l], cache_na_v[:, l],
                  cache_gqa_k[:, l], cache_gqa_v[:, l])
        y_sample, _ = _layer(y_sample, mod_lat, shared, cached)
    new_state_rwkv = jnp.stack(st_rwkv, 1)
    new_cache_na_k = jnp.stack(st_na_k, 1)
    new_cache_na_v = jnp.stack(st_na_v, 1)
    new_cache_gqa_k = jnp.stack(st_g_k, 1)
    new_cache_gqa_v = jnp.stack(st_g_v, 1)
    return (y_prompt, y_sample, new_state_rwkv, new_cache_na_k, new_cache_na_v, new_cache_gqa_k, new_cache_gqa_v)
```

```cpp
#include <hip/hip_runtime.h>
#include <hip/hip_cooperative_groups.h>
#include <cstdio>
#include <cstdint>
#include <cstring>
namespace cg = cooperative_groups;

#ifndef MEGA
#define MEGA 0
#endif

typedef unsigned short u16;
using bf16x8 = __attribute__((ext_vector_type(8))) short;
using f32x4 = __attribute__((ext_vector_type(4))) float;

#define NTOK 6144
#define NCTX 4096
#define DM 1024
#define DIN 2688
#define DFF 2816
#define NPH 39
#define ALPHA 1.681792830507429f
#define LOG2E 1.4426950408889634f
#define QSCALE (0.125f * LOG2E)

struct Params {
  const float* in[33];
  float *out_yp, *out_ys, *out_st, *out_nak, *out_nav, *out_gk, *out_gv;
  unsigned *bar, *wq;
  float *modp, *mod;
  u16 *winT, *woutT, *wfiT, *wfoT;
  float *X, *X1, *Y, *PROJ, *SC, *G, *BV, *OF, *OB;
  u16 *A, *MIX, *ACT;
  u16 *QNc, *KNc, *VNtc, *QGc, *KGc, *VGtc;
  u16 *QNl, *KNl, *VNtl, *QGl, *KGl, *VGtl;
  int never; int pad;
};

__device__ __forceinline__ u16 f2bf(float f) {
  unsigned u = __float_as_uint(f);
  u += 0x7FFFu + ((u >> 16) & 1u);
  return (u16)(u >> 16);
}
__device__ __forceinline__ unsigned pack2(float a, float b) { return (unsigned)f2bf(a) | ((unsigned)f2bf(b) << 16); }
__device__ __forceinline__ float wave_sum(float v) {
#pragma unroll
  for (int o = 32; o; o >>= 1) v += __shfl_xor(v, o);
  return v;
}
template <int CTRL> __device__ __forceinline__ float dpp_mov(float v) {
  return __int_as_float(__builtin_amdgcn_update_dpp(0, __float_as_int(v), CTRL, 0xF, 0xF, false));
}
__device__ __forceinline__ float reduce16(float v) {
  v += dpp_mov<0xB1>(v);
  v += dpp_mov<0x4E>(v);
  v += dpp_mov<0x141>(v);
  v += dpp_mov<0x140>(v);
  return v;
}
__device__ __forceinline__ float sigmoidf_(float x) { return 1.f / (1.f + __expf(-x)); }
__device__ __forceinline__ float siluf_(float x) { return x / (1.f + __expf(-x)); }
__device__ __forceinline__ int modrow_of(int tok) { return tok < NCTX ? 0 : 1 + ((tok - NCTX) >> 10); }

#define XB_TMO      128
#define XB_XCNT(j)  (256  + 64 * (j))
#define XB_XSUB(j)  (1280 + 64 * (j))
#define XB_XGEN(j)  (2304 + 64 * (j))
#define XB_TOP      3328
#define XB_TOPGEN   3392
#define XCD_BAR_WORDS 3456
#define XB_SPIN_CAP (1u << 22)
#define LAS __attribute__((address_space(3)))
__device__ __forceinline__ unsigned xb_ld(unsigned* p) { return __hip_atomic_load(p, __ATOMIC_RELAXED, __HIP_MEMORY_SCOPE_AGENT); }
__device__ __forceinline__ unsigned xb_add(unsigned* p, unsigned v) { return __hip_atomic_fetch_add(p, v, __ATOMIC_RELAXED, __HIP_MEMORY_SCOPE_AGENT); }
__device__ __forceinline__ unsigned xb_xcc_id() { return (unsigned)__builtin_amdgcn_s_getreg((3 << 11) | 20) & 0xFu; }
#define XB_SPIN(cond, bar) do { unsigned _sp = 0; while (cond) { __builtin_amdgcn_s_sleep(1); \
    if ((++_sp & 255u) == 0u) { if (xb_ld(&(bar)[XB_TMO])) break; if (_sp > XB_SPIN_CAP) { atomicAdd(&(bar)[XB_TMO], 1u); break; } } } } while (0)
struct XcdBarrier { unsigned* bar; unsigned x; volatile LAS unsigned* st; };
__device__ __forceinline__ XcdBarrier xcd_barrier_post(unsigned* bar, volatile LAS unsigned* st) {
  XcdBarrier b; b.bar = bar; b.x = xb_xcc_id(); b.st = st;
  if (threadIdx.x == 0) (void)xb_add(&bar[XB_XCNT(b.x)], 1u);
  return b;
}
__device__ __forceinline__ void xcd_barrier_complete(unsigned* bar, unsigned x, unsigned& nloc, unsigned& nx) {
  const unsigned G = gridDim.x * gridDim.y * gridDim.z;
  unsigned sum, cnt, mine, sp = 0u;
  for (;;) {
    sum = 0u; cnt = 0u; mine = 0u;
#pragma unroll
    for (unsigned j = 0; j < 16; ++j) { const unsigned c = xb_ld(&bar[XB_XCNT(j)]); sum += c; cnt += (c > 0u) ? 1u : 0u; mine = (j == x) ? c : mine; }
    if (sum == G) break;
    __builtin_amdgcn_s_sleep(1);
    if ((++sp & 255u) == 0u) { if (xb_ld(&bar[XB_TMO])) break; if (sp > XB_SPIN_CAP) { atomicAdd(&bar[XB_TMO], 1u); break; } }
  }
  nloc = mine > 0u ? mine : 1u; nx = cnt > 0u ? cnt : 1u;
}
__device__ __forceinline__ void xcd_barrier(const XcdBarrier& b) {
  asm volatile("s_waitcnt vmcnt(0)" ::: "memory");
  __syncthreads();
  if (threadIdx.x == 0) {
    unsigned* bar = b.bar;
    __builtin_amdgcn_s_waitcnt(0);
    unsigned nloc = b.st[0], nx = b.st[1];
    if (nloc == 0u) { xcd_barrier_complete(bar, b.x, nloc, nx); b.st[0] = nloc; b.st[1] = nx; }
    const unsigned old = xb_add(&bar[XB_XSUB(b.x)], 1u);
    const unsigned gen = old / nloc;
    if (old + 1u == (gen + 1u) * nloc) {
      __builtin_amdgcn_fence(__ATOMIC_RELEASE, "agent");
      asm volatile("s_waitcnt vmcnt(0)" ::: "memory");
      const unsigned og = xb_add(&bar[XB_TOP], 1u);
      const unsigned tg = og / nx;
      if (og + 1u == (tg + 1u) * nx) xb_add(&bar[XB_TOPGEN], 1u);
      else XB_SPIN(xb_ld(&bar[XB_TOPGEN]) == tg, bar);
      __builtin_amdgcn_fence(__ATOMIC_ACQUIRE, "agent");
      xb_add(&bar[XB_XGEN(b.x)], 1u);
      asm volatile("s_waitcnt vmcnt(0)" ::: "memory");
    } else {
      XB_SPIN(xb_ld(&bar[XB_XGEN(b.x)]) == gen, bar);
      __builtin_amdgcn_fence(__ATOMIC_ACQUIRE, "agent");
      asm volatile("s_waitcnt vmcnt(0)" ::: "memory");
    }
  }
  __syncthreads();
}

__device__ __forceinline__ int lds_byte(int r, int c) {
  int st = (r >> 4) * 2 + (c >> 5), rr = r & 15, cc = c & 31, ob = rr * 64 + cc * 2;
  return st * 1024 + (ob ^ (((ob >> 9) & 1) << 5));
}
__device__ __forceinline__ void stage_rc(int b, int& R, int& C) {
  int st = b / 1024, sb = b % 1024, swz = sb ^ (((sb >> 9) & 1) << 5);
  R = (st >> 1) * 16 + swz / 64; C = (st & 1) * 32 + (swz % 64) / 2;
}
__device__ __forceinline__ void stage_tile(const u16* __restrict__ g, int ld, char* lds, int tidx) {
#pragma unroll
  for (int i = 0; i < 4; ++i) {
    int b = tidx * 16 + i * 4096; int R, C; stage_rc(b, R, C);
    __builtin_amdgcn_global_load_lds((const unsigned*)(g + (size_t)R * ld + C), (unsigned LAS*)(lds + b), 16, 0, 0);
  }
}

enum { EPI_PROJ = 0, EPI_OUT = 1, EPI_FFI = 2, EPI_FFO = 3 };

template <int EPI>
__device__ __forceinline__ void gemm_phase(const Params& p, int layer, const u16* __restrict__ A, const u16* __restrict__ Bt,
                                           int N, int K, char* smem, int bid, int nblk, int tidx) {
  const int tid = tidx, lane = tid & 63, wid = tid >> 6, wr = wid >> 1, wc = wid & 1, fr = lane & 15, fq = lane >> 4;
  const int nM = NTOK / 128, nN = N / 128, ntiles = nM * nN, nk = K / 64;
  for (int tile = bid; tile < ntiles; tile += nblk) {
    const int pm = tile % nM, pn = tile / nM, m0 = pm * 128, n0 = pn * 128;
    f32x4 acc[4][4];
#pragma unroll
    for (int m = 0; m < 4; ++m)
#pragma unroll
      for (int n = 0; n < 4; ++n) acc[m][n] = (f32x4){0.f, 0.f, 0.f, 0.f};
    const u16* Ag = A + (size_t)m0 * K;
    const u16* Bg = Bt + (size_t)n0 * K;
    stage_tile(Ag, K, smem, tidx);
    stage_tile(Bg, K, smem + 16384, tidx);
    for (int kt = 0; kt < nk; ++kt) {
      asm volatile("s_waitcnt vmcnt(0)" ::: "memory");
      __syncthreads();
      if (kt + 1 < nk) {
        char* nb = smem + ((kt + 1) & 1) * 32768;
        stage_tile(Ag + (kt + 1) * 64, K, nb, tidx);
        stage_tile(Bg + (kt + 1) * 64, K, nb + 16384, tidx);
      }
      const char* sa = smem + (kt & 1) * 32768;
      const char* sb = sa + 16384;
      bf16x8 af[4][2], bfr[4][2];
#pragma unroll
      for (int m = 0; m < 4; ++m)
#pragma unroll
        for (int k = 0; k < 2; ++k) af[m][k] = *reinterpret_cast<const bf16x8*>(sa + lds_byte(wr * 64 + m * 16 + fr, k * 32 + fq * 8));
#pragma unroll
      for (int n = 0; n < 4; ++n)
#pragma unroll
        for (int k = 0; k < 2; ++k) bfr[n][k] = *reinterpret_cast<const bf16x8*>(sb + lds_byte(wc * 64 + n * 16 + fr, k * 32 + fq * 8));
#pragma unroll
      for (int k = 0; k < 2; ++k)
#pragma unroll
        for (int m = 0; m < 4; ++m)
#pragma unroll
          for (int n = 0; n < 4; ++n) acc[m][n] = __builtin_amdgcn_mfma_f32_16x16x32_bf16(bfr[n][k], af[m][k], acc[m][n], 0, 0, 0);
    }
    const int mr = modrow_of(m0);
#pragma unroll
    for (int m = 0; m < 4; ++m) {
      const int row = m0 + wr * 64 + m * 16 + fr;
      if (EPI == EPI_PROJ) {
#pragma unroll
        for (int n = 0; n < 4; ++n) {
          const int col = n0 + wc * 64 + n * 16 + 4 * fq;
          *reinterpret_cast<float4*>(p.PROJ + (size_t)row * DIN + col) = make_float4(acc[m][n][0], acc[m][n][1], acc[m][n][2], acc[m][n][3]);
        }
      } else if (EPI == EPI_OUT || EPI == EPI_FFO) {
        const float* res = (EPI == EPI_OUT) ? p.X : p.X1;
        const float* gate = p.mod + ((size_t)(layer * 3 + mr) * 6 + (EPI == EPI_OUT ? 2 : 5)) * 1024;
#pragma unroll
        for (int n = 0; n < 4; ++n) {
          const int col = n0 + wc * 64 + n * 16 + 4 * fq;
          const float4 xr = *reinterpret_cast<const float4*>(res + (size_t)row * DM + col);
          const float4 gt = *reinterpret_cast<const float4*>(gate + col);
          float4 y;
          y.x = ALPHA * xr.x + gt.x * acc[m][n][0];
          y.y = ALPHA * xr.y + gt.y * acc[m][n][1];
          y.z = ALPHA * xr.z + gt.z * acc[m][n][2];
          y.w = ALPHA * xr.w + gt.w * acc[m][n][3];
          *reinterpret_cast<float4*>(p.Y + (size_t)row * DM + col) = y;
        }
      } else {
#pragma unroll
        for (int n2 = 0; n2 < 2; ++n2) {
          const int j0 = ((n0 + wc * 64) / 32 + n2) * 16 + 4 * fq;
          float a[4];
#pragma unroll
          for (int r = 0; r < 4; ++r) a[r] = siluf_(acc[m][2 * n2][r]) * acc[m][2 * n2 + 1][r];
          uint2 pk; pk.x = pack2(a[0], a[1]); pk.y = pack2(a[2], a[3]);
          *reinterpret_cast<uint2*>(p.ACT + (size_t)row * DFF + j0) = pk;
        }
      }
    }
    __syncthreads();
  }
}

__device__ __forceinline__ void pack8_store(u16* dst, const float* v) {
  uint4 pk; pk.x = pack2(v[0], v[1]); pk.y = pack2(v[2], v[3]); pk.z = pack2(v[4], v[5]); pk.w = pack2(v[6], v[7]);
  *reinterpret_cast<uint4*>(dst) = pk;
}

__device__ void setup_phase(const Params& p, char* smem, int bid, int nblk, int tidx) {
  const int tid = tidx;
  const int NI = 768 + 512 + 4 * 3040;
  for (int it = bid; it < NI; it += nblk) {
    if (it < 768) {
      const int l = it / 192, nc = (it / 32) % 6, kc = it % 32;
      const int col = nc * 1024 + tid * 4;
      const float* wm = p.in[9] + (size_t)l * 1024 * 6144;
      float4 a0 = make_float4(0, 0, 0, 0), a1 = a0, a2 = a0;
      for (int kk = 0; kk < 32; ++kk) {
        const int k = kc * 32 + kk;
        const float s0 = siluf_(p.in[8][k]), s1 = siluf_(p.in[7][k]), s2 = siluf_(p.in[7][1024 + k]);
        const float4 w = *reinterpret_cast<const float4*>(wm + (size_t)k * 6144 + col);
        a0.x += s0 * w.x; a0.y += s0 * w.y; a0.z += s0 * w.z; a0.w += s0 * w.w;
        a1.x += s1 * w.x; a1.y += s1 * w.y; a1.z += s1 * w.z; a1.w += s1 * w.w;
        a2.x += s2 * w.x; a2.y += s2 * w.y; a2.z += s2 * w.z; a2.w += s2 * w.w;
      }
      float* dst = p.modp + (size_t)((l * 32 + kc) * 3) * 6144 + col;
      *reinterpret_cast<float4*>(dst) = a0;
      *reinterpret_cast<float4*>(dst + 6144) = a1;
      *reinterpret_cast<float4*>(dst + 2 * 6144) = a2;
    } else if (it < 1280) {
      const int ci = it - 768, b = ci / 256, l = (ci / 64) % 4, tg = ci % 64, t0 = tg * 8;
      {
        const float* ck = p.in[3] + ((size_t)(b * 4 + l) * 512 + t0) * 256 + tid;
        const float* cv = p.in[4] + ((size_t)(b * 4 + l) * 512 + t0) * 256 + tid;
        float v[8];
#pragma unroll
        for (int tt = 0; tt < 8; ++tt) {
          p.KNl[((size_t)(l * 2 + b) * 1536 + t0 + tt) * 256 + tid] = f2bf(ck[tt * 256]);
          v[tt] = cv[tt * 256];
        }
        pack8_store(p.VNtl + ((size_t)(l * 2 + b) * 256 + tid) * 1536 + t0, v);
      }
      if (tid < 128) {
        const float* ck = p.in[5] + ((size_t)(b * 4 + l) * 512 + t0) * 128 + tid;
#pragma unroll
        for (int tt = 0; tt < 8; ++tt) p.KGl[((size_t)(l * 2 + b) * 1536 + t0 + tt) * 128 + tid] = f2bf(ck[tt * 128]);
      } else {
        const int c = tid - 128;
        const float* cv = p.in[6] + ((size_t)(b * 4 + l) * 512 + t0) * 128 + c;
        float v[8];
#pragma unroll
        for (int tt = 0; tt < 8; ++tt) v[tt] = cv[tt * 128];
        pack8_store(p.VGtl + ((size_t)(l * 2 + b) * 128 + c) * 1536 + t0, v);
      }
    } else {
      const int wi = it - 1280, l = wi / 3040; int r = wi % 3040;
      const float* src; u16* dst; int K, N, mat, kt, nt;
      if (r < 672) { mat = 0; K = 1024; N = 2688; src = p.in[11] + (size_t)l * K * N; dst = p.winT + (size_t)l * N * K; kt = r / 42; nt = r % 42; }
      else if (r < 928) { r -= 672; mat = 1; K = 1024; N = 1024; src = p.in[26] + (size_t)l * K * N; dst = p.woutT + (size_t)l * N * K; kt = r / 16; nt = r % 16; }
      else if (r < 2336) { r -= 928; mat = 2; K = 1024; N = 5632; src = p.in[29] + (size_t)l * K * N; dst = p.wfiT + (size_t)l * N * K; kt = r / 88; nt = r % 88; }
      else { r -= 2336; mat = 3; K = 2816; N = 1024; src = p.in[30] + (size_t)l * K * N; dst = p.wfoT + (size_t)l * N * K; kt = r / 16; nt = r % 16; }
      float* tile = reinterpret_cast<float*>(smem);
      const int k0 = kt * 64, n0 = nt * 64;
#pragma unroll
      for (int i = 0; i < 4; ++i) {
        const int kr = (tid >> 4) + 16 * i, c4 = (tid & 15) * 4;
        const float4 v = *reinterpret_cast<const float4*>(src + (size_t)(k0 + kr) * N + n0 + c4);
        tile[kr * 65 + c4 + 0] = v.x; tile[kr * 65 + c4 + 1] = v.y; tile[kr * 65 + c4 + 2] = v.z; tile[kr * 65 + c4 + 3] = v.w;
      }
      __syncthreads();
#pragma unroll
      for (int i = 0; i < 2; ++i) {
        const int idx = tid + 256 * i, nl = idx >> 3, kc = idx & 7;
        int n = n0 + nl;
        if (mat == 2) { const int isup = n >= DFF ? 1 : 0; const int j = n - isup * DFF; n = (j >> 4) * 32 + isup * 16 + (j & 15); }
        float v[8];
#pragma unroll
        for (int jj = 0; jj < 8; ++jj) v[jj] = tile[(kc * 8 + jj) * 65 + nl];
        pack8_store(dst + (size_t)n * K + k0 + kc * 8, v);
      }
      __syncthreads();
    }
  }
}

__device__ void modreduce_phase(const Params& p, int bid, int nblk, int tidx) {
  for (int idx = bid * 256 + tidx; idx < 18432; idx += nblk * 256) {
    const int l = idx / 4608, rem = idx % 4608, mr = rem / 1536, c4 = (rem % 1536) * 4;
    float4 a = *reinterpret_cast<const float4*>(p.in[10] + (size_t)l * 6144 + c4);
    for (int kc = 0; kc < 32; ++kc) {
      const float4 v = *reinterpret_cast<const float4*>(p.modp + (size_t)((l * 32 + kc) * 3 + mr) * 6144 + c4);
      a.x += v.x; a.y += v.y; a.z += v.z; a.w += v.w;
    }
    *reinterpret_cast<float4*>(p.mod + (size_t)(l * 3 + mr) * 6144 + c4) = a;
  }
}

template <int MODE>
__device__ void ln_phase(const Params& p, int layer, int bid, int nblk, int tidx) {
  const int lane = tidx & 63, wid = tidx >> 6;
  for (int it = bid; it < NTOK / 4; it += nblk) {
    const int row = it * 4 + wid;
    const float* src;
    if (MODE == 0) src = row < NCTX ? p.in[0] + (size_t)row * DM : p.in[1] + (size_t)(row - NCTX) * DM;
    else src = p.Y + (size_t)row * DM;
    float4 v[4];
#pragma unroll
    for (int i = 0; i < 4; ++i) v[i] = reinterpret_cast<const float4*>(src)[lane + 64 * i];
    if (MODE != 0) {
      float s = 0.f;
#pragma unroll
      for (int i = 0; i < 4; ++i) s += v[i].x + v[i].y + v[i].z + v[i].w;
      const float mu = wave_sum(s) * (1.f / 1024.f);
      float q = 0.f;
#pragma unroll
      for (int i = 0; i < 4; ++i) {
        v[i].x -= mu; v[i].y -= mu; v[i].z -= mu; v[i].w -= mu;
        q += v[i].x * v[i].x + v[i].y * v[i].y + v[i].z * v[i].z + v[i].w * v[i].w;
      }
      const float rstd = rsqrtf(wave_sum(q) * (1.f / 1024.f) + 1e-5f);
      const float* lw = (MODE == 1 ? p.in[27] : p.in[31]) + (size_t)layer * DM;
      const float* lb = (MODE == 1 ? p.in[28] : p.in[32]) + (size_t)layer * DM;
#pragma unroll
      for (int i = 0; i < 4; ++i) {
        const float4 w = reinterpret_cast<const float4*>(lw)[lane + 64 * i];
        const float4 b = reinterpret_cast<const float4*>(lb)[lane + 64 * i];
        v[i].x = v[i].x * rstd * w.x + b.x; v[i].y = v[i].y * rstd * w.y + b.y;
        v[i].z = v[i].z * rstd * w.z + b.z; v[i].w = v[i].w * rstd * w.w + b.w;
      }
    }
    float* xdst = (MODE == 1 ? p.X1 : p.X) + (size_t)row * DM;
#pragma unroll
    for (int i = 0; i < 4; ++i) reinterpret_cast<float4*>(xdst)[lane + 64 * i] = v[i];
    if (MODE == 2 && layer == 3) {
      float* o = row < NCTX ? p.out_yp + (size_t)row * DM : p.out_ys + (size_t)(row - NCTX) * DM;
#pragma unroll
      for (int i = 0; i < 4; ++i) reinterpret_cast<float4*>(o)[lane + 64 * i] = v[i];
    } else {
      const int ml = (MODE == 2) ? layer + 1 : layer;
      const int which = (MODE == 1) ? 3 : 0;
      const float* sh = p.mod + ((size_t)(ml * 3 + modrow_of(row)) * 6 + which) * 1024;
      const float* sc = sh + 1024;
      u16* adst = p.A + (size_t)row * DM;
#pragma unroll
      for (int i = 0; i < 4; ++i) {
        const float4 s4 = reinterpret_cast<const float4*>(sh)[lane + 64 * i];
        const float4 c4 = reinterpret_cast<const float4*>(sc)[lane + 64 * i];
        uint2 pk;
        pk.x = pack2(v[i].x * (1.f + c4.x) + s4.x, v[i].y * (1.f + c4.y) + s4.y);
        pk.y = pack2(v[i].z * (1.f + c4.z) + s4.z, v[i].w * (1.f + c4.w) + s4.w);
        reinterpret_cast<uint2*>(adst)[lane + 64 * i] = pk;
      }
    }
  }
}

__device__ void prep_phase(const Params& p, int layer, char* smem, int bid, int nblk, int tidx) {
  const int tid = tidx, lane = tid & 63, wid = tid >> 6;
  float* F = reinterpret_cast<float*>(smem);
  float* LI = F + 8 * 768;
  const float* cw = p.in[12] + (size_t)layer * 3 * 1152;
  for (int it = bid; it < NTOK / 8; it += nblk) {
    const int tok0 = it * 8;
    int b, tpos0, L, seqbase;
    const bool isctx = tok0 < NCTX;
    if (isctx) { b = tok0 >> 8; tpos0 = tok0 & 255; L = 256; seqbase = b * 256; }
    else { const int tl = tok0 - NCTX; b = tl >> 10; tpos0 = tl & 1023; L = 1024; seqbase = NCTX + b * 1024; }
    for (int idx = tid; idx < 8 * 288; idx += 256) {
      const int tt = idx / 288, c = (idx % 288) * 4, tpos = tpos0 + tt;
      const float* pr = p.PROJ + (size_t)(tok0 + tt) * DIN + c;
      const float4 w0 = *reinterpret_cast<const float4*>(cw + c);
      const float4 w1 = *reinterpret_cast<const float4*>(cw + 1152 + c);
      const float4 w2 = *reinterpret_cast<const float4*>(cw + 2304 + c);
      const float4 xc = *reinterpret_cast<const float4*>(pr);
      float4 f = make_float4(w1.x * xc.x, w1.y * xc.y, w1.z * xc.z, w1.w * xc.w);
      if (tpos > 0) { const float4 xp = *reinterpret_cast<const float4*>(pr - DIN); f.x += w0.x * xp.x; f.y += w0.y * xp.y; f.z += w0.z * xp.z; f.w += w0.w * xp.w; }
      if (tpos < L - 1) { const float4 xn = *reinterpret_cast<const float4*>(pr + DIN); f.x += w2.x * xn.x; f.y += w2.y * xn.y; f.z += w2.z * xn.z; f.w += w2.w * xn.w; }
      if (c < 768) { *reinterpret_cast<float4*>(F + tt * 768 + c) = f; }
      else {
        const int cc = c - 768;
        float e[4] = {f.x, f.y, f.z, f.w};
#pragma unroll
        for (int q = 0; q < 4; ++q) {
          float v = e[q];
          if (cc < 128) v = tanhf(v); else if (cc >= 256) v = sigmoidf_(v);
          LI[(cc + q) * 8 + tt] = v;
        }
      }
    }
    __syncthreads();
    const int c = tid;
    float lw0[8], lw1[8], la0[8], la1[8], gg[8];
#pragma unroll
    for (int tt = 0; tt < 8; ++tt) { lw0[tt] = 0.f; lw1[tt] = 0.f; la0[tt] = 0.f; la1[tt] = 0.f; gg[tt] = 0.f; }
    {
      const float* w2 = p.in[14] + (size_t)layer * 2 * 64 * 256 + c;
      const float* a2 = p.in[16] + (size_t)layer * 2 * 64 * 256 + c;
      const float* g2 = p.in[17] + (size_t)layer * 128 * 256 + c;
      for (int r = 0; r < 64; ++r) {
        const float w20 = w2[r * 256], w21 = w2[(64 + r) * 256], a20 = a2[r * 256], a21 = a2[(64 + r) * 256];
        const float4* l0 = reinterpret_cast<const float4*>(LI + (r) * 8);
        const float4* l1 = reinterpret_cast<const float4*>(LI + (64 + r) * 8);
        const float4* l2 = reinterpret_cast<const float4*>(LI + (128 + r) * 8);
        const float4* l3 = reinterpret_cast<const float4*>(LI + (192 + r) * 8);
#pragma unroll
        for (int h = 0; h < 2; ++h) {
          const float4 x0 = l0[h], x1 = l1[h], x2 = l2[h], x3 = l3[h];
          lw0[4 * h + 0] += x0.x * w20; lw0[4 * h + 1] += x0.y * w20; lw0[4 * h + 2] += x0.z * w20; lw0[4 * h + 3] += x0.w * w20;
          lw1[4 * h + 0] += x1.x * w21; lw1[4 * h + 1] += x1.y * w21; lw1[4 * h + 2] += x1.z * w21; lw1[4 * h + 3] += x1.w * w21;
          la0[4 * h + 0] += x2.x * a20; la0[4 * h + 1] += x2.y * a20; la0[4 * h + 2] += x2.z * a20; la0[4 * h + 3] += x2.w * a20;
          la1[4 * h + 0] += x3.x * a21; la1[4 * h + 1] += x3.y * a21; la1[4 * h + 2] += x3.z * a21; la1[4 * h + 3] += x3.w * a21;
        }
      }
      for (int j = 0; j < 128; ++j) {
        const float gv = g2[j * 256];
        const float4* lg = reinterpret_cast<const float4*>(LI + (256 + j) * 8);
#pragma unroll
        for (int h = 0; h < 2; ++h) {
          const float4 x = lg[h];
          gg[4 * h + 0] += x.x * gv; gg[4 * h + 1] += x.y * gv; gg[4 * h + 2] += x.z * gv; gg[4 * h + 3] += x.w * gv;
        }
      }
    }
    {
      const float w00 = p.in[13][(size_t)layer * 512 + c], w01 = p.in[13][(size_t)layer * 512 + 256 + c];
      const float a00 = p.in[15][(size_t)layer * 512 + c], a01 = p.in[15][(size_t)layer * 512 + 256 + c];
      const float kkw = p.in[18][(size_t)layer * 256 + c], kaw = p.in[19][(size_t)layer * 256 + c], rkw = p.in[20][(size_t)layer * 256 + c];
#pragma unroll
      for (int tt = 0; tt < 8; ++tt) {
        const float r = F[tt * 768 + c], k = F[tt * 768 + 256 + c], v = F[tt * 768 + 512 + c];
        float dec[2], av[2];
#pragma unroll
        for (int d = 0; d < 2; ++d) {
          const float x = (d == 0 ? w00 + lw0[tt] : w01 + lw1[tt]);
          const float z = -x;
          const float sp = fmaxf(z, 0.f) + log1pf(__expf(-fabsf(z)));
          const float logw = -sp - 0.5f;
          dec[d] = __expf(-__expf(logw));
          av[d] = sigmoidf_((d == 0 ? a00 + la0[tt] : a01 + la1[tt]));
        }
        float kk = k * kkw;
        const float ss = wave_sum(kk * kk);
        kk = kk / fmaxf(sqrtf(ss), 1e-12f);
        const float kd0 = k * (1.f + (av[0] - 1.f) * kaw), kd1 = k * (1.f + (av[1] - 1.f) * kaw);
        const float bon = wave_sum(r * (kd0 + kd1) * rkw);
        const int tok = tok0 + tt;
        float* sc = p.SC + ((size_t)(tok * 4 + wid) * 9) * 64 + lane;
        sc[0] = r; sc[64] = kk; sc[128] = v;
        sc[192] = dec[0]; sc[256] = av[0] * kk; sc[320] = kd0;
        sc[384] = dec[1]; sc[448] = av[1] * kk; sc[512] = kd1;
        p.G[(size_t)tok * 256 + c] = gg[tt];
        p.BV[(size_t)tok * 256 + c] = bon * v;
      }
    }
    {
      float vv[8];
#pragma unroll
      for (int tt = 0; tt < 8; ++tt) {
        const int tok = tok0 + tt;
        const float* pr = p.PROJ + (size_t)tok * DIN + 1152 + c;
        const float q = pr[0], k = pr[256], v = pr[512];
        vv[tt] = v;
        if (isctx) {
          const size_t oi = ((size_t)(b * 4 + layer) * 256 + tpos0 + tt) * 256 + c;
          p.out_nak[oi] = k; p.out_nav[oi] = v;
          p.QNc[(size_t)tok * 256 + c] = f2bf(q * QSCALE);
          p.KNc[(size_t)tok * 256 + c] = f2bf(k);
        } else {
          p.QNl[(size_t)(tok - NCTX) * 256 + c] = f2bf(q * QSCALE);
          p.KNl[((size_t)(layer * 2 + b) * 1536 + 512 + tpos0 + tt) * 256 + c] = f2bf(k);
        }
      }
      if (isctx) pack8_store(p.VNtc + ((size_t)b * 256 + c) * 256 + tpos0, vv);
      else pack8_store(p.VNtl + ((size_t)(layer * 2 + b) * 256 + c) * 1536 + 512 + tpos0, vv);
    }
    {
      const float qn = p.in[24][(size_t)layer * 64 + lane], kn = p.in[25][(size_t)layer * 64 + lane];
      const int fi = lane & 15;
      const float inv = exp2f(-(float)fi * (13.287712379549449f / 16.f));
      float vv[8];
#pragma unroll
      for (int tt = 0; tt < 8; ++tt) {
        const int tok = tok0 + tt, tpos = tpos0 + tt;
        const float* pr = p.PROJ + (size_t)tok * DIN + 1920;
        float cs = 1.f, sn = 0.f;
        if (!isctx) {
          const float pos = (lane < 32) ? (float)(tpos >> 6) : (float)(tpos & 63);
          const float ang = pos * inv;
          cs = cosf(ang); sn = sinf(ang);
          if ((lane & 16) == 0) sn = -sn;
        }
#pragma unroll
        for (int hh = 0; hh < 2; ++hh) {
          float q = pr[hh * 256 + c];
          const float ms = wave_sum(q * q) * (1.f / 64.f);
          q = q * rsqrtf(ms + 1e-6f) * qn;
          if (!isctx) { const float qp = __shfl_xor(q, 16); q = q * cs + qp * sn; }
          if (isctx) p.QGc[(size_t)tok * 512 + hh * 256 + c] = f2bf(q * QSCALE);
          else p.QGl[(size_t)(tok - NCTX) * 512 + hh * 256 + c] = f2bf(q * QSCALE);
        }
        if (wid < 2) {
          float k = pr[512 + c];
          const float ms = wave_sum(k * k) * (1.f / 64.f);
          k = k * rsqrtf(ms + 1e-6f) * kn;
          if (isctx) {
            p.out_gk[((size_t)(b * 4 + layer) * 256 + tpos) * 128 + c] = k;
            p.KGc[(size_t)tok * 128 + c] = f2bf(k);
          } else {
            const float kp = __shfl_xor(k, 16); k = k * cs + kp * sn;
            p.KGl[((size_t)(layer * 2 + b) * 1536 + 512 + tpos) * 128 + c] = f2bf(k);
          }
        } else {
          const int cv = c - 128;
          const float v = pr[640 + cv];
          vv[tt] = v;
          if (isctx) p.out_gv[((size_t)(b * 4 + layer) * 256 + tpos) * 128 + cv] = v;
        }
      }
      if (wid >= 2) {
        const int cv = c - 128;
        if (isctx) pack8_store(p.VGtc + ((size_t)b * 128 + cv) * 256 + tpos0, vv);
        else pack8_store(p.VGtl + ((size_t)(layer * 2 + b) * 128 + cv) * 1536 + 512 + tpos0, vv);
      }
    }
    __syncthreads();
  }
}

__device__ __forceinline__ void attn_wave(const u16* __restrict__ Q, int ldq, const u16* __restrict__ Kb, int ldk,
                                          const u16* __restrict__ Vt, int ldv, int ndense, const bool NA,
                                          const float* __restrict__ rpb, int grow, int cq0,
                                          u16* __restrict__ out, int ldo, int tidx) {
  const int lane = tidx & 63, fr = lane & 15, fq = lane >> 4;
  bf16x8 qf[2];
#pragma unroll
  for (int ks = 0; ks < 2; ++ks) qf[ks] = *reinterpret_cast<const bf16x8*>(Q + (size_t)fr * ldq + ks * 32 + fq * 8);
  f32x4 o[4];
#pragma unroll
  for (int dt = 0; dt < 4; ++dt) o[dt] = (f32x4){0.f, 0.f, 0.f, 0.f};
  float m = -1e30f, l = 0.f;

  auto chunk = [&](int kb, const bool nb, int dr, int cc) {
    f32x4 s[2];
#pragma unroll
    for (int kt = 0; kt < 2; ++kt) {
      s[kt] = (f32x4){0.f, 0.f, 0.f, 0.f};
#pragma unroll
      for (int ks = 0; ks < 2; ++ks) {
        const bf16x8 kf = *reinterpret_cast<const bf16x8*>(Kb + (size_t)(kb + 16 * kt + fr) * ldk + ks * 32 + fq * 8);
        s[kt] = __builtin_amdgcn_mfma_f32_16x16x32_bf16(kf, qf[ks], s[kt], 0, 0, 0);
      }
    }
    bool ok[2][4];
    float mx = -1e30f;
#pragma unroll
    for (int kt = 0; kt < 2; ++kt)
#pragma unroll
      for (int r = 0; r < 4; ++r) {
        ok[kt][r] = true;
        if (nb) {
          const int cq = cq0 + fr, c0 = min(max(cq - 8, 0), 48);
          const int ck = cc * 32 + 16 * kt + 4 * fq + r;
          ok[kt][r] = (ck >= c0) && (ck < c0 + 16);
          const int dc = min(max(ck - cq, -15), 15) + 15;
          const float bias = rpb[dr * 31 + dc] * LOG2E;
          s[kt][r] = ok[kt][r] ? s[kt][r] + bias : -1e30f;
        }
        mx = fmaxf(mx, s[kt][r]);
      }
    mx = fmaxf(mx, __shfl_xor(mx, 16));
    mx = fmaxf(mx, __shfl_xor(mx, 32));
    const float mn = fmaxf(m, mx);
    const float alpha = exp2f(m - mn);
    m = mn;
    float pv[8]; float ps = 0.f;
#pragma unroll
    for (int kt = 0; kt < 2; ++kt)
#pragma unroll
      for (int r = 0; r < 4; ++r) {
        const float e = ok[kt][r] ? exp2f(s[kt][r] - mn) : 0.f;
        pv[kt * 4 + r] = e; ps += e;
      }
    l = l * alpha + ps;
    union { bf16x8 v; unsigned u[4]; } pf;
    pf.u[0] = pack2(pv[0], pv[1]); pf.u[1] = pack2(pv[2], pv[3]); pf.u[2] = pack2(pv[4], pv[5]); pf.u[3] = pack2(pv[6], pv[7]);
#pragma unroll
    for (int dt = 0; dt < 4; ++dt) {
      const u16* vp = Vt + (size_t)(16 * dt + fr) * ldv + kb + 4 * fq;
      const uint2 lo = *reinterpret_cast<const uint2*>(vp);
      const uint2 hi = *reinterpret_cast<const uint2*>(vp + 16);
      union { bf16x8 v; unsigned u[4]; } vf;
      vf.u[0] = lo.x; vf.u[1] = lo.y; vf.u[2] = hi.x; vf.u[3] = hi.y;
      o[dt][0] *= alpha; o[dt][1] *= alpha; o[dt][2] *= alpha; o[dt][3] *= alpha;
      o[dt] = __builtin_amdgcn_mfma_f32_16x16x32_bf16(vf.v, pf.v, o[dt], 0, 0, 0);
    }
  };

  for (int kb = 0; kb < ndense; kb += 32) chunk(kb, false, 0, 0);
  if (NA) {
    const int rb = min(max(grow - 4, 0), 8);
    const int ulo = min(max(cq0 - 8, 0), 48), uhi = min(max(cq0 + 15 - 8, 0), 48) + 16;
    for (int j = 0; j < 8; ++j) {
      const int krow = rb + j;
      const int dr = krow - grow + 7;
      for (int cc = 0; cc < 2; ++cc) {
        if (cc * 32 + 32 <= ulo || cc * 32 >= uhi) continue;
        chunk(512 + krow * 64 + cc * 32, true, dr, cc);
      }
    }
  }
  l += __shfl_xor(l, 16);
  l += __shfl_xor(l, 32);
  const float il = 1.f / l;
#pragma unroll
  for (int dt = 0; dt < 4; ++dt) {
    uint2 pk; pk.x = pack2(o[dt][0] * il, o[dt][1] * il); pk.y = pack2(o[dt][2] * il, o[dt][3] * il);
    *reinterpret_cast<uint2*>(out + (size_t)fr * ldo + 16 * dt + 4 * fq) = pk;
  }
}

__device__ void scan_item(const Params& p, int layer, char* smem, bool lat, int b, int h, int dir, int qd, int tidx) {
  const int tid = tidx, lane = tid & 63, wid = tid >> 6, rr = lane >> 4, j = lane & 15;
  const int L = lat ? 1024 : 256, seqbase = lat ? NCTX + b * 1024 : b * 256;
  const int rowl = wid * 4 + rr, row = qd * 16 + rowl;
  float* cbuf = reinterpret_cast<float*>(smem);
  float* obuf = cbuf + 2 * 16 * 6 * 64;
  float4 S = make_float4(0.f, 0.f, 0.f, 0.f);
  if (lat) S = *reinterpret_cast<const float4*>(p.in[2] + ((((size_t)(b * 4 + layer) * 2 + dir) * 4 + h) * 64 + row) * 64 + 4 * j);
  const int nch = L / 16;
  float* odst = dir == 0 ? p.OF : p.OB;
  float4 pre0, pre1, pre2, pre3, pre4, pre5;
#define SC_GL1(PR, I, CH) { const int idx = tid + 256 * (I), tt_ = idx / 96, rem = idx % 96, vec = rem >> 4, f4 = rem & 15; \
    const int st_ = (CH) * 16 + tt_, t_ = dir == 0 ? st_ : L - 1 - st_; const int svec = vec < 3 ? vec : vec + 3 * dir; \
    PR = *reinterpret_cast<const float4*>(p.SC + ((size_t)((seqbase + t_) * 4 + h) * 9 + svec) * 64 + f4 * 4); }
#define gload(CH) { SC_GL1(pre0, 0, CH) SC_GL1(pre1, 1, CH) SC_GL1(pre2, 2, CH) SC_GL1(pre3, 3, CH) SC_GL1(pre4, 4, CH) SC_GL1(pre5, 5, CH) }
#define SC_LS1(PR, I, BUF) *reinterpret_cast<float4*>(cbuf + (BUF) * 6144 + (tid + 256 * (I)) * 4) = PR;
#define lstore(BUF) { SC_LS1(pre0, 0, BUF) SC_LS1(pre1, 1, BUF) SC_LS1(pre2, 2, BUF) SC_LS1(pre3, 3, BUF) SC_LS1(pre4, 4, BUF) SC_LS1(pre5, 5, BUF) }
  gload(0); lstore(0);
  __syncthreads();
  for (int ch = 0; ch < nch; ++ch) {
    if (ch + 1 < nch) gload(ch + 1);
    const float* cb = cbuf + (ch & 1) * 6144;
    float* ob = obuf + (ch & 1) * 256;
#pragma unroll 4
    for (int tt = 0; tt < 16; ++tt) {
      const float* base = cb + tt * 384;
      const float4 r4 = *reinterpret_cast<const float4*>(base + 4 * j);
      const float4 kk4 = *reinterpret_cast<const float4*>(base + 64 + 4 * j);
      const float vv = base[128 + row];
      const float4 w4 = *reinterpret_cast<const float4*>(base + 192 + 4 * j);
      const float4 ak4 = *reinterpret_cast<const float4*>(base + 256 + 4 * j);
      const float4 kd4 = *reinterpret_cast<const float4*>(base + 320 + 4 * j);
      float sk = S.x * kk4.x + S.y * kk4.y + S.z * kk4.z + S.w * kk4.w;
      sk = reduce16(sk);
      S.x = S.x * w4.x + (vv * kd4.x - sk * ak4.x);
      S.y = S.y * w4.y + (vv * kd4.y - sk * ak4.y);
      S.z = S.z * w4.z + (vv * kd4.z - sk * ak4.z);
      S.w = S.w * w4.w + (vv * kd4.w - sk * ak4.w);
      float ov = S.x * r4.x + S.y * r4.y + S.z * r4.z + S.w * r4.w;
      ov = reduce16(ov);
      if (j == 0) ob[tt * 16 + rowl] = ov;
    }
    if (ch + 1 < nch) lstore((ch + 1) & 1);
    __syncthreads();
    {
      const int tt = tid >> 4, rl = tid & 15;
      const int st = ch * 16 + tt, t = dir == 0 ? st : L - 1 - st;
      odst[(size_t)(seqbase + t) * 256 + h * 64 + qd * 16 + rl] = ob[tt * 16 + rl];
    }
  }
  if (!lat) *reinterpret_cast<float4*>(p.out_st + ((((size_t)(b * 4 + layer) * 2 + dir) * 4 + h) * 64 + row) * 64 + 4 * j) = S;
  __syncthreads();
}

__device__ void mixer_phase(const Params& p, int layer, char* smem, int tidx) {
  const int tid = tidx, wid = tid >> 6;
  int* slot = reinterpret_cast<int*>(smem + 60 * 1024);
  for (;;) {
    __syncthreads();
    if (tid == 0) *slot = (int)atomicAdd(&p.wq[layer], 1u);
    __syncthreads();
    int it = *slot;
    if (it >= 1728) break;
    const bool is_scan = (it < 64) || (it >= 448 && it < 960);
    if (is_scan) {
      const bool lat = it < 64;
      const int si = lat ? it : it - 448;
      scan_item(p, layer, smem, lat, si / 32, (si / 8) % 4, (si / 4) % 2, si % 4, tidx);
      continue;
    }
    const u16 *Q, *Kb, *Vt; u16* out; int ldq, ldk, ldv, ndense, grow = 0, cq0 = 0; bool na = false;
    const float* rpb = p.in[23];
    if (it < 320) {
      it -= 64;
      const int b = it / 128, qh = (it / 16) % 8, qt = it % 16, kvh = qh >> 2;
      const int q0 = b * 1024 + qt * 64 + wid * 16;
      Q = p.QGl + (size_t)q0 * 512 + qh * 64; ldq = 512;
      Kb = p.KGl + (size_t)(layer * 2 + b) * 1536 * 128 + kvh * 64; ldk = 128;
      Vt = p.VGtl + ((size_t)(layer * 2 + b) * 128 + kvh * 64) * 1536; ldv = 1536; ndense = 1536;
      out = p.MIX + (size_t)(NCTX + q0) * DM + 512 + qh * 64;
    } else if (it < 448) {
      it -= 320;
      const int b = it / 64, h = (it / 16) % 4, r = it % 16;
      const int q0 = b * 1024 + r * 64 + wid * 16;
      Q = p.QNl + (size_t)q0 * 256 + h * 64; ldq = 256;
      Kb = p.KNl + (size_t)(layer * 2 + b) * 1536 * 256 + h * 64; ldk = 256;
      Vt = p.VNtl + ((size_t)(layer * 2 + b) * 256 + h * 64) * 1536; ldv = 1536; ndense = 512;
      rpb = p.in[23] + (size_t)(layer * 4 + h) * 15 * 31; grow = r; cq0 = wid * 16; na = true;
      out = p.MIX + (size_t)(NCTX + q0) * DM + 256 + h * 64;
    } else if (it < 1472) {
      it -= 960;
      const int b = it / 32, qh = (it / 4) % 8, qt = it % 4, kvh = qh >> 2;
      const int q0 = b * 256 + qt * 64 + wid * 16;
      Q = p.QGc + (size_t)q0 * 512 + qh * 64; ldq = 512;
      Kb = p.KGc + (size_t)b * 256 * 128 + kvh * 64; ldk = 128;
      Vt = p.VGtc + ((size_t)b * 128 + kvh * 64) * 256; ldv = 256; ndense = 256;
      out = p.MIX + (size_t)q0 * DM + 512 + qh * 64;
    } else {
      it -= 1472;
      const int b = it / 16, h = (it / 4) % 4, qt = it % 4;
      const int q0 = b * 256 + qt * 64 + wid * 16;
      Q = p.QNc + (size_t)q0 * 256 + h * 64; ldq = 256;
      Kb = p.KNc + (size_t)b * 256 * 256 + h * 64; ldk = 256;
      Vt = p.VNtc + ((size_t)b * 256 + h * 64) * 256; ldv = 256; ndense = 256;
      out = p.MIX + (size_t)q0 * DM + 256 + h * 64;
    }
    attn_wave(Q, ldq, Kb, ldk, Vt, ldv, ndense, na, rpb, grow, cq0, out, DM, tidx);
  }
}

__device__ void rwkv_fin_phase(const Params& p, int layer, int bid, int nblk, int tidx) {
  const int tid = tidx;
  const float lw = p.in[21][(size_t)layer * 256 + tid], lb = p.in[22][(size_t)layer * 256 + tid];
  for (int tok = bid; tok < NTOK; tok += nblk) {
    const size_t i = (size_t)tok * 256 + tid;
    const float o = p.OF[i] + p.OB[i];
    const float mu = wave_sum(o) * (1.f / 64.f);
    const float d = o - mu;
    const float var = wave_sum(d * d) * (1.f / 64.f);
    const float y = (d * rsqrtf(var + 64e-5f) * lw + lb + p.BV[i]) * p.G[i];
    p.MIX[(size_t)tok * DM + tid] = f2bf(y);
  }
}

#ifndef ONLY_PH
#define ONLY_PH -1
#endif
#define PH_EN(x) (ONLY_PH < 0 || ONLY_PH == (x))
__device__ __forceinline__ void run_phase(const Params& p, int ph, char* smem, int bid, int nblk, int tidx) {
  if (ph == 0) { if (PH_EN(0)) setup_phase(p, smem, bid, nblk, tidx); return; }
  if (ph == 1) { if (PH_EN(1)) modreduce_phase(p, bid, nblk, tidx); return; }
  if (ph == 2) { if (PH_EN(2)) ln_phase<0>(p, 0, bid, nblk, tidx); return; }
  const int layer = (ph - 3) / 9, s = (ph - 3) % 9;
  switch (s) {
    case 0: if (PH_EN(3)) gemm_phase<EPI_PROJ>(p, layer, p.A, p.winT + (size_t)layer * DIN * DM, DIN, DM, smem, bid, nblk, tidx); break;
    case 1: if (PH_EN(4)) prep_phase(p, layer, smem, bid, nblk, tidx); break;
    case 2: if (PH_EN(5)) mixer_phase(p, layer, smem, tidx); break;
    case 3: if (PH_EN(6)) rwkv_fin_phase(p, layer, bid, nblk, tidx); break;
    case 4: if (PH_EN(7)) gemm_phase<EPI_OUT>(p, layer, p.MIX, p.woutT + (size_t)layer * DM * DM, DM, DM, smem, bid, nblk, tidx); break;
    case 5: if (PH_EN(8)) ln_phase<1>(p, layer, bid, nblk, tidx); break;
    case 6: if (PH_EN(9)) gemm_phase<EPI_FFI>(p, layer, p.A, p.wfiT + (size_t)layer * 2 * DFF * DM, 2 * DFF, DM, smem, bid, nblk, tidx); break;
    case 7: if (PH_EN(10)) gemm_phase<EPI_FFO>(p, layer, p.ACT, p.wfoT + (size_t)layer * DM * DFF, DM, DFF, smem, bid, nblk, tidx); break;
    default: if (PH_EN(11)) ln_phase<2>(p, layer, bid, nblk, tidx); break;
  }
}

__global__ void __launch_bounds__(256, 2) fwd_kernel(Params p, int ph0, int ph1, int usebar) {
  __shared__ __attribute__((aligned(16))) char smem[65536];
  const int bid = blockIdx.x, nblk = gridDim.x;
  XcdBarrier xb;
  if (usebar && p.never) cg::this_grid().sync();
  __shared__ uint4 xb_words;
  if (usebar) {
    if (threadIdx.x == 0) xb_words = make_uint4(0u, 0u, 0u, 0u);
    __syncthreads();
    xb = xcd_barrier_post(p.bar, (volatile LAS unsigned*)&xb_words);
  }
  for (int ph = ph0; ph < ph1; ++ph) {
    int tidx = threadIdx.x;
    asm volatile("" : "+v"(tidx));
    run_phase(p, ph, smem, bid, nblk, tidx);
    if (usebar && ph + 1 < ph1) xcd_barrier(xb);
  }
}

static inline size_t al256(size_t x) { return (x + 255) & ~(size_t)255; }

extern "C" void kernel_launch(void* const* d_in, const int* in_sizes, int n_in, void* d_out, int out_size, void* d_ws, size_t ws_size,
                              hipStream_t stream) {
  Params p;
  memset(&p, 0, sizeof(p));
  for (int i = 0; i < 33; ++i) p.in[i] = (const float*)d_in[i];
  float* o = (float*)d_out;
  p.out_yp = o; o += 4194304;
  p.out_ys = o; o += 2097152;
  p.out_st = o; o += 2097152;
  p.out_nak = o; o += 4194304;
  p.out_nav = o; o += 4194304;
  p.out_gk = o; o += 2097152;
  p.out_gv = o;
  char* w = (char*)d_ws; size_t off = 0;
  auto take = [&](size_t bytes) { char* r = w + off; off += al256(bytes); return r; };
  p.bar = (unsigned*)take(16384);
  p.wq = p.bar + 3584;
  p.modp = (float*)take((size_t)4 * 32 * 3 * 6144 * 4);
  p.mod = (float*)take((size_t)4 * 3 * 6144 * 4);
  p.winT = (u16*)take((size_t)4 * DIN * DM * 2);
  p.woutT = (u16*)take((size_t)4 * DM * DM * 2);
  p.wfiT = (u16*)take((size_t)4 * 2 * DFF * DM * 2);
  p.wfoT = (u16*)take((size_t)4 * DM * DFF * 2);
  p.X = (float*)take((size_t)NTOK * DM * 4);
  p.PROJ = (float*)take((size_t)NTOK * DIN * 4);
  p.X1 = p.PROJ;
  p.Y = p.PROJ + (size_t)NTOK * DM;
  p.SC = (float*)take((size_t)NTOK * 4 * 9 * 64 * 4);
  p.ACT = (u16*)p.SC;
  p.G = (float*)take((size_t)NTOK * 256 * 4);
  p.BV = (float*)take((size_t)NTOK * 256 * 4);
  p.OF = (float*)take((size_t)NTOK * 256 * 4);
  p.OB = (float*)take((size_t)NTOK * 256 * 4);
  p.A = (u16*)take((size_t)NTOK * DM * 2);
  p.MIX = (u16*)take((size_t)NTOK * DM * 2);
  p.QNc = (u16*)take((size_t)NCTX * 256 * 2);
  p.KNc = (u16*)take((size_t)NCTX * 256 * 2);
  p.VNtc = (u16*)take((size_t)NCTX * 256 * 2);
  p.QGc = (u16*)take((size_t)NCTX * 512 * 2);
  p.KGc = (u16*)take((size_t)NCTX * 128 * 2);
  p.VGtc = (u16*)take((size_t)NCTX * 128 * 2);
  p.QNl = (u16*)take((size_t)2048 * 256 * 2);
  p.KNl = (u16*)take((size_t)4 * 2 * 1536 * 256 * 2);
  p.VNtl = (u16*)take((size_t)4 * 2 * 1536 * 256 * 2);
  p.QGl = (u16*)take((size_t)2048 * 512 * 2);
  p.KGl = (u16*)take((size_t)4 * 2 * 1536 * 128 * 2);
  p.VGtl = (u16*)take((size_t)4 * 2 * 1536 * 128 * 2);
  if (off > ws_size) { fprintf(stderr, "workspace too small: need %zu have %zu\n", off, ws_size); return; }

  (void)hipMemsetAsync(p.bar, 0, 16384, stream);
#if MEGA
  static int grid_blocks = 0;
  if (!grid_blocks) {
    int dev = 0, cus = 0, per_cu = 0;
    hipGetDevice(&dev);
    hipDeviceGetAttribute(&cus, hipDeviceAttributeMultiprocessorCount, dev);
    hipOccupancyMaxActiveBlocksPerMultiprocessor(&per_cu, fwd_kernel, 256, 0);
    if (per_cu > 2) per_cu = 2;
    if (per_cu < 1) per_cu = 1;
    grid_blocks = cus * per_cu;
  }
  int ph0 = 0, ph1 = NPH, ub = 1;
  void* args[] = {&p, &ph0, &ph1, &ub};
  hipError_t e = hipLaunchCooperativeKernel((void*)fwd_kernel, dim3(grid_blocks), dim3(256), args, 0, stream);
  if (e != hipSuccess) fprintf(stderr, "cooperative launch failed: %s (grid %d)\n", hipGetErrorString(e), grid_blocks);
#else
  for (int ph = 0; ph < NPH; ++ph) fwd_kernel<<<512, 256, 0, stream>>>(p, ph, ph + 1, 0);
#endif
}
```

```cpp
#include <hip/hip_runtime.h>
#include <hip/hip_cooperative_groups.h>
#include <cstdio>
#include <cstdint>
#include <cstring>
namespace cg = cooperative_groups;

#ifndef REPMASK
#define REPMASK 0
#endif
#ifndef MEGA
#define MEGA 1
#endif

typedef unsigned short u16;
using bf16x8 = __attribute__((ext_vector_type(8))) short;
using f32x4 = __attribute__((ext_vector_type(4))) float;

#define NTOK 6144
#define NCTX 4096
#define DM 1024
#define DIN 2688
#define DFF 2816
#define NPH 39
#define ALPHA 1.681792830507429f
#define LOG2E 1.4426950408889634f
#define QSCALE (0.125f * LOG2E)

struct Params {
  const float* in[33];
  float *out_yp, *out_ys, *out_st, *out_nak, *out_nav, *out_gk, *out_gv;
  unsigned *bar, *wq;
  float *modp, *mod;
  u16 *winT, *woutT, *wfiT, *wfoT;
  float *X, *X1, *Y, *PROJ, *SC, *G, *BV, *OF, *OB;
  u16 *A, *MIX, *ACT;
  u16 *QNc, *KNc, *VNtc, *QGc, *KGc, *VGtc;
  u16 *QNl, *KNl, *VNtl, *QGl, *KGl, *VGtl;
  u16* loraT; float* rope;
  int never; int pad;
};

__device__ __forceinline__ u16 f2bf(float f) {
  unsigned u = __float_as_uint(f);
  u += 0x7FFFu + ((u >> 16) & 1u);
  return (u16)(u >> 16);
}
__device__ __forceinline__ unsigned pack2(float a, float b) { return (unsigned)f2bf(a) | ((unsigned)f2bf(b) << 16); }
__device__ __forceinline__ float wave_sum(float v) {
#pragma unroll
  for (int o = 32; o; o >>= 1) v += __shfl_xor(v, o);
  return v;
}
template <int CTRL> __device__ __forceinline__ float dpp_mov(float v) {
  return __int_as_float(__builtin_amdgcn_update_dpp(0, __float_as_int(v), CTRL, 0xF, 0xF, false));
}
__device__ __forceinline__ float reduce16(float v) {
  v += dpp_mov<0xB1>(v);
  v += dpp_mov<0x4E>(v);
  v += dpp_mov<0x141>(v);
  v += dpp_mov<0x140>(v);
  return v;
}
__device__ __forceinline__ float sigmoidf_(float x) { return 1.f / (1.f + __expf(-x)); }
__device__ __forceinline__ float siluf_(float x) { return x / (1.f + __expf(-x)); }
__device__ __forceinline__ int modrow_of(int tok) { return tok < NCTX ? 0 : 1 + ((tok - NCTX) >> 10); }

#define XB_TMO      128
#define XB_XCNT(j)  (256  + 64 * (j))
#define XB_XSUB(j)  (1280 + 64 * (j))
#define XB_XGEN(j)  (2304 + 64 * (j))
#define XB_TOP      3328
#define XB_TOPGEN   3392
#define XCD_BAR_WORDS 3456
#define XB_SPIN_CAP (1u << 22)
#define LAS __attribute__((address_space(3)))
__device__ __forceinline__ unsigned xb_ld(unsigned* p) { return __hip_atomic_load(p, __ATOMIC_RELAXED, __HIP_MEMORY_SCOPE_AGENT); }
__device__ __forceinline__ unsigned xb_add(unsigned* p, unsigned v) { return __hip_atomic_fetch_add(p, v, __ATOMIC_RELAXED, __HIP_MEMORY_SCOPE_AGENT); }
__device__ __forceinline__ unsigned xb_xcc_id() { return (unsigned)__builtin_amdgcn_s_getreg((3 << 11) | 20) & 0xFu; }
#define XB_SPIN(cond, bar) do { unsigned _sp = 0; while (cond) { __builtin_amdgcn_s_sleep(1); \
    if ((++_sp & 255u) == 0u) { if (xb_ld(&(bar)[XB_TMO])) break; if (_sp > XB_SPIN_CAP) { atomicAdd(&(bar)[XB_TMO], 1u); break; } } } } while (0)
struct XcdBarrier { unsigned* bar; unsigned x; volatile LAS unsigned* st; };
__device__ __forceinline__ XcdBarrier xcd_barrier_post(unsigned* bar, volatile LAS unsigned* st) {
  XcdBarrier b; b.bar = bar; b.x = xb_xcc_id(); b.st = st;
  if (threadIdx.x == 0) (void)xb_add(&bar[XB_XCNT(b.x)], 1u);
  return b;
}
__device__ __forceinline__ void xcd_barrier_complete(unsigned* bar, unsigned x, unsigned& nloc, unsigned& nx) {
  const unsigned G = gridDim.x * gridDim.y * gridDim.z;
  unsigned sum, cnt, mine, sp = 0u;
  for (;;) {
    sum = 0u; cnt = 0u; mine = 0u;
#pragma unroll
    for (unsigned j = 0; j < 16; ++j) { const unsigned c = xb_ld(&bar[XB_XCNT(j)]); sum += c; cnt += (c > 0u) ? 1u : 0u; mine = (j == x) ? c : mine; }
    if (sum == G) break;
    __builtin_amdgcn_s_sleep(1);
    if ((++sp & 255u) == 0u) { if (xb_ld(&bar[XB_TMO])) break; if (sp > XB_SPIN_CAP) { atomicAdd(&bar[XB_TMO], 1u); break; } }
  }
  nloc = mine > 0u ? mine : 1u; nx = cnt > 0u ? cnt : 1u;
}
__device__ __forceinline__ void xcd_barrier(const XcdBarrier& b) {
  asm volatile("s_waitcnt vmcnt(0)" ::: "memory");
  __syncthreads();
  if (threadIdx.x == 0) {
    unsigned* bar = b.bar;
    __builtin_amdgcn_s_waitcnt(0);
    unsigned nloc = b.st[0], nx = b.st[1];
    if (nloc == 0u) { xcd_barrier_complete(bar, b.x, nloc, nx); b.st[0] = nloc; b.st[1] = nx; }
    const unsigned old = xb_add(&bar[XB_XSUB(b.x)], 1u);
    const unsigned gen = old / nloc;
    if (old + 1u == (gen + 1u) * nloc) {
      __builtin_amdgcn_fence(__ATOMIC_RELEASE, "agent");
      asm volatile("s_waitcnt vmcnt(0)" ::: "memory");
      const unsigned og = xb_add(&bar[XB_TOP], 1u);
      const unsigned tg = og / nx;
      if (og + 1u == (tg + 1u) * nx) xb_add(&bar[XB_TOPGEN], 1u);
      else XB_SPIN(xb_ld(&bar[XB_TOPGEN]) == tg, bar);
      __builtin_amdgcn_fence(__ATOMIC_ACQUIRE, "agent");
      xb_add(&bar[XB_XGEN(b.x)], 1u);
      asm volatile("s_waitcnt vmcnt(0)" ::: "memory");
    } else {
      XB_SPIN(xb_ld(&bar[XB_XGEN(b.x)]) == gen, bar);
      __builtin_amdgcn_fence(__ATOMIC_ACQUIRE, "agent");
      asm volatile("s_waitcnt vmcnt(0)" ::: "memory");
    }
  }
  __syncthreads();
}

__device__ __forceinline__ int lds_byte32(int r, int c) {
  const int ob = (r & 15) * 64 + c * 2;
  return (r >> 4) * 1024 + (ob ^ (((ob >> 9) & 1) << 5));
}
__device__ __forceinline__ void stage_rc32(int b, int& R, int& C) {
  const int sb = b & 1023, swz = sb ^ (((sb >> 9) & 1) << 5);
  R = (b >> 10) * 16 + (swz >> 6); C = (swz & 63) >> 1;
}
template <int ROWS>
__device__ __forceinline__ void stage_tile32(const u16* __restrict__ g, int ld, char* lds, int tidx) {
#pragma unroll
  for (int i = 0; i < 2; ++i) {
    const int b = tidx * 16 + i * 4096;
    if (i == 0 || ROWS == 128 || tidx < 128) {
      int R, C; stage_rc32(b, R, C);
      __builtin_amdgcn_global_load_lds((const unsigned*)(g + (size_t)R * ld + C), (unsigned LAS*)(lds + b), 16, 0, 0);
    }
  }
}

enum { EPI_PROJ = 0, EPI_OUT = 1, EPI_FFI = 2, EPI_FFO = 3 };

template <int EPI, int BM>
__device__ __forceinline__ void gemm_phase(const Params& p, int layer, const u16* __restrict__ A, const u16* __restrict__ Bt,
                                           int N, int K, char* smem, int bid, int nblk, int tidx) {
  constexpr int MF = BM / 32;
  const int tid = tidx, lane = tid & 63, wid = tid >> 6, wr = wid >> 1, wc = wid & 1, fr = lane & 15, fq = lane >> 4;
  const int nM = NTOK / BM, nN = N / 128, ntiles = nM * nN, nk = K / 32;
  const bool fullA = (BM == 128) || (wid < 2);
  for (int tile = bid; tile < ntiles; tile += nblk) {
    const int pm = tile % nM, pn = tile / nM, m0 = pm * BM, n0 = pn * 128;
    f32x4 acc[MF][4];
#pragma unroll
    for (int m = 0; m < MF; ++m)
#pragma unroll
      for (int n = 0; n < 4; ++n) acc[m][n] = (f32x4){0.f, 0.f, 0.f, 0.f};
    const u16* Ag = A + (size_t)m0 * K;
    const u16* Bg = Bt + (size_t)n0 * K;
#pragma unroll
    for (int s = 0; s < 3; ++s) {
      stage_tile32<BM>(Ag + s * 32, K, smem + s * 16384, tidx);
      stage_tile32<128>(Bg + s * 32, K, smem + s * 16384 + 8192, tidx);
    }
    for (int kt = 0; kt < nk; ++kt) {
      if (kt + 2 < nk) {
        if (fullA) asm volatile("s_waitcnt vmcnt(8)" ::: "memory");
        else asm volatile("s_waitcnt vmcnt(6)" ::: "memory");
      } else {
        asm volatile("s_waitcnt vmcnt(0)" ::: "memory");
      }
      __builtin_amdgcn_s_barrier();
      if (kt + 3 < nk) {
        char* nb = smem + ((kt + 3) & 3) * 16384;
        stage_tile32<BM>(Ag + (kt + 3) * 32, K, nb, tidx);
        stage_tile32<128>(Bg + (kt + 3) * 32, K, nb + 8192, tidx);
      }
      const char* sa = smem + (kt & 3) * 16384;
      const char* sb = sa + 8192;
      bf16x8 af[MF], bfr[4];
#pragma unroll
      for (int m = 0; m < MF; ++m) af[m] = *reinterpret_cast<const bf16x8*>(sa + lds_byte32(wr * (BM / 2) + m * 16 + fr, fq * 8));
#pragma unroll
      for (int n = 0; n < 4; ++n) bfr[n] = *reinterpret_cast<const bf16x8*>(sb + lds_byte32(wc * 64 + n * 16 + fr, fq * 8));
#pragma unroll
      for (int m = 0; m < MF; ++m)
#pragma unroll
        for (int n = 0; n < 4; ++n) acc[m][n] = __builtin_amdgcn_mfma_f32_16x16x32_bf16(bfr[n], af[m], acc[m][n], 0, 0, 0);
    }
#pragma unroll
    for (int m = 0; m < MF; ++m) {
      const int row = m0 + wr * (BM / 2) + m * 16 + fr;
      if (EPI == EPI_PROJ) {
#pragma unroll
        for (int n = 0; n < 4; ++n) {
          const int col = n0 + wc * 64 + n * 16 + 4 * fq;
          *reinterpret_cast<float4*>(p.PROJ + (size_t)row * DIN + col) = make_float4(acc[m][n][0], acc[m][n][1], acc[m][n][2], acc[m][n][3]);
        }
      } else if (EPI == EPI_OUT || EPI == EPI_FFO) {
        const float* res = (EPI == EPI_OUT) ? p.X : p.X1;
        const float* gate = p.mod + ((size_t)(layer * 3 + modrow_of(row)) * 6 + (EPI == EPI_OUT ? 2 : 5)) * 1024;
#pragma unroll
        for (int n = 0; n < 4; ++n) {
          const int col = n0 + wc * 64 + n * 16 + 4 * fq;
          const float4 xr = *reinterpret_cast<const float4*>(res + (size_t)row * DM + col);
          const float4 gt = *reinterpret_cast<const float4*>(gate + col);
          float4 y;
          y.x = ALPHA * xr.x + gt.x * acc[m][n][0];
          y.y = ALPHA * xr.y + gt.y * acc[m][n][1];
          y.z = ALPHA * xr.z + gt.z * acc[m][n][2];
          y.w = ALPHA * xr.w + gt.w * acc[m][n][3];
          *reinterpret_cast<float4*>(p.Y + (size_t)row * DM + col) = y;
        }
      } else {
#pragma unroll
        for (int n2 = 0; n2 < 2; ++n2) {
          const int j0 = ((n0 + wc * 64) / 32 + n2) * 16 + 4 * fq;
          float a[4];
#pragma unroll
          for (int r = 0; r < 4; ++r) a[r] = siluf_(acc[m][2 * n2][r]) * acc[m][2 * n2 + 1][r];
          uint2 pk; pk.x = pack2(a[0], a[1]); pk.y = pack2(a[2], a[3]);
          *reinterpret_cast<uint2*>(p.ACT + (size_t)row * DFF + j0) = pk;
        }
      }
    }
    __syncthreads();
  }
}

__device__ __forceinline__ void pack8_store(u16* dst, const float* v) {
  uint4 pk; pk.x = pack2(v[0], v[1]); pk.y = pack2(v[2], v[3]); pk.z = pack2(v[4], v[5]); pk.w = pack2(v[6], v[7]);
  *reinterpret_cast<uint4*>(dst) = pk;
}

__device__ void setup_phase(const Params& p, char* smem, int bid, int nblk, int tidx) {
  const int tid = tidx;
  const int NI = 768 + 512 + 4 * 3040 + 13;
  for (int it = bid; it < NI; it += nblk) {
    if (it < 768) {
      const int l = it / 192, nc = (it / 32) % 6, kc = it % 32;
      const int col = nc * 1024 + tid * 4;
      const float* wm = p.in[9] + (size_t)l * 1024 * 6144;
      float4 a0 = make_float4(0, 0, 0, 0), a1 = a0, a2 = a0;
      for (int kk = 0; kk < 32; ++kk) {
        const int k = kc * 32 + kk;
        const float s0 = siluf_(p.in[8][k]), s1 = siluf_(p.in[7][k]), s2 = siluf_(p.in[7][1024 + k]);
        const float4 w = *reinterpret_cast<const float4*>(wm + (size_t)k * 6144 + col);
        a0.x += s0 * w.x; a0.y += s0 * w.y; a0.z += s0 * w.z; a0.w += s0 * w.w;
        a1.x += s1 * w.x; a1.y += s1 * w.y; a1.z += s1 * w.z; a1.w += s1 * w.w;
        a2.x += s2 * w.x; a2.y += s2 * w.y; a2.z += s2 * w.z; a2.w += s2 * w.w;
      }
      float* dst = p.modp + (size_t)((l * 32 + kc) * 3) * 6144 + col;
      *reinterpret_cast<float4*>(dst) = a0;
      *reinterpret_cast<float4*>(dst + 6144) = a1;
      *reinterpret_cast<float4*>(dst + 2 * 6144) = a2;
    } else if (it < 1280) {
      const int ci = it - 768, b = ci / 256, l = (ci / 64) % 4, tg = ci % 64, t0 = tg * 8;
      {
        const float* ck = p.in[3] + ((size_t)(b * 4 + l) * 512 + t0) * 256 + tid;
        const float* cv = p.in[4] + ((size_t)(b * 4 + l) * 512 + t0) * 256 + tid;
        float v[8];
#pragma unroll
        for (int tt = 0; tt < 8; ++tt) {
          p.KNl[((size_t)(l * 2 + b) * 1536 + t0 + tt) * 256 + tid] = f2bf(ck[tt * 256]);
          v[tt] = cv[tt * 256];
        }
        pack8_store(p.VNtl + ((size_t)(l * 2 + b) * 256 + tid) * 1536 + t0, v);
      }
      if (tid < 128) {
        const float* ck = p.in[5] + ((size_t)(b * 4 + l) * 512 + t0) * 128 + tid;
#pragma unroll
        for (int tt = 0; tt < 8; ++tt) p.KGl[((size_t)(l * 2 + b) * 1536 + t0 + tt) * 128 + tid] = f2bf(ck[tt * 128]);
      } else {
        const int c = tid - 128;
        const float* cv = p.in[6] + ((size_t)(b * 4 + l) * 512 + t0) * 128 + c;
        float v[8];
#pragma unroll
        for (int tt = 0; tt < 8; ++tt) v[tt] = cv[tt * 128];
        pack8_store(p.VGtl + ((size_t)(l * 2 + b) * 128 + c) * 1536 + t0, v);
      }
    } else if (it >= 768 + 512 + 4 * 3040) {
      const int li = it - (768 + 512 + 4 * 3040);
      if (li == 12) {
        for (int idx = tid; idx < 1024; idx += 256) {
          const int pos = idx >> 4, fi = idx & 15;
          const float ang = (float)pos * exp2f(-(float)fi * (13.287712379549449f / 16.f));
          p.rope[idx * 2] = cosf(ang); p.rope[idx * 2 + 1] = sinf(ang);
        }
      } else {
        const int l = li / 3, m = li % 3;
        u16* dst = p.loraT + (size_t)l * 98304 + m * 32768;
        if (m < 2) {
          const float* src = p.in[m == 0 ? 14 : 16] + (size_t)l * 32768;
          for (int idx = tid; idx < 32768; idx += 256) {
            const int d = idx >> 14, cch = (idx >> 6) & 255, r = idx & 63;
            dst[idx] = f2bf(src[(d * 64 + r) * 256 + cch]);
          }
        } else {
          const float* src = p.in[17] + (size_t)l * 32768;
          for (int idx = tid; idx < 32768; idx += 256) {
            const int cch = idx >> 7, j = idx & 127;
            dst[idx] = f2bf(src[j * 256 + cch]);
          }
        }
      }
    } else {
      const int wi = it - 1280, l = wi / 3040; int r = wi % 3040;
      const float* src; u16* dst; int K, N, mat, kt, nt;
      if (r < 672) { mat = 0; K = 1024; N = 2688; src = p.in[11] + (size_t)l * K * N; dst = p.winT + (size_t)l * N * K; kt = r / 42; nt = r % 42; }
      else if (r < 928) { r -= 672; mat = 1; K = 1024; N = 1024; src = p.in[26] + (size_t)l * K * N; dst = p.woutT + (size_t)l * N * K; kt = r / 16; nt = r % 16; }
      else if (r < 2336) { r -= 928; mat = 2; K = 1024; N = 5632; src = p.in[29] + (size_t)l * K * N; dst = p.wfiT + (size_t)l * N * K; kt = r / 88; nt = r % 88; }
      else { r -= 2336; mat = 3; K = 2816; N = 1024; src = p.in[30] + (size_t)l * K * N; dst = p.wfoT + (size_t)l * N * K; kt = r / 16; nt = r % 16; }
      float* tile = reinterpret_cast<float*>(smem);
      const int k0 = kt * 64, n0 = nt * 64;
#pragma unroll
      for (int i = 0; i < 4; ++i) {
        const int kr = (tid >> 4) + 16 * i, c4 = (tid & 15) * 4;
        const float4 v = *reinterpret_cast<const float4*>(src + (size_t)(k0 + kr) * N + n0 + c4);
        tile[kr * 65 + c4 + 0] = v.x; tile[kr * 65 + c4 + 1] = v.y; tile[kr * 65 + c4 + 2] = v.z; tile[kr * 65 + c4 + 3] = v.w;
      }
      __syncthreads();
#pragma unroll
      for (int i = 0; i < 2; ++i) {
        const int idx = tid + 256 * i, nl = idx >> 3, kc = idx & 7;
        int n = n0 + nl;
        if (mat == 2) { const int isup = n >= DFF ? 1 : 0; const int j = n - isup * DFF; n = (j >> 4) * 32 + isup * 16 + (j & 15); }
        float v[8];
#pragma unroll
        for (int jj = 0; jj < 8; ++jj) v[jj] = tile[(kc * 8 + jj) * 65 + nl];
        pack8_store(dst + (size_t)n * K + k0 + kc * 8, v);
      }
      __syncthreads();
    }
  }
}

__device__ void modreduce_phase(const Params& p, int bid, int nblk, int tidx) {
  for (int idx = bid * 256 + tidx; idx < 18432; idx += nblk * 256) {
    const int l = idx / 4608, rem = idx % 4608, mr = rem / 1536, c4 = (rem % 1536) * 4;
    float4 a = *reinterpret_cast<const float4*>(p.in[10] + (size_t)l * 6144 + c4);
    for (int kc = 0; kc < 32; ++kc) {
      const float4 v = *reinterpret_cast<const float4*>(p.modp + (size_t)((l * 32 + kc) * 3 + mr) * 6144 + c4);
      a.x += v.x; a.y += v.y; a.z += v.z; a.w += v.w;
    }
    *reinterpret_cast<float4*>(p.mod + (size_t)(l * 3 + mr) * 6144 + c4) = a;
  }
}

template <int MODE>
__device__ void ln_phase(const Params& p, int layer, int bid, int nblk, int tidx) {
  const int lane = tidx & 63, wid = tidx >> 6;
  for (int it = bid; it < NTOK / 4; it += nblk) {
    const int row = it * 4 + wid;
    const float* src;
    if (MODE == 0) src = row < NCTX ? p.in[0] + (size_t)row * DM : p.in[1] + (size_t)(row - NCTX) * DM;
    else src = p.Y + (size_t)row * DM;
    float4 v[4];
#pragma unroll
    for (int i = 0; i < 4; ++i) v[i] = reinterpret_cast<const float4*>(src)[lane + 64 * i];
    if (MODE != 0) {
      float s = 0.f;
#pragma unroll
      for (int i = 0; i < 4; ++i) s += v[i].x + v[i].y + v[i].z + v[i].w;
      const float mu = wave_sum(s) * (1.f / 1024.f);
      float q = 0.f;
#pragma unroll
      for (int i = 0; i < 4; ++i) {
        v[i].x -= mu; v[i].y -= mu; v[i].z -= mu; v[i].w -= mu;
        q += v[i].x * v[i].x + v[i].y * v[i].y + v[i].z * v[i].z + v[i].w * v[i].w;
      }
      const float rstd = rsqrtf(wave_sum(q) * (1.f / 1024.f) + 1e-5f);
      const float* lw = (MODE == 1 ? p.in[27] : p.in[31]) + (size_t)layer * DM;
      const float* lb = (MODE == 1 ? p.in[28] : p.in[32]) + (size_t)layer * DM;
#pragma unroll
      for (int i = 0; i < 4; ++i) {
        const float4 w = reinterpret_cast<const float4*>(lw)[lane + 64 * i];
        const float4 b = reinterpret_cast<const float4*>(lb)[lane + 64 * i];
        v[i].x = v[i].x * rstd * w.x + b.x; v[i].y = v[i].y * rstd * w.y + b.y;
        v[i].z = v[i].z * rstd * w.z + b.z; v[i].w = v[i].w * rstd * w.w + b.w;
      }
    }
    float* xdst = (MODE == 1 ? p.X1 : p.X) + (size_t)row * DM;
#pragma unroll
    for (int i = 0; i < 4; ++i) reinterpret_cast<float4*>(xdst)[lane + 64 * i] = v[i];
    if (MODE == 2 && layer == 3) {
      float* o = row < NCTX ? p.out_yp + (size_t)row * DM : p.out_ys + (size_t)(row - NCTX) * DM;
#pragma unroll
      for (int i = 0; i < 4; ++i) reinterpret_cast<float4*>(o)[lane + 64 * i] = v[i];
    } else {
      const int ml = (MODE == 2) ? layer + 1 : layer;
      const int which = (MODE == 1) ? 3 : 0;
      const float* sh = p.mod + ((size_t)(ml * 3 + modrow_of(row)) * 6 + which) * 1024;
      const float* sc = sh + 1024;
      u16* adst = p.A + (size_t)row * DM;
#pragma unroll
      for (int i = 0; i < 4; ++i) {
        const float4 s4 = reinterpret_cast<const float4*>(sh)[lane + 64 * i];
        const float4 c4 = reinterpret_cast<const float4*>(sc)[lane + 64 * i];
        uint2 pk;
        pk.x = pack2(v[i].x * (1.f + c4.x) + s4.x, v[i].y * (1.f + c4.y) + s4.y);
        pk.y = pack2(v[i].z * (1.f + c4.z) + s4.z, v[i].w * (1.f + c4.w) + s4.w);
        reinterpret_cast<uint2*>(adst)[lane + 64 * i] = pk;
      }
    }
  }
}

#define FLD 772
#define LLD 392
__device__ void prep_phase(const Params& p, int layer, char* smem, int bid, int nblk, int tidx) {
  float* F = reinterpret_cast<float*>(smem);
  u16* LIb = reinterpret_cast<u16*>(smem + 16 * FLD * 4);
  const float* cw = p.in[12] + (size_t)layer * 3 * 1152;
  const u16* LW = p.loraT + (size_t)layer * 98304;
  for (int it = bid; it < NTOK / 16; it += nblk) {
    int tid = tidx;
    asm volatile("" : "+v"(tid));
    const int lane = tid & 63, wid = tid >> 6, fr = lane & 15, fq = lane >> 4;
    const int tok0 = it * 16;
    int b, tpos0, L;
    const bool isctx = tok0 < NCTX;
    if (isctx) { b = tok0 >> 8; tpos0 = tok0 & 255; L = 256; }
    else { const int tl = tok0 - NCTX; b = tl >> 10; tpos0 = tl & 1023; L = 1024; }
#pragma unroll 2
    for (int idx = tid; idx < 16 * 288; idx += 256) {
      const int tt = idx / 288, c = (idx % 288) * 4, tpos = tpos0 + tt;
      const float* pr = p.PROJ + (size_t)(tok0 + tt) * DIN + c;
      const float4 w0 = *reinterpret_cast<const float4*>(cw + c);
      const float4 w1 = *reinterpret_cast<const float4*>(cw + 1152 + c);
      const float4 w2 = *reinterpret_cast<const float4*>(cw + 2304 + c);
      const float4 xc = *reinterpret_cast<const float4*>(pr);
      float4 f = make_float4(w1.x * xc.x, w1.y * xc.y, w1.z * xc.z, w1.w * xc.w);
      if (tpos > 0) { const float4 xp = *reinterpret_cast<const float4*>(pr - DIN); f.x += w0.x * xp.x; f.y += w0.y * xp.y; f.z += w0.z * xp.z; f.w += w0.w * xp.w; }
      if (tpos < L - 1) { const float4 xn = *reinterpret_cast<const float4*>(pr + DIN); f.x += w2.x * xn.x; f.y += w2.y * xn.y; f.z += w2.z * xn.z; f.w += w2.w * xn.w; }
      if (c < 768) { *reinterpret_cast<float4*>(F + tt * FLD + c) = f; }
      else {
        const int cc = c - 768;
        if (cc < 128) { f.x = tanhf(f.x); f.y = tanhf(f.y); f.z = tanhf(f.z); f.w = tanhf(f.w); }
        else if (cc >= 256) { f.x = sigmoidf_(f.x); f.y = sigmoidf_(f.y); f.z = sigmoidf_(f.z); f.w = sigmoidf_(f.w); }
        uint2 pk; pk.x = pack2(f.x, f.y); pk.y = pack2(f.z, f.w);
        *reinterpret_cast<uint2*>(LIb + tt * LLD + cc) = pk;
      }
    }
    __syncthreads();
    f32x4 acc[5][4];
#pragma unroll
    for (int g = 0; g < 5; ++g)
#pragma unroll
      for (int nf = 0; nf < 4; ++nf) acc[g][nf] = (f32x4){0.f, 0.f, 0.f, 0.f};
#pragma unroll
    for (int g = 0; g < 4; ++g) {
      const u16* wt = LW + (size_t)g * 16384;
#pragma unroll
      for (int ks = 0; ks < 2; ++ks) {
        const bf16x8 xb = *reinterpret_cast<const bf16x8*>(LIb + fr * LLD + g * 64 + ks * 32 + fq * 8);
#pragma unroll
        for (int nf = 0; nf < 4; ++nf) {
          const bf16x8 wa = *reinterpret_cast<const bf16x8*>(wt + (size_t)(64 * wid + 16 * nf + fr) * 64 + ks * 32 + fq * 8);
          acc[g][nf] = __builtin_amdgcn_mfma_f32_16x16x32_bf16(wa, xb, acc[g][nf], 0, 0, 0);
        }
      }
      __builtin_amdgcn_sched_barrier(0);
    }
    {
      const u16* wt = LW + 65536;
#pragma unroll
      for (int ks = 0; ks < 4; ++ks) {
        const bf16x8 xb = *reinterpret_cast<const bf16x8*>(LIb + fr * LLD + 256 + ks * 32 + fq * 8);
#pragma unroll
        for (int nf = 0; nf < 4; ++nf) {
          const bf16x8 wa = *reinterpret_cast<const bf16x8*>(wt + (size_t)(64 * wid + 16 * nf + fr) * 128 + ks * 32 + fq * 8);
          acc[4][nf] = __builtin_amdgcn_mfma_f32_16x16x32_bf16(wa, xb, acc[4][nf], 0, 0, 0);
        }
        if (ks == 1) __builtin_amdgcn_sched_barrier(0);
      }
      __builtin_amdgcn_sched_barrier(0);
    }
#ifndef NO_C
    {
      const int tok = tok0 + fr;
      float ss = 0.f, bs = 0.f;
#pragma unroll
      for (int nf = 0; nf < 4; ++nf) {
        const int c0 = 64 * wid + 16 * nf + 4 * fq;
        const float4 r4 = *reinterpret_cast<const float4*>(F + fr * FLD + c0);
        const float4 k4 = *reinterpret_cast<const float4*>(F + fr * FLD + 256 + c0);
        const float4 w00 = *reinterpret_cast<const float4*>(p.in[13] + (size_t)layer * 512 + c0);
        const float4 w01 = *reinterpret_cast<const float4*>(p.in[13] + (size_t)layer * 512 + 256 + c0);
        const float4 a00 = *reinterpret_cast<const float4*>(p.in[15] + (size_t)layer * 512 + c0);
        const float4 a01 = *reinterpret_cast<const float4*>(p.in[15] + (size_t)layer * 512 + 256 + c0);
        const float4 kkw = *reinterpret_cast<const float4*>(p.in[18] + (size_t)layer * 256 + c0);
        const float4 kaw = *reinterpret_cast<const float4*>(p.in[19] + (size_t)layer * 256 + c0);
        const float4 rkw = *reinterpret_cast<const float4*>(p.in[20] + (size_t)layer * 256 + c0);
        const float rr[4] = {r4.x, r4.y, r4.z, r4.w}, kk_[4] = {k4.x, k4.y, k4.z, k4.w};
        const float w0a[4] = {w00.x, w00.y, w00.z, w00.w}, w0b[4] = {w01.x, w01.y, w01.z, w01.w};
        const float a0a[4] = {a00.x, a00.y, a00.z, a00.w}, a0b[4] = {a01.x, a01.y, a01.z, a01.w};
        const float kkw_[4] = {kkw.x, kkw.y, kkw.z, kkw.w}, kaw_[4] = {kaw.x, kaw.y, kaw.z, kaw.w}, rkw_[4] = {rkw.x, rkw.y, rkw.z, rkw.w};
#pragma unroll
        for (int r = 0; r < 4; ++r) {
          {
            const float z = -(w0a[r] + acc[0][nf][r]);
            const float sp = fmaxf(z, 0.f) + log1pf(__expf(-fabsf(z)));
            acc[0][nf][r] = __expf(-__expf(-sp - 0.5f));
          }
          {
            const float z = -(w0b[r] + acc[1][nf][r]);
            const float sp = fmaxf(z, 0.f) + log1pf(__expf(-fabsf(z)));
            acc[1][nf][r] = __expf(-__expf(-sp - 0.5f));
          }
          const float av0 = sigmoidf_(a0a[r] + acc[2][nf][r]);
          const float av1 = sigmoidf_(a0b[r] + acc[3][nf][r]);
          acc[2][nf][r] = av0; acc[3][nf][r] = av1;
          const float k = kk_[r];
          const float kq = k * kkw_[r];
          ss += kq * kq;
          const float kd0 = k * (1.f + (av0 - 1.f) * kaw_[r]);
          const float kd1 = k * (1.f + (av1 - 1.f) * kaw_[r]);
          bs += rr[r] * (kd0 + kd1) * rkw_[r];
        }
        __builtin_amdgcn_sched_barrier(0);
      }
      ss += __shfl_xor(ss, 16); ss += __shfl_xor(ss, 32);
      bs += __shfl_xor(bs, 16); bs += __shfl_xor(bs, 32);
      const float inrm = 1.f / fmaxf(sqrtf(ss), 1e-12f);
#pragma unroll
      for (int nf = 0; nf < 4; ++nf) {
        const int c0 = 64 * wid + 16 * nf + 4 * fq, n0 = 16 * nf + 4 * fq;
        const float4 r4 = *reinterpret_cast<const float4*>(F + fr * FLD + c0);
        const float4 k4 = *reinterpret_cast<const float4*>(F + fr * FLD + 256 + c0);
        const float4 v4 = *reinterpret_cast<const float4*>(F + fr * FLD + 512 + c0);
        const float4 kkw = *reinterpret_cast<const float4*>(p.in[18] + (size_t)layer * 256 + c0);
        const float4 kaw = *reinterpret_cast<const float4*>(p.in[19] + (size_t)layer * 256 + c0);
        const float kk_[4] = {k4.x, k4.y, k4.z, k4.w}, kkw_[4] = {kkw.x, kkw.y, kkw.z, kkw.w}, kaw_[4] = {kaw.x, kaw.y, kaw.z, kaw.w};
        float* sc = p.SC + ((size_t)(tok * 4 + wid) * 9) * 64 + n0;
        float kn[4], kd0[4], kd1[4];
#pragma unroll
        for (int r = 0; r < 4; ++r) {
          kn[r] = kk_[r] * kkw_[r] * inrm;
          kd0[r] = kk_[r] * (1.f + (acc[2][nf][r] - 1.f) * kaw_[r]);
          kd1[r] = kk_[r] * (1.f + (acc[3][nf][r] - 1.f) * kaw_[r]);
        }
        *reinterpret_cast<float4*>(sc) = r4;
        *reinterpret_cast<float4*>(sc + 64) = make_float4(kn[0], kn[1], kn[2], kn[3]);
        *reinterpret_cast<float4*>(sc + 128) = v4;
        *reinterpret_cast<float4*>(sc + 192) = make_float4(acc[0][nf][0], acc[0][nf][1], acc[0][nf][2], acc[0][nf][3]);
        *reinterpret_cast<float4*>(sc + 256) = make_float4(acc[2][nf][0] * kn[0], acc[2][nf][1] * kn[1], acc[2][nf][2] * kn[2], acc[2][nf][3] * kn[3]);
        *reinterpret_cast<float4*>(sc + 320) = make_float4(kd0[0], kd0[1], kd0[2], kd0[3]);
        *reinterpret_cast<float4*>(sc + 384) = make_float4(acc[1][nf][0], acc[1][nf][1], acc[1][nf][2], acc[1][nf][3]);
        *reinterpret_cast<float4*>(sc + 448) = make_float4(acc[3][nf][0] * kn[0], acc[3][nf][1] * kn[1], acc[3][nf][2] * kn[2], acc[3][nf][3] * kn[3]);
        *reinterpret_cast<float4*>(sc + 512) = make_float4(kd1[0], kd1[1], kd1[2], kd1[3]);
        *reinterpret_cast<float4*>(p.G + (size_t)tok * 256 + c0) = make_float4(acc[4][nf][0], acc[4][nf][1], acc[4][nf][2], acc[4][nf][3]);
        *reinterpret_cast<float4*>(p.BV + (size_t)tok * 256 + c0) = make_float4(bs * v4.x, bs * v4.y, bs * v4.z, bs * v4.w);
        __builtin_amdgcn_sched_barrier(0);
      }
    }
#endif
#ifndef NO_D
    const int c = tid;
#pragma unroll
    for (int half = 0; half < 2; ++half) {
      float vv[8];
#pragma unroll
      for (int t8 = 0; t8 < 8; ++t8) {
        const int tt = half * 8 + t8, tok = tok0 + tt;
        const float* pr = p.PROJ + (size_t)tok * DIN + 1152 + c;
        const float q = pr[0], k = pr[256], v = pr[512];
        vv[t8] = v;
        if (isctx) {
          const size_t oi = ((size_t)(b * 4 + layer) * 256 + tpos0 + tt) * 256 + c;
          p.out_nak[oi] = k; p.out_nav[oi] = v;
          p.QNc[(size_t)tok * 256 + c] = f2bf(q * QSCALE);
          p.KNc[(size_t)tok * 256 + c] = f2bf(k);
        } else {
          p.QNl[(size_t)(tok - NCTX) * 256 + c] = f2bf(q * QSCALE);
          p.KNl[((size_t)(layer * 2 + b) * 1536 + 512 + tpos0 + tt) * 256 + c] = f2bf(k);
        }
      }
      if (isctx) pack8_store(p.VNtc + ((size_t)b * 256 + c) * 256 + tpos0 + half * 8, vv);
      else pack8_store(p.VNtl + ((size_t)(layer * 2 + b) * 256 + c) * 1536 + 512 + tpos0 + half * 8, vv);
    }
    {
      const float qn = p.in[24][(size_t)layer * 64 + lane], kn = p.in[25][(size_t)layer * 64 + lane];
      const int fi = lane & 15;
#pragma unroll
      for (int half = 0; half < 2; ++half) {
        float vv[8];
#pragma unroll
        for (int t8 = 0; t8 < 8; ++t8) {
          const int tt = half * 8 + t8, tok = tok0 + tt, tpos = tpos0 + tt;
          const float* pr = p.PROJ + (size_t)tok * DIN + 1920;
          float cs = 1.f, sn = 0.f;
          if (!isctx) {
            const int pos = (lane < 32) ? (tpos >> 6) : (tpos & 63);
            const float2 t2 = *reinterpret_cast<const float2*>(p.rope + (size_t)(pos * 16 + fi) * 2);
            cs = t2.x; sn = t2.y;
            if ((lane & 16) == 0) sn = -sn;
          }
#pragma unroll
          for (int hh = 0; hh < 2; ++hh) {
            float q = pr[hh * 256 + c];
            const float ms = wave_sum(q * q) * (1.f / 64.f);
            q = q * rsqrtf(ms + 1e-6f) * qn;
            if (!isctx) { const float qp = __shfl_xor(q, 16); q = q * cs + qp * sn; }
            if (isctx) p.QGc[(size_t)tok * 512 + hh * 256 + c] = f2bf(q * QSCALE);
            else p.QGl[(size_t)(tok - NCTX) * 512 + hh * 256 + c] = f2bf(q * QSCALE);
          }
          if (wid < 2) {
            float k = pr[512 + c];
            const float ms = wave_sum(k * k) * (1.f / 64.f);
            k = k * rsqrtf(ms + 1e-6f) * kn;
            if (isctx) {
              p.out_gk[((size_t)(b * 4 + layer) * 256 + tpos) * 128 + c] = k;
              p.KGc[(size_t)tok * 128 + c] = f2bf(k);
            } else {
              const float kp = __shfl_xor(k, 16); k = k * cs + kp * sn;
              p.KGl[((size_t)(layer * 2 + b) * 1536 + 512 + tpos) * 128 + c] = f2bf(k);
            }
          } else {
            const int cv = c - 128;
            const float v = pr[640 + cv];
            vv[t8] = v;
            if (isctx) p.out_gv[((size_t)(b * 4 + layer) * 256 + tpos) * 128 + cv] = v;
          }
        }
        if (wid >= 2) {
          const int cv = c - 128;
          if (isctx) pack8_store(p.VGtc + ((size_t)b * 128 + cv) * 256 + tpos0 + half * 8, vv);
          else pack8_store(p.VGtl + ((size_t)(layer * 2 + b) * 128 + cv) * 1536 + 512 + tpos0 + half * 8, vv);
        }
      }
    }
#endif
    __syncthreads();
  }
}

__device__ __forceinline__ void attn_wave(const u16* __restrict__ Q, int ldq, const u16* __restrict__ Kb, int ldk,
                                          const u16* __restrict__ Vt, int ldv, int ndense, const bool NA,
                                          const float* __restrict__ rpb, int grow, int cq0,
                                          u16* __restrict__ out, int ldo, int tidx) {
  const int lane = tidx & 63, fr = lane & 15, fq = lane >> 4;
  bf16x8 qf[2];
#pragma unroll
  for (int ks = 0; ks < 2; ++ks) qf[ks] = *reinterpret_cast<const bf16x8*>(Q + (size_t)fr * ldq + ks * 32 + fq * 8);
  f32x4 o[4];
#pragma unroll
  for (int dt = 0; dt < 4; ++dt) o[dt] = (f32x4){0.f, 0.f, 0.f, 0.f};
  float m = -1e30f, l = 0.f;

  auto chunk = [&](int kb, const bool nb, int dr, int cc) {
    f32x4 s[2];
#pragma unroll
    for (int kt = 0; kt < 2; ++kt) {
      s[kt] = (f32x4){0.f, 0.f, 0.f, 0.f};
#pragma unroll
      for (int ks = 0; ks < 2; ++ks) {
        const bf16x8 kf = *reinterpret_cast<const bf16x8*>(Kb + (size_t)(kb + 16 * kt + fr) * ldk + ks * 32 + fq * 8);
        s[kt] = __builtin_amdgcn_mfma_f32_16x16x32_bf16(kf, qf[ks], s[kt], 0, 0, 0);
      }
    }
    bool ok[2][4];
    float mx = -1e30f;
#pragma unroll
    for (int kt = 0; kt < 2; ++kt)
#pragma unroll
      for (int r = 0; r < 4; ++r) {
        ok[kt][r] = true;
        if (nb) {
          const int cq = cq0 + fr, c0 = min(max(cq - 8, 0), 48);
          const int ck = cc * 32 + 16 * kt + 4 * fq + r;
          ok[kt][r] = (ck >= c0) && (ck < c0 + 16);
          const int dc = min(max(ck - cq, -15), 15) + 15;
          const float bias = rpb[dr * 31 + dc] * LOG2E;
          s[kt][r] = ok[kt][r] ? s[kt][r] + bias : -1e30f;
        }
        mx = fmaxf(mx, s[kt][r]);
      }
    mx = fmaxf(mx, __shfl_xor(mx, 16));
    mx = fmaxf(mx, __shfl_xor(mx, 32));
    const float mn = fmaxf(m, mx);
    const float alpha = exp2f(m - mn);
    m = mn;
    float pv[8]; float ps = 0.f;
#pragma unroll
    for (int kt = 0; kt < 2; ++kt)
#pragma unroll
      for (int r = 0; r < 4; ++r) {
        const float e = ok[kt][r] ? exp2f(s[kt][r] - mn) : 0.f;
        pv[kt * 4 + r] = e; ps += e;
      }
    l = l * alpha + ps;
    union { bf16x8 v; unsigned u[4]; } pf;
    pf.u[0] = pack2(pv[0], pv[1]); pf.u[1] = pack2(pv[2], pv[3]); pf.u[2] = pack2(pv[4], pv[5]); pf.u[3] = pack2(pv[6], pv[7]);
#pragma unroll
    for (int dt = 0; dt < 4; ++dt) {
      const u16* vp = Vt + (size_t)(16 * dt + fr) * ldv + kb + 4 * fq;
      const uint2 lo = *reinterpret_cast<const uint2*>(vp);
      const uint2 hi = *reinterpret_cast<const uint2*>(vp + 16);
      union { bf16x8 v; unsigned u[4]; } vf;
      vf.u[0] = lo.x; vf.u[1] = lo.y; vf.u[2] = hi.x; vf.u[3] = hi.y;
      o[dt][0] *= alpha; o[dt][1] *= alpha; o[dt][2] *= alpha; o[dt][3] *= alpha;
      o[dt] = __builtin_amdgcn_mfma_f32_16x16x32_bf16(vf.v, pf.v, o[dt], 0, 0, 0);
    }
  };

  for (int kb = 0; kb < ndense; kb += 32) chunk(kb, false, 0, 0);
  if (NA) {
    const int rb = min(max(grow - 4, 0), 8);
    const int ulo = min(max(cq0 - 8, 0), 48), uhi = min(max(cq0 + 15 - 8, 0), 48) + 16;
    for (int j = 0; j < 8; ++j) {
      const int krow = rb + j;
      const int dr = krow - grow + 7;
      for (int cc = 0; cc < 2; ++cc) {
        if (cc * 32 + 32 <= ulo || cc * 32 >= uhi) continue;
        chunk(512 + krow * 64 + cc * 32, true, dr, cc);
      }
    }
  }
  l += __shfl_xor(l, 16);
  l += __shfl_xor(l, 32);
  const float il = 1.f / l;
#pragma unroll
  for (int dt = 0; dt < 4; ++dt) {
    uint2 pk; pk.x = pack2(o[dt][0] * il, o[dt][1] * il); pk.y = pack2(o[dt][2] * il, o[dt][3] * il);
    *reinterpret_cast<uint2*>(out + (size_t)fr * ldo + 16 * dt + 4 * fq) = pk;
  }
}

__device__ void scan_item(const Params& p, int layer, char* smem, bool lat, int b, int h, int dir, int qd, int tidx) {
  const int tid = tidx, lane = tid & 63, wid = tid >> 6, rr = lane >> 4, j = lane & 15;
  const int L = lat ? 1024 : 256, seqbase = lat ? NCTX + b * 1024 : b * 256;
  const int rowl = wid * 4 + rr, row = qd * 16 + rowl;
  float* cbuf = reinterpret_cast<float*>(smem);
  float* obuf = cbuf + 2 * 16 * 6 * 64;
  float4 S = make_float4(0.f, 0.f, 0.f, 0.f);
  if (lat) S = *reinterpret_cast<const float4*>(p.in[2] + ((((size_t)(b * 4 + layer) * 2 + dir) * 4 + h) * 64 + row) * 64 + 4 * j);
  const int nch = L / 16;
  float* odst = dir == 0 ? p.OF : p.OB;
  float4 pre0, pre1, pre2, pre3, pre4, pre5;
#define SC_GL1(PR, I, CH) { const int idx = tid + 256 * (I), tt_ = idx / 96, rem = idx % 96, vec = rem >> 4, f4 = rem & 15; \
    const int st_ = (CH) * 16 + tt_, t_ = dir == 0 ? st_ : L - 1 - st_; const int svec = vec < 3 ? vec : vec + 3 * dir; \
    PR = *reinterpret_cast<const float4*>(p.SC + ((size_t)((seqbase + t_) * 4 + h) * 9 + svec) * 64 + f4 * 4); }
#define gload(CH) { SC_GL1(pre0, 0, CH) SC_GL1(pre1, 1, CH) SC_GL1(pre2, 2, CH) SC_GL1(pre3, 3, CH) SC_GL1(pre4, 4, CH) SC_GL1(pre5, 5, CH) }
#define SC_LS1(PR, I, BUF) *reinterpret_cast<float4*>(cbuf + (BUF) * 6144 + (tid + 256 * (I)) * 4) = PR;
#define lstore(BUF) { SC_LS1(pre0, 0, BUF) SC_LS1(pre1, 1, BUF) SC_LS1(pre2, 2, BUF) SC_LS1(pre3, 3, BUF) SC_LS1(pre4, 4, BUF) SC_LS1(pre5, 5, BUF) }
  gload(0); lstore(0);
  __syncthreads();
  for (int ch = 0; ch < nch; ++ch) {
    if (ch + 1 < nch) gload(ch + 1);
    const float* cb = cbuf + (ch & 1) * 6144;
    float* ob = obuf + (ch & 1) * 256;
#pragma unroll 4
    for (int tt = 0; tt < 16; ++tt) {
      const float* base = cb + tt * 384;
      const float4 r4 = *reinterpret_cast<const float4*>(base + 4 * j);
      const float4 kk4 = *reinterpret_cast<const float4*>(base + 64 + 4 * j);
      const float vv = base[128 + row];
      const float4 w4 = *reinterpret_cast<const float4*>(base + 192 + 4 * j);
      const float4 ak4 = *reinterpret_cast<const float4*>(base + 256 + 4 * j);
      const float4 kd4 = *reinterpret_cast<const float4*>(base + 320 + 4 * j);
      float sk = S.x * kk4.x + S.y * kk4.y + S.z * kk4.z + S.w * kk4.w;
      sk = reduce16(sk);
      S.x = S.x * w4.x + (vv * kd4.x - sk * ak4.x);
      S.y = S.y * w4.y + (vv * kd4.y - sk * ak4.y);
      S.z = S.z * w4.z + (vv * kd4.z - sk * ak4.z);
      S.w = S.w * w4.w + (vv * kd4.w - sk * ak4.w);
      float ov = S.x * r4.x + S.y * r4.y + S.z * r4.z + S.w * r4.w;
      ov = reduce16(ov);
      if (j == 0) ob[tt * 16 + rowl] = ov;
    }
    if (ch + 1 < nch) lstore((ch + 1) & 1);
    __syncthreads();
    {
      const int tt = tid >> 4, rl = tid & 15;
      const int st = ch * 16 + tt, t = dir == 0 ? st : L - 1 - st;
      odst[(size_t)(seqbase + t) * 256 + h * 64 + qd * 16 + rl] = ob[tt * 16 + rl];
    }
  }
  if (!lat) *reinterpret_cast<float4*>(p.out_st + ((((size_t)(b * 4 + layer) * 2 + dir) * 4 + h) * 64 + row) * 64 + 4 * j) = S;
  __syncthreads();
}

__device__ void mixer_phase(const Params& p, int layer, char* smem, int tidx) {
  const int tid = tidx, wid = tid >> 6;
  int* slot = reinterpret_cast<int*>(smem + 60 * 1024);
  for (;;) {
    __syncthreads();
    if (tid == 0) *slot = (int)atomicAdd(&p.wq[layer], 1u);
    __syncthreads();
    int it = *slot;
    if (it >= 1728) break;
    const bool is_scan = (it < 64) || (it >= 448 && it < 960);
    if (is_scan) {
      const bool lat = it < 64;
      const int si = lat ? it : it - 448;
      scan_item(p, layer, smem, lat, si / 32, (si / 8) % 4, (si / 4) % 2, si % 4, tidx);
      continue;
    }
    const u16 *Q, *Kb, *Vt; u16* out; int ldq, ldk, ldv, ndense, grow = 0, cq0 = 0; bool na = false;
    const float* rpb = p.in[23];
    if (it < 320) {
      it -= 64;
      const int b = it / 128, qh = (it / 16) % 8, qt = it % 16, kvh = qh >> 2;
      const int q0 = b * 1024 + qt * 64 + wid * 16;
      Q = p.QGl + (size_t)q0 * 512 + qh * 64; ldq = 512;
      Kb = p.KGl + (size_t)(layer * 2 + b) * 1536 * 128 + kvh * 64; ldk = 128;
      Vt = p.VGtl + ((size_t)(layer * 2 + b) * 128 + kvh * 64) * 1536; ldv = 1536; ndense = 1536;
      out = p.MIX + (size_t)(NCTX + q0) * DM + 512 + qh * 64;
    } else if (it < 448) {
      it -= 320;
      const int b = it / 64, h = (it / 16) % 4, r = it % 16;
      const int q0 = b * 1024 + r * 64 + wid * 16;
      Q = p.QNl + (size_t)q0 * 256 + h * 64; ldq = 256;
      Kb = p.KNl + (size_t)(layer * 2 + b) * 1536 * 256 + h * 64; ldk = 256;
      Vt = p.VNtl + ((size_t)(layer * 2 + b) * 256 + h * 64) * 1536; ldv = 1536; ndense = 512;
      rpb = p.in[23] + (size_t)(layer * 4 + h) * 15 * 31; grow = r; cq0 = wid * 16; na = true;
      out = p.MIX + (size_t)(NCTX + q0) * DM + 256 + h * 64;
    } else if (it < 1472) {
      it -= 960;
      const int b = it / 32, qh = (it / 4) % 8, qt = it % 4, kvh = qh >> 2;
      const int q0 = b * 256 + qt * 64 + wid * 16;
      Q = p.QGc + (size_t)q0 * 512 + qh * 64; ldq = 512;
      Kb = p.KGc + (size_t)b * 256 * 128 + kvh * 64; ldk = 128;
      Vt = p.VGtc + ((size_t)b * 128 + kvh * 64) * 256; ldv = 256; ndense = 256;
      out = p.MIX + (size_t)q0 * DM + 512 + qh * 64;
    } else {
      it -= 1472;
      const int b = it / 16, h = (it / 4) % 4, qt = it % 4;
      const int q0 = b * 256 + qt * 64 + wid * 16;
      Q = p.QNc + (size_t)q0 * 256 + h * 64; ldq = 256;
      Kb = p.KNc + (size_t)b * 256 * 256 + h * 64; ldk = 256;
      Vt = p.VNtc + ((size_t)b * 256 + h * 64) * 256; ldv = 256; ndense = 256;
      out = p.MIX + (size_t)q0 * DM + 256 + h * 64;
    }
    attn_wave(Q, ldq, Kb, ldk, Vt, ldv, ndense, na, rpb, grow, cq0, out, DM, tidx);
  }
}

__device__ void rwkv_fin_phase(const Params& p, int layer, int bid, int nblk, int tidx) {
  const int tid = tidx;
  const float lw = p.in[21][(size_t)layer * 256 + tid], lb = p.in[22][(size_t)layer * 256 + tid];
  for (int tok = bid; tok < NTOK; tok += nblk) {
    const size_t i = (size_t)tok * 256 + tid;
    const float o = p.OF[i] + p.OB[i];
    const float mu = wave_sum(o) * (1.f / 64.f);
    const float d = o - mu;
    const float var = wave_sum(d * d) * (1.f / 64.f);
    const float y = (d * rsqrtf(var + 64e-5f) * lw + lb + p.BV[i]) * p.G[i];
    p.MIX[(size_t)tok * DM + tid] = f2bf(y);
  }
}

#ifndef ONLY_PH
#define ONLY_PH -1
#endif
#define PH_EN(x) (ONLY_PH < 0 || ONLY_PH == (x))
__device__ __forceinline__ void run_phase(const Params& p, int ph, char* smem, int bid, int nblk, int tidx) {
  if (ph == 0) { if (PH_EN(0)) setup_phase(p, smem, bid, nblk, tidx); return; }
  if (ph == 1) { if (PH_EN(1)) modreduce_phase(p, bid, nblk, tidx); return; }
  if (ph == 2) { if (PH_EN(2)) ln_phase<0>(p, 0, bid, nblk, tidx); return; }
  const int layer = (ph - 3) / 9, s = (ph - 3) % 9;
  switch (s) {
    case 0: if (PH_EN(3)) gemm_phase<EPI_PROJ, 128>(p, layer, p.A, p.winT + (size_t)layer * DIN * DM, DIN, DM, smem, bid, nblk, tidx); break;
    case 1: if (PH_EN(4)) prep_phase(p, layer, smem, bid, nblk, tidx); break;
    case 2: if (PH_EN(5)) mixer_phase(p, layer, smem, tidx); break;
    case 3: if (PH_EN(6)) rwkv_fin_phase(p, layer, bid, nblk, tidx); break;
    case 4: if (PH_EN(7)) gemm_phase<EPI_OUT, 96>(p, layer, p.MIX, p.woutT + (size_t)layer * DM * DM, DM, DM, smem, bid, nblk, tidx); break;
    case 5: if (PH_EN(8)) ln_phase<1>(p, layer, bid, nblk, tidx); break;
    case 6: if (PH_EN(9)) gemm_phase<EPI_FFI, 128>(p, layer, p.A, p.wfiT + (size_t)layer * 2 * DFF * DM, 2 * DFF, DM, smem, bid, nblk, tidx); break;
    case 7: if (PH_EN(10)) gemm_phase<EPI_FFO, 96>(p, layer, p.ACT, p.wfoT + (size_t)layer * DM * DFF, DM, DFF, smem, bid, nblk, tidx); break;
    default: if (PH_EN(11)) ln_phase<2>(p, layer, bid, nblk, tidx); break;
  }
}

__global__ void __launch_bounds__(256, 2) fwd_kernel(Params p, int ph0, int ph1, int usebar) {
  __shared__ __attribute__((aligned(16))) char smem[65536 + 16];
  const int bid = blockIdx.x, nblk = gridDim.x;
  XcdBarrier xb;
  if (usebar && p.never) cg::this_grid().sync();
  if (usebar) {
    if (threadIdx.x == 0) *reinterpret_cast<uint4*>(smem + 65536) = make_uint4(0u, 0u, 0u, 0u);
    __syncthreads();
    xb = xcd_barrier_post(p.bar, (volatile LAS unsigned*)(smem + 65536));
  }
  for (int ph = ph0; ph < ph1; ++ph) {
    int tidx = threadIdx.x;
    asm volatile("" : "+v"(tidx));
    run_phase(p, ph, smem, bid, nblk, tidx);
#if REPMASK
    {
      const int slot_ = ph < 3 ? 9 + ph : (ph - 3) % 9;
      if ((REPMASK >> slot_) & 1) {
        if (usebar) xcd_barrier(xb);
        Params p2 = p; p2.wq = p.wq + 4;
        run_phase(p2, ph, smem, bid, nblk, tidx);
      }
    }
#endif
    if (usebar && ph + 1 < ph1) xcd_barrier(xb);
  }
}

static inline size_t al256(size_t x) { return (x + 255) & ~(size_t)255; }

extern "C" void kernel_launch(void* const* d_in, const int* in_sizes, int n_in, void* d_out, int out_size, void* d_ws, size_t ws_size,
                              hipStream_t stream) {
  Params p;
  memset(&p, 0, sizeof(p));
  for (int i = 0; i < 33; ++i) p.in[i] = (const float*)d_in[i];
  float* o = (float*)d_out;
  p.out_yp = o; o += 4194304;
  p.out_ys = o; o += 2097152;
  p.out_st = o; o += 2097152;
  p.out_nak = o; o += 4194304;
  p.out_nav = o; o += 4194304;
  p.out_gk = o; o += 2097152;
  p.out_gv = o;
  char* w = (char*)d_ws; size_t off = 0;
  auto take = [&](size_t bytes) { char* r = w + off; off += al256(bytes); return r; };
  p.bar = (unsigned*)take(16384);
  p.wq = p.bar + 3584;
  p.modp = (float*)take((size_t)4 * 32 * 3 * 6144 * 4);
  p.mod = (float*)take((size_t)4 * 3 * 6144 * 4);
  p.winT = (u16*)take((size_t)4 * DIN * DM * 2);
  p.woutT = (u16*)take((size_t)4 * DM * DM * 2);
  p.wfiT = (u16*)take((size_t)4 * 2 * DFF * DM * 2);
  p.wfoT = (u16*)take((size_t)4 * DM * DFF * 2);
  p.X = (float*)take((size_t)NTOK * DM * 4);
  p.PROJ = (float*)take((size_t)NTOK * DIN * 4);
  p.X1 = p.PROJ;
  p.Y = p.PROJ + (size_t)NTOK * DM;
  p.SC = (float*)take((size_t)NTOK * 4 * 9 * 64 * 4);
  p.ACT = (u16*)p.SC;
  p.G = (float*)take((size_t)NTOK * 256 * 4);
  p.BV = (float*)take((size_t)NTOK * 256 * 4);
  p.OF = (float*)take((size_t)NTOK * 256 * 4);
  p.OB = (float*)take((size_t)NTOK * 256 * 4);
  p.A = (u16*)take((size_t)NTOK * DM * 2);
  p.MIX = (u16*)take((size_t)NTOK * DM * 2);
  p.QNc = (u16*)take((size_t)NCTX * 256 * 2);
  p.KNc = (u16*)take((size_t)NCTX * 256 * 2);
  p.VNtc = (u16*)take((size_t)NCTX * 256 * 2);
  p.QGc = (u16*)take((size_t)NCTX * 512 * 2);
  p.KGc = (u16*)take((size_t)NCTX * 128 * 2);
  p.VGtc = (u16*)take((size_t)NCTX * 128 * 2);
  p.QNl = (u16*)take((size_t)2048 * 256 * 2);
  p.KNl = (u16*)take((size_t)4 * 2 * 1536 * 256 * 2);
  p.VNtl = (u16*)take((size_t)4 * 2 * 1536 * 256 * 2);
  p.QGl = (u16*)take((size_t)2048 * 512 * 2);
  p.KGl = (u16*)take((size_t)4 * 2 * 1536 * 128 * 2);
  p.VGtl = (u16*)take((size_t)4 * 2 * 1536 * 128 * 2);
  p.loraT = (u16*)take((size_t)4 * 98304 * 2);
  p.rope = (float*)take((size_t)64 * 16 * 2 * 4);
  if (off > ws_size) { fprintf(stderr, "workspace too small: need %zu have %zu\n", off, ws_size); return; }

  (void)hipMemsetAsync(p.bar, 0, 16384, stream);
#if MEGA
  static int grid_blocks = 0;
  if (!grid_blocks) {
    int dev = 0, cus = 0, per_cu = 0;
    hipGetDevice(&dev);
    hipDeviceGetAttribute(&cus, hipDeviceAttributeMultiprocessorCount, dev);
    hipOccupancyMaxActiveBlocksPerMultiprocessor(&per_cu, fwd_kernel, 256, 0);
    if (per_cu > 2) per_cu = 2;
    if (per_cu < 1) per_cu = 1;
    grid_blocks = cus * per_cu;
  }
  int ph0 = 0, ph1 = NPH, ub = 1;
  void* args[] = {&p, &ph0, &ph1, &ub};
  hipError_t e = hipLaunchCooperativeKernel((void*)fwd_kernel, dim3(grid_blocks), dim3(256), args, 0, stream);
  if (e != hipSuccess) fprintf(stderr, "cooperative launch failed: %s (grid %d)\n", hipGetErrorString(e), grid_blocks);
#else
  for (int ph = 0; ph < NPH; ++ph) fwd_kernel<<<512, 256, 0, stream>>>(p, ph, ph + 1, 0);
#endif
}
```

```cpp
#include <hip/hip_runtime.h>
#include <hip/hip_cooperative_groups.h>
#include <cstdio>
#include <cstdint>
#include <cstring>
namespace cg = cooperative_groups;

#ifndef REPMASK
#define REPMASK 0
#endif
#ifndef REPVAR
#define REPVAR 0
#endif
#ifndef MEGA
#define MEGA 1
#endif

typedef unsigned short u16;
using bf16x8 = __attribute__((ext_vector_type(8))) short;
using f32x4 = __attribute__((ext_vector_type(4))) float;

#define NTOK 6144
#define NCTX 4096
#define DM 1024
#define DIN 2688
#define DFF 2816
#define NPH 39
#define ALPHA 1.681792830507429f
#define LOG2E 1.4426950408889634f
#define QSCALE (0.125f * LOG2E)

struct Params {
  const float* in[33];
  float *out_yp, *out_ys, *out_st, *out_nak, *out_nav, *out_gk, *out_gv;
  unsigned *bar, *wq;
  float *modp, *mod;
  u16 *winT, *woutT, *wfiT, *wfoT;
  float *X, *X1, *Y, *PROJ, *SC, *G, *BV, *OF, *OB;
  u16 *A, *MIX, *ACT;
  u16 *QNc, *KNc, *VNtc, *QGc, *KGc, *VGtc;
  u16 *QNl, *KNl, *VNtl, *QGl, *KGl, *VGtl;
  u16* loraT; float* rope;
  int never; int pad;
};

__device__ __forceinline__ u16 f2bf(float f) {
  unsigned u = __float_as_uint(f);
  u += 0x7FFFu + ((u >> 16) & 1u);
  return (u16)(u >> 16);
}
__device__ __forceinline__ unsigned pack2(float a, float b) { return (unsigned)f2bf(a) | ((unsigned)f2bf(b) << 16); }
__device__ __forceinline__ float wave_sum(float v) {
#pragma unroll
  for (int o = 32; o; o >>= 1) v += __shfl_xor(v, o);
  return v;
}
template <int CTRL> __device__ __forceinline__ float dpp_mov(float v) {
  return __int_as_float(__builtin_amdgcn_update_dpp(0, __float_as_int(v), CTRL, 0xF, 0xF, false));
}
__device__ __forceinline__ float reduce16(float v) {
  v += dpp_mov<0xB1>(v);
  v += dpp_mov<0x4E>(v);
  v += dpp_mov<0x141>(v);
  v += dpp_mov<0x140>(v);
  return v;
}
__device__ __forceinline__ float sigmoidf_(float x) { return 1.f / (1.f + __expf(-x)); }
__device__ __forceinline__ float siluf_(float x) { return x / (1.f + __expf(-x)); }
__device__ __forceinline__ int modrow_of(int tok) { return tok < NCTX ? 0 : 1 + ((tok - NCTX) >> 10); }

#define XB_TMO      128
#define XB_XCNT(j)  (256  + 64 * (j))
#define XB_XSUB(j)  (1280 + 64 * (j))
#define XB_XGEN(j)  (2304 + 64 * (j))
#define XB_TOP      3328
#define XB_TOPGEN   3392
#define XCD_BAR_WORDS 3456
#define XB_SPIN_CAP (1u << 22)
#define LAS __attribute__((address_space(3)))
__device__ __forceinline__ unsigned xb_ld(unsigned* p) { return __hip_atomic_load(p, __ATOMIC_RELAXED, __HIP_MEMORY_SCOPE_AGENT); }
__device__ __forceinline__ unsigned xb_add(unsigned* p, unsigned v) { return __hip_atomic_fetch_add(p, v, __ATOMIC_RELAXED, __HIP_MEMORY_SCOPE_AGENT); }
__device__ __forceinline__ unsigned xb_xcc_id() { return (unsigned)__builtin_amdgcn_s_getreg((3 << 11) | 20) & 0xFu; }
#define XB_SPIN(cond, bar) do { unsigned _sp = 0; while (cond) { __builtin_amdgcn_s_sleep(1); \
    if ((++_sp & 255u) == 0u) { if (xb_ld(&(bar)[XB_TMO])) break; if (_sp > XB_SPIN_CAP) { atomicAdd(&(bar)[XB_TMO], 1u); break; } } } } while (0)
struct XcdBarrier { unsigned* bar; unsigned x; volatile LAS unsigned* st; };
__device__ __forceinline__ XcdBarrier xcd_barrier_post(unsigned* bar, volatile LAS unsigned* st) {
  XcdBarrier b; b.bar = bar; b.x = xb_xcc_id(); b.st = st;
  if (threadIdx.x == 0) (void)xb_add(&bar[XB_XCNT(b.x)], 1u);
  return b;
}
__device__ __forceinline__ void xcd_barrier_complete(unsigned* bar, unsigned x, unsigned& nloc, unsigned& nx) {
  const unsigned G = gridDim.x * gridDim.y * gridDim.z;
  unsigned sum, cnt, mine, sp = 0u;
  for (;;) {
    sum = 0u; cnt = 0u; mine = 0u;
#pragma unroll
    for (unsigned j = 0; j < 16; ++j) { const unsigned c = xb_ld(&bar[XB_XCNT(j)]); sum += c; cnt += (c > 0u) ? 1u : 0u; mine = (j == x) ? c : mine; }
    if (sum == G) break;
    __builtin_amdgcn_s_sleep(1);
    if ((++sp & 255u) == 0u) { if (xb_ld(&bar[XB_TMO])) break; if (sp > XB_SPIN_CAP) { atomicAdd(&bar[XB_TMO], 1u); break; } }
  }
  nloc = mine > 0u ? mine : 1u; nx = cnt > 0u ? cnt : 1u;
}
__device__ __forceinline__ void xcd_barrier(const XcdBarrier& b) {
  asm volatile("s_waitcnt vmcnt(0)" ::: "memory");
  __syncthreads();
  if (threadIdx.x == 0) {
    unsigned* bar = b.bar;
    __builtin_amdgcn_s_waitcnt(0);
    unsigned nloc = b.st[0], nx = b.st[1];
    if (nloc == 0u) { xcd_barrier_complete(bar, b.x, nloc, nx); b.st[0] = nloc; b.st[1] = nx; }
    const unsigned old = xb_add(&bar[XB_XSUB(b.x)], 1u);
    const unsigned gen = old / nloc;
    if (old + 1u == (gen + 1u) * nloc) {
      __builtin_amdgcn_fence(__ATOMIC_RELEASE, "agent");
      asm volatile("s_waitcnt vmcnt(0)" ::: "memory");
      const unsigned og = xb_add(&bar[XB_TOP], 1u);
      const unsigned tg = og / nx;
      if (og + 1u == (tg + 1u) * nx) xb_add(&bar[XB_TOPGEN], 1u);
      else XB_SPIN(xb_ld(&bar[XB_TOPGEN]) == tg, bar);
      __builtin_amdgcn_fence(__ATOMIC_ACQUIRE, "agent");
      xb_add(&bar[XB_XGEN(b.x)], 1u);
      asm volatile("s_waitcnt vmcnt(0)" ::: "memory");
    } else {
      XB_SPIN(xb_ld(&bar[XB_XGEN(b.x)]) == gen, bar);
      __builtin_amdgcn_fence(__ATOMIC_ACQUIRE, "agent");
      asm volatile("s_waitcnt vmcnt(0)" ::: "memory");
    }
  }
  __syncthreads();
}

__device__ __forceinline__ int lds_byte32(int r, int c) {
  const int ob = (r & 15) * 64 + c * 2;
  return (r >> 4) * 1024 + (ob ^ (((ob >> 9) & 1) << 5));
}
__device__ __forceinline__ void stage_rc32(int b, int& R, int& C) {
  const int sb = b & 1023, swz = sb ^ (((sb >> 9) & 1) << 5);
  R = (b >> 10) * 16 + (swz >> 6); C = (swz & 63) >> 1;
}
template <int ROWS>
__device__ __forceinline__ void stage_tile32(const u16* __restrict__ g, int ld, char* lds, int tidx) {
#pragma unroll
  for (int i = 0; i < 2; ++i) {
    const int b = tidx * 16 + i * 4096;
    if (i == 0 || ROWS == 128 || tidx < 128) {
      int R, C; stage_rc32(b, R, C);
      __builtin_amdgcn_global_load_lds((const unsigned*)(g + (size_t)R * ld + C), (unsigned LAS*)(lds + b), 16, 0, 0);
    }
  }
}

enum { EPI_PROJ = 0, EPI_OUT = 1, EPI_FFI = 2, EPI_FFO = 3 };

template <int EPI, int BM>
__device__ __forceinline__ void gemm_phase(const Params& p, int layer, const u16* __restrict__ A, const u16* __restrict__ Bt,
                                           int N, int K, char* smem, int bid, int nblk, int tidx) {
  constexpr int MF = BM / 32;
  const int tid = tidx, lane = tid & 63, wid = tid >> 6, wr = wid >> 1, wc = wid & 1, fr = lane & 15, fq = lane >> 4;
  const int nM = NTOK / BM, nN = N / 128, ntiles = nM * nN, nk = K / 32;
  const bool fullA = (BM == 128) || (wid < 2);
  for (int tile = bid; tile < ntiles; tile += nblk) {
    const int pm = tile % nM, pn = tile / nM, m0 = pm * BM, n0 = pn * 128;
    f32x4 acc[MF][4];
#pragma unroll
    for (int m = 0; m < MF; ++m)
#pragma unroll
      for (int n = 0; n < 4; ++n) acc[m][n] = (f32x4){0.f, 0.f, 0.f, 0.f};
    const u16* Ag = A + (size_t)m0 * K;
    const u16* Bg = Bt + (size_t)n0 * K;
#pragma unroll
    for (int s = 0; s < 3; ++s) {
      stage_tile32<BM>(Ag + s * 32, K, smem + s * 16384, tidx);
      stage_tile32<128>(Bg + s * 32, K, smem + s * 16384 + 8192, tidx);
    }
    for (int kt = 0; kt < nk; ++kt) {
      if (kt + 2 < nk) {
        if (fullA) asm volatile("s_waitcnt vmcnt(8)" ::: "memory");
        else asm volatile("s_waitcnt vmcnt(6)" ::: "memory");
      } else {
        asm volatile("s_waitcnt vmcnt(0)" ::: "memory");
      }
      __builtin_amdgcn_s_barrier();
      if (kt + 3 < nk) {
        char* nb = smem + ((kt + 3) & 3) * 16384;
        stage_tile32<BM>(Ag + (kt + 3) * 32, K, nb, tidx);
        stage_tile32<128>(Bg + (kt + 3) * 32, K, nb + 8192, tidx);
      }
      const char* sa = smem + (kt & 3) * 16384;
      const char* sb = sa + 8192;
      bf16x8 af[MF], bfr[4];
#pragma unroll
      for (int m = 0; m < MF; ++m) af[m] = *reinterpret_cast<const bf16x8*>(sa + lds_byte32(wr * (BM / 2) + m * 16 + fr, fq * 8));
#pragma unroll
      for (int n = 0; n < 4; ++n) bfr[n] = *reinterpret_cast<const bf16x8*>(sb + lds_byte32(wc * 64 + n * 16 + fr, fq * 8));
#pragma unroll
      for (int m = 0; m < MF; ++m)
#pragma unroll
        for (int n = 0; n < 4; ++n) acc[m][n] = __builtin_amdgcn_mfma_f32_16x16x32_bf16(bfr[n], af[m], acc[m][n], 0, 0, 0);
    }
#pragma unroll
    for (int m = 0; m < MF; ++m) {
      const int row = m0 + wr * (BM / 2) + m * 16 + fr;
      if (EPI == EPI_PROJ) {
#pragma unroll
        for (int n = 0; n < 4; ++n) {
          const int col = n0 + wc * 64 + n * 16 + 4 * fq;
          *reinterpret_cast<float4*>(p.PROJ + (size_t)row * DIN + col) = make_float4(acc[m][n][0], acc[m][n][1], acc[m][n][2], acc[m][n][3]);
        }
      } else if (EPI == EPI_OUT || EPI == EPI_FFO) {
        const float* res = (EPI == EPI_OUT) ? p.X : p.X1;
        const float* gate = p.mod + ((size_t)(layer * 3 + modrow_of(row)) * 6 + (EPI == EPI_OUT ? 2 : 5)) * 1024;
#pragma unroll
        for (int n = 0; n < 4; ++n) {
          const int col = n0 + wc * 64 + n * 16 + 4 * fq;
          const float4 xr = *reinterpret_cast<const float4*>(res + (size_t)row * DM + col);
          const float4 gt = *reinterpret_cast<const float4*>(gate + col);
          float4 y;
          y.x = ALPHA * xr.x + gt.x * acc[m][n][0];
          y.y = ALPHA * xr.y + gt.y * acc[m][n][1];
          y.z = ALPHA * xr.z + gt.z * acc[m][n][2];
          y.w = ALPHA * xr.w + gt.w * acc[m][n][3];
          *reinterpret_cast<float4*>(p.Y + (size_t)row * DM + col) = y;
        }
      } else {
#pragma unroll
        for (int n2 = 0; n2 < 2; ++n2) {
          const int j0 = ((n0 + wc * 64) / 32 + n2) * 16 + 4 * fq;
          float a[4];
#pragma unroll
          for (int r = 0; r < 4; ++r) a[r] = siluf_(acc[m][2 * n2][r]) * acc[m][2 * n2 + 1][r];
          uint2 pk; pk.x = pack2(a[0], a[1]); pk.y = pack2(a[2], a[3]);
          *reinterpret_cast<uint2*>(p.ACT + (size_t)row * DFF + j0) = pk;
        }
      }
    }
    asm volatile("s_waitcnt lgkmcnt(0)" ::: "memory");
    __builtin_amdgcn_s_barrier();
  }
}

__device__ __forceinline__ int kf_off(int t, int d) { return (t >> 4) * 1024 + (d >> 5) * 512 + ((d & 31) >> 3) * 128 + (t & 15) * 8 + (d & 7); }
__device__ __forceinline__ int vf_off(int t, int d) { return (t >> 5) * 2048 + (d >> 4) * 512 + (((t & 15) >> 2) * 16 + (d & 15)) * 8 + ((t >> 4) & 1) * 4 + (t & 3); }
__device__ __forceinline__ void pack44_store(u16* base, int t0, int d, const float* v) {
  uint2 a, b; a.x = pack2(v[0], v[1]); a.y = pack2(v[2], v[3]); b.x = pack2(v[4], v[5]); b.y = pack2(v[6], v[7]);
  *reinterpret_cast<uint2*>(base + vf_off(t0, d)) = a;
  *reinterpret_cast<uint2*>(base + vf_off(t0 + 4, d)) = b;
}
__device__ __forceinline__ void pack8_store(u16* dst, const float* v) {
  uint4 pk; pk.x = pack2(v[0], v[1]); pk.y = pack2(v[2], v[3]); pk.z = pack2(v[4], v[5]); pk.w = pack2(v[6], v[7]);
  *reinterpret_cast<uint4*>(dst) = pk;
}

__device__ void setup_phase(const Params& p, char* smem, int bid, int nblk, int tidx) {
  const int tid = tidx;
  const int NI = 768 + 512 + 4 * 3040 + 13;
  for (int it = bid; it < NI; it += nblk) {
    if (it < 768) {
      const int l = it / 192, nc = (it / 32) % 6, kc = it % 32;
      const int col = nc * 1024 + tid * 4;
      const float* wm = p.in[9] + (size_t)l * 1024 * 6144;
      float4 a0 = make_float4(0, 0, 0, 0), a1 = a0, a2 = a0;
      for (int kk = 0; kk < 32; ++kk) {
        const int k = kc * 32 + kk;
        const float s0 = siluf_(p.in[8][k]), s1 = siluf_(p.in[7][k]), s2 = siluf_(p.in[7][1024 + k]);
        const float4 w = *reinterpret_cast<const float4*>(wm + (size_t)k * 6144 + col);
        a0.x += s0 * w.x; a0.y += s0 * w.y; a0.z += s0 * w.z; a0.w += s0 * w.w;
        a1.x += s1 * w.x; a1.y += s1 * w.y; a1.z += s1 * w.z; a1.w += s1 * w.w;
        a2.x += s2 * w.x; a2.y += s2 * w.y; a2.z += s2 * w.z; a2.w += s2 * w.w;
      }
      float* dst = p.modp + (size_t)((l * 32 + kc) * 3) * 6144 + col;
      *reinterpret_cast<float4*>(dst) = a0;
      *reinterpret_cast<float4*>(dst + 6144) = a1;
      *reinterpret_cast<float4*>(dst + 2 * 6144) = a2;
    } else if (it < 1280) {
      const int ci = it - 768, b = ci / 256, l = (ci / 64) % 4, tg = ci % 64, t0 = tg * 8;
      {
        const float* ck = p.in[3] + ((size_t)(b * 4 + l) * 512 + t0) * 256 + tid;
        const float* cv = p.in[4] + ((size_t)(b * 4 + l) * 512 + t0) * 256 + tid;
        float v[8];
#pragma unroll
        for (int tt = 0; tt < 8; ++tt) {
          p.KNl[((size_t)((l * 2 + b) * 4 + (tid >> 6))) * 98304 + kf_off(t0 + tt, tid & 63)] = f2bf(ck[tt * 256]);
          v[tt] = cv[tt * 256];
        }
        pack44_store(p.VNtl + ((size_t)((l * 2 + b) * 4 + (tid >> 6))) * 98304, t0, tid & 63, v);
      }
      if (tid < 128) {
        const float* ck = p.in[5] + ((size_t)(b * 4 + l) * 512 + t0) * 128 + tid;
#pragma unroll
        for (int tt = 0; tt < 8; ++tt) p.KGl[((size_t)((l * 2 + b) * 2 + (tid >> 6))) * 98304 + kf_off(t0 + tt, tid & 63)] = f2bf(ck[tt * 128]);
      } else {
        const int c = tid - 128;
        const float* cv = p.in[6] + ((size_t)(b * 4 + l) * 512 + t0) * 128 + c;
        float v[8];
#pragma unroll
        for (int tt = 0; tt < 8; ++tt) v[tt] = cv[tt * 128];
        pack44_store(p.VGtl + ((size_t)((l * 2 + b) * 2 + (c >> 6))) * 98304, t0, c & 63, v);
      }
    } else if (it >= 768 + 512 + 4 * 3040) {
      const int li = it - (768 + 512 + 4 * 3040);
      if (li == 12) {
        for (int idx = tid; idx < 1024; idx += 256) {
          const int pos = idx >> 4, fi = idx & 15;
          const float ang = (float)pos * exp2f(-(float)fi * (13.287712379549449f / 16.f));
          p.rope[idx * 2] = cosf(ang); p.rope[idx * 2 + 1] = sinf(ang);
        }
      } else {
        const int l = li / 3, m = li % 3;
        u16* dst = p.loraT + (size_t)l * 98304 + m * 32768;
        if (m < 2) {
          const float* src = p.in[m == 0 ? 14 : 16] + (size_t)l * 32768;
          for (int idx = tid; idx < 32768; idx += 256) {
            const int d = idx >> 14, cch = (idx >> 6) & 255, r = idx & 63;
            dst[idx] = f2bf(src[(d * 64 + r) * 256 + cch]);
          }
        } else {
          const float* src = p.in[17] + (size_t)l * 32768;
          for (int idx = tid; idx < 32768; idx += 256) {
            const int cch = idx >> 7, j = idx & 127;
            dst[idx] = f2bf(src[j * 256 + cch]);
          }
        }
      }
    } else {
      const int wi = it - 1280, l = wi / 3040; int r = wi % 3040;
      const float* src; u16* dst; int K, N, mat, kt, nt;
      if (r < 672) { mat = 0; K = 1024; N = 2688; src = p.in[11] + (size_t)l * K * N; dst = p.winT + (size_t)l * N * K; kt = r / 42; nt = r % 42; }
      else if (r < 928) { r -= 672; mat = 1; K = 1024; N = 1024; src = p.in[26] + (size_t)l * K * N; dst = p.woutT + (size_t)l * N * K; kt = r / 16; nt = r % 16; }
      else if (r < 2336) { r -= 928; mat = 2; K = 1024; N = 5632; src = p.in[29] + (size_t)l * K * N; dst = p.wfiT + (size_t)l * N * K; kt = r / 88; nt = r % 88; }
      else { r -= 2336; mat = 3; K = 2816; N = 1024; src = p.in[30] + (size_t)l * K * N; dst = p.wfoT + (size_t)l * N * K; kt = r / 16; nt = r % 16; }
      float* tile = reinterpret_cast<float*>(smem);
      const int k0 = kt * 64, n0 = nt * 64;
#pragma unroll
      for (int i = 0; i < 4; ++i) {
        const int kr = (tid >> 4) + 16 * i, c4 = (tid & 15) * 4;
        const float4 v = *reinterpret_cast<const float4*>(src + (size_t)(k0 + kr) * N + n0 + c4);
        tile[kr * 65 + c4 + 0] = v.x; tile[kr * 65 + c4 + 1] = v.y; tile[kr * 65 + c4 + 2] = v.z; tile[kr * 65 + c4 + 3] = v.w;
      }
      __syncthreads();
#pragma unroll
      for (int i = 0; i < 2; ++i) {
        const int idx = tid + 256 * i, nl = idx >> 3, kc = idx & 7;
        int n = n0 + nl;
        if (mat == 2) { const int isup = n >= DFF ? 1 : 0; const int j = n - isup * DFF; n = (j >> 4) * 32 + isup * 16 + (j & 15); }
        float v[8];
#pragma unroll
        for (int jj = 0; jj < 8; ++jj) v[jj] = tile[(kc * 8 + jj) * 65 + nl];
        pack8_store(dst + (size_t)n * K + k0 + kc * 8, v);
      }
      __syncthreads();
    }
  }
}

__device__ void modreduce_phase(const Params& p, int bid, int nblk, int tidx) {
  for (int idx = bid * 256 + tidx; idx < 18432; idx += nblk * 256) {
    const int l = idx / 4608, rem = idx % 4608, mr = rem / 1536, c4 = (rem % 1536) * 4;
    float4 a = *reinterpret_cast<const float4*>(p.in[10] + (size_t)l * 6144 + c4);
    for (int kc = 0; kc < 32; ++kc) {
      const float4 v = *reinterpret_cast<const float4*>(p.modp + (size_t)((l * 32 + kc) * 3 + mr) * 6144 + c4);
      a.x += v.x; a.y += v.y; a.z += v.z; a.w += v.w;
    }
    *reinterpret_cast<float4*>(p.mod + (size_t)(l * 3 + mr) * 6144 + c4) = a;
  }
}

template <int MODE>
__device__ void ln_phase(const Params& p, int layer, int bid, int nblk, int tidx) {
  const int lane = tidx & 63, wid = tidx >> 6;
  for (int it = bid; it < NTOK / 4; it += nblk) {
    const int row = it * 4 + wid;
    const float* src;
    if (MODE == 0) src = row < NCTX ? p.in[0] + (size_t)row * DM : p.in[1] + (size_t)(row - NCTX) * DM;
    else src = p.Y + (size_t)row * DM;
    float4 v[4];
#pragma unroll
    for (int i = 0; i < 4; ++i) v[i] = reinterpret_cast<const float4*>(src)[lane + 64 * i];
    if (MODE != 0) {
      float s = 0.f;
#pragma unroll
      for (int i = 0; i < 4; ++i) s += v[i].x + v[i].y + v[i].z + v[i].w;
      const float mu = wave_sum(s) * (1.f / 1024.f);
      float q = 0.f;
#pragma unroll
      for (int i = 0; i < 4; ++i) {
        v[i].x -= mu; v[i].y -= mu; v[i].z -= mu; v[i].w -= mu;
        q += v[i].x * v[i].x + v[i].y * v[i].y + v[i].z * v[i].z + v[i].w * v[i].w;
      }
      const float rstd = rsqrtf(wave_sum(q) * (1.f / 1024.f) + 1e-5f);
      const float* lw = (MODE == 1 ? p.in[27] : p.in[31]) + (size_t)layer * DM;
      const float* lb = (MODE == 1 ? p.in[28] : p.in[32]) + (size_t)layer * DM;
#pragma unroll
      for (int i = 0; i < 4; ++i) {
        const float4 w = reinterpret_cast<const float4*>(lw)[lane + 64 * i];
        const float4 b = reinterpret_cast<const float4*>(lb)[lane + 64 * i];
        v[i].x = v[i].x * rstd * w.x + b.x; v[i].y = v[i].y * rstd * w.y + b.y;
        v[i].z = v[i].z * rstd * w.z + b.z; v[i].w = v[i].w * rstd * w.w + b.w;
      }
    }
    float* xdst = (MODE == 1 ? p.X1 : p.X) + (size_t)row * DM;
#pragma unroll
    for (int i = 0; i < 4; ++i) reinterpret_cast<float4*>(xdst)[lane + 64 * i] = v[i];
    if (MODE == 2 && layer == 3) {
      float* o = row < NCTX ? p.out_yp + (size_t)row * DM : p.out_ys + (size_t)(row - NCTX) * DM;
#pragma unroll
      for (int i = 0; i < 4; ++i) reinterpret_cast<float4*>(o)[lane + 64 * i] = v[i];
    } else {
      const int ml = (MODE == 2) ? layer + 1 : layer;
      const int which = (MODE == 1) ? 3 : 0;
      const float* sh = p.mod + ((size_t)(ml * 3 + modrow_of(row)) * 6 + which) * 1024;
      const float* sc = sh + 1024;
      u16* adst = p.A + (size_t)row * DM;
#pragma unroll
      for (int i = 0; i < 4; ++i) {
        const float4 s4 = reinterpret_cast<const float4*>(sh)[lane + 64 * i];
        const float4 c4 = reinterpret_cast<const float4*>(sc)[lane + 64 * i];
        uint2 pk;
        pk.x = pack2(v[i].x * (1.f + c4.x) + s4.x, v[i].y * (1.f + c4.y) + s4.y);
        pk.y = pack2(v[i].z * (1.f + c4.z) + s4.z, v[i].w * (1.f + c4.w) + s4.w);
        reinterpret_cast<uint2*>(adst)[lane + 64 * i] = pk;
      }
    }
  }
}

#define FLD 772
#define LLD 392
__device__ void prep_phase(const Params& p, int layer, char* smem, int bid, int nblk, int tidx) {
  float* F = reinterpret_cast<float*>(smem);
  u16* LIb = reinterpret_cast<u16*>(smem + 16 * FLD * 4);
  const float* cw = p.in[12] + (size_t)layer * 3 * 1152;
  const u16* LW = p.loraT + (size_t)layer * 98304;
  for (int it = bid; it < NTOK / 16; it += nblk) {
    int tid = tidx;
    asm volatile("" : "+v"(tid));
    const int lane = tid & 63, wid = tid >> 6, fr = lane & 15, fq = lane >> 4;
    const int tok0 = it * 16;
    int b, tpos0, L;
    const bool isctx = tok0 < NCTX;
    if (isctx) { b = tok0 >> 8; tpos0 = tok0 & 255; L = 256; }
    else { const int tl = tok0 - NCTX; b = tl >> 10; tpos0 = tl & 1023; L = 1024; }
#pragma unroll 2
    for (int idx = tid; idx < 16 * 288; idx += 256) {
      const int tt = idx / 288, c = (idx % 288) * 4, tpos = tpos0 + tt;
      const float* pr = p.PROJ + (size_t)(tok0 + tt) * DIN + c;
      const float4 w0 = *reinterpret_cast<const float4*>(cw + c);
      const float4 w1 = *reinterpret_cast<const float4*>(cw + 1152 + c);
      const float4 w2 = *reinterpret_cast<const float4*>(cw + 2304 + c);
      const float4 xc = *reinterpret_cast<const float4*>(pr);
      float4 f = make_float4(w1.x * xc.x, w1.y * xc.y, w1.z * xc.z, w1.w * xc.w);
      if (tpos > 0) { const float4 xp = *reinterpret_cast<const float4*>(pr - DIN); f.x += w0.x * xp.x; f.y += w0.y * xp.y; f.z += w0.z * xp.z; f.w += w0.w * xp.w; }
      if (tpos < L - 1) { const float4 xn = *reinterpret_cast<const float4*>(pr + DIN); f.x += w2.x * xn.x; f.y += w2.y * xn.y; f.z += w2.z * xn.z; f.w += w2.w * xn.w; }
      if (c < 768) { *reinterpret_cast<float4*>(F + tt * FLD + c) = f; }
      else {
        const int cc = c - 768;
        if (cc < 128) { f.x = tanhf(f.x); f.y = tanhf(f.y); f.z = tanhf(f.z); f.w = tanhf(f.w); }
        else if (cc >= 256) { f.x = sigmoidf_(f.x); f.y = sigmoidf_(f.y); f.z = sigmoidf_(f.z); f.w = sigmoidf_(f.w); }
        uint2 pk; pk.x = pack2(f.x, f.y); pk.y = pack2(f.z, f.w);
        *reinterpret_cast<uint2*>(LIb + tt * LLD + cc) = pk;
      }
    }
    __syncthreads();
    f32x4 acc[5][4];
#pragma unroll
    for (int g = 0; g < 5; ++g)
#pragma unroll
      for (int nf = 0; nf < 4; ++nf) acc[g][nf] = (f32x4){0.f, 0.f, 0.f, 0.f};
#pragma unroll
    for (int g = 0; g < 4; ++g) {
      const u16* wt = LW + (size_t)g * 16384;
#pragma unroll
      for (int ks = 0; ks < 2; ++ks) {
        const bf16x8 xb = *reinterpret_cast<const bf16x8*>(LIb + fr * LLD + g * 64 + ks * 32 + fq * 8);
#pragma unroll
        for (int nf = 0; nf < 4; ++nf) {
          const bf16x8 wa = *reinterpret_cast<const bf16x8*>(wt + (size_t)(64 * wid + 16 * nf + fr) * 64 + ks * 32 + fq * 8);
          acc[g][nf] = __builtin_amdgcn_mfma_f32_16x16x32_bf16(wa, xb, acc[g][nf], 0, 0, 0);
        }
      }
      __builtin_amdgcn_sched_barrier(0);
    }
    {
      const u16* wt = LW + 65536;
#pragma unroll
      for (int ks = 0; ks < 4; ++ks) {
        const bf16x8 xb = *reinterpret_cast<const bf16x8*>(LIb + fr * LLD + 256 + ks * 32 + fq * 8);
#pragma unroll
        for (int nf = 0; nf < 4; ++nf) {
          const bf16x8 wa = *reinterpret_cast<const bf16x8*>(wt + (size_t)(64 * wid + 16 * nf + fr) * 128 + ks * 32 + fq * 8);
          acc[4][nf] = __builtin_amdgcn_mfma_f32_16x16x32_bf16(wa, xb, acc[4][nf], 0, 0, 0);
        }
        if (ks == 1) __builtin_amdgcn_sched_barrier(0);
      }
      __builtin_amdgcn_sched_barrier(0);
    }
#ifndef NO_C
    {
      const int tok = tok0 + fr;
      float ss = 0.f, bs = 0.f;
#pragma unroll
      for (int nf = 0; nf < 4; ++nf) {
        const int c0 = 64 * wid + 16 * nf + 4 * fq;
        const float4 r4 = *reinterpret_cast<const float4*>(F + fr * FLD + c0);
        const float4 k4 = *reinterpret_cast<const float4*>(F + fr * FLD + 256 + c0);
        const float4 w00 = *reinterpret_cast<const float4*>(p.in[13] + (size_t)layer * 512 + c0);
        const float4 w01 = *reinterpret_cast<const float4*>(p.in[13] + (size_t)layer * 512 + 256 + c0);
        const float4 a00 = *reinterpret_cast<const float4*>(p.in[15] + (size_t)layer * 512 + c0);
        const float4 a01 = *reinterpret_cast<const float4*>(p.in[15] + (size_t)layer * 512 + 256 + c0);
        const float4 kkw = *reinterpret_cast<const float4*>(p.in[18] + (size_t)layer * 256 + c0);
        const float4 kaw = *reinterpret_cast<const float4*>(p.in[19] + (size_t)layer * 256 + c0);
        const float4 rkw = *reinterpret_cast<const float4*>(p.in[20] + (size_t)layer * 256 + c0);
        const float rr[4] = {r4.x, r4.y, r4.z, r4.w}, kk_[4] = {k4.x, k4.y, k4.z, k4.w};
        const float w0a[4] = {w00.x, w00.y, w00.z, w00.w}, w0b[4] = {w01.x, w01.y, w01.z, w01.w};
        const float a0a[4] = {a00.x, a00.y, a00.z, a00.w}, a0b[4] = {a01.x, a01.y, a01.z, a01.w};
        const float kkw_[4] = {kkw.x, kkw.y, kkw.z, kkw.w}, kaw_[4] = {kaw.x, kaw.y, kaw.z, kaw.w}, rkw_[4] = {rkw.x, rkw.y, rkw.z, rkw.w};
#pragma unroll
        for (int r = 0; r < 4; ++r) {
          {
            const float z = -(w0a[r] + acc[0][nf][r]);
            const float sp = fmaxf(z, 0.f) + log1pf(__expf(-fabsf(z)));
            acc[0][nf][r] = __expf(-__expf(-sp - 0.5f));
          }
          {
            const float z = -(w0b[r] + acc[1][nf][r]);
            const float sp = fmaxf(z, 0.f) + log1pf(__expf(-fabsf(z)));
            acc[1][nf][r] = __expf(-__expf(-sp - 0.5f));
          }
          const float av0 = sigmoidf_(a0a[r] + acc[2][nf][r]);
          const float av1 = sigmoidf_(a0b[r] + acc[3][nf][r]);
          acc[2][nf][r] = av0; acc[3][nf][r] = av1;
          const float k = kk_[r];
          const float kq = k * kkw_[r];
          ss += kq * kq;
          const float kd0 = k * (1.f + (av0 - 1.f) * kaw_[r]);
          const float kd1 = k * (1.f + (av1 - 1.f) * kaw_[r]);
          bs += rr[r] * (kd0 + kd1) * rkw_[r];
        }
        __builtin_amdgcn_sched_barrier(0);
      }
      ss += __shfl_xor(ss, 16); ss += __shfl_xor(ss, 32);
      bs += __shfl_xor(bs, 16); bs += __shfl_xor(bs, 32);
      const float inrm = 1.f / fmaxf(sqrtf(ss), 1e-12f);
#pragma unroll
      for (int nf = 0; nf < 4; ++nf) {
        const int c0 = 64 * wid + 16 * nf + 4 * fq, n0 = 16 * nf + 4 * fq;
        const float4 r4 = *reinterpret_cast<const float4*>(F + fr * FLD + c0);
        const float4 k4 = *reinterpret_cast<const float4*>(F + fr * FLD + 256 + c0);
        const float4 v4 = *reinterpret_cast<const float4*>(F + fr * FLD + 512 + c0);
        const float4 kkw = *reinterpret_cast<const float4*>(p.in[18] + (size_t)layer * 256 + c0);
        const float4 kaw = *reinterpret_cast<const float4*>(p.in[19] + (size_t)layer * 256 + c0);
        const float kk_[4] = {k4.x, k4.y, k4.z, k4.w}, kkw_[4] = {kkw.x, kkw.y, kkw.z, kkw.w}, kaw_[4] = {kaw.x, kaw.y, kaw.z, kaw.w};
        float* sc = p.SC + ((size_t)(tok * 4 + wid) * 9) * 64 + n0;
        float kn[4], kd0[4], kd1[4];
#pragma unroll
        for (int r = 0; r < 4; ++r) {
          kn[r] = kk_[r] * kkw_[r] * inrm;
          kd0[r] = kk_[r] * (1.f + (acc[2][nf][r] - 1.f) * kaw_[r]);
          kd1[r] = kk_[r] * (1.f + (acc[3][nf][r] - 1.f) * kaw_[r]);
        }
        *reinterpret_cast<float4*>(sc) = r4;
        *reinterpret_cast<float4*>(sc + 64) = make_float4(kn[0], kn[1], kn[2], kn[3]);
        *reinterpret_cast<float4*>(sc + 128) = v4;
        *reinterpret_cast<float4*>(sc + 192) = make_float4(acc[0][nf][0], acc[0][nf][1], acc[0][nf][2], acc[0][nf][3]);
        *reinterpret_cast<float4*>(sc + 256) = make_float4(acc[2][nf][0] * kn[0], acc[2][nf][1] * kn[1], acc[2][nf][2] * kn[2], acc[2][nf][3] * kn[3]);
        *reinterpret_cast<float4*>(sc + 320) = make_float4(kd0[0], kd0[1], kd0[2], kd0[3]);
        *reinterpret_cast<float4*>(sc + 384) = make_float4(acc[1][nf][0], acc[1][nf][1], acc[1][nf][2], acc[1][nf][3]);
        *reinterpret_cast<float4*>(sc + 448) = make_float4(acc[3][nf][0] * kn[0], acc[3][nf][1] * kn[1], acc[3][nf][2] * kn[2], acc[3][nf][3] * kn[3]);
        *reinterpret_cast<float4*>(sc + 512) = make_float4(kd1[0], kd1[1], kd1[2], kd1[3]);
        *reinterpret_cast<float4*>(p.G + (size_t)tok * 256 + c0) = make_float4(acc[4][nf][0], acc[4][nf][1], acc[4][nf][2], acc[4][nf][3]);
        *reinterpret_cast<float4*>(p.BV + (size_t)tok * 256 + c0) = make_float4(bs * v4.x, bs * v4.y, bs * v4.z, bs * v4.w);
        __builtin_amdgcn_sched_barrier(0);
      }
    }
#endif
#ifndef NO_D
    const int c = tid;
#pragma unroll
    for (int half = 0; half < 2; ++half) {
      float vv[8];
#pragma unroll
      for (int t8 = 0; t8 < 8; ++t8) {
        const int tt = half * 8 + t8, tok = tok0 + tt;
        const float* pr = p.PROJ + (size_t)tok * DIN + 1152 + c;
        const float q = pr[0], k = pr[256], v = pr[512];
        vv[t8] = v;
        if (isctx) {
          const size_t oi = ((size_t)(b * 4 + layer) * 256 + tpos0 + tt) * 256 + c;
          p.out_nak[oi] = k; p.out_nav[oi] = v;
          p.QNc[(size_t)tok * 256 + c] = f2bf(q * QSCALE);
          p.KNc[(size_t)(b * 4 + (c >> 6)) * 16384 + kf_off(tpos0 + tt, c & 63)] = f2bf(k);
        } else {
          p.QNl[(size_t)(tok - NCTX) * 256 + c] = f2bf(q * QSCALE);
          p.KNl[((size_t)((layer * 2 + b) * 4 + (c >> 6))) * 98304 + kf_off(512 + tpos0 + tt, c & 63)] = f2bf(k);
        }
      }
      if (isctx) pack44_store(p.VNtc + (size_t)(b * 4 + (c >> 6)) * 16384, tpos0 + half * 8, c & 63, vv);
      else pack44_store(p.VNtl + ((size_t)((layer * 2 + b) * 4 + (c >> 6))) * 98304, 512 + tpos0 + half * 8, c & 63, vv);
    }
    {
      const float qn = p.in[24][(size_t)layer * 64 + lane], kn = p.in[25][(size_t)layer * 64 + lane];
      const int fi = lane & 15;
#pragma unroll
      for (int half = 0; half < 2; ++half) {
        float vv[8];
#pragma unroll
        for (int t8 = 0; t8 < 8; ++t8) {
          const int tt = half * 8 + t8, tok = tok0 + tt, tpos = tpos0 + tt;
          const float* pr = p.PROJ + (size_t)tok * DIN + 1920;
          float cs = 1.f, sn = 0.f;
          if (!isctx) {
            const int pos = (lane < 32) ? (tpos >> 6) : (tpos & 63);
            const float2 t2 = *reinterpret_cast<const float2*>(p.rope + (size_t)(pos * 16 + fi) * 2);
            cs = t2.x; sn = t2.y;
            if ((lane & 16) == 0) sn = -sn;
          }
#pragma unroll
          for (int hh = 0; hh < 2; ++hh) {
            float q = pr[hh * 256 + c];
            const float ms = wave_sum(q * q) * (1.f / 64.f);
            q = q * rsqrtf(ms + 1e-6f) * qn;
            if (!isctx) { const float qp = __shfl_xor(q, 16); q = q * cs + qp * sn; }
            if (isctx) p.QGc[(size_t)tok * 512 + hh * 256 + c] = f2bf(q * QSCALE);
            else p.QGl[(size_t)(tok - NCTX) * 512 + hh * 256 + c] = f2bf(q * QSCALE);
          }
          if (wid < 2) {
            float k = pr[512 + c];
            const float ms = wave_sum(k * k) * (1.f / 64.f);
            k = k * rsqrtf(ms + 1e-6f) * kn;
            if (isctx) {
              p.out_gk[((size_t)(b * 4 + layer) * 256 + tpos) * 128 + c] = k;
              p.KGc[(size_t)(b * 2 + (c >> 6)) * 16384 + kf_off(tpos, c & 63)] = f2bf(k);
            } else {
              const float kp = __shfl_xor(k, 16); k = k * cs + kp * sn;
              p.KGl[((size_t)((layer * 2 + b) * 2 + (c >> 6))) * 98304 + kf_off(512 + tpos, c & 63)] = f2bf(k);
            }
          } else {
            const int cv = c - 128;
            const float v = pr[640 + cv];
            vv[t8] = v;
            if (isctx) p.out_gv[((size_t)(b * 4 + layer) * 256 + tpos) * 128 + cv] = v;
          }
        }
        if (wid >= 2) {
          const int cv = c - 128;
          if (isctx) pack44_store(p.VGtc + (size_t)(b * 2 + (cv >> 6)) * 16384, tpos0 + half * 8, cv & 63, vv);
          else pack44_store(p.VGtl + ((size_t)((layer * 2 + b) * 2 + (cv >> 6))) * 98304, 512 + tpos0 + half * 8, cv & 63, vv);
        }
      }
    }
#endif
    __syncthreads();
  }
}

#define ATT_LOAD(KF, VF, CI) { \
    const int ci_ = min((CI), nt - 1); \
    int kb_; \
    if (ci_ < nd) kb_ = ci_ * 32; \
    else { const int e_ = ci_ - nd; const int j_ = (ncc == 2) ? (e_ >> 1) : e_; const int cc_ = cc0 + ((ncc == 2) ? (e_ & 1) : 0); kb_ = 512 + (rb + j_) * 64 + cc_ * 32; } \
    const u16* kp_ = Kb + (size_t)(kb_ >> 4) * 1024 + lane * 8; \
    KF##00 = *reinterpret_cast<const bf16x8*>(kp_); \
    KF##01 = *reinterpret_cast<const bf16x8*>(kp_ + 512); \
    KF##10 = *reinterpret_cast<const bf16x8*>(kp_ + 1024); \
    KF##11 = *reinterpret_cast<const bf16x8*>(kp_ + 1536); \
    const u16* vp_ = Vt + (size_t)(kb_ >> 5) * 2048 + lane * 8; \
    VF##0 = *reinterpret_cast<const bf16x8*>(vp_); \
    VF##1 = *reinterpret_cast<const bf16x8*>(vp_ + 512); \
    VF##2 = *reinterpret_cast<const bf16x8*>(vp_ + 1024); \
    VF##3 = *reinterpret_cast<const bf16x8*>(vp_ + 1536); }

#define ATT_PV(DT, VV) { \
    o[DT][0] *= alpha; o[DT][1] *= alpha; o[DT][2] *= alpha; o[DT][3] *= alpha; \
    o[DT] = __builtin_amdgcn_mfma_f32_16x16x32_bf16(VV, pf.v, o[DT], 0, 0, 0); }

#define ATT_COMPUTE(KF, VF, CI) { \
    const int ci_ = (CI); \
    f32x4 s0 = (f32x4){0.f, 0.f, 0.f, 0.f}, s1 = (f32x4){0.f, 0.f, 0.f, 0.f}; \
    s0 = __builtin_amdgcn_mfma_f32_16x16x32_bf16(KF##00, qf0, s0, 0, 0, 0); \
    s0 = __builtin_amdgcn_mfma_f32_16x16x32_bf16(KF##01, qf1, s0, 0, 0, 0); \
    s1 = __builtin_amdgcn_mfma_f32_16x16x32_bf16(KF##10, qf0, s1, 0, 0, 0); \
    s1 = __builtin_amdgcn_mfma_f32_16x16x32_bf16(KF##11, qf1, s1, 0, 0, 0); \
    float sv[8] = {s0[0], s0[1], s0[2], s0[3], s1[0], s1[1], s1[2], s1[3]}; \
    bool ok[8]; \
    _Pragma("unroll") for (int e = 0; e < 8; ++e) ok[e] = true; \
    if (ci_ >= nd) { \
      const int e_ = ci_ - nd; const int j_ = (ncc == 2) ? (e_ >> 1) : e_; const int cc_ = cc0 + ((ncc == 2) ? (e_ & 1) : 0); \
      const int dr_ = rb + j_ - grow + 7; \
      const int cq = cq0 + fr, c0 = min(max(cq - 8, 0), 48); \
      _Pragma("unroll") for (int e = 0; e < 8; ++e) { \
        const int ck = cc_ * 32 + 16 * (e >> 2) + 4 * fq + (e & 3); \
        ok[e] = (ck >= c0) && (ck < c0 + 16); \
        const int dc = min(max(ck - cq, -15), 15) + 15; \
        const float bias = rpb[dr_ * 31 + dc] * LOG2E; \
        sv[e] = ok[e] ? sv[e] + bias : -1e30f; \
      } \
    } \
    float mx = fmaxf(fmaxf(fmaxf(sv[0], sv[1]), fmaxf(sv[2], sv[3])), fmaxf(fmaxf(sv[4], sv[5]), fmaxf(sv[6], sv[7]))); \
    mx = fmaxf(mx, __shfl_xor(mx, 16)); \
    mx = fmaxf(mx, __shfl_xor(mx, 32)); \
    const float mn = fmaxf(m, mx); \
    const float alpha = exp2f(m - mn); \
    m = mn; \
    float ps = 0.f; \
    _Pragma("unroll") for (int e = 0; e < 8; ++e) { sv[e] = ok[e] ? exp2f(sv[e] - mn) : 0.f; ps += sv[e]; } \
    l = l * alpha + ps; \
    union { bf16x8 v; unsigned u[4]; } pf; \
    pf.u[0] = pack2(sv[0], sv[1]); pf.u[1] = pack2(sv[2], sv[3]); pf.u[2] = pack2(sv[4], sv[5]); pf.u[3] = pack2(sv[6], sv[7]); \
    ATT_PV(0, VF##0) ATT_PV(1, VF##1) ATT_PV(2, VF##2) ATT_PV(3, VF##3) }

__device__ __forceinline__ void attn_wave(const u16* __restrict__ Q, int ldq, const u16* __restrict__ Kb, int ldk,
                                          const u16* __restrict__ Vt, int ldv, int ndense, const bool NA,
                                          const float* __restrict__ rpb, int grow, int cq0,
                                          u16* __restrict__ out, int ldo, int tidx) {
  const int lane = tidx & 63, fr = lane & 15, fq = lane >> 4;
  const bf16x8 qf0 = *reinterpret_cast<const bf16x8*>(Q + (size_t)fr * ldq + fq * 8);
  const bf16x8 qf1 = *reinterpret_cast<const bf16x8*>(Q + (size_t)fr * ldq + 32 + fq * 8);
  f32x4 o[4];
#pragma unroll
  for (int dt = 0; dt < 4; ++dt) o[dt] = (f32x4){0.f, 0.f, 0.f, 0.f};
  float m = -1e30f, l = 0.f;
  const int nd = ndense >> 5;
  const int rb = min(max(grow - 4, 0), 8);
  const int ulo = min(max(cq0 - 8, 0), 48), uhi = min(max(cq0 + 15 - 8, 0), 48) + 16;
  const bool c0ok = ulo < 32, c1ok = uhi > 32;
  const int ncc = (c0ok && c1ok) ? 2 : 1, cc0 = c0ok ? 0 : 1;
  const int nt = nd + (NA ? 8 * ncc : 0);
  bf16x8 ka00, ka01, ka10, ka11, kb00, kb01, kb10, kb11;
  bf16x8 va0, va1, va2, va3, vb0, vb1, vb2, vb3;
  ATT_LOAD(ka, va, 0)
  for (int ci = 0; ci < nt; ci += 2) {
    ATT_LOAD(kb, vb, ci + 1)
    ATT_COMPUTE(ka, va, ci)
    if (ci + 1 < nt) {
      ATT_LOAD(ka, va, ci + 2)
      ATT_COMPUTE(kb, vb, ci + 1)
    }
  }
  l += __shfl_xor(l, 16);
  l += __shfl_xor(l, 32);
  const float il = 1.f / l;
#pragma unroll
  for (int dt = 0; dt < 4; ++dt) {
    uint2 pk; pk.x = pack2(o[dt][0] * il, o[dt][1] * il); pk.y = pack2(o[dt][2] * il, o[dt][3] * il);
    *reinterpret_cast<uint2*>(out + (size_t)fr * ldo + 16 * dt + 4 * fq) = pk;
  }
}

__device__ void scan_item(const Params& p, int layer, char* smem, bool lat, int b, int h, int dir, int qd, int tidx) {
  const int tid = tidx, lane = tid & 63, wid = tid >> 6, rr = lane >> 4, j = lane & 15;
  const int L = lat ? 1024 : 256, seqbase = lat ? NCTX + b * 1024 : b * 256;
  const int rowl = wid * 4 + rr, row = qd * 16 + rowl;
  float* cbuf = reinterpret_cast<float*>(smem);
  float* obuf = cbuf + 2 * 16 * 6 * 64;
  float4 S = make_float4(0.f, 0.f, 0.f, 0.f);
  if (lat) S = *reinterpret_cast<const float4*>(p.in[2] + ((((size_t)(b * 4 + layer) * 2 + dir) * 4 + h) * 64 + row) * 64 + 4 * j);
  const int nch = L / 16;
  float* odst = dir == 0 ? p.OF : p.OB;
  float4 pre0, pre1, pre2, pre3, pre4, pre5;
#define SC_GL1(PR, I, CH) { const int idx = tid + 256 * (I), tt_ = idx / 96, rem = idx % 96, vec = rem >> 4, f4 = rem & 15; \
    const int st_ = (CH) * 16 + tt_, t_ = dir == 0 ? st_ : L - 1 - st_; const int svec = vec < 3 ? vec : vec + 3 * dir; \
    PR = *reinterpret_cast<const float4*>(p.SC + ((size_t)((seqbase + t_) * 4 + h) * 9 + svec) * 64 + f4 * 4); }
#define gload(CH) { SC_GL1(pre0, 0, CH) SC_GL1(pre1, 1, CH) SC_GL1(pre2, 2, CH) SC_GL1(pre3, 3, CH) SC_GL1(pre4, 4, CH) SC_GL1(pre5, 5, CH) }
#define SC_LS1(PR, I, BUF) *reinterpret_cast<float4*>(cbuf + (BUF) * 6144 + (tid + 256 * (I)) * 4) = PR;
#define lstore(BUF) { SC_LS1(pre0, 0, BUF) SC_LS1(pre1, 1, BUF) SC_LS1(pre2, 2, BUF) SC_LS1(pre3, 3, BUF) SC_LS1(pre4, 4, BUF) SC_LS1(pre5, 5, BUF) }
  gload(0); lstore(0);
  __syncthreads();
#define SC_LD(R4, K4, VV, W4, A4, D4, TT) { const float* base_ = cb + (TT) * 384; \
    R4 = *reinterpret_cast<const float4*>(base_ + 4 * j); K4 = *reinterpret_cast<const float4*>(base_ + 64 + 4 * j); \
    VV = base_[128 + row]; W4 = *reinterpret_cast<const float4*>(base_ + 192 + 4 * j); \
    A4 = *reinterpret_cast<const float4*>(base_ + 256 + 4 * j); D4 = *reinterpret_cast<const float4*>(base_ + 320 + 4 * j); }
  for (int ch = 0; ch < nch; ++ch) {
#if REPMASK
    if (ch + 1 < nch && p.pad != 5) gload(ch + 1);
#else
    if (ch + 1 < nch) gload(ch + 1);
#endif
    const float* cb = cbuf + (ch & 1) * 6144;
    float osel = 0.f;
    float4 r4, kk4, w4, ak4, kd4; float vv;
    SC_LD(r4, kk4, vv, w4, ak4, kd4, 0)
    float ovp = 0.f;
#pragma unroll 4
    for (int tt = 0; tt < 16; ++tt) {
      float4 r4n, kk4n, w4n, ak4n, kd4n; float vvn;
      SC_LD(r4n, kk4n, vvn, w4n, ak4n, kd4n, tt + 1)
      float sk = (S.x * kk4.x + S.y * kk4.y) + (S.z * kk4.z + S.w * kk4.w);
      sk += dpp_mov<0xB1>(sk);  ovp += dpp_mov<0xB1>(ovp);
      sk += dpp_mov<0x4E>(sk);  ovp += dpp_mov<0x4E>(ovp);
      sk += dpp_mov<0x141>(sk); ovp += dpp_mov<0x141>(ovp);
      sk += dpp_mov<0x140>(sk); ovp += dpp_mov<0x140>(ovp);
      osel = (j == tt - 1) ? ovp : osel;
      const float tx = vv * kd4.x - sk * ak4.x, ty = vv * kd4.y - sk * ak4.y, tz = vv * kd4.z - sk * ak4.z, tw = vv * kd4.w - sk * ak4.w;
      S.x = S.x * w4.x + tx; S.y = S.y * w4.y + ty; S.z = S.z * w4.z + tz; S.w = S.w * w4.w + tw;
      ovp = (S.x * r4.x + S.y * r4.y) + (S.z * r4.z + S.w * r4.w);
      r4 = r4n; kk4 = kk4n; w4 = w4n; ak4 = ak4n; kd4 = kd4n; vv = vvn;
    }
    ovp = reduce16(ovp);
    osel = (j == 15) ? ovp : osel;
    {
      const int st = ch * 16 + j, t = dir == 0 ? st : L - 1 - st;
      odst[(size_t)(seqbase + t) * 256 + h * 64 + row] = osel;
    }
#if REPMASK
    if (ch + 1 < nch && p.pad != 5) lstore((ch + 1) & 1);
#else
    if (ch + 1 < nch) lstore((ch + 1) & 1);
#endif
    asm volatile("s_waitcnt lgkmcnt(0)" ::: "memory");
    __builtin_amdgcn_s_barrier();
  }
  if (!lat) *reinterpret_cast<float4*>(p.out_st + ((((size_t)(b * 4 + layer) * 2 + dir) * 4 + h) * 64 + row) * 64 + 4 * j) = S;
  __syncthreads();
}

__device__ void mixer_phase(const Params& p, int layer, char* smem, int tidx0) {
  int* slot = reinterpret_cast<int*>(smem + 60 * 1024);
  for (;;) {
    int tidx = tidx0;
    asm volatile("" : "+v"(tidx));
    const int tid = tidx, wid = tid >> 6;
    __syncthreads();
    if (tid == 0) *slot = (int)atomicAdd(&p.wq[layer], 1u);
    __syncthreads();
    int it = *slot;
    if (it >= 1728) break;
    const bool is_scan = (it < 64) || (it >= 448 && it < 960);
#if REPMASK
    if ((p.pad == 1 && !is_scan) || (p.pad == 2 && is_scan) || ((p.pad == 3 || p.pad == 5 || p.pad == 6) && !(it < 64)) || (p.pad == 4 && !(it >= 64 && it < 320))) continue;
#endif
    if (is_scan) {
      const bool lat = it < 64;
      const int si = lat ? it : it - 448;
#ifndef NO_SCAN
      scan_item(p, layer, smem, lat, si / 32, (si / 8) % 4, (si / 4) % 2, si % 4, tidx);
#endif
      continue;
    }
    const u16 *Q, *Kb, *Vt; u16* out; int ldq, ldk, ldv, ndense, grow = 0, cq0 = 0; bool na = false;
    const float* rpb = p.in[23];
    if (it < 320) {
      it -= 64;
      const int b = it / 128, qh = (it / 16) % 8, qt = it % 16, kvh = qh >> 2;
      const int q0 = b * 1024 + qt * 64 + wid * 16;
      Q = p.QGl + (size_t)q0 * 512 + qh * 64; ldq = 512;
      Kb = p.KGl + (size_t)((layer * 2 + b) * 2 + kvh) * 98304; ldk = 0;
      Vt = p.VGtl + (size_t)((layer * 2 + b) * 2 + kvh) * 98304; ldv = 0; ndense = 1536;
      out = p.MIX + (size_t)(NCTX + q0) * DM + 512 + qh * 64;
    } else if (it < 448) {
      it -= 320;
      const int b = it / 64, h = (it / 16) % 4, r = it % 16;
      const int q0 = b * 1024 + r * 64 + wid * 16;
      Q = p.QNl + (size_t)q0 * 256 + h * 64; ldq = 256;
      Kb = p.KNl + (size_t)((layer * 2 + b) * 4 + h) * 98304; ldk = 0;
      Vt = p.VNtl + (size_t)((layer * 2 + b) * 4 + h) * 98304; ldv = 0; ndense = 512;
      rpb = p.in[23] + (size_t)(layer * 4 + h) * 15 * 31; grow = r; cq0 = wid * 16; na = true;
      out = p.MIX + (size_t)(NCTX + q0) * DM + 256 + h * 64;
    } else if (it < 1472) {
      it -= 960;
      const int b = it / 32, qh = (it / 4) % 8, qt = it % 4, kvh = qh >> 2;
      const int q0 = b * 256 + qt * 64 + wid * 16;
      Q = p.QGc + (size_t)q0 * 512 + qh * 64; ldq = 512;
      Kb = p.KGc + (size_t)(b * 2 + kvh) * 16384; ldk = 0;
      Vt = p.VGtc + (size_t)(b * 2 + kvh) * 16384; ldv = 0; ndense = 256;
      out = p.MIX + (size_t)q0 * DM + 512 + qh * 64;
    } else {
      it -= 1472;
      const int b = it / 16, h = (it / 4) % 4, qt = it % 4;
      const int q0 = b * 256 + qt * 64 + wid * 16;
      Q = p.QNc + (size_t)q0 * 256 + h * 64; ldq = 256;
      Kb = p.KNc + (size_t)(b * 4 + h) * 16384; ldk = 0;
      Vt = p.VNtc + (size_t)(b * 4 + h) * 16384; ldv = 0; ndense = 256;
      out = p.MIX + (size_t)q0 * DM + 256 + h * 64;
    }
#ifndef NO_ATT
    attn_wave(Q, ldq, Kb, ldk, Vt, ldv, ndense, na, rpb, grow, cq0, out, DM, tidx);
#endif
  }
}

__device__ void rwkv_fin_phase(const Params& p, int layer, int bid, int nblk, int tidx) {
  const int tid = tidx;
  const float lw = p.in[21][(size_t)layer * 256 + tid], lb = p.in[22][(size_t)layer * 256 + tid];
  for (int tok = bid; tok < NTOK; tok += nblk) {
    const size_t i = (size_t)tok * 256 + tid;
    const float o = p.OF[i] + p.OB[i];
    const float mu = wave_sum(o) * (1.f / 64.f);
    const float d = o - mu;
    const float var = wave_sum(d * d) * (1.f / 64.f);
    const float y = (d * rsqrtf(var + 64e-5f) * lw + lb + p.BV[i]) * p.G[i];
    p.MIX[(size_t)tok * DM + tid] = f2bf(y);
  }
}

#ifndef ONLY_PH
#define ONLY_PH -1
#endif
#define PH_EN(x) (ONLY_PH < 0 || ONLY_PH == (x))
__device__ __forceinline__ void run_phase(const Params& p, int ph, char* smem, int bid, int nblk, int tidx) {
  if (ph == 0) { if (PH_EN(0)) setup_phase(p, smem, bid, nblk, tidx); return; }
  if (ph == 1) { if (PH_EN(1)) modreduce_phase(p, bid, nblk, tidx); return; }
  if (ph == 2) { if (PH_EN(2)) ln_phase<0>(p, 0, bid, nblk, tidx); return; }
  const int layer = (ph - 3) / 9, s = (ph - 3) % 9;
  switch (s) {
    case 0: if (PH_EN(3)) gemm_phase<EPI_PROJ, 128>(p, layer, p.A, p.winT + (size_t)layer * DIN * DM, DIN, DM, smem, bid, nblk, tidx); break;
    case 1: if (PH_EN(4)) prep_phase(p, layer, smem, bid, nblk, tidx); break;
    case 2: if (PH_EN(5)) mixer_phase(p, layer, smem, tidx); break;
    case 3: if (PH_EN(6)) rwkv_fin_phase(p, layer, bid, nblk, tidx); break;
    case 4: if (PH_EN(7)) gemm_phase<EPI_OUT, 96>(p, layer, p.MIX, p.woutT + (size_t)layer * DM * DM, DM, DM, smem, bid, nblk, tidx); break;
    case 5: if (PH_EN(8)) ln_phase<1>(p, layer, bid, nblk, tidx); break;
    case 6: if (PH_EN(9)) gemm_phase<EPI_FFI, 128>(p, layer, p.A, p.wfiT + (size_t)layer * 2 * DFF * DM, 2 * DFF, DM, smem, bid, nblk, tidx); break;
    case 7: if (PH_EN(10)) gemm_phase<EPI_FFO, 96>(p, layer, p.ACT, p.wfoT + (size_t)layer * DM * DFF, DM, DFF, smem, bid, nblk, tidx); break;
    default: if (PH_EN(11)) ln_phase<2>(p, layer, bid, nblk, tidx); break;
  }
}

__global__ void __launch_bounds__(256, 2) fwd_kernel(Params p, int ph0, int ph1, int usebar) {
  __shared__ __attribute__((aligned(16))) char smem[65536 + 16];
  const int bid = blockIdx.x, nblk = gridDim.x;
  XcdBarrier xb;
  if (usebar && p.never) cg::this_grid().sync();
  if (usebar) {
    if (threadIdx.x == 0) *reinterpret_cast<uint4*>(smem + 65536) = make_uint4(0u, 0u, 0u, 0u);
    __syncthreads();
    xb = xcd_barrier_post(p.bar, (volatile LAS unsigned*)(smem + 65536));
  }
  for (int ph = ph0; ph < ph1; ++ph) {
    int tidx = threadIdx.x;
    asm volatile("" : "+v"(tidx));
    run_phase(p, ph, smem, bid, nblk, tidx);
#if REPMASK
    {
      const int slot_ = ph < 3 ? 9 + ph : (ph - 3) % 9;
      if ((REPMASK >> slot_) & 1) {
        if (usebar) xcd_barrier(xb);
        Params p2 = p; p2.wq = p.wq + 4; p2.pad = REPVAR;
        if (REPVAR >= 5) { p2.OF = p.PROJ; p2.OB = p.PROJ; p2.out_st = p.PROJ + 4000000; p2.MIX = (u16*)(p.PROJ + 8000000); }
        run_phase(p2, ph, smem, bid, nblk, tidx);
      }
    }
#endif
    if (usebar && ph + 1 < ph1) xcd_barrier(xb);
  }
}

static inline size_t al256(size_t x) { return (x + 255) & ~(size_t)255; }

extern "C" void kernel_launch(void* const* d_in, const int* in_sizes, int n_in, void* d_out, int out_size, void* d_ws, size_t ws_size,
                              hipStream_t stream) {
  Params p;
  memset(&p, 0, sizeof(p));
  for (int i = 0; i < 33; ++i) p.in[i] = (const float*)d_in[i];
  float* o = (float*)d_out;
  p.out_yp = o; o += 4194304;
  p.out_ys = o; o += 2097152;
  p.out_st = o; o += 2097152;
  p.out_nak = o; o += 4194304;
  p.out_nav = o; o += 4194304;
  p.out_gk = o; o += 2097152;
  p.out_gv = o;
  char* w = (char*)d_ws; size_t off = 0;
  auto take = [&](size_t bytes) { char* r = w + off; off += al256(bytes); return r; };
  p.bar = (unsigned*)take(16384);
  p.wq = p.bar + 3584;
  p.modp = (float*)take((size_t)4 * 32 * 3 * 6144 * 4);
  p.mod = (float*)take((size_t)4 * 3 * 6144 * 4);
  p.winT = (u16*)take((size_t)4 * DIN * DM * 2);
  p.woutT = (u16*)take((size_t)4 * DM * DM * 2);
  p.wfiT = (u16*)take((size_t)4 * 2 * DFF * DM * 2);
  p.wfoT = (u16*)take((size_t)4 * DM * DFF * 2);
  p.X = (float*)take((size_t)NTOK * DM * 4);
  p.PROJ = (float*)take((size_t)NTOK * DIN * 4);
  p.X1 = p.PROJ;
  p.Y = p.PROJ + (size_t)NTOK * DM;
  p.SC = (float*)take((size_t)NTOK * 4 * 9 * 64 * 4);
  p.ACT = (u16*)p.SC;
  p.G = (float*)take((size_t)NTOK * 256 * 4);
  p.BV = (float*)take((size_t)NTOK * 256 * 4);
  p.OF = (float*)take((size_t)NTOK * 256 * 4);
  p.OB = (float*)take((size_t)NTOK * 256 * 4);
  p.A = (u16*)take((size_t)NTOK * DM * 2);
  p.MIX = (u16*)take((size_t)NTOK * DM * 2);
  p.QNc = (u16*)take((size_t)NCTX * 256 * 2);
  p.KNc = (u16*)take((size_t)NCTX * 256 * 2);
  p.VNtc = (u16*)take((size_t)NCTX * 256 * 2);
  p.QGc = (u16*)take((size_t)NCTX * 512 * 2);
  p.KGc = (u16*)take((size_t)NCTX * 128 * 2);
  p.VGtc = (u16*)take((size_t)NCTX * 128 * 2);
  p.QNl = (u16*)take((size_t)2048 * 256 * 2);
  p.KNl = (u16*)take((size_t)4 * 2 * 1536 * 256 * 2);
  p.VNtl = (u16*)take((size_t)4 * 2 * 1536 * 256 * 2);
  p.QGl = (u16*)take((size_t)2048 * 512 * 2);
  p.KGl = (u16*)take((size_t)4 * 2 * 1536 * 128 * 2);
  p.VGtl = (u16*)take((size_t)4 * 2 * 1536 * 128 * 2);
  p.loraT = (u16*)take((size_t)4 * 98304 * 2);
  p.rope = (float*)take((size_t)64 * 16 * 2 * 4);
  if (off > ws_size) { fprintf(stderr, "workspace too small: need %zu have %zu\n", off, ws_size); return; }

  (void)hipMemsetAsync(p.bar, 0, 16384, stream);
#if MEGA
  static int grid_blocks = 0;
  if (!grid_blocks) {
    int dev = 0, cus = 0, per_cu = 0;
    hipGetDevice(&dev);
    hipDeviceGetAttribute(&cus, hipDeviceAttributeMultiprocessorCount, dev);
    hipOccupancyMaxActiveBlocksPerMultiprocessor(&per_cu, fwd_kernel, 256, 0);
    if (per_cu > 2) per_cu = 2;
    if (per_cu < 1) per_cu = 1;
    grid_blocks = cus * per_cu;
  }
  int ph0 = 0, ph1 = NPH, ub = 1;
  void* args[] = {&p, &ph0, &ph1, &ub};
  hipError_t e = hipLaunchCooperativeKernel((void*)fwd_kernel, dim3(grid_blocks), dim3(256), args, 0, stream);
  if (e != hipSuccess) fprintf(stderr, "cooperative launch failed: %s (grid %d)\n", hipGetErrorString(e), grid_blocks);
#else
  for (int ph = 0; ph < NPH; ++ph) fwd_kernel<<<512, 256, 0, stream>>>(p, ph, ph + 1, 0);
#endif
}
```

```cpp
#include <hip/hip_runtime.h>
#include <hip/hip_cooperative_groups.h>
#include <cstdio>
#include <cstdint>
#include <cstring>
namespace cg = cooperative_groups;

#ifndef REPMASK
#define REPMASK 0
#endif
#ifndef REPVAR
#define REPVAR 0
#endif
#ifndef MEGA
#define MEGA 1
#endif

typedef unsigned short u16;
using bf16x8 = __attribute__((ext_vector_type(8))) short;
using f32x4 = __attribute__((ext_vector_type(4))) float;

#define NTOK 6144
#define NCTX 4096
#define DM 1024
#define DIN 2688
#define DFF 2816
#define NPH 39
#define ALPHA 1.681792830507429f
#define LOG2E 1.4426950408889634f
#define QSCALE (0.125f * LOG2E)

struct Params {
  const float* in[33];
  float *out_yp, *out_ys, *out_st, *out_nak, *out_nav, *out_gk, *out_gv;
  unsigned *bar, *wq;
  float *modp, *mod;
  u16 *winT, *woutT, *wfiT, *wfoT;
  float *X, *X1, *Y, *PROJ, *SC, *G, *BV, *OF, *OB;
  u16 *A, *MIX, *ACT;
  u16 *QNc, *KNc, *VNtc, *QGc, *KGc, *VGtc;
  u16 *QNl, *KNl, *VNtl, *QGl, *KGl, *VGtl;
  u16* loraT; float* rope;
  int never; int pad;
};

__device__ __forceinline__ u16 f2bf(float f) {
  unsigned u = __float_as_uint(f);
  u += 0x7FFFu + ((u >> 16) & 1u);
  return (u16)(u >> 16);
}
__device__ __forceinline__ unsigned pack2(float a, float b) { return (unsigned)f2bf(a) | ((unsigned)f2bf(b) << 16); }
__device__ __forceinline__ float wave_sum(float v) {
#pragma unroll
  for (int o = 32; o; o >>= 1) v += __shfl_xor(v, o);
  return v;
}
template <int CTRL> __device__ __forceinline__ float dpp_mov(float v) {
  return __int_as_float(__builtin_amdgcn_update_dpp(0, __float_as_int(v), CTRL, 0xF, 0xF, false));
}
__device__ __forceinline__ float reduce16(float v) {
  v += dpp_mov<0xB1>(v);
  v += dpp_mov<0x4E>(v);
  v += dpp_mov<0x141>(v);
  v += dpp_mov<0x140>(v);
  return v;
}
__device__ __forceinline__ float sigmoidf_(float x) { return 1.f / (1.f + __expf(-x)); }
__device__ __forceinline__ float siluf_(float x) { return x / (1.f + __expf(-x)); }
__device__ __forceinline__ int modrow_of(int tok) { return tok < NCTX ? 0 : 1 + ((tok - NCTX) >> 10); }

#define XB_TMO      128
#define XB_XCNT(j)  (256  + 64 * (j))
#define XB_XSUB(j)  (1280 + 64 * (j))
#define XB_XGEN(j)  (2304 + 64 * (j))
#define XB_TOP      3328
#define XB_TOPGEN   3392
#define XCD_BAR_WORDS 3456
#define XB_SPIN_CAP (1u << 22)
#define LAS __attribute__((address_space(3)))
__device__ __forceinline__ unsigned xb_ld(unsigned* p) { return __hip_atomic_load(p, __ATOMIC_RELAXED, __HIP_MEMORY_SCOPE_AGENT); }
__device__ __forceinline__ unsigned xb_add(unsigned* p, unsigned v) { return __hip_atomic_fetch_add(p, v, __ATOMIC_RELAXED, __HIP_MEMORY_SCOPE_AGENT); }
__device__ __forceinline__ unsigned xb_xcc_id() { return (unsigned)__builtin_amdgcn_s_getreg((3 << 11) | 20) & 0xFu; }
#define XB_SPIN(cond, bar) do { unsigned _sp = 0; while (cond) { __builtin_amdgcn_s_sleep(1); \
    if ((++_sp & 255u) == 0u) { if (xb_ld(&(bar)[XB_TMO])) break; if (_sp > XB_SPIN_CAP) { atomicAdd(&(bar)[XB_TMO], 1u); break; } } } } while (0)
struct XcdBarrier { unsigned* bar; unsigned x; volatile LAS unsigned* st; };
__device__ __forceinline__ XcdBarrier xcd_barrier_post(unsigned* bar, volatile LAS unsigned* st) {
  XcdBarrier b; b.bar = bar; b.x = xb_xcc_id(); b.st = st;
  if (threadIdx.x == 0) (void)xb_add(&bar[XB_XCNT(b.x)], 1u);
  return b;
}
__device__ __forceinline__ void xcd_barrier_complete(unsigned* bar, unsigned x, unsigned& nloc, unsigned& nx) {
  const unsigned G = gridDim.x * gridDim.y * gridDim.z;
  unsigned sum, cnt, mine, sp = 0u;
  for (;;) {
    sum = 0u; cnt = 0u; mine = 0u;
#pragma unroll
    for (unsigned j = 0; j < 16; ++j) { const unsigned c = xb_ld(&bar[XB_XCNT(j)]); sum += c; cnt += (c > 0u) ? 1u : 0u; mine = (j == x) ? c : mine; }
    if (sum == G) break;
    __builtin_amdgcn_s_sleep(1);
    if ((++sp & 255u) == 0u) { if (xb_ld(&bar[XB_TMO])) break; if (sp > XB_SPIN_CAP) { atomicAdd(&bar[XB_TMO], 1u); break; } }
  }
  nloc = mine > 0u ? mine : 1u; nx = cnt > 0u ? cnt : 1u;
}
__device__ __forceinline__ void xcd_barrier(const XcdBarrier& b) {
  asm volatile("s_waitcnt vmcnt(0)" ::: "memory");
  __syncthreads();
  if (threadIdx.x == 0) {
    unsigned* bar = b.bar;
    __builtin_amdgcn_s_waitcnt(0);
    unsigned nloc = b.st[0], nx = b.st[1];
    if (nloc == 0u) { xcd_barrier_complete(bar, b.x, nloc, nx); b.st[0] = nloc; b.st[1] = nx; }
    const unsigned old = xb_add(&bar[XB_XSUB(b.x)], 1u);
    const unsigned gen = old / nloc;
    if (old + 1u == (gen + 1u) * nloc) {
      __builtin_amdgcn_fence(__ATOMIC_RELEASE, "agent");
      asm volatile("s_waitcnt vmcnt(0)" ::: "memory");
      const unsigned og = xb_add(&bar[XB_TOP], 1u);
      const unsigned tg = og / nx;
      if (og + 1u == (tg + 1u) * nx) xb_add(&bar[XB_TOPGEN], 1u);
      else XB_SPIN(xb_ld(&bar[XB_TOPGEN]) == tg, bar);
      __builtin_amdgcn_fence(__ATOMIC_ACQUIRE, "agent");
      xb_add(&bar[XB_XGEN(b.x)], 1u);
      asm volatile("s_waitcnt vmcnt(0)" ::: "memory");
    } else {
      XB_SPIN(xb_ld(&bar[XB_XGEN(b.x)]) == gen, bar);
      __builtin_amdgcn_fence(__ATOMIC_ACQUIRE, "agent");
      asm volatile("s_waitcnt vmcnt(0)" ::: "memory");
    }
  }
  __syncthreads();
}

__device__ __forceinline__ int lds_byte32(int r, int c) {
  const int ob = (r & 15) * 64 + c * 2;
  return (r >> 4) * 1024 + (ob ^ (((ob >> 9) & 1) << 5));
}
__device__ __forceinline__ void stage_rc32(int b, int& R, int& C) {
  const int sb = b & 1023, swz = sb ^ (((sb >> 9) & 1) << 5);
  R = (b >> 10) * 16 + (swz >> 6); C = (swz & 63) >> 1;
}
template <int ROWS>
__device__ __forceinline__ void stage_tile32(const u16* __restrict__ g, int ld, char* lds, int tidx) {
#pragma unroll
  for (int i = 0; i < (ROWS * 64 + 4095) / 4096; ++i) {
    const int b = tidx * 16 + i * 4096;
    if ((i + 1) * 4096 <= ROWS * 64 || tidx < (ROWS * 64 - i * 4096) / 16) {
      int R, C; stage_rc32(b, R, C);
      __builtin_amdgcn_global_load_lds((const unsigned*)(g + (size_t)R * ld + C), (unsigned LAS*)(lds + b), 16, 0, 0);
    }
  }
}
template <int N> __device__ __forceinline__ void wait_vmcnt() {
  if (N == 0) asm volatile("s_waitcnt vmcnt(0)" ::: "memory");
  else if (N == 3) asm volatile("s_waitcnt vmcnt(3)" ::: "memory");
  else if (N == 4) asm volatile("s_waitcnt vmcnt(4)" ::: "memory");
  else if (N == 5) asm volatile("s_waitcnt vmcnt(5)" ::: "memory");
  else if (N == 6) asm volatile("s_waitcnt vmcnt(6)" ::: "memory");
  else if (N == 8) asm volatile("s_waitcnt vmcnt(8)" ::: "memory");
  else if (N == 10) asm volatile("s_waitcnt vmcnt(10)" ::: "memory");
  else if (N == 12) asm volatile("s_waitcnt vmcnt(12)" ::: "memory");
  else asm volatile("s_waitcnt vmcnt(0)" ::: "memory");
}

enum { EPI_PROJ = 0, EPI_OUT = 1, EPI_FFI = 2, EPI_FFO = 3 };

template <int EPI, int BM, int NST>
__device__ __forceinline__ void gemm_phase(const Params& p, int layer, const u16* __restrict__ A, const u16* __restrict__ Bt,
                                           int N, int K, char* smem, int bid, int nblk, int tidx) {
  constexpr int MF = BM / 32;
  const int tid = tidx, lane = tid & 63, wid = tid >> 6, wr = wid >> 1, wc = wid & 1, fr = lane & 15, fq = lane >> 4;
  const int nM = NTOK / BM, nN = N / 128, ntiles = nM * nN, nk = K / 32;
  constexpr int SB = (BM + 128) * 64;
  constexpr int LA = (BM * 64) / 4096;
  const bool extraA = (BM == 96) && (wid < 2);
  for (int tile = bid; tile < ntiles; tile += nblk) {
    const int pm = tile % nM, pn = tile / nM, m0 = pm * BM, n0 = pn * 128;
    f32x4 acc[MF][4];
#pragma unroll
    for (int m = 0; m < MF; ++m)
#pragma unroll
      for (int n = 0; n < 4; ++n) acc[m][n] = (f32x4){0.f, 0.f, 0.f, 0.f};
    const u16* Ag = A + (size_t)m0 * K;
    const u16* Bg = Bt + (size_t)n0 * K;
#pragma unroll
    for (int s_ = 0; s_ < NST - 1; ++s_) {
      stage_tile32<BM>(Ag + s_ * 32, K, smem + s_ * SB, tidx);
      stage_tile32<128>(Bg + s_ * 32, K, smem + s_ * SB + BM * 64, tidx);
    }
    int slot = 0, pslot = NST - 1;
    for (int kt = 0; kt < nk; ++kt) {
      if (kt + NST - 2 < nk) {
        if (BM == 96) { if (extraA) wait_vmcnt<(NST - 2) * 4>(); else wait_vmcnt<(NST - 2) * 3>(); }
        else wait_vmcnt<(NST - 2) * (LA + 2)>();
      } else {
        asm volatile("s_waitcnt vmcnt(0)" ::: "memory");
      }
      __builtin_amdgcn_s_barrier();
      if (kt + NST - 1 < nk) {
        char* nb = smem + pslot * SB;
        stage_tile32<BM>(Ag + (kt + NST - 1) * 32, K, nb, tidx);
        stage_tile32<128>(Bg + (kt + NST - 1) * 32, K, nb + BM * 64, tidx);
      }
      const char* sa = smem + slot * SB;
      const char* sb = sa + BM * 64;
      slot = (slot + 1 == NST) ? 0 : slot + 1;
      pslot = (pslot + 1 == NST) ? 0 : pslot + 1;
      bf16x8 af[MF], bfr[4];
#pragma unroll
      for (int m = 0; m < MF; ++m) af[m] = *reinterpret_cast<const bf16x8*>(sa + lds_byte32(wr * (BM / 2) + m * 16 + fr, fq * 8));
#pragma unroll
      for (int n = 0; n < 4; ++n) bfr[n] = *reinterpret_cast<const bf16x8*>(sb + lds_byte32(wc * 64 + n * 16 + fr, fq * 8));
#pragma unroll
      for (int m = 0; m < MF; ++m)
#pragma unroll
        for (int n = 0; n < 4; ++n) acc[m][n] = __builtin_amdgcn_mfma_f32_16x16x32_bf16(bfr[n], af[m], acc[m][n], 0, 0, 0);
    }
#pragma unroll
    for (int m = 0; m < MF; ++m) {
      const int row = m0 + wr * (BM / 2) + m * 16 + fr;
      if (EPI == EPI_PROJ) {
#pragma unroll
        for (int n = 0; n < 4; ++n) {
          const int col = n0 + wc * 64 + n * 16 + 4 * fq;
          *reinterpret_cast<float4*>(p.PROJ + (size_t)row * DIN + col) = make_float4(acc[m][n][0], acc[m][n][1], acc[m][n][2], acc[m][n][3]);
        }
      } else if (EPI == EPI_OUT || EPI == EPI_FFO) {
        const float* res = (EPI == EPI_OUT) ? p.X : p.X1;
        const float* gate = p.mod + ((size_t)(layer * 3 + modrow_of(row)) * 6 + (EPI == EPI_OUT ? 2 : 5)) * 1024;
#pragma unroll
        for (int n = 0; n < 4; ++n) {
          const int col = n0 + wc * 64 + n * 16 + 4 * fq;
          const float4 xr = *reinterpret_cast<const float4*>(res + (size_t)row * DM + col);
          const float4 gt = *reinterpret_cast<const float4*>(gate + col);
          float4 y;
          y.x = ALPHA * xr.x + gt.x * acc[m][n][0];
          y.y = ALPHA * xr.y + gt.y * acc[m][n][1];
          y.z = ALPHA * xr.z + gt.z * acc[m][n][2];
          y.w = ALPHA * xr.w + gt.w * acc[m][n][3];
          *reinterpret_cast<float4*>(p.Y + (size_t)row * DM + col) = y;
        }
      } else {
#pragma unroll
        for (int n2 = 0; n2 < 2; ++n2) {
          const int j0 = ((n0 + wc * 64) / 32 + n2) * 16 + 4 * fq;
          float a[4];
#pragma unroll
          for (int r = 0; r < 4; ++r) a[r] = siluf_(acc[m][2 * n2][r]) * acc[m][2 * n2 + 1][r];
          uint2 pk; pk.x = pack2(a[0], a[1]); pk.y = pack2(a[2], a[3]);
          *reinterpret_cast<uint2*>(p.ACT + (size_t)row * DFF + j0) = pk;
        }
      }
    }
    asm volatile("s_waitcnt lgkmcnt(0)" ::: "memory");
    __builtin_amdgcn_s_barrier();
  }
}

__device__ __forceinline__ int kf_off(int t, int d) { return (t >> 4) * 1024 + (d >> 5) * 512 + ((d & 31) >> 3) * 128 + (t & 15) * 8 + (d & 7); }
__device__ __forceinline__ int vf_off(int t, int d) { return (t >> 5) * 2048 + (d >> 4) * 512 + (((t & 15) >> 2) * 16 + (d & 15)) * 8 + ((t >> 4) & 1) * 4 + (t & 3); }
__device__ __forceinline__ void pack44_store(u16* base, int t0, int d, const float* v) {
  uint2 a, b; a.x = pack2(v[0], v[1]); a.y = pack2(v[2], v[3]); b.x = pack2(v[4], v[5]); b.y = pack2(v[6], v[7]);
  *reinterpret_cast<uint2*>(base + vf_off(t0, d)) = a;
  *reinterpret_cast<uint2*>(base + vf_off(t0 + 4, d)) = b;
}
__device__ __forceinline__ void pack8_store(u16* dst, const float* v) {
  uint4 pk; pk.x = pack2(v[0], v[1]); pk.y = pack2(v[2], v[3]); pk.z = pack2(v[4], v[5]); pk.w = pack2(v[6], v[7]);
  *reinterpret_cast<uint4*>(dst) = pk;
}

__device__ void setup_phase(const Params& p, char* smem, int bid, int nblk, int tidx) {
  const int tid = tidx;
  const int NI = 768 + 512 + 4 * 3040 + 13;
  for (int it = bid; it < NI; it += nblk) {
    if (it < 768) {
      const int l = it / 192, nc = (it / 32) % 6, kc = it % 32;
      const int col = nc * 1024 + tid * 4;
      const float* wm = p.in[9] + (size_t)l * 1024 * 6144;
      float4 a0 = make_float4(0, 0, 0, 0), a1 = a0, a2 = a0;
      for (int kk = 0; kk < 32; ++kk) {
        const int k = kc * 32 + kk;
        const float s0 = siluf_(p.in[8][k]), s1 = siluf_(p.in[7][k]), s2 = siluf_(p.in[7][1024 + k]);
        const float4 w = *reinterpret_cast<const float4*>(wm + (size_t)k * 6144 + col);
        a0.x += s0 * w.x; a0.y += s0 * w.y; a0.z += s0 * w.z; a0.w += s0 * w.w;
        a1.x += s1 * w.x; a1.y += s1 * w.y; a1.z += s1 * w.z; a1.w += s1 * w.w;
        a2.x += s2 * w.x; a2.y += s2 * w.y; a2.z += s2 * w.z; a2.w += s2 * w.w;
      }
      float* dst = p.modp + (size_t)((l * 32 + kc) * 3) * 6144 + col;
      *reinterpret_cast<float4*>(dst) = a0;
      *reinterpret_cast<float4*>(dst + 6144) = a1;
      *reinterpret_cast<float4*>(dst + 2 * 6144) = a2;
    } else if (it < 1280) {
      const int ci = it - 768, b = ci / 256, l = (ci / 64) % 4, tg = ci % 64, t0 = tg * 8;
      {
        const float* ck = p.in[3] + ((size_t)(b * 4 + l) * 512 + t0) * 256 + tid;
        const float* cv = p.in[4] + ((size_t)(b * 4 + l) * 512 + t0) * 256 + tid;
        float v[8];
#pragma unroll
        for (int tt = 0; tt < 8; ++tt) {
          p.KNl[((size_t)((l * 2 + b) * 4 + (tid >> 6))) * 98304 + kf_off(t0 + tt, tid & 63)] = f2bf(ck[tt * 256]);
          v[tt] = cv[tt * 256];
        }
        pack44_store(p.VNtl + ((size_t)((l * 2 + b) * 4 + (tid >> 6))) * 98304, t0, tid & 63, v);
      }
      if (tid < 128) {
        const float* ck = p.in[5] + ((size_t)(b * 4 + l) * 512 + t0) * 128 + tid;
#pragma unroll
        for (int tt = 0; tt < 8; ++tt) p.KGl[((size_t)((l * 2 + b) * 2 + (tid >> 6))) * 98304 + kf_off(t0 + tt, tid & 63)] = f2bf(ck[tt * 128]);
      } else {
        const int c = tid - 128;
        const float* cv = p.in[6] + ((size_t)(b * 4 + l) * 512 + t0) * 128 + c;
        float v[8];
#pragma unroll
        for (int tt = 0; tt < 8; ++tt) v[tt] = cv[tt * 128];
        pack44_store(p.VGtl + ((size_t)((l * 2 + b) * 2 + (c >> 6))) * 98304, t0, c & 63, v);
      }
    } else if (it >= 768 + 512 + 4 * 3040) {
      const int li = it - (768 + 512 + 4 * 3040);
      if (li == 12) {
        for (int idx = tid; idx < 1024; idx += 256) {
          const int pos = idx >> 4, fi = idx & 15;
          const float ang = (float)pos * exp2f(-(float)fi * (13.287712379549449f / 16.f));
          p.rope[idx * 2] = cosf(ang); p.rope[idx * 2 + 1] = sinf(ang);
        }
      } else {
        const int l = li / 3, m = li % 3;
        u16* dst = p.loraT + (size_t)l * 98304 + m * 32768;
        if (m < 2) {
          const float* src = p.in[m == 0 ? 14 : 16] + (size_t)l * 32768;
          for (int idx = tid; idx < 32768; idx += 256) {
            const int d = idx >> 14, cch = (idx >> 6) & 255, r = idx & 63;
            dst[idx] = f2bf(src[(d * 64 + r) * 256 + cch]);
          }
        } else {
          const float* src = p.in[17] + (size_t)l * 32768;
          for (int idx = tid; idx < 32768; idx += 256) {
            const int cch = idx >> 7, j = idx & 127;
            dst[idx] = f2bf(src[j * 256 + cch]);
          }
        }
      }
    } else {
      const int wi = it - 1280, l = wi / 3040; int r = wi % 3040;
      const float* src; u16* dst; int K, N, mat, kt, nt;
      if (r < 672) { mat = 0; K = 1024; N = 2688; src = p.in[11] + (size_t)l * K * N; dst = p.winT + (size_t)l * N * K; kt = r / 42; nt = r % 42; }
      else if (r < 928) { r -= 672; mat = 1; K = 1024; N = 1024; src = p.in[26] + (size_t)l * K * N; dst = p.woutT + (size_t)l * N * K; kt = r / 16; nt = r % 16; }
      else if (r < 2336) { r -= 928; mat = 2; K = 1024; N = 5632; src = p.in[29] + (size_t)l * K * N; dst = p.wfiT + (size_t)l * N * K; kt = r / 88; nt = r % 88; }
      else { r -= 2336; mat = 3; K = 2816; N = 1024; src = p.in[30] + (size_t)l * K * N; dst = p.wfoT + (size_t)l * N * K; kt = r / 16; nt = r % 16; }
      float* tile = reinterpret_cast<float*>(smem);
      const int k0 = kt * 64, n0 = nt * 64;
#pragma unroll
      for (int i = 0; i < 4; ++i) {
        const int kr = (tid >> 4) + 16 * i, c4 = (tid & 15) * 4;
        const float4 v = *reinterpret_cast<const float4*>(src + (size_t)(k0 + kr) * N + n0 + c4);
        tile[kr * 65 + c4 + 0] = v.x; tile[kr * 65 + c4 + 1] = v.y; tile[kr * 65 + c4 + 2] = v.z; tile[kr * 65 + c4 + 3] = v.w;
      }
      __syncthreads();
#pragma unroll
      for (int i = 0; i < 2; ++i) {
        const int idx = tid + 256 * i, nl = idx >> 3, kc = idx & 7;
        int n = n0 + nl;
        if (mat == 2) { const int isup = n >= DFF ? 1 : 0; const int j = n - isup * DFF; n = (j >> 4) * 32 + isup * 16 + (j & 15); }
        float v[8];
#pragma unroll
        for (int jj = 0; jj < 8; ++jj) v[jj] = tile[(kc * 8 + jj) * 65 + nl];
        pack8_store(dst + (size_t)n * K + k0 + kc * 8, v);
      }
      __syncthreads();
    }
  }
}

__device__ void modreduce_phase(const Params& p, int bid, int nblk, int tidx) {
  for (int idx = bid * 256 + tidx; idx < 18432; idx += nblk * 256) {
    const int l = idx / 4608, rem = idx % 4608, mr = rem / 1536, c4 = (rem % 1536) * 4;
    float4 a = *reinterpret_cast<const float4*>(p.in[10] + (size_t)l * 6144 + c4);
    for (int kc = 0; kc < 32; ++kc) {
      const float4 v = *reinterpret_cast<const float4*>(p.modp + (size_t)((l * 32 + kc) * 3 + mr) * 6144 + c4);
      a.x += v.x; a.y += v.y; a.z += v.z; a.w += v.w;
    }
    *reinterpret_cast<float4*>(p.mod + (size_t)(l * 3 + mr) * 6144 + c4) = a;
  }
}

template <int MODE>
__device__ void ln_phase(const Params& p, int layer, int bid, int nblk, int tidx) {
  const int lane = tidx & 63, wid = tidx >> 6;
  for (int it = bid; it < NTOK / 4; it += nblk) {
    const int row = it * 4 + wid;
    const float* src;
    if (MODE == 0) src = row < NCTX ? p.in[0] + (size_t)row * DM : p.in[1] + (size_t)(row - NCTX) * DM;
    else src = p.Y + (size_t)row * DM;
    float4 v[4];
#pragma unroll
    for (int i = 0; i < 4; ++i) v[i] = reinterpret_cast<const float4*>(src)[lane + 64 * i];
    if (MODE != 0) {
      float s = 0.f;
#pragma unroll
      for (int i = 0; i < 4; ++i) s += v[i].x + v[i].y + v[i].z + v[i].w;
      const float mu = wave_sum(s) * (1.f / 1024.f);
      float q = 0.f;
#pragma unroll
      for (int i = 0; i < 4; ++i) {
        v[i].x -= mu; v[i].y -= mu; v[i].z -= mu; v[i].w -= mu;
        q += v[i].x * v[i].x + v[i].y * v[i].y + v[i].z * v[i].z + v[i].w * v[i].w;
      }
      const float rstd = rsqrtf(wave_sum(q) * (1.f / 1024.f) + 1e-5f);
      const float* lw = (MODE == 1 ? p.in[27] : p.in[31]) + (size_t)layer * DM;
      const float* lb = (MODE == 1 ? p.in[28] : p.in[32]) + (size_t)layer * DM;
#pragma unroll
      for (int i = 0; i < 4; ++i) {
        const float4 w = reinterpret_cast<const float4*>(lw)[lane + 64 * i];
        const float4 b = reinterpret_cast<const float4*>(lb)[lane + 64 * i];
        v[i].x = v[i].x * rstd * w.x + b.x; v[i].y = v[i].y * rstd * w.y + b.y;
        v[i].z = v[i].z * rstd * w.z + b.z; v[i].w = v[i].w * rstd * w.w + b.w;
      }
    }
    float* xdst = (MODE == 1 ? p.X1 : p.X) + (size_t)row * DM;
#pragma unroll
    for (int i = 0; i < 4; ++i) reinterpret_cast<float4*>(xdst)[lane + 64 * i] = v[i];
    if (MODE == 2 && layer == 3) {
      float* o = row < NCTX ? p.out_yp + (size_t)row * DM : p.out_ys + (size_t)(row - NCTX) * DM;
#pragma unroll
      for (int i = 0; i < 4; ++i) reinterpret_cast<float4*>(o)[lane + 64 * i] = v[i];
    } else {
      const int ml = (MODE == 2) ? layer + 1 : layer;
      const int which = (MODE == 1) ? 3 : 0;
      const float* sh = p.mod + ((size_t)(ml * 3 + modrow_of(row)) * 6 + which) * 1024;
      const float* sc = sh + 1024;
      u16* adst = p.A + (size_t)row * DM;
#pragma unroll
      for (int i = 0; i < 4; ++i) {
        const float4 s4 = reinterpret_cast<const float4*>(sh)[lane + 64 * i];
        const float4 c4 = reinterpret_cast<const float4*>(sc)[lane + 64 * i];
        uint2 pk;
        pk.x = pack2(v[i].x * (1.f + c4.x) + s4.x, v[i].y * (1.f + c4.y) + s4.y);
        pk.y = pack2(v[i].z * (1.f + c4.z) + s4.z, v[i].w * (1.f + c4.w) + s4.w);
        reinterpret_cast<uint2*>(adst)[lane + 64 * i] = pk;
      }
    }
  }
}

#define FLD 772
#define LLD 392
__device__ void prep_phase(const Params& p, int layer, char* smem, int bid, int nblk, int tidx) {
  float* F = reinterpret_cast<float*>(smem);
  u16* LIb = reinterpret_cast<u16*>(smem + 16 * FLD * 4);
  const float* cw = p.in[12] + (size_t)layer * 3 * 1152;
  const u16* LW = p.loraT + (size_t)layer * 98304;
  for (int it = bid; it < NTOK / 16; it += nblk) {
    int tid = tidx;
    asm volatile("" : "+v"(tid));
    const int lane = tid & 63, wid = tid >> 6, fr = lane & 15, fq = lane >> 4;
    const int tok0 = it * 16;
    int b, tpos0, L;
    const bool isctx = tok0 < NCTX;
    if (isctx) { b = tok0 >> 8; tpos0 = tok0 & 255; L = 256; }
    else { const int tl = tok0 - NCTX; b = tl >> 10; tpos0 = tl & 1023; L = 1024; }
#pragma unroll 2
    for (int idx = tid; idx < 16 * 288; idx += 256) {
      const int tt = idx / 288, c = (idx % 288) * 4, tpos = tpos0 + tt;
      const float* pr = p.PROJ + (size_t)(tok0 + tt) * DIN + c;
      const float4 w0 = *reinterpret_cast<const float4*>(cw + c);
      const float4 w1 = *reinterpret_cast<const float4*>(cw + 1152 + c);
      const float4 w2 = *reinterpret_cast<const float4*>(cw + 2304 + c);
      const float4 xc = *reinterpret_cast<const float4*>(pr);
      float4 f = make_float4(w1.x * xc.x, w1.y * xc.y, w1.z * xc.z, w1.w * xc.w);
      if (tpos > 0) { const float4 xp = *reinterpret_cast<const float4*>(pr - DIN); f.x += w0.x * xp.x; f.y += w0.y * xp.y; f.z += w0.z * xp.z; f.w += w0.w * xp.w; }
      if (tpos < L - 1) { const float4 xn = *reinterpret_cast<const float4*>(pr + DIN); f.x += w2.x * xn.x; f.y += w2.y * xn.y; f.z += w2.z * xn.z; f.w += w2.w * xn.w; }
      if (c < 768) { *reinterpret_cast<float4*>(F + tt * FLD + c) = f; }
      else {
        const int cc = c - 768;
        if (cc < 128) { f.x = tanhf(f.x); f.y = tanhf(f.y); f.z = tanhf(f.z); f.w = tanhf(f.w); }
        else if (cc >= 256) { f.x = sigmoidf_(f.x); f.y = sigmoidf_(f.y); f.z = sigmoidf_(f.z); f.w = sigmoidf_(f.w); }
        uint2 pk; pk.x = pack2(f.x, f.y); pk.y = pack2(f.z, f.w);
        *reinterpret_cast<uint2*>(LIb + tt * LLD + cc) = pk;
      }
    }
    __syncthreads();
    f32x4 acc[5][4];
#pragma unroll
    for (int g = 0; g < 5; ++g)
#pragma unroll
      for (int nf = 0; nf < 4; ++nf) acc[g][nf] = (f32x4){0.f, 0.f, 0.f, 0.f};
#pragma unroll
    for (int g = 0; g < 4; ++g) {
      const u16* wt = LW + (size_t)g * 16384;
#pragma unroll
      for (int ks = 0; ks < 2; ++ks) {
        const bf16x8 xb = *reinterpret_cast<const bf16x8*>(LIb + fr * LLD + g * 64 + ks * 32 + fq * 8);
#pragma unroll
        for (int nf = 0; nf < 4; ++nf) {
          const bf16x8 wa = *reinterpret_cast<const bf16x8*>(wt + (size_t)(64 * wid + 16 * nf + fr) * 64 + ks * 32 + fq * 8);
          acc[g][nf] = __builtin_amdgcn_mfma_f32_16x16x32_bf16(wa, xb, acc[g][nf], 0, 0, 0);
        }
      }
      __builtin_amdgcn_sched_barrier(0);
    }
    {
      const u16* wt = LW + 65536;
#pragma unroll
      for (int ks = 0; ks < 4; ++ks) {
        const bf16x8 xb = *reinterpret_cast<const bf16x8*>(LIb + fr * LLD + 256 + ks * 32 + fq * 8);
#pragma unroll
        for (int nf = 0; nf < 4; ++nf) {
          const bf16x8 wa = *reinterpret_cast<const bf16x8*>(wt + (size_t)(64 * wid + 16 * nf + fr) * 128 + ks * 32 + fq * 8);
          acc[4][nf] = __builtin_amdgcn_mfma_f32_16x16x32_bf16(wa, xb, acc[4][nf], 0, 0, 0);
        }
        if (ks == 1) __builtin_amdgcn_sched_barrier(0);
      }
      __builtin_amdgcn_sched_barrier(0);
    }
#ifndef NO_C
    {
      const int tok = tok0 + fr;
      float ss = 0.f, bs = 0.f;
#pragma unroll
      for (int nf = 0; nf < 4; ++nf) {
        const int c0 = 64 * wid + 16 * nf + 4 * fq;
        const float4 r4 = *reinterpret_cast<const float4*>(F + fr * FLD + c0);
        const float4 k4 = *reinterpret_cast<const float4*>(F + fr * FLD + 256 + c0);
        const float4 w00 = *reinterpret_cast<const float4*>(p.in[13] + (size_t)layer * 512 + c0);
        const float4 w01 = *reinterpret_cast<const float4*>(p.in[13] + (size_t)layer * 512 + 256 + c0);
        const float4 a00 = *reinterpret_cast<const float4*>(p.in[15] + (size_t)layer * 512 + c0);
        const float4 a01 = *reinterpret_cast<const float4*>(p.in[15] + (size_t)layer * 512 + 256 + c0);
        const float4 kkw = *reinterpret_cast<const float4*>(p.in[18] + (size_t)layer * 256 + c0);
        const float4 kaw = *reinterpret_cast<const float4*>(p.in[19] + (size_t)layer * 256 + c0);
        const float4 rkw = *reinterpret_cast<const float4*>(p.in[20] + (size_t)layer * 256 + c0);
        const float rr[4] = {r4.x, r4.y, r4.z, r4.w}, kk_[4] = {k4.x, k4.y, k4.z, k4.w};
        const float w0a[4] = {w00.x, w00.y, w00.z, w00.w}, w0b[4] = {w01.x, w01.y, w01.z, w01.w};
        const float a0a[4] = {a00.x, a00.y, a00.z, a00.w}, a0b[4] = {a01.x, a01.y, a01.z, a01.w};
        const float kkw_[4] = {kkw.x, kkw.y, kkw.z, kkw.w}, kaw_[4] = {kaw.x, kaw.y, kaw.z, kaw.w}, rkw_[4] = {rkw.x, rkw.y, rkw.z, rkw.w};
#pragma unroll
        for (int r = 0; r < 4; ++r) {
          {
            const float z = -(w0a[r] + acc[0][nf][r]);
            const float sp = fmaxf(z, 0.f) + log1pf(__expf(-fabsf(z)));
            acc[0][nf][r] = __expf(-__expf(-sp - 0.5f));
          }
          {
            const float z = -(w0b[r] + acc[1][nf][r]);
            const float sp = fmaxf(z, 0.f) + log1pf(__expf(-fabsf(z)));
            acc[1][nf][r] = __expf(-__expf(-sp - 0.5f));
          }
          const float av0 = sigmoidf_(a0a[r] + acc[2][nf][r]);
          const float av1 = sigmoidf_(a0b[r] + acc[3][nf][r]);
          acc[2][nf][r] = av0; acc[3][nf][r] = av1;
          const float k = kk_[r];
          const float kq = k * kkw_[r];
          ss += kq * kq;
          const float kd0 = k * (1.f + (av0 - 1.f) * kaw_[r]);
          const float kd1 = k * (1.f + (av1 - 1.f) * kaw_[r]);
          bs += rr[r] * (kd0 + kd1) * rkw_[r];
        }
        __builtin_amdgcn_sched_barrier(0);
      }
      ss += __shfl_xor(ss, 16); ss += __shfl_xor(ss, 32);
      bs += __shfl_xor(bs, 16); bs += __shfl_xor(bs, 32);
      const float inrm = 1.f / fmaxf(sqrtf(ss), 1e-12f);
#pragma unroll
      for (int nf = 0; nf < 4; ++nf) {
        const int c0 = 64 * wid + 16 * nf + 4 * fq, n0 = 16 * nf + 4 * fq;
        const float4 r4 = *reinterpret_cast<const float4*>(F + fr * FLD + c0);
        const float4 k4 = *reinterpret_cast<const float4*>(F + fr * FLD + 256 + c0);
        const float4 v4 = *reinterpret_cast<const float4*>(F + fr * FLD + 512 + c0);
        const float4 kkw = *reinterpret_cast<const float4*>(p.in[18] + (size_t)layer * 256 + c0);
        const float4 kaw = *reinterpret_cast<const float4*>(p.in[19] + (size_t)layer * 256 + c0);
        const float kk_[4] = {k4.x, k4.y, k4.z, k4.w}, kkw_[4] = {kkw.x, kkw.y, kkw.z, kkw.w}, kaw_[4] = {kaw.x, kaw.y, kaw.z, kaw.w};
        float* sc = p.SC + ((size_t)(tok * 4 + wid) * 9) * 64 + n0;
        float kn[4], kd0[4], kd1[4];
#pragma unroll
        for (int r = 0; r < 4; ++r) {
          kn[r] = kk_[r] * kkw_[r] * inrm;
          kd0[r] = kk_[r] * (1.f + (acc[2][nf][r] - 1.f) * kaw_[r]);
          kd1[r] = kk_[r] * (1.f + (acc[3][nf][r] - 1.f) * kaw_[r]);
        }
        *reinterpret_cast<float4*>(sc) = r4;
        *reinterpret_cast<float4*>(sc + 64) = make_float4(kn[0], kn[1], kn[2], kn[3]);
        *reinterpret_cast<float4*>(sc + 128) = v4;
        *reinterpret_cast<float4*>(sc + 192) = make_float4(acc[0][nf][0], acc[0][nf][1], acc[0][nf][2], acc[0][nf][3]);
        *reinterpret_cast<float4*>(sc + 256) = make_float4(acc[2][nf][0] * kn[0], acc[2][nf][1] * kn[1], acc[2][nf][2] * kn[2], acc[2][nf][3] * kn[3]);
        *reinterpret_cast<float4*>(sc + 320) = make_float4(kd0[0], kd0[1], kd0[2], kd0[3]);
        *reinterpret_cast<float4*>(sc + 384) = make_float4(acc[1][nf][0], acc[1][nf][1], acc[1][nf][2], acc[1][nf][3]);
        *reinterpret_cast<float4*>(sc + 448) = make_float4(acc[3][nf][0] * kn[0], acc[3][nf][1] * kn[1], acc[3][nf][2] * kn[2], acc[3][nf][3] * kn[3]);
        *reinterpret_cast<float4*>(sc + 512) = make_float4(kd1[0], kd1[1], kd1[2], kd1[3]);
        *reinterpret_cast<float4*>(p.G + (size_t)tok * 256 + c0) = make_float4(acc[4][nf][0], acc[4][nf][1], acc[4][nf][2], acc[4][nf][3]);
        *reinterpret_cast<float4*>(p.BV + (size_t)tok * 256 + c0) = make_float4(bs * v4.x, bs * v4.y, bs * v4.z, bs * v4.w);
        __builtin_amdgcn_sched_barrier(0);
      }
    }
#endif
#ifndef NO_D
    const int c = tid;
#pragma unroll
    for (int half = 0; half < 2; ++half) {
      float vv[8];
#pragma unroll
      for (int t8 = 0; t8 < 8; ++t8) {
        const int tt = half * 8 + t8, tok = tok0 + tt;
        const float* pr = p.PROJ + (size_t)tok * DIN + 1152 + c;
        const float q = pr[0], k = pr[256], v = pr[512];
        vv[t8] = v;
        if (isctx) {
          const size_t oi = ((size_t)(b * 4 + layer) * 256 + tpos0 + tt) * 256 + c;
          p.out_nak[oi] = k; p.out_nav[oi] = v;
          p.QNc[(size_t)tok * 256 + c] = f2bf(q * QSCALE);
          p.KNc[(size_t)(b * 4 + (c >> 6)) * 16384 + kf_off(tpos0 + tt, c & 63)] = f2bf(k);
        } else {
          p.QNl[(size_t)(tok - NCTX) * 256 + c] = f2bf(q * QSCALE);
          p.KNl[((size_t)((layer * 2 + b) * 4 + (c >> 6))) * 98304 + kf_off(512 + tpos0 + tt, c & 63)] = f2bf(k);
        }
      }
      if (isctx) pack44_store(p.VNtc + (size_t)(b * 4 + (c >> 6)) * 16384, tpos0 + half * 8, c & 63, vv);
      else pack44_store(p.VNtl + ((size_t)((layer * 2 + b) * 4 + (c >> 6))) * 98304, 512 + tpos0 + half * 8, c & 63, vv);
    }
    {
      const float qn = p.in[24][(size_t)layer * 64 + lane], kn = p.in[25][(size_t)layer * 64 + lane];
      const int fi = lane & 15;
#pragma unroll
      for (int half = 0; half < 2; ++half) {
        float vv[8];
#pragma unroll
        for (int t8 = 0; t8 < 8; ++t8) {
          const int tt = half * 8 + t8, tok = tok0 + tt, tpos = tpos0 + tt;
          const float* pr = p.PROJ + (size_t)tok * DIN + 1920;
          float cs = 1.f, sn = 0.f;
          if (!isctx) {
            const int pos = (lane < 32) ? (tpos >> 6) : (tpos & 63);
            const float2 t2 = *reinterpret_cast<const float2*>(p.rope + (size_t)(pos * 16 + fi) * 2);
            cs = t2.x; sn = t2.y;
            if ((lane & 16) == 0) sn = -sn;
          }
#pragma unroll
          for (int hh = 0; hh < 2; ++hh) {
            float q = pr[hh * 256 + c];
            const float ms = wave_sum(q * q) * (1.f / 64.f);
            q = q * rsqrtf(ms + 1e-6f) * qn;
            if (!isctx) { const float qp = __shfl_xor(q, 16); q = q * cs + qp * sn; }
            if (isctx) p.QGc[(size_t)tok * 512 + hh * 256 + c] = f2bf(q * QSCALE);
            else p.QGl[(size_t)(tok - NCTX) * 512 + hh * 256 + c] = f2bf(q * QSCALE);
          }
          if (wid < 2) {
            float k = pr[512 + c];
            const float ms = wave_sum(k * k) * (1.f / 64.f);
            k = k * rsqrtf(ms + 1e-6f) * kn;
            if (isctx) {
              p.out_gk[((size_t)(b * 4 + layer) * 256 + tpos) * 128 + c] = k;
              p.KGc[(size_t)(b * 2 + (c >> 6)) * 16384 + kf_off(tpos, c & 63)] = f2bf(k);
            } else {
              const float kp = __shfl_xor(k, 16); k = k * cs + kp * sn;
              p.KGl[((size_t)((layer * 2 + b) * 2 + (c >> 6))) * 98304 + kf_off(512 + tpos, c & 63)] = f2bf(k);
            }
          } else {
            const int cv = c - 128;
            const float v = pr[640 + cv];
            vv[t8] = v;
            if (isctx) p.out_gv[((size_t)(b * 4 + layer) * 256 + tpos) * 128 + cv] = v;
          }
        }
        if (wid >= 2) {
          const int cv = c - 128;
          if (isctx) pack44_store(p.VGtc + (size_t)(b * 2 + (cv >> 6)) * 16384, tpos0 + half * 8, cv & 63, vv);
          else pack44_store(p.VGtl + ((size_t)((layer * 2 + b) * 2 + (cv >> 6))) * 98304, 512 + tpos0 + half * 8, cv & 63, vv);
        }
      }
    }
#endif
    __syncthreads();
  }
}

#define ATT_LOAD(KF, VF, CI) { \
    const int ci_ = min((CI), nt - 1); \
    int kb_; \
    if (ci_ < nd) kb_ = ci_ * 32; \
    else { const int e_ = ci_ - nd; const int j_ = (ncc == 2) ? (e_ >> 1) : e_; const int cc_ = cc0 + ((ncc == 2) ? (e_ & 1) : 0); kb_ = 512 + (rb + j_) * 64 + cc_ * 32; } \
    const u16* kp_ = Kb + (size_t)(kb_ >> 4) * 1024 + lane * 8; \
    KF##00 = *reinterpret_cast<const bf16x8*>(kp_); \
    KF##01 = *reinterpret_cast<const bf16x8*>(kp_ + 512); \
    KF##10 = *reinterpret_cast<const bf16x8*>(kp_ + 1024); \
    KF##11 = *reinterpret_cast<const bf16x8*>(kp_ + 1536); \
    const u16* vp_ = Vt + (size_t)(kb_ >> 5) * 2048 + lane * 8; \
    VF##0 = *reinterpret_cast<const bf16x8*>(vp_); \
    VF##1 = *reinterpret_cast<const bf16x8*>(vp_ + 512); \
    VF##2 = *reinterpret_cast<const bf16x8*>(vp_ + 1024); \
    VF##3 = *reinterpret_cast<const bf16x8*>(vp_ + 1536); }

#define ATT_PV(DT, VV) { \
    o[DT][0] *= alpha; o[DT][1] *= alpha; o[DT][2] *= alpha; o[DT][3] *= alpha; \
    o[DT] = __builtin_amdgcn_mfma_f32_16x16x32_bf16(VV, pf.v, o[DT], 0, 0, 0); }

#define ATT_COMPUTE(KF, VF, CI) { \
    const int ci_ = (CI); \
    f32x4 s0 = (f32x4){0.f, 0.f, 0.f, 0.f}, s1 = (f32x4){0.f, 0.f, 0.f, 0.f}; \
    s0 = __builtin_amdgcn_mfma_f32_16x16x32_bf16(KF##00, qf0, s0, 0, 0, 0); \
    s0 = __builtin_amdgcn_mfma_f32_16x16x32_bf16(KF##01, qf1, s0, 0, 0, 0); \
    s1 = __builtin_amdgcn_mfma_f32_16x16x32_bf16(KF##10, qf0, s1, 0, 0, 0); \
    s1 = __builtin_amdgcn_mfma_f32_16x16x32_bf16(KF##11, qf1, s1, 0, 0, 0); \
    float sv[8] = {s0[0], s0[1], s0[2], s0[3], s1[0], s1[1], s1[2], s1[3]}; \
    bool ok[8]; \
    _Pragma("unroll") for (int e = 0; e < 8; ++e) ok[e] = true; \
    if (ci_ >= nd) { \
      const int e_ = ci_ - nd; const int j_ = (ncc == 2) ? (e_ >> 1) : e_; const int cc_ = cc0 + ((ncc == 2) ? (e_ & 1) : 0); \
      const int dr_ = rb + j_ - grow + 7; \
      const int cq = cq0 + fr, c0 = min(max(cq - 8, 0), 48); \
      _Pragma("unroll") for (int e = 0; e < 8; ++e) { \
        const int ck = cc_ * 32 + 16 * (e >> 2) + 4 * fq + (e & 3); \
        ok[e] = (ck >= c0) && (ck < c0 + 16); \
        const int dc = min(max(ck - cq, -15), 15) + 15; \
        const float bias = rpb[dr_ * 31 + dc] * LOG2E; \
        sv[e] = ok[e] ? sv[e] + bias : -1e30f; \
      } \
    } \
    float mx = fmaxf(fmaxf(fmaxf(sv[0], sv[1]), fmaxf(sv[2], sv[3])), fmaxf(fmaxf(sv[4], sv[5]), fmaxf(sv[6], sv[7]))); \
    mx = fmaxf(mx, __shfl_xor(mx, 16)); \
    mx = fmaxf(mx, __shfl_xor(mx, 32)); \
    const float mn = fmaxf(m, mx); \
    const float alpha = exp2f(m - mn); \
    m = mn; \
    float ps = 0.f; \
    _Pragma("unroll") for (int e = 0; e < 8; ++e) { sv[e] = ok[e] ? exp2f(sv[e] - mn) : 0.f; ps += sv[e]; } \
    l = l * alpha + ps; \
    union { bf16x8 v; unsigned u[4]; } pf; \
    pf.u[0] = pack2(sv[0], sv[1]); pf.u[1] = pack2(sv[2], sv[3]); pf.u[2] = pack2(sv[4], sv[5]); pf.u[3] = pack2(sv[6], sv[7]); \
    ATT_PV(0, VF##0) ATT_PV(1, VF##1) ATT_PV(2, VF##2) ATT_PV(3, VF##3) }

__device__ __forceinline__ void attn_wave(const u16* __restrict__ Q, int ldq, const u16* __restrict__ Kb, int ldk,
                                          const u16* __restrict__ Vt, int ldv, int ndense, const bool NA,
                                          const float* __restrict__ rpb, int grow, int cq0,
                                          u16* __restrict__ out, int ldo, int tidx) {
  const int lane = tidx & 63, fr = lane & 15, fq = lane >> 4;
  const bf16x8 qf0 = *reinterpret_cast<const bf16x8*>(Q + (size_t)fr * ldq + fq * 8);
  const bf16x8 qf1 = *reinterpret_cast<const bf16x8*>(Q + (size_t)fr * ldq + 32 + fq * 8);
  f32x4 o[4];
#pragma unroll
  for (int dt = 0; dt < 4; ++dt) o[dt] = (f32x4){0.f, 0.f, 0.f, 0.f};
  float m = -1e30f, l = 0.f;
  const int nd = ndense >> 5;
  const int rb = min(max(grow - 4, 0), 8);
  const int ulo = min(max(cq0 - 8, 0), 48), uhi = min(max(cq0 + 15 - 8, 0), 48) + 16;
  const bool c0ok = ulo < 32, c1ok = uhi > 32;
  const int ncc = (c0ok && c1ok) ? 2 : 1, cc0 = c0ok ? 0 : 1;
  const int nt = nd + (NA ? 8 * ncc : 0);
  bf16x8 ka00, ka01, ka10, ka11, kb00, kb01, kb10, kb11;
  bf16x8 va0, va1, va2, va3, vb0, vb1, vb2, vb3;
  ATT_LOAD(ka, va, 0)
  for (int ci = 0; ci < nt; ci += 2) {
    ATT_LOAD(kb, vb, ci + 1)
    ATT_COMPUTE(ka, va, ci)
    if (ci + 1 < nt) {
      ATT_LOAD(ka, va, ci + 2)
      ATT_COMPUTE(kb, vb, ci + 1)
    }
  }
  l += __shfl_xor(l, 16);
  l += __shfl_xor(l, 32);
  const float il = 1.f / l;
#pragma unroll
  for (int dt = 0; dt < 4; ++dt) {
    uint2 pk; pk.x = pack2(o[dt][0] * il, o[dt][1] * il); pk.y = pack2(o[dt][2] * il, o[dt][3] * il);
    *reinterpret_cast<uint2*>(out + (size_t)fr * ldo + 16 * dt + 4 * fq) = pk;
  }
}

__device__ void scan_item(const Params& p, int layer, char* smem, bool lat, int b, int h, int dir, int qd, int tidx) {
  const int tid = tidx, lane = tid & 63, wid = tid >> 6, rr = lane >> 4, j = lane & 15;
  const int L = lat ? 1024 : 256, seqbase = lat ? NCTX + b * 1024 : b * 256;
  const int rowl = wid * 4 + rr, row = qd * 16 + rowl;
  float* cbuf = reinterpret_cast<float*>(smem);
  float* obuf = cbuf + 2 * 16 * 6 * 64;
  float4 S = make_float4(0.f, 0.f, 0.f, 0.f);
  if (lat) S = *reinterpret_cast<const float4*>(p.in[2] + ((((size_t)(b * 4 + layer) * 2 + dir) * 4 + h) * 64 + row) * 64 + 4 * j);
  const int nch = L / 16;
  float* odst = dir == 0 ? p.OF : p.OB;
  float4 pre0, pre1, pre2, pre3, pre4, pre5;
#define SC_GL1(PR, I, CH) { const int idx = tid + 256 * (I), tt_ = idx / 96, rem = idx % 96, vec = rem >> 4, f4 = rem & 15; \
    const int st_ = (CH) * 16 + tt_, t_ = dir == 0 ? st_ : L - 1 - st_; const int svec = vec < 3 ? vec : vec + 3 * dir; \
    PR = *reinterpret_cast<const float4*>(p.SC + ((size_t)((seqbase + t_) * 4 + h) * 9 + svec) * 64 + f4 * 4); }
#define gload(CH) { SC_GL1(pre0, 0, CH) SC_GL1(pre1, 1, CH) SC_GL1(pre2, 2, CH) SC_GL1(pre3, 3, CH) SC_GL1(pre4, 4, CH) SC_GL1(pre5, 5, CH) }
#define SC_LS1(PR, I, BUF) *reinterpret_cast<float4*>(cbuf + (BUF) * 6144 + (tid + 256 * (I)) * 4) = PR;
#define lstore(BUF) { SC_LS1(pre0, 0, BUF) SC_LS1(pre1, 1, BUF) SC_LS1(pre2, 2, BUF) SC_LS1(pre3, 3, BUF) SC_LS1(pre4, 4, BUF) SC_LS1(pre5, 5, BUF) }
  gload(0); lstore(0);
  __syncthreads();
#define SC_LD(R4, K4, VV, W4, A4, D4, TT) { const float* base_ = cb + (TT) * 384; \
    R4 = *reinterpret_cast<const float4*>(base_ + 4 * j); K4 = *reinterpret_cast<const float4*>(base_ + 64 + 4 * j); \
    VV = base_[128 + row]; W4 = *reinterpret_cast<const float4*>(base_ + 192 + 4 * j); \
    A4 = *reinterpret_cast<const float4*>(base_ + 256 + 4 * j); D4 = *reinterpret_cast<const float4*>(base_ + 320 + 4 * j); }
  for (int ch = 0; ch < nch; ++ch) {
#if REPMASK
    if (ch + 1 < nch && p.pad != 5) gload(ch + 1);
#else
    if (ch + 1 < nch) gload(ch + 1);
#endif
    const float* cb = cbuf + (ch & 1) * 6144;
    float osel = 0.f;
    float4 r4, kk4, w4, ak4, kd4; float vv;
    SC_LD(r4, kk4, vv, w4, ak4, kd4, 0)
    float ovp = 0.f;
#pragma unroll 4
    for (int tt = 0; tt < 16; ++tt) {
      float4 r4n, kk4n, w4n, ak4n, kd4n; float vvn;
      SC_LD(r4n, kk4n, vvn, w4n, ak4n, kd4n, tt + 1)
      float sk = (S.x * kk4.x + S.y * kk4.y) + (S.z * kk4.z + S.w * kk4.w);
      sk += dpp_mov<0xB1>(sk);  ovp += dpp_mov<0xB1>(ovp);
      sk += dpp_mov<0x4E>(sk);  ovp += dpp_mov<0x4E>(ovp);
      sk += dpp_mov<0x141>(sk); ovp += dpp_mov<0x141>(ovp);
      sk += dpp_mov<0x140>(sk); ovp += dpp_mov<0x140>(ovp);
      osel = (j == tt - 1) ? ovp : osel;
      const float tx = vv * kd4.x - sk * ak4.x, ty = vv * kd4.y - sk * ak4.y, tz = vv * kd4.z - sk * ak4.z, tw = vv * kd4.w - sk * ak4.w;
      S.x = S.x * w4.x + tx; S.y = S.y * w4.y + ty; S.z = S.z * w4.z + tz; S.w = S.w * w4.w + tw;
      ovp = (S.x * r4.x + S.y * r4.y) + (S.z * r4.z + S.w * r4.w);
      r4 = r4n; kk4 = kk4n; w4 = w4n; ak4 = ak4n; kd4 = kd4n; vv = vvn;
    }
    ovp = reduce16(ovp);
    osel = (j == 15) ? ovp : osel;
    {
      const int st = ch * 16 + j, t = dir == 0 ? st : L - 1 - st;
      odst[(size_t)(seqbase + t) * 256 + h * 64 + row] = osel;
    }
#if REPMASK
    if (ch + 1 < nch && p.pad != 5) lstore((ch + 1) & 1);
#else
    if (ch + 1 < nch) lstore((ch + 1) & 1);
#endif
    asm volatile("s_waitcnt lgkmcnt(0)" ::: "memory");
    __builtin_amdgcn_s_barrier();
  }
  if (!lat) *reinterpret_cast<float4*>(p.out_st + ((((size_t)(b * 4 + layer) * 2 + dir) * 4 + h) * 64 + row) * 64 + 4 * j) = S;
  __syncthreads();
}

__device__ void mixer_phase(const Params& p, int layer, char* smem, int tidx0) {
  int* slot = reinterpret_cast<int*>(smem + 60 * 1024);
  for (;;) {
    int tidx = tidx0;
    asm volatile("" : "+v"(tidx));
    const int tid = tidx, wid = tid >> 6;
    __syncthreads();
    if (tid == 0) *slot = (int)atomicAdd(&p.wq[layer], 1u);
    __syncthreads();
    int it = *slot;
    if (it >= 1728) break;
    const bool is_scan = (it < 64) || (it >= 448 && it < 960);
#if REPMASK
    if ((p.pad == 1 && !is_scan) || (p.pad == 2 && is_scan) || ((p.pad == 3 || p.pad == 5 || p.pad == 6) && !(it < 64)) || (p.pad == 4 && !(it >= 64 && it < 320))) continue;
#endif
    if (is_scan) {
      const bool lat = it < 64;
      const int si = lat ? it : it - 448;
#ifndef NO_SCAN
      scan_item(p, layer, smem, lat, si / 32, (si / 8) % 4, (si / 4) % 2, si % 4, tidx);
#endif
      continue;
    }
    const u16 *Q, *Kb, *Vt; u16* out; int ldq, ldk, ldv, ndense, grow = 0, cq0 = 0; bool na = false;
    const float* rpb = p.in[23];
    if (it < 320) {
      it -= 64;
      const int b = it / 128, qh = (it / 16) % 8, qt = it % 16, kvh = qh >> 2;
      const int q0 = b * 1024 + qt * 64 + wid * 16;
      Q = p.QGl + (size_t)q0 * 512 + qh * 64; ldq = 512;
      Kb = p.KGl + (size_t)((layer * 2 + b) * 2 + kvh) * 98304; ldk = 0;
      Vt = p.VGtl + (size_t)((layer * 2 + b) * 2 + kvh) * 98304; ldv = 0; ndense = 1536;
      out = p.MIX + (size_t)(NCTX + q0) * DM + 512 + qh * 64;
    } else if (it < 448) {
      it -= 320;
      const int b = it / 64, h = (it / 16) % 4, r = it % 16;
      const int q0 = b * 1024 + r * 64 + wid * 16;
      Q = p.QNl + (size_t)q0 * 256 + h * 64; ldq = 256;
      Kb = p.KNl + (size_t)((layer * 2 + b) * 4 + h) * 98304; ldk = 0;
      Vt = p.VNtl + (size_t)((layer * 2 + b) * 4 + h) * 98304; ldv = 0; ndense = 512;
      rpb = p.in[23] + (size_t)(layer * 4 + h) * 15 * 31; grow = r; cq0 = wid * 16; na = true;
      out = p.MIX + (size_t)(NCTX + q0) * DM + 256 + h * 64;
    } else if (it < 1472) {
      it -= 960;
      const int b = it / 32, qh = (it / 4) % 8, qt = it % 4, kvh = qh >> 2;
      const int q0 = b * 256 + qt * 64 + wid * 16;
      Q = p.QGc + (size_t)q0 * 512 + qh * 64; ldq = 512;
      Kb = p.KGc + (size_t)(b * 2 + kvh) * 16384; ldk = 0;
      Vt = p.VGtc + (size_t)(b * 2 + kvh) * 16384; ldv = 0; ndense = 256;
      out = p.MIX + (size_t)q0 * DM + 512 + qh * 64;
    } else {
      it -= 1472;
      const int b = it / 16, h = (it / 4) % 4, qt = it % 4;
      const int q0 = b * 256 + qt * 64 + wid * 16;
      Q = p.QNc + (size_t)q0 * 256 + h * 64; ldq = 256;
      Kb = p.KNc + (size_t)(b * 4 + h) * 16384; ldk = 0;
      Vt = p.VNtc + (size_t)(b * 4 + h) * 16384; ldv = 0; ndense = 256;
      out = p.MIX + (size_t)q0 * DM + 256 + h * 64;
    }
#ifndef NO_ATT
    attn_wave(Q, ldq, Kb, ldk, Vt, ldv, ndense, na, rpb, grow, cq0, out, DM, tidx);
#endif
  }
}

__device__ void rwkv_fin_phase(const Params& p, int layer, int bid, int nblk, int tidx) {
  const int tid = tidx;
  const float lw = p.in[21][(size_t)layer * 256 + tid], lb = p.in[22][(size_t)layer * 256 + tid];
  for (int tok = bid; tok < NTOK; tok += nblk) {
    const size_t i = (size_t)tok * 256 + tid;
    const float o = p.OF[i] + p.OB[i];
    const float mu = wave_sum(o) * (1.f / 64.f);
    const float d = o - mu;
    const float var = wave_sum(d * d) * (1.f / 64.f);
    const float y = (d * rsqrtf(var + 64e-5f) * lw + lb + p.BV[i]) * p.G[i];
    p.MIX[(size_t)tok * DM + tid] = f2bf(y);
  }
}

#ifndef ONLY_PH
#define ONLY_PH -1
#endif
#define PH_EN(x) (ONLY_PH < 0 || ONLY_PH == (x))
__device__ __forceinline__ void run_phase(const Params& p, int ph, char* smem, int bid, int nblk, int tidx) {
  if (ph == 0) { if (PH_EN(0)) setup_phase(p, smem, bid, nblk, tidx); return; }
  if (ph == 1) { if (PH_EN(1)) modreduce_phase(p, bid, nblk, tidx); return; }
  if (ph == 2) { if (PH_EN(2)) ln_phase<0>(p, 0, bid, nblk, tidx); return; }
  const int layer = (ph - 3) / 9, s = (ph - 3) % 9;
  switch (s) {
    case 0: if (PH_EN(3)) gemm_phase<EPI_PROJ, 256, 3>(p, layer, p.A, p.winT + (size_t)layer * DIN * DM, DIN, DM, smem, bid, nblk, tidx); break;
    case 1: if (PH_EN(4)) prep_phase(p, layer, smem, bid, nblk, tidx); break;
    case 2: if (PH_EN(5)) mixer_phase(p, layer, smem, tidx); break;
    case 3: if (PH_EN(6)) rwkv_fin_phase(p, layer, bid, nblk, tidx); break;
    case 4: if (PH_EN(7)) gemm_phase<EPI_OUT, 96, 4>(p, layer, p.MIX, p.woutT + (size_t)layer * DM * DM, DM, DM, smem, bid, nblk, tidx); break;
    case 5: if (PH_EN(8)) ln_phase<1>(p, layer, bid, nblk, tidx); break;
    case 6: if (PH_EN(9)) gemm_phase<EPI_FFI, 192, 3>(p, layer, p.A, p.wfiT + (size_t)layer * 2 * DFF * DM, 2 * DFF, DM, smem, bid, nblk, tidx); break;
    case 7: if (PH_EN(10)) gemm_phase<EPI_FFO, 96, 4>(p, layer, p.ACT, p.wfoT + (size_t)layer * DM * DFF, DM, DFF, smem, bid, nblk, tidx); break;
    default: if (PH_EN(11)) ln_phase<2>(p, layer, bid, nblk, tidx); break;
  }
}

__global__ void __launch_bounds__(256, 2) fwd_kernel(Params p, int ph0, int ph1, int usebar) {
  __shared__ __attribute__((aligned(16))) char smem[73728 + 16];
  const int bid = blockIdx.x, nblk = gridDim.x;
  XcdBarrier xb;
  if (usebar && p.never) cg::this_grid().sync();
  if (usebar) {
    if (threadIdx.x == 0) *reinterpret_cast<uint4*>(smem + 73728) = make_uint4(0u, 0u, 0u, 0u);
    __syncthreads();
    xb = xcd_barrier_post(p.bar, (volatile LAS unsigned*)(smem + 73728));
  }
  for (int ph = ph0; ph < ph1; ++ph) {
    int tidx = threadIdx.x;
    asm volatile("" : "+v"(tidx));
    run_phase(p, ph, smem, bid, nblk, tidx);
#if REPMASK
    {
      const int slot_ = ph < 3 ? 9 + ph : (ph - 3) % 9;
      if ((REPMASK >> slot_) & 1) {
        if (usebar) xcd_barrier(xb);
        Params p2 = p; p2.wq = p.wq + 4; p2.pad = REPVAR;
        if (REPVAR >= 5) { p2.OF = p.PROJ; p2.OB = p.PROJ; p2.out_st = p.PROJ + 4000000; p2.MIX = (u16*)(p.PROJ + 8000000); }
        run_phase(p2, ph, smem, bid, nblk, tidx);
      }
    }
#endif
    if (usebar && ph + 1 < ph1) xcd_barrier(xb);
  }
}

static inline size_t al256(size_t x) { return (x + 255) & ~(size_t)255; }

extern "C" void kernel_launch(void* const* d_in, const int* in_sizes, int n_in, void* d_out, int out_size, void* d_ws, size_t ws_size,
                              hipStream_t stream) {
  Params p;
  memset(&p, 0, sizeof(p));
  for (int i = 0; i < 33; ++i) p.in[i] = (const float*)d_in[i];
  float* o = (float*)d_out;
  p.out_yp = o; o += 4194304;
  p.out_ys = o; o += 2097152;
  p.out_st = o; o += 2097152;
  p.out_nak = o; o += 4194304;
  p.out_nav = o; o += 4194304;
  p.out_gk = o; o += 2097152;
  p.out_gv = o;
  char* w = (char*)d_ws; size_t off = 0;
  auto take = [&](size_t bytes) { char* r = w + off; off += al256(bytes); return r; };
  p.bar = (unsigned*)take(16384);
  p.wq = p.bar + 3584;
  p.modp = (float*)take((size_t)4 * 32 * 3 * 6144 * 4);
  p.mod = (float*)take((size_t)4 * 3 * 6144 * 4);
  p.winT = (u16*)take((size_t)4 * DIN * DM * 2);
  p.woutT = (u16*)take((size_t)4 * DM * DM * 2);
  p.wfiT = (u16*)take((size_t)4 * 2 * DFF * DM * 2);
  p.wfoT = (u16*)take((size_t)4 * DM * DFF * 2);
  p.X = (float*)take((size_t)NTOK * DM * 4);
  p.PROJ = (float*)take((size_t)NTOK * DIN * 4);
  p.X1 = p.PROJ;
  p.Y = p.PROJ + (size_t)NTOK * DM;
  p.SC = (float*)take((size_t)NTOK * 4 * 9 * 64 * 4);
  p.ACT = (u16*)p.SC;
  p.G = (float*)take((size_t)NTOK * 256 * 4);
  p.BV = (float*)take((size_t)NTOK * 256 * 4);
  p.OF = (float*)take((size_t)NTOK * 256 * 4);
  p.OB = (float*)take((size_t)NTOK * 256 * 4);
  p.A = (u16*)take((size_t)NTOK * DM * 2);
  p.MIX = (u16*)take((size_t)NTOK * DM * 2);
  p.QNc = (u16*)take((size_t)NCTX * 256 * 2);
  p.KNc = (u16*)take((size_t)NCTX * 256 * 2);
  p.VNtc = (u16*)take((size_t)NCTX * 256 * 2);
  p.QGc = (u16*)take((size_t)NCTX * 512 * 2);
  p.KGc = (u16*)take((size_t)NCTX * 128 * 2);
  p.VGtc = (u16*)take((size_t)NCTX * 128 * 2);
  p.QNl = (u16*)take((size_t)2048 * 256 * 2);
  p.KNl = (u16*)take((size_t)4 * 2 * 1536 * 256 * 2);
  p.VNtl = (u16*)take((size_t)4 * 2 * 1536 * 256 * 2);
  p.QGl = (u16*)take((size_t)2048 * 512 * 2);
  p.KGl = (u16*)take((size_t)4 * 2 * 1536 * 128 * 2);
  p.VGtl = (u16*)take((size_t)4 * 2 * 1536 * 128 * 2);
  p.loraT = (u16*)take((size_t)4 * 98304 * 2);
  p.rope = (float*)take((size_t)64 * 16 * 2 * 4);
  if (off > ws_size) { fprintf(stderr, "workspace too small: need %zu have %zu\n", off, ws_size); return; }

  (void)hipMemsetAsync(p.bar, 0, 16384, stream);
#if MEGA
  static int grid_blocks = 0;
  if (!grid_blocks) {
    int dev = 0, cus = 0, per_cu = 0;
    hipGetDevice(&dev);
    hipDeviceGetAttribute(&cus, hipDeviceAttributeMultiprocessorCount, dev);
    hipOccupancyMaxActiveBlocksPerMultiprocessor(&per_cu, fwd_kernel, 256, 0);
    if (per_cu > 2) per_cu = 2;
    if (per_cu < 1) per_cu = 1;
    grid_blocks = cus * per_cu;
  }
  int ph0 = 0, ph1 = NPH, ub = 1;
  void* args[] = {&p, &ph0, &ph1, &ub};
  hipError_t e = hipLaunchCooperativeKernel((void*)fwd_kernel, dim3(grid_blocks), dim3(256), args, 0, stream);
  if (e != hipSuccess) fprintf(stderr, "cooperative launch failed: %s (grid %d)\n", hipGetErrorString(e), grid_blocks);
#else
  for (int ph = 0; ph < NPH; ++ph) fwd_kernel<<<512, 256, 0, stream>>>(p, ph, ph + 1, 0);
#endif
}
```

```cpp
#include <hip/hip_runtime.h>
#include <hip/hip_cooperative_groups.h>
#include <cstdio>
#include <cstdint>
#include <cstring>
namespace cg = cooperative_groups;

#ifndef REPMASK
#define REPMASK 0
#endif
#ifndef REPVAR
#define REPVAR 0
#endif
#ifndef MEGA
#define MEGA 1
#endif

typedef unsigned short u16;
using bf16x8 = __attribute__((ext_vector_type(8))) short;
using f32x4 = __attribute__((ext_vector_type(4))) float;

#define NTOK 6144
#define NCTX 4096
#define DM 1024
#define DIN 2688
#define DFF 2816
#define NPH 39
#define ALPHA 1.681792830507429f
#define LOG2E 1.4426950408889634f
#define QSCALE (0.125f * LOG2E)

struct Params {
  const float* in[33];
  float *out_yp, *out_ys, *out_st, *out_nak, *out_nav, *out_gk, *out_gv;
  unsigned *bar, *wq;
  float *modp, *mod;
  u16 *winT, *woutT, *wfiT, *wfoT;
  float *X, *X1, *Y, *PROJ, *SC, *G, *BV, *OF, *OB;
  u16 *A, *MIX, *ACT;
  u16 *QNc, *KNc, *VNtc, *QGc, *KGc, *VGtc;
  u16 *QNl, *KNl, *VNtl, *QGl, *KGl, *VGtl;
  u16* loraT; float* rope;
  int never; int pad;
};

__device__ __forceinline__ u16 f2bf(float f) {
  unsigned u = __float_as_uint(f);
  u += 0x7FFFu + ((u >> 16) & 1u);
  return (u16)(u >> 16);
}
__device__ __forceinline__ unsigned pack2(float a, float b) { return (unsigned)f2bf(a) | ((unsigned)f2bf(b) << 16); }
template <int CTRL> __device__ __forceinline__ float dpp_mov(float v) {
  return __int_as_float(__builtin_amdgcn_update_dpp(0, __float_as_int(v), CTRL, 0xF, 0xF, false));
}
__device__ __forceinline__ float reduce16(float v) {
  v += dpp_mov<0xB1>(v);
  v += dpp_mov<0x4E>(v);
  v += dpp_mov<0x141>(v);
  v += dpp_mov<0x140>(v);
  return v;
}
__device__ __forceinline__ float wave_sum(float v) {
  v = reduce16(v);
  v += __shfl_xor(v, 16);
  v += __shfl_xor(v, 32);
  return v;
}
__device__ __forceinline__ float sigmoidf_(float x) { return 1.f / (1.f + __expf(-x)); }
__device__ __forceinline__ float siluf_(float x) { return x / (1.f + __expf(-x)); }
__device__ __forceinline__ int modrow_of(int tok) { return tok < NCTX ? 0 : 1 + ((tok - NCTX) >> 10); }

#define XB_TMO      128
#define XB_XCNT(j)  (256  + 64 * (j))
#define XB_XSUB(j)  (1280 + 64 * (j))
#define XB_XGEN(j)  (2304 + 64 * (j))
#define XB_TOP      3328
#define XB_TOPGEN   3392
#define XCD_BAR_WORDS 3456
#define XB_SPIN_CAP (1u << 22)
#define LAS __attribute__((address_space(3)))
__device__ __forceinline__ unsigned xb_ld(unsigned* p) { return __hip_atomic_load(p, __ATOMIC_RELAXED, __HIP_MEMORY_SCOPE_AGENT); }
__device__ __forceinline__ unsigned xb_add(unsigned* p, unsigned v) { return __hip_atomic_fetch_add(p, v, __ATOMIC_RELAXED, __HIP_MEMORY_SCOPE_AGENT); }
__device__ __forceinline__ unsigned xb_xcc_id() { return (unsigned)__builtin_amdgcn_s_getreg((3 << 11) | 20) & 0xFu; }
#define XB_SPIN(cond, bar) do { unsigned _sp = 0; while (cond) { __builtin_amdgcn_s_sleep(1); \
    if ((++_sp & 255u) == 0u) { if (xb_ld(&(bar)[XB_TMO])) break; if (_sp > XB_SPIN_CAP) { atomicAdd(&(bar)[XB_TMO], 1u); break; } } } } while (0)
struct XcdBarrier { unsigned* bar; unsigned x; volatile LAS unsigned* st; };
__device__ __forceinline__ XcdBarrier xcd_barrier_post(unsigned* bar, volatile LAS unsigned* st) {
  XcdBarrier b; b.bar = bar; b.x = xb_xcc_id(); b.st = st;
  if (threadIdx.x == 0) (void)xb_add(&bar[XB_XCNT(b.x)], 1u);
  return b;
}
__device__ __forceinline__ void xcd_barrier_complete(unsigned* bar, unsigned x, unsigned& nloc, unsigned& nx) {
  const unsigned G = gridDim.x * gridDim.y * gridDim.z;
  unsigned sum, cnt, mine, sp = 0u;
  for (;;) {
    sum = 0u; cnt = 0u; mine = 0u;
#pragma unroll
    for (unsigned j = 0; j < 16; ++j) { const unsigned c = xb_ld(&bar[XB_XCNT(j)]); sum += c; cnt += (c > 0u) ? 1u : 0u; mine = (j == x) ? c : mine; }
    if (sum == G) break;
    __builtin_amdgcn_s_sleep(1);
    if ((++sp & 255u) == 0u) { if (xb_ld(&bar[XB_TMO])) break; if (sp > XB_SPIN_CAP) { atomicAdd(&bar[XB_TMO], 1u); break; } }
  }
  nloc = mine > 0u ? mine : 1u; nx = cnt > 0u ? cnt : 1u;
}
__device__ __forceinline__ void xcd_barrier(const XcdBarrier& b) {
  asm volatile("s_waitcnt vmcnt(0)" ::: "memory");
  __syncthreads();
  if (threadIdx.x == 0) {
    unsigned* bar = b.bar;
    asm volatile("" : "+s"(bar));
    __builtin_amdgcn_s_waitcnt(0);
    unsigned nloc = b.st[0], nx = b.st[1];
    if (nloc == 0u) { xcd_barrier_complete(bar, b.x, nloc, nx); b.st[0] = nloc; b.st[1] = nx; }
    const unsigned old = xb_add(&bar[XB_XSUB(b.x)], 1u);
    const unsigned gen = old / nloc;
    if (old + 1u == (gen + 1u) * nloc) {
      __builtin_amdgcn_fence(__ATOMIC_RELEASE, "agent");
      asm volatile("s_waitcnt vmcnt(0)" ::: "memory");
      const unsigned og = xb_add(&bar[XB_TOP], 1u);
      const unsigned tg = og / nx;
      if (og + 1u == (tg + 1u) * nx) xb_add(&bar[XB_TOPGEN], 1u);
      else XB_SPIN(xb_ld(&bar[XB_TOPGEN]) == tg, bar);
      __builtin_amdgcn_fence(__ATOMIC_ACQUIRE, "agent");
      xb_add(&bar[XB_XGEN(b.x)], 1u);
      asm volatile("s_waitcnt vmcnt(0)" ::: "memory");
    } else {
      XB_SPIN(xb_ld(&bar[XB_XGEN(b.x)]) == gen, bar);
      __builtin_amdgcn_fence(__ATOMIC_ACQUIRE, "agent");
      asm volatile("s_waitcnt vmcnt(0)" ::: "memory");
    }
  }
  __syncthreads();
}

__device__ __forceinline__ int lds_byte32(int r, int c) {
  const int ob = (r & 15) * 64 + c * 2;
  return (r >> 4) * 1024 + (ob ^ (((ob >> 9) & 1) << 5));
}
__device__ __forceinline__ void stage_rc32(int b, int& R, int& C) {
  const int sb = b & 1023, swz = sb ^ (((sb >> 9) & 1) << 5);
  R = (b >> 10) * 16 + (swz >> 6); C = (swz & 63) >> 1;
}
template <int ROWS>
__device__ __forceinline__ void stage_tile32(const u16* __restrict__ g, int ld, char* lds, int tidx) {
#pragma unroll
  for (int i = 0; i < (ROWS * 64 + 4095) / 4096; ++i) {
    const int b = tidx * 16 + i * 4096;
    if ((i + 1) * 4096 <= ROWS * 64 || tidx < (ROWS * 64 - i * 4096) / 16) {
      int R, C; stage_rc32(b, R, C);
      __builtin_amdgcn_global_load_lds((const unsigned*)(g + (size_t)R * ld + C), (unsigned LAS*)(lds + b), 16, 0, 0);
    }
  }
}
template <int N> __device__ __forceinline__ void wait_vmcnt() {
  if (N == 0) asm volatile("s_waitcnt vmcnt(0)" ::: "memory");
  else if (N == 3) asm volatile("s_waitcnt vmcnt(3)" ::: "memory");
  else if (N == 4) asm volatile("s_waitcnt vmcnt(4)" ::: "memory");
  else if (N == 5) asm volatile("s_waitcnt vmcnt(5)" ::: "memory");
  else if (N == 6) asm volatile("s_waitcnt vmcnt(6)" ::: "memory");
  else if (N == 8) asm volatile("s_waitcnt vmcnt(8)" ::: "memory");
  else if (N == 9) asm volatile("s_waitcnt vmcnt(9)" ::: "memory");
  else if (N == 10) asm volatile("s_waitcnt vmcnt(10)" ::: "memory");
  else if (N == 12) asm volatile("s_waitcnt vmcnt(12)" ::: "memory");
  else asm volatile("s_waitcnt vmcnt(0)" ::: "memory");
}

enum { EPI_PROJ = 0, EPI_OUT = 1, EPI_FFI = 2, EPI_FFO = 3 };

template <int EPI, int BM, int NST>
__device__ __forceinline__ void gemm_phase(const Params& p, int layer, const u16* __restrict__ A, const u16* __restrict__ Bt,
                                           int N, int K, char* smem, int bid, int nblk, int tidx) {
  constexpr int MF = BM / 32;
  const int tid = tidx, lane = tid & 63, wid = tid >> 6, wr = wid >> 1, wc = wid & 1, fr = lane & 15, fq = lane >> 4;
  const int nM = NTOK / BM, nN = N / 128, ntiles = nM * nN, nk = K / 32;
  constexpr int SB = (BM + 128) * 64;
  constexpr int LA = (BM * 64) / 4096;
  const bool extraA = (BM == 96) && (wid < 2);
  for (int tile = bid; tile < ntiles; tile += nblk) {
    const int pm = tile % nM, pn = tile / nM, m0 = pm * BM, n0 = pn * 128;
    f32x4 acc[MF][4];
#pragma unroll
    for (int m = 0; m < MF; ++m)
#pragma unroll
      for (int n = 0; n < 4; ++n) acc[m][n] = (f32x4){0.f, 0.f, 0.f, 0.f};
    const u16* Ag = A + (size_t)m0 * K;
    const u16* Bg = Bt + (size_t)n0 * K;
#pragma unroll
    for (int s_ = 0; s_ < NST - 1; ++s_) {
      stage_tile32<BM>(Ag + s_ * 32, K, smem + s_ * SB, tidx);
      stage_tile32<128>(Bg + s_ * 32, K, smem + s_ * SB + BM * 64, tidx);
    }
    int slot = 0, pslot = NST - 1;
    for (int kt = 0; kt < nk; ++kt) {
      if (kt + NST - 2 < nk) {
        if (BM == 96) { if (extraA) wait_vmcnt<(NST - 2) * 4>(); else wait_vmcnt<(NST - 2) * 3>(); }
        else wait_vmcnt<(NST - 2) * (LA + 2)>();
      } else {
        asm volatile("s_waitcnt vmcnt(0)" ::: "memory");
      }
      __builtin_amdgcn_s_barrier();
      if (kt + NST - 1 < nk) {
        char* nb = smem + pslot * SB;
        stage_tile32<BM>(Ag + (kt + NST - 1) * 32, K, nb, tidx);
        stage_tile32<128>(Bg + (kt + NST - 1) * 32, K, nb + BM * 64, tidx);
      }
      const char* sa = smem + slot * SB;
      const char* sb = sa + BM * 64;
      slot = (slot + 1 == NST) ? 0 : slot + 1;
      pslot = (pslot + 1 == NST) ? 0 : pslot + 1;
      bf16x8 af[MF], bfr[4];
#pragma unroll
      for (int m = 0; m < MF; ++m) af[m] = *reinterpret_cast<const bf16x8*>(sa + lds_byte32(wr * (BM / 2) + m * 16 + fr, fq * 8));
#pragma unroll
      for (int n = 0; n < 4; ++n) bfr[n] = *reinterpret_cast<const bf16x8*>(sb + lds_byte32(wc * 64 + n * 16 + fr, fq * 8));
#pragma unroll
      for (int m = 0; m < MF; ++m)
#pragma unroll
        for (int n = 0; n < 4; ++n) acc[m][n] = __builtin_amdgcn_mfma_f32_16x16x32_bf16(bfr[n], af[m], acc[m][n], 0, 0, 0);
    }
#pragma unroll
    for (int m = 0; m < MF; ++m) {
      const int row = m0 + wr * (BM / 2) + m * 16 + fr;
      if (EPI == EPI_PROJ) {
#pragma unroll
        for (int n = 0; n < 4; ++n) {
          const int col = n0 + wc * 64 + n * 16 + 4 * fq;
          *reinterpret_cast<float4*>(p.PROJ + (size_t)row * DIN + col) = make_float4(acc[m][n][0], acc[m][n][1], acc[m][n][2], acc[m][n][3]);
        }
      } else if (EPI == EPI_OUT || EPI == EPI_FFO) {
        const float* res = (EPI == EPI_OUT) ? p.X : p.X1;
        const float* gate = p.mod + ((size_t)(layer * 3 + modrow_of(row)) * 6 + (EPI == EPI_OUT ? 2 : 5)) * 1024;
#pragma unroll
        for (int n = 0; n < 4; ++n) {
          const int col = n0 + wc * 64 + n * 16 + 4 * fq;
          const float4 xr = *reinterpret_cast<const float4*>(res + (size_t)row * DM + col);
          const float4 gt = *reinterpret_cast<const float4*>(gate + col);
          float4 y;
          y.x = ALPHA * xr.x + gt.x * acc[m][n][0];
          y.y = ALPHA * xr.y + gt.y * acc[m][n][1];
          y.z = ALPHA * xr.z + gt.z * acc[m][n][2];
          y.w = ALPHA * xr.w + gt.w * acc[m][n][3];
          *reinterpret_cast<float4*>(p.Y + (size_t)row * DM + col) = y;
        }
      } else {
#pragma unroll
        for (int n2 = 0; n2 < 2; ++n2) {
          const int j0 = ((n0 + wc * 64) / 32 + n2) * 16 + 4 * fq;
          float a[4];
#pragma unroll
          for (int r = 0; r < 4; ++r) a[r] = siluf_(acc[m][2 * n2][r]) * acc[m][2 * n2 + 1][r];
          uint2 pk; pk.x = pack2(a[0], a[1]); pk.y = pack2(a[2], a[3]);
          *reinterpret_cast<uint2*>(p.ACT + (size_t)row * DFF + j0) = pk;
        }
      }
    }
    asm volatile("s_waitcnt lgkmcnt(0)" ::: "memory");
    __builtin_amdgcn_s_barrier();
  }
}

__device__ __forceinline__ int kf_off(int t, int d) { return (t >> 4) * 1024 + (d >> 5) * 512 + ((d & 31) >> 3) * 128 + (t & 15) * 8 + (d & 7); }
__device__ __forceinline__ int vf_off(int t, int d) { return (t >> 5) * 2048 + (d >> 4) * 512 + (((t & 15) >> 2) * 16 + (d & 15)) * 8 + ((t >> 4) & 1) * 4 + (t & 3); }
__device__ __forceinline__ void pack44_store(u16* base, int t0, int d, const float* v) {
  uint2 a, b; a.x = pack2(v[0], v[1]); a.y = pack2(v[2], v[3]); b.x = pack2(v[4], v[5]); b.y = pack2(v[6], v[7]);
  *reinterpret_cast<uint2*>(base + vf_off(t0, d)) = a;
  *reinterpret_cast<uint2*>(base + vf_off(t0 + 4, d)) = b;
}
__device__ __forceinline__ void pack8_store(u16* dst, const float* v) {
  uint4 pk; pk.x = pack2(v[0], v[1]); pk.y = pack2(v[2], v[3]); pk.z = pack2(v[4], v[5]); pk.w = pack2(v[6], v[7]);
  *reinterpret_cast<uint4*>(dst) = pk;
}

__device__ void setup_phase(const Params& p, char* smem, int bid, int nblk, int tidx) {
  const int tid = tidx;
  const int NI = 768 + 512 + 13;
  for (int it = bid; it < NI; it += nblk) {
    if (it < 768) {
      const int l = it / 192, nc = (it / 32) % 6, kc = it % 32;
      const int col = nc * 1024 + tid * 4;
      const float* wm = p.in[9] + (size_t)l * 1024 * 6144;
      float4 a0 = make_float4(0, 0, 0, 0), a1 = a0, a2 = a0;
      for (int kk = 0; kk < 32; ++kk) {
        const int k = kc * 32 + kk;
        const float s0 = siluf_(p.in[8][k]), s1 = siluf_(p.in[7][k]), s2 = siluf_(p.in[7][1024 + k]);
        const float4 w = *reinterpret_cast<const float4*>(wm + (size_t)k * 6144 + col);
        a0.x += s0 * w.x; a0.y += s0 * w.y; a0.z += s0 * w.z; a0.w += s0 * w.w;
        a1.x += s1 * w.x; a1.y += s1 * w.y; a1.z += s1 * w.z; a1.w += s1 * w.w;
        a2.x += s2 * w.x; a2.y += s2 * w.y; a2.z += s2 * w.z; a2.w += s2 * w.w;
      }
      float* dst = p.modp + (size_t)((l * 32 + kc) * 3) * 6144 + col;
      *reinterpret_cast<float4*>(dst) = a0;
      *reinterpret_cast<float4*>(dst + 6144) = a1;
      *reinterpret_cast<float4*>(dst + 2 * 6144) = a2;
    } else if (it < 1280) {
      const int ci = it - 768, b = ci / 256, l = (ci / 64) % 4, tg = ci % 64, t0 = tg * 8;
      {
        const float* ck = p.in[3] + ((size_t)(b * 4 + l) * 512 + t0) * 256 + tid;
        const float* cv = p.in[4] + ((size_t)(b * 4 + l) * 512 + t0) * 256 + tid;
        float v[8];
#pragma unroll
        for (int tt = 0; tt < 8; ++tt) {
          p.KNl[((size_t)((l * 2 + b) * 4 + (tid >> 6))) * 98304 + kf_off(t0 + tt, tid & 63)] = f2bf(ck[tt * 256]);
          v[tt] = cv[tt * 256];
        }
        pack44_store(p.VNtl + ((size_t)((l * 2 + b) * 4 + (tid >> 6))) * 98304, t0, tid & 63, v);
      }
      if (tid < 128) {
        const float* ck = p.in[5] + ((size_t)(b * 4 + l) * 512 + t0) * 128 + tid;
#pragma unroll
        for (int tt = 0; tt < 8; ++tt) p.KGl[((size_t)((l * 2 + b) * 2 + (tid >> 6))) * 98304 + kf_off(t0 + tt, tid & 63)] = f2bf(ck[tt * 128]);
      } else {
        const int c = tid - 128;
        const float* cv = p.in[6] + ((size_t)(b * 4 + l) * 512 + t0) * 128 + c;
        float v[8];
#pragma unroll
        for (int tt = 0; tt < 8; ++tt) v[tt] = cv[tt * 128];
        pack44_store(p.VGtl + ((size_t)((l * 2 + b) * 2 + (c >> 6))) * 98304, t0, c & 63, v);
      }
    } else {
      const int li = it - (768 + 512);
      if (li == 12) {
        for (int idx = tid; idx < 1024; idx += 256) {
          const int pos = idx >> 4, fi = idx & 15;
          const float ang = (float)pos * exp2f(-(float)fi * (13.287712379549449f / 16.f));
          p.rope[idx * 2] = cosf(ang); p.rope[idx * 2 + 1] = sinf(ang);
        }
      } else {
        const int l = li / 3, m = li % 3;
        u16* dst = p.loraT + (size_t)l * 98304 + m * 32768;
        if (m < 2) {
          const float* src = p.in[m == 0 ? 14 : 16] + (size_t)l * 32768;
          for (int idx = tid; idx < 32768; idx += 256) {
            const int d = idx >> 14, cch = (idx >> 6) & 255, r = idx & 63;
            dst[idx] = f2bf(src[(d * 64 + r) * 256 + cch]);
          }
        } else {
          const float* src = p.in[17] + (size_t)l * 32768;
          for (int idx = tid; idx < 32768; idx += 256) {
            const int cch = idx >> 7, j = idx & 127;
            dst[idx] = f2bf(src[j * 256 + cch]);
          }
        }
      }
    }
  }
  {
    float* tile = reinterpret_cast<float*>(smem);
    const int NT = 4 * 3040;
    float4 cur0, cur1, cur2, cur3;
    const float* src; u16* dst; int K, N, mat, k0, n0;
#define TR_DECODE(TR) { const int l_ = (TR) / 3040; int r_ = (TR) % 3040; int kt_, nt_; \
      if (r_ < 672) { mat = 0; K = 1024; N = 2688; src = p.in[11] + (size_t)l_ * K * N; dst = p.winT + (size_t)l_ * N * K; kt_ = r_ / 42; nt_ = r_ % 42; } \
      else if (r_ < 928) { r_ -= 672; mat = 1; K = 1024; N = 1024; src = p.in[26] + (size_t)l_ * K * N; dst = p.woutT + (size_t)l_ * N * K; kt_ = r_ / 16; nt_ = r_ % 16; } \
      else if (r_ < 2336) { r_ -= 928; mat = 2; K = 1024; N = 5632; src = p.in[29] + (size_t)l_ * K * N; dst = p.wfiT + (size_t)l_ * N * K; kt_ = r_ / 88; nt_ = r_ % 88; } \
      else { r_ -= 2336; mat = 3; K = 2816; N = 1024; src = p.in[30] + (size_t)l_ * K * N; dst = p.wfoT + (size_t)l_ * N * K; kt_ = r_ / 16; nt_ = r_ % 16; } \
      k0 = kt_ * 64; n0 = nt_ * 64; }
#define TR_LOAD(V, I) V = *reinterpret_cast<const float4*>(src + (size_t)(k0 + (tid >> 4) + 16 * (I)) * N + n0 + (tid & 15) * 4);
#define TR_PUT(V, I) { const int kr_ = (tid >> 4) + 16 * (I), c4_ = (tid & 15) * 4; \
      tile[kr_ * 65 + c4_ + 0] = V.x; tile[kr_ * 65 + c4_ + 1] = V.y; tile[kr_ * 65 + c4_ + 2] = V.z; tile[kr_ * 65 + c4_ + 3] = V.w; }
    int tr = bid;
    if (tr < NT) { TR_DECODE(tr) TR_LOAD(cur0, 0) TR_LOAD(cur1, 1) TR_LOAD(cur2, 2) TR_LOAD(cur3, 3) }
    for (; tr < NT; tr += nblk) {
      TR_PUT(cur0, 0) TR_PUT(cur1, 1) TR_PUT(cur2, 2) TR_PUT(cur3, 3)
      if (tr + nblk < NT) { TR_DECODE(tr + nblk) TR_LOAD(cur0, 0) TR_LOAD(cur1, 1) TR_LOAD(cur2, 2) TR_LOAD(cur3, 3) }
      TR_DECODE(tr)
      __syncthreads();
#pragma unroll
      for (int i = 0; i < 2; ++i) {
        const int idx = tid + 256 * i, nl = idx >> 3, kc = idx & 7;
        int n = n0 + nl;
        if (mat == 2) { const int isup = n >= DFF ? 1 : 0; const int j = n - isup * DFF; n = (j >> 4) * 32 + isup * 16 + (j & 15); }
        float v[8];
#pragma unroll
        for (int jj = 0; jj < 8; ++jj) v[jj] = tile[(kc * 8 + jj) * 65 + nl];
        pack8_store(dst + (size_t)n * K + k0 + kc * 8, v);
      }
      __syncthreads();
    }
#undef TR_DECODE
#undef TR_LOAD
#undef TR_PUT
  }
}

__device__ void modreduce_phase(const Params& p, int bid, int nblk, int tidx) {
  for (int idx = bid * 256 + tidx; idx < 18432; idx += nblk * 256) {
    const int l = idx / 4608, rem = idx % 4608, mr = rem / 1536, c4 = (rem % 1536) * 4;
    float4 a = *reinterpret_cast<const float4*>(p.in[10] + (size_t)l * 6144 + c4);
    for (int kc = 0; kc < 32; ++kc) {
      const float4 v = *reinterpret_cast<const float4*>(p.modp + (size_t)((l * 32 + kc) * 3 + mr) * 6144 + c4);
      a.x += v.x; a.y += v.y; a.z += v.z; a.w += v.w;
    }
    *reinterpret_cast<float4*>(p.mod + (size_t)(l * 3 + mr) * 6144 + c4) = a;
  }
}

template <int MODE>
__device__ void ln_phase(const Params& p, int layer, int bid, int nblk, int tidx) {
  const int lane = tidx & 63, wid = tidx >> 6;
  for (int it = bid; it < NTOK / 4; it += nblk) {
    const int row = it * 4 + wid;
    const float* src;
    if (MODE == 0) src = row < NCTX ? p.in[0] + (size_t)row * DM : p.in[1] + (size_t)(row - NCTX) * DM;
    else src = p.Y + (size_t)row * DM;
    float4 v[4];
#pragma unroll
    for (int i = 0; i < 4; ++i) v[i] = reinterpret_cast<const float4*>(src)[lane + 64 * i];
    if (MODE != 0) {
      float s = 0.f;
#pragma unroll
      for (int i = 0; i < 4; ++i) s += v[i].x + v[i].y + v[i].z + v[i].w;
      const float mu = wave_sum(s) * (1.f / 1024.f);
      float q = 0.f;
#pragma unroll
      for (int i = 0; i < 4; ++i) {
        v[i].x -= mu; v[i].y -= mu; v[i].z -= mu; v[i].w -= mu;
        q += v[i].x * v[i].x + v[i].y * v[i].y + v[i].z * v[i].z + v[i].w * v[i].w;
      }
      const float rstd = rsqrtf(wave_sum(q) * (1.f / 1024.f) + 1e-5f);
      const float* lw = (MODE == 1 ? p.in[27] : p.in[31]) + (size_t)layer * DM;
      const float* lb = (MODE == 1 ? p.in[28] : p.in[32]) + (size_t)layer * DM;
#pragma unroll
      for (int i = 0; i < 4; ++i) {
        const float4 w = reinterpret_cast<const float4*>(lw)[lane + 64 * i];
        const float4 b = reinterpret_cast<const float4*>(lb)[lane + 64 * i];
        v[i].x = v[i].x * rstd * w.x + b.x; v[i].y = v[i].y * rstd * w.y + b.y;
        v[i].z = v[i].z * rstd * w.z + b.z; v[i].w = v[i].w * rstd * w.w + b.w;
      }
    }
    float* xdst = (MODE == 1 ? p.X1 : p.X) + (size_t)row * DM;
#pragma unroll
    for (int i = 0; i < 4; ++i) reinterpret_cast<float4*>(xdst)[lane + 64 * i] = v[i];
    if (MODE == 2 && layer == 3) {
      float* o = row < NCTX ? p.out_yp + (size_t)row * DM : p.out_ys + (size_t)(row - NCTX) * DM;
#pragma unroll
      for (int i = 0; i < 4; ++i) reinterpret_cast<float4*>(o)[lane + 64 * i] = v[i];
    } else {
      const int ml = (MODE == 2) ? layer + 1 : layer;
      const int which = (MODE == 1) ? 3 : 0;
      const float* sh = p.mod + ((size_t)(ml * 3 + modrow_of(row)) * 6 + which) * 1024;
      const float* sc = sh + 1024;
      u16* adst = p.A + (size_t)row * DM;
#pragma unroll
      for (int i = 0; i < 4; ++i) {
        const float4 s4 = reinterpret_cast<const float4*>(sh)[lane + 64 * i];
        const float4 c4 = reinterpret_cast<const float4*>(sc)[lane + 64 * i];
        uint2 pk;
        pk.x = pack2(v[i].x * (1.f + c4.x) + s4.x, v[i].y * (1.f + c4.y) + s4.y);
        pk.y = pack2(v[i].z * (1.f + c4.z) + s4.z, v[i].w * (1.f + c4.w) + s4.w);
        reinterpret_cast<uint2*>(adst)[lane + 64 * i] = pk;
      }
    }
  }
}

#define FLD 772
#define LLD 392
__device__ void prep_phase(const Params& p, int layer, char* smem, int bid, int nblk, int tidx) {
  float* F = reinterpret_cast<float*>(smem);
  u16* LIb = reinterpret_cast<u16*>(smem + 16 * FLD * 4);
  const float* cw = p.in[12] + (size_t)layer * 3 * 1152;
  const u16* LW = p.loraT + (size_t)layer * 98304;
  for (int it = bid; it < NTOK / 16; it += nblk) {
    int tid = tidx;
    asm volatile("" : "+v"(tid));
    const int lane = tid & 63, wid = tid >> 6, fr = lane & 15, fq = lane >> 4;
    const int tok0 = it * 16;
    int b, tpos0, L;
    const bool isctx = tok0 < NCTX;
    if (isctx) { b = tok0 >> 8; tpos0 = tok0 & 255; L = 256; }
    else { const int tl = tok0 - NCTX; b = tl >> 10; tpos0 = tl & 1023; L = 1024; }
#pragma unroll 1
    for (int cg = tid; cg < 288; cg += 256) {
      const int c = cg * 4;
      const float4 w0 = *reinterpret_cast<const float4*>(cw + c);
      const float4 w1 = *reinterpret_cast<const float4*>(cw + 1152 + c);
      const float4 w2 = *reinterpret_cast<const float4*>(cw + 2304 + c);
      const float* pr = p.PROJ + (size_t)tok0 * DIN + c;
      float4 x[18];
#pragma unroll
      for (int i = 0; i < 18; ++i) {
        const int tpos = tpos0 + i - 1;
        x[i] = (tpos >= 0 && tpos < L) ? *reinterpret_cast<const float4*>(pr + (ptrdiff_t)(i - 1) * DIN) : make_float4(0.f, 0.f, 0.f, 0.f);
      }
#pragma unroll
      for (int tt = 0; tt < 16; ++tt) {
        float4 f;
        f.x = w0.x * x[tt].x + w1.x * x[tt + 1].x + w2.x * x[tt + 2].x;
        f.y = w0.y * x[tt].y + w1.y * x[tt + 1].y + w2.y * x[tt + 2].y;
        f.z = w0.z * x[tt].z + w1.z * x[tt + 1].z + w2.z * x[tt + 2].z;
        f.w = w0.w * x[tt].w + w1.w * x[tt + 1].w + w2.w * x[tt + 2].w;
        if (c < 768) { *reinterpret_cast<float4*>(F + tt * FLD + c) = f; }
        else {
          const int cc = c - 768;
          if (cc < 128) { f.x = tanhf(f.x); f.y = tanhf(f.y); f.z = tanhf(f.z); f.w = tanhf(f.w); }
          else if (cc >= 256) { f.x = sigmoidf_(f.x); f.y = sigmoidf_(f.y); f.z = sigmoidf_(f.z); f.w = sigmoidf_(f.w); }
          uint2 pk; pk.x = pack2(f.x, f.y); pk.y = pack2(f.z, f.w);
          *reinterpret_cast<uint2*>(LIb + tt * LLD + cc) = pk;
        }
      }
    }
    __syncthreads();
    f32x4 acc[5][4];
#pragma unroll
    for (int g = 0; g < 5; ++g)
#pragma unroll
      for (int nf = 0; nf < 4; ++nf) acc[g][nf] = (f32x4){0.f, 0.f, 0.f, 0.f};
#pragma unroll
    for (int g = 0; g < 4; ++g) {
      const u16* wt = LW + (size_t)g * 16384;
#pragma unroll
      for (int ks = 0; ks < 2; ++ks) {
        const bf16x8 xb = *reinterpret_cast<const bf16x8*>(LIb + fr * LLD + g * 64 + ks * 32 + fq * 8);
#pragma unroll
        for (int nf = 0; nf < 4; ++nf) {
          const bf16x8 wa = *reinterpret_cast<const bf16x8*>(wt + (size_t)(64 * wid + 16 * nf + fr) * 64 + ks * 32 + fq * 8);
          acc[g][nf] = __builtin_amdgcn_mfma_f32_16x16x32_bf16(wa, xb, acc[g][nf], 0, 0, 0);
        }
      }
      __builtin_amdgcn_sched_barrier(0);
    }
    {
      const u16* wt = LW + 65536;
#pragma unroll
      for (int ks = 0; ks < 4; ++ks) {
        const bf16x8 xb = *reinterpret_cast<const bf16x8*>(LIb + fr * LLD + 256 + ks * 32 + fq * 8);
#pragma unroll
        for (int nf = 0; nf < 4; ++nf) {
          const bf16x8 wa = *reinterpret_cast<const bf16x8*>(wt + (size_t)(64 * wid + 16 * nf + fr) * 128 + ks * 32 + fq * 8);
          acc[4][nf] = __builtin_amdgcn_mfma_f32_16x16x32_bf16(wa, xb, acc[4][nf], 0, 0, 0);
        }
        if (ks == 1) __builtin_amdgcn_sched_barrier(0);
      }
      __builtin_amdgcn_sched_barrier(0);
    }
#ifndef NO_C
    {
      const int tok = tok0 + fr;
      float ss = 0.f, bs = 0.f;
#pragma unroll
      for (int nf = 0; nf < 4; ++nf) {
        const int c0 = 64 * wid + 16 * nf + 4 * fq;
        const float4 r4 = *reinterpret_cast<const float4*>(F + fr * FLD + c0);
        const float4 k4 = *reinterpret_cast<const float4*>(F + fr * FLD + 256 + c0);
        const float4 w00 = *reinterpret_cast<const float4*>(p.in[13] + (size_t)layer * 512 + c0);
        const float4 w01 = *reinterpret_cast<const float4*>(p.in[13] + (size_t)layer * 512 + 256 + c0);
        const float4 a00 = *reinterpret_cast<const float4*>(p.in[15] + (size_t)layer * 512 + c0);
        const float4 a01 = *reinterpret_cast<const float4*>(p.in[15] + (size_t)layer * 512 + 256 + c0);
        const float4 kkw = *reinterpret_cast<const float4*>(p.in[18] + (size_t)layer * 256 + c0);
        const float4 kaw = *reinterpret_cast<const float4*>(p.in[19] + (size_t)layer * 256 + c0);
        const float4 rkw = *reinterpret_cast<const float4*>(p.in[20] + (size_t)layer * 256 + c0);
        const float rr[4] = {r4.x, r4.y, r4.z, r4.w}, kk_[4] = {k4.x, k4.y, k4.z, k4.w};
        const float w0a[4] = {w00.x, w00.y, w00.z, w00.w}, w0b[4] = {w01.x, w01.y, w01.z, w01.w};
        const float a0a[4] = {a00.x, a00.y, a00.z, a00.w}, a0b[4] = {a01.x, a01.y, a01.z, a01.w};
        const float kkw_[4] = {kkw.x, kkw.y, kkw.z, kkw.w}, kaw_[4] = {kaw.x, kaw.y, kaw.z, kaw.w}, rkw_[4] = {rkw.x, rkw.y, rkw.z, rkw.w};
#pragma unroll
        for (int r = 0; r < 4; ++r) {
          {
            const float z = -(w0a[r] + acc[0][nf][r]);
            const float sp = fmaxf(z, 0.f) + log1pf(__expf(-fabsf(z)));
            acc[0][nf][r] = __expf(-__expf(-sp - 0.5f));
          }
          {
            const float z = -(w0b[r] + acc[1][nf][r]);
            const float sp = fmaxf(z, 0.f) + log1pf(__expf(-fabsf(z)));
            acc[1][nf][r] = __expf(-__expf(-sp - 0.5f));
          }
          const float av0 = sigmoidf_(a0a[r] + acc[2][nf][r]);
          const float av1 = sigmoidf_(a0b[r] + acc[3][nf][r]);
          acc[2][nf][r] = av0; acc[3][nf][r] = av1;
          const float k = kk_[r];
          const float kq = k * kkw_[r];
          ss += kq * kq;
          const float kd0 = k * (1.f + (av0 - 1.f) * kaw_[r]);
          const float kd1 = k * (1.f + (av1 - 1.f) * kaw_[r]);
          bs += rr[r] * (kd0 + kd1) * rkw_[r];
        }
        __builtin_amdgcn_sched_barrier(0);
      }
      ss += __shfl_xor(ss, 16); ss += __shfl_xor(ss, 32);
      bs += __shfl_xor(bs, 16); bs += __shfl_xor(bs, 32);
      const float inrm = 1.f / fmaxf(sqrtf(ss), 1e-12f);
#pragma unroll
      for (int nf = 0; nf < 4; ++nf) {
        const int c0 = 64 * wid + 16 * nf + 4 * fq, n0 = 16 * nf + 4 * fq;
        const float4 r4 = *reinterpret_cast<const float4*>(F + fr * FLD + c0);
        const float4 k4 = *reinterpret_cast<const float4*>(F + fr * FLD + 256 + c0);
        const float4 v4 = *reinterpret_cast<const float4*>(F + fr * FLD + 512 + c0);
        const float4 kkw = *reinterpret_cast<const float4*>(p.in[18] + (size_t)layer * 256 + c0);
        const float4 kaw = *reinterpret_cast<const float4*>(p.in[19] + (size_t)layer * 256 + c0);
        const float kk_[4] = {k4.x, k4.y, k4.z, k4.w}, kkw_[4] = {kkw.x, kkw.y, kkw.z, kkw.w}, kaw_[4] = {kaw.x, kaw.y, kaw.z, kaw.w};
        float* sc = p.SC + ((size_t)(tok * 4 + wid) * 9) * 64 + n0;
        float kn[4], kd0[4], kd1[4];
#pragma unroll
        for (int r = 0; r < 4; ++r) {
          kn[r] = kk_[r] * kkw_[r] * inrm;
          kd0[r] = kk_[r] * (1.f + (acc[2][nf][r] - 1.f) * kaw_[r]);
          kd1[r] = kk_[r] * (1.f + (acc[3][nf][r] - 1.f) * kaw_[r]);
        }
        *reinterpret_cast<float4*>(sc) = r4;
        *reinterpret_cast<float4*>(sc + 64) = make_float4(kn[0], kn[1], kn[2], kn[3]);
        *reinterpret_cast<float4*>(sc + 128) = v4;
        *reinterpret_cast<float4*>(sc + 192) = make_float4(acc[0][nf][0], acc[0][nf][1], acc[0][nf][2], acc[0][nf][3]);
        *reinterpret_cast<float4*>(sc + 256) = make_float4(acc[2][nf][0] * kn[0], acc[2][nf][1] * kn[1], acc[2][nf][2] * kn[2], acc[2][nf][3] * kn[3]);
        *reinterpret_cast<float4*>(sc + 320) = make_float4(kd0[0], kd0[1], kd0[2], kd0[3]);
        *reinterpret_cast<float4*>(sc + 384) = make_float4(acc[1][nf][0], acc[1][nf][1], acc[1][nf][2], acc[1][nf][3]);
        *reinterpret_cast<float4*>(sc + 448) = make_float4(acc[3][nf][0] * kn[0], acc[3][nf][1] * kn[1], acc[3][nf][2] * kn[2], acc[3][nf][3] * kn[3]);
        *reinterpret_cast<float4*>(sc + 512) = make_float4(kd1[0], kd1[1], kd1[2], kd1[3]);
        *reinterpret_cast<float4*>(p.G + (size_t)tok * 256 + c0) = make_float4(acc[4][nf][0], acc[4][nf][1], acc[4][nf][2], acc[4][nf][3]);
        *reinterpret_cast<float4*>(p.BV + (size_t)tok * 256 + c0) = make_float4(bs * v4.x, bs * v4.y, bs * v4.z, bs * v4.w);
        __builtin_amdgcn_sched_barrier(0);
      }
    }
#endif
#ifndef NO_D
    const int c = tid;
#pragma unroll
    for (int half = 0; half < 2; ++half) {
      float vv[8];
#pragma unroll
      for (int t8 = 0; t8 < 8; ++t8) {
        const int tt = half * 8 + t8, tok = tok0 + tt;
        const float* pr = p.PROJ + (size_t)tok * DIN + 1152 + c;
        const float q = pr[0], k = pr[256], v = pr[512];
        vv[t8] = v;
        if (isctx) {
          const size_t oi = ((size_t)(b * 4 + layer) * 256 + tpos0 + tt) * 256 + c;
          p.out_nak[oi] = k; p.out_nav[oi] = v;
          p.QNc[(size_t)tok * 256 + c] = f2bf(q * QSCALE);
          p.KNc[(size_t)(b * 4 + (c >> 6)) * 16384 + kf_off(tpos0 + tt, c & 63)] = f2bf(k);
        } else {
          p.QNl[(size_t)(tok - NCTX) * 256 + c] = f2bf(q * QSCALE);
          p.KNl[((size_t)((layer * 2 + b) * 4 + (c >> 6))) * 98304 + kf_off(512 + tpos0 + tt, c & 63)] = f2bf(k);
        }
      }
      if (isctx) pack44_store(p.VNtc + (size_t)(b * 4 + (c >> 6)) * 16384, tpos0 + half * 8, c & 63, vv);
      else pack44_store(p.VNtl + ((size_t)((layer * 2 + b) * 4 + (c >> 6))) * 98304, 512 + tpos0 + half * 8, c & 63, vv);
    }
    {
      const float qn = p.in[24][(size_t)layer * 64 + lane], kn = p.in[25][(size_t)layer * 64 + lane];
      const int fi = lane & 15;
#pragma unroll
      for (int half = 0; half < 2; ++half) {
        float vv[8];
#pragma unroll
        for (int t8 = 0; t8 < 8; ++t8) {
          const int tt = half * 8 + t8, tok = tok0 + tt, tpos = tpos0 + tt;
          const float* pr = p.PROJ + (size_t)tok * DIN + 1920;
          float cs = 1.f, sn = 0.f;
          if (!isctx) {
            const int pos = (lane < 32) ? (tpos >> 6) : (tpos & 63);
            const float2 t2 = *reinterpret_cast<const float2*>(p.rope + (size_t)(pos * 16 + fi) * 2);
            cs = t2.x; sn = t2.y;
            if ((lane & 16) == 0) sn = -sn;
          }
#pragma unroll
          for (int hh = 0; hh < 2; ++hh) {
            float q = pr[hh * 256 + c];
            const float ms = wave_sum(q * q) * (1.f / 64.f);
            q = q * rsqrtf(ms + 1e-6f) * qn;
            if (!isctx) { const float qp = __shfl_xor(q, 16); q = q * cs + qp * sn; }
            if (isctx) p.QGc[(size_t)tok * 512 + hh * 256 + c] = f2bf(q * QSCALE);
            else p.QGl[(size_t)(tok - NCTX) * 512 + hh * 256 + c] = f2bf(q * QSCALE);
          }
          if (wid < 2) {
            float k = pr[512 + c];
            const float ms = wave_sum(k * k) * (1.f / 64.f);
            k = k * rsqrtf(ms + 1e-6f) * kn;
            if (isctx) {
              p.out_gk[((size_t)(b * 4 + layer) * 256 + tpos) * 128 + c] = k;
              p.KGc[(size_t)(b * 2 + (c >> 6)) * 16384 + kf_off(tpos, c & 63)] = f2bf(k);
            } else {
              const float kp = __shfl_xor(k, 16); k = k * cs + kp * sn;
              p.KGl[((size_t)((layer * 2 + b) * 2 + (c >> 6))) * 98304 + kf_off(512 + tpos, c & 63)] = f2bf(k);
            }
          } else {
            const int cv = c - 128;
            const float v = pr[640 + cv];
            vv[t8] = v;
            if (isctx) p.out_gv[((size_t)(b * 4 + layer) * 256 + tpos) * 128 + cv] = v;
          }
        }
        if (wid >= 2) {
          const int cv = c - 128;
          if (isctx) pack44_store(p.VGtc + (size_t)(b * 2 + (cv >> 6)) * 16384, tpos0 + half * 8, cv & 63, vv);
          else pack44_store(p.VGtl + ((size_t)((layer * 2 + b) * 2 + (cv >> 6))) * 98304, 512 + tpos0 + half * 8, cv & 63, vv);
        }
      }
    }
#endif
    __syncthreads();
  }
}

#define ATT_LOAD(KF, VF, CI) { \
    const int ci_ = min((CI), nt - 1); \
    int kb_; \
    if (ci_ < nd) kb_ = ci_ * 32; \
    else { const int e_ = ci_ - nd; const int j_ = (ncc == 2) ? (e_ >> 1) : e_; const int cc_ = cc0 + ((ncc == 2) ? (e_ & 1) : 0); kb_ = 512 + (rb + j_) * 64 + cc_ * 32; } \
    const u16* kp_ = Kb + (size_t)(kb_ >> 4) * 1024 + lane * 8; \
    KF##00 = *reinterpret_cast<const bf16x8*>(kp_); \
    KF##01 = *reinterpret_cast<const bf16x8*>(kp_ + 512); \
    KF##10 = *reinterpret_cast<const bf16x8*>(kp_ + 1024); \
    KF##11 = *reinterpret_cast<const bf16x8*>(kp_ + 1536); \
    const u16* vp_ = Vt + (size_t)(kb_ >> 5) * 2048 + lane * 8; \
    VF##0 = *reinterpret_cast<const bf16x8*>(vp_); \
    VF##1 = *reinterpret_cast<const bf16x8*>(vp_ + 512); \
    VF##2 = *reinterpret_cast<const bf16x8*>(vp_ + 1024); \
    VF##3 = *reinterpret_cast<const bf16x8*>(vp_ + 1536); }

#define ATT_PV(DT, VV) { \
    o[DT][0] *= alpha; o[DT][1] *= alpha; o[DT][2] *= alpha; o[DT][3] *= alpha; \
    o[DT] = __builtin_amdgcn_mfma_f32_16x16x32_bf16(VV, pf.v, o[DT], 0, 0, 0); }

#define ATT_COMPUTE(KF, VF, CI) { \
    const int ci_ = (CI); \
    f32x4 s0 = (f32x4){0.f, 0.f, 0.f, 0.f}, s1 = (f32x4){0.f, 0.f, 0.f, 0.f}; \
    s0 = __builtin_amdgcn_mfma_f32_16x16x32_bf16(KF##00, qf0, s0, 0, 0, 0); \
    s0 = __builtin_amdgcn_mfma_f32_16x16x32_bf16(KF##01, qf1, s0, 0, 0, 0); \
    s1 = __builtin_amdgcn_mfma_f32_16x16x32_bf16(KF##10, qf0, s1, 0, 0, 0); \
    s1 = __builtin_amdgcn_mfma_f32_16x16x32_bf16(KF##11, qf1, s1, 0, 0, 0); \
    float sv[8] = {s0[0], s0[1], s0[2], s0[3], s1[0], s1[1], s1[2], s1[3]}; \
    bool ok[8]; \
    _Pragma("unroll") for (int e = 0; e < 8; ++e) ok[e] = true; \
    if (ci_ >= nd) { \
      const int e_ = ci_ - nd; const int j_ = (ncc == 2) ? (e_ >> 1) : e_; const int cc_ = cc0 + ((ncc == 2) ? (e_ & 1) : 0); \
      const int dr_ = rb + j_ - grow + 7; \
      const int cq = cq0 + fr, c0 = min(max(cq - 8, 0), 48); \
      _Pragma("unroll") for (int e = 0; e < 8; ++e) { \
        const int ck = cc_ * 32 + 16 * (e >> 2) + 4 * fq + (e & 3); \
        ok[e] = (ck >= c0) && (ck < c0 + 16); \
        const int dc = min(max(ck - cq, -15), 15) + 15; \
        const float bias = rpb[dr_ * 31 + dc] * LOG2E; \
        sv[e] = ok[e] ? sv[e] + bias : -1e30f; \
      } \
    } \
    float mx = fmaxf(fmaxf(fmaxf(sv[0], sv[1]), fmaxf(sv[2], sv[3])), fmaxf(fmaxf(sv[4], sv[5]), fmaxf(sv[6], sv[7]))); \
    mx = fmaxf(mx, __shfl_xor(mx, 16)); \
    mx = fmaxf(mx, __shfl_xor(mx, 32)); \
    const float mn = fmaxf(m, mx); \
    const float alpha = exp2f(m - mn); \
    m = mn; \
    float ps = 0.f; \
    _Pragma("unroll") for (int e = 0; e < 8; ++e) { sv[e] = ok[e] ? exp2f(sv[e] - mn) : 0.f; ps += sv[e]; } \
    l = l * alpha + ps; \
    union { bf16x8 v; unsigned u[4]; } pf; \
    pf.u[0] = pack2(sv[0], sv[1]); pf.u[1] = pack2(sv[2], sv[3]); pf.u[2] = pack2(sv[4], sv[5]); pf.u[3] = pack2(sv[6], sv[7]); \
    ATT_PV(0, VF##0) ATT_PV(1, VF##1) ATT_PV(2, VF##2) ATT_PV(3, VF##3) }

__device__ __forceinline__ void attn_wave(const u16* __restrict__ Q, int ldq, const u16* __restrict__ Kb, int ldk,
                                          const u16* __restrict__ Vt, int ldv, int ndense, const bool NA,
                                          const float* __restrict__ rpb, int grow, int cq0,
                                          u16* __restrict__ out, int ldo, int tidx) {
  const int lane = tidx & 63, fr = lane & 15, fq = lane >> 4;
  const bf16x8 qf0 = *reinterpret_cast<const bf16x8*>(Q + (size_t)fr * ldq + fq * 8);
  const bf16x8 qf1 = *reinterpret_cast<const bf16x8*>(Q + (size_t)fr * ldq + 32 + fq * 8);
  f32x4 o[4];
#pragma unroll
  for (int dt = 0; dt < 4; ++dt) o[dt] = (f32x4){0.f, 0.f, 0.f, 0.f};
  float m = -1e30f, l = 0.f;
  const int nd = ndense >> 5;
  const int rb = min(max(grow - 4, 0), 8);
  const int ulo = min(max(cq0 - 8, 0), 48), uhi = min(max(cq0 + 15 - 8, 0), 48) + 16;
  const bool c0ok = ulo < 32, c1ok = uhi > 32;
  const int ncc = (c0ok && c1ok) ? 2 : 1, cc0 = c0ok ? 0 : 1;
  const int nt = nd + (NA ? 8 * ncc : 0);
  bf16x8 ka00, ka01, ka10, ka11, kb00, kb01, kb10, kb11;
  bf16x8 va0, va1, va2, va3, vb0, vb1, vb2, vb3;
  ATT_LOAD(ka, va, 0)
  for (int ci = 0; ci < nt; ci += 2) {
    ATT_LOAD(kb, vb, ci + 1)
    ATT_COMPUTE(ka, va, ci)
    if (ci + 1 < nt) {
      ATT_LOAD(ka, va, ci + 2)
      ATT_COMPUTE(kb, vb, ci + 1)
    }
  }
  l += __shfl_xor(l, 16);
  l += __shfl_xor(l, 32);
  const float il = 1.f / l;
#pragma unroll
  for (int dt = 0; dt < 4; ++dt) {
    uint2 pk; pk.x = pack2(o[dt][0] * il, o[dt][1] * il); pk.y = pack2(o[dt][2] * il, o[dt][3] * il);
    *reinterpret_cast<uint2*>(out + (size_t)fr * ldo + 16 * dt + 4 * fq) = pk;
  }
}

__device__ void scan_item(const Params& p, int layer, char* smem, bool lat, int b, int h, int dir, int qd, int tidx) {
  const int tid = tidx, lane = tid & 63, wid = tid >> 6, rr = lane >> 4, j = lane & 15;
  const int L = lat ? 1024 : 256, seqbase = lat ? NCTX + b * 1024 : b * 256;
  const int rowl = wid * 4 + rr, row = qd * 16 + rowl;
  float* cbuf = reinterpret_cast<float*>(smem);
  float* obuf = cbuf + 2 * 16 * 6 * 64;
  float4 S = make_float4(0.f, 0.f, 0.f, 0.f);
  if (lat) S = *reinterpret_cast<const float4*>(p.in[2] + ((((size_t)(b * 4 + layer) * 2 + dir) * 4 + h) * 64 + row) * 64 + 4 * j);
  const int nch = L / 16;
  float* odst = dir == 0 ? p.OF : p.OB;
  float4 pre0, pre1, pre2, pre3, pre4, pre5;
#define SC_GL1(PR, I, CH) { const int idx = tid + 256 * (I), tt_ = idx / 96, rem = idx % 96, vec = rem >> 4, f4 = rem & 15; \
    const int st_ = (CH) * 16 + tt_, t_ = dir == 0 ? st_ : L - 1 - st_; const int svec = vec < 3 ? vec : vec + 3 * dir; \
    PR = *reinterpret_cast<const float4*>(p.SC + ((size_t)((seqbase + t_) * 4 + h) * 9 + svec) * 64 + f4 * 4); }
#define gload(CH) { SC_GL1(pre0, 0, CH) SC_GL1(pre1, 1, CH) SC_GL1(pre2, 2, CH) SC_GL1(pre3, 3, CH) SC_GL1(pre4, 4, CH) SC_GL1(pre5, 5, CH) }
#define SC_LS1(PR, I, BUF) *reinterpret_cast<float4*>(cbuf + (BUF) * 6144 + (tid + 256 * (I)) * 4) = PR;
#define lstore(BUF) { SC_LS1(pre0, 0, BUF) SC_LS1(pre1, 1, BUF) SC_LS1(pre2, 2, BUF) SC_LS1(pre3, 3, BUF) SC_LS1(pre4, 4, BUF) SC_LS1(pre5, 5, BUF) }
  gload(0); lstore(0);
  __syncthreads();
#define SC_LD(R4, K4, VV, W4, A4, D4, TT) { const float* base_ = cb + (TT) * 384; \
    R4 = *reinterpret_cast<const float4*>(base_ + 4 * j); K4 = *reinterpret_cast<const float4*>(base_ + 64 + 4 * j); \
    VV = base_[128 + row]; W4 = *reinterpret_cast<const float4*>(base_ + 192 + 4 * j); \
    A4 = *reinterpret_cast<const float4*>(base_ + 256 + 4 * j); D4 = *reinterpret_cast<const float4*>(base_ + 320 + 4 * j); }
  for (int ch = 0; ch < nch; ++ch) {
#if REPMASK
    if (ch + 1 < nch && p.pad != 5) gload(ch + 1);
#else
    if (ch + 1 < nch) gload(ch + 1);
#endif
    const float* cb = cbuf + (ch & 1) * 6144;
    float osel = 0.f;
    float4 r4, kk4, w4, ak4, kd4; float vv;
    SC_LD(r4, kk4, vv, w4, ak4, kd4, 0)
    float ovp = 0.f;
#pragma unroll 4
    for (int tt = 0; tt < 16; ++tt) {
      float4 r4n, kk4n, w4n, ak4n, kd4n; float vvn;
      SC_LD(r4n, kk4n, vvn, w4n, ak4n, kd4n, tt + 1)
      float sk = (S.x * kk4.x + S.y * kk4.y) + (S.z * kk4.z + S.w * kk4.w);
      sk += dpp_mov<0xB1>(sk);  ovp += dpp_mov<0xB1>(ovp);
      sk += dpp_mov<0x4E>(sk);  ovp += dpp_mov<0x4E>(ovp);
      sk += dpp_mov<0x141>(sk); ovp += dpp_mov<0x141>(ovp);
      sk += dpp_mov<0x140>(sk); ovp += dpp_mov<0x140>(ovp);
      osel = (j == tt - 1) ? ovp : osel;
      const float tx = vv * kd4.x - sk * ak4.x, ty = vv * kd4.y - sk * ak4.y, tz = vv * kd4.z - sk * ak4.z, tw = vv * kd4.w - sk * ak4.w;
      S.x = S.x * w4.x + tx; S.y = S.y * w4.y + ty; S.z = S.z * w4.z + tz; S.w = S.w * w4.w + tw;
      ovp = (S.x * r4.x + S.y * r4.y) + (S.z * r4.z + S.w * r4.w);
      r4 = r4n; kk4 = kk4n; w4 = w4n; ak4 = ak4n; kd4 = kd4n; vv = vvn;
    }
    ovp = reduce16(ovp);
    osel = (j == 15) ? ovp : osel;
    {
      const int st = ch * 16 + j, t = dir == 0 ? st : L - 1 - st;
      odst[(size_t)(seqbase + t) * 256 + h * 64 + row] = osel;
    }
#if REPMASK
    if (ch + 1 < nch && p.pad != 5) lstore((ch + 1) & 1);
#else
    if (ch + 1 < nch) lstore((ch + 1) & 1);
#endif
    asm volatile("s_waitcnt lgkmcnt(0)" ::: "memory");
    __builtin_amdgcn_s_barrier();
  }
  if (!lat) *reinterpret_cast<float4*>(p.out_st + ((((size_t)(b * 4 + layer) * 2 + dir) * 4 + h) * 64 + row) * 64 + 4 * j) = S;
  __syncthreads();
}

__device__ void mixer_phase(const Params& p, int layer, char* smem, int tidx0) {
  int* slot = reinterpret_cast<int*>(smem + 60 * 1024);
  for (;;) {
    int tidx = tidx0;
    asm volatile("" : "+v"(tidx));
    const int tid = tidx, wid = tid >> 6;
    __syncthreads();
    if (tid == 0) *slot = (int)atomicAdd(&p.wq[layer], 1u);
    __syncthreads();
    int it = *slot;
    if (it >= 1728) break;
    const bool is_scan = (it < 64) || (it >= 448 && it < 960);
#if REPMASK
    if ((p.pad == 1 && !is_scan) || (p.pad == 2 && is_scan) || ((p.pad == 3 || p.pad == 5 || p.pad == 6) && !(it < 64)) || (p.pad == 4 && !(it >= 64 && it < 320))) continue;
#endif
    if (is_scan) {
      const bool lat = it < 64;
      const int si = lat ? it : it - 448;
#ifndef NO_SCAN
      scan_item(p, layer, smem, lat, si / 32, (si / 8) % 4, (si / 4) % 2, si % 4, tidx);
#endif
      continue;
    }
    const u16 *Q, *Kb, *Vt; u16* out; int ldq, ldk, ldv, ndense, grow = 0, cq0 = 0; bool na = false;
    const float* rpb = p.in[23];
    if (it < 320) {
      it -= 64;
      const int b = it / 128, qh = (it / 16) % 8, qt = it % 16, kvh = qh >> 2;
      const int q0 = b * 1024 + qt * 64 + wid * 16;
      Q = p.QGl + (size_t)q0 * 512 + qh * 64; ldq = 512;
      Kb = p.KGl + (size_t)((layer * 2 + b) * 2 + kvh) * 98304; ldk = 0;
      Vt = p.VGtl + (size_t)((layer * 2 + b) * 2 + kvh) * 98304; ldv = 0; ndense = 1536;
      out = p.MIX + (size_t)(NCTX + q0) * DM + 512 + qh * 64;
    } else if (it < 448) {
      it -= 320;
      const int b = it / 64, h = (it / 16) % 4, r = it % 16;
      const int q0 = b * 1024 + r * 64 + wid * 16;
      Q = p.QNl + (size_t)q0 * 256 + h * 64; ldq = 256;
      Kb = p.KNl + (size_t)((layer * 2 + b) * 4 + h) * 98304; ldk = 0;
      Vt = p.VNtl + (size_t)((layer * 2 + b) * 4 + h) * 98304; ldv = 0; ndense = 512;
      rpb = p.in[23] + (size_t)(layer * 4 + h) * 15 * 31; grow = r; cq0 = wid * 16; na = true;
      out = p.MIX + (size_t)(NCTX + q0) * DM + 256 + h * 64;
    } else if (it < 1472) {
      it -= 960;
      const int b = it / 32, qh = (it / 4) % 8, qt = it % 4, kvh = qh >> 2;
      const int q0 = b * 256 + qt * 64 + wid * 16;
      Q = p.QGc + (size_t)q0 * 512 + qh * 64; ldq = 512;
      Kb = p.KGc + (size_t)(b * 2 + kvh) * 16384; ldk = 0;
      Vt = p.VGtc + (size_t)(b * 2 + kvh) * 16384; ldv = 0; ndense = 256;
      out = p.MIX + (size_t)q0 * DM + 512 + qh * 64;
    } else {
      it -= 1472;
      const int b = it / 16, h = (it / 4) % 4, qt = it % 4;
      const int q0 = b * 256 + qt * 64 + wid * 16;
      Q = p.QNc + (size_t)q0 * 256 + h * 64; ldq = 256;
      Kb = p.KNc + (size_t)(b * 4 + h) * 16384; ldk = 0;
      Vt = p.VNtc + (size_t)(b * 4 + h) * 16384; ldv = 0; ndense = 256;
      out = p.MIX + (size_t)q0 * DM + 256 + h * 64;
    }
#ifndef NO_ATT
    attn_wave(Q, ldq, Kb, ldk, Vt, ldv, ndense, na, rpb, grow, cq0, out, DM, tidx);
#endif
  }
}

__device__ void rwkv_fin_phase(const Params& p, int layer, int bid, int nblk, int tidx) {
  const int tid = tidx;
  const float lw = p.in[21][(size_t)layer * 256 + tid], lb = p.in[22][(size_t)layer * 256 + tid];
  for (int tok = bid; tok < NTOK; tok += nblk) {
    const size_t i = (size_t)tok * 256 + tid;
    const float o = p.OF[i] + p.OB[i];
    const float mu = wave_sum(o) * (1.f / 64.f);
    const float d = o - mu;
    const float var = wave_sum(d * d) * (1.f / 64.f);
    const float y = (d * rsqrtf(var + 64e-5f) * lw + lb + p.BV[i]) * p.G[i];
    p.MIX[(size_t)tok * DM + tid] = f2bf(y);
  }
}

#ifndef ONLY_PH
#define ONLY_PH -1
#endif
#define PH_EN(x) (ONLY_PH < 0 || ONLY_PH == (x))
__device__ __forceinline__ void run_phase(const Params& p, int ph, char* smem, int bid, int nblk, int tidx) {
  if (ph == 0) { if (PH_EN(0)) setup_phase(p, smem, bid, nblk, tidx); return; }
  if (ph == 1) { if (PH_EN(1)) modreduce_phase(p, bid, nblk, tidx); return; }
  if (ph == 2) { if (PH_EN(2)) ln_phase<0>(p, 0, bid, nblk, tidx); return; }
  const int layer = (ph - 3) / 9, s = (ph - 3) % 9;
  switch (s) {
    case 0: if (PH_EN(3)) gemm_phase<EPI_PROJ, 256, 3>(p, layer, p.A, p.winT + (size_t)layer * DIN * DM, DIN, DM, smem, bid, nblk, tidx); break;
    case 1: if (PH_EN(4)) prep_phase(p, layer, smem, bid, nblk, tidx); break;
    case 2: if (PH_EN(5)) mixer_phase(p, layer, smem, tidx); break;
    case 3: if (PH_EN(6)) rwkv_fin_phase(p, layer, bid, nblk, tidx); break;
    case 4: if (PH_EN(7)) gemm_phase<EPI_OUT, 96, 5>(p, layer, p.MIX, p.woutT + (size_t)layer * DM * DM, DM, DM, smem, bid, nblk, tidx); break;
    case 5: if (PH_EN(8)) ln_phase<1>(p, layer, bid, nblk, tidx); break;
    case 6: if (PH_EN(9)) gemm_phase<EPI_FFI, 192, 3>(p, layer, p.A, p.wfiT + (size_t)layer * 2 * DFF * DM, 2 * DFF, DM, smem, bid, nblk, tidx); break;
    case 7: if (PH_EN(10)) gemm_phase<EPI_FFO, 96, 5>(p, layer, p.ACT, p.wfoT + (size_t)layer * DM * DFF, DM, DFF, smem, bid, nblk, tidx); break;
    default: if (PH_EN(11)) ln_phase<2>(p, layer, bid, nblk, tidx); break;
  }
}

__global__ void __launch_bounds__(256, 2) fwd_kernel(Params p, int ph0, int ph1, int usebar) {
  __shared__ __attribute__((aligned(16))) char smem[73728 + 16];
  const int bid = blockIdx.x, nblk = gridDim.x;
  XcdBarrier xb;
  if (usebar && p.never) cg::this_grid().sync();
  if (usebar) {
    if (threadIdx.x == 0) *reinterpret_cast<uint4*>(smem + 73728) = make_uint4(0u, 0u, 0u, 0u);
    __syncthreads();
    xb = xcd_barrier_post(p.bar, (volatile LAS unsigned*)(smem + 73728));
  }
  for (int ph = ph0; ph < ph1; ++ph) {
    int tidx = threadIdx.x;
    asm volatile("" : "+v"(tidx));
    run_phase(p, ph, smem, bid, nblk, tidx);
#if REPMASK
    {
      const int slot_ = ph < 3 ? 9 + ph : (ph - 3) % 9;
      if ((REPMASK >> slot_) & 1) {
        if (usebar) xcd_barrier(xb);
        Params p2 = p; p2.wq = p.wq + 4; p2.pad = REPVAR;
        if (REPVAR >= 5) { p2.OF = p.PROJ; p2.OB = p.PROJ; p2.out_st = p.PROJ + 4000000; p2.MIX = (u16*)(p.PROJ + 8000000); }
        run_phase(p2, ph, smem, bid, nblk, tidx);
      }
    }
#endif
    if (usebar && ph + 1 < ph1) xcd_barrier(xb);
  }
}

static inline size_t al256(size_t x) { return (x + 255) & ~(size_t)255; }

extern "C" void kernel_launch(void* const* d_in, const int* in_sizes, int n_in, void* d_out, int out_size, void* d_ws, size_t ws_size,
                              hipStream_t stream) {
  Params p;
  memset(&p, 0, sizeof(p));
  for (int i = 0; i < 33; ++i) p.in[i] = (const float*)d_in[i];
  float* o = (float*)d_out;
  p.out_yp = o; o += 4194304;
  p.out_ys = o; o += 2097152;
  p.out_st = o; o += 2097152;
  p.out_nak = o; o += 4194304;
  p.out_nav = o; o += 4194304;
  p.out_gk = o; o += 2097152;
  p.out_gv = o;
  char* w = (char*)d_ws; size_t off = 0;
  auto take = [&](size_t bytes) { char* r = w + off; off += al256(bytes); return r; };
  p.bar = (unsigned*)take(16384);
  p.wq = p.bar + 3584;
  p.modp = (float*)take((size_t)4 * 32 * 3 * 6144 * 4);
  p.mod = (float*)take((size_t)4 * 3 * 6144 * 4);
  p.winT = (u16*)take((size_t)4 * DIN * DM * 2);
  p.woutT = (u16*)take((size_t)4 * DM * DM * 2);
  p.wfiT = (u16*)take((size_t)4 * 2 * DFF * DM * 2);
  p.wfoT = (u16*)take((size_t)4 * DM * DFF * 2);
  p.X = (float*)take((size_t)NTOK * DM * 4);
  p.PROJ = (float*)take((size_t)NTOK * DIN * 4);
  p.X1 = p.PROJ;
  p.Y = p.PROJ + (size_t)NTOK * DM;
  p.SC = (float*)take((size_t)NTOK * 4 * 9 * 64 * 4);
  p.ACT = (u16*)p.SC;
  p.G = (float*)take((size_t)NTOK * 256 * 4);
  p.BV = (float*)take((size_t)NTOK * 256 * 4);
  p.OF = (float*)take((size_t)NTOK * 256 * 4);
  p.OB = (float*)take((size_t)NTOK * 256 * 4);
  p.A = (u16*)take((size_t)NTOK * DM * 2);
  p.MIX = (u16*)take((size_t)NTOK * DM * 2);
  p.QNc = (u16*)take((size_t)NCTX * 256 * 2);
  p.KNc = (u16*)take((size_t)NCTX * 256 * 2);
  p.VNtc = (u16*)take((size_t)NCTX * 256 * 2);
  p.QGc = (u16*)take((size_t)NCTX * 512 * 2);
  p.KGc = (u16*)take((size_t)NCTX * 128 * 2);
  p.VGtc = (u16*)take((size_t)NCTX * 128 * 2);
  p.QNl = (u16*)take((size_t)2048 * 256 * 2);
  p.KNl = (u16*)take((size_t)4 * 2 * 1536 * 256 * 2);
  p.VNtl = (u16*)take((size_t)4 * 2 * 1536 * 256 * 2);
  p.QGl = (u16*)take((size_t)2048 * 512 * 2);
  p.KGl = (u16*)take((size_t)4 * 2 * 1536 * 128 * 2);
  p.VGtl = (u16*)take((size_t)4 * 2 * 1536 * 128 * 2);
  p.loraT = (u16*)take((size_t)4 * 98304 * 2);
  p.rope = (float*)take((size_t)64 * 16 * 2 * 4);
  if (off > ws_size) { fprintf(stderr, "workspace too small: need %zu have %zu\n", off, ws_size); return; }

  (void)hipMemsetAsync(p.bar, 0, 16384, stream);
#if MEGA
  static int grid_blocks = 0;
  if (!grid_blocks) {
    int dev = 0, cus = 0, per_cu = 0;
    hipGetDevice(&dev);
    hipDeviceGetAttribute(&cus, hipDeviceAttributeMultiprocessorCount, dev);
    hipOccupancyMaxActiveBlocksPerMultiprocessor(&per_cu, fwd_kernel, 256, 0);
    if (per_cu > 2) per_cu = 2;
    if (per_cu < 1) per_cu = 1;
    grid_blocks = cus * per_cu;
  }
  int ph0 = 0, ph1 = NPH, ub = 1;
  void* args[] = {&p, &ph0, &ph1, &ub};
  hipError_t e = hipLaunchCooperativeKernel((void*)fwd_kernel, dim3(grid_blocks), dim3(256), args, 0, stream);
  if (e != hipSuccess) fprintf(stderr, "cooperative launch failed: %s (grid %d)\n", hipGetErrorString(e), grid_blocks);
#else
  for (int ph = 0; ph < NPH; ++ph) fwd_kernel<<<512, 256, 0, stream>>>(p, ph, ph + 1, 0);
#endif
}
```

```cpp
#include <hip/hip_runtime.h>
#include <hip/hip_cooperative_groups.h>
#include <cstdio>
#include <cstdint>
#include <cstring>
namespace cg = cooperative_groups;

#ifndef REPMASK
#define REPMASK 0
#endif
#ifndef REPVAR
#define REPVAR 0
#endif
#ifndef MEGA
#define MEGA 1
#endif

typedef unsigned short u16;
using bf16x8 = __attribute__((ext_vector_type(8))) short;
using f32x4 = __attribute__((ext_vector_type(4))) float;

#define NTOK 6144
#define NCTX 4096
#define DM 1024
#define DIN 2688
#define DFF 2816
#define NPH 39
#define ALPHA 1.681792830507429f
#define LOG2E 1.4426950408889634f
#define QSCALE (0.125f * LOG2E)

struct Params {
  const float* in[33];
  float *out_yp, *out_ys, *out_st, *out_nak, *out_nav, *out_gk, *out_gv;
  unsigned *bar, *wq;
  float *modp, *mod;
  u16 *winT, *woutT, *wfiT, *wfoT;
  float *X, *X1, *Y, *PROJ, *SC, *G, *BV, *OF, *OB;
  u16 *A, *MIX, *ACT;
  u16 *QNc, *KNc, *VNtc, *QGc, *KGc, *VGtc;
  u16 *QNl, *KNl, *VNtl, *QGl, *KGl, *VGtl;
  u16* loraT; float* rope;
  int never; int pad;
};

__device__ __forceinline__ u16 f2bf(float f) {
  unsigned u = __float_as_uint(f);
  u += 0x7FFFu + ((u >> 16) & 1u);
  return (u16)(u >> 16);
}
__device__ __forceinline__ unsigned pack2(float a, float b) { return (unsigned)f2bf(a) | ((unsigned)f2bf(b) << 16); }
template <int CTRL> __device__ __forceinline__ float dpp_mov(float v) {
  return __int_as_float(__builtin_amdgcn_update_dpp(0, __float_as_int(v), CTRL, 0xF, 0xF, false));
}
__device__ __forceinline__ float reduce16(float v) {
  v += dpp_mov<0xB1>(v);
  v += dpp_mov<0x4E>(v);
  v += dpp_mov<0x141>(v);
  v += dpp_mov<0x140>(v);
  return v;
}
__device__ __forceinline__ float wave_sum(float v) {
  v = reduce16(v);
  v += __shfl_xor(v, 16);
  v += __shfl_xor(v, 32);
  return v;
}
__device__ __forceinline__ float sigmoidf_(float x) { return 1.f / (1.f + __expf(-x)); }
__device__ __forceinline__ float siluf_(float x) { return x / (1.f + __expf(-x)); }
__device__ __forceinline__ int modrow_of(int tok) { return tok < NCTX ? 0 : 1 + ((tok - NCTX) >> 10); }

#define XB_TMO      128
#define XB_XCNT(j)  (256  + 64 * (j))
#define XB_XSUB(j)  (1280 + 64 * (j))
#define XB_XGEN(j)  (2304 + 64 * (j))
#define XB_TOP      3328
#define XB_TOPGEN   3392
#define XCD_BAR_WORDS 3456
#define XB_SPIN_CAP (1u << 22)
#define LAS __attribute__((address_space(3)))
__device__ __forceinline__ unsigned xb_ld(unsigned* p) { return __hip_atomic_load(p, __ATOMIC_RELAXED, __HIP_MEMORY_SCOPE_AGENT); }
__device__ __forceinline__ unsigned xb_add(unsigned* p, unsigned v) { return __hip_atomic_fetch_add(p, v, __ATOMIC_RELAXED, __HIP_MEMORY_SCOPE_AGENT); }
__device__ __forceinline__ unsigned xb_xcc_id() { return (unsigned)__builtin_amdgcn_s_getreg((3 << 11) | 20) & 0xFu; }
#define XB_SPIN(cond, bar) do { unsigned _sp = 0; while (cond) { __builtin_amdgcn_s_sleep(1); \
    if ((++_sp & 255u) == 0u) { if (xb_ld(&(bar)[XB_TMO])) break; if (_sp > XB_SPIN_CAP) { atomicAdd(&(bar)[XB_TMO], 1u); break; } } } } while (0)
struct XcdBarrier { unsigned* bar; unsigned x; volatile LAS unsigned* st; };
__device__ __forceinline__ XcdBarrier xcd_barrier_post(unsigned* bar, volatile LAS unsigned* st) {
  XcdBarrier b; b.bar = bar; b.x = xb_xcc_id(); b.st = st;
  if (threadIdx.x == 0) (void)xb_add(&bar[XB_XCNT(b.x)], 1u);
  return b;
}
__device__ __forceinline__ void xcd_barrier_complete(unsigned* bar, unsigned x, unsigned& nloc, unsigned& nx) {
  const unsigned G = gridDim.x * gridDim.y * gridDim.z;
  unsigned sum, cnt, mine, sp = 0u;
  for (;;) {
    sum = 0u; cnt = 0u; mine = 0u;
#pragma unroll
    for (unsigned j = 0; j < 16; ++j) { const unsigned c = xb_ld(&bar[XB_XCNT(j)]); sum += c; cnt += (c > 0u) ? 1u : 0u; mine = (j == x) ? c : mine; }
    if (sum == G) break;
    __builtin_amdgcn_s_sleep(1);
    if ((++sp & 255u) == 0u) { if (xb_ld(&bar[XB_TMO])) break; if (sp > XB_SPIN_CAP) { atomicAdd(&bar[XB_TMO], 1u); break; } }
  }
  nloc = mine > 0u ? mine : 1u; nx = cnt > 0u ? cnt : 1u;
}
__device__ __forceinline__ void xcd_barrier(const XcdBarrier& b) {
  asm volatile("s_waitcnt vmcnt(0)" ::: "memory");
  __syncthreads();
  if (threadIdx.x == 0) {
    unsigned* bar = b.bar;
    asm volatile("" : "+s"(bar));
    __builtin_amdgcn_s_waitcnt(0);
    unsigned nloc = b.st[0], nx = b.st[1];
    if (nloc == 0u) { xcd_barrier_complete(bar, b.x, nloc, nx); b.st[0] = nloc; b.st[1] = nx; }
    const unsigned old = xb_add(&bar[XB_XSUB(b.x)], 1u);
    const unsigned gen = old / nloc;
    if (old + 1u == (gen + 1u) * nloc) {
      __builtin_amdgcn_fence(__ATOMIC_RELEASE, "agent");
      asm volatile("s_waitcnt vmcnt(0)" ::: "memory");
      const unsigned og = xb_add(&bar[XB_TOP], 1u);
      const unsigned tg = og / nx;
      if (og + 1u == (tg + 1u) * nx) xb_add(&bar[XB_TOPGEN], 1u);
      else XB_SPIN(xb_ld(&bar[XB_TOPGEN]) == tg, bar);
      __builtin_amdgcn_fence(__ATOMIC_ACQUIRE, "agent");
      xb_add(&bar[XB_XGEN(b.x)], 1u);
      asm volatile("s_waitcnt vmcnt(0)" ::: "memory");
    } else {
      XB_SPIN(xb_ld(&bar[XB_XGEN(b.x)]) == gen, bar);
      __builtin_amdgcn_fence(__ATOMIC_ACQUIRE, "agent");
      asm volatile("s_waitcnt vmcnt(0)" ::: "memory");
    }
  }
  __syncthreads();
}

__device__ __forceinline__ int lds_byte32(int r, int c) {
  const int ob = (r & 15) * 64 + c * 2;
  return (r >> 4) * 1024 + (ob ^ (((ob >> 9) & 1) << 5));
}
__device__ __forceinline__ void stage_rc32(int b, int& R, int& C) {
  const int sb = b & 1023, swz = sb ^ (((sb >> 9) & 1) << 5);
  R = (b >> 10) * 16 + (swz >> 6); C = (swz & 63) >> 1;
}
template <int ROWS>
__device__ __forceinline__ void stage_tile32(const u16* __restrict__ g, int ld, char* lds, int tidx) {
#pragma unroll
  for (int i = 0; i < (ROWS * 64 + 4095) / 4096; ++i) {
    const int b = tidx * 16 + i * 4096;
    if ((i + 1) * 4096 <= ROWS * 64 || tidx < (ROWS * 64 - i * 4096) / 16) {
      int R, C; stage_rc32(b, R, C);
      __builtin_amdgcn_global_load_lds((const unsigned*)(g + (size_t)R * ld + C), (unsigned LAS*)(lds + b), 16, 0, 0);
    }
  }
}
template <int N> __device__ __forceinline__ void wait_vmcnt() {
  if (N == 0) asm volatile("s_waitcnt vmcnt(0)" ::: "memory");
  else if (N == 3) asm volatile("s_waitcnt vmcnt(3)" ::: "memory");
  else if (N == 4) asm volatile("s_waitcnt vmcnt(4)" ::: "memory");
  else if (N == 5) asm volatile("s_waitcnt vmcnt(5)" ::: "memory");
  else if (N == 6) asm volatile("s_waitcnt vmcnt(6)" ::: "memory");
  else if (N == 8) asm volatile("s_waitcnt vmcnt(8)" ::: "memory");
  else if (N == 9) asm volatile("s_waitcnt vmcnt(9)" ::: "memory");
  else if (N == 10) asm volatile("s_waitcnt vmcnt(10)" ::: "memory");
  else if (N == 12) asm volatile("s_waitcnt vmcnt(12)" ::: "memory");
  else asm volatile("s_waitcnt vmcnt(0)" ::: "memory");
}

enum { EPI_PROJ = 0, EPI_OUT = 1, EPI_FFI = 2, EPI_FFO = 3 };

template <int EPI, int BM, int NST>
__device__ __forceinline__ void gemm_phase(const Params& p, int layer, const u16* __restrict__ A, const u16* __restrict__ Bt,
                                           int N, int K, char* smem, int bid, int nblk, int tidx) {
  constexpr int MF = BM / 32;
  const int tid = tidx, lane = tid & 63, wid = tid >> 6, wr = wid >> 1, wc = wid & 1, fr = lane & 15, fq = lane >> 4;
  const int nM = NTOK / BM, nN = N / 128, ntiles = nM * nN, nk = K / 32;
  constexpr int SB = (BM + 128) * 64;
  constexpr int LA = (BM * 64) / 4096;
  const bool extraA = (BM == 96) && (wid < 2);
  for (int tile = bid; tile < ntiles; tile += nblk) {
    const int pm = tile % nM, pn = tile / nM, m0 = pm * BM, n0 = pn * 128;
    f32x4 acc[MF][4];
#pragma unroll
    for (int m = 0; m < MF; ++m)
#pragma unroll
      for (int n = 0; n < 4; ++n) acc[m][n] = (f32x4){0.f, 0.f, 0.f, 0.f};
    const u16* Ag = A + (size_t)m0 * K;
    const u16* Bg = Bt + (size_t)n0 * K;
#pragma unroll
    for (int s_ = 0; s_ < NST - 1; ++s_) {
      stage_tile32<BM>(Ag + s_ * 32, K, smem + s_ * SB, tidx);
      stage_tile32<128>(Bg + s_ * 32, K, smem + s_ * SB + BM * 64, tidx);
    }
    int slot = 0, pslot = NST - 1;
    for (int kt = 0; kt < nk; ++kt) {
      if (kt + NST - 2 < nk) {
        if (BM == 96) { if (extraA) wait_vmcnt<(NST - 2) * 4>(); else wait_vmcnt<(NST - 2) * 3>(); }
        else wait_vmcnt<(NST - 2) * (LA + 2)>();
      } else {
        asm volatile("s_waitcnt vmcnt(0)" ::: "memory");
      }
      __builtin_amdgcn_s_barrier();
      if (kt + NST - 1 < nk) {
        char* nb = smem + pslot * SB;
        stage_tile32<BM>(Ag + (kt + NST - 1) * 32, K, nb, tidx);
        stage_tile32<128>(Bg + (kt + NST - 1) * 32, K, nb + BM * 64, tidx);
      }
      const char* sa = smem + slot * SB;
      const char* sb = sa + BM * 64;
      slot = (slot + 1 == NST) ? 0 : slot + 1;
      pslot = (pslot + 1 == NST) ? 0 : pslot + 1;
      bf16x8 af[MF], bfr[4];
#pragma unroll
      for (int m = 0; m < MF; ++m) af[m] = *reinterpret_cast<const bf16x8*>(sa + lds_byte32(wr * (BM / 2) + m * 16 + fr, fq * 8));
#pragma unroll
      for (int n = 0; n < 4; ++n) bfr[n] = *reinterpret_cast<const bf16x8*>(sb + lds_byte32(wc * 64 + n * 16 + fr, fq * 8));
#pragma unroll
      for (int m = 0; m < MF; ++m)
#pragma unroll
        for (int n = 0; n < 4; ++n) acc[m][n] = __builtin_amdgcn_mfma_f32_16x16x32_bf16(bfr[n], af[m], acc[m][n], 0, 0, 0);
    }
#pragma unroll
    for (int m = 0; m < MF; ++m) {
      const int row = m0 + wr * (BM / 2) + m * 16 + fr;
      if (EPI == EPI_PROJ) {
#pragma unroll
        for (int n = 0; n < 4; ++n) {
          const int col = n0 + wc * 64 + n * 16 + 4 * fq;
          *reinterpret_cast<float4*>(p.PROJ + (size_t)row * DIN + col) = make_float4(acc[m][n][0], acc[m][n][1], acc[m][n][2], acc[m][n][3]);
        }
      } else if (EPI == EPI_OUT || EPI == EPI_FFO) {
        const float* res = (EPI == EPI_OUT) ? p.X : p.X1;
        const float* gate = p.mod + ((size_t)(layer * 3 + modrow_of(row)) * 6 + (EPI == EPI_OUT ? 2 : 5)) * 1024;
#pragma unroll
        for (int n = 0; n < 4; ++n) {
          const int col = n0 + wc * 64 + n * 16 + 4 * fq;
          const float4 xr = *reinterpret_cast<const float4*>(res + (size_t)row * DM + col);
          const float4 gt = *reinterpret_cast<const float4*>(gate + col);
          float4 y;
          y.x = ALPHA * xr.x + gt.x * acc[m][n][0];
          y.y = ALPHA * xr.y + gt.y * acc[m][n][1];
          y.z = ALPHA * xr.z + gt.z * acc[m][n][2];
          y.w = ALPHA * xr.w + gt.w * acc[m][n][3];
          *reinterpret_cast<float4*>(p.Y + (size_t)row * DM + col) = y;
        }
      } else {
#pragma unroll
        for (int n2 = 0; n2 < 2; ++n2) {
          const int j0 = ((n0 + wc * 64) / 32 + n2) * 16 + 4 * fq;
          float a[4];
#pragma unroll
          for (int r = 0; r < 4; ++r) a[r] = siluf_(acc[m][2 * n2][r]) * acc[m][2 * n2 + 1][r];
          uint2 pk; pk.x = pack2(a[0], a[1]); pk.y = pack2(a[2], a[3]);
          *reinterpret_cast<uint2*>(p.ACT + (size_t)row * DFF + j0) = pk;
        }
      }
    }
    asm volatile("s_waitcnt lgkmcnt(0)" ::: "memory");
    __builtin_amdgcn_s_barrier();
  }
}

__device__ __forceinline__ int kf_off(int t, int d) { return (t >> 4) * 1024 + (d >> 5) * 512 + ((d & 31) >> 3) * 128 + (t & 15) * 8 + (d & 7); }
__device__ __forceinline__ int vf_off(int t, int d) { return (t >> 5) * 2048 + (d >> 4) * 512 + (((t & 15) >> 2) * 16 + (d & 15)) * 8 + ((t >> 4) & 1) * 4 + (t & 3); }
__device__ __forceinline__ void pack44_store(u16* base, int t0, int d, const float* v) {
  uint2 a, b; a.x = pack2(v[0], v[1]); a.y = pack2(v[2], v[3]); b.x = pack2(v[4], v[5]); b.y = pack2(v[6], v[7]);
  *reinterpret_cast<uint2*>(base + vf_off(t0, d)) = a;
  *reinterpret_cast<uint2*>(base + vf_off(t0 + 4, d)) = b;
}
__device__ __forceinline__ void pack8_store(u16* dst, const float* v) {
  uint4 pk; pk.x = pack2(v[0], v[1]); pk.y = pack2(v[2], v[3]); pk.z = pack2(v[4], v[5]); pk.w = pack2(v[6], v[7]);
  *reinterpret_cast<uint4*>(dst) = pk;
}

__device__ void setup_phase(const Params& p, char* smem, int bid, int nblk, int tidx) {
  const int tid = tidx;
  const int NI = 768 + 512 + 13;
  for (int it = bid; it < NI; it += nblk) {
    if (it < 768) {
      const int l = it / 192, nc = (it / 32) % 6, kc = it % 32;
      const int col = nc * 1024 + tid * 4;
      const float* wm = p.in[9] + (size_t)l * 1024 * 6144;
      float4 a0 = make_float4(0, 0, 0, 0), a1 = a0, a2 = a0;
      for (int kk = 0; kk < 32; ++kk) {
        const int k = kc * 32 + kk;
        const float s0 = siluf_(p.in[8][k]), s1 = siluf_(p.in[7][k]), s2 = siluf_(p.in[7][1024 + k]);
        const float4 w = *reinterpret_cast<const float4*>(wm + (size_t)k * 6144 + col);
        a0.x += s0 * w.x; a0.y += s0 * w.y; a0.z += s0 * w.z; a0.w += s0 * w.w;
        a1.x += s1 * w.x; a1.y += s1 * w.y; a1.z += s1 * w.z; a1.w += s1 * w.w;
        a2.x += s2 * w.x; a2.y += s2 * w.y; a2.z += s2 * w.z; a2.w += s2 * w.w;
      }
      float* dst = p.modp + (size_t)((l * 32 + kc) * 3) * 6144 + col;
      *reinterpret_cast<float4*>(dst) = a0;
      *reinterpret_cast<float4*>(dst + 6144) = a1;
      *reinterpret_cast<float4*>(dst + 2 * 6144) = a2;
    } else if (it < 1280) {
      const int ci = it - 768, b = ci / 256, l = (ci / 64) % 4, tg = ci % 64, t0 = tg * 8;
      {
        const float* ck = p.in[3] + ((size_t)(b * 4 + l) * 512 + t0) * 256 + tid;
        const float* cv = p.in[4] + ((size_t)(b * 4 + l) * 512 + t0) * 256 + tid;
        float v[8];
#pragma unroll
        for (int tt = 0; tt < 8; ++tt) {
          p.KNl[((size_t)((l * 2 + b) * 4 + (tid >> 6))) * 98304 + kf_off(t0 + tt, tid & 63)] = f2bf(ck[tt * 256]);
          v[tt] = cv[tt * 256];
        }
        pack44_store(p.VNtl + ((size_t)((l * 2 + b) * 4 + (tid >> 6))) * 98304, t0, tid & 63, v);
      }
      if (tid < 128) {
        const float* ck = p.in[5] + ((size_t)(b * 4 + l) * 512 + t0) * 128 + tid;
#pragma unroll
        for (int tt = 0; tt < 8; ++tt) p.KGl[((size_t)((l * 2 + b) * 2 + (tid >> 6))) * 98304 + kf_off(t0 + tt, tid & 63)] = f2bf(ck[tt * 128]);
      } else {
        const int c = tid - 128;
        const float* cv = p.in[6] + ((size_t)(b * 4 + l) * 512 + t0) * 128 + c;
        float v[8];
#pragma unroll
        for (int tt = 0; tt < 8; ++tt) v[tt] = cv[tt * 128];
        pack44_store(p.VGtl + ((size_t)((l * 2 + b) * 2 + (c >> 6))) * 98304, t0, c & 63, v);
      }
    } else {
      const int li = it - (768 + 512);
      if (li == 12) {
        for (int idx = tid; idx < 1024; idx += 256) {
          const int pos = idx >> 4, fi = idx & 15;
          const float ang = (float)pos * exp2f(-(float)fi * (13.287712379549449f / 16.f));
          p.rope[idx * 2] = cosf(ang); p.rope[idx * 2 + 1] = sinf(ang);
        }
      } else {
        const int l = li / 3, m = li % 3;
        u16* dst = p.loraT + (size_t)l * 98304 + m * 32768;
        if (m < 2) {
          const float* src = p.in[m == 0 ? 14 : 16] + (size_t)l * 32768;
          for (int idx = tid; idx < 32768; idx += 256) {
            const int d = idx >> 14, cch = (idx >> 6) & 255, r = idx & 63;
            dst[idx] = f2bf(src[(d * 64 + r) * 256 + cch]);
          }
        } else {
          const float* src = p.in[17] + (size_t)l * 32768;
          for (int idx = tid; idx < 32768; idx += 256) {
            const int cch = idx >> 7, j = idx & 127;
            dst[idx] = f2bf(src[j * 256 + cch]);
          }
        }
      }
    }
  }
  {
    float* tile = reinterpret_cast<float*>(smem);
    const int NT = 4 * 3040;
    float4 cur0, cur1, cur2, cur3;
    const float* src; u16* dst; int K, N, mat, k0, n0;
#define TR_DECODE(TR) { const int l_ = (TR) / 3040; int r_ = (TR) % 3040; int kt_, nt_; \
      if (r_ < 672) { mat = 0; K = 1024; N = 2688; src = p.in[11] + (size_t)l_ * K * N; dst = p.winT + (size_t)l_ * N * K; kt_ = r_ / 42; nt_ = r_ % 42; } \
      else if (r_ < 928) { r_ -= 672; mat = 1; K = 1024; N = 1024; src = p.in[26] + (size_t)l_ * K * N; dst = p.woutT + (size_t)l_ * N * K; kt_ = r_ / 16; nt_ = r_ % 16; } \
      else if (r_ < 2336) { r_ -= 928; mat = 2; K = 1024; N = 5632; src = p.in[29] + (size_t)l_ * K * N; dst = p.wfiT + (size_t)l_ * N * K; kt_ = r_ / 88; nt_ = r_ % 88; } \
      else { r_ -= 2336; mat = 3; K = 2816; N = 1024; src = p.in[30] + (size_t)l_ * K * N; dst = p.wfoT + (size_t)l_ * N * K; kt_ = r_ / 16; nt_ = r_ % 16; } \
      k0 = kt_ * 64; n0 = nt_ * 64; }
#define TR_LOAD(V, I) V = *reinterpret_cast<const float4*>(src + (size_t)(k0 + (tid >> 4) + 16 * (I)) * N + n0 + (tid & 15) * 4);
#define TR_PUT(V, I) { const int kr_ = (tid >> 4) + 16 * (I), c4_ = (tid & 15) * 4; \
      tile[kr_ * 65 + c4_ + 0] = V.x; tile[kr_ * 65 + c4_ + 1] = V.y; tile[kr_ * 65 + c4_ + 2] = V.z; tile[kr_ * 65 + c4_ + 3] = V.w; }
    int tr = bid;
    if (tr < NT) { TR_DECODE(tr) TR_LOAD(cur0, 0) TR_LOAD(cur1, 1) TR_LOAD(cur2, 2) TR_LOAD(cur3, 3) }
    for (; tr < NT; tr += nblk) {
      TR_PUT(cur0, 0) TR_PUT(cur1, 1) TR_PUT(cur2, 2) TR_PUT(cur3, 3)
      if (tr + nblk < NT) { TR_DECODE(tr + nblk) TR_LOAD(cur0, 0) TR_LOAD(cur1, 1) TR_LOAD(cur2, 2) TR_LOAD(cur3, 3) }
      TR_DECODE(tr)
      __syncthreads();
#pragma unroll
      for (int i = 0; i < 2; ++i) {
        const int idx = tid + 256 * i, nl = idx >> 3, kc = idx & 7;
        int n = n0 + nl;
        if (mat == 2) { const int isup = n >= DFF ? 1 : 0; const int j = n - isup * DFF; n = (j >> 4) * 32 + isup * 16 + (j & 15); }
        float v[8];
#pragma unroll
        for (int jj = 0; jj < 8; ++jj) v[jj] = tile[(kc * 8 + jj) * 65 + nl];
        pack8_store(dst + (size_t)n * K + k0 + kc * 8, v);
      }
      __syncthreads();
    }
#undef TR_DECODE
#undef TR_LOAD
#undef TR_PUT
  }
}

__device__ void modreduce_phase(const Params& p, int bid, int nblk, int tidx) {
  for (int idx = bid * 256 + tidx; idx < 18432; idx += nblk * 256) {
    const int l = idx / 4608, rem = idx % 4608, mr = rem / 1536, c4 = (rem % 1536) * 4;
    float4 a = *reinterpret_cast<const float4*>(p.in[10] + (size_t)l * 6144 + c4);
    for (int kc = 0; kc < 32; ++kc) {
      const float4 v = *reinterpret_cast<const float4*>(p.modp + (size_t)((l * 32 + kc) * 3 + mr) * 6144 + c4);
      a.x += v.x; a.y += v.y; a.z += v.z; a.w += v.w;
    }
    *reinterpret_cast<float4*>(p.mod + (size_t)(l * 3 + mr) * 6144 + c4) = a;
  }
}

template <int MODE>
__device__ void ln_phase(const Params& p, int layer, int bid, int nblk, int tidx) {
  const int lane = tidx & 63, wid = tidx >> 6;
  for (int it = bid; it < NTOK / 4; it += nblk) {
    const int row = it * 4 + wid;
    const float* src;
    if (MODE == 0) src = row < NCTX ? p.in[0] + (size_t)row * DM : p.in[1] + (size_t)(row - NCTX) * DM;
    else src = p.Y + (size_t)row * DM;
    float4 v[4];
#pragma unroll
    for (int i = 0; i < 4; ++i) v[i] = reinterpret_cast<const float4*>(src)[lane + 64 * i];
    if (MODE != 0) {
      float s = 0.f;
#pragma unroll
      for (int i = 0; i < 4; ++i) s += v[i].x + v[i].y + v[i].z + v[i].w;
      const float mu = wave_sum(s) * (1.f / 1024.f);
      float q = 0.f;
#pragma unroll
      for (int i = 0; i < 4; ++i) {
        v[i].x -= mu; v[i].y -= mu; v[i].z -= mu; v[i].w -= mu;
        q += v[i].x * v[i].x + v[i].y * v[i].y + v[i].z * v[i].z + v[i].w * v[i].w;
      }
      const float rstd = rsqrtf(wave_sum(q) * (1.f / 1024.f) + 1e-5f);
      const float* lw = (MODE == 1 ? p.in[27] : p.in[31]) + (size_t)layer * DM;
      const float* lb = (MODE == 1 ? p.in[28] : p.in[32]) + (size_t)layer * DM;
#pragma unroll
      for (int i = 0; i < 4; ++i) {
        const float4 w = reinterpret_cast<const float4*>(lw)[lane + 64 * i];
        const float4 b = reinterpret_cast<const float4*>(lb)[lane + 64 * i];
        v[i].x = v[i].x * rstd * w.x + b.x; v[i].y = v[i].y * rstd * w.y + b.y;
        v[i].z = v[i].z * rstd * w.z + b.z; v[i].w = v[i].w * rstd * w.w + b.w;
      }
    }
    float* xdst = (MODE == 1 ? p.X1 : p.X) + (size_t)row * DM;
#pragma unroll
    for (int i = 0; i < 4; ++i) reinterpret_cast<float4*>(xdst)[lane + 64 * i] = v[i];
    if (MODE == 2 && layer == 3) {
      float* o = row < NCTX ? p.out_yp + (size_t)row * DM : p.out_ys + (size_t)(row - NCTX) * DM;
#pragma unroll
      for (int i = 0; i < 4; ++i) reinterpret_cast<float4*>(o)[lane + 64 * i] = v[i];
    } else {
      const int ml = (MODE == 2) ? layer + 1 : layer;
      const int which = (MODE == 1) ? 3 : 0;
      const float* sh = p.mod + ((size_t)(ml * 3 + modrow_of(row)) * 6 + which) * 1024;
      const float* sc = sh + 1024;
      u16* adst = p.A + (size_t)row * DM;
#pragma unroll
      for (int i = 0; i < 4; ++i) {
        const float4 s4 = reinterpret_cast<const float4*>(sh)[lane + 64 * i];
        const float4 c4 = reinterpret_cast<const float4*>(sc)[lane + 64 * i];
        uint2 pk;
        pk.x = pack2(v[i].x * (1.f + c4.x) + s4.x, v[i].y * (1.f + c4.y) + s4.y);
        pk.y = pack2(v[i].z * (1.f + c4.z) + s4.z, v[i].w * (1.f + c4.w) + s4.w);
        reinterpret_cast<uint2*>(adst)[lane + 64 * i] = pk;
      }
    }
  }
}

#define FLD 772
#define LLD 392
__device__ void prep_phase(const Params& p, int layer, char* smem, int bid, int nblk, int tidx) {
  float* F = reinterpret_cast<float*>(smem);
  u16* LIb = reinterpret_cast<u16*>(smem + 16 * FLD * 4);
  const float* cw = p.in[12] + (size_t)layer * 3 * 1152;
  const u16* LW = p.loraT + (size_t)layer * 98304;
  for (int it = bid; it < NTOK / 16; it += nblk) {
    int tid = tidx;
    asm volatile("" : "+v"(tid));
    const int lane = tid & 63, wid = tid >> 6, fr = lane & 15, fq = lane >> 4;
    const int tok0 = it * 16;
    int b, tpos0, L;
    const bool isctx = tok0 < NCTX;
    if (isctx) { b = tok0 >> 8; tpos0 = tok0 & 255; L = 256; }
    else { const int tl = tok0 - NCTX; b = tl >> 10; tpos0 = tl & 1023; L = 1024; }
#pragma unroll 1
    for (int cg = tid; cg < 288; cg += 256) {
      const int c = cg * 4;
      const float4 w0 = *reinterpret_cast<const float4*>(cw + c);
      const float4 w1 = *reinterpret_cast<const float4*>(cw + 1152 + c);
      const float4 w2 = *reinterpret_cast<const float4*>(cw + 2304 + c);
      const float* pr = p.PROJ + (size_t)tok0 * DIN + c;
      float4 x[18];
#pragma unroll
      for (int i = 0; i < 18; ++i) {
        const int tpos = tpos0 + i - 1;
        x[i] = (tpos >= 0 && tpos < L) ? *reinterpret_cast<const float4*>(pr + (ptrdiff_t)(i - 1) * DIN) : make_float4(0.f, 0.f, 0.f, 0.f);
      }
#pragma unroll
      for (int tt = 0; tt < 16; ++tt) {
        float4 f;
        f.x = w0.x * x[tt].x + w1.x * x[tt + 1].x + w2.x * x[tt + 2].x;
        f.y = w0.y * x[tt].y + w1.y * x[tt + 1].y + w2.y * x[tt + 2].y;
        f.z = w0.z * x[tt].z + w1.z * x[tt + 1].z + w2.z * x[tt + 2].z;
        f.w = w0.w * x[tt].w + w1.w * x[tt + 1].w + w2.w * x[tt + 2].w;
        if (c < 768) { *reinterpret_cast<float4*>(F + tt * FLD + c) = f; }
        else {
          const int cc = c - 768;
          if (cc < 128) { f.x = tanhf(f.x); f.y = tanhf(f.y); f.z = tanhf(f.z); f.w = tanhf(f.w); }
          else if (cc >= 256) { f.x = sigmoidf_(f.x); f.y = sigmoidf_(f.y); f.z = sigmoidf_(f.z); f.w = sigmoidf_(f.w); }
          uint2 pk; pk.x = pack2(f.x, f.y); pk.y = pack2(f.z, f.w);
          *reinterpret_cast<uint2*>(LIb + tt * LLD + cc) = pk;
        }
      }
    }
    __syncthreads();
    f32x4 acc[5][4];
#pragma unroll
    for (int g = 0; g < 5; ++g)
#pragma unroll
      for (int nf = 0; nf < 4; ++nf) acc[g][nf] = (f32x4){0.f, 0.f, 0.f, 0.f};
#pragma unroll
    for (int g = 0; g < 4; ++g) {
      const u16* wt = LW + (size_t)g * 16384;
#pragma unroll
      for (int ks = 0; ks < 2; ++ks) {
        const bf16x8 xb = *reinterpret_cast<const bf16x8*>(LIb + fr * LLD + g * 64 + ks * 32 + fq * 8);
#pragma unroll
        for (int nf = 0; nf < 4; ++nf) {
          const bf16x8 wa = *reinterpret_cast<const bf16x8*>(wt + (size_t)(64 * wid + 16 * nf + fr) * 64 + ks * 32 + fq * 8);
          acc[g][nf] = __builtin_amdgcn_mfma_f32_16x16x32_bf16(wa, xb, acc[g][nf], 0, 0, 0);
        }
      }
      __builtin_amdgcn_sched_barrier(0);
    }
    {
      const u16* wt = LW + 65536;
#pragma unroll
      for (int ks = 0; ks < 4; ++ks) {
        const bf16x8 xb = *reinterpret_cast<const bf16x8*>(LIb + fr * LLD + 256 + ks * 32 + fq * 8);
#pragma unroll
        for (int nf = 0; nf < 4; ++nf) {
          const bf16x8 wa = *reinterpret_cast<const bf16x8*>(wt + (size_t)(64 * wid + 16 * nf + fr) * 128 + ks * 32 + fq * 8);
          acc[4][nf] = __builtin_amdgcn_mfma_f32_16x16x32_bf16(wa, xb, acc[4][nf], 0, 0, 0);
        }
        if (ks == 1) __builtin_amdgcn_sched_barrier(0);
      }
      __builtin_amdgcn_sched_barrier(0);
    }
#ifndef NO_C
    {
      const int tok = tok0 + fr;
      float ss = 0.f, bs = 0.f;
#pragma unroll
      for (int nf = 0; nf < 4; ++nf) {
        const int c0 = 64 * wid + 16 * nf + 4 * fq;
        const float4 r4 = *reinterpret_cast<const float4*>(F + fr * FLD + c0);
        const float4 k4 = *reinterpret_cast<const float4*>(F + fr * FLD + 256 + c0);
        const float4 w00 = *reinterpret_cast<const float4*>(p.in[13] + (size_t)layer * 512 + c0);
        const float4 w01 = *reinterpret_cast<const float4*>(p.in[13] + (size_t)layer * 512 + 256 + c0);
        const float4 a00 = *reinterpret_cast<const float4*>(p.in[15] + (size_t)layer * 512 + c0);
        const float4 a01 = *reinterpret_cast<const float4*>(p.in[15] + (size_t)layer * 512 + 256 + c0);
        const float4 kkw = *reinterpret_cast<const float4*>(p.in[18] + (size_t)layer * 256 + c0);
        const float4 kaw = *reinterpret_cast<const float4*>(p.in[19] + (size_t)layer * 256 + c0);
        const float4 rkw = *reinterpret_cast<const float4*>(p.in[20] + (size_t)layer * 256 + c0);
        const float rr[4] = {r4.x, r4.y, r4.z, r4.w}, kk_[4] = {k4.x, k4.y, k4.z, k4.w};
        const float w0a[4] = {w00.x, w00.y, w00.z, w00.w}, w0b[4] = {w01.x, w01.y, w01.z, w01.w};
        const float a0a[4] = {a00.x, a00.y, a00.z, a00.w}, a0b[4] = {a01.x, a01.y, a01.z, a01.w};
        const float kkw_[4] = {kkw.x, kkw.y, kkw.z, kkw.w}, kaw_[4] = {kaw.x, kaw.y, kaw.z, kaw.w}, rkw_[4] = {rkw.x, rkw.y, rkw.z, rkw.w};
#pragma unroll
        for (int r = 0; r < 4; ++r) {
          {
            const float z = -(w0a[r] + acc[0][nf][r]);
            const float sp = fmaxf(z, 0.f) + log1pf(__expf(-fabsf(z)));
            acc[0][nf][r] = __expf(-__expf(-sp - 0.5f));
          }
          {
            const float z = -(w0b[r] + acc[1][nf][r]);
            const float sp = fmaxf(z, 0.f) + log1pf(__expf(-fabsf(z)));
            acc[1][nf][r] = __expf(-__expf(-sp - 0.5f));
          }
          const float av0 = sigmoidf_(a0a[r] + acc[2][nf][r]);
          const float av1 = sigmoidf_(a0b[r] + acc[3][nf][r]);
          acc[2][nf][r] = av0; acc[3][nf][r] = av1;
          const float k = kk_[r];
          const float kq = k * kkw_[r];
          ss += kq * kq;
          const float kd0 = k * (1.f + (av0 - 1.f) * kaw_[r]);
          const float kd1 = k * (1.f + (av1 - 1.f) * kaw_[r]);
          bs += rr[r] * (kd0 + kd1) * rkw_[r];
        }
        __builtin_amdgcn_sched_barrier(0);
      }
      ss += __shfl_xor(ss, 16); ss += __shfl_xor(ss, 32);
      bs += __shfl_xor(bs, 16); bs += __shfl_xor(bs, 32);
      const float inrm = 1.f / fmaxf(sqrtf(ss), 1e-12f);
#pragma unroll
      for (int nf = 0; nf < 4; ++nf) {
        const int c0 = 64 * wid + 16 * nf + 4 * fq, n0 = 16 * nf + 4 * fq;
        const float4 r4 = *reinterpret_cast<const float4*>(F + fr * FLD + c0);
        const float4 k4 = *reinterpret_cast<const float4*>(F + fr * FLD + 256 + c0);
        const float4 v4 = *reinterpret_cast<const float4*>(F + fr * FLD + 512 + c0);
        const float4 kkw = *reinterpret_cast<const float4*>(p.in[18] + (size_t)layer * 256 + c0);
        const float4 kaw = *reinterpret_cast<const float4*>(p.in[19] + (size_t)layer * 256 + c0);
        const float kk_[4] = {k4.x, k4.y, k4.z, k4.w}, kkw_[4] = {kkw.x, kkw.y, kkw.z, kkw.w}, kaw_[4] = {kaw.x, kaw.y, kaw.z, kaw.w};
        float* sc = p.SC + ((size_t)(tok * 4 + wid) * 9) * 64 + n0;
        float kn[4], kd0[4], kd1[4];
#pragma unroll
        for (int r = 0; r < 4; ++r) {
          kn[r] = kk_[r] * kkw_[r] * inrm;
          kd0[r] = kk_[r] * (1.f + (acc[2][nf][r] - 1.f) * kaw_[r]);
          kd1[r] = kk_[r] * (1.f + (acc[3][nf][r] - 1.f) * kaw_[r]);
        }
        *reinterpret_cast<float4*>(sc) = r4;
        *reinterpret_cast<float4*>(sc + 64) = make_float4(kn[0], kn[1], kn[2], kn[3]);
        *reinterpret_cast<float4*>(sc + 128) = v4;
        *reinterpret_cast<float4*>(sc + 192) = make_float4(acc[0][nf][0], acc[0][nf][1], acc[0][nf][2], acc[0][nf][3]);
        *reinterpret_cast<float4*>(sc + 256) = make_float4(acc[2][nf][0] * kn[0], acc[2][nf][1] * kn[1], acc[2][nf][2] * kn[2], acc[2][nf][3] * kn[3]);
        *reinterpret_cast<float4*>(sc + 320) = make_float4(kd0[0], kd0[1], kd0[2], kd0[3]);
        *reinterpret_cast<float4*>(sc + 384) = make_float4(acc[1][nf][0], acc[1][nf][1], acc[1][nf][2], acc[1][nf][3]);
        *reinterpret_cast<float4*>(sc + 448) = make_float4(acc[3][nf][0] * kn[0], acc[3][nf][1] * kn[1], acc[3][nf][2] * kn[2], acc[3][nf][3] * kn[3]);
        *reinterpret_cast<float4*>(sc + 512) = make_float4(kd1[0], kd1[1], kd1[2], kd1[3]);
        *reinterpret_cast<float4*>(p.G + (size_t)tok * 256 + c0) = make_float4(acc[4][nf][0], acc[4][nf][1], acc[4][nf][2], acc[4][nf][3]);
        *reinterpret_cast<float4*>(p.BV + (size_t)tok * 256 + c0) = make_float4(bs * v4.x, bs * v4.y, bs * v4.z, bs * v4.w);
        __builtin_amdgcn_sched_barrier(0);
      }
    }
#endif
#ifndef NO_D
    const int c = tid;
#pragma unroll
    for (int half = 0; half < 2; ++half) {
      float vv[8];
#pragma unroll
      for (int t8 = 0; t8 < 8; ++t8) {
        const int tt = half * 8 + t8, tok = tok0 + tt;
        const float* pr = p.PROJ + (size_t)tok * DIN + 1152 + c;
        const float q = pr[0], k = pr[256], v = pr[512];
        vv[t8] = v;
        if (isctx) {
          const size_t oi = ((size_t)(b * 4 + layer) * 256 + tpos0 + tt) * 256 + c;
          p.out_nak[oi] = k; p.out_nav[oi] = v;
          p.QNc[(size_t)tok * 256 + c] = f2bf(q * QSCALE);
          p.KNc[(size_t)(b * 4 + (c >> 6)) * 16384 + kf_off(tpos0 + tt, c & 63)] = f2bf(k);
        } else {
          p.QNl[(size_t)(tok - NCTX) * 256 + c] = f2bf(q * QSCALE);
          p.KNl[((size_t)((layer * 2 + b) * 4 + (c >> 6))) * 98304 + kf_off(512 + tpos0 + tt, c & 63)] = f2bf(k);
        }
      }
      if (isctx) pack44_store(p.VNtc + (size_t)(b * 4 + (c >> 6)) * 16384, tpos0 + half * 8, c & 63, vv);
      else pack44_store(p.VNtl + ((size_t)((layer * 2 + b) * 4 + (c >> 6))) * 98304, 512 + tpos0 + half * 8, c & 63, vv);
    }
    {
      const float qn = p.in[24][(size_t)layer * 64 + lane], kn = p.in[25][(size_t)layer * 64 + lane];
      const int fi = lane & 15;
#pragma unroll
      for (int half = 0; half < 2; ++half) {
        float vv[8];
#pragma unroll
        for (int t8 = 0; t8 < 8; ++t8) {
          const int tt = half * 8 + t8, tok = tok0 + tt, tpos = tpos0 + tt;
          const float* pr = p.PROJ + (size_t)tok * DIN + 1920;
          float cs = 1.f, sn = 0.f;
          if (!isctx) {
            const int pos = (lane < 32) ? (tpos >> 6) : (tpos & 63);
            const float2 t2 = *reinterpret_cast<const float2*>(p.rope + (size_t)(pos * 16 + fi) * 2);
            cs = t2.x; sn = t2.y;
            if ((lane & 16) == 0) sn = -sn;
          }
#pragma unroll
          for (int hh = 0; hh < 2; ++hh) {
            float q = pr[hh * 256 + c];
            const float ms = wave_sum(q * q) * (1.f / 64.f);
            q = q * rsqrtf(ms + 1e-6f) * qn;
            if (!isctx) { const float qp = __shfl_xor(q, 16); q = q * cs + qp * sn; }
            if (isctx) p.QGc[(size_t)tok * 512 + hh * 256 + c] = f2bf(q * QSCALE);
            else p.QGl[(size_t)(tok - NCTX) * 512 + hh * 256 + c] = f2bf(q * QSCALE);
          }
          if (wid < 2) {
            float k = pr[512 + c];
            const float ms = wave_sum(k * k) * (1.f / 64.f);
            k = k * rsqrtf(ms + 1e-6f) * kn;
            if (isctx) {
              p.out_gk[((size_t)(b * 4 + layer) * 256 + tpos) * 128 + c] = k;
              p.KGc[(size_t)(b * 2 + (c >> 6)) * 16384 + kf_off(tpos, c & 63)] = f2bf(k);
            } else {
              const float kp = __shfl_xor(k, 16); k = k * cs + kp * sn;
              p.KGl[((size_t)((layer * 2 + b) * 2 + (c >> 6))) * 98304 + kf_off(512 + tpos, c & 63)] = f2bf(k);
            }
          } else {
            const int cv = c - 128;
            const float v = pr[640 + cv];
            vv[t8] = v;
            if (isctx) p.out_gv[((size_t)(b * 4 + layer) * 256 + tpos) * 128 + cv] = v;
          }
        }
        if (wid >= 2) {
          const int cv = c - 128;
          if (isctx) pack44_store(p.VGtc + (size_t)(b * 2 + (cv >> 6)) * 16384, tpos0 + half * 8, cv & 63, vv);
          else pack44_store(p.VGtl + ((size_t)((layer * 2 + b) * 2 + (cv >> 6))) * 98304, 512 + tpos0 + half * 8, cv & 63, vv);
        }
      }
    }
#endif
    __syncthreads();
  }
}

#define ATT_LOAD(KF, VF, CI) { \
    const int ci_ = min((CI), nt - 1); \
    int kb_; \
    if (ci_ < nd) kb_ = ci_ * 32; \
    else { const int e_ = ci_ - nd; const int j_ = (ncc == 2) ? (e_ >> 1) : e_; const int cc_ = cc0 + ((ncc == 2) ? (e_ & 1) : 0); kb_ = 512 + (rb + j_) * 64 + cc_ * 32; } \
    const u16* kp_ = Kb + (size_t)(kb_ >> 4) * 1024 + lane * 8; \
    KF##00 = *reinterpret_cast<const bf16x8*>(kp_); \
    KF##01 = *reinterpret_cast<const bf16x8*>(kp_ + 512); \
    KF##10 = *reinterpret_cast<const bf16x8*>(kp_ + 1024); \
    KF##11 = *reinterpret_cast<const bf16x8*>(kp_ + 1536); \
    const u16* vp_ = Vt + (size_t)(kb_ >> 5) * 2048 + lane * 8; \
    VF##0 = *reinterpret_cast<const bf16x8*>(vp_); \
    VF##1 = *reinterpret_cast<const bf16x8*>(vp_ + 512); \
    VF##2 = *reinterpret_cast<const bf16x8*>(vp_ + 1024); \
    VF##3 = *reinterpret_cast<const bf16x8*>(vp_ + 1536); }

#define ATT_PV(DT, VV) { \
    o[DT][0] *= alpha; o[DT][1] *= alpha; o[DT][2] *= alpha; o[DT][3] *= alpha; \
    o[DT] = __builtin_amdgcn_mfma_f32_16x16x32_bf16(VV, pf.v, o[DT], 0, 0, 0); }

#define ATT_COMPUTE(KF, VF, CI) { \
    const int ci_ = (CI); \
    f32x4 s0 = (f32x4){0.f, 0.f, 0.f, 0.f}, s1 = (f32x4){0.f, 0.f, 0.f, 0.f}; \
    s0 = __builtin_amdgcn_mfma_f32_16x16x32_bf16(KF##00, qf0, s0, 0, 0, 0); \
    s0 = __builtin_amdgcn_mfma_f32_16x16x32_bf16(KF##01, qf1, s0, 0, 0, 0); \
    s1 = __builtin_amdgcn_mfma_f32_16x16x32_bf16(KF##10, qf0, s1, 0, 0, 0); \
    s1 = __builtin_amdgcn_mfma_f32_16x16x32_bf16(KF##11, qf1, s1, 0, 0, 0); \
    float sv[8] = {s0[0], s0[1], s0[2], s0[3], s1[0], s1[1], s1[2], s1[3]}; \
    bool ok[8]; \
    _Pragma("unroll") for (int e = 0; e < 8; ++e) ok[e] = true; \
    if (ci_ >= nd) { \
      const int e_ = ci_ - nd; const int j_ = (ncc == 2) ? (e_ >> 1) : e_; const int cc_ = cc0 + ((ncc == 2) ? (e_ & 1) : 0); \
      const int dr_ = rb + j_ - grow + 7; \
      const int cq = cq0 + fr, c0 = min(max(cq - 8, 0), 48); \
      _Pragma("unroll") for (int e = 0; e < 8; ++e) { \
        const int ck = cc_ * 32 + 16 * (e >> 2) + 4 * fq + (e & 3); \
        ok[e] = (ck >= c0) && (ck < c0 + 16); \
        const int dc = min(max(ck - cq, -15), 15) + 15; \
        const float bias = rpb[dr_ * 31 + dc] * LOG2E; \
        sv[e] = ok[e] ? sv[e] + bias : -1e30f; \
      } \
    } \
    float mx = fmaxf(fmaxf(fmaxf(sv[0], sv[1]), fmaxf(sv[2], sv[3])), fmaxf(fmaxf(sv[4], sv[5]), fmaxf(sv[6], sv[7]))); \
    mx = fmaxf(mx, __shfl_xor(mx, 16)); \
    mx = fmaxf(mx, __shfl_xor(mx, 32)); \
    const float mn = fmaxf(m, mx); \
    const float alpha = exp2f(m - mn); \
    m = mn; \
    float ps = 0.f; \
    _Pragma("unroll") for (int e = 0; e < 8; ++e) { sv[e] = ok[e] ? exp2f(sv[e] - mn) : 0.f; ps += sv[e]; } \
    l = l * alpha + ps; \
    union { bf16x8 v; unsigned u[4]; } pf; \
    pf.u[0] = pack2(sv[0], sv[1]); pf.u[1] = pack2(sv[2], sv[3]); pf.u[2] = pack2(sv[4], sv[5]); pf.u[3] = pack2(sv[6], sv[7]); \
    ATT_PV(0, VF##0) ATT_PV(1, VF##1) ATT_PV(2, VF##2) ATT_PV(3, VF##3) }

__device__ __forceinline__ void attn_wave(const u16* __restrict__ Q, int ldq, const u16* __restrict__ Kb, int ldk,
                                          const u16* __restrict__ Vt, int ldv, int ndense, const bool NA,
                                          const float* __restrict__ rpb, int grow, int cq0,
                                          u16* __restrict__ out, int ldo, int tidx) {
  const int lane = tidx & 63, fr = lane & 15, fq = lane >> 4;
  const bf16x8 qf0 = *reinterpret_cast<const bf16x8*>(Q + (size_t)fr * ldq + fq * 8);
  const bf16x8 qf1 = *reinterpret_cast<const bf16x8*>(Q + (size_t)fr * ldq + 32 + fq * 8);
  f32x4 o[4];
#pragma unroll
  for (int dt = 0; dt < 4; ++dt) o[dt] = (f32x4){0.f, 0.f, 0.f, 0.f};
  float m = -1e30f, l = 0.f;
  const int nd = ndense >> 5;
  const int rb = min(max(grow - 4, 0), 8);
  const int ulo = min(max(cq0 - 8, 0), 48), uhi = min(max(cq0 + 15 - 8, 0), 48) + 16;
  const bool c0ok = ulo < 32, c1ok = uhi > 32;
  const int ncc = (c0ok && c1ok) ? 2 : 1, cc0 = c0ok ? 0 : 1;
  const int nt = nd + (NA ? 8 * ncc : 0);
  bf16x8 ka00, ka01, ka10, ka11, kb00, kb01, kb10, kb11;
  bf16x8 va0, va1, va2, va3, vb0, vb1, vb2, vb3;
  ATT_LOAD(ka, va, 0)
  for (int ci = 0; ci < nt; ci += 2) {
    ATT_LOAD(kb, vb, ci + 1)
    ATT_COMPUTE(ka, va, ci)
    if (ci + 1 < nt) {
      ATT_LOAD(ka, va, ci + 2)
      ATT_COMPUTE(kb, vb, ci + 1)
    }
  }
  l += __shfl_xor(l, 16);
  l += __shfl_xor(l, 32);
  const float il = 1.f / l;
#pragma unroll
  for (int dt = 0; dt < 4; ++dt) {
    uint2 pk; pk.x = pack2(o[dt][0] * il, o[dt][1] * il); pk.y = pack2(o[dt][2] * il, o[dt][3] * il);
    *reinterpret_cast<uint2*>(out + (size_t)fr * ldo + 16 * dt + 4 * fq) = pk;
  }
}

__device__ void scan_item(const Params& p, int layer, char* smem, bool lat, int b, int h, int dir, int qd, int tidx) {
  const int tid = tidx, lane = tid & 63, wid = tid >> 6, rr = lane >> 4, j = lane & 15;
  const int L = lat ? 1024 : 256, seqbase = lat ? NCTX + b * 1024 : b * 256;
  const int rowl = wid * 4 + rr, row = qd * 16 + rowl;
  float* cbuf = reinterpret_cast<float*>(smem);
  float* obuf = cbuf + 2 * 16 * 6 * 64;
  float4 S = make_float4(0.f, 0.f, 0.f, 0.f);
  if (lat) S = *reinterpret_cast<const float4*>(p.in[2] + ((((size_t)(b * 4 + layer) * 2 + dir) * 4 + h) * 64 + row) * 64 + 4 * j);
  const int nch = L / 16;
  float* odst = dir == 0 ? p.OF : p.OB;
  float4 pre0, pre1, pre2, pre3, pre4, pre5;
#define SC_GL1(PR, I, CH) { const int idx = tid + 256 * (I), tt_ = idx / 96, rem = idx % 96, vec = rem >> 4, f4 = rem & 15; \
    const int st_ = (CH) * 16 + tt_, t_ = dir == 0 ? st_ : L - 1 - st_; const int svec = vec < 3 ? vec : vec + 3 * dir; \
    PR = *reinterpret_cast<const float4*>(p.SC + ((size_t)((seqbase + t_) * 4 + h) * 9 + svec) * 64 + f4 * 4); }
#define gload(CH) { SC_GL1(pre0, 0, CH) SC_GL1(pre1, 1, CH) SC_GL1(pre2, 2, CH) SC_GL1(pre3, 3, CH) SC_GL1(pre4, 4, CH) SC_GL1(pre5, 5, CH) }
#define SC_LS1(PR, I, BUF) *reinterpret_cast<float4*>(cbuf + (BUF) * 6144 + (tid + 256 * (I)) * 4) = PR;
#define lstore(BUF) { SC_LS1(pre0, 0, BUF) SC_LS1(pre1, 1, BUF) SC_LS1(pre2, 2, BUF) SC_LS1(pre3, 3, BUF) SC_LS1(pre4, 4, BUF) SC_LS1(pre5, 5, BUF) }
  gload(0); lstore(0);
  __syncthreads();
#define SC_LD(R4, K4, VV, W4, A4, D4, TT) { const float* base_ = cb + (TT) * 384; \
    R4 = *reinterpret_cast<const float4*>(base_ + 4 * j); K4 = *reinterpret_cast<const float4*>(base_ + 64 + 4 * j); \
    VV = base_[128 + row]; W4 = *reinterpret_cast<const float4*>(base_ + 192 + 4 * j); \
    A4 = *reinterpret_cast<const float4*>(base_ + 256 + 4 * j); D4 = *reinterpret_cast<const float4*>(base_ + 320 + 4 * j); }
  for (int ch = 0; ch < nch; ++ch) {
#if REPMASK
    if (ch + 1 < nch && p.pad != 5) gload(ch + 1);
#else
    if (ch + 1 < nch) gload(ch + 1);
#endif
    const float* cb = cbuf + (ch & 1) * 6144;
    float osel = 0.f;
    float4 r4, kk4, w4, ak4, kd4; float vv;
    SC_LD(r4, kk4, vv, w4, ak4, kd4, 0)
    float ovp = 0.f;
#pragma unroll 4
    for (int tt = 0; tt < 16; ++tt) {
      float4 r4n, kk4n, w4n, ak4n, kd4n; float vvn;
      SC_LD(r4n, kk4n, vvn, w4n, ak4n, kd4n, tt + 1)
      float sk = (S.x * kk4.x + S.y * kk4.y) + (S.z * kk4.z + S.w * kk4.w);
      sk += dpp_mov<0xB1>(sk);  ovp += dpp_mov<0xB1>(ovp);
      sk += dpp_mov<0x4E>(sk);  ovp += dpp_mov<0x4E>(ovp);
      sk += dpp_mov<0x141>(sk); ovp += dpp_mov<0x141>(ovp);
      sk += dpp_mov<0x140>(sk); ovp += dpp_mov<0x140>(ovp);
      osel = (j == tt - 1) ? ovp : osel;
      const float tx = vv * kd4.x - sk * ak4.x, ty = vv * kd4.y - sk * ak4.y, tz = vv * kd4.z - sk * ak4.z, tw = vv * kd4.w - sk * ak4.w;
      S.x = S.x * w4.x + tx; S.y = S.y * w4.y + ty; S.z = S.z * w4.z + tz; S.w = S.w * w4.w + tw;
      ovp = (S.x * r4.x + S.y * r4.y) + (S.z * r4.z + S.w * r4.w);
      r4 = r4n; kk4 = kk4n; w4 = w4n; ak4 = ak4n; kd4 = kd4n; vv = vvn;
    }
    ovp = reduce16(ovp);
    osel = (j == 15) ? ovp : osel;
    {
      const int st = ch * 16 + j, t = dir == 0 ? st : L - 1 - st;
      odst[(size_t)(seqbase + t) * 256 + h * 64 + row] = osel;
    }
#if REPMASK
    if (ch + 1 < nch && p.pad != 5) lstore((ch + 1) & 1);
#else
    if (ch + 1 < nch) lstore((ch + 1) & 1);
#endif
    asm volatile("s_waitcnt lgkmcnt(0)" ::: "memory");
    __builtin_amdgcn_s_barrier();
  }
  if (!lat) *reinterpret_cast<float4*>(p.out_st + ((((size_t)(b * 4 + layer) * 2 + dir) * 4 + h) * 64 + row) * 64 + 4 * j) = S;
  __syncthreads();
}

__device__ void mixer_phase(const Params& p, int layer, char* smem, int tidx0) {
  int* slot = reinterpret_cast<int*>(smem + 60 * 1024);
  for (;;) {
    int tidx = tidx0;
    asm volatile("" : "+v"(tidx));
    const int tid = tidx, wid = tid >> 6;
    __syncthreads();
    if (tid == 0) *slot = (int)atomicAdd(&p.wq[layer], 1u);
    __syncthreads();
    int it = *slot;
    if (it >= 1728) break;
    const bool is_scan = (it < 64) || (it >= 448 && it < 960);
#if REPMASK
    if ((p.pad == 1 && !is_scan) || (p.pad == 2 && is_scan) || ((p.pad == 3 || p.pad == 5 || p.pad == 6) && !(it < 64)) || (p.pad == 4 && !(it >= 64 && it < 320))) continue;
#endif
    if (is_scan) {
      const bool lat = it < 64;
      const int si = lat ? it : it - 448;
#ifndef NO_SCAN
      scan_item(p, layer, smem, lat, si / 32, (si / 8) % 4, (si / 4) % 2, si % 4, tidx);
#endif
      continue;
    }
    const u16 *Q, *Kb, *Vt; u16* out; int ldq, ldk, ldv, ndense, grow = 0, cq0 = 0; bool na = false;
    const float* rpb = p.in[23];
    if (it < 320) {
      it -= 64;
      const int b = it / 128, qh = (it / 16) % 8, qt = it % 16, kvh = qh >> 2;
      const int q0 = b * 1024 + qt * 64 + wid * 16;
      Q = p.QGl + (size_t)q0 * 512 + qh * 64; ldq = 512;
      Kb = p.KGl + (size_t)((layer * 2 + b) * 2 + kvh) * 98304; ldk = 0;
      Vt = p.VGtl + (size_t)((layer * 2 + b) * 2 + kvh) * 98304; ldv = 0; ndense = 1536;
      out = p.MIX + (size_t)(NCTX + q0) * DM + 512 + qh * 64;
    } else if (it < 448) {
      it -= 320;
      const int b = it / 64, h = (it / 16) % 4, r = it % 16;
      const int q0 = b * 1024 + r * 64 + wid * 16;
      Q = p.QNl + (size_t)q0 * 256 + h * 64; ldq = 256;
      Kb = p.KNl + (size_t)((layer * 2 + b) * 4 + h) * 98304; ldk = 0;
      Vt = p.VNtl + (size_t)((layer * 2 + b) * 4 + h) * 98304; ldv = 0; ndense = 512;
      rpb = p.in[23] + (size_t)(layer * 4 + h) * 15 * 31; grow = r; cq0 = wid * 16; na = true;
      out = p.MIX + (size_t)(NCTX + q0) * DM + 256 + h * 64;
    } else if (it < 1472) {
      it -= 960;
      const int b = it / 32, qh = (it / 4) % 8, qt = it % 4, kvh = qh >> 2;
      const int q0 = b * 256 + qt * 64 + wid * 16;
      Q = p.QGc + (size_t)q0 * 512 + qh * 64; ldq = 512;
      Kb = p.KGc + (size_t)(b * 2 + kvh) * 16384; ldk = 0;
      Vt = p.VGtc + (size_t)(b * 2 + kvh) * 16384; ldv = 0; ndense = 256;
      out = p.MIX + (size_t)q0 * DM + 512 + qh * 64;
    } else {
      it -= 1472;
      const int b = it / 16, h = (it / 4) % 4, qt = it % 4;
      const int q0 = b * 256 + qt * 64 + wid * 16;
      Q = p.QNc + (size_t)q0 * 256 + h * 64; ldq = 256;
      Kb = p.KNc + (size_t)(b * 4 + h) * 16384; ldk = 0;
      Vt = p.VNtc + (size_t)(b * 4 + h) * 16384; ldv = 0; ndense = 256;
      out = p.MIX + (size_t)q0 * DM + 256 + h * 64;
    }
#ifndef NO_ATT
    attn_wave(Q, ldq, Kb, ldk, Vt, ldv, ndense, na, rpb, grow, cq0, out, DM, tidx);
#endif
  }
}

__device__ void rwkv_fin_phase(const Params& p, int layer, int bid, int nblk, int tidx) {
  const int tid = tidx;
  const float lw = p.in[21][(size_t)layer * 256 + tid], lb = p.in[22][(size_t)layer * 256 + tid];
  for (int tok = bid; tok < NTOK; tok += nblk) {
    const size_t i = (size_t)tok * 256 + tid;
    const float o = p.OF[i] + p.OB[i];
    const float mu = wave_sum(o) * (1.f / 64.f);
    const float d = o - mu;
    const float var = wave_sum(d * d) * (1.f / 64.f);
    const float y = (d * rsqrtf(var + 64e-5f) * lw + lb + p.BV[i]) * p.G[i];
    p.MIX[(size_t)tok * DM + tid] = f2bf(y);
  }
}

#ifndef ONLY_PH
#define ONLY_PH -1
#endif
#define PH_EN(x) (ONLY_PH < 0 || ONLY_PH == (x))
__device__ __forceinline__ void run_phase(const Params& p, int ph, char* smem, int bid, int nblk, int tidx) {
  if (ph == 0) { if (PH_EN(0)) setup_phase(p, smem, bid, nblk, tidx); return; }
  if (ph == 1) { if (PH_EN(1)) modreduce_phase(p, bid, nblk, tidx); return; }
  if (ph == 2) { if (PH_EN(2)) ln_phase<0>(p, 0, bid, nblk, tidx); return; }
  const int layer = (ph - 3) / 9, s = (ph - 3) % 9;
  switch (s) {
    case 0: if (PH_EN(3)) gemm_phase<EPI_PROJ, 256, 3>(p, layer, p.A, p.winT + (size_t)layer * DIN * DM, DIN, DM, smem, bid, nblk, tidx); break;
    case 1: if (PH_EN(4)) prep_phase(p, layer, smem, bid, nblk, tidx); break;
    case 2: if (PH_EN(5)) mixer_phase(p, layer, smem, tidx); break;
    case 3: if (PH_EN(6)) rwkv_fin_phase(p, layer, bid, nblk, tidx); break;
    case 4: if (PH_EN(7)) gemm_phase<EPI_OUT, 192, 3>(p, layer, p.MIX, p.woutT + (size_t)layer * DM * DM, DM, DM, smem, bid, nblk, tidx); break;
    case 5: if (PH_EN(8)) ln_phase<1>(p, layer, bid, nblk, tidx); break;
    case 6: if (PH_EN(9)) gemm_phase<EPI_FFI, 192, 3>(p, layer, p.A, p.wfiT + (size_t)layer * 2 * DFF * DM, 2 * DFF, DM, smem, bid, nblk, tidx); break;
    case 7: if (PH_EN(10)) gemm_phase<EPI_FFO, 192, 3>(p, layer, p.ACT, p.wfoT + (size_t)layer * DM * DFF, DM, DFF, smem, bid, nblk, tidx); break;
    default: if (PH_EN(11)) ln_phase<2>(p, layer, bid, nblk, tidx); break;
  }
}

__global__ void __launch_bounds__(256, 2) fwd_kernel(Params p, int ph0, int ph1, int usebar) {
  __shared__ __attribute__((aligned(16))) char smem[73728 + 16];
  const int bid = blockIdx.x, nblk = gridDim.x;
  XcdBarrier xb;
  if (usebar && p.never) cg::this_grid().sync();
  if (usebar) {
    if (threadIdx.x == 0) *reinterpret_cast<uint4*>(smem + 73728) = make_uint4(0u, 0u, 0u, 0u);
    __syncthreads();
    xb = xcd_barrier_post(p.bar, (volatile LAS unsigned*)(smem + 73728));
  }
  for (int ph = ph0; ph < ph1; ++ph) {
    int tidx = threadIdx.x;
    asm volatile("" : "+v"(tidx));
    run_phase(p, ph, smem, bid, nblk, tidx);
#if REPMASK
    {
      const int slot_ = ph < 3 ? 9 + ph : (ph - 3) % 9;
      if ((REPMASK >> slot_) & 1) {
        if (usebar) xcd_barrier(xb);
        Params p2 = p; p2.wq = p.wq + 4; p2.pad = REPVAR;
        if (REPVAR >= 5) { p2.OF = p.PROJ; p2.OB = p.PROJ; p2.out_st = p.PROJ + 4000000; p2.MIX = (u16*)(p.PROJ + 8000000); }
        run_phase(p2, ph, smem, bid, nblk, tidx);
      }
    }
#endif
    if (usebar && ph + 1 < ph1) xcd_barrier(xb);
  }
}

static inline size_t al256(size_t x) { return (x + 255) & ~(size_t)255; }

extern "C" void kernel_launch(void* const* d_in, const int* in_sizes, int n_in, void* d_out, int out_size, void* d_ws, size_t ws_size,
                              hipStream_t stream) {
  Params p;
  memset(&p, 0, sizeof(p));
  for (int i = 0; i < 33; ++i) p.in[i] = (const float*)d_in[i];
  float* o = (float*)d_out;
  p.out_yp = o; o += 4194304;
  p.out_ys = o; o += 2097152;
  p.out_st = o; o += 2097152;
  p.out_nak = o; o += 4194304;
  p.out_nav = o; o += 4194304;
  p.out_gk = o; o += 2097152;
  p.out_gv = o;
  char* w = (char*)d_ws; size_t off = 0;
  auto take = [&](size_t bytes) { char* r = w + off; off += al256(bytes); return r; };
  p.bar = (unsigned*)take(16384);
  p.wq = p.bar + 3584;
  p.modp = (float*)take((size_t)4 * 32 * 3 * 6144 * 4);
  p.mod = (float*)take((size_t)4 * 3 * 6144 * 4);
  p.winT = (u16*)take((size_t)4 * DIN * DM * 2);
  p.woutT = (u16*)take((size_t)4 * DM * DM * 2);
  p.wfiT = (u16*)take((size_t)4 * 2 * DFF * DM * 2);
  p.wfoT = (u16*)take((size_t)4 * DM * DFF * 2);
  p.X = (float*)take((size_t)NTOK * DM * 4);
  p.PROJ = (float*)take((size_t)NTOK * DIN * 4);
  p.X1 = p.PROJ;
  p.Y = p.PROJ + (size_t)NTOK * DM;
  p.SC = (float*)take((size_t)NTOK * 4 * 9 * 64 * 4);
  p.ACT = (u16*)p.SC;
  p.G = (float*)take((size_t)NTOK * 256 * 4);
  p.BV = (float*)take((size_t)NTOK * 256 * 4);
  p.OF = (float*)take((size_t)NTOK * 256 * 4);
  p.OB = (float*)take((size_t)NTOK * 256 * 4);
  p.A = (u16*)take((size_t)NTOK * DM * 2);
  p.MIX = (u16*)take((size_t)NTOK * DM * 2);
  p.QNc = (u16*)take((size_t)NCTX * 256 * 2);
  p.KNc = (u16*)take((size_t)NCTX * 256 * 2);
  p.VNtc = (u16*)take((size_t)NCTX * 256 * 2);
  p.QGc = (u16*)take((size_t)NCTX * 512 * 2);
  p.KGc = (u16*)take((size_t)NCTX * 128 * 2);
  p.VGtc = (u16*)take((size_t)NCTX * 128 * 2);
  p.QNl = (u16*)take((size_t)2048 * 256 * 2);
  p.KNl = (u16*)take((size_t)4 * 2 * 1536 * 256 * 2);
  p.VNtl = (u16*)take((size_t)4 * 2 * 1536 * 256 * 2);
  p.QGl = (u16*)take((size_t)2048 * 512 * 2);
  p.KGl = (u16*)take((size_t)4 * 2 * 1536 * 128 * 2);
  p.VGtl = (u16*)take((size_t)4 * 2 * 1536 * 128 * 2);
  p.loraT = (u16*)take((size_t)4 * 98304 * 2);
  p.rope = (float*)take((size_t)64 * 16 * 2 * 4);
  if (off > ws_size) { fprintf(stderr, "workspace too small: need %zu have %zu\n", off, ws_size); return; }

  (void)hipMemsetAsync(p.bar, 0, 16384, stream);
#if MEGA
  static int grid_blocks = 0;
  if (!grid_blocks) {
    int dev = 0, cus = 0, per_cu = 0;
    hipGetDevice(&dev);
    hipDeviceGetAttribute(&cus, hipDeviceAttributeMultiprocessorCount, dev);
    hipOccupancyMaxActiveBlocksPerMultiprocessor(&per_cu, fwd_kernel, 256, 0);
    if (per_cu > 2) per_cu = 2;
    if (per_cu < 1) per_cu = 1;
    grid_blocks = cus * per_cu;
  }
  int ph0 = 0, ph1 = NPH, ub = 1;
  void* args[] = {&p, &ph0, &ph1, &ub};
  hipError_t e = hipLaunchCooperativeKernel((void*)fwd_kernel, dim3(grid_blocks), dim3(256), args, 0, stream);
  if (e != hipSuccess) fprintf(stderr, "cooperative launch failed: %s (grid %d)\n", hipGetErrorString(e), grid_blocks);
#else
  for (int ph = 0; ph < NPH; ++ph) fwd_kernel<<<512, 256, 0, stream>>>(p, ph, ph + 1, 0);
#endif
}
```

```cpp
#include <hip/hip_runtime.h>
#include <hip/hip_cooperative_groups.h>
#include <cstdio>
#include <cstdint>
#include <cstring>
namespace cg = cooperative_groups;

#ifndef REPMASK
#define REPMASK 0
#endif
#ifndef REPVAR
#define REPVAR 0
#endif
#ifndef MEGA
#define MEGA 1
#endif

typedef unsigned short u16;
using bf16x8 = __attribute__((ext_vector_type(8))) short;
using f32x4 = __attribute__((ext_vector_type(4))) float;

#define NTOK 6144
#define NCTX 4096
#define DM 1024
#define DIN 2688
#define DFF 2816
#define NPH 39
#define ALPHA 1.681792830507429f
#define LOG2E 1.4426950408889634f
#define QSCALE (0.125f * LOG2E)

struct Params {
  const float* in[33];
  float *out_yp, *out_ys, *out_st, *out_nak, *out_nav, *out_gk, *out_gv;
  unsigned *bar, *wq;
  float *modp, *mod;
  u16 *winT, *woutT, *wfiT, *wfoT;
  float *X, *X1, *Y, *PROJ, *SC, *G, *BV, *OF, *OB;
  u16 *A, *MIX, *ACT;
  u16 *QNc, *KNc, *VNtc, *QGc, *KGc, *VGtc;
  u16 *QNl, *KNl, *VNtl, *QGl, *KGl, *VGtl;
  u16* loraT; float* rope;
  int never; int pad;
};

__device__ __forceinline__ u16 f2bf(float f) {
  unsigned u = __float_as_uint(f);
  u += 0x7FFFu + ((u >> 16) & 1u);
  return (u16)(u >> 16);
}
__device__ __forceinline__ unsigned pack2(float a, float b) { return (unsigned)f2bf(a) | ((unsigned)f2bf(b) << 16); }
template <int CTRL> __device__ __forceinline__ float dpp_mov(float v) {
  return __int_as_float(__builtin_amdgcn_update_dpp(0, __float_as_int(v), CTRL, 0xF, 0xF, false));
}
__device__ __forceinline__ float reduce16(float v) {
  v += dpp_mov<0xB1>(v);
  v += dpp_mov<0x4E>(v);
  v += dpp_mov<0x141>(v);
  v += dpp_mov<0x140>(v);
  return v;
}
__device__ __forceinline__ float wave_sum(float v) {
  v = reduce16(v);
  v += __shfl_xor(v, 16);
  v += __shfl_xor(v, 32);
  return v;
}
__device__ __forceinline__ float sigmoidf_(float x) { return 1.f / (1.f + __expf(-x)); }
__device__ __forceinline__ float siluf_(float x) { return x / (1.f + __expf(-x)); }
__device__ __forceinline__ int modrow_of(int tok) { return tok < NCTX ? 0 : 1 + ((tok - NCTX) >> 10); }

#define XB_TMO      128
#define XB_XCNT(j)  (256  + 64 * (j))
#define XB_XSUB(j)  (1280 + 64 * (j))
#define XB_XGEN(j)  (2304 + 64 * (j))
#define XB_TOP      3328
#define XB_TOPGEN   3392
#define XCD_BAR_WORDS 3456
#define XB_SPIN_CAP (1u << 22)
#define LAS __attribute__((address_space(3)))
__device__ __forceinline__ unsigned xb_ld(unsigned* p) { return __hip_atomic_load(p, __ATOMIC_RELAXED, __HIP_MEMORY_SCOPE_AGENT); }
__device__ __forceinline__ unsigned xb_add(unsigned* p, unsigned v) { return __hip_atomic_fetch_add(p, v, __ATOMIC_RELAXED, __HIP_MEMORY_SCOPE_AGENT); }
__device__ __forceinline__ unsigned xb_xcc_id() { return (unsigned)__builtin_amdgcn_s_getreg((3 << 11) | 20) & 0xFu; }
#define XB_SPIN(cond, bar) do { unsigned _sp = 0; while (cond) { __builtin_amdgcn_s_sleep(1); \
    if ((++_sp & 255u) == 0u) { if (xb_ld(&(bar)[XB_TMO])) break; if (_sp > XB_SPIN_CAP) { atomicAdd(&(bar)[XB_TMO], 1u); break; } } } } while (0)
struct XcdBarrier { unsigned* bar; unsigned x; volatile LAS unsigned* st; };
__device__ __forceinline__ XcdBarrier xcd_barrier_post(unsigned* bar, volatile LAS unsigned* st) {
  XcdBarrier b; b.bar = bar; b.x = xb_xcc_id(); b.st = st;
  if (threadIdx.x == 0) (void)xb_add(&bar[XB_XCNT(b.x)], 1u);
  return b;
}
__device__ __forceinline__ void xcd_barrier_complete(unsigned* bar, unsigned x, unsigned& nloc, unsigned& nx) {
  const unsigned G = gridDim.x * gridDim.y * gridDim.z;
  unsigned sum, cnt, mine, sp = 0u;
  for (;;) {
    sum = 0u; cnt = 0u; mine = 0u;
#pragma unroll
    for (unsigned j = 0; j < 16; ++j) { const unsigned c = xb_ld(&bar[XB_XCNT(j)]); sum += c; cnt += (c > 0u) ? 1u : 0u; mine = (j == x) ? c : mine; }
    if (sum == G) break;
    __builtin_amdgcn_s_sleep(1);
    if ((++sp & 255u) == 0u) { if (xb_ld(&bar[XB_TMO])) break; if (sp > XB_SPIN_CAP) { atomicAdd(&bar[XB_TMO], 1u); break; } }
  }
  nloc = mine > 0u ? mine : 1u; nx = cnt > 0u ? cnt : 1u;
}
__device__ __forceinline__ void xcd_barrier(const XcdBarrier& b) {
  asm volatile("s_waitcnt vmcnt(0)" ::: "memory");
  __syncthreads();
  if (threadIdx.x == 0) {
    unsigned* bar = b.bar;
    asm volatile("" : "+s"(bar));
    __builtin_amdgcn_s_waitcnt(0);
    unsigned nloc = b.st[0], nx = b.st[1];
    if (nloc == 0u) { xcd_barrier_complete(bar, b.x, nloc, nx); b.st[0] = nloc; b.st[1] = nx; }
    const unsigned old = xb_add(&bar[XB_XSUB(b.x)], 1u);
    const unsigned gen = old / nloc;
    if (old + 1u == (gen + 1u) * nloc) {
      __builtin_amdgcn_fence(__ATOMIC_RELEASE, "agent");
      asm volatile("s_waitcnt vmcnt(0)" ::: "memory");
      const unsigned og = xb_add(&bar[XB_TOP], 1u);
      const unsigned tg = og / nx;
      if (og + 1u == (tg + 1u) * nx) xb_add(&bar[XB_TOPGEN], 1u);
      else XB_SPIN(xb_ld(&bar[XB_TOPGEN]) == tg, bar);
      __builtin_amdgcn_fence(__ATOMIC_ACQUIRE, "agent");
      xb_add(&bar[XB_XGEN(b.x)], 1u);
      asm volatile("s_waitcnt vmcnt(0)" ::: "memory");
    } else {
      XB_SPIN(xb_ld(&bar[XB_XGEN(b.x)]) == gen, bar);
      __builtin_amdgcn_fence(__ATOMIC_ACQUIRE, "agent");
      asm volatile("s_waitcnt vmcnt(0)" ::: "memory");
    }
  }
  __syncthreads();
}

__device__ __forceinline__ int lds_byte32(int r, int c) {
  const int ob = (r & 15) * 64 + c * 2;
  return (r >> 4) * 1024 + (ob ^ (((ob >> 9) & 1) << 5));
}
__device__ __forceinline__ void stage_rc32(int b, int& R, int& C) {
  const int sb = b & 1023, swz = sb ^ (((sb >> 9) & 1) << 5);
  R = (b >> 10) * 16 + (swz >> 6); C = (swz & 63) >> 1;
}
template <int ROWS>
__device__ __forceinline__ void stage_tile32(const u16* __restrict__ g, int ld, char* lds, int tidx) {
#pragma unroll
  for (int i = 0; i < (ROWS * 64 + 4095) / 4096; ++i) {
    const int b = tidx * 16 + i * 4096;
    if ((i + 1) * 4096 <= ROWS * 64 || tidx < (ROWS * 64 - i * 4096) / 16) {
      int R, C; stage_rc32(b, R, C);
      __builtin_amdgcn_global_load_lds((const unsigned*)(g + (size_t)R * ld + C), (unsigned LAS*)(lds + b), 16, 0, 0);
    }
  }
}
template <int N> __device__ __forceinline__ void wait_vmcnt() {
  if (N == 0) asm volatile("s_waitcnt vmcnt(0)" ::: "memory");
  else if (N == 3) asm volatile("s_waitcnt vmcnt(3)" ::: "memory");
  else if (N == 4) asm volatile("s_waitcnt vmcnt(4)" ::: "memory");
  else if (N == 5) asm volatile("s_waitcnt vmcnt(5)" ::: "memory");
  else if (N == 6) asm volatile("s_waitcnt vmcnt(6)" ::: "memory");
  else if (N == 8) asm volatile("s_waitcnt vmcnt(8)" ::: "memory");
  else if (N == 9) asm volatile("s_waitcnt vmcnt(9)" ::: "memory");
  else if (N == 10) asm volatile("s_waitcnt vmcnt(10)" ::: "memory");
  else if (N == 12) asm volatile("s_waitcnt vmcnt(12)" ::: "memory");
  else asm volatile("s_waitcnt vmcnt(0)" ::: "memory");
}

enum { EPI_PROJ = 0, EPI_OUT = 1, EPI_FFI = 2, EPI_FFO = 3 };

template <int EPI, int BM, int NST>
__device__ __forceinline__ void gemm_phase(const Params& p, int layer, const u16* __restrict__ A, const u16* __restrict__ Bt,
                                           int N, int K, char* smem, int bid, int nblk, int tidx) {
  constexpr int MF = BM / 32;
  const int tid = tidx, lane = tid & 63, wid = tid >> 6, wr = wid >> 1, wc = wid & 1, fr = lane & 15, fq = lane >> 4;
  const int nM = NTOK / BM, nN = N / 128, ntiles = nM * nN, nk = K / 32;
  constexpr int SB = (BM + 128) * 64;
  constexpr int LA = (BM * 64) / 4096;
  const bool extraA = (BM == 96) && (wid < 2);
  for (int tile = bid; tile < ntiles; tile += nblk) {
    const int pm = tile % nM, pn = tile / nM, m0 = pm * BM, n0 = pn * 128;
    f32x4 acc[MF][4];
#pragma unroll
    for (int m = 0; m < MF; ++m)
#pragma unroll
      for (int n = 0; n < 4; ++n) acc[m][n] = (f32x4){0.f, 0.f, 0.f, 0.f};
    const u16* Ag = A + (size_t)m0 * K;
    const u16* Bg = Bt + (size_t)n0 * K;
#pragma unroll
    for (int s_ = 0; s_ < NST - 1; ++s_) {
      stage_tile32<BM>(Ag + s_ * 32, K, smem + s_ * SB, tidx);
      stage_tile32<128>(Bg + s_ * 32, K, smem + s_ * SB + BM * 64, tidx);
    }
    int slot = 0, pslot = NST - 1;
    for (int kt = 0; kt < nk; ++kt) {
      if (kt + NST - 2 < nk) {
        if (BM == 96) { if (extraA) wait_vmcnt<(NST - 2) * 4>(); else wait_vmcnt<(NST - 2) * 3>(); }
        else wait_vmcnt<(NST - 2) * (LA + 2)>();
      } else {
        asm volatile("s_waitcnt vmcnt(0)" ::: "memory");
      }
      __builtin_amdgcn_s_barrier();
      if (kt + NST - 1 < nk) {
        char* nb = smem + pslot * SB;
        stage_tile32<BM>(Ag + (kt + NST - 1) * 32, K, nb, tidx);
        stage_tile32<128>(Bg + (kt + NST - 1) * 32, K, nb + BM * 64, tidx);
      }
      const char* sa = smem + slot * SB;
      const char* sb = sa + BM * 64;
      slot = (slot + 1 == NST) ? 0 : slot + 1;
      pslot = (pslot + 1 == NST) ? 0 : pslot + 1;
      bf16x8 af[MF], bfr[4];
#pragma unroll
      for (int m = 0; m < MF; ++m) af[m] = *reinterpret_cast<const bf16x8*>(sa + lds_byte32(wr * (BM / 2) + m * 16 + fr, fq * 8));
#pragma unroll
      for (int n = 0; n < 4; ++n) bfr[n] = *reinterpret_cast<const bf16x8*>(sb + lds_byte32(wc * 64 + n * 16 + fr, fq * 8));
#pragma unroll
      for (int m = 0; m < MF; ++m)
#pragma unroll
        for (int n = 0; n < 4; ++n) acc[m][n] = __builtin_amdgcn_mfma_f32_16x16x32_bf16(bfr[n], af[m], acc[m][n], 0, 0, 0);
    }
#pragma unroll
    for (int m = 0; m < MF; ++m) {
      const int row = m0 + wr * (BM / 2) + m * 16 + fr;
      if (EPI == EPI_PROJ) {
#pragma unroll
        for (int n = 0; n < 4; ++n) {
          const int col = n0 + wc * 64 + n * 16 + 4 * fq;
          *reinterpret_cast<float4*>(p.PROJ + (size_t)row * DIN + col) = make_float4(acc[m][n][0], acc[m][n][1], acc[m][n][2], acc[m][n][3]);
        }
      } else if (EPI == EPI_OUT || EPI == EPI_FFO) {
        const float* res = (EPI == EPI_OUT) ? p.X : p.X1;
        const float* gate = p.mod + ((size_t)(layer * 3 + modrow_of(row)) * 6 + (EPI == EPI_OUT ? 2 : 5)) * 1024;
#pragma unroll
        for (int n = 0; n < 4; ++n) {
          const int col = n0 + wc * 64 + n * 16 + 4 * fq;
          const float4 xr = *reinterpret_cast<const float4*>(res + (size_t)row * DM + col);
          const float4 gt = *reinterpret_cast<const float4*>(gate + col);
          float4 y;
          y.x = ALPHA * xr.x + gt.x * acc[m][n][0];
          y.y = ALPHA * xr.y + gt.y * acc[m][n][1];
          y.z = ALPHA * xr.z + gt.z * acc[m][n][2];
          y.w = ALPHA * xr.w + gt.w * acc[m][n][3];
          *reinterpret_cast<float4*>(p.Y + (size_t)row * DM + col) = y;
        }
      } else {
#pragma unroll
        for (int n2 = 0; n2 < 2; ++n2) {
          const int j0 = ((n0 + wc * 64) / 32 + n2) * 16 + 4 * fq;
          float a[4];
#pragma unroll
          for (int r = 0; r < 4; ++r) a[r] = siluf_(acc[m][2 * n2][r]) * acc[m][2 * n2 + 1][r];
          uint2 pk; pk.x = pack2(a[0], a[1]); pk.y = pack2(a[2], a[3]);
          *reinterpret_cast<uint2*>(p.ACT + (size_t)row * DFF + j0) = pk;
        }
      }
    }
    asm volatile("s_waitcnt lgkmcnt(0)" ::: "memory");
    __builtin_amdgcn_s_barrier();
  }
}

__device__ __forceinline__ int kf_off(int t, int d) { return (t >> 4) * 1024 + (d >> 5) * 512 + ((d & 31) >> 3) * 128 + (t & 15) * 8 + (d & 7); }
__device__ __forceinline__ int vf_off(int t, int d) { return (t >> 5) * 2048 + (d >> 4) * 512 + (((t & 15) >> 2) * 16 + (d & 15)) * 8 + ((t >> 4) & 1) * 4 + (t & 3); }
__device__ __forceinline__ void pack44_store(u16* base, int t0, int d, const float* v) {
  uint2 a, b; a.x = pack2(v[0], v[1]); a.y = pack2(v[2], v[3]); b.x = pack2(v[4], v[5]); b.y = pack2(v[6], v[7]);
  *reinterpret_cast<uint2*>(base + vf_off(t0, d)) = a;
  *reinterpret_cast<uint2*>(base + vf_off(t0 + 4, d)) = b;
}
__device__ __forceinline__ void pack8_store(u16* dst, const float* v) {
  uint4 pk; pk.x = pack2(v[0], v[1]); pk.y = pack2(v[2], v[3]); pk.z = pack2(v[4], v[5]); pk.w = pack2(v[6], v[7]);
  *reinterpret_cast<uint4*>(dst) = pk;
}

__device__ void setup_phase(const Params& p, char* smem, int bid, int nblk, int tidx) {
  const int tid = tidx;
  const int NI = 768 + 512 + 13;
  for (int it = bid; it < NI; it += nblk) {
    if (it < 768) {
      const int l = it / 192, nc = (it / 32) % 6, kc = it % 32;
      const int col = nc * 1024 + tid * 4;
      const float* wm = p.in[9] + (size_t)l * 1024 * 6144;
      float4 a0 = make_float4(0, 0, 0, 0), a1 = a0, a2 = a0;
      for (int k8 = 0; k8 < 32; k8 += 8) {
        float4 w[8];
#pragma unroll
        for (int u = 0; u < 8; ++u) w[u] = *reinterpret_cast<const float4*>(wm + (size_t)(kc * 32 + k8 + u) * 6144 + col);
#pragma unroll
        for (int u = 0; u < 8; ++u) {
          const int k = kc * 32 + k8 + u;
          const float s0 = siluf_(p.in[8][k]), s1 = siluf_(p.in[7][k]), s2 = siluf_(p.in[7][1024 + k]);
          a0.x += s0 * w[u].x; a0.y += s0 * w[u].y; a0.z += s0 * w[u].z; a0.w += s0 * w[u].w;
          a1.x += s1 * w[u].x; a1.y += s1 * w[u].y; a1.z += s1 * w[u].z; a1.w += s1 * w[u].w;
          a2.x += s2 * w[u].x; a2.y += s2 * w[u].y; a2.z += s2 * w[u].z; a2.w += s2 * w[u].w;
        }
      }
      float* dst = p.modp + (size_t)((l * 32 + kc) * 3) * 6144 + col;
      *reinterpret_cast<float4*>(dst) = a0;
      *reinterpret_cast<float4*>(dst + 6144) = a1;
      *reinterpret_cast<float4*>(dst + 2 * 6144) = a2;
    } else if (it < 1280) {
      const int ci = it - 768, b = ci / 256, l = (ci / 64) % 4, tg = ci % 64, t0 = tg * 8;
      {
        const float* ck = p.in[3] + ((size_t)(b * 4 + l) * 512 + t0) * 256 + tid;
        const float* cv = p.in[4] + ((size_t)(b * 4 + l) * 512 + t0) * 256 + tid;
        float v[8];
#pragma unroll
        for (int tt = 0; tt < 8; ++tt) {
          p.KNl[((size_t)((l * 2 + b) * 4 + (tid >> 6))) * 98304 + kf_off(t0 + tt, tid & 63)] = f2bf(ck[tt * 256]);
          v[tt] = cv[tt * 256];
        }
        pack44_store(p.VNtl + ((size_t)((l * 2 + b) * 4 + (tid >> 6))) * 98304, t0, tid & 63, v);
      }
      if (tid < 128) {
        const float* ck = p.in[5] + ((size_t)(b * 4 + l) * 512 + t0) * 128 + tid;
#pragma unroll
        for (int tt = 0; tt < 8; ++tt) p.KGl[((size_t)((l * 2 + b) * 2 + (tid >> 6))) * 98304 + kf_off(t0 + tt, tid & 63)] = f2bf(ck[tt * 128]);
      } else {
        const int c = tid - 128;
        const float* cv = p.in[6] + ((size_t)(b * 4 + l) * 512 + t0) * 128 + c;
        float v[8];
#pragma unroll
        for (int tt = 0; tt < 8; ++tt) v[tt] = cv[tt * 128];
        pack44_store(p.VGtl + ((size_t)((l * 2 + b) * 2 + (c >> 6))) * 98304, t0, c & 63, v);
      }
    } else {
      const int li = it - (768 + 512);
      if (li == 12) {
        for (int idx = tid; idx < 1024; idx += 256) {
          const int pos = idx >> 4, fi = idx & 15;
          const float ang = (float)pos * exp2f(-(float)fi * (13.287712379549449f / 16.f));
          p.rope[idx * 2] = cosf(ang); p.rope[idx * 2 + 1] = sinf(ang);
        }
      } else {
        const int l = li / 3, m = li % 3;
        u16* dst = p.loraT + (size_t)l * 98304 + m * 32768;
        if (m < 2) {
          const float* src = p.in[m == 0 ? 14 : 16] + (size_t)l * 32768;
          for (int i0 = tid; i0 < 32768; i0 += 256 * 16) {
            float v[16];
#pragma unroll
            for (int u = 0; u < 16; ++u) { const int idx = i0 + 256 * u; const int d = idx >> 14, cch = (idx >> 6) & 255, r = idx & 63; v[u] = src[(d * 64 + r) * 256 + cch]; }
#pragma unroll
            for (int u = 0; u < 16; ++u) dst[i0 + 256 * u] = f2bf(v[u]);
          }
        } else {
          const float* src = p.in[17] + (size_t)l * 32768;
          for (int i0 = tid; i0 < 32768; i0 += 256 * 16) {
            float v[16];
#pragma unroll
            for (int u = 0; u < 16; ++u) { const int idx = i0 + 256 * u; const int cch = idx >> 7, j = idx & 127; v[u] = src[j * 256 + cch]; }
#pragma unroll
            for (int u = 0; u < 16; ++u) dst[i0 + 256 * u] = f2bf(v[u]);
          }
        }
      }
    }
  }
  {
    float* tile = reinterpret_cast<float*>(smem);
    const int NT = 4 * 3040;
    float4 cur0, cur1, cur2, cur3;
    const float* src; u16* dst; int K, N, mat, k0, n0;
#define TR_DECODE(TR) { const int l_ = (TR) / 3040; int r_ = (TR) % 3040; int kt_, nt_; \
      if (r_ < 672) { mat = 0; K = 1024; N = 2688; src = p.in[11] + (size_t)l_ * K * N; dst = p.winT + (size_t)l_ * N * K; kt_ = r_ / 42; nt_ = r_ % 42; } \
      else if (r_ < 928) { r_ -= 672; mat = 1; K = 1024; N = 1024; src = p.in[26] + (size_t)l_ * K * N; dst = p.woutT + (size_t)l_ * N * K; kt_ = r_ / 16; nt_ = r_ % 16; } \
      else if (r_ < 2336) { r_ -= 928; mat = 2; K = 1024; N = 5632; src = p.in[29] + (size_t)l_ * K * N; dst = p.wfiT + (size_t)l_ * N * K; kt_ = r_ / 88; nt_ = r_ % 88; } \
      else { r_ -= 2336; mat = 3; K = 2816; N = 1024; src = p.in[30] + (size_t)l_ * K * N; dst = p.wfoT + (size_t)l_ * N * K; kt_ = r_ / 16; nt_ = r_ % 16; } \
      k0 = kt_ * 64; n0 = nt_ * 64; }
#define TR_LOAD(V, I) V = *reinterpret_cast<const float4*>(src + (size_t)(k0 + (tid >> 4) + 16 * (I)) * N + n0 + (tid & 15) * 4);
#define TR_PUT(V, I) { const int kr_ = (tid >> 4) + 16 * (I), c4_ = (tid & 15) * 4; \
      tile[kr_ * 65 + c4_ + 0] = V.x; tile[kr_ * 65 + c4_ + 1] = V.y; tile[kr_ * 65 + c4_ + 2] = V.z; tile[kr_ * 65 + c4_ + 3] = V.w; }
    int tr = bid;
    if (tr < NT) { TR_DECODE(tr) TR_LOAD(cur0, 0) TR_LOAD(cur1, 1) TR_LOAD(cur2, 2) TR_LOAD(cur3, 3) }
    for (; tr < NT; tr += nblk) {
      TR_PUT(cur0, 0) TR_PUT(cur1, 1) TR_PUT(cur2, 2) TR_PUT(cur3, 3)
      if (tr + nblk < NT) { TR_DECODE(tr + nblk) TR_LOAD(cur0, 0) TR_LOAD(cur1, 1) TR_LOAD(cur2, 2) TR_LOAD(cur3, 3) }
      TR_DECODE(tr)
      __syncthreads();
#pragma unroll
      for (int i = 0; i < 2; ++i) {
        const int idx = tid + 256 * i, nl = idx >> 3, kc = idx & 7;
        int n = n0 + nl;
        if (mat == 2) { const int isup = n >= DFF ? 1 : 0; const int j = n - isup * DFF; n = (j >> 4) * 32 + isup * 16 + (j & 15); }
        float v[8];
#pragma unroll
        for (int jj = 0; jj < 8; ++jj) v[jj] = tile[(kc * 8 + jj) * 65 + nl];
        pack8_store(dst + (size_t)n * K + k0 + kc * 8, v);
      }
      __syncthreads();
    }
#undef TR_DECODE
#undef TR_LOAD
#undef TR_PUT
  }
}

__device__ void modreduce_phase(const Params& p, int bid, int nblk, int tidx) {
  for (int idx = bid * 256 + tidx; idx < 18432; idx += nblk * 256) {
    const int l = idx / 4608, rem = idx % 4608, mr = rem / 1536, c4 = (rem % 1536) * 4;
    float4 a = *reinterpret_cast<const float4*>(p.in[10] + (size_t)l * 6144 + c4);
    for (int k8 = 0; k8 < 32; k8 += 8) {
      float4 v[8];
#pragma unroll
      for (int u = 0; u < 8; ++u) v[u] = *reinterpret_cast<const float4*>(p.modp + (size_t)((l * 32 + k8 + u) * 3 + mr) * 6144 + c4);
#pragma unroll
      for (int u = 0; u < 8; ++u) { a.x += v[u].x; a.y += v[u].y; a.z += v[u].z; a.w += v[u].w; }
    }
    *reinterpret_cast<float4*>(p.mod + (size_t)(l * 3 + mr) * 6144 + c4) = a;
  }
}

template <int MODE>
__device__ void ln_phase(const Params& p, int layer, int bid, int nblk, int tidx) {
  const int lane = tidx & 63, wid = tidx >> 6;
  for (int it = bid; it < NTOK / 4; it += nblk) {
    const int row = it * 4 + wid;
    const float* src;
    if (MODE == 0) src = row < NCTX ? p.in[0] + (size_t)row * DM : p.in[1] + (size_t)(row - NCTX) * DM;
    else src = p.Y + (size_t)row * DM;
    float4 v[4];
#pragma unroll
    for (int i = 0; i < 4; ++i) v[i] = reinterpret_cast<const float4*>(src)[lane + 64 * i];
    if (MODE != 0) {
      float s = 0.f;
#pragma unroll
      for (int i = 0; i < 4; ++i) s += v[i].x + v[i].y + v[i].z + v[i].w;
      const float mu = wave_sum(s) * (1.f / 1024.f);
      float q = 0.f;
#pragma unroll
      for (int i = 0; i < 4; ++i) {
        v[i].x -= mu; v[i].y -= mu; v[i].z -= mu; v[i].w -= mu;
        q += v[i].x * v[i].x + v[i].y * v[i].y + v[i].z * v[i].z + v[i].w * v[i].w;
      }
      const float rstd = rsqrtf(wave_sum(q) * (1.f / 1024.f) + 1e-5f);
      const float* lw = (MODE == 1 ? p.in[27] : p.in[31]) + (size_t)layer * DM;
      const float* lb = (MODE == 1 ? p.in[28] : p.in[32]) + (size_t)layer * DM;
#pragma unroll
      for (int i = 0; i < 4; ++i) {
        const float4 w = reinterpret_cast<const float4*>(lw)[lane + 64 * i];
        const float4 b = reinterpret_cast<const float4*>(lb)[lane + 64 * i];
        v[i].x = v[i].x * rstd * w.x + b.x; v[i].y = v[i].y * rstd * w.y + b.y;
        v[i].z = v[i].z * rstd * w.z + b.z; v[i].w = v[i].w * rstd * w.w + b.w;
      }
    }
    float* xdst = (MODE == 1 ? p.X1 : p.X) + (size_t)row * DM;
#pragma unroll
    for (int i = 0; i < 4; ++i) reinterpret_cast<float4*>(xdst)[lane + 64 * i] = v[i];
    if (MODE == 2 && layer == 3) {
      float* o = row < NCTX ? p.out_yp + (size_t)row * DM : p.out_ys + (size_t)(row - NCTX) * DM;
#pragma unroll
      for (int i = 0; i < 4; ++i) reinterpret_cast<float4*>(o)[lane + 64 * i] = v[i];
    } else {
      const int ml = (MODE == 2) ? layer + 1 : layer;
      const int which = (MODE == 1) ? 3 : 0;
      const float* sh = p.mod + ((size_t)(ml * 3 + modrow_of(row)) * 6 + which) * 1024;
      const float* sc = sh + 1024;
      u16* adst = p.A + (size_t)row * DM;
#pragma unroll
      for (int i = 0; i < 4; ++i) {
        const float4 s4 = reinterpret_cast<const float4*>(sh)[lane + 64 * i];
        const float4 c4 = reinterpret_cast<const float4*>(sc)[lane + 64 * i];
        uint2 pk;
        pk.x = pack2(v[i].x * (1.f + c4.x) + s4.x, v[i].y * (1.f + c4.y) + s4.y);
        pk.y = pack2(v[i].z * (1.f + c4.z) + s4.z, v[i].w * (1.f + c4.w) + s4.w);
        reinterpret_cast<uint2*>(adst)[lane + 64 * i] = pk;
      }
    }
  }
}

#define FLD 772
#define LLD 392
__device__ void prep_phase(const Params& p, int layer, char* smem, int bid, int nblk, int tidx) {
  float* F = reinterpret_cast<float*>(smem);
  u16* LIb = reinterpret_cast<u16*>(smem + 16 * FLD * 4);
  const float* cw = p.in[12] + (size_t)layer * 3 * 1152;
  const u16* LW = p.loraT + (size_t)layer * 98304;
  for (int it = bid; it < NTOK / 16; it += nblk) {
    int tid = tidx;
    asm volatile("" : "+v"(tid));
    const int lane = tid & 63, wid = tid >> 6, fr = lane & 15, fq = lane >> 4;
    const int tok0 = it * 16;
    int b, tpos0, L;
    const bool isctx = tok0 < NCTX;
    if (isctx) { b = tok0 >> 8; tpos0 = tok0 & 255; L = 256; }
    else { const int tl = tok0 - NCTX; b = tl >> 10; tpos0 = tl & 1023; L = 1024; }
#pragma unroll 1
    for (int cg = tid; cg < 288; cg += 256) {
      const int c = cg * 4;
      const float4 w0 = *reinterpret_cast<const float4*>(cw + c);
      const float4 w1 = *reinterpret_cast<const float4*>(cw + 1152 + c);
      const float4 w2 = *reinterpret_cast<const float4*>(cw + 2304 + c);
      const float* pr = p.PROJ + (size_t)tok0 * DIN + c;
      float4 x[18];
#pragma unroll
      for (int i = 0; i < 18; ++i) {
        const int tpos = tpos0 + i - 1;
        x[i] = (tpos >= 0 && tpos < L) ? *reinterpret_cast<const float4*>(pr + (ptrdiff_t)(i - 1) * DIN) : make_float4(0.f, 0.f, 0.f, 0.f);
      }
#pragma unroll
      for (int tt = 0; tt < 16; ++tt) {
        float4 f;
        f.x = w0.x * x[tt].x + w1.x * x[tt + 1].x + w2.x * x[tt + 2].x;
        f.y = w0.y * x[tt].y + w1.y * x[tt + 1].y + w2.y * x[tt + 2].y;
        f.z = w0.z * x[tt].z + w1.z * x[tt + 1].z + w2.z * x[tt + 2].z;
        f.w = w0.w * x[tt].w + w1.w * x[tt + 1].w + w2.w * x[tt + 2].w;
        if (c < 768) { *reinterpret_cast<float4*>(F + tt * FLD + c) = f; }
        else {
          const int cc = c - 768;
          if (cc < 128) { f.x = tanhf(f.x); f.y = tanhf(f.y); f.z = tanhf(f.z); f.w = tanhf(f.w); }
          else if (cc >= 256) { f.x = sigmoidf_(f.x); f.y = sigmoidf_(f.y); f.z = sigmoidf_(f.z); f.w = sigmoidf_(f.w); }
          uint2 pk; pk.x = pack2(f.x, f.y); pk.y = pack2(f.z, f.w);
          *reinterpret_cast<uint2*>(LIb + tt * LLD + cc) = pk;
        }
      }
    }
    __syncthreads();
    f32x4 acc[5][4];
#pragma unroll
    for (int g = 0; g < 5; ++g)
#pragma unroll
      for (int nf = 0; nf < 4; ++nf) acc[g][nf] = (f32x4){0.f, 0.f, 0.f, 0.f};
#pragma unroll
    for (int g = 0; g < 4; ++g) {
      const u16* wt = LW + (size_t)g * 16384;
#pragma unroll
      for (int ks = 0; ks < 2; ++ks) {
        const bf16x8 xb = *reinterpret_cast<const bf16x8*>(LIb + fr * LLD + g * 64 + ks * 32 + fq * 8);
#pragma unroll
        for (int nf = 0; nf < 4; ++nf) {
          const bf16x8 wa = *reinterpret_cast<const bf16x8*>(wt + (size_t)(64 * wid + 16 * nf + fr) * 64 + ks * 32 + fq * 8);
          acc[g][nf] = __builtin_amdgcn_mfma_f32_16x16x32_bf16(wa, xb, acc[g][nf], 0, 0, 0);
        }
      }
      __builtin_amdgcn_sched_barrier(0);
    }
    {
      const u16* wt = LW + 65536;
#pragma unroll
      for (int ks = 0; ks < 4; ++ks) {
        const bf16x8 xb = *reinterpret_cast<const bf16x8*>(LIb + fr * LLD + 256 + ks * 32 + fq * 8);
#pragma unroll
        for (int nf = 0; nf < 4; ++nf) {
          const bf16x8 wa = *reinterpret_cast<const bf16x8*>(wt + (size_t)(64 * wid + 16 * nf + fr) * 128 + ks * 32 + fq * 8);
          acc[4][nf] = __builtin_amdgcn_mfma_f32_16x16x32_bf16(wa, xb, acc[4][nf], 0, 0, 0);
        }
        if (ks == 1) __builtin_amdgcn_sched_barrier(0);
      }
      __builtin_amdgcn_sched_barrier(0);
    }
#ifndef NO_C
    {
      const int tok = tok0 + fr;
      float ss = 0.f, bs = 0.f;
#pragma unroll
      for (int nf = 0; nf < 4; ++nf) {
        const int c0 = 64 * wid + 16 * nf + 4 * fq;
        const float4 r4 = *reinterpret_cast<const float4*>(F + fr * FLD + c0);
        const float4 k4 = *reinterpret_cast<const float4*>(F + fr * FLD + 256 + c0);
        const float4 w00 = *reinterpret_cast<const float4*>(p.in[13] + (size_t)layer * 512 + c0);
        const float4 w01 = *reinterpret_cast<const float4*>(p.in[13] + (size_t)layer * 512 + 256 + c0);
        const float4 a00 = *reinterpret_cast<const float4*>(p.in[15] + (size_t)layer * 512 + c0);
        const float4 a01 = *reinterpret_cast<const float4*>(p.in[15] + (size_t)layer * 512 + 256 + c0);
        const float4 kkw = *reinterpret_cast<const float4*>(p.in[18] + (size_t)layer * 256 + c0);
        const float4 kaw = *reinterpret_cast<const float4*>(p.in[19] + (size_t)layer * 256 + c0);
        const float4 rkw = *reinterpret_cast<const float4*>(p.in[20] + (size_t)layer * 256 + c0);
        const float rr[4] = {r4.x, r4.y, r4.z, r4.w}, kk_[4] = {k4.x, k4.y, k4.z, k4.w};
        const float w0a[4] = {w00.x, w00.y, w00.z, w00.w}, w0b[4] = {w01.x, w01.y, w01.z, w01.w};
        const float a0a[4] = {a00.x, a00.y, a00.z, a00.w}, a0b[4] = {a01.x, a01.y, a01.z, a01.w};
        const float kkw_[4] = {kkw.x, kkw.y, kkw.z, kkw.w}, kaw_[4] = {kaw.x, kaw.y, kaw.z, kaw.w}, rkw_[4] = {rkw.x, rkw.y, rkw.z, rkw.w};
#pragma unroll
        for (int r = 0; r < 4; ++r) {
          {
            const float z = -(w0a[r] + acc[0][nf][r]);
            const float sp = fmaxf(z, 0.f) + log1pf(__expf(-fabsf(z)));
            acc[0][nf][r] = __expf(-__expf(-sp - 0.5f));
          }
          {
            const float z = -(w0b[r] + acc[1][nf][r]);
            const float sp = fmaxf(z, 0.f) + log1pf(__expf(-fabsf(z)));
            acc[1][nf][r] = __expf(-__expf(-sp - 0.5f));
          }
          const float av0 = sigmoidf_(a0a[r] + acc[2][nf][r]);
          const float av1 = sigmoidf_(a0b[r] + acc[3][nf][r]);
          acc[2][nf][r] = av0; acc[3][nf][r] = av1;
          const float k = kk_[r];
          const float kq = k * kkw_[r];
          ss += kq * kq;
          const float kd0 = k * (1.f + (av0 - 1.f) * kaw_[r]);
          const float kd1 = k * (1.f + (av1 - 1.f) * kaw_[r]);
          bs += rr[r] * (kd0 + kd1) * rkw_[r];
        }
        __builtin_amdgcn_sched_barrier(0);
      }
      ss += __shfl_xor(ss, 16); ss += __shfl_xor(ss, 32);
      bs += __shfl_xor(bs, 16); bs += __shfl_xor(bs, 32);
      const float inrm = 1.f / fmaxf(sqrtf(ss), 1e-12f);
#pragma unroll
      for (int nf = 0; nf < 4; ++nf) {
        const int c0 = 64 * wid + 16 * nf + 4 * fq, n0 = 16 * nf + 4 * fq;
        const float4 r4 = *reinterpret_cast<const float4*>(F + fr * FLD + c0);
        const float4 k4 = *reinterpret_cast<const float4*>(F + fr * FLD + 256 + c0);
        const float4 v4 = *reinterpret_cast<const float4*>(F + fr * FLD + 512 + c0);
        const float4 kkw = *reinterpret_cast<const float4*>(p.in[18] + (size_t)layer * 256 + c0);
        const float4 kaw = *reinterpret_cast<const float4*>(p.in[19] + (size_t)layer * 256 + c0);
        const float kk_[4] = {k4.x, k4.y, k4.z, k4.w}, kkw_[4] = {kkw.x, kkw.y, kkw.z, kkw.w}, kaw_[4] = {kaw.x, kaw.y, kaw.z, kaw.w};
        float* sc = p.SC + ((size_t)(tok * 4 + wid) * 9) * 64 + n0;
        float kn[4], kd0[4], kd1[4];
#pragma unroll
        for (int r = 0; r < 4; ++r) {
          kn[r] = kk_[r] * kkw_[r] * inrm;
          kd0[r] = kk_[r] * (1.f + (acc[2][nf][r] - 1.f) * kaw_[r]);
          kd1[r] = kk_[r] * (1.f + (acc[3][nf][r] - 1.f) * kaw_[r]);
        }
        *reinterpret_cast<float4*>(sc) = r4;
        *reinterpret_cast<float4*>(sc + 64) = make_float4(kn[0], kn[1], kn[2], kn[3]);
        *reinterpret_cast<float4*>(sc + 128) = v4;
        *reinterpret_cast<float4*>(sc + 192) = make_float4(acc[0][nf][0], acc[0][nf][1], acc[0][nf][2], acc[0][nf][3]);
        *reinterpret_cast<float4*>(sc + 256) = make_float4(acc[2][nf][0] * kn[0], acc[2][nf][1] * kn[1], acc[2][nf][2] * kn[2], acc[2][nf][3] * kn[3]);
        *reinterpret_cast<float4*>(sc + 320) = make_float4(kd0[0], kd0[1], kd0[2], kd0[3]);
        *reinterpret_cast<float4*>(sc + 384) = make_float4(acc[1][nf][0], acc[1][nf][1], acc[1][nf][2], acc[1][nf][3]);
        *reinterpret_cast<float4*>(sc + 448) = make_float4(acc[3][nf][0] * kn[0], acc[3][nf][1] * kn[1], acc[3][nf][2] * kn[2], acc[3][nf][3] * kn[3]);
        *reinterpret_cast<float4*>(sc + 512) = make_float4(kd1[0], kd1[1], kd1[2], kd1[3]);
        *reinterpret_cast<float4*>(p.G + (size_t)tok * 256 + c0) = make_float4(acc[4][nf][0], acc[4][nf][1], acc[4][nf][2], acc[4][nf][3]);
        *reinterpret_cast<float4*>(p.BV + (size_t)tok * 256 + c0) = make_float4(bs * v4.x, bs * v4.y, bs * v4.z, bs * v4.w);
        __builtin_amdgcn_sched_barrier(0);
      }
    }
#endif
#ifndef NO_D
    const int c = tid;
#pragma unroll
    for (int half = 0; half < 2; ++half) {
      float vv[8];
#pragma unroll
      for (int t8 = 0; t8 < 8; ++t8) {
        const int tt = half * 8 + t8, tok = tok0 + tt;
        const float* pr = p.PROJ + (size_t)tok * DIN + 1152 + c;
        const float q = pr[0], k = pr[256], v = pr[512];
        vv[t8] = v;
        if (isctx) {
          const size_t oi = ((size_t)(b * 4 + layer) * 256 + tpos0 + tt) * 256 + c;
          p.out_nak[oi] = k; p.out_nav[oi] = v;
          p.QNc[(size_t)tok * 256 + c] = f2bf(q * QSCALE);
          p.KNc[(size_t)(b * 4 + (c >> 6)) * 16384 + kf_off(tpos0 + tt, c & 63)] = f2bf(k);
        } else {
          p.QNl[(size_t)(tok - NCTX) * 256 + c] = f2bf(q * QSCALE);
          p.KNl[((size_t)((layer * 2 + b) * 4 + (c >> 6))) * 98304 + kf_off(512 + tpos0 + tt, c & 63)] = f2bf(k);
        }
      }
      if (isctx) pack44_store(p.VNtc + (size_t)(b * 4 + (c >> 6)) * 16384, tpos0 + half * 8, c & 63, vv);
      else pack44_store(p.VNtl + ((size_t)((layer * 2 + b) * 4 + (c >> 6))) * 98304, 512 + tpos0 + half * 8, c & 63, vv);
    }
    {
      const float qn = p.in[24][(size_t)layer * 64 + lane], kn = p.in[25][(size_t)layer * 64 + lane];
      const int fi = lane & 15;
#pragma unroll
      for (int half = 0; half < 2; ++half) {
        float vv[8];
#pragma unroll
        for (int t8 = 0; t8 < 8; ++t8) {
          const int tt = half * 8 + t8, tok = tok0 + tt, tpos = tpos0 + tt;
          const float* pr = p.PROJ + (size_t)tok * DIN + 1920;
          float cs = 1.f, sn = 0.f;
          if (!isctx) {
            const int pos = (lane < 32) ? (tpos >> 6) : (tpos & 63);
            const float2 t2 = *reinterpret_cast<const float2*>(p.rope + (size_t)(pos * 16 + fi) * 2);
            cs = t2.x; sn = t2.y;
            if ((lane & 16) == 0) sn = -sn;
          }
#pragma unroll
          for (int hh = 0; hh < 2; ++hh) {
            float q = pr[hh * 256 + c];
            const float ms = wave_sum(q * q) * (1.f / 64.f);
            q = q * rsqrtf(ms + 1e-6f) * qn;
            if (!isctx) { const float qp = __shfl_xor(q, 16); q = q * cs + qp * sn; }
            if (isctx) p.QGc[(size_t)tok * 512 + hh * 256 + c] = f2bf(q * QSCALE);
            else p.QGl[(size_t)(tok - NCTX) * 512 + hh * 256 + c] = f2bf(q * QSCALE);
          }
          if (wid < 2) {
            float k = pr[512 + c];
            const float ms = wave_sum(k * k) * (1.f / 64.f);
            k = k * rsqrtf(ms + 1e-6f) * kn;
            if (isctx) {
              p.out_gk[((size_t)(b * 4 + layer) * 256 + tpos) * 128 + c] = k;
              p.KGc[(size_t)(b * 2 + (c >> 6)) * 16384 + kf_off(tpos, c & 63)] = f2bf(k);
            } else {
              const float kp = __shfl_xor(k, 16); k = k * cs + kp * sn;
              p.KGl[((size_t)((layer * 2 + b) * 2 + (c >> 6))) * 98304 + kf_off(512 + tpos, c & 63)] = f2bf(k);
            }
          } else {
            const int cv = c - 128;
            const float v = pr[640 + cv];
            vv[t8] = v;
            if (isctx) p.out_gv[((size_t)(b * 4 + layer) * 256 + tpos) * 128 + cv] = v;
          }
        }
        if (wid >= 2) {
          const int cv = c - 128;
          if (isctx) pack44_store(p.VGtc + (size_t)(b * 2 + (cv >> 6)) * 16384, tpos0 + half * 8, cv & 63, vv);
          else pack44_store(p.VGtl + ((size_t)((layer * 2 + b) * 2 + (cv >> 6))) * 98304, 512 + tpos0 + half * 8, cv & 63, vv);
        }
      }
    }
#endif
    __syncthreads();
  }
}

#define ATT_LOAD(KF, VF, CI) { \
    const int ci_ = min((CI), nt - 1); \
    int kb_; \
    if (ci_ < nd) kb_ = ci_ * 32; \
    else { const int e_ = ci_ - nd; const int j_ = (ncc == 2) ? (e_ >> 1) : e_; const int cc_ = cc0 + ((ncc == 2) ? (e_ & 1) : 0); kb_ = 512 + (rb + j_) * 64 + cc_ * 32; } \
    const u16* kp_ = Kb + (size_t)(kb_ >> 4) * 1024 + lane * 8; \
    KF##00 = *reinterpret_cast<const bf16x8*>(kp_); \
    KF##01 = *reinterpret_cast<const bf16x8*>(kp_ + 512); \
    KF##10 = *reinterpret_cast<const bf16x8*>(kp_ + 1024); \
    KF##11 = *reinterpret_cast<const bf16x8*>(kp_ + 1536); \
    const u16* vp_ = Vt + (size_t)(kb_ >> 5) * 2048 + lane * 8; \
    VF##0 = *reinterpret_cast<const bf16x8*>(vp_); \
    VF##1 = *reinterpret_cast<const bf16x8*>(vp_ + 512); \
    VF##2 = *reinterpret_cast<const bf16x8*>(vp_ + 1024); \
    VF##3 = *reinterpret_cast<const bf16x8*>(vp_ + 1536); }

#define ATT_PV(DT, VV) { \
    o[DT][0] *= alpha; o[DT][1] *= alpha; o[DT][2] *= alpha; o[DT][3] *= alpha; \
    o[DT] = __builtin_amdgcn_mfma_f32_16x16x32_bf16(VV, pf.v, o[DT], 0, 0, 0); }

#define ATT_COMPUTE(KF, VF, CI) { \
    const int ci_ = (CI); \
    f32x4 s0 = (f32x4){0.f, 0.f, 0.f, 0.f}, s1 = (f32x4){0.f, 0.f, 0.f, 0.f}; \
    s0 = __builtin_amdgcn_mfma_f32_16x16x32_bf16(KF##00, qf0, s0, 0, 0, 0); \
    s0 = __builtin_amdgcn_mfma_f32_16x16x32_bf16(KF##01, qf1, s0, 0, 0, 0); \
    s1 = __builtin_amdgcn_mfma_f32_16x16x32_bf16(KF##10, qf0, s1, 0, 0, 0); \
    s1 = __builtin_amdgcn_mfma_f32_16x16x32_bf16(KF##11, qf1, s1, 0, 0, 0); \
    float sv[8] = {s0[0], s0[1], s0[2], s0[3], s1[0], s1[1], s1[2], s1[3]}; \
    bool ok[8]; \
    _Pragma("unroll") for (int e = 0; e < 8; ++e) ok[e] = true; \
    if (ci_ >= nd) { \
      const int e_ = ci_ - nd; const int j_ = (ncc == 2) ? (e_ >> 1) : e_; const int cc_ = cc0 + ((ncc == 2) ? (e_ & 1) : 0); \
      const int dr_ = rb + j_ - grow + 7; \
      const int cq = cq0 + fr, c0 = min(max(cq - 8, 0), 48); \
      _Pragma("unroll") for (int e = 0; e < 8; ++e) { \
        const int ck = cc_ * 32 + 16 * (e >> 2) + 4 * fq + (e & 3); \
        ok[e] = (ck >= c0) && (ck < c0 + 16); \
        const int dc = min(max(ck - cq, -15), 15) + 15; \
        const float bias = rpb[dr_ * 31 + dc] * LOG2E; \
        sv[e] = ok[e] ? sv[e] + bias : -1e30f; \
      } \
    } \
    float mx = fmaxf(fmaxf(fmaxf(sv[0], sv[1]), fmaxf(sv[2], sv[3])), fmaxf(fmaxf(sv[4], sv[5]), fmaxf(sv[6], sv[7]))); \
    mx = fmaxf(mx, __shfl_xor(mx, 16)); \
    mx = fmaxf(mx, __shfl_xor(mx, 32)); \
    const float mn = fmaxf(m, mx); \
    const float alpha = exp2f(m - mn); \
    m = mn; \
    float ps = 0.f; \
    _Pragma("unroll") for (int e = 0; e < 8; ++e) { sv[e] = ok[e] ? exp2f(sv[e] - mn) : 0.f; ps += sv[e]; } \
    l = l * alpha + ps; \
    union { bf16x8 v; unsigned u[4]; } pf; \
    pf.u[0] = pack2(sv[0], sv[1]); pf.u[1] = pack2(sv[2], sv[3]); pf.u[2] = pack2(sv[4], sv[5]); pf.u[3] = pack2(sv[6], sv[7]); \
    ATT_PV(0, VF##0) ATT_PV(1, VF##1) ATT_PV(2, VF##2) ATT_PV(3, VF##3) }

__device__ __forceinline__ void attn_wave(const u16* __restrict__ Q, int ldq, const u16* __restrict__ Kb, int ldk,
                                          const u16* __restrict__ Vt, int ldv, int ndense, const bool NA,
                                          const float* __restrict__ rpb, int grow, int cq0,
                                          u16* __restrict__ out, int ldo, int tidx) {
  const int lane = tidx & 63, fr = lane & 15, fq = lane >> 4;
  const bf16x8 qf0 = *reinterpret_cast<const bf16x8*>(Q + (size_t)fr * ldq + fq * 8);
  const bf16x8 qf1 = *reinterpret_cast<const bf16x8*>(Q + (size_t)fr * ldq + 32 + fq * 8);
  f32x4 o[4];
#pragma unroll
  for (int dt = 0; dt < 4; ++dt) o[dt] = (f32x4){0.f, 0.f, 0.f, 0.f};
  float m = -1e30f, l = 0.f;
  const int nd = ndense >> 5;
  const int rb = min(max(grow - 4, 0), 8);
  const int ulo = min(max(cq0 - 8, 0), 48), uhi = min(max(cq0 + 15 - 8, 0), 48) + 16;
  const bool c0ok = ulo < 32, c1ok = uhi > 32;
  const int ncc = (c0ok && c1ok) ? 2 : 1, cc0 = c0ok ? 0 : 1;
  const int nt = nd + (NA ? 8 * ncc : 0);
  bf16x8 ka00, ka01, ka10, ka11, kb00, kb01, kb10, kb11;
  bf16x8 va0, va1, va2, va3, vb0, vb1, vb2, vb3;
  ATT_LOAD(ka, va, 0)
  for (int ci = 0; ci < nt; ci += 2) {
    ATT_LOAD(kb, vb, ci + 1)
    ATT_COMPUTE(ka, va, ci)
    if (ci + 1 < nt) {
      ATT_LOAD(ka, va, ci + 2)
      ATT_COMPUTE(kb, vb, ci + 1)
    }
  }
  l += __shfl_xor(l, 16);
  l += __shfl_xor(l, 32);
  const float il = 1.f / l;
#pragma unroll
  for (int dt = 0; dt < 4; ++dt) {
    uint2 pk; pk.x = pack2(o[dt][0] * il, o[dt][1] * il); pk.y = pack2(o[dt][2] * il, o[dt][3] * il);
    *reinterpret_cast<uint2*>(out + (size_t)fr * ldo + 16 * dt + 4 * fq) = pk;
  }
}

__device__ void scan_item(const Params& p, int layer, char* smem, bool lat, int b, int h, int dir, int qd, int tidx) {
  const int tid = tidx, lane = tid & 63, wid = tid >> 6, rr = lane >> 4, j = lane & 15;
  const int L = lat ? 1024 : 256, seqbase = lat ? NCTX + b * 1024 : b * 256;
  const int rowl = wid * 4 + rr, row = qd * 16 + rowl;
  float* cbuf = reinterpret_cast<float*>(smem);
  float* obuf = cbuf + 2 * 16 * 6 * 64;
  float4 S = make_float4(0.f, 0.f, 0.f, 0.f);
  if (lat) S = *reinterpret_cast<const float4*>(p.in[2] + ((((size_t)(b * 4 + layer) * 2 + dir) * 4 + h) * 64 + row) * 64 + 4 * j);
  const int nch = L / 16;
  float* odst = dir == 0 ? p.OF : p.OB;
  float4 pre0, pre1, pre2, pre3, pre4, pre5;
#define SC_GL1(PR, I, CH) { const int idx = tid + 256 * (I), tt_ = idx / 96, rem = idx % 96, vec = rem >> 4, f4 = rem & 15; \
    const int st_ = (CH) * 16 + tt_, t_ = dir == 0 ? st_ : L - 1 - st_; const int svec = vec < 3 ? vec : vec + 3 * dir; \
    PR = *reinterpret_cast<const float4*>(p.SC + ((size_t)((seqbase + t_) * 4 + h) * 9 + svec) * 64 + f4 * 4); }
#define gload(CH) { SC_GL1(pre0, 0, CH) SC_GL1(pre1, 1, CH) SC_GL1(pre2, 2, CH) SC_GL1(pre3, 3, CH) SC_GL1(pre4, 4, CH) SC_GL1(pre5, 5, CH) }
#define SC_LS1(PR, I, BUF) *reinterpret_cast<float4*>(cbuf + (BUF) * 6144 + (tid + 256 * (I)) * 4) = PR;
#define lstore(BUF) { SC_LS1(pre0, 0, BUF) SC_LS1(pre1, 1, BUF) SC_LS1(pre2, 2, BUF) SC_LS1(pre3, 3, BUF) SC_LS1(pre4, 4, BUF) SC_LS1(pre5, 5, BUF) }
  gload(0); lstore(0);
  __syncthreads();
#define SC_LD(R4, K4, VV, W4, A4, D4, TT) { const float* base_ = cb + (TT) * 384; \
    R4 = *reinterpret_cast<const float4*>(base_ + 4 * j); K4 = *reinterpret_cast<const float4*>(base_ + 64 + 4 * j); \
    VV = base_[128 + row]; W4 = *reinterpret_cast<const float4*>(base_ + 192 + 4 * j); \
    A4 = *reinterpret_cast<const float4*>(base_ + 256 + 4 * j); D4 = *reinterpret_cast<const float4*>(base_ + 320 + 4 * j); }
  for (int ch = 0; ch < nch; ++ch) {
#if REPMASK
    if (ch + 1 < nch && p.pad != 5) gload(ch + 1);
#else
    if (ch + 1 < nch) gload(ch + 1);
#endif
    const float* cb = cbuf + (ch & 1) * 6144;
    float osel = 0.f;
    float4 r4, kk4, w4, ak4, kd4; float vv;
    SC_LD(r4, kk4, vv, w4, ak4, kd4, 0)
    float ovp = 0.f;
#pragma unroll 4
    for (int tt = 0; tt < 16; ++tt) {
      float4 r4n, kk4n, w4n, ak4n, kd4n; float vvn;
      SC_LD(r4n, kk4n, vvn, w4n, ak4n, kd4n, tt + 1)
      float sk = (S.x * kk4.x + S.y * kk4.y) + (S.z * kk4.z + S.w * kk4.w);
      sk += dpp_mov<0xB1>(sk);  ovp += dpp_mov<0xB1>(ovp);
      sk += dpp_mov<0x4E>(sk);  ovp += dpp_mov<0x4E>(ovp);
      sk += dpp_mov<0x141>(sk); ovp += dpp_mov<0x141>(ovp);
      sk += dpp_mov<0x140>(sk); ovp += dpp_mov<0x140>(ovp);
      osel = (j == tt - 1) ? ovp : osel;
      const float tx = vv * kd4.x - sk * ak4.x, ty = vv * kd4.y - sk * ak4.y, tz = vv * kd4.z - sk * ak4.z, tw = vv * kd4.w - sk * ak4.w;
      S.x = S.x * w4.x + tx; S.y = S.y * w4.y + ty; S.z = S.z * w4.z + tz; S.w = S.w * w4.w + tw;
      ovp = (S.x * r4.x + S.y * r4.y) + (S.z * r4.z + S.w * r4.w);
      r4 = r4n; kk4 = kk4n; w4 = w4n; ak4 = ak4n; kd4 = kd4n; vv = vvn;
    }
    ovp = reduce16(ovp);
    osel = (j == 15) ? ovp : osel;
    {
      const int st = ch * 16 + j, t = dir == 0 ? st : L - 1 - st;
      odst[(size_t)(seqbase + t) * 256 + h * 64 + row] = osel;
    }
#if REPMASK
    if (ch + 1 < nch && p.pad != 5) lstore((ch + 1) & 1);
#else
    if (ch + 1 < nch) lstore((ch + 1) & 1);
#endif
    asm volatile("s_waitcnt lgkmcnt(0)" ::: "memory");
    __builtin_amdgcn_s_barrier();
  }
  if (!lat) *reinterpret_cast<float4*>(p.out_st + ((((size_t)(b * 4 + layer) * 2 + dir) * 4 + h) * 64 + row) * 64 + 4 * j) = S;
  __syncthreads();
}

__device__ void mixer_phase(const Params& p, int layer, char* smem, int tidx0) {
  int* slot = reinterpret_cast<int*>(smem + 60 * 1024);
  for (;;) {
    int tidx = tidx0;
    asm volatile("" : "+v"(tidx));
    const int tid = tidx, wid = tid >> 6;
    __syncthreads();
    if (tid == 0) *slot = (int)atomicAdd(&p.wq[layer], 1u);
    __syncthreads();
    int it = *slot;
    if (it >= 1728) break;
    const bool is_scan = (it < 64) || (it >= 448 && it < 960);
#if REPMASK
    if ((p.pad == 1 && !is_scan) || (p.pad == 2 && is_scan) || ((p.pad == 3 || p.pad == 5 || p.pad == 6) && !(it < 64)) || (p.pad == 4 && !(it >= 64 && it < 320))) continue;
#endif
    if (is_scan) {
      const bool lat = it < 64;
      const int si = lat ? it : it - 448;
#ifndef NO_SCAN
      scan_item(p, layer, smem, lat, si / 32, (si / 8) % 4, (si / 4) % 2, si % 4, tidx);
#endif
      continue;
    }
    const u16 *Q, *Kb, *Vt; u16* out; int ldq, ldk, ldv, ndense, grow = 0, cq0 = 0; bool na = false;
    const float* rpb = p.in[23];
    if (it < 320) {
      it -= 64;
      const int b = it / 128, qh = (it / 16) % 8, qt = it % 16, kvh = qh >> 2;
      const int q0 = b * 1024 + qt * 64 + wid * 16;
      Q = p.QGl + (size_t)q0 * 512 + qh * 64; ldq = 512;
      Kb = p.KGl + (size_t)((layer * 2 + b) * 2 + kvh) * 98304; ldk = 0;
      Vt = p.VGtl + (size_t)((layer * 2 + b) * 2 + kvh) * 98304; ldv = 0; ndense = 1536;
      out = p.MIX + (size_t)(NCTX + q0) * DM + 512 + qh * 64;
    } else if (it < 448) {
      it -= 320;
      const int b = it / 64, h = (it / 16) % 4, r = it % 16;
      const int q0 = b * 1024 + r * 64 + wid * 16;
      Q = p.QNl + (size_t)q0 * 256 + h * 64; ldq = 256;
      Kb = p.KNl + (size_t)((layer * 2 + b) * 4 + h) * 98304; ldk = 0;
      Vt = p.VNtl + (size_t)((layer * 2 + b) * 4 + h) * 98304; ldv = 0; ndense = 512;
      rpb = p.in[23] + (size_t)(layer * 4 + h) * 15 * 31; grow = r; cq0 = wid * 16; na = true;
      out = p.MIX + (size_t)(NCTX + q0) * DM + 256 + h * 64;
    } else if (it < 1472) {
      it -= 960;
      const int b = it / 32, qh = (it / 4) % 8, qt = it % 4, kvh = qh >> 2;
      const int q0 = b * 256 + qt * 64 + wid * 16;
      Q = p.QGc + (size_t)q0 * 512 + qh * 64; ldq = 512;
      Kb = p.KGc + (size_t)(b * 2 + kvh) * 16384; ldk = 0;
      Vt = p.VGtc + (size_t)(b * 2 + kvh) * 16384; ldv = 0; ndense = 256;
      out = p.MIX + (size_t)q0 * DM + 512 + qh * 64;
    } else {
      it -= 1472;
      const int b = it / 16, h = (it / 4) % 4, qt = it % 4;
      const int q0 = b * 256 + qt * 64 + wid * 16;
      Q = p.QNc + (size_t)q0 * 256 + h * 64; ldq = 256;
      Kb = p.KNc + (size_t)(b * 4 + h) * 16384; ldk = 0;
      Vt = p.VNtc + (size_t)(b * 4 + h) * 16384; ldv = 0; ndense = 256;
      out = p.MIX + (size_t)q0 * DM + 256 + h * 64;
    }
#ifndef NO_ATT
    attn_wave(Q, ldq, Kb, ldk, Vt, ldv, ndense, na, rpb, grow, cq0, out, DM, tidx);
#endif
  }
}

__device__ void rwkv_fin_phase(const Params& p, int layer, int bid, int nblk, int tidx) {
  const int tid = tidx;
  const float lw = p.in[21][(size_t)layer * 256 + tid], lb = p.in[22][(size_t)layer * 256 + tid];
  for (int t4 = bid; t4 < NTOK / 4; t4 += nblk) {
    float of[4], ob[4], bv[4], gg[4];
#pragma unroll
    for (int u = 0; u < 4; ++u) {
      const size_t i = (size_t)(t4 * 4 + u) * 256 + tid;
      of[u] = p.OF[i]; ob[u] = p.OB[i]; bv[u] = p.BV[i]; gg[u] = p.G[i];
    }
#pragma unroll
    for (int u = 0; u < 4; ++u) {
      const float o = of[u] + ob[u];
      const float mu = wave_sum(o) * (1.f / 64.f);
      const float d = o - mu;
      const float var = wave_sum(d * d) * (1.f / 64.f);
      const float y = (d * rsqrtf(var + 64e-5f) * lw + lb + bv[u]) * gg[u];
      p.MIX[(size_t)(t4 * 4 + u) * DM + tid] = f2bf(y);
    }
  }
}

#ifndef ONLY_PH
#define ONLY_PH -1
#endif
#define PH_EN(x) (ONLY_PH < 0 || ONLY_PH == (x))
__device__ __forceinline__ void run_phase(const Params& p, int ph, char* smem, int bid, int nblk, int tidx) {
  if (ph == 0) { if (PH_EN(0)) setup_phase(p, smem, bid, nblk, tidx); return; }
  if (ph == 1) { if (PH_EN(1)) modreduce_phase(p, bid, nblk, tidx); return; }
  if (ph == 2) { if (PH_EN(2)) ln_phase<0>(p, 0, bid, nblk, tidx); return; }
  const int layer = (ph - 3) / 9, s = (ph - 3) % 9;
  switch (s) {
    case 0: if (PH_EN(3)) gemm_phase<EPI_PROJ, 256, 3>(p, layer, p.A, p.winT + (size_t)layer * DIN * DM, DIN, DM, smem, bid, nblk, tidx); break;
    case 1: if (PH_EN(4)) prep_phase(p, layer, smem, bid, nblk, tidx); break;
    case 2: if (PH_EN(5)) mixer_phase(p, layer, smem, tidx); break;
    case 3: if (PH_EN(6)) rwkv_fin_phase(p, layer, bid, nblk, tidx); break;
    case 4: if (PH_EN(7)) gemm_phase<EPI_OUT, 192, 3>(p, layer, p.MIX, p.woutT + (size_t)layer * DM * DM, DM, DM, smem, bid, nblk, tidx); break;
    case 5: if (PH_EN(8)) ln_phase<1>(p, layer, bid, nblk, tidx); break;
    case 6: if (PH_EN(9)) gemm_phase<EPI_FFI, 192, 3>(p, layer, p.A, p.wfiT + (size_t)layer * 2 * DFF * DM, 2 * DFF, DM, smem, bid, nblk, tidx); break;
    case 7: if (PH_EN(10)) gemm_phase<EPI_FFO, 192, 3>(p, layer, p.ACT, p.wfoT + (size_t)layer * DM * DFF, DM, DFF, smem, bid, nblk, tidx); break;
    default: if (PH_EN(11)) ln_phase<2>(p, layer, bid, nblk, tidx); break;
  }
}

__global__ void __launch_bounds__(256, 2) fwd_kernel(Params p, int ph0, int ph1, int usebar) {
  __shared__ __attribute__((aligned(16))) char smem[73728 + 16];
  const int bid = blockIdx.x, nblk = gridDim.x;
  XcdBarrier xb;
  if (usebar && p.never) cg::this_grid().sync();
  if (usebar) {
    if (threadIdx.x == 0) *reinterpret_cast<uint4*>(smem + 73728) = make_uint4(0u, 0u, 0u, 0u);
    __syncthreads();
    xb = xcd_barrier_post(p.bar, (volatile LAS unsigned*)(smem + 73728));
  }
  for (int ph = ph0; ph < ph1; ++ph) {
    int tidx = threadIdx.x;
    asm volatile("" : "+v"(tidx));
    run_phase(p, ph, smem, bid, nblk, tidx);
#if REPMASK
    {
      const int slot_ = ph < 3 ? 9 + ph : (ph - 3) % 9;
      if ((REPMASK >> slot_) & 1) {
        if (usebar) xcd_barrier(xb);
        Params p2 = p; p2.wq = p.wq + 4; p2.pad = REPVAR;
        if (REPVAR >= 5) { p2.OF = p.PROJ; p2.OB = p.PROJ; p2.out_st = p.PROJ + 4000000; p2.MIX = (u16*)(p.PROJ + 8000000); }
        run_phase(p2, ph, smem, bid, nblk, tidx);
      }
    }
#endif
    if (usebar && ph + 1 < ph1) xcd_barrier(xb);
  }
}

static inline size_t al256(size_t x) { return (x + 255) & ~(size_t)255; }

extern "C" void kernel_launch(void* const* d_in, const int* in_sizes, int n_in, void* d_out, int out_size, void* d_ws, size_t ws_size,
                              hipStream_t stream) {
  Params p;
  memset(&p, 0, sizeof(p));
  for (int i = 0; i < 33; ++i) p.in[i] = (const float*)d_in[i];
  float* o = (float*)d_out;
  p.out_yp = o; o += 4194304;
  p.out_ys = o; o += 2097152;
  p.out_st = o; o += 2097152;
  p.out_nak = o; o += 4194304;
  p.out_nav = o; o += 4194304;
  p.out_gk = o; o += 2097152;
  p.out_gv = o;
  char* w = (char*)d_ws; size_t off = 0;
  auto take = [&](size_t bytes) { char* r = w + off; off += al256(bytes); return r; };
  p.bar = (unsigned*)take(16384);
  p.wq = p.bar + 3584;
  p.modp = (float*)take((size_t)4 * 32 * 3 * 6144 * 4);
  p.mod = (float*)take((size_t)4 * 3 * 6144 * 4);
  p.winT = (u16*)take((size_t)4 * DIN * DM * 2);
  p.woutT = (u16*)take((size_t)4 * DM * DM * 2);
  p.wfiT = (u16*)take((size_t)4 * 2 * DFF * DM * 2);
  p.wfoT = (u16*)take((size_t)4 * DM * DFF * 2);
  p.X = (float*)take((size_t)NTOK * DM * 4);
  p.PROJ = (float*)take((size_t)NTOK * DIN * 4);
  p.X1 = p.PROJ;
  p.Y = p.PROJ + (size_t)NTOK * DM;
  p.SC = (float*)take((size_t)NTOK * 4 * 9 * 64 * 4);
  p.ACT = (u16*)p.SC;
  p.G = (float*)take((size_t)NTOK * 256 * 4);
  p.BV = (float*)take((size_t)NTOK * 256 * 4);
  p.OF = (float*)take((size_t)NTOK * 256 * 4);
  p.OB = (float*)take((size_t)NTOK * 256 * 4);
  p.A = (u16*)take((size_t)NTOK * DM * 2);
  p.MIX = (u16*)take((size_t)NTOK * DM * 2);
  p.QNc = (u16*)take((size_t)NCTX * 256 * 2);
  p.KNc = (u16*)take((size_t)NCTX * 256 * 2);
  p.VNtc = (u16*)take((size_t)NCTX * 256 * 2);
  p.QGc = (u16*)take((size_t)NCTX * 512 * 2);
  p.KGc = (u16*)take((size_t)NCTX * 128 * 2);
  p.VGtc = (u16*)take((size_t)NCTX * 128 * 2);
  p.QNl = (u16*)take((size_t)2048 * 256 * 2);
  p.KNl = (u16*)take((size_t)4 * 2 * 1536 * 256 * 2);
  p.VNtl = (u16*)take((size_t)4 * 2 * 1536 * 256 * 2);
  p.QGl = (u16*)take((size_t)2048 * 512 * 2);
  p.KGl = (u16*)take((size_t)4 * 2 * 1536 * 128 * 2);
  p.VGtl = (u16*)take((size_t)4 * 2 * 1536 * 128 * 2);
  p.loraT = (u16*)take((size_t)4 * 98304 * 2);
  p.rope = (float*)take((size_t)64 * 16 * 2 * 4);
  if (off > ws_size) { fprintf(stderr, "workspace too small: need %zu have %zu\n", off, ws_size); return; }

  (void)hipMemsetAsync(p.bar, 0, 16384, stream);
#if MEGA
  static int grid_blocks = 0;
  if (!grid_blocks) {
    int dev = 0, cus = 0, per_cu = 0;
    hipGetDevice(&dev);
    hipDeviceGetAttribute(&cus, hipDeviceAttributeMultiprocessorCount, dev);
    hipOccupancyMaxActiveBlocksPerMultiprocessor(&per_cu, fwd_kernel, 256, 0);
    if (per_cu > 2) per_cu = 2;
    if (per_cu < 1) per_cu = 1;
    grid_blocks = cus * per_cu;
  }
  int ph0 = 0, ph1 = NPH, ub = 1;
  void* args[] = {&p, &ph0, &ph1, &ub};
  hipError_t e = hipLaunchCooperativeKernel((void*)fwd_kernel, dim3(grid_blocks), dim3(256), args, 0, stream);
  if (e != hipSuccess) fprintf(stderr, "cooperative launch failed: %s (grid %d)\n", hipGetErrorString(e), grid_blocks);
#else
  for (int ph = 0; ph < NPH; ++ph) fwd_kernel<<<512, 256, 0, stream>>>(p, ph, ph + 1, 0);
#endif
}
```

```cpp
#include <hip/hip_runtime.h>
#include <hip/hip_cooperative_groups.h>
#include <cstdio>
#include <cstdint>
#include <cstring>
namespace cg = cooperative_groups;

#ifndef REPMASK
#define REPMASK 0
#endif
#ifndef REPVAR
#define REPVAR 0
#endif
#ifndef MEGA
#define MEGA 1
#endif

typedef unsigned short u16;
using bf16x8 = __attribute__((ext_vector_type(8))) short;
using f32x4 = __attribute__((ext_vector_type(4))) float;

#define NTOK 6144
#define NCTX 4096
#define DM 1024
#define DIN 2688
#define DFF 2816
#define NPH 39
#define ALPHA 1.681792830507429f
#define LOG2E 1.4426950408889634f
#define QSCALE (0.125f * LOG2E)

struct Params {
  const float* in[33];
  float *out_yp, *out_ys, *out_st, *out_nak, *out_nav, *out_gk, *out_gv;
  unsigned *bar, *wq;
  float *modp, *mod;
  u16 *winT, *woutT, *wfiT, *wfoT;
  float *X, *X1, *Y, *PROJ, *SC, *G, *BV, *OF, *OB;
  u16 *A, *MIX, *ACT;
  u16 *QNc, *KNc, *VNtc, *QGc, *KGc, *VGtc;
  u16 *QNl, *KNl, *VNtl, *QGl, *KGl, *VGtl;
  u16* loraT; float* rope;
  int never; int pad;
};

__device__ __forceinline__ u16 f2bf(float f) {
  unsigned u = __float_as_uint(f);
  u += 0x7FFFu + ((u >> 16) & 1u);
  return (u16)(u >> 16);
}
__device__ __forceinline__ unsigned pack2(float a, float b) { return (unsigned)f2bf(a) | ((unsigned)f2bf(b) << 16); }
template <int CTRL> __device__ __forceinline__ float dpp_mov(float v) {
  return __int_as_float(__builtin_amdgcn_update_dpp(0, __float_as_int(v), CTRL, 0xF, 0xF, false));
}
__device__ __forceinline__ float reduce16(float v) {
  v += dpp_mov<0xB1>(v);
  v += dpp_mov<0x4E>(v);
  v += dpp_mov<0x141>(v);
  v += dpp_mov<0x140>(v);
  return v;
}
__device__ __forceinline__ float wave_sum(float v) {
  v = reduce16(v);
  v += __shfl_xor(v, 16);
  v += __shfl_xor(v, 32);
  return v;
}
__device__ __forceinline__ float sigmoidf_(float x) { return 1.f / (1.f + __expf(-x)); }
__device__ __forceinline__ float siluf_(float x) { return x / (1.f + __expf(-x)); }
__device__ __forceinline__ int modrow_of(int tok) { return tok < NCTX ? 0 : 1 + ((tok - NCTX) >> 10); }

#define XB_TMO      128
#define XB_XCNT(j)  (256  + 64 * (j))
#define XB_XSUB(j)  (1280 + 64 * (j))
#define XB_XGEN(j)  (2304 + 64 * (j))
#define XB_TOP      3328
#define XB_TOPGEN   3392
#define XCD_BAR_WORDS 3456
#define XB_SPIN_CAP (1u << 22)
#define LAS __attribute__((address_space(3)))
__device__ __forceinline__ unsigned xb_ld(unsigned* p) { return __hip_atomic_load(p, __ATOMIC_RELAXED, __HIP_MEMORY_SCOPE_AGENT); }
__device__ __forceinline__ unsigned xb_add(unsigned* p, unsigned v) { return __hip_atomic_fetch_add(p, v, __ATOMIC_RELAXED, __HIP_MEMORY_SCOPE_AGENT); }
__device__ __forceinline__ unsigned xb_xcc_id() { return (unsigned)__builtin_amdgcn_s_getreg((3 << 11) | 20) & 0xFu; }
#define XB_SPIN(cond, bar) do { unsigned _sp = 0; while (cond) { __builtin_amdgcn_s_sleep(1); \
    if ((++_sp & 255u) == 0u) { if (xb_ld(&(bar)[XB_TMO])) break; if (_sp > XB_SPIN_CAP) { atomicAdd(&(bar)[XB_TMO], 1u); break; } } } } while (0)
struct XcdBarrier { unsigned* bar; unsigned x; volatile LAS unsigned* st; };
__device__ __forceinline__ XcdBarrier xcd_barrier_post(unsigned* bar, volatile LAS unsigned* st) {
  XcdBarrier b; b.bar = bar; b.x = xb_xcc_id(); b.st = st;
  if (threadIdx.x == 0) (void)xb_add(&bar[XB_XCNT(b.x)], 1u);
  return b;
}
__device__ __forceinline__ void xcd_barrier_complete(unsigned* bar, unsigned x, unsigned& nloc, unsigned& nx) {
  const unsigned G = gridDim.x * gridDim.y * gridDim.z;
  unsigned sum, cnt, mine, sp = 0u;
  for (;;) {
    sum = 0u; cnt = 0u; mine = 0u;
#pragma unroll
    for (unsigned j = 0; j < 16; ++j) { const unsigned c = xb_ld(&bar[XB_XCNT(j)]); sum += c; cnt += (c > 0u) ? 1u : 0u; mine = (j == x) ? c : mine; }
    if (sum == G) break;
    __builtin_amdgcn_s_sleep(1);
    if ((++sp & 255u) == 0u) { if (xb_ld(&bar[XB_TMO])) break; if (sp > XB_SPIN_CAP) { atomicAdd(&bar[XB_TMO], 1u); break; } }
  }
  nloc = mine > 0u ? mine : 1u; nx = cnt > 0u ? cnt : 1u;
}
__device__ __forceinline__ void xcd_barrier(const XcdBarrier& b) {
  asm volatile("s_waitcnt vmcnt(0)" ::: "memory");
  __syncthreads();
  if (threadIdx.x == 0) {
    unsigned* bar = b.bar;
    asm volatile("" : "+s"(bar));
    __builtin_amdgcn_s_waitcnt(0);
    unsigned nloc = b.st[0], nx = b.st[1];
    if (nloc == 0u) { xcd_barrier_complete(bar, b.x, nloc, nx); b.st[0] = nloc; b.st[1] = nx; }
    const unsigned old = xb_add(&bar[XB_XSUB(b.x)], 1u);
    const unsigned gen = old / nloc;
    if (old + 1u == (gen + 1u) * nloc) {
      __builtin_amdgcn_fence(__ATOMIC_RELEASE, "agent");
      asm volatile("s_waitcnt vmcnt(0)" ::: "memory");
      const unsigned og = xb_add(&bar[XB_TOP], 1u);
      const unsigned tg = og / nx;
      if (og + 1u == (tg + 1u) * nx) xb_add(&bar[XB_TOPGEN], 1u);
      else XB_SPIN(xb_ld(&bar[XB_TOPGEN]) == tg, bar);
      __builtin_amdgcn_fence(__ATOMIC_ACQUIRE, "agent");
      xb_add(&bar[XB_XGEN(b.x)], 1u);
      asm volatile("s_waitcnt vmcnt(0)" ::: "memory");
    } else {
      XB_SPIN(xb_ld(&bar[XB_XGEN(b.x)]) == gen, bar);
      __builtin_amdgcn_fence(__ATOMIC_ACQUIRE, "agent");
      asm volatile("s_waitcnt vmcnt(0)" ::: "memory");
    }
  }
  __syncthreads();
}

__device__ __forceinline__ int lds_byte32(int r, int c) {
  const int ob = (r & 15) * 64 + c * 2;
  return (r >> 4) * 1024 + (ob ^ (((ob >> 9) & 1) << 5));
}
__device__ __forceinline__ void stage_rc32(int b, int& R, int& C) {
  const int sb = b & 1023, swz = sb ^ (((sb >> 9) & 1) << 5);
  R = (b >> 10) * 16 + (swz >> 6); C = (swz & 63) >> 1;
}
template <int ROWS>
__device__ __forceinline__ void stage_tile32(const u16* __restrict__ g, int ld, char* lds, int tidx) {
#pragma unroll
  for (int i = 0; i < (ROWS * 64 + 4095) / 4096; ++i) {
    const int b = tidx * 16 + i * 4096;
    if ((i + 1) * 4096 <= ROWS * 64 || tidx < (ROWS * 64 - i * 4096) / 16) {
      int R, C; stage_rc32(b, R, C);
      __builtin_amdgcn_global_load_lds((const unsigned*)(g + (size_t)R * ld + C), (unsigned LAS*)(lds + b), 16, 0, 0);
    }
  }
}
template <int N> __device__ __forceinline__ void wait_vmcnt() {
  if (N == 0) asm volatile("s_waitcnt vmcnt(0)" ::: "memory");
  else if (N == 3) asm volatile("s_waitcnt vmcnt(3)" ::: "memory");
  else if (N == 4) asm volatile("s_waitcnt vmcnt(4)" ::: "memory");
  else if (N == 5) asm volatile("s_waitcnt vmcnt(5)" ::: "memory");
  else if (N == 6) asm volatile("s_waitcnt vmcnt(6)" ::: "memory");
  else if (N == 8) asm volatile("s_waitcnt vmcnt(8)" ::: "memory");
  else if (N == 9) asm volatile("s_waitcnt vmcnt(9)" ::: "memory");
  else if (N == 10) asm volatile("s_waitcnt vmcnt(10)" ::: "memory");
  else if (N == 12) asm volatile("s_waitcnt vmcnt(12)" ::: "memory");
  else asm volatile("s_waitcnt vmcnt(0)" ::: "memory");
}

enum { EPI_PROJ = 0, EPI_OUT = 1, EPI_FFI = 2, EPI_FFO = 3 };

template <int EPI, int BM, int NST>
__device__ __forceinline__ void gemm_phase(const Params& p, int layer, const u16* __restrict__ A, const u16* __restrict__ Bt,
                                           int N, int K, char* smem, int bid, int nblk, int tidx) {
  constexpr int MF = BM / 32;
  const int tid = tidx, lane = tid & 63, wid = tid >> 6, wr = wid >> 1, wc = wid & 1, fr = lane & 15, fq = lane >> 4;
  const int nM = NTOK / BM, nN = N / 128, ntiles = nM * nN, nk = K / 32;
  constexpr int SB = (BM + 128) * 64;
  constexpr int LA = (BM * 64) / 4096;
  const bool extraA = (BM == 96) && (wid < 2);
  for (int tile = bid; tile < ntiles; tile += nblk) {
    const int pm = tile % nM, pn = tile / nM, m0 = pm * BM, n0 = pn * 128;
    f32x4 acc[MF][4];
#pragma unroll
    for (int m = 0; m < MF; ++m)
#pragma unroll
      for (int n = 0; n < 4; ++n) acc[m][n] = (f32x4){0.f, 0.f, 0.f, 0.f};
    const u16* Ag = A + (size_t)m0 * K;
    const u16* Bg = Bt + (size_t)n0 * K;
#pragma unroll
    for (int s_ = 0; s_ < NST - 1; ++s_) {
      stage_tile32<BM>(Ag + s_ * 32, K, smem + s_ * SB, tidx);
      stage_tile32<128>(Bg + s_ * 32, K, smem + s_ * SB + BM * 64, tidx);
    }
    int slot = 0, pslot = NST - 1;
    for (int kt = 0; kt < nk; ++kt) {
      if (kt + NST - 2 < nk) {
        if (BM == 96) { if (extraA) wait_vmcnt<(NST - 2) * 4>(); else wait_vmcnt<(NST - 2) * 3>(); }
        else wait_vmcnt<(NST - 2) * (LA + 2)>();
      } else {
        asm volatile("s_waitcnt vmcnt(0)" ::: "memory");
      }
      __builtin_amdgcn_s_barrier();
      if (kt + NST - 1 < nk) {
        char* nb = smem + pslot * SB;
        stage_tile32<BM>(Ag + (kt + NST - 1) * 32, K, nb, tidx);
        stage_tile32<128>(Bg + (kt + NST - 1) * 32, K, nb + BM * 64, tidx);
      }
      const char* sa = smem + slot * SB;
      const char* sb = sa + BM * 64;
      slot = (slot + 1 == NST) ? 0 : slot + 1;
      pslot = (pslot + 1 == NST) ? 0 : pslot + 1;
      bf16x8 af[MF], bfr[4];
#pragma unroll
      for (int m = 0; m < MF; ++m) af[m] = *reinterpret_cast<const bf16x8*>(sa + lds_byte32(wr * (BM / 2) + m * 16 + fr, fq * 8));
#pragma unroll
      for (int n = 0; n < 4; ++n) bfr[n] = *reinterpret_cast<const bf16x8*>(sb + lds_byte32(wc * 64 + n * 16 + fr, fq * 8));
#pragma unroll
      for (int m = 0; m < MF; ++m)
#pragma unroll
        for (int n = 0; n < 4; ++n) acc[m][n] = __builtin_amdgcn_mfma_f32_16x16x32_bf16(bfr[n], af[m], acc[m][n], 0, 0, 0);
    }
#pragma unroll
    for (int m = 0; m < MF; ++m) {
      const int row = m0 + wr * (BM / 2) + m * 16 + fr;
      if (EPI == EPI_PROJ) {
#pragma unroll
        for (int n = 0; n < 4; ++n) {
          const int col = n0 + wc * 64 + n * 16 + 4 * fq;
          *reinterpret_cast<float4*>(p.PROJ + (size_t)row * DIN + col) = make_float4(acc[m][n][0], acc[m][n][1], acc[m][n][2], acc[m][n][3]);
        }
      } else if (EPI == EPI_OUT || EPI == EPI_FFO) {
        const float* res = (EPI == EPI_OUT) ? p.X : p.X1;
        const float* gate = p.mod + ((size_t)(layer * 3 + modrow_of(row)) * 6 + (EPI == EPI_OUT ? 2 : 5)) * 1024;
#pragma unroll
        for (int n = 0; n < 4; ++n) {
          const int col = n0 + wc * 64 + n * 16 + 4 * fq;
          const float4 xr = *reinterpret_cast<const float4*>(res + (size_t)row * DM + col);
          const float4 gt = *reinterpret_cast<const float4*>(gate + col);
          float4 y;
          y.x = ALPHA * xr.x + gt.x * acc[m][n][0];
          y.y = ALPHA * xr.y + gt.y * acc[m][n][1];
          y.z = ALPHA * xr.z + gt.z * acc[m][n][2];
          y.w = ALPHA * xr.w + gt.w * acc[m][n][3];
          *reinterpret_cast<float4*>(p.Y + (size_t)row * DM + col) = y;
        }
      } else {
#pragma unroll
        for (int n2 = 0; n2 < 2; ++n2) {
          const int j0 = ((n0 + wc * 64) / 32 + n2) * 16 + 4 * fq;
          float a[4];
#pragma unroll
          for (int r = 0; r < 4; ++r) a[r] = siluf_(acc[m][2 * n2][r]) * acc[m][2 * n2 + 1][r];
          uint2 pk; pk.x = pack2(a[0], a[1]); pk.y = pack2(a[2], a[3]);
          *reinterpret_cast<uint2*>(p.ACT + (size_t)row * DFF + j0) = pk;
        }
      }
    }
    asm volatile("s_waitcnt lgkmcnt(0)" ::: "memory");
    __builtin_amdgcn_s_barrier();
  }
}

__device__ __forceinline__ int kf_off(int t, int d) { return (t >> 4) * 1024 + (d >> 5) * 512 + ((d & 31) >> 3) * 128 + (t & 15) * 8 + (d & 7); }
__device__ __forceinline__ int vf_off(int t, int d) { return (t >> 5) * 2048 + (d >> 4) * 512 + (((t & 15) >> 2) * 16 + (d & 15)) * 8 + ((t >> 4) & 1) * 4 + (t & 3); }
__device__ __forceinline__ void pack44_store(u16* base, int t0, int d, const float* v) {
  uint2 a, b; a.x = pack2(v[0], v[1]); a.y = pack2(v[2], v[3]); b.x = pack2(v[4], v[5]); b.y = pack2(v[6], v[7]);
  *reinterpret_cast<uint2*>(base + vf_off(t0, d)) = a;
  *reinterpret_cast<uint2*>(base + vf_off(t0 + 4, d)) = b;
}
__device__ __forceinline__ void pack8_store(u16* dst, const float* v) {
  uint4 pk; pk.x = pack2(v[0], v[1]); pk.y = pack2(v[2], v[3]); pk.z = pack2(v[4], v[5]); pk.w = pack2(v[6], v[7]);
  *reinterpret_cast<uint4*>(dst) = pk;
}

__device__ void setup_phase(const Params& p, char* smem, int bid, int nblk, int tidx) {
  const int tid = tidx;
  const int NI = 768 + 512 + 13;
  for (int it = bid; it < NI; it += nblk) {
    if (it < 768) {
      const int l = it / 192, nc = (it / 32) % 6, kc = it % 32;
      const int col = nc * 1024 + tid * 4;
      const float* wm = p.in[9] + (size_t)l * 1024 * 6144;
      float4 a0 = make_float4(0, 0, 0, 0), a1 = a0, a2 = a0;
      for (int k8 = 0; k8 < 32; k8 += 8) {
        float4 w[8];
#pragma unroll
        for (int u = 0; u < 8; ++u) w[u] = *reinterpret_cast<const float4*>(wm + (size_t)(kc * 32 + k8 + u) * 6144 + col);
#pragma unroll
        for (int u = 0; u < 8; ++u) {
          const int k = kc * 32 + k8 + u;
          const float s0 = siluf_(p.in[8][k]), s1 = siluf_(p.in[7][k]), s2 = siluf_(p.in[7][1024 + k]);
          a0.x += s0 * w[u].x; a0.y += s0 * w[u].y; a0.z += s0 * w[u].z; a0.w += s0 * w[u].w;
          a1.x += s1 * w[u].x; a1.y += s1 * w[u].y; a1.z += s1 * w[u].z; a1.w += s1 * w[u].w;
          a2.x += s2 * w[u].x; a2.y += s2 * w[u].y; a2.z += s2 * w[u].z; a2.w += s2 * w[u].w;
        }
      }
      float* dst = p.modp + (size_t)((l * 32 + kc) * 3) * 6144 + col;
      *reinterpret_cast<float4*>(dst) = a0;
      *reinterpret_cast<float4*>(dst + 6144) = a1;
      *reinterpret_cast<float4*>(dst + 2 * 6144) = a2;
    } else if (it < 1280) {
      const int ci = it - 768, b = ci / 256, l = (ci / 64) % 4, tg = ci % 64, t0 = tg * 8;
      {
        const float* ck = p.in[3] + ((size_t)(b * 4 + l) * 512 + t0) * 256 + tid;
        const float* cv = p.in[4] + ((size_t)(b * 4 + l) * 512 + t0) * 256 + tid;
        float v[8];
#pragma unroll
        for (int tt = 0; tt < 8; ++tt) {
          p.KNl[((size_t)((l * 2 + b) * 4 + (tid >> 6))) * 98304 + kf_off(t0 + tt, tid & 63)] = f2bf(ck[tt * 256]);
          v[tt] = cv[tt * 256];
        }
        pack44_store(p.VNtl + ((size_t)((l * 2 + b) * 4 + (tid >> 6))) * 98304, t0, tid & 63, v);
      }
      if (tid < 128) {
        const float* ck = p.in[5] + ((size_t)(b * 4 + l) * 512 + t0) * 128 + tid;
#pragma unroll
        for (int tt = 0; tt < 8; ++tt) p.KGl[((size_t)((l * 2 + b) * 2 + (tid >> 6))) * 98304 + kf_off(t0 + tt, tid & 63)] = f2bf(ck[tt * 128]);
      } else {
        const int c = tid - 128;
        const float* cv = p.in[6] + ((size_t)(b * 4 + l) * 512 + t0) * 128 + c;
        float v[8];
#pragma unroll
        for (int tt = 0; tt < 8; ++tt) v[tt] = cv[tt * 128];
        pack44_store(p.VGtl + ((size_t)((l * 2 + b) * 2 + (c >> 6))) * 98304, t0, c & 63, v);
      }
    } else {
      const int li = it - (768 + 512);
      if (li == 12) {
        for (int idx = tid; idx < 1024; idx += 256) {
          const int pos = idx >> 4, fi = idx & 15;
          const float ang = (float)pos * exp2f(-(float)fi * (13.287712379549449f / 16.f));
          p.rope[idx * 2] = cosf(ang); p.rope[idx * 2 + 1] = sinf(ang);
        }
      } else {
        const int l = li / 3, m = li % 3;
        u16* dst = p.loraT + (size_t)l * 98304 + m * 32768;
        if (m < 2) {
          const float* src = p.in[m == 0 ? 14 : 16] + (size_t)l * 32768;
          for (int i0 = tid; i0 < 32768; i0 += 256 * 16) {
            float v[16];
#pragma unroll
            for (int u = 0; u < 16; ++u) { const int idx = i0 + 256 * u; const int d = idx >> 14, cch = (idx >> 6) & 255, r = idx & 63; v[u] = src[(d * 64 + r) * 256 + cch]; }
#pragma unroll
            for (int u = 0; u < 16; ++u) dst[i0 + 256 * u] = f2bf(v[u]);
          }
        } else {
          const float* src = p.in[17] + (size_t)l * 32768;
          for (int i0 = tid; i0 < 32768; i0 += 256 * 16) {
            float v[16];
#pragma unroll
            for (int u = 0; u < 16; ++u) { const int idx = i0 + 256 * u; const int cch = idx >> 7, j = idx & 127; v[u] = src[j * 256 + cch]; }
#pragma unroll
            for (int u = 0; u < 16; ++u) dst[i0 + 256 * u] = f2bf(v[u]);
          }
        }
      }
    }
  }
  {
    float* tile = reinterpret_cast<float*>(smem);
    const int NT = 4 * 3040;
    float4 cur0, cur1, cur2, cur3;
    const float* src; u16* dst; int K, N, mat, k0, n0;
#define TR_DECODE(TR) { const int l_ = (TR) / 3040; int r_ = (TR) % 3040; int kt_, nt_; \
      if (r_ < 672) { mat = 0; K = 1024; N = 2688; src = p.in[11] + (size_t)l_ * K * N; dst = p.winT + (size_t)l_ * N * K; kt_ = r_ / 42; nt_ = r_ % 42; } \
      else if (r_ < 928) { r_ -= 672; mat = 1; K = 1024; N = 1024; src = p.in[26] + (size_t)l_ * K * N; dst = p.woutT + (size_t)l_ * N * K; kt_ = r_ / 16; nt_ = r_ % 16; } \
      else if (r_ < 2336) { r_ -= 928; mat = 2; K = 1024; N = 5632; src = p.in[29] + (size_t)l_ * K * N; dst = p.wfiT + (size_t)l_ * N * K; kt_ = r_ / 88; nt_ = r_ % 88; } \
      else { r_ -= 2336; mat = 3; K = 2816; N = 1024; src = p.in[30] + (size_t)l_ * K * N; dst = p.wfoT + (size_t)l_ * N * K; kt_ = r_ / 16; nt_ = r_ % 16; } \
      k0 = kt_ * 64; n0 = nt_ * 64; }
#define TR_LOAD(V, I) V = *reinterpret_cast<const float4*>(src + (size_t)(k0 + (tid >> 4) + 16 * (I)) * N + n0 + (tid & 15) * 4);
#define TR_PUT(V, I) { const int kr_ = (tid >> 4) + 16 * (I), c4_ = (tid & 15) * 4; \
      tile[kr_ * 65 + c4_ + 0] = V.x; tile[kr_ * 65 + c4_ + 1] = V.y; tile[kr_ * 65 + c4_ + 2] = V.z; tile[kr_ * 65 + c4_ + 3] = V.w; }
    int tr = bid;
    if (tr < NT) { TR_DECODE(tr) TR_LOAD(cur0, 0) TR_LOAD(cur1, 1) TR_LOAD(cur2, 2) TR_LOAD(cur3, 3) }
    for (; tr < NT; tr += nblk) {
      TR_PUT(cur0, 0) TR_PUT(cur1, 1) TR_PUT(cur2, 2) TR_PUT(cur3, 3)
      if (tr + nblk < NT) { TR_DECODE(tr + nblk) TR_LOAD(cur0, 0) TR_LOAD(cur1, 1) TR_LOAD(cur2, 2) TR_LOAD(cur3, 3) }
      TR_DECODE(tr)
      __syncthreads();
#pragma unroll
      for (int i = 0; i < 2; ++i) {
        const int idx = tid + 256 * i, nl = idx >> 3, kc = idx & 7;
        int n = n0 + nl;
        if (mat == 2) { const int isup = n >= DFF ? 1 : 0; const int j = n - isup * DFF; n = (j >> 4) * 32 + isup * 16 + (j & 15); }
        float v[8];
#pragma unroll
        for (int jj = 0; jj < 8; ++jj) v[jj] = tile[(kc * 8 + jj) * 65 + nl];
        pack8_store(dst + (size_t)n * K + k0 + kc * 8, v);
      }
      __syncthreads();
    }
#undef TR_DECODE
#undef TR_LOAD
#undef TR_PUT
  }
}

__device__ void modreduce_phase(const Params& p, int bid, int nblk, int tidx) {
  for (int idx = bid * 256 + tidx; idx < 18432; idx += nblk * 256) {
    const int l = idx / 4608, rem = idx % 4608, mr = rem / 1536, c4 = (rem % 1536) * 4;
    float4 a = *reinterpret_cast<const float4*>(p.in[10] + (size_t)l * 6144 + c4);
    for (int k8 = 0; k8 < 32; k8 += 8) {
      float4 v[8];
#pragma unroll
      for (int u = 0; u < 8; ++u) v[u] = *reinterpret_cast<const float4*>(p.modp + (size_t)((l * 32 + k8 + u) * 3 + mr) * 6144 + c4);
#pragma unroll
      for (int u = 0; u < 8; ++u) { a.x += v[u].x; a.y += v[u].y; a.z += v[u].z; a.w += v[u].w; }
    }
    *reinterpret_cast<float4*>(p.mod + (size_t)(l * 3 + mr) * 6144 + c4) = a;
  }
}

template <int MODE>
__device__ void ln_phase(const Params& p, int layer, int bid, int nblk, int tidx) {
  const int lane = tidx & 63, wid = tidx >> 6;
  const bool fin = (MODE == 2 && layer == 3);
  const float* lw = (MODE == 1 ? p.in[27] : p.in[31]) + (size_t)layer * DM;
  const float* lb = (MODE == 1 ? p.in[28] : p.in[32]) + (size_t)layer * DM;
  const int ml = (MODE == 2) ? (layer + 1 < 4 ? layer + 1 : 3) : layer;
  const int which = (MODE == 1) ? 3 : 0;
#define LN_SRC(ROW) (MODE == 0 ? ((ROW) < NCTX ? p.in[0] + (size_t)(ROW) * DM : p.in[1] + (size_t)((ROW) - NCTX) * DM) : p.Y + (size_t)(ROW) * DM)
  float4 nv0, nv1, nv2, nv3;
  int it = bid;
  if (it < NTOK / 4) {
    const float4* s4 = reinterpret_cast<const float4*>(LN_SRC(it * 4 + wid));
    nv0 = s4[lane]; nv1 = s4[lane + 64]; nv2 = s4[lane + 128]; nv3 = s4[lane + 192];
  }
  for (; it < NTOK / 4; it += nblk) {
    const int row = it * 4 + wid;
    float4 v[4] = {nv0, nv1, nv2, nv3};
    if (it + nblk < NTOK / 4) {
      const float4* s4 = reinterpret_cast<const float4*>(LN_SRC((it + nblk) * 4 + wid));
      nv0 = s4[lane]; nv1 = s4[lane + 64]; nv2 = s4[lane + 128]; nv3 = s4[lane + 192];
    }
    float4 w4[4], b4[4], s4v[4], c4v[4];
    const float* sh = p.mod + ((size_t)(ml * 3 + modrow_of(row)) * 6 + which) * 1024;
    const float* sc = sh + 1024;
#pragma unroll
    for (int i = 0; i < 4; ++i) {
      if (MODE != 0) { w4[i] = reinterpret_cast<const float4*>(lw)[lane + 64 * i]; b4[i] = reinterpret_cast<const float4*>(lb)[lane + 64 * i]; }
      if (!fin) { s4v[i] = reinterpret_cast<const float4*>(sh)[lane + 64 * i]; c4v[i] = reinterpret_cast<const float4*>(sc)[lane + 64 * i]; }
    }
    if (MODE != 0) {
      float s = 0.f;
#pragma unroll
      for (int i = 0; i < 4; ++i) s += v[i].x + v[i].y + v[i].z + v[i].w;
      const float mu = wave_sum(s) * (1.f / 1024.f);
      float q = 0.f;
#pragma unroll
      for (int i = 0; i < 4; ++i) {
        v[i].x -= mu; v[i].y -= mu; v[i].z -= mu; v[i].w -= mu;
        q += v[i].x * v[i].x + v[i].y * v[i].y + v[i].z * v[i].z + v[i].w * v[i].w;
      }
      const float rstd = rsqrtf(wave_sum(q) * (1.f / 1024.f) + 1e-5f);
#pragma unroll
      for (int i = 0; i < 4; ++i) {
        v[i].x = v[i].x * rstd * w4[i].x + b4[i].x; v[i].y = v[i].y * rstd * w4[i].y + b4[i].y;
        v[i].z = v[i].z * rstd * w4[i].z + b4[i].z; v[i].w = v[i].w * rstd * w4[i].w + b4[i].w;
      }
    }
    float* xdst = (MODE == 1 ? p.X1 : p.X) + (size_t)row * DM;
#pragma unroll
    for (int i = 0; i < 4; ++i) reinterpret_cast<float4*>(xdst)[lane + 64 * i] = v[i];
    if (fin) {
      float* o = row < NCTX ? p.out_yp + (size_t)row * DM : p.out_ys + (size_t)(row - NCTX) * DM;
#pragma unroll
      for (int i = 0; i < 4; ++i) reinterpret_cast<float4*>(o)[lane + 64 * i] = v[i];
    } else {
      u16* adst = p.A + (size_t)row * DM;
#pragma unroll
      for (int i = 0; i < 4; ++i) {
        uint2 pk;
        pk.x = pack2(v[i].x * (1.f + c4v[i].x) + s4v[i].x, v[i].y * (1.f + c4v[i].y) + s4v[i].y);
        pk.y = pack2(v[i].z * (1.f + c4v[i].z) + s4v[i].z, v[i].w * (1.f + c4v[i].w) + s4v[i].w);
        reinterpret_cast<uint2*>(adst)[lane + 64 * i] = pk;
      }
    }
  }
#undef LN_SRC
}

#define FLD 772
#define LLD 392
__device__ void prep_phase(const Params& p, int layer, char* smem, int bid, int nblk, int tidx) {
  float* F = reinterpret_cast<float*>(smem);
  u16* LIb = reinterpret_cast<u16*>(smem + 16 * FLD * 4);
  const float* cw = p.in[12] + (size_t)layer * 3 * 1152;
  const u16* LW = p.loraT + (size_t)layer * 98304;
  for (int it = bid; it < NTOK / 16; it += nblk) {
    int tid = tidx;
    asm volatile("" : "+v"(tid));
    const int lane = tid & 63, wid = tid >> 6, fr = lane & 15, fq = lane >> 4;
    const int tok0 = it * 16;
    int b, tpos0, L;
    const bool isctx = tok0 < NCTX;
    if (isctx) { b = tok0 >> 8; tpos0 = tok0 & 255; L = 256; }
    else { const int tl = tok0 - NCTX; b = tl >> 10; tpos0 = tl & 1023; L = 1024; }
#pragma unroll 1
    for (int cg = tid; cg < 288; cg += 256) {
      const int c = cg * 4;
      const float4 w0 = *reinterpret_cast<const float4*>(cw + c);
      const float4 w1 = *reinterpret_cast<const float4*>(cw + 1152 + c);
      const float4 w2 = *reinterpret_cast<const float4*>(cw + 2304 + c);
      const float* pr = p.PROJ + (size_t)tok0 * DIN + c;
      float4 x[18];
#pragma unroll
      for (int i = 0; i < 18; ++i) {
        const int tpos = tpos0 + i - 1;
        x[i] = (tpos >= 0 && tpos < L) ? *reinterpret_cast<const float4*>(pr + (ptrdiff_t)(i - 1) * DIN) : make_float4(0.f, 0.f, 0.f, 0.f);
      }
#pragma unroll
      for (int tt = 0; tt < 16; ++tt) {
        float4 f;
        f.x = w0.x * x[tt].x + w1.x * x[tt + 1].x + w2.x * x[tt + 2].x;
        f.y = w0.y * x[tt].y + w1.y * x[tt + 1].y + w2.y * x[tt + 2].y;
        f.z = w0.z * x[tt].z + w1.z * x[tt + 1].z + w2.z * x[tt + 2].z;
        f.w = w0.w * x[tt].w + w1.w * x[tt + 1].w + w2.w * x[tt + 2].w;
        if (c < 768) { *reinterpret_cast<float4*>(F + tt * FLD + c) = f; }
        else {
          const int cc = c - 768;
          if (cc < 128) { f.x = tanhf(f.x); f.y = tanhf(f.y); f.z = tanhf(f.z); f.w = tanhf(f.w); }
          else if (cc >= 256) { f.x = sigmoidf_(f.x); f.y = sigmoidf_(f.y); f.z = sigmoidf_(f.z); f.w = sigmoidf_(f.w); }
          uint2 pk; pk.x = pack2(f.x, f.y); pk.y = pack2(f.z, f.w);
          *reinterpret_cast<uint2*>(LIb + tt * LLD + cc) = pk;
        }
      }
    }
    __syncthreads();
    f32x4 acc[5][4];
#pragma unroll
    for (int g = 0; g < 5; ++g)
#pragma unroll
      for (int nf = 0; nf < 4; ++nf) acc[g][nf] = (f32x4){0.f, 0.f, 0.f, 0.f};
#pragma unroll
    for (int g = 0; g < 4; ++g) {
      const u16* wt = LW + (size_t)g * 16384;
#pragma unroll
      for (int ks = 0; ks < 2; ++ks) {
        const bf16x8 xb = *reinterpret_cast<const bf16x8*>(LIb + fr * LLD + g * 64 + ks * 32 + fq * 8);
#pragma unroll
        for (int nf = 0; nf < 4; ++nf) {
          const bf16x8 wa = *reinterpret_cast<const bf16x8*>(wt + (size_t)(64 * wid + 16 * nf + fr) * 64 + ks * 32 + fq * 8);
          acc[g][nf] = __builtin_amdgcn_mfma_f32_16x16x32_bf16(wa, xb, acc[g][nf], 0, 0, 0);
        }
      }
      __builtin_amdgcn_sched_barrier(0);
    }
    {
      const u16* wt = LW + 65536;
#pragma unroll
      for (int ks = 0; ks < 4; ++ks) {
        const bf16x8 xb = *reinterpret_cast<const bf16x8*>(LIb + fr * LLD + 256 + ks * 32 + fq * 8);
#pragma unroll
        for (int nf = 0; nf < 4; ++nf) {
          const bf16x8 wa = *reinterpret_cast<const bf16x8*>(wt + (size_t)(64 * wid + 16 * nf + fr) * 128 + ks * 32 + fq * 8);
          acc[4][nf] = __builtin_amdgcn_mfma_f32_16x16x32_bf16(wa, xb, acc[4][nf], 0, 0, 0);
        }
        if (ks == 1) __builtin_amdgcn_sched_barrier(0);
      }
      __builtin_amdgcn_sched_barrier(0);
    }
#ifndef NO_C
    {
      const int tok = tok0 + fr;
      float ss = 0.f, bs = 0.f;
#pragma unroll
      for (int nf = 0; nf < 4; ++nf) {
        const int c0 = 64 * wid + 16 * nf + 4 * fq;
        const float4 r4 = *reinterpret_cast<const float4*>(F + fr * FLD + c0);
        const float4 k4 = *reinterpret_cast<const float4*>(F + fr * FLD + 256 + c0);
        const float4 w00 = *reinterpret_cast<const float4*>(p.in[13] + (size_t)layer * 512 + c0);
        const float4 w01 = *reinterpret_cast<const float4*>(p.in[13] + (size_t)layer * 512 + 256 + c0);
        const float4 a00 = *reinterpret_cast<const float4*>(p.in[15] + (size_t)layer * 512 + c0);
        const float4 a01 = *reinterpret_cast<const float4*>(p.in[15] + (size_t)layer * 512 + 256 + c0);
        const float4 kkw = *reinterpret_cast<const float4*>(p.in[18] + (size_t)layer * 256 + c0);
        const float4 kaw = *reinterpret_cast<const float4*>(p.in[19] + (size_t)layer * 256 + c0);
        const float4 rkw = *reinterpret_cast<const float4*>(p.in[20] + (size_t)layer * 256 + c0);
        const float rr[4] = {r4.x, r4.y, r4.z, r4.w}, kk_[4] = {k4.x, k4.y, k4.z, k4.w};
        const float w0a[4] = {w00.x, w00.y, w00.z, w00.w}, w0b[4] = {w01.x, w01.y, w01.z, w01.w};
        const float a0a[4] = {a00.x, a00.y, a00.z, a00.w}, a0b[4] = {a01.x, a01.y, a01.z, a01.w};
        const float kkw_[4] = {kkw.x, kkw.y, kkw.z, kkw.w}, kaw_[4] = {kaw.x, kaw.y, kaw.z, kaw.w}, rkw_[4] = {rkw.x, rkw.y, rkw.z, rkw.w};
#pragma unroll
        for (int r = 0; r < 4; ++r) {
          {
            const float z = -(w0a[r] + acc[0][nf][r]);
            const float sp = fmaxf(z, 0.f) + log1pf(__expf(-fabsf(z)));
            acc[0][nf][r] = __expf(-__expf(-sp - 0.5f));
          }
          {
            const float z = -(w0b[r] + acc[1][nf][r]);
            const float sp = fmaxf(z, 0.f) + log1pf(__expf(-fabsf(z)));
            acc[1][nf][r] = __expf(-__expf(-sp - 0.5f));
          }
          const float av0 = sigmoidf_(a0a[r] + acc[2][nf][r]);
          const float av1 = sigmoidf_(a0b[r] + acc[3][nf][r]);
          acc[2][nf][r] = av0; acc[3][nf][r] = av1;
          const float k = kk_[r];
          const float kq = k * kkw_[r];
          ss += kq * kq;
          const float kd0 = k * (1.f + (av0 - 1.f) * kaw_[r]);
          const float kd1 = k * (1.f + (av1 - 1.f) * kaw_[r]);
          bs += rr[r] * (kd0 + kd1) * rkw_[r];
        }
        __builtin_amdgcn_sched_barrier(0);
      }
      ss += __shfl_xor(ss, 16); ss += __shfl_xor(ss, 32);
      bs += __shfl_xor(bs, 16); bs += __shfl_xor(bs, 32);
      const float inrm = 1.f / fmaxf(sqrtf(ss), 1e-12f);
#pragma unroll
      for (int nf = 0; nf < 4; ++nf) {
        const int c0 = 64 * wid + 16 * nf + 4 * fq, n0 = 16 * nf + 4 * fq;
        const float4 r4 = *reinterpret_cast<const float4*>(F + fr * FLD + c0);
        const float4 k4 = *reinterpret_cast<const float4*>(F + fr * FLD + 256 + c0);
        const float4 v4 = *reinterpret_cast<const float4*>(F + fr * FLD + 512 + c0);
        const float4 kkw = *reinterpret_cast<const float4*>(p.in[18] + (size_t)layer * 256 + c0);
        const float4 kaw = *reinterpret_cast<const float4*>(p.in[19] + (size_t)layer * 256 + c0);
        const float kk_[4] = {k4.x, k4.y, k4.z, k4.w}, kkw_[4] = {kkw.x, kkw.y, kkw.z, kkw.w}, kaw_[4] = {kaw.x, kaw.y, kaw.z, kaw.w};
        float* sc = p.SC + ((size_t)(tok * 4 + wid) * 9) * 64 + n0;
        float kn[4], kd0[4], kd1[4];
#pragma unroll
        for (int r = 0; r < 4; ++r) {
          kn[r] = kk_[r] * kkw_[r] * inrm;
          kd0[r] = kk_[r] * (1.f + (acc[2][nf][r] - 1.f) * kaw_[r]);
          kd1[r] = kk_[r] * (1.f + (acc[3][nf][r] - 1.f) * kaw_[r]);
        }
        *reinterpret_cast<float4*>(sc) = r4;
        *reinterpret_cast<float4*>(sc + 64) = make_float4(kn[0], kn[1], kn[2], kn[3]);
        *reinterpret_cast<float4*>(sc + 128) = v4;
        *reinterpret_cast<float4*>(sc + 192) = make_float4(acc[0][nf][0], acc[0][nf][1], acc[0][nf][2], acc[0][nf][3]);
        *reinterpret_cast<float4*>(sc + 256) = make_float4(acc[2][nf][0] * kn[0], acc[2][nf][1] * kn[1], acc[2][nf][2] * kn[2], acc[2][nf][3] * kn[3]);
        *reinterpret_cast<float4*>(sc + 320) = make_float4(kd0[0], kd0[1], kd0[2], kd0[3]);
        *reinterpret_cast<float4*>(sc + 384) = make_float4(acc[1][nf][0], acc[1][nf][1], acc[1][nf][2], acc[1][nf][3]);
        *reinterpret_cast<float4*>(sc + 448) = make_float4(acc[3][nf][0] * kn[0], acc[3][nf][1] * kn[1], acc[3][nf][2] * kn[2], acc[3][nf][3] * kn[3]);
        *reinterpret_cast<float4*>(sc + 512) = make_float4(kd1[0], kd1[1], kd1[2], kd1[3]);
        *reinterpret_cast<float4*>(p.G + (size_t)tok * 256 + c0) = make_float4(acc[4][nf][0], acc[4][nf][1], acc[4][nf][2], acc[4][nf][3]);
        *reinterpret_cast<float4*>(p.BV + (size_t)tok * 256 + c0) = make_float4(bs * v4.x, bs * v4.y, bs * v4.z, bs * v4.w);
        __builtin_amdgcn_sched_barrier(0);
      }
    }
#endif
#ifndef NO_D
    const int c = tid;
#pragma unroll
    for (int half = 0; half < 2; ++half) {
      float vv[8];
#pragma unroll
      for (int t8 = 0; t8 < 8; ++t8) {
        const int tt = half * 8 + t8, tok = tok0 + tt;
        const float* pr = p.PROJ + (size_t)tok * DIN + 1152 + c;
        const float q = pr[0], k = pr[256], v = pr[512];
        vv[t8] = v;
        if (isctx) {
          const size_t oi = ((size_t)(b * 4 + layer) * 256 + tpos0 + tt) * 256 + c;
          p.out_nak[oi] = k; p.out_nav[oi] = v;
          p.QNc[(size_t)tok * 256 + c] = f2bf(q * QSCALE);
          p.KNc[(size_t)(b * 4 + (c >> 6)) * 16384 + kf_off(tpos0 + tt, c & 63)] = f2bf(k);
        } else {
          p.QNl[(size_t)(tok - NCTX) * 256 + c] = f2bf(q * QSCALE);
          p.KNl[((size_t)((layer * 2 + b) * 4 + (c >> 6))) * 98304 + kf_off(512 + tpos0 + tt, c & 63)] = f2bf(k);
        }
      }
      if (isctx) pack44_store(p.VNtc + (size_t)(b * 4 + (c >> 6)) * 16384, tpos0 + half * 8, c & 63, vv);
      else pack44_store(p.VNtl + ((size_t)((layer * 2 + b) * 4 + (c >> 6))) * 98304, 512 + tpos0 + half * 8, c & 63, vv);
    }
    {
      const float qn = p.in[24][(size_t)layer * 64 + lane], kn = p.in[25][(size_t)layer * 64 + lane];
      const int fi = lane & 15;
#pragma unroll
      for (int half = 0; half < 2; ++half) {
        float vv[8];
#pragma unroll
        for (int t8 = 0; t8 < 8; ++t8) {
          const int tt = half * 8 + t8, tok = tok0 + tt, tpos = tpos0 + tt;
          const float* pr = p.PROJ + (size_t)tok * DIN + 1920;
          float cs = 1.f, sn = 0.f;
          if (!isctx) {
            const int pos = (lane < 32) ? (tpos >> 6) : (tpos & 63);
            const float2 t2 = *reinterpret_cast<const float2*>(p.rope + (size_t)(pos * 16 + fi) * 2);
            cs = t2.x; sn = t2.y;
            if ((lane & 16) == 0) sn = -sn;
          }
#pragma unroll
          for (int hh = 0; hh < 2; ++hh) {
            float q = pr[hh * 256 + c];
            const float ms = wave_sum(q * q) * (1.f / 64.f);
            q = q * rsqrtf(ms + 1e-6f) * qn;
            if (!isctx) { const float qp = __shfl_xor(q, 16); q = q * cs + qp * sn; }
            if (isctx) p.QGc[(size_t)tok * 512 + hh * 256 + c] = f2bf(q * QSCALE);
            else p.QGl[(size_t)(tok - NCTX) * 512 + hh * 256 + c] = f2bf(q * QSCALE);
          }
          if (wid < 2) {
            float k = pr[512 + c];
            const float ms = wave_sum(k * k) * (1.f / 64.f);
            k = k * rsqrtf(ms + 1e-6f) * kn;
            if (isctx) {
              p.out_gk[((size_t)(b * 4 + layer) * 256 + tpos) * 128 + c] = k;
              p.KGc[(size_t)(b * 2 + (c >> 6)) * 16384 + kf_off(tpos, c & 63)] = f2bf(k);
            } else {
              const float kp = __shfl_xor(k, 16); k = k * cs + kp * sn;
              p.KGl[((size_t)((layer * 2 + b) * 2 + (c >> 6))) * 98304 + kf_off(512 + tpos, c & 63)] = f2bf(k);
            }
          } else {
            const int cv = c - 128;
            const float v = pr[640 + cv];
            vv[t8] = v;
            if (isctx) p.out_gv[((size_t)(b * 4 + layer) * 256 + tpos) * 128 + cv] = v;
          }
        }
        if (wid >= 2) {
          const int cv = c - 128;
          if (isctx) pack44_store(p.VGtc + (size_t)(b * 2 + (cv >> 6)) * 16384, tpos0 + half * 8, cv & 63, vv);
          else pack44_store(p.VGtl + ((size_t)((layer * 2 + b) * 2 + (cv >> 6))) * 98304, 512 + tpos0 + half * 8, cv & 63, vv);
        }
      }
    }
#endif
    __syncthreads();
  }
}

#define ATT_LOAD(KF, VF, CI) { \
    const int ci_ = min((CI), nt - 1); \
    int kb_; \
    if (ci_ < nd) kb_ = ci_ * 32; \
    else { const int e_ = ci_ - nd; const int j_ = (ncc == 2) ? (e_ >> 1) : e_; const int cc_ = cc0 + ((ncc == 2) ? (e_ & 1) : 0); kb_ = 512 + (rb + j_) * 64 + cc_ * 32; } \
    const u16* kp_ = Kb + (size_t)(kb_ >> 4) * 1024 + lane * 8; \
    KF##00 = *reinterpret_cast<const bf16x8*>(kp_); \
    KF##01 = *reinterpret_cast<const bf16x8*>(kp_ + 512); \
    KF##10 = *reinterpret_cast<const bf16x8*>(kp_ + 1024); \
    KF##11 = *reinterpret_cast<const bf16x8*>(kp_ + 1536); \
    const u16* vp_ = Vt + (size_t)(kb_ >> 5) * 2048 + lane * 8; \
    VF##0 = *reinterpret_cast<const bf16x8*>(vp_); \
    VF##1 = *reinterpret_cast<const bf16x8*>(vp_ + 512); \
    VF##2 = *reinterpret_cast<const bf16x8*>(vp_ + 1024); \
    VF##3 = *reinterpret_cast<const bf16x8*>(vp_ + 1536); }

#define ATT_PV(DT, VV) { \
    o[DT][0] *= alpha; o[DT][1] *= alpha; o[DT][2] *= alpha; o[DT][3] *= alpha; \
    o[DT] = __builtin_amdgcn_mfma_f32_16x16x32_bf16(VV, pf.v, o[DT], 0, 0, 0); }

#define ATT_COMPUTE(KF, VF, CI) { \
    const int ci_ = (CI); \
    f32x4 s0 = (f32x4){0.f, 0.f, 0.f, 0.f}, s1 = (f32x4){0.f, 0.f, 0.f, 0.f}; \
    s0 = __builtin_amdgcn_mfma_f32_16x16x32_bf16(KF##00, qf0, s0, 0, 0, 0); \
    s0 = __builtin_amdgcn_mfma_f32_16x16x32_bf16(KF##01, qf1, s0, 0, 0, 0); \
    s1 = __builtin_amdgcn_mfma_f32_16x16x32_bf16(KF##10, qf0, s1, 0, 0, 0); \
    s1 = __builtin_amdgcn_mfma_f32_16x16x32_bf16(KF##11, qf1, s1, 0, 0, 0); \
    float sv[8] = {s0[0], s0[1], s0[2], s0[3], s1[0], s1[1], s1[2], s1[3]}; \
    bool ok[8]; \
    _Pragma("unroll") for (int e = 0; e < 8; ++e) ok[e] = true; \
    if (ci_ >= nd) { \
      const int e_ = ci_ - nd; const int j_ = (ncc == 2) ? (e_ >> 1) : e_; const int cc_ = cc0 + ((ncc == 2) ? (e_ & 1) : 0); \
      const int dr_ = rb + j_ - grow + 7; \
      const int cq = cq0 + fr, c0 = min(max(cq - 8, 0), 48); \
      _Pragma("unroll") for (int e = 0; e < 8; ++e) { \
        const int ck = cc_ * 32 + 16 * (e >> 2) + 4 * fq + (e & 3); \
        ok[e] = (ck >= c0) && (ck < c0 + 16); \
        const int dc = min(max(ck - cq, -15), 15) + 15; \
        const float bias = rpb[dr_ * 31 + dc] * LOG2E; \
        sv[e] = ok[e] ? sv[e] + bias : -1e30f; \
      } \
    } \
    float mx = fmaxf(fmaxf(fmaxf(sv[0], sv[1]), fmaxf(sv[2], sv[3])), fmaxf(fmaxf(sv[4], sv[5]), fmaxf(sv[6], sv[7]))); \
    mx = fmaxf(mx, __shfl_xor(mx, 16)); \
    mx = fmaxf(mx, __shfl_xor(mx, 32)); \
    const float mn = fmaxf(m, mx); \
    const float alpha = exp2f(m - mn); \
    m = mn; \
    float ps = 0.f; \
    _Pragma("unroll") for (int e = 0; e < 8; ++e) { sv[e] = ok[e] ? exp2f(sv[e] - mn) : 0.f; ps += sv[e]; } \
    l = l * alpha + ps; \
    union { bf16x8 v; unsigned u[4]; } pf; \
    pf.u[0] = pack2(sv[0], sv[1]); pf.u[1] = pack2(sv[2], sv[3]); pf.u[2] = pack2(sv[4], sv[5]); pf.u[3] = pack2(sv[6], sv[7]); \
    ATT_PV(0, VF##0) ATT_PV(1, VF##1) ATT_PV(2, VF##2) ATT_PV(3, VF##3) }

__device__ __forceinline__ void attn_wave(const u16* __restrict__ Q, int ldq, const u16* __restrict__ Kb, int ldk,
                                          const u16* __restrict__ Vt, int ldv, int ndense, const bool NA,
                                          const float* __restrict__ rpb, int grow, int cq0,
                                          u16* __restrict__ out, int ldo, int tidx) {
  const int lane = tidx & 63, fr = lane & 15, fq = lane >> 4;
  const bf16x8 qf0 = *reinterpret_cast<const bf16x8*>(Q + (size_t)fr * ldq + fq * 8);
  const bf16x8 qf1 = *reinterpret_cast<const bf16x8*>(Q + (size_t)fr * ldq + 32 + fq * 8);
  f32x4 o[4];
#pragma unroll
  for (int dt = 0; dt < 4; ++dt) o[dt] = (f32x4){0.f, 0.f, 0.f, 0.f};
  float m = -1e30f, l = 0.f;
  const int nd = ndense >> 5;
  const int rb = min(max(grow - 4, 0), 8);
  const int ulo = min(max(cq0 - 8, 0), 48), uhi = min(max(cq0 + 15 - 8, 0), 48) + 16;
  const bool c0ok = ulo < 32, c1ok = uhi > 32;
  const int ncc = (c0ok && c1ok) ? 2 : 1, cc0 = c0ok ? 0 : 1;
  const int nt = nd + (NA ? 8 * ncc : 0);
  bf16x8 ka00, ka01, ka10, ka11, kb00, kb01, kb10, kb11;
  bf16x8 va0, va1, va2, va3, vb0, vb1, vb2, vb3;
  ATT_LOAD(ka, va, 0)
  for (int ci = 0; ci < nt; ci += 2) {
    ATT_LOAD(kb, vb, ci + 1)
    ATT_COMPUTE(ka, va, ci)
    if (ci + 1 < nt) {
      ATT_LOAD(ka, va, ci + 2)
      ATT_COMPUTE(kb, vb, ci + 1)
    }
  }
  l += __shfl_xor(l, 16);
  l += __shfl_xor(l, 32);
  const float il = 1.f / l;
#pragma unroll
  for (int dt = 0; dt < 4; ++dt) {
    uint2 pk; pk.x = pack2(o[dt][0] * il, o[dt][1] * il); pk.y = pack2(o[dt][2] * il, o[dt][3] * il);
    *reinterpret_cast<uint2*>(out + (size_t)fr * ldo + 16 * dt + 4 * fq) = pk;
  }
}

__device__ void scan_item(const Params& p, int layer, char* smem, bool lat, int b, int h, int dir, int qd, int tidx) {
  const int tid = tidx, lane = tid & 63, wid = tid >> 6, rr = lane >> 4, j = lane & 15;
  const int L = lat ? 1024 : 256, seqbase = lat ? NCTX + b * 1024 : b * 256;
  const int rowl = wid * 4 + rr, row = qd * 16 + rowl;
  float* cbuf = reinterpret_cast<float*>(smem);
  float* obuf = cbuf + 2 * 16 * 6 * 64;
  float4 S = make_float4(0.f, 0.f, 0.f, 0.f);
  if (lat) S = *reinterpret_cast<const float4*>(p.in[2] + ((((size_t)(b * 4 + layer) * 2 + dir) * 4 + h) * 64 + row) * 64 + 4 * j);
  const int nch = L / 16;
  float* odst = dir == 0 ? p.OF : p.OB;
  float4 pre0, pre1, pre2, pre3, pre4, pre5;
#define SC_GL1(PR, I, CH) { const int idx = tid + 256 * (I), tt_ = idx / 96, rem = idx % 96, vec = rem >> 4, f4 = rem & 15; \
    const int st_ = (CH) * 16 + tt_, t_ = dir == 0 ? st_ : L - 1 - st_; const int svec = vec < 3 ? vec : vec + 3 * dir; \
    PR = *reinterpret_cast<const float4*>(p.SC + ((size_t)((seqbase + t_) * 4 + h) * 9 + svec) * 64 + f4 * 4); }
#define gload(CH) { SC_GL1(pre0, 0, CH) SC_GL1(pre1, 1, CH) SC_GL1(pre2, 2, CH) SC_GL1(pre3, 3, CH) SC_GL1(pre4, 4, CH) SC_GL1(pre5, 5, CH) }
#define SC_LS1(PR, I, BUF) *reinterpret_cast<float4*>(cbuf + (BUF) * 6144 + (tid + 256 * (I)) * 4) = PR;
#define lstore(BUF) { SC_LS1(pre0, 0, BUF) SC_LS1(pre1, 1, BUF) SC_LS1(pre2, 2, BUF) SC_LS1(pre3, 3, BUF) SC_LS1(pre4, 4, BUF) SC_LS1(pre5, 5, BUF) }
  gload(0); lstore(0);
  __syncthreads();
#define SC_LD(R4, K4, VV, W4, A4, D4, TT) { const float* base_ = cb + (TT) * 384; \
    R4 = *reinterpret_cast<const float4*>(base_ + 4 * j); K4 = *reinterpret_cast<const float4*>(base_ + 64 + 4 * j); \
    VV = base_[128 + row]; W4 = *reinterpret_cast<const float4*>(base_ + 192 + 4 * j); \
    A4 = *reinterpret_cast<const float4*>(base_ + 256 + 4 * j); D4 = *reinterpret_cast<const float4*>(base_ + 320 + 4 * j); }
  for (int ch = 0; ch < nch; ++ch) {
#if REPMASK
    if (ch + 1 < nch && p.pad != 5) gload(ch + 1);
#else
    if (ch + 1 < nch) gload(ch + 1);
#endif
    const float* cb = cbuf + (ch & 1) * 6144;
    float osel = 0.f;
    float4 r4, kk4, w4, ak4, kd4; float vv;
    SC_LD(r4, kk4, vv, w4, ak4, kd4, 0)
    float ovp = 0.f;
#pragma unroll 4
    for (int tt = 0; tt < 16; ++tt) {
      float4 r4n, kk4n, w4n, ak4n, kd4n; float vvn;
      SC_LD(r4n, kk4n, vvn, w4n, ak4n, kd4n, tt + 1)
      float sk = (S.x * kk4.x + S.y * kk4.y) + (S.z * kk4.z + S.w * kk4.w);
      sk += dpp_mov<0xB1>(sk);  ovp += dpp_mov<0xB1>(ovp);
      sk += dpp_mov<0x4E>(sk);  ovp += dpp_mov<0x4E>(ovp);
      sk += dpp_mov<0x141>(sk); ovp += dpp_mov<0x141>(ovp);
      sk += dpp_mov<0x140>(sk); ovp += dpp_mov<0x140>(ovp);
      osel = (j == tt - 1) ? ovp : osel;
      const float tx = vv * kd4.x - sk * ak4.x, ty = vv * kd4.y - sk * ak4.y, tz = vv * kd4.z - sk * ak4.z, tw = vv * kd4.w - sk * ak4.w;
      S.x = S.x * w4.x + tx; S.y = S.y * w4.y + ty; S.z = S.z * w4.z + tz; S.w = S.w * w4.w + tw;
      ovp = (S.x * r4.x + S.y * r4.y) + (S.z * r4.z + S.w * r4.w);
      r4 = r4n; kk4 = kk4n; w4 = w4n; ak4 = ak4n; kd4 = kd4n; vv = vvn;
    }
    ovp = reduce16(ovp);
    osel = (j == 15) ? ovp : osel;
    {
      const int st = ch * 16 + j, t = dir == 0 ? st : L - 1 - st;
      odst[(size_t)(seqbase + t) * 256 + h * 64 + row] = osel;
    }
#if REPMASK
    if (ch + 1 < nch && p.pad != 5) lstore((ch + 1) & 1);
#else
    if (ch + 1 < nch) lstore((ch + 1) & 1);
#endif
    asm volatile("s_waitcnt lgkmcnt(0)" ::: "memory");
    __builtin_amdgcn_s_barrier();
  }
  if (!lat) *reinterpret_cast<float4*>(p.out_st + ((((size_t)(b * 4 + layer) * 2 + dir) * 4 + h) * 64 + row) * 64 + 4 * j) = S;
  __syncthreads();
}

__device__ void mixer_phase(const Params& p, int layer, char* smem, int tidx0) {
  int* slot = reinterpret_cast<int*>(smem + 60 * 1024);
  bool first = true;
  for (;;) {
    int tidx = tidx0;
    asm volatile("" : "+v"(tidx));
    const int tid = tidx, wid = tid >> 6;
    __syncthreads();
    if (tid == 0) *slot = first ? (int)blockIdx.x : (int)(gridDim.x + atomicAdd(&p.wq[layer], 1u));
    first = false;
    __syncthreads();
    int it = *slot;
    if (it >= 1728) break;
    const bool is_scan = (it < 64) || (it >= 448 && it < 960);
#if REPMASK
    if ((p.pad == 1 && !is_scan) || (p.pad == 2 && is_scan) || ((p.pad == 3 || p.pad == 5 || p.pad == 6) && !(it < 64)) || (p.pad == 4 && !(it >= 64 && it < 320))) continue;
#endif
    if (is_scan) {
      const bool lat = it < 64;
      const int si = lat ? it : it - 448;
#ifndef NO_SCAN
      scan_item(p, layer, smem, lat, si / 32, (si / 8) % 4, (si / 4) % 2, si % 4, tidx);
#endif
      continue;
    }
    const u16 *Q, *Kb, *Vt; u16* out; int ldq, ldk, ldv, ndense, grow = 0, cq0 = 0; bool na = false;
    const float* rpb = p.in[23];
    if (it < 320) {
      it -= 64;
      const int b = it / 128, qh = (it / 16) % 8, qt = it % 16, kvh = qh >> 2;
      const int q0 = b * 1024 + qt * 64 + wid * 16;
      Q = p.QGl + (size_t)q0 * 512 + qh * 64; ldq = 512;
      Kb = p.KGl + (size_t)((layer * 2 + b) * 2 + kvh) * 98304; ldk = 0;
      Vt = p.VGtl + (size_t)((layer * 2 + b) * 2 + kvh) * 98304; ldv = 0; ndense = 1536;
      out = p.MIX + (size_t)(NCTX + q0) * DM + 512 + qh * 64;
    } else if (it < 448) {
      it -= 320;
      const int b = it / 64, h = (it / 16) % 4, r = it % 16;
      const int q0 = b * 1024 + r * 64 + wid * 16;
      Q = p.QNl + (size_t)q0 * 256 + h * 64; ldq = 256;
      Kb = p.KNl + (size_t)((layer * 2 + b) * 4 + h) * 98304; ldk = 0;
      Vt = p.VNtl + (size_t)((layer * 2 + b) * 4 + h) * 98304; ldv = 0; ndense = 512;
      rpb = p.in[23] + (size_t)(layer * 4 + h) * 15 * 31; grow = r; cq0 = wid * 16; na = true;
      out = p.MIX + (size_t)(NCTX + q0) * DM + 256 + h * 64;
    } else if (it < 1472) {
      it -= 960;
      const int b = it / 32, qh = (it / 4) % 8, qt = it % 4, kvh = qh >> 2;
      const int q0 = b * 256 + qt * 64 + wid * 16;
      Q = p.QGc + (size_t)q0 * 512 + qh * 64; ldq = 512;
      Kb = p.KGc + (size_t)(b * 2 + kvh) * 16384; ldk = 0;
      Vt = p.VGtc + (size_t)(b * 2 + kvh) * 16384; ldv = 0; ndense = 256;
      out = p.MIX + (size_t)q0 * DM + 512 + qh * 64;
    } else {
      it -= 1472;
      const int b = it / 16, h = (it / 4) % 4, qt = it % 4;
      const int q0 = b * 256 + qt * 64 + wid * 16;
      Q = p.QNc + (size_t)q0 * 256 + h * 64; ldq = 256;
      Kb = p.KNc + (size_t)(b * 4 + h) * 16384; ldk = 0;
      Vt = p.VNtc + (size_t)(b * 4 + h) * 16384; ldv = 0; ndense = 256;
      out = p.MIX + (size_t)q0 * DM + 256 + h * 64;
    }
#ifndef NO_ATT
    attn_wave(Q, ldq, Kb, ldk, Vt, ldv, ndense, na, rpb, grow, cq0, out, DM, tidx);
#endif
  }
}

__device__ void rwkv_fin_phase(const Params& p, int layer, int bid, int nblk, int tidx) {
  const int tid = tidx;
  const float lw = p.in[21][(size_t)layer * 256 + tid], lb = p.in[22][(size_t)layer * 256 + tid];
  for (int t4 = bid; t4 < NTOK / 4; t4 += nblk) {
    float of[4], ob[4], bv[4], gg[4];
#pragma unroll
    for (int u = 0; u < 4; ++u) {
      const size_t i = (size_t)(t4 * 4 + u) * 256 + tid;
      of[u] = p.OF[i]; ob[u] = p.OB[i]; bv[u] = p.BV[i]; gg[u] = p.G[i];
    }
#pragma unroll
    for (int u = 0; u < 4; ++u) {
      const float o = of[u] + ob[u];
      const float mu = wave_sum(o) * (1.f / 64.f);
      const float d = o - mu;
      const float var = wave_sum(d * d) * (1.f / 64.f);
      const float y = (d * rsqrtf(var + 64e-5f) * lw + lb + bv[u]) * gg[u];
      p.MIX[(size_t)(t4 * 4 + u) * DM + tid] = f2bf(y);
    }
  }
}

#ifndef ONLY_PH
#define ONLY_PH -1
#endif
#define PH_EN(x) (ONLY_PH < 0 || ONLY_PH == (x))
__device__ __forceinline__ void run_phase(const Params& p, int ph, char* smem, int bid, int nblk, int tidx) {
  if (ph == 0) { if (PH_EN(0)) setup_phase(p, smem, bid, nblk, tidx); return; }
  if (ph == 1) { if (PH_EN(1)) modreduce_phase(p, bid, nblk, tidx); return; }
  if (ph == 2) { if (PH_EN(2)) ln_phase<0>(p, 0, bid, nblk, tidx); return; }
  const int layer = (ph - 3) / 9, s = (ph - 3) % 9;
  switch (s) {
    case 0: if (PH_EN(3)) gemm_phase<EPI_PROJ, 256, 3>(p, layer, p.A, p.winT + (size_t)layer * DIN * DM, DIN, DM, smem, bid, nblk, tidx); break;
    case 1: if (PH_EN(4)) prep_phase(p, layer, smem, bid, nblk, tidx); break;
    case 2: if (PH_EN(5)) mixer_phase(p, layer, smem, tidx); break;
    case 3: if (PH_EN(6)) rwkv_fin_phase(p, layer, bid, nblk, tidx); break;
    case 4: if (PH_EN(7)) gemm_phase<EPI_OUT, 192, 3>(p, layer, p.MIX, p.woutT + (size_t)layer * DM * DM, DM, DM, smem, bid, nblk, tidx); break;
    case 5: if (PH_EN(8)) ln_phase<1>(p, layer, bid, nblk, tidx); break;
    case 6: if (PH_EN(9)) gemm_phase<EPI_FFI, 192, 3>(p, layer, p.A, p.wfiT + (size_t)layer * 2 * DFF * DM, 2 * DFF, DM, smem, bid, nblk, tidx); break;
    case 7: if (PH_EN(10)) gemm_phase<EPI_FFO, 192, 3>(p, layer, p.ACT, p.wfoT + (size_t)layer * DM * DFF, DM, DFF, smem, bid, nblk, tidx); break;
    default: if (PH_EN(11)) ln_phase<2>(p, layer, bid, nblk, tidx); break;
  }
}

__global__ void __launch_bounds__(256, 2) fwd_kernel(Params p, int ph0, int ph1, int usebar) {
  __shared__ __attribute__((aligned(16))) char smem[73728 + 16];
  const int bid = blockIdx.x, nblk = gridDim.x;
  XcdBarrier xb;
  if (usebar && p.never) cg::this_grid().sync();
  if (usebar) {
    if (threadIdx.x == 0) *reinterpret_cast<uint4*>(smem + 73728) = make_uint4(0u, 0u, 0u, 0u);
    __syncthreads();
    xb = xcd_barrier_post(p.bar, (volatile LAS unsigned*)(smem + 73728));
  }
  for (int ph = ph0; ph < ph1; ++ph) {
    int tidx = threadIdx.x;
    asm volatile("" : "+v"(tidx));
    run_phase(p, ph, smem, bid, nblk, tidx);
#if REPMASK
    {
      const int slot_ = ph < 3 ? 9 + ph : (ph - 3) % 9;
      if ((REPMASK >> slot_) & 1) {
        if (usebar) xcd_barrier(xb);
        Params p2 = p; p2.wq = p.wq + 4; p2.pad = REPVAR;
        if (REPVAR >= 5) { p2.OF = p.PROJ; p2.OB = p.PROJ; p2.out_st = p.PROJ + 4000000; p2.MIX = (u16*)(p.PROJ + 8000000); }
        run_phase(p2, ph, smem, bid, nblk, tidx);
      }
    }
#endif
    if (usebar && ph + 1 < ph1) xcd_barrier(xb);
  }
}

static inline size_t al256(size_t x) { return (x + 255) & ~(size_t)255; }

extern "C" void kernel_launch(void* const* d_in, const int* in_sizes, int n_in, void* d_out, int out_size, void* d_ws, size_t ws_size,
                              hipStream_t stream) {
  Params p;
  memset(&p, 0, sizeof(p));
  for (int i = 0; i < 33; ++i) p.in[i] = (const float*)d_in[i];
  float* o = (float*)d_out;
  p.out_yp = o; o += 4194304;
  p.out_ys = o; o += 2097152;
  p.out_st = o; o += 2097152;
  p.out_nak = o; o += 4194304;
  p.out_nav = o; o += 4194304;
  p.out_gk = o; o += 2097152;
  p.out_gv = o;
  char* w = (char*)d_ws; size_t off = 0;
  auto take = [&](size_t bytes) { char* r = w + off; off += al256(bytes); return r; };
  p.bar = (unsigned*)take(16384);
  p.wq = p.bar + 3584;
  p.modp = (float*)take((size_t)4 * 32 * 3 * 6144 * 4);
  p.mod = (float*)take((size_t)4 * 3 * 6144 * 4);
  p.winT = (u16*)take((size_t)4 * DIN * DM * 2);
  p.woutT = (u16*)take((size_t)4 * DM * DM * 2);
  p.wfiT = (u16*)take((size_t)4 * 2 * DFF * DM * 2);
  p.wfoT = (u16*)take((size_t)4 * DM * DFF * 2);
  p.X = (float*)take((size_t)NTOK * DM * 4);
  p.PROJ = (float*)take((size_t)NTOK * DIN * 4);
  p.X1 = p.PROJ;
  p.Y = p.PROJ + (size_t)NTOK * DM;
  p.SC = (float*)take((size_t)NTOK * 4 * 9 * 64 * 4);
  p.ACT = (u16*)p.SC;
  p.G = (float*)take((size_t)NTOK * 256 * 4);
  p.BV = (float*)take((size_t)NTOK * 256 * 4);
  p.OF = (float*)take((size_t)NTOK * 256 * 4);
  p.OB = (float*)take((size_t)NTOK * 256 * 4);
  p.A = (u16*)take((size_t)NTOK * DM * 2);
  p.MIX = (u16*)take((size_t)NTOK * DM * 2);
  p.QNc = (u16*)take((size_t)NCTX * 256 * 2);
  p.KNc = (u16*)take((size_t)NCTX * 256 * 2);
  p.VNtc = (u16*)take((size_t)NCTX * 256 * 2);
  p.QGc = (u16*)take((size_t)NCTX * 512 * 2);
  p.KGc = (u16*)take((size_t)NCTX * 128 * 2);
  p.VGtc = (u16*)take((size_t)NCTX * 128 * 2);
  p.QNl = (u16*)take((size_t)2048 * 256 * 2);
  p.KNl = (u16*)take((size_t)4 * 2 * 1536 * 256 * 2);
  p.VNtl = (u16*)take((size_t)4 * 2 * 1536 * 256 * 2);
  p.QGl = (u16*)take((size_t)2048 * 512 * 2);
  p.KGl = (u16*)take((size_t)4 * 2 * 1536 * 128 * 2);
  p.VGtl = (u16*)take((size_t)4 * 2 * 1536 * 128 * 2);
  p.loraT = (u16*)take((size_t)4 * 98304 * 2);
  p.rope = (float*)take((size_t)64 * 16 * 2 * 4);
  if (off > ws_size) { fprintf(stderr, "workspace too small: need %zu have %zu\n", off, ws_size); return; }

  (void)hipMemsetAsync(p.bar, 0, 16384, stream);
#if MEGA
  static int grid_blocks = 0;
  if (!grid_blocks) {
    int dev = 0, cus = 0, per_cu = 0;
    hipGetDevice(&dev);
    hipDeviceGetAttribute(&cus, hipDeviceAttributeMultiprocessorCount, dev);
    hipOccupancyMaxActiveBlocksPerMultiprocessor(&per_cu, fwd_kernel, 256, 0);
    if (per_cu > 2) per_cu = 2;
    if (per_cu < 1) per_cu = 1;
    grid_blocks = cus * per_cu;
  }
  int ph0 = 0, ph1 = NPH, ub = 1;
  void* args[] = {&p, &ph0, &ph1, &ub};
  hipError_t e = hipLaunchCooperativeKernel((void*)fwd_kernel, dim3(grid_blocks), dim3(256), args, 0, stream);
  if (e != hipSuccess) fprintf(stderr, "cooperative launch failed: %s (grid %d)\n", hipGetErrorString(e), grid_blocks);
#else
  for (int ph = 0; ph < NPH; ++ph) fwd_kernel<<<512, 256, 0, stream>>>(p, ph, ph + 1, 0);
#endif
}
```

```cpp
#include <hip/hip_runtime.h>
#include <hip/hip_cooperative_groups.h>
#include <cstdio>
#include <cstdint>
#include <cstring>
namespace cg = cooperative_groups;

#ifndef REPMASK
#define REPMASK 0
#endif
#ifndef SCANVAR
#define SCANVAR 0
#endif
#ifndef REPVAR
#define REPVAR 0
#endif
#ifndef MEGA
#define MEGA 1
#endif

typedef unsigned short u16;
using bf16x8 = __attribute__((ext_vector_type(8))) short;
using f32x4 = __attribute__((ext_vector_type(4))) float;
using v2f = __attribute__((ext_vector_type(2))) float;

#define NTOK 6144
#define NCTX 4096
#define DM 1024
#define DIN 2688
#define DFF 2816
#define NPH 39
#define ALPHA 1.681792830507429f
#define LOG2E 1.4426950408889634f
#define QSCALE (0.125f * LOG2E)

struct Params {
  const float* in[33];
  float *out_yp, *out_ys, *out_st, *out_nak, *out_nav, *out_gk, *out_gv;
  unsigned *bar, *wq;
  float *modp, *mod;
  u16 *winT, *woutT, *wfiT, *wfoT;
  float *X, *X1, *Y, *PROJ, *SC, *G, *BV, *OF, *OB;
  u16 *A, *MIX, *ACT;
  u16 *QNc, *KNc, *VNtc, *QGc, *KGc, *VGtc;
  u16 *QNl, *KNl, *VNtl, *QGl, *KGl, *VGtl;
  u16* loraT; float* rope;
  int never; int pad;
};

__device__ __forceinline__ u16 f2bf(float f) {
  unsigned u = __float_as_uint(f);
  u += 0x7FFFu + ((u >> 16) & 1u);
  return (u16)(u >> 16);
}
__device__ __forceinline__ unsigned pack2(float a, float b) { return (unsigned)f2bf(a) | ((unsigned)f2bf(b) << 16); }
template <int CTRL> __device__ __forceinline__ float dpp_mov(float v) {
  return __int_as_float(__builtin_amdgcn_update_dpp(0, __float_as_int(v), CTRL, 0xF, 0xF, false));
}
__device__ __forceinline__ float reduce16(float v) {
  v += dpp_mov<0xB1>(v);
  v += dpp_mov<0x4E>(v);
  v += dpp_mov<0x141>(v);
  v += dpp_mov<0x140>(v);
  return v;
}
__device__ __forceinline__ float wave_sum(float v) {
  v = reduce16(v);
  v += __shfl_xor(v, 16);
  v += __shfl_xor(v, 32);
  return v;
}
__device__ __forceinline__ float sigmoidf_(float x) { return 1.f / (1.f + __expf(-x)); }
__device__ __forceinline__ float siluf_(float x) { return x / (1.f + __expf(-x)); }
__device__ __forceinline__ int modrow_of(int tok) { return tok < NCTX ? 0 : 1 + ((tok - NCTX) >> 10); }

#define XB_TMO      128
#define XB_XCNT(j)  (256  + 64 * (j))
#define XB_XSUB(j)  (1280 + 64 * (j))
#define XB_XGEN(j)  (2304 + 64 * (j))
#define XB_TOP      3328
#define XB_TOPGEN   3392
#define XCD_BAR_WORDS 3456
#define XB_SPIN_CAP (1u << 22)
#define LAS __attribute__((address_space(3)))
__device__ __forceinline__ unsigned xb_ld(unsigned* p) { return __hip_atomic_load(p, __ATOMIC_RELAXED, __HIP_MEMORY_SCOPE_AGENT); }
__device__ __forceinline__ unsigned xb_add(unsigned* p, unsigned v) { return __hip_atomic_fetch_add(p, v, __ATOMIC_RELAXED, __HIP_MEMORY_SCOPE_AGENT); }
__device__ __forceinline__ unsigned xb_xcc_id() { return (unsigned)__builtin_amdgcn_s_getreg((3 << 11) | 20) & 0xFu; }
#define XB_SPIN(cond, bar) do { unsigned _sp = 0; while (cond) { __builtin_amdgcn_s_sleep(1); \
    if ((++_sp & 255u) == 0u) { if (xb_ld(&(bar)[XB_TMO])) break; if (_sp > XB_SPIN_CAP) { atomicAdd(&(bar)[XB_TMO], 1u); break; } } } } while (0)
struct XcdBarrier { unsigned* bar; unsigned x; volatile LAS unsigned* st; };
__device__ __forceinline__ XcdBarrier xcd_barrier_post(unsigned* bar, volatile LAS unsigned* st) {
  XcdBarrier b; b.bar = bar; b.x = xb_xcc_id(); b.st = st;
  if (threadIdx.x == 0) (void)xb_add(&bar[XB_XCNT(b.x)], 1u);
  return b;
}
__device__ __forceinline__ void xcd_barrier_complete(unsigned* bar, unsigned x, unsigned& nloc, unsigned& nx) {
  const unsigned G = gridDim.x * gridDim.y * gridDim.z;
  unsigned sum, cnt, mine, sp = 0u;
  for (;;) {
    sum = 0u; cnt = 0u; mine = 0u;
#pragma unroll
    for (unsigned j = 0; j < 16; ++j) { const unsigned c = xb_ld(&bar[XB_XCNT(j)]); sum += c; cnt += (c > 0u) ? 1u : 0u; mine = (j == x) ? c : mine; }
    if (sum == G) break;
    __builtin_amdgcn_s_sleep(1);
    if ((++sp & 255u) == 0u) { if (xb_ld(&bar[XB_TMO])) break; if (sp > XB_SPIN_CAP) { atomicAdd(&bar[XB_TMO], 1u); break; } }
  }
  nloc = mine > 0u ? mine : 1u; nx = cnt > 0u ? cnt : 1u;
}
__device__ __forceinline__ void xcd_barrier(const XcdBarrier& b) {
  asm volatile("s_waitcnt vmcnt(0)" ::: "memory");
  __syncthreads();
  if (threadIdx.x == 0) {
    unsigned* bar = b.bar;
    asm volatile("" : "+s"(bar));
    __builtin_amdgcn_s_waitcnt(0);
    unsigned nloc = b.st[0], nx = b.st[1];
    if (nloc == 0u) { xcd_barrier_complete(bar, b.x, nloc, nx); b.st[0] = nloc; b.st[1] = nx; }
    const unsigned old = xb_add(&bar[XB_XSUB(b.x)], 1u);
    const unsigned gen = old / nloc;
    if (old + 1u == (gen + 1u) * nloc) {
      __builtin_amdgcn_fence(__ATOMIC_RELEASE, "agent");
      asm volatile("s_waitcnt vmcnt(0)" ::: "memory");
      const unsigned og = xb_add(&bar[XB_TOP], 1u);
      const unsigned tg = og / nx;
      if (og + 1u == (tg + 1u) * nx) xb_add(&bar[XB_TOPGEN], 1u);
      else XB_SPIN(xb_ld(&bar[XB_TOPGEN]) == tg, bar);
      __builtin_amdgcn_fence(__ATOMIC_ACQUIRE, "agent");
      xb_add(&bar[XB_XGEN(b.x)], 1u);
      asm volatile("s_waitcnt vmcnt(0)" ::: "memory");
    } else {
      XB_SPIN(xb_ld(&bar[XB_XGEN(b.x)]) == gen, bar);
      __builtin_amdgcn_fence(__ATOMIC_ACQUIRE, "agent");
      asm volatile("s_waitcnt vmcnt(0)" ::: "memory");
    }
  }
  __syncthreads();
}

__device__ __forceinline__ int lds_byte32(int r, int c) {
  const int ob = (r & 15) * 64 + c * 2;
  return (r >> 4) * 1024 + (ob ^ (((ob >> 9) & 1) << 5));
}
__device__ __forceinline__ void stage_rc32(int b, int& R, int& C) {
  const int sb = b & 1023, swz = sb ^ (((sb >> 9) & 1) << 5);
  R = (b >> 10) * 16 + (swz >> 6); C = (swz & 63) >> 1;
}
template <int ROWS>
__device__ __forceinline__ void stage_tile32(const u16* __restrict__ g, int ld, char* lds, int tidx) {
#pragma unroll
  for (int i = 0; i < (ROWS * 64 + 4095) / 4096; ++i) {
    const int b = tidx * 16 + i * 4096;
    if ((i + 1) * 4096 <= ROWS * 64 || tidx < (ROWS * 64 - i * 4096) / 16) {
      int R, C; stage_rc32(b, R, C);
      __builtin_amdgcn_global_load_lds((const unsigned*)(g + (size_t)R * ld + C), (unsigned LAS*)(lds + b), 16, 0, 0);
    }
  }
}
template <int N> __device__ __forceinline__ void wait_vmcnt() {
  if (N == 0) asm volatile("s_waitcnt vmcnt(0)" ::: "memory");
  else if (N == 3) asm volatile("s_waitcnt vmcnt(3)" ::: "memory");
  else if (N == 4) asm volatile("s_waitcnt vmcnt(4)" ::: "memory");
  else if (N == 5) asm volatile("s_waitcnt vmcnt(5)" ::: "memory");
  else if (N == 6) asm volatile("s_waitcnt vmcnt(6)" ::: "memory");
  else if (N == 8) asm volatile("s_waitcnt vmcnt(8)" ::: "memory");
  else if (N == 9) asm volatile("s_waitcnt vmcnt(9)" ::: "memory");
  else if (N == 10) asm volatile("s_waitcnt vmcnt(10)" ::: "memory");
  else if (N == 12) asm volatile("s_waitcnt vmcnt(12)" ::: "memory");
  else asm volatile("s_waitcnt vmcnt(0)" ::: "memory");
}

enum { EPI_PROJ = 0, EPI_OUT = 1, EPI_FFI = 2, EPI_FFO = 3 };

template <int EPI, int BM, int NST>
__device__ __forceinline__ void gemm_phase(const Params& p, int layer, const u16* __restrict__ A, const u16* __restrict__ Bt,
                                           int N, int K, char* smem, int bid, int nblk, int tidx) {
  constexpr int MF = BM / 32;
  const int tid = tidx, lane = tid & 63, wid = tid >> 6, wr = wid >> 1, wc = wid & 1, fr = lane & 15, fq = lane >> 4;
  const int nM = NTOK / BM, nN = N / 128, ntiles = nM * nN, nk = K / 32;
  constexpr int SB = (BM + 128) * 64;
  constexpr int LA = (BM * 64) / 4096;
  const bool extraA = (BM == 96) && (wid < 2);
  for (int tile = bid; tile < ntiles; tile += nblk) {
    const int pm = tile % nM, pn = tile / nM, m0 = pm * BM, n0 = pn * 128;
    f32x4 acc[MF][4];
#pragma unroll
    for (int m = 0; m < MF; ++m)
#pragma unroll
      for (int n = 0; n < 4; ++n) acc[m][n] = (f32x4){0.f, 0.f, 0.f, 0.f};
    const u16* Ag = A + (size_t)m0 * K;
    const u16* Bg = Bt + (size_t)n0 * K;
#pragma unroll
    for (int s_ = 0; s_ < NST - 1; ++s_) {
      stage_tile32<BM>(Ag + s_ * 32, K, smem + s_ * SB, tidx);
      stage_tile32<128>(Bg + s_ * 32, K, smem + s_ * SB + BM * 64, tidx);
    }
    int slot = 0, pslot = NST - 1;
    for (int kt = 0; kt < nk; ++kt) {
      if (kt + NST - 2 < nk) {
        if (BM == 96) { if (extraA) wait_vmcnt<(NST - 2) * 4>(); else wait_vmcnt<(NST - 2) * 3>(); }
        else wait_vmcnt<(NST - 2) * (LA + 2)>();
      } else {
        asm volatile("s_waitcnt vmcnt(0)" ::: "memory");
      }
      __builtin_amdgcn_s_barrier();
      if (kt + NST - 1 < nk) {
        char* nb = smem + pslot * SB;
        stage_tile32<BM>(Ag + (kt + NST - 1) * 32, K, nb, tidx);
        stage_tile32<128>(Bg + (kt + NST - 1) * 32, K, nb + BM * 64, tidx);
      }
      const char* sa = smem + slot * SB;
      const char* sb = sa + BM * 64;
      slot = (slot + 1 == NST) ? 0 : slot + 1;
      pslot = (pslot + 1 == NST) ? 0 : pslot + 1;
      bf16x8 af[MF], bfr[4];
#pragma unroll
      for (int m = 0; m < MF; ++m) af[m] = *reinterpret_cast<const bf16x8*>(sa + lds_byte32(wr * (BM / 2) + m * 16 + fr, fq * 8));
#pragma unroll
      for (int n = 0; n < 4; ++n) bfr[n] = *reinterpret_cast<const bf16x8*>(sb + lds_byte32(wc * 64 + n * 16 + fr, fq * 8));
#pragma unroll
      for (int m = 0; m < MF; ++m)
#pragma unroll
        for (int n = 0; n < 4; ++n) acc[m][n] = __builtin_amdgcn_mfma_f32_16x16x32_bf16(bfr[n], af[m], acc[m][n], 0, 0, 0);
    }
#pragma unroll
    for (int m = 0; m < MF; ++m) {
      const int row = m0 + wr * (BM / 2) + m * 16 + fr;
      if (EPI == EPI_PROJ) {
#pragma unroll
        for (int n = 0; n < 4; ++n) {
          const int col = n0 + wc * 64 + n * 16 + 4 * fq;
          *reinterpret_cast<float4*>(p.PROJ + (size_t)row * DIN + col) = make_float4(acc[m][n][0], acc[m][n][1], acc[m][n][2], acc[m][n][3]);
        }
      } else if (EPI == EPI_OUT || EPI == EPI_FFO) {
        const float* res = (EPI == EPI_OUT) ? p.X : p.X1;
        const float* gate = p.mod + ((size_t)(layer * 3 + modrow_of(row)) * 6 + (EPI == EPI_OUT ? 2 : 5)) * 1024;
#pragma unroll
        for (int n = 0; n < 4; ++n) {
          const int col = n0 + wc * 64 + n * 16 + 4 * fq;
          const float4 xr = *reinterpret_cast<const float4*>(res + (size_t)row * DM + col);
          const float4 gt = *reinterpret_cast<const float4*>(gate + col);
          float4 y;
          y.x = ALPHA * xr.x + gt.x * acc[m][n][0];
          y.y = ALPHA * xr.y + gt.y * acc[m][n][1];
          y.z = ALPHA * xr.z + gt.z * acc[m][n][2];
          y.w = ALPHA * xr.w + gt.w * acc[m][n][3];
          *reinterpret_cast<float4*>(p.Y + (size_t)row * DM + col) = y;
        }
      } else {
#pragma unroll
        for (int n2 = 0; n2 < 2; ++n2) {
          const int j0 = ((n0 + wc * 64) / 32 + n2) * 16 + 4 * fq;
          float a[4];
#pragma unroll
          for (int r = 0; r < 4; ++r) a[r] = siluf_(acc[m][2 * n2][r]) * acc[m][2 * n2 + 1][r];
          uint2 pk; pk.x = pack2(a[0], a[1]); pk.y = pack2(a[2], a[3]);
          *reinterpret_cast<uint2*>(p.ACT + (size_t)row * DFF + j0) = pk;
        }
      }
    }
    asm volatile("s_waitcnt lgkmcnt(0)" ::: "memory");
    __builtin_amdgcn_s_barrier();
  }
}

__device__ __forceinline__ int kf_off(int t, int d) { return (t >> 4) * 1024 + (d >> 5) * 512 + ((d & 31) >> 3) * 128 + (t & 15) * 8 + (d & 7); }
__device__ __forceinline__ int vf_off(int t, int d) { return (t >> 5) * 2048 + (d >> 4) * 512 + (((t & 15) >> 2) * 16 + (d & 15)) * 8 + ((t >> 4) & 1) * 4 + (t & 3); }
__device__ __forceinline__ void pack44_store(u16* base, int t0, int d, const float* v) {
  uint2 a, b; a.x = pack2(v[0], v[1]); a.y = pack2(v[2], v[3]); b.x = pack2(v[4], v[5]); b.y = pack2(v[6], v[7]);
  *reinterpret_cast<uint2*>(base + vf_off(t0, d)) = a;
  *reinterpret_cast<uint2*>(base + vf_off(t0 + 4, d)) = b;
}
__device__ __forceinline__ void pack8_store(u16* dst, const float* v) {
  uint4 pk; pk.x = pack2(v[0], v[1]); pk.y = pack2(v[2], v[3]); pk.z = pack2(v[4], v[5]); pk.w = pack2(v[6], v[7]);
  *reinterpret_cast<uint4*>(dst) = pk;
}

__device__ void setup_phase(const Params& p, char* smem, int bid, int nblk, int tidx) {
  const int tid = tidx;
  const int NI = 768 + 512 + 13;
  for (int it = bid; it < NI; it += nblk) {
    if (it < 768) {
      const int l = it / 192, nc = (it / 32) % 6, kc = it % 32;
      const int col = nc * 1024 + tid * 4;
      const float* wm = p.in[9] + (size_t)l * 1024 * 6144;
      float4 a0 = make_float4(0, 0, 0, 0), a1 = a0, a2 = a0;
      for (int k8 = 0; k8 < 32; k8 += 8) {
        float4 w[8];
#pragma unroll
        for (int u = 0; u < 8; ++u) w[u] = *reinterpret_cast<const float4*>(wm + (size_t)(kc * 32 + k8 + u) * 6144 + col);
#pragma unroll
        for (int u = 0; u < 8; ++u) {
          const int k = kc * 32 + k8 + u;
          const float s0 = siluf_(p.in[8][k]), s1 = siluf_(p.in[7][k]), s2 = siluf_(p.in[7][1024 + k]);
          a0.x += s0 * w[u].x; a0.y += s0 * w[u].y; a0.z += s0 * w[u].z; a0.w += s0 * w[u].w;
          a1.x += s1 * w[u].x; a1.y += s1 * w[u].y; a1.z += s1 * w[u].z; a1.w += s1 * w[u].w;
          a2.x += s2 * w[u].x; a2.y += s2 * w[u].y; a2.z += s2 * w[u].z; a2.w += s2 * w[u].w;
        }
      }
      float* dst = p.modp + (size_t)((l * 32 + kc) * 3) * 6144 + col;
      *reinterpret_cast<float4*>(dst) = a0;
      *reinterpret_cast<float4*>(dst + 6144) = a1;
      *reinterpret_cast<float4*>(dst + 2 * 6144) = a2;
    } else if (it < 1280) {
      const int ci = it - 768, b = ci / 256, l = (ci / 64) % 4, tg = ci % 64, t0 = tg * 8;
      {
        const float* ck = p.in[3] + ((size_t)(b * 4 + l) * 512 + t0) * 256 + tid;
        const float* cv = p.in[4] + ((size_t)(b * 4 + l) * 512 + t0) * 256 + tid;
        float v[8];
#pragma unroll
        for (int tt = 0; tt < 8; ++tt) {
          p.KNl[((size_t)((l * 2 + b) * 4 + (tid >> 6))) * 98304 + kf_off(t0 + tt, tid & 63)] = f2bf(ck[tt * 256]);
          v[tt] = cv[tt * 256];
        }
        pack44_store(p.VNtl + ((size_t)((l * 2 + b) * 4 + (tid >> 6))) * 98304, t0, tid & 63, v);
      }
      if (tid < 128) {
        const float* ck = p.in[5] + ((size_t)(b * 4 + l) * 512 + t0) * 128 + tid;
#pragma unroll
        for (int tt = 0; tt < 8; ++tt) p.KGl[((size_t)((l * 2 + b) * 2 + (tid >> 6))) * 98304 + kf_off(t0 + tt, tid & 63)] = f2bf(ck[tt * 128]);
      } else {
        const int c = tid - 128;
        const float* cv = p.in[6] + ((size_t)(b * 4 + l) * 512 + t0) * 128 + c;
        float v[8];
#pragma unroll
        for (int tt = 0; tt < 8; ++tt) v[tt] = cv[tt * 128];
        pack44_store(p.VGtl + ((size_t)((l * 2 + b) * 2 + (c >> 6))) * 98304, t0, c & 63, v);
      }
    } else {
      const int li = it - (768 + 512);
      if (li == 12) {
        for (int idx = tid; idx < 1024; idx += 256) {
          const int pos = idx >> 4, fi = idx & 15;
          const float ang = (float)pos * exp2f(-(float)fi * (13.287712379549449f / 16.f));
          p.rope[idx * 2] = cosf(ang); p.rope[idx * 2 + 1] = sinf(ang);
        }
      } else {
        const int l = li / 3, m = li % 3;
        u16* dst = p.loraT + (size_t)l * 98304 + m * 32768;
        if (m < 2) {
          const float* src = p.in[m == 0 ? 14 : 16] + (size_t)l * 32768;
          for (int i0 = tid; i0 < 32768; i0 += 256 * 16) {
            float v[16];
#pragma unroll
            for (int u = 0; u < 16; ++u) { const int idx = i0 + 256 * u; const int d = idx >> 14, cch = (idx >> 6) & 255, r = idx & 63; v[u] = src[(d * 64 + r) * 256 + cch]; }
#pragma unroll
            for (int u = 0; u < 16; ++u) dst[i0 + 256 * u] = f2bf(v[u]);
          }
        } else {
          const float* src = p.in[17] + (size_t)l * 32768;
          for (int i0 = tid; i0 < 32768; i0 += 256 * 16) {
            float v[16];
#pragma unroll
            for (int u = 0; u < 16; ++u) { const int idx = i0 + 256 * u; const int cch = idx >> 7, j = idx & 127; v[u] = src[j * 256 + cch]; }
#pragma unroll
            for (int u = 0; u < 16; ++u) dst[i0 + 256 * u] = f2bf(v[u]);
          }
        }
      }
    }
  }
  {
    float* tile = reinterpret_cast<float*>(smem);
    const int NT = 4 * 3040;
    float4 cur0, cur1, cur2, cur3;
    const float* src; u16* dst; int K, N, mat, k0, n0;
#define TR_DECODE(TR) { const int l_ = (TR) / 3040; int r_ = (TR) % 3040; int kt_, nt_; \
      if (r_ < 672) { mat = 0; K = 1024; N = 2688; src = p.in[11] + (size_t)l_ * K * N; dst = p.winT + (size_t)l_ * N * K; kt_ = r_ / 42; nt_ = r_ % 42; } \
      else if (r_ < 928) { r_ -= 672; mat = 1; K = 1024; N = 1024; src = p.in[26] + (size_t)l_ * K * N; dst = p.woutT + (size_t)l_ * N * K; kt_ = r_ / 16; nt_ = r_ % 16; } \
      else if (r_ < 2336) { r_ -= 928; mat = 2; K = 1024; N = 5632; src = p.in[29] + (size_t)l_ * K * N; dst = p.wfiT + (size_t)l_ * N * K; kt_ = r_ / 88; nt_ = r_ % 88; } \
      else { r_ -= 2336; mat = 3; K = 2816; N = 1024; src = p.in[30] + (size_t)l_ * K * N; dst = p.wfoT + (size_t)l_ * N * K; kt_ = r_ / 16; nt_ = r_ % 16; } \
      k0 = kt_ * 64; n0 = nt_ * 64; }
#define TR_LOAD(V, I) V = *reinterpret_cast<const float4*>(src + (size_t)(k0 + (tid >> 4) + 16 * (I)) * N + n0 + (tid & 15) * 4);
#define TR_PUT(V, I) { const int kr_ = (tid >> 4) + 16 * (I), c4_ = (tid & 15) * 4; \
      tile[kr_ * 65 + c4_ + 0] = V.x; tile[kr_ * 65 + c4_ + 1] = V.y; tile[kr_ * 65 + c4_ + 2] = V.z; tile[kr_ * 65 + c4_ + 3] = V.w; }
    int tr = bid;
    if (tr < NT) { TR_DECODE(tr) TR_LOAD(cur0, 0) TR_LOAD(cur1, 1) TR_LOAD(cur2, 2) TR_LOAD(cur3, 3) }
    for (; tr < NT; tr += nblk) {
      TR_PUT(cur0, 0) TR_PUT(cur1, 1) TR_PUT(cur2, 2) TR_PUT(cur3, 3)
      if (tr + nblk < NT) { TR_DECODE(tr + nblk) TR_LOAD(cur0, 0) TR_LOAD(cur1, 1) TR_LOAD(cur2, 2) TR_LOAD(cur3, 3) }
      TR_DECODE(tr)
      __syncthreads();
#pragma unroll
      for (int i = 0; i < 2; ++i) {
        const int idx = tid + 256 * i, nl = idx >> 3, kc = idx & 7;
        int n = n0 + nl;
        if (mat == 2) { const int isup = n >= DFF ? 1 : 0; const int j = n - isup * DFF; n = (j >> 4) * 32 + isup * 16 + (j & 15); }
        float v[8];
#pragma unroll
        for (int jj = 0; jj < 8; ++jj) v[jj] = tile[(kc * 8 + jj) * 65 + nl];
        pack8_store(dst + (size_t)n * K + k0 + kc * 8, v);
      }
      __syncthreads();
    }
#undef TR_DECODE
#undef TR_LOAD
#undef TR_PUT
  }
}

__device__ void modreduce_phase(const Params& p, int bid, int nblk, int tidx) {
  for (int idx = bid * 256 + tidx; idx < 18432; idx += nblk * 256) {
    const int l = idx / 4608, rem = idx % 4608, mr = rem / 1536, c4 = (rem % 1536) * 4;
    float4 a = *reinterpret_cast<const float4*>(p.in[10] + (size_t)l * 6144 + c4);
    for (int k8 = 0; k8 < 32; k8 += 8) {
      float4 v[8];
#pragma unroll
      for (int u = 0; u < 8; ++u) v[u] = *reinterpret_cast<const float4*>(p.modp + (size_t)((l * 32 + k8 + u) * 3 + mr) * 6144 + c4);
#pragma unroll
      for (int u = 0; u < 8; ++u) { a.x += v[u].x; a.y += v[u].y; a.z += v[u].z; a.w += v[u].w; }
    }
    *reinterpret_cast<float4*>(p.mod + (size_t)(l * 3 + mr) * 6144 + c4) = a;
  }
}

template <int MODE>
__device__ void ln_phase(const Params& p, int layer, int bid, int nblk, int tidx) {
  const int lane = tidx & 63, wid = tidx >> 6;
  const bool fin = (MODE == 2 && layer == 3);
  const float* lw = (MODE == 1 ? p.in[27] : p.in[31]) + (size_t)layer * DM;
  const float* lb = (MODE == 1 ? p.in[28] : p.in[32]) + (size_t)layer * DM;
  const int ml = (MODE == 2) ? (layer + 1 < 4 ? layer + 1 : 3) : layer;
  const int which = (MODE == 1) ? 3 : 0;
#define LN_SRC(ROW) (MODE == 0 ? ((ROW) < NCTX ? p.in[0] + (size_t)(ROW) * DM : p.in[1] + (size_t)((ROW) - NCTX) * DM) : p.Y + (size_t)(ROW) * DM)
  float4 nv0, nv1, nv2, nv3;
  int it = bid;
  if (it < NTOK / 4) {
    const float4* s4 = reinterpret_cast<const float4*>(LN_SRC(it * 4 + wid));
    nv0 = s4[lane]; nv1 = s4[lane + 64]; nv2 = s4[lane + 128]; nv3 = s4[lane + 192];
  }
  for (; it < NTOK / 4; it += nblk) {
    const int row = it * 4 + wid;
    float4 v[4] = {nv0, nv1, nv2, nv3};
    if (it + nblk < NTOK / 4) {
      const float4* s4 = reinterpret_cast<const float4*>(LN_SRC((it + nblk) * 4 + wid));
      nv0 = s4[lane]; nv1 = s4[lane + 64]; nv2 = s4[lane + 128]; nv3 = s4[lane + 192];
    }
    float4 w4[4], b4[4], s4v[4], c4v[4];
    const float* sh = p.mod + ((size_t)(ml * 3 + modrow_of(row)) * 6 + which) * 1024;
    const float* sc = sh + 1024;
#pragma unroll
    for (int i = 0; i < 4; ++i) {
      if (MODE != 0) { w4[i] = reinterpret_cast<const float4*>(lw)[lane + 64 * i]; b4[i] = reinterpret_cast<const float4*>(lb)[lane + 64 * i]; }
      if (!fin) { s4v[i] = reinterpret_cast<const float4*>(sh)[lane + 64 * i]; c4v[i] = reinterpret_cast<const float4*>(sc)[lane + 64 * i]; }
    }
    if (MODE != 0) {
      float s = 0.f;
#pragma unroll
      for (int i = 0; i < 4; ++i) s += v[i].x + v[i].y + v[i].z + v[i].w;
      const float mu = wave_sum(s) * (1.f / 1024.f);
      float q = 0.f;
#pragma unroll
      for (int i = 0; i < 4; ++i) {
        v[i].x -= mu; v[i].y -= mu; v[i].z -= mu; v[i].w -= mu;
        q += v[i].x * v[i].x + v[i].y * v[i].y + v[i].z * v[i].z + v[i].w * v[i].w;
      }
      const float rstd = rsqrtf(wave_sum(q) * (1.f / 1024.f) + 1e-5f);
#pragma unroll
      for (int i = 0; i < 4; ++i) {
        v[i].x = v[i].x * rstd * w4[i].x + b4[i].x; v[i].y = v[i].y * rstd * w4[i].y + b4[i].y;
        v[i].z = v[i].z * rstd * w4[i].z + b4[i].z; v[i].w = v[i].w * rstd * w4[i].w + b4[i].w;
      }
    }
    float* xdst = (MODE == 1 ? p.X1 : p.X) + (size_t)row * DM;
#pragma unroll
    for (int i = 0; i < 4; ++i) reinterpret_cast<float4*>(xdst)[lane + 64 * i] = v[i];
    if (fin) {
      float* o = row < NCTX ? p.out_yp + (size_t)row * DM : p.out_ys + (size_t)(row - NCTX) * DM;
#pragma unroll
      for (int i = 0; i < 4; ++i) reinterpret_cast<float4*>(o)[lane + 64 * i] = v[i];
    } else {
      u16* adst = p.A + (size_t)row * DM;
#pragma unroll
      for (int i = 0; i < 4; ++i) {
        uint2 pk;
        pk.x = pack2(v[i].x * (1.f + c4v[i].x) + s4v[i].x, v[i].y * (1.f + c4v[i].y) + s4v[i].y);
        pk.y = pack2(v[i].z * (1.f + c4v[i].z) + s4v[i].z, v[i].w * (1.f + c4v[i].w) + s4v[i].w);
        reinterpret_cast<uint2*>(adst)[lane + 64 * i] = pk;
      }
    }
  }
#undef LN_SRC
}

#define FLD 772
#define LLD 392
__device__ void prep_phase(const Params& p, int layer, char* smem, int bid, int nblk, int tidx) {
  float* F = reinterpret_cast<float*>(smem);
  u16* LIb = reinterpret_cast<u16*>(smem + 16 * FLD * 4);
  const float* cw = p.in[12] + (size_t)layer * 3 * 1152;
  const u16* LW = p.loraT + (size_t)layer * 98304;
  for (int it = bid; it < NTOK / 16; it += nblk) {
    int tid = tidx;
    asm volatile("" : "+v"(tid));
    const int lane = tid & 63, wid = tid >> 6, fr = lane & 15, fq = lane >> 4;
    const int tok0 = it * 16;
    int b, tpos0, L;
    const bool isctx = tok0 < NCTX;
    if (isctx) { b = tok0 >> 8; tpos0 = tok0 & 255; L = 256; }
    else { const int tl = tok0 - NCTX; b = tl >> 10; tpos0 = tl & 1023; L = 1024; }
#pragma unroll 1
    for (int cg = tid; cg < 288; cg += 256) {
      const int c = cg * 4;
      const float4 w0 = *reinterpret_cast<const float4*>(cw + c);
      const float4 w1 = *reinterpret_cast<const float4*>(cw + 1152 + c);
      const float4 w2 = *reinterpret_cast<const float4*>(cw + 2304 + c);
      const float* pr = p.PROJ + (size_t)tok0 * DIN + c;
      float4 x[18];
#pragma unroll
      for (int i = 0; i < 18; ++i) {
        const int tpos = tpos0 + i - 1;
        x[i] = (tpos >= 0 && tpos < L) ? *reinterpret_cast<const float4*>(pr + (ptrdiff_t)(i - 1) * DIN) : make_float4(0.f, 0.f, 0.f, 0.f);
      }
#pragma unroll
      for (int tt = 0; tt < 16; ++tt) {
        float4 f;
        f.x = w0.x * x[tt].x + w1.x * x[tt + 1].x + w2.x * x[tt + 2].x;
        f.y = w0.y * x[tt].y + w1.y * x[tt + 1].y + w2.y * x[tt + 2].y;
        f.z = w0.z * x[tt].z + w1.z * x[tt + 1].z + w2.z * x[tt + 2].z;
        f.w = w0.w * x[tt].w + w1.w * x[tt + 1].w + w2.w * x[tt + 2].w;
        if (c < 768) { *reinterpret_cast<float4*>(F + tt * FLD + c) = f; }
        else {
          const int cc = c - 768;
          if (cc < 128) { f.x = tanhf(f.x); f.y = tanhf(f.y); f.z = tanhf(f.z); f.w = tanhf(f.w); }
          else if (cc >= 256) { f.x = sigmoidf_(f.x); f.y = sigmoidf_(f.y); f.z = sigmoidf_(f.z); f.w = sigmoidf_(f.w); }
          uint2 pk; pk.x = pack2(f.x, f.y); pk.y = pack2(f.z, f.w);
          *reinterpret_cast<uint2*>(LIb + tt * LLD + cc) = pk;
        }
      }
    }
    __syncthreads();
    f32x4 acc[5][4];
#pragma unroll
    for (int g = 0; g < 5; ++g)
#pragma unroll
      for (int nf = 0; nf < 4; ++nf) acc[g][nf] = (f32x4){0.f, 0.f, 0.f, 0.f};
#pragma unroll
    for (int g = 0; g < 4; ++g) {
      const u16* wt = LW + (size_t)g * 16384;
#pragma unroll
      for (int ks = 0; ks < 2; ++ks) {
        const bf16x8 xb = *reinterpret_cast<const bf16x8*>(LIb + fr * LLD + g * 64 + ks * 32 + fq * 8);
#pragma unroll
        for (int nf = 0; nf < 4; ++nf) {
          const bf16x8 wa = *reinterpret_cast<const bf16x8*>(wt + (size_t)(64 * wid + 16 * nf + fr) * 64 + ks * 32 + fq * 8);
          acc[g][nf] = __builtin_amdgcn_mfma_f32_16x16x32_bf16(wa, xb, acc[g][nf], 0, 0, 0);
        }
      }
      __builtin_amdgcn_sched_barrier(0);
    }
    {
      const u16* wt = LW + 65536;
#pragma unroll
      for (int ks = 0; ks < 4; ++ks) {
        const bf16x8 xb = *reinterpret_cast<const bf16x8*>(LIb + fr * LLD + 256 + ks * 32 + fq * 8);
#pragma unroll
        for (int nf = 0; nf < 4; ++nf) {
          const bf16x8 wa = *reinterpret_cast<const bf16x8*>(wt + (size_t)(64 * wid + 16 * nf + fr) * 128 + ks * 32 + fq * 8);
          acc[4][nf] = __builtin_amdgcn_mfma_f32_16x16x32_bf16(wa, xb, acc[4][nf], 0, 0, 0);
        }
        if (ks == 1) __builtin_amdgcn_sched_barrier(0);
      }
      __builtin_amdgcn_sched_barrier(0);
    }
#ifndef NO_C
    {
      const int tok = tok0 + fr;
      float ss = 0.f, bs = 0.f;
#pragma unroll
      for (int nf = 0; nf < 4; ++nf) {
        const int c0 = 64 * wid + 16 * nf + 4 * fq;
        const float4 r4 = *reinterpret_cast<const float4*>(F + fr * FLD + c0);
        const float4 k4 = *reinterpret_cast<const float4*>(F + fr * FLD + 256 + c0);
        const float4 w00 = *reinterpret_cast<const float4*>(p.in[13] + (size_t)layer * 512 + c0);
        const float4 w01 = *reinterpret_cast<const float4*>(p.in[13] + (size_t)layer * 512 + 256 + c0);
        const float4 a00 = *reinterpret_cast<const float4*>(p.in[15] + (size_t)layer * 512 + c0);
        const float4 a01 = *reinterpret_cast<const float4*>(p.in[15] + (size_t)layer * 512 + 256 + c0);
        const float4 kkw = *reinterpret_cast<const float4*>(p.in[18] + (size_t)layer * 256 + c0);
        const float4 kaw = *reinterpret_cast<const float4*>(p.in[19] + (size_t)layer * 256 + c0);
        const float4 rkw = *reinterpret_cast<const float4*>(p.in[20] + (size_t)layer * 256 + c0);
        const float rr[4] = {r4.x, r4.y, r4.z, r4.w}, kk_[4] = {k4.x, k4.y, k4.z, k4.w};
        const float w0a[4] = {w00.x, w00.y, w00.z, w00.w}, w0b[4] = {w01.x, w01.y, w01.z, w01.w};
        const float a0a[4] = {a00.x, a00.y, a00.z, a00.w}, a0b[4] = {a01.x, a01.y, a01.z, a01.w};
        const float kkw_[4] = {kkw.x, kkw.y, kkw.z, kkw.w}, kaw_[4] = {kaw.x, kaw.y, kaw.z, kaw.w}, rkw_[4] = {rkw.x, rkw.y, rkw.z, rkw.w};
#pragma unroll
        for (int r = 0; r < 4; ++r) {
          {
            const float z = -(w0a[r] + acc[0][nf][r]);
            const float sp = fmaxf(z, 0.f) + log1pf(__expf(-fabsf(z)));
            acc[0][nf][r] = __expf(-__expf(-sp - 0.5f));
          }
          {
            const float z = -(w0b[r] + acc[1][nf][r]);
            const float sp = fmaxf(z, 0.f) + log1pf(__expf(-fabsf(z)));
            acc[1][nf][r] = __expf(-__expf(-sp - 0.5f));
          }
          const float av0 = sigmoidf_(a0a[r] + acc[2][nf][r]);
          const float av1 = sigmoidf_(a0b[r] + acc[3][nf][r]);
          acc[2][nf][r] = av0; acc[3][nf][r] = av1;
          const float k = kk_[r];
          const float kq = k * kkw_[r];
          ss += kq * kq;
          const float kd0 = k * (1.f + (av0 - 1.f) * kaw_[r]);
          const float kd1 = k * (1.f + (av1 - 1.f) * kaw_[r]);
          bs += rr[r] * (kd0 + kd1) * rkw_[r];
        }
        __builtin_amdgcn_sched_barrier(0);
      }
      ss += __shfl_xor(ss, 16); ss += __shfl_xor(ss, 32);
      bs += __shfl_xor(bs, 16); bs += __shfl_xor(bs, 32);
      const float inrm = 1.f / fmaxf(sqrtf(ss), 1e-12f);
#pragma unroll
      for (int nf = 0; nf < 4; ++nf) {
        const int c0 = 64 * wid + 16 * nf + 4 * fq, n0 = 16 * nf + 4 * fq;
        const float4 r4 = *reinterpret_cast<const float4*>(F + fr * FLD + c0);
        const float4 k4 = *reinterpret_cast<const float4*>(F + fr * FLD + 256 + c0);
        const float4 v4 = *reinterpret_cast<const float4*>(F + fr * FLD + 512 + c0);
        const float4 kkw = *reinterpret_cast<const float4*>(p.in[18] + (size_t)layer * 256 + c0);
        const float4 kaw = *reinterpret_cast<const float4*>(p.in[19] + (size_t)layer * 256 + c0);
        const float kk_[4] = {k4.x, k4.y, k4.z, k4.w}, kkw_[4] = {kkw.x, kkw.y, kkw.z, kkw.w}, kaw_[4] = {kaw.x, kaw.y, kaw.z, kaw.w};
        float* sc = p.SC + ((size_t)(tok * 4 + wid) * 9) * 64 + n0;
        float kn[4], kd0[4], kd1[4];
#pragma unroll
        for (int r = 0; r < 4; ++r) {
          kn[r] = kk_[r] * kkw_[r] * inrm;
          kd0[r] = kk_[r] * (1.f + (acc[2][nf][r] - 1.f) * kaw_[r]);
          kd1[r] = kk_[r] * (1.f + (acc[3][nf][r] - 1.f) * kaw_[r]);
        }
        *reinterpret_cast<float4*>(sc) = r4;
        *reinterpret_cast<float4*>(sc + 64) = make_float4(kn[0], kn[1], kn[2], kn[3]);
        *reinterpret_cast<float4*>(sc + 128) = v4;
        *reinterpret_cast<float4*>(sc + 192) = make_float4(acc[0][nf][0], acc[0][nf][1], acc[0][nf][2], acc[0][nf][3]);
        *reinterpret_cast<float4*>(sc + 256) = make_float4(acc[2][nf][0] * kn[0], acc[2][nf][1] * kn[1], acc[2][nf][2] * kn[2], acc[2][nf][3] * kn[3]);
        *reinterpret_cast<float4*>(sc + 320) = make_float4(kd0[0], kd0[1], kd0[2], kd0[3]);
        *reinterpret_cast<float4*>(sc + 384) = make_float4(acc[1][nf][0], acc[1][nf][1], acc[1][nf][2], acc[1][nf][3]);
        *reinterpret_cast<float4*>(sc + 448) = make_float4(acc[3][nf][0] * kn[0], acc[3][nf][1] * kn[1], acc[3][nf][2] * kn[2], acc[3][nf][3] * kn[3]);
        *reinterpret_cast<float4*>(sc + 512) = make_float4(kd1[0], kd1[1], kd1[2], kd1[3]);
        *reinterpret_cast<float4*>(p.G + (size_t)tok * 256 + c0) = make_float4(acc[4][nf][0], acc[4][nf][1], acc[4][nf][2], acc[4][nf][3]);
        *reinterpret_cast<float4*>(p.BV + (size_t)tok * 256 + c0) = make_float4(bs * v4.x, bs * v4.y, bs * v4.z, bs * v4.w);
        __builtin_amdgcn_sched_barrier(0);
      }
    }
#endif
#ifndef NO_D
    const int c = tid;
#pragma unroll
    for (int half = 0; half < 2; ++half) {
      float vv[8];
#pragma unroll
      for (int t8 = 0; t8 < 8; ++t8) {
        const int tt = half * 8 + t8, tok = tok0 + tt;
        const float* pr = p.PROJ + (size_t)tok * DIN + 1152 + c;
        const float q = pr[0], k = pr[256], v = pr[512];
        vv[t8] = v;
        if (isctx) {
          const size_t oi = ((size_t)(b * 4 + layer) * 256 + tpos0 + tt) * 256 + c;
          p.out_nak[oi] = k; p.out_nav[oi] = v;
          p.QNc[(size_t)tok * 256 + c] = f2bf(q * QSCALE);
          p.KNc[(size_t)(b * 4 + (c >> 6)) * 16384 + kf_off(tpos0 + tt, c & 63)] = f2bf(k);
        } else {
          p.QNl[(size_t)(tok - NCTX) * 256 + c] = f2bf(q * QSCALE);
          p.KNl[((size_t)((layer * 2 + b) * 4 + (c >> 6))) * 98304 + kf_off(512 + tpos0 + tt, c & 63)] = f2bf(k);
        }
      }
      if (isctx) pack44_store(p.VNtc + (size_t)(b * 4 + (c >> 6)) * 16384, tpos0 + half * 8, c & 63, vv);
      else pack44_store(p.VNtl + ((size_t)((layer * 2 + b) * 4 + (c >> 6))) * 98304, 512 + tpos0 + half * 8, c & 63, vv);
    }
    {
      const float qn = p.in[24][(size_t)layer * 64 + lane], kn = p.in[25][(size_t)layer * 64 + lane];
      const int fi = lane & 15;
#pragma unroll
      for (int half = 0; half < 2; ++half) {
        float vv[8];
#pragma unroll
        for (int t8 = 0; t8 < 8; ++t8) {
          const int tt = half * 8 + t8, tok = tok0 + tt, tpos = tpos0 + tt;
          const float* pr = p.PROJ + (size_t)tok * DIN + 1920;
          float cs = 1.f, sn = 0.f;
          if (!isctx) {
            const int pos = (lane < 32) ? (tpos >> 6) : (tpos & 63);
            const float2 t2 = *reinterpret_cast<const float2*>(p.rope + (size_t)(pos * 16 + fi) * 2);
            cs = t2.x; sn = t2.y;
            if ((lane & 16) == 0) sn = -sn;
          }
#pragma unroll
          for (int hh = 0; hh < 2; ++hh) {
            float q = pr[hh * 256 + c];
            const float ms = wave_sum(q * q) * (1.f / 64.f);
            q = q * rsqrtf(ms + 1e-6f) * qn;
            if (!isctx) { const float qp = __shfl_xor(q, 16); q = q * cs + qp * sn; }
            if (isctx) p.QGc[(size_t)tok * 512 + hh * 256 + c] = f2bf(q * QSCALE);
            else p.QGl[(size_t)(tok - NCTX) * 512 + hh * 256 + c] = f2bf(q * QSCALE);
          }
          if (wid < 2) {
            float k = pr[512 + c];
            const float ms = wave_sum(k * k) * (1.f / 64.f);
            k = k * rsqrtf(ms + 1e-6f) * kn;
            if (isctx) {
              p.out_gk[((size_t)(b * 4 + layer) * 256 + tpos) * 128 + c] = k;
              p.KGc[(size_t)(b * 2 + (c >> 6)) * 16384 + kf_off(tpos, c & 63)] = f2bf(k);
            } else {
              const float kp = __shfl_xor(k, 16); k = k * cs + kp * sn;
              p.KGl[((size_t)((layer * 2 + b) * 2 + (c >> 6))) * 98304 + kf_off(512 + tpos, c & 63)] = f2bf(k);
            }
          } else {
            const int cv = c - 128;
            const float v = pr[640 + cv];
            vv[t8] = v;
            if (isctx) p.out_gv[((size_t)(b * 4 + layer) * 256 + tpos) * 128 + cv] = v;
          }
        }
        if (wid >= 2) {
          const int cv = c - 128;
          if (isctx) pack44_store(p.VGtc + (size_t)(b * 2 + (cv >> 6)) * 16384, tpos0 + half * 8, cv & 63, vv);
          else pack44_store(p.VGtl + ((size_t)((layer * 2 + b) * 2 + (cv >> 6))) * 98304, 512 + tpos0 + half * 8, cv & 63, vv);
        }
      }
    }
#endif
    __syncthreads();
  }
}

#define ATT_LOAD(KF, VF, CI) { \
    const int ci_ = min((CI), nt - 1); \
    int kb_; \
    if (ci_ < nd) kb_ = ci_ * 32; \
    else { const int e_ = ci_ - nd; const int j_ = (ncc == 2) ? (e_ >> 1) : e_; const int cc_ = cc0 + ((ncc == 2) ? (e_ & 1) : 0); kb_ = 512 + (rb + j_) * 64 + cc_ * 32; } \
    const u16* kp_ = Kb + (size_t)(kb_ >> 4) * 1024 + lane * 8; \
    KF##00 = *reinterpret_cast<const bf16x8*>(kp_); \
    KF##01 = *reinterpret_cast<const bf16x8*>(kp_ + 512); \
    KF##10 = *reinterpret_cast<const bf16x8*>(kp_ + 1024); \
    KF##11 = *reinterpret_cast<const bf16x8*>(kp_ + 1536); \
    const u16* vp_ = Vt + (size_t)(kb_ >> 5) * 2048 + lane * 8; \
    VF##0 = *reinterpret_cast<const bf16x8*>(vp_); \
    VF##1 = *reinterpret_cast<const bf16x8*>(vp_ + 512); \
    VF##2 = *reinterpret_cast<const bf16x8*>(vp_ + 1024); \
    VF##3 = *reinterpret_cast<const bf16x8*>(vp_ + 1536); }

#define ATT_PV(DT, VV) { \
    o[DT][0] *= alpha; o[DT][1] *= alpha; o[DT][2] *= alpha; o[DT][3] *= alpha; \
    o[DT] = __builtin_amdgcn_mfma_f32_16x16x32_bf16(VV, pf.v, o[DT], 0, 0, 0); }

#define ATT_COMPUTE(KF, VF, CI) { \
    const int ci_ = (CI); \
    f32x4 s0 = (f32x4){0.f, 0.f, 0.f, 0.f}, s1 = (f32x4){0.f, 0.f, 0.f, 0.f}; \
    s0 = __builtin_amdgcn_mfma_f32_16x16x32_bf16(KF##00, qf0, s0, 0, 0, 0); \
    s0 = __builtin_amdgcn_mfma_f32_16x16x32_bf16(KF##01, qf1, s0, 0, 0, 0); \
    s1 = __builtin_amdgcn_mfma_f32_16x16x32_bf16(KF##10, qf0, s1, 0, 0, 0); \
    s1 = __builtin_amdgcn_mfma_f32_16x16x32_bf16(KF##11, qf1, s1, 0, 0, 0); \
    float sv[8] = {s0[0], s0[1], s0[2], s0[3], s1[0], s1[1], s1[2], s1[3]}; \
    bool ok[8]; \
    _Pragma("unroll") for (int e = 0; e < 8; ++e) ok[e] = true; \
    if (ci_ >= nd) { \
      const int e_ = ci_ - nd; const int j_ = (ncc == 2) ? (e_ >> 1) : e_; const int cc_ = cc0 + ((ncc == 2) ? (e_ & 1) : 0); \
      const int dr_ = rb + j_ - grow + 7; \
      const int cq = cq0 + fr, c0 = min(max(cq - 8, 0), 48); \
      _Pragma("unroll") for (int e = 0; e < 8; ++e) { \
        const int ck = cc_ * 32 + 16 * (e >> 2) + 4 * fq + (e & 3); \
        ok[e] = (ck >= c0) && (ck < c0 + 16); \
        const int dc = min(max(ck - cq, -15), 15) + 15; \
        const float bias = rpb[dr_ * 31 + dc] * LOG2E; \
        sv[e] = ok[e] ? sv[e] + bias : -1e30f; \
      } \
    } \
    float mx = fmaxf(fmaxf(fmaxf(sv[0], sv[1]), fmaxf(sv[2], sv[3])), fmaxf(fmaxf(sv[4], sv[5]), fmaxf(sv[6], sv[7]))); \
    mx = fmaxf(mx, __shfl_xor(mx, 16)); \
    mx = fmaxf(mx, __shfl_xor(mx, 32)); \
    const float mn = fmaxf(m, mx); \
    const float alpha = exp2f(m - mn); \
    m = mn; \
    float ps = 0.f; \
    _Pragma("unroll") for (int e = 0; e < 8; ++e) { sv[e] = ok[e] ? exp2f(sv[e] - mn) : 0.f; ps += sv[e]; } \
    l = l * alpha + ps; \
    union { bf16x8 v; unsigned u[4]; } pf; \
    pf.u[0] = pack2(sv[0], sv[1]); pf.u[1] = pack2(sv[2], sv[3]); pf.u[2] = pack2(sv[4], sv[5]); pf.u[3] = pack2(sv[6], sv[7]); \
    ATT_PV(0, VF##0) ATT_PV(1, VF##1) ATT_PV(2, VF##2) ATT_PV(3, VF##3) }

__device__ __forceinline__ void attn_wave(const u16* __restrict__ Q, int ldq, const u16* __restrict__ Kb, int ldk,
                                          const u16* __restrict__ Vt, int ldv, int ndense, const bool NA,
                                          const float* __restrict__ rpb, int grow, int cq0,
                                          u16* __restrict__ out, int ldo, int tidx) {
  const int lane = tidx & 63, fr = lane & 15, fq = lane >> 4;
  const bf16x8 qf0 = *reinterpret_cast<const bf16x8*>(Q + (size_t)fr * ldq + fq * 8);
  const bf16x8 qf1 = *reinterpret_cast<const bf16x8*>(Q + (size_t)fr * ldq + 32 + fq * 8);
  f32x4 o[4];
#pragma unroll
  for (int dt = 0; dt < 4; ++dt) o[dt] = (f32x4){0.f, 0.f, 0.f, 0.f};
  float m = -1e30f, l = 0.f;
  const int nd = ndense >> 5;
  const int rb = min(max(grow - 4, 0), 8);
  const int ulo = min(max(cq0 - 8, 0), 48), uhi = min(max(cq0 + 15 - 8, 0), 48) + 16;
  const bool c0ok = ulo < 32, c1ok = uhi > 32;
  const int ncc = (c0ok && c1ok) ? 2 : 1, cc0 = c0ok ? 0 : 1;
  const int nt = nd + (NA ? 8 * ncc : 0);
  bf16x8 ka00, ka01, ka10, ka11, kb00, kb01, kb10, kb11;
  bf16x8 va0, va1, va2, va3, vb0, vb1, vb2, vb3;
  ATT_LOAD(ka, va, 0)
  for (int ci = 0; ci < nt; ci += 2) {
    ATT_LOAD(kb, vb, ci + 1)
    ATT_COMPUTE(ka, va, ci)
    if (ci + 1 < nt) {
      ATT_LOAD(ka, va, ci + 2)
      ATT_COMPUTE(kb, vb, ci + 1)
    }
  }
  l += __shfl_xor(l, 16);
  l += __shfl_xor(l, 32);
  const float il = 1.f / l;
#pragma unroll
  for (int dt = 0; dt < 4; ++dt) {
    uint2 pk; pk.x = pack2(o[dt][0] * il, o[dt][1] * il); pk.y = pack2(o[dt][2] * il, o[dt][3] * il);
    *reinterpret_cast<uint2*>(out + (size_t)fr * ldo + 16 * dt + 4 * fq) = pk;
  }
}

__device__ void scan_item(const Params& p, int layer, char* smem, bool lat, int b, int h, int dir, int qd, int tidx) {
  const int tid = tidx, lane = tid & 63, wid = tid >> 6, rr = lane >> 4, j = lane & 15;
  const int L = lat ? 1024 : 256, seqbase = lat ? NCTX + b * 1024 : b * 256;
  const int rowl = wid * 4 + rr, row = qd * 16 + rowl;
  float* cbuf = reinterpret_cast<float*>(smem);
  float* obuf = cbuf + 2 * 16 * 6 * 64;
  float4 S = make_float4(0.f, 0.f, 0.f, 0.f);
  if (lat) S = *reinterpret_cast<const float4*>(p.in[2] + ((((size_t)(b * 4 + layer) * 2 + dir) * 4 + h) * 64 + row) * 64 + 4 * j);
  v2f S01 = (v2f){S.x, S.y}, S23 = (v2f){S.z, S.w};
  const int nch = L / 16;
  float* odst = dir == 0 ? p.OF : p.OB;
  float4 pre0, pre1, pre2, pre3, pre4, pre5;
#define SC_GL1(PR, I, CH) { const int idx = tid + 256 * (I), tt_ = idx / 96, rem = idx % 96, vec = rem >> 4, f4 = rem & 15; \
    const int st_ = (CH) * 16 + tt_, t_ = dir == 0 ? st_ : L - 1 - st_; const int svec = vec < 3 ? vec : vec + 3 * dir; \
    PR = *reinterpret_cast<const float4*>(p.SC + ((size_t)((seqbase + t_) * 4 + h) * 9 + svec) * 64 + f4 * 4); }
#define gload(CH) { SC_GL1(pre0, 0, CH) SC_GL1(pre1, 1, CH) SC_GL1(pre2, 2, CH) SC_GL1(pre3, 3, CH) SC_GL1(pre4, 4, CH) SC_GL1(pre5, 5, CH) }
#define SC_LS1(PR, I, BUF) *reinterpret_cast<float4*>(cbuf + (BUF) * 6144 + (tid + 256 * (I)) * 4) = PR;
#define lstore(BUF) { SC_LS1(pre0, 0, BUF) SC_LS1(pre1, 1, BUF) SC_LS1(pre2, 2, BUF) SC_LS1(pre3, 3, BUF) SC_LS1(pre4, 4, BUF) SC_LS1(pre5, 5, BUF) }
  gload(0); lstore(0);
  __syncthreads();
#define SC_LD(R4, K4, VV, W4, A4, D4, TT) { const float* base_ = cb + (TT) * 384; \
    R4 = *reinterpret_cast<const float4*>(base_ + 4 * j); K4 = *reinterpret_cast<const float4*>(base_ + 64 + 4 * j); \
    VV = base_[128 + row]; W4 = *reinterpret_cast<const float4*>(base_ + 192 + 4 * j); \
    A4 = *reinterpret_cast<const float4*>(base_ + 256 + 4 * j); D4 = *reinterpret_cast<const float4*>(base_ + 320 + 4 * j); }
#if SCANVAR
  for (int pass_ = 0; pass_ < (lat ? 2 : 1); ++pass_) {
  int var_ = pass_ ? SCANVAR : 0;
  asm volatile("" : "+v"(var_)); var_ = __builtin_amdgcn_readfirstlane(var_);
#else
  const int var_ = 0;
#endif
  for (int ch = 0; ch < nch; ++ch) {
    if (ch + 1 < nch && var_ != 3) gload(ch + 1);
    const float* cb = cbuf + (ch & 1) * 6144;
    float osel = 0.f;
    float4 r4, kk4, w4, ak4, kd4; float vv;
    SC_LD(r4, kk4, vv, w4, ak4, kd4, 0)
    float ovp = 0.f;
    if (var_ != 2)
#pragma unroll 8
    for (int tt = 0; tt < 16; ++tt) {
      float4 r4n, kk4n, w4n, ak4n, kd4n; float vvn;
      SC_LD(r4n, kk4n, vvn, w4n, ak4n, kd4n, tt + 1)
      v2f p = S01 * (v2f){kk4.x, kk4.y};
      p = S23 * (v2f){kk4.z, kk4.w} + p;
      float sk = p.x + p.y;
      sk += dpp_mov<0xB1>(sk);  ovp += dpp_mov<0xB1>(ovp);
      sk += dpp_mov<0x4E>(sk);  ovp += dpp_mov<0x4E>(ovp);
      sk += dpp_mov<0x141>(sk); ovp += dpp_mov<0x141>(ovp);
      sk += dpp_mov<0x140>(sk); ovp += dpp_mov<0x140>(ovp);
      osel = (j == tt - 1) ? ovp : osel;
      const v2f vv2 = (v2f){vv, vv}, sk2 = (v2f){sk, sk};
      v2f t01 = (v2f){kd4.x, kd4.y} * vv2; t01 = t01 - (v2f){ak4.x, ak4.y} * sk2;
      v2f t23 = (v2f){kd4.z, kd4.w} * vv2; t23 = t23 - (v2f){ak4.z, ak4.w} * sk2;
      S01 = S01 * (v2f){w4.x, w4.y} + t01;
      S23 = S23 * (v2f){w4.z, w4.w} + t23;
      v2f q = S01 * (v2f){r4.x, r4.y};
      q = S23 * (v2f){r4.z, r4.w} + q;
      ovp = q.x + q.y;
      r4 = r4n; kk4 = kk4n; w4 = w4n; ak4 = ak4n; kd4 = kd4n; vv = vvn;
    }
    ovp = reduce16(ovp);
    osel = (j == 15) ? ovp : osel;
    if (var_ == 0) {
      const int st = ch * 16 + j, t = dir == 0 ? st : L - 1 - st;
      odst[(size_t)(seqbase + t) * 256 + h * 64 + row] = osel;
    } else asm volatile("" :: "v"(osel), "v"(S01), "v"(S23));
    if (ch + 1 < nch && var_ != 3) lstore((ch + 1) & 1);
    asm volatile("s_waitcnt lgkmcnt(0)" ::: "memory");
    __builtin_amdgcn_s_barrier();
  }
#if SCANVAR
  }
#endif
  if (!lat) *reinterpret_cast<float4*>(p.out_st + ((((size_t)(b * 4 + layer) * 2 + dir) * 4 + h) * 64 + row) * 64 + 4 * j) = make_float4(S01.x, S01.y, S23.x, S23.y);
  __syncthreads();
}

__device__ void mixer_phase(const Params& p, int layer, char* smem, int tidx0) {
  int* slot = reinterpret_cast<int*>(smem + 60 * 1024);
  bool first = true;
  for (;;) {
    int tidx = tidx0;
    asm volatile("" : "+v"(tidx));
    const int tid = tidx, wid = tid >> 6;
    __syncthreads();
    if (tid == 0) *slot = first ? (int)blockIdx.x : (int)(gridDim.x + atomicAdd(&p.wq[layer], 1u));
    first = false;
    __syncthreads();
    int it = *slot;
    if (it >= 1728) break;
    const bool is_scan = (it < 64) || (it >= 448 && it < 960);
#if REPMASK
    if ((p.pad == 1 && !is_scan) || (p.pad == 2 && is_scan) || ((p.pad == 3 || p.pad == 5 || p.pad == 6) && !(it < 64)) || (p.pad == 4 && !(it >= 64 && it < 320))) continue;
#endif
    if (is_scan) {
      const bool lat = it < 64;
      const int si = lat ? it : it - 448;
#ifndef NO_SCAN
      scan_item(p, layer, smem, lat, si / 32, (si / 8) % 4, (si / 4) % 2, si % 4, tidx);
#endif
      continue;
    }
    const u16 *Q, *Kb, *Vt; u16* out; int ldq, ldk, ldv, ndense, grow = 0, cq0 = 0; bool na = false;
    const float* rpb = p.in[23];
    if (it < 320) {
      it -= 64;
      const int b = it / 128, qh = (it / 16) % 8, qt = it % 16, kvh = qh >> 2;
      const int q0 = b * 1024 + qt * 64 + wid * 16;
      Q = p.QGl + (size_t)q0 * 512 + qh * 64; ldq = 512;
      Kb = p.KGl + (size_t)((layer * 2 + b) * 2 + kvh) * 98304; ldk = 0;
      Vt = p.VGtl + (size_t)((layer * 2 + b) * 2 + kvh) * 98304; ldv = 0; ndense = 1536;
      out = p.MIX + (size_t)(NCTX + q0) * DM + 512 + qh * 64;
    } else if (it < 448) {
      it -= 320;
      const int b = it / 64, h = (it / 16) % 4, r = it % 16;
      const int q0 = b * 1024 + r * 64 + wid * 16;
      Q = p.QNl + (size_t)q0 * 256 + h * 64; ldq = 256;
      Kb = p.KNl + (size_t)((layer * 2 + b) * 4 + h) * 98304; ldk = 0;
      Vt = p.VNtl + (size_t)((layer * 2 + b) * 4 + h) * 98304; ldv = 0; ndense = 512;
      rpb = p.in[23] + (size_t)(layer * 4 + h) * 15 * 31; grow = r; cq0 = wid * 16; na = true;
      out = p.MIX + (size_t)(NCTX + q0) * DM + 256 + h * 64;
    } else if (it < 1472) {
      it -= 960;
      const int b = it / 32, qh = (it / 4) % 8, qt = it % 4, kvh = qh >> 2;
      const int q0 = b * 256 + qt * 64 + wid * 16;
      Q = p.QGc + (size_t)q0 * 512 + qh * 64; ldq = 512;
      Kb = p.KGc + (size_t)(b * 2 + kvh) * 16384; ldk = 0;
      Vt = p.VGtc + (size_t)(b * 2 + kvh) * 16384; ldv = 0; ndense = 256;
      out = p.MIX + (size_t)q0 * DM + 512 + qh * 64;
    } else {
      it -= 1472;
      const int b = it / 16, h = (it / 4) % 4, qt = it % 4;
      const int q0 = b * 256 + qt * 64 + wid * 16;
      Q = p.QNc + (size_t)q0 * 256 + h * 64; ldq = 256;
      Kb = p.KNc + (size_t)(b * 4 + h) * 16384; ldk = 0;
      Vt = p.VNtc + (size_t)(b * 4 + h) * 16384; ldv = 0; ndense = 256;
      out = p.MIX + (size_t)q0 * DM + 256 + h * 64;
    }
#ifndef NO_ATT
    attn_wave(Q, ldq, Kb, ldk, Vt, ldv, ndense, na, rpb, grow, cq0, out, DM, tidx);
#endif
  }
}

__device__ void rwkv_fin_phase(const Params& p, int layer, int bid, int nblk, int tidx) {
  const int tid = tidx;
  const float lw = p.in[21][(size_t)layer * 256 + tid], lb = p.in[22][(size_t)layer * 256 + tid];
  for (int t4 = bid; t4 < NTOK / 4; t4 += nblk) {
    float of[4], ob[4], bv[4], gg[4];
#pragma unroll
    for (int u = 0; u < 4; ++u) {
      const size_t i = (size_t)(t4 * 4 + u) * 256 + tid;
      of[u] = p.OF[i]; ob[u] = p.OB[i]; bv[u] = p.BV[i]; gg[u] = p.G[i];
    }
#pragma unroll
    for (int u = 0; u < 4; ++u) {
      const float o = of[u] + ob[u];
      const float mu = wave_sum(o) * (1.f / 64.f);
      const float d = o - mu;
      const float var = wave_sum(d * d) * (1.f / 64.f);
      const float y = (d * rsqrtf(var + 64e-5f) * lw + lb + bv[u]) * gg[u];
      p.MIX[(size_t)(t4 * 4 + u) * DM + tid] = f2bf(y);
    }
  }
}

#ifndef ONLY_PH
#define ONLY_PH -1
#endif
#define PH_EN(x) (ONLY_PH < 0 || ONLY_PH == (x))
__device__ __forceinline__ void run_phase(const Params& p, int ph, char* smem, int bid, int nblk, int tidx) {
  if (ph == 0) { if (PH_EN(0)) setup_phase(p, smem, bid, nblk, tidx); return; }
  if (ph == 1) { if (PH_EN(1)) modreduce_phase(p, bid, nblk, tidx); return; }
  if (ph == 2) { if (PH_EN(2)) ln_phase<0>(p, 0, bid, nblk, tidx); return; }
  const int layer = (ph - 3) / 9, s = (ph - 3) % 9;
  switch (s) {
    case 0: if (PH_EN(3)) gemm_phase<EPI_PROJ, 256, 3>(p, layer, p.A, p.winT + (size_t)layer * DIN * DM, DIN, DM, smem, bid, nblk, tidx); break;
    case 1: if (PH_EN(4)) prep_phase(p, layer, smem, bid, nblk, tidx); break;
    case 2: if (PH_EN(5)) mixer_phase(p, layer, smem, tidx); break;
    case 3: if (PH_EN(6)) rwkv_fin_phase(p, layer, bid, nblk, tidx); break;
    case 4: if (PH_EN(7)) gemm_phase<EPI_OUT, 192, 3>(p, layer, p.MIX, p.woutT + (size_t)layer * DM * DM, DM, DM, smem, bid, nblk, tidx); break;
    case 5: if (PH_EN(8)) ln_phase<1>(p, layer, bid, nblk, tidx); break;
    case 6: if (PH_EN(9)) gemm_phase<EPI_FFI, 192, 3>(p, layer, p.A, p.wfiT + (size_t)layer * 2 * DFF * DM, 2 * DFF, DM, smem, bid, nblk, tidx); break;
    case 7: if (PH_EN(10)) gemm_phase<EPI_FFO, 192, 3>(p, layer, p.ACT, p.wfoT + (size_t)layer * DM * DFF, DM, DFF, smem, bid, nblk, tidx); break;
    default: if (PH_EN(11)) ln_phase<2>(p, layer, bid, nblk, tidx); break;
  }
}

__global__ void __launch_bounds__(256, 2) fwd_kernel(Params p, int ph0, int ph1, int usebar) {
  __shared__ __attribute__((aligned(16))) char smem[73728 + 16];
  const int bid = blockIdx.x, nblk = gridDim.x;
  XcdBarrier xb;
  if (usebar && p.never) cg::this_grid().sync();
  if (usebar) {
    if (threadIdx.x == 0) *reinterpret_cast<uint4*>(smem + 73728) = make_uint4(0u, 0u, 0u, 0u);
    __syncthreads();
    xb = xcd_barrier_post(p.bar, (volatile LAS unsigned*)(smem + 73728));
  }
  for (int ph = ph0; ph < ph1; ++ph) {
    int tidx = threadIdx.x;
    asm volatile("" : "+v"(tidx));
    run_phase(p, ph, smem, bid, nblk, tidx);
#if REPMASK
    {
      const int slot_ = ph < 3 ? 9 + ph : (ph - 3) % 9;
      if ((REPMASK >> slot_) & 1) {
        if (usebar) xcd_barrier(xb);
        Params p2 = p; p2.wq = p.wq + 4; p2.pad = REPVAR;
        if (REPVAR >= 5) { p2.OF = p.PROJ; p2.OB = p.PROJ; p2.out_st = p.PROJ + 4000000; p2.MIX = (u16*)(p.PROJ + 8000000); }
        run_phase(p2, ph, smem, bid, nblk, tidx);
      }
    }
#endif
    if (usebar && ph + 1 < ph1) xcd_barrier(xb);
  }
}

static inline size_t al256(size_t x) { return (x + 255) & ~(size_t)255; }

extern "C" void kernel_launch(void* const* d_in, const int* in_sizes, int n_in, void* d_out, int out_size, void* d_ws, size_t ws_size,
                              hipStream_t stream) {
  Params p;
  memset(&p, 0, sizeof(p));
  for (int i = 0; i < 33; ++i) p.in[i] = (const float*)d_in[i];
  float* o = (float*)d_out;
  p.out_yp = o; o += 4194304;
  p.out_ys = o; o += 2097152;
  p.out_st = o; o += 2097152;
  p.out_nak = o; o += 4194304;
  p.out_nav = o; o += 4194304;
  p.out_gk = o; o += 2097152;
  p.out_gv = o;
  char* w = (char*)d_ws; size_t off = 0;
  auto take = [&](size_t bytes) { char* r = w + off; off += al256(bytes); return r; };
  p.bar = (unsigned*)take(16384);
  p.wq = p.bar + 3584;
  p.modp = (float*)take((size_t)4 * 32 * 3 * 6144 * 4);
  p.mod = (float*)take((size_t)4 * 3 * 6144 * 4);
  p.winT = (u16*)take((size_t)4 * DIN * DM * 2);
  p.woutT = (u16*)take((size_t)4 * DM * DM * 2);
  p.wfiT = (u16*)take((size_t)4 * 2 * DFF * DM * 2);
  p.wfoT = (u16*)take((size_t)4 * DM * DFF * 2);
  p.X = (float*)take((size_t)NTOK * DM * 4);
  p.PROJ = (float*)take((size_t)NTOK * DIN * 4);
  p.X1 = p.PROJ;
  p.Y = p.PROJ + (size_t)NTOK * DM;
  p.SC = (float*)take((size_t)NTOK * 4 * 9 * 64 * 4);
  p.ACT = (u16*)p.SC;
  p.G = (float*)take((size_t)NTOK * 256 * 4);
  p.BV = (float*)take((size_t)NTOK * 256 * 4);
  p.OF = (float*)take((size_t)NTOK * 256 * 4);
  p.OB = (float*)take((size_t)NTOK * 256 * 4);
  p.A = (u16*)take((size_t)NTOK * DM * 2);
  p.MIX = (u16*)take((size_t)NTOK * DM * 2);
  p.QNc = (u16*)take((size_t)NCTX * 256 * 2);
  p.KNc = (u16*)take((size_t)NCTX * 256 * 2);
  p.VNtc = (u16*)take((size_t)NCTX * 256 * 2);
  p.QGc = (u16*)take((size_t)NCTX * 512 * 2);
  p.KGc = (u16*)take((size_t)NCTX * 128 * 2);
  p.VGtc = (u16*)take((size_t)NCTX * 128 * 2);
  p.QNl = (u16*)take((size_t)2048 * 256 * 2);
  p.KNl = (u16*)take((size_t)4 * 2 * 1536 * 256 * 2);
  p.VNtl = (u16*)take((size_t)4 * 2 * 1536 * 256 * 2);
  p.QGl = (u16*)take((size_t)2048 * 512 * 2);
  p.KGl = (u16*)take((size_t)4 * 2 * 1536 * 128 * 2);
  p.VGtl = (u16*)take((size_t)4 * 2 * 1536 * 128 * 2);
  p.loraT = (u16*)take((size_t)4 * 98304 * 2);
  p.rope = (float*)take((size_t)64 * 16 * 2 * 4);
  if (off > ws_size) { fprintf(stderr, "workspace too small: need %zu have %zu\n", off, ws_size); return; }

  (void)hipMemsetAsync(p.bar, 0, 16384, stream);
#if MEGA
  static int grid_blocks = 0;
  if (!grid_blocks) {
    int dev = 0, cus = 0, per_cu = 0;
    hipGetDevice(&dev);
    hipDeviceGetAttribute(&cus, hipDeviceAttributeMultiprocessorCount, dev);
    hipOccupancyMaxActiveBlocksPerMultiprocessor(&per_cu, fwd_kernel, 256, 0);
    if (per_cu > 2) per_cu = 2;
    if (per_cu < 1) per_cu = 1;
    grid_blocks = cus * per_cu;
  }
  int ph0 = 0, ph1 = NPH, ub = 1;
  void* args[] = {&p, &ph0, &ph1, &ub};
  hipError_t e = hipLaunchCooperativeKernel((void*)fwd_kernel, dim3(grid_blocks), dim3(256), args, 0, stream);
  if (e != hipSuccess) fprintf(stderr, "cooperative launch failed: %s (grid %d)\n", hipGetErrorString(e), grid_blocks);
#else
  for (int ph = 0; ph < NPH; ++ph) fwd_kernel<<<512, 256, 0, stream>>>(p, ph, ph + 1, 0);
#endif
}
```

```cpp
#include <hip/hip_runtime.h>
#include <hip/hip_cooperative_groups.h>
#include <cstdio>
#include <cstdint>
#include <cstring>
namespace cg = cooperative_groups;

#ifndef REPMASK
#define REPMASK 0
#endif
#ifndef REPSLOT
#define REPSLOT -1
#endif
#ifndef PREPVAR
#define PREPVAR 0
#endif
#ifndef SCANVAR
#define SCANVAR 0
#endif
#ifndef REPVAR
#define REPVAR 0
#endif
#ifndef MEGA
#define MEGA 1
#endif

typedef unsigned short u16;
using bf16x8 = __attribute__((ext_vector_type(8))) short;
using f32x4 = __attribute__((ext_vector_type(4))) float;
using v2f = __attribute__((ext_vector_type(2))) float;

#define NTOK 6144
#define NCTX 4096
#define DM 1024
#define DIN 2688
#define DFF 2816
#define NPH 39
#define ALPHA 1.681792830507429f
#define LOG2E 1.4426950408889634f
#define QSCALE (0.125f * LOG2E)

struct Params {
  const float* in[33];
  float *out_yp, *out_ys, *out_st, *out_nak, *out_nav, *out_gk, *out_gv;
  unsigned *bar, *wq;
  float *modp, *mod;
  u16 *winT, *woutT, *wfiT, *wfoT;
  float *X, *X1, *Y, *PROJ, *SC, *G, *BV, *OF, *OB;
  u16 *A, *MIX, *ACT;
  u16 *QNc, *KNc, *VNtc, *QGc, *KGc, *VGtc;
  u16 *QNl, *KNl, *VNtl, *QGl, *KGl, *VGtl;
  u16* loraT; float* rope;
  int never; int pad;
};

__device__ __forceinline__ u16 f2bf(float f) {
  unsigned u = __float_as_uint(f);
  u += 0x7FFFu + ((u >> 16) & 1u);
  return (u16)(u >> 16);
}
__device__ __forceinline__ unsigned pack2(float a, float b) { return (unsigned)f2bf(a) | ((unsigned)f2bf(b) << 16); }
template <int CTRL> __device__ __forceinline__ float dpp_mov(float v) {
  return __int_as_float(__builtin_amdgcn_update_dpp(0, __float_as_int(v), CTRL, 0xF, 0xF, false));
}
__device__ __forceinline__ float reduce16(float v) {
  v += dpp_mov<0xB1>(v);
  v += dpp_mov<0x4E>(v);
  v += dpp_mov<0x141>(v);
  v += dpp_mov<0x140>(v);
  return v;
}
__device__ __forceinline__ float wave_sum(float v) {
  v = reduce16(v);
  v += __shfl_xor(v, 16);
  v += __shfl_xor(v, 32);
  return v;
}
__device__ __forceinline__ float sigmoidf_(float x) { return 1.f / (1.f + __expf(-x)); }
__device__ __forceinline__ float siluf_(float x) { return x / (1.f + __expf(-x)); }
__device__ __forceinline__ int modrow_of(int tok) { return tok < NCTX ? 0 : 1 + ((tok - NCTX) >> 10); }

#define XB_TMO      128
#define XB_XCNT(j)  (256  + 64 * (j))
#define XB_XSUB(j)  (1280 + 64 * (j))
#define XB_XGEN(j)  (2304 + 64 * (j))
#define XB_TOP      3328
#define XB_TOPGEN   3392
#define XCD_BAR_WORDS 3456
#define XB_SPIN_CAP (1u << 22)
#define LAS __attribute__((address_space(3)))
__device__ __forceinline__ unsigned xb_ld(unsigned* p) { return __hip_atomic_load(p, __ATOMIC_RELAXED, __HIP_MEMORY_SCOPE_AGENT); }
__device__ __forceinline__ unsigned xb_add(unsigned* p, unsigned v) { return __hip_atomic_fetch_add(p, v, __ATOMIC_RELAXED, __HIP_MEMORY_SCOPE_AGENT); }
__device__ __forceinline__ unsigned xb_xcc_id() { return (unsigned)__builtin_amdgcn_s_getreg((3 << 11) | 20) & 0xFu; }
#define XB_SPIN(cond, bar) do { unsigned _sp = 0; while (cond) { __builtin_amdgcn_s_sleep(1); \
    if ((++_sp & 255u) == 0u) { if (xb_ld(&(bar)[XB_TMO])) break; if (_sp > XB_SPIN_CAP) { atomicAdd(&(bar)[XB_TMO], 1u); break; } } } } while (0)
struct XcdBarrier { unsigned* bar; unsigned x; volatile LAS unsigned* st; };
__device__ __forceinline__ XcdBarrier xcd_barrier_post(unsigned* bar, volatile LAS unsigned* st) {
  XcdBarrier b; b.bar = bar; b.x = xb_xcc_id(); b.st = st;
  if (threadIdx.x == 0) (void)xb_add(&bar[XB_XCNT(b.x)], 1u);
  return b;
}
__device__ __forceinline__ void xcd_barrier_complete(unsigned* bar, unsigned x, unsigned& nloc, unsigned& nx) {
  const unsigned G = gridDim.x * gridDim.y * gridDim.z;
  unsigned sum, cnt, mine, sp = 0u;
  for (;;) {
    sum = 0u; cnt = 0u; mine = 0u;
#pragma unroll
    for (unsigned j = 0; j < 16; ++j) { const unsigned c = xb_ld(&bar[XB_XCNT(j)]); sum += c; cnt += (c > 0u) ? 1u : 0u; mine = (j == x) ? c : mine; }
    if (sum == G) break;
    __builtin_amdgcn_s_sleep(1);
    if ((++sp & 255u) == 0u) { if (xb_ld(&bar[XB_TMO])) break; if (sp > XB_SPIN_CAP) { atomicAdd(&bar[XB_TMO], 1u); break; } }
  }
  nloc = mine > 0u ? mine : 1u; nx = cnt > 0u ? cnt : 1u;
}
__device__ __forceinline__ void xcd_barrier(const XcdBarrier& b) {
  asm volatile("s_waitcnt vmcnt(0)" ::: "memory");
  __syncthreads();
  if (threadIdx.x == 0) {
    unsigned* bar = b.bar;
    asm volatile("" : "+s"(bar));
    __builtin_amdgcn_s_waitcnt(0);
    unsigned nloc = b.st[0], nx = b.st[1];
    if (nloc == 0u) { xcd_barrier_complete(bar, b.x, nloc, nx); b.st[0] = nloc; b.st[1] = nx; }
    const unsigned old = xb_add(&bar[XB_XSUB(b.x)], 1u);
    const unsigned gen = old / nloc;
    if (old + 1u == (gen + 1u) * nloc) {
      __builtin_amdgcn_fence(__ATOMIC_RELEASE, "agent");
      asm volatile("s_waitcnt vmcnt(0)" ::: "memory");
      const unsigned og = xb_add(&bar[XB_TOP], 1u);
      const unsigned tg = og / nx;
      if (og + 1u == (tg + 1u) * nx) xb_add(&bar[XB_TOPGEN], 1u);
      else XB_SPIN(xb_ld(&bar[XB_TOPGEN]) == tg, bar);
      __builtin_amdgcn_fence(__ATOMIC_ACQUIRE, "agent");
      xb_add(&bar[XB_XGEN(b.x)], 1u);
      asm volatile("s_waitcnt vmcnt(0)" ::: "memory");
    } else {
      XB_SPIN(xb_ld(&bar[XB_XGEN(b.x)]) == gen, bar);
      __builtin_amdgcn_fence(__ATOMIC_ACQUIRE, "agent");
      asm volatile("s_waitcnt vmcnt(0)" ::: "memory");
    }
  }
  __syncthreads();
}

__device__ __forceinline__ int lds_byte32(int r, int c) {
  const int ob = (r & 15) * 64 + c * 2;
  return (r >> 4) * 1024 + (ob ^ (((ob >> 9) & 1) << 5));
}
__device__ __forceinline__ void stage_rc32(int b, int& R, int& C) {
  const int sb = b & 1023, swz = sb ^ (((sb >> 9) & 1) << 5);
  R = (b >> 10) * 16 + (swz >> 6); C = (swz & 63) >> 1;
}
template <int ROWS>
__device__ __forceinline__ void stage_tile32(const u16* __restrict__ g, int ld, char* lds, int tidx) {
#pragma unroll
  for (int i = 0; i < (ROWS * 64 + 4095) / 4096; ++i) {
    const int b = tidx * 16 + i * 4096;
    if ((i + 1) * 4096 <= ROWS * 64 || tidx < (ROWS * 64 - i * 4096) / 16) {
      int R, C; stage_rc32(b, R, C);
      __builtin_amdgcn_global_load_lds((const unsigned*)(g + (size_t)R * ld + C), (unsigned LAS*)(lds + b), 16, 0, 0);
    }
  }
}
template <int N> __device__ __forceinline__ void wait_vmcnt() {
  if (N == 0) asm volatile("s_waitcnt vmcnt(0)" ::: "memory");
  else if (N == 3) asm volatile("s_waitcnt vmcnt(3)" ::: "memory");
  else if (N == 4) asm volatile("s_waitcnt vmcnt(4)" ::: "memory");
  else if (N == 5) asm volatile("s_waitcnt vmcnt(5)" ::: "memory");
  else if (N == 6) asm volatile("s_waitcnt vmcnt(6)" ::: "memory");
  else if (N == 8) asm volatile("s_waitcnt vmcnt(8)" ::: "memory");
  else if (N == 9) asm volatile("s_waitcnt vmcnt(9)" ::: "memory");
  else if (N == 10) asm volatile("s_waitcnt vmcnt(10)" ::: "memory");
  else if (N == 12) asm volatile("s_waitcnt vmcnt(12)" ::: "memory");
  else asm volatile("s_waitcnt vmcnt(0)" ::: "memory");
}

enum { EPI_PROJ = 0, EPI_OUT = 1, EPI_FFI = 2, EPI_FFO = 3 };

template <int EPI, int BM, int NST>
__device__ __forceinline__ void gemm_phase(const Params& p, int layer, const u16* __restrict__ A, const u16* __restrict__ Bt,
                                           int N, int K, char* smem, int bid, int nblk, int tidx) {
  constexpr int MF = BM / 32;
  const int tid = tidx, lane = tid & 63, wid = tid >> 6, wr = wid >> 1, wc = wid & 1, fr = lane & 15, fq = lane >> 4;
  const int nM = NTOK / BM, nN = N / 128, ntiles = nM * nN, nk = K / 32;
  constexpr int SB = (BM + 128) * 64;
  constexpr int LA = (BM * 64) / 4096;
  const bool extraA = (BM == 96) && (wid < 2);
  for (int tile = bid; tile < ntiles; tile += nblk) {
    const int pm = tile % nM, pn = tile / nM, m0 = pm * BM, n0 = pn * 128;
    f32x4 acc[MF][4];
#pragma unroll
    for (int m = 0; m < MF; ++m)
#pragma unroll
      for (int n = 0; n < 4; ++n) acc[m][n] = (f32x4){0.f, 0.f, 0.f, 0.f};
    const u16* Ag = A + (size_t)m0 * K;
    const u16* Bg = Bt + (size_t)n0 * K;
#pragma unroll
    for (int s_ = 0; s_ < NST - 1; ++s_) {
      stage_tile32<BM>(Ag + s_ * 32, K, smem + s_ * SB, tidx);
      stage_tile32<128>(Bg + s_ * 32, K, smem + s_ * SB + BM * 64, tidx);
    }
    int slot = 0, pslot = NST - 1;
    for (int kt = 0; kt < nk; ++kt) {
      if (kt + NST - 2 < nk) {
        if (BM == 96) { if (extraA) wait_vmcnt<(NST - 2) * 4>(); else wait_vmcnt<(NST - 2) * 3>(); }
        else wait_vmcnt<(NST - 2) * (LA + 2)>();
      } else {
        asm volatile("s_waitcnt vmcnt(0)" ::: "memory");
      }
      __builtin_amdgcn_s_barrier();
      if (kt + NST - 1 < nk) {
        char* nb = smem + pslot * SB;
        stage_tile32<BM>(Ag + (kt + NST - 1) * 32, K, nb, tidx);
        stage_tile32<128>(Bg + (kt + NST - 1) * 32, K, nb + BM * 64, tidx);
      }
      const char* sa = smem + slot * SB;
      const char* sb = sa + BM * 64;
      slot = (slot + 1 == NST) ? 0 : slot + 1;
      pslot = (pslot + 1 == NST) ? 0 : pslot + 1;
      bf16x8 af[MF], bfr[4];
#pragma unroll
      for (int m = 0; m < MF; ++m) af[m] = *reinterpret_cast<const bf16x8*>(sa + lds_byte32(wr * (BM / 2) + m * 16 + fr, fq * 8));
#pragma unroll
      for (int n = 0; n < 4; ++n) bfr[n] = *reinterpret_cast<const bf16x8*>(sb + lds_byte32(wc * 64 + n * 16 + fr, fq * 8));
#pragma unroll
      for (int m = 0; m < MF; ++m)
#pragma unroll
        for (int n = 0; n < 4; ++n) acc[m][n] = __builtin_amdgcn_mfma_f32_16x16x32_bf16(bfr[n], af[m], acc[m][n], 0, 0, 0);
    }
#pragma unroll
    for (int m = 0; m < MF; ++m) {
      const int row = m0 + wr * (BM / 2) + m * 16 + fr;
      if (EPI == EPI_PROJ) {
#pragma unroll
        for (int n = 0; n < 4; ++n) {
          const int col = n0 + wc * 64 + n * 16 + 4 * fq;
          *reinterpret_cast<float4*>(p.PROJ + (size_t)row * DIN + col) = make_float4(acc[m][n][0], acc[m][n][1], acc[m][n][2], acc[m][n][3]);
        }
      } else if (EPI == EPI_OUT || EPI == EPI_FFO) {
        const float* res = (EPI == EPI_OUT) ? p.X : p.X1;
        const float* gate = p.mod + ((size_t)(layer * 3 + modrow_of(row)) * 6 + (EPI == EPI_OUT ? 2 : 5)) * 1024;
#pragma unroll
        for (int n = 0; n < 4; ++n) {
          const int col = n0 + wc * 64 + n * 16 + 4 * fq;
          const float4 xr = *reinterpret_cast<const float4*>(res + (size_t)row * DM + col);
          const float4 gt = *reinterpret_cast<const float4*>(gate + col);
          float4 y;
          y.x = ALPHA * xr.x + gt.x * acc[m][n][0];
          y.y = ALPHA * xr.y + gt.y * acc[m][n][1];
          y.z = ALPHA * xr.z + gt.z * acc[m][n][2];
          y.w = ALPHA * xr.w + gt.w * acc[m][n][3];
          *reinterpret_cast<float4*>(p.Y + (size_t)row * DM + col) = y;
        }
      } else {
#pragma unroll
        for (int n2 = 0; n2 < 2; ++n2) {
          const int j0 = ((n0 + wc * 64) / 32 + n2) * 16 + 4 * fq;
          float a[4];
#pragma unroll
          for (int r = 0; r < 4; ++r) a[r] = siluf_(acc[m][2 * n2][r]) * acc[m][2 * n2 + 1][r];
          uint2 pk; pk.x = pack2(a[0], a[1]); pk.y = pack2(a[2], a[3]);
          *reinterpret_cast<uint2*>(p.ACT + (size_t)row * DFF + j0) = pk;
        }
      }
    }
    asm volatile("s_waitcnt lgkmcnt(0)" ::: "memory");
    __builtin_amdgcn_s_barrier();
  }
}

__device__ __forceinline__ int kf_off(int t, int d) { return (t >> 4) * 1024 + (d >> 5) * 512 + ((d & 31) >> 3) * 128 + (t & 15) * 8 + (d & 7); }
__device__ __forceinline__ int vf_off(int t, int d) { return (t >> 5) * 2048 + (d >> 4) * 512 + (((t & 15) >> 2) * 16 + (d & 15)) * 8 + ((t >> 4) & 1) * 4 + (t & 3); }
__device__ __forceinline__ void pack44_store(u16* base, int t0, int d, const float* v) {
  uint2 a, b; a.x = pack2(v[0], v[1]); a.y = pack2(v[2], v[3]); b.x = pack2(v[4], v[5]); b.y = pack2(v[6], v[7]);
  *reinterpret_cast<uint2*>(base + vf_off(t0, d)) = a;
  *reinterpret_cast<uint2*>(base + vf_off(t0 + 4, d)) = b;
}
__device__ __forceinline__ void pack8_store(u16* dst, const float* v) {
  uint4 pk; pk.x = pack2(v[0], v[1]); pk.y = pack2(v[2], v[3]); pk.z = pack2(v[4], v[5]); pk.w = pack2(v[6], v[7]);
  *reinterpret_cast<uint4*>(dst) = pk;
}

__device__ void setup_phase(const Params& p, char* smem, int bid, int nblk, int tidx) {
  const int tid = tidx;
  const int NI = 768 + 512 + 13;
  for (int it = bid; it < NI; it += nblk) {
    if (it < 768) {
      const int l = it / 192, nc = (it / 32) % 6, kc = it % 32;
      const int col = nc * 1024 + tid * 4;
      const float* wm = p.in[9] + (size_t)l * 1024 * 6144;
      float4 a0 = make_float4(0, 0, 0, 0), a1 = a0, a2 = a0;
      for (int k8 = 0; k8 < 32; k8 += 8) {
        float4 w[8];
#pragma unroll
        for (int u = 0; u < 8; ++u) w[u] = *reinterpret_cast<const float4*>(wm + (size_t)(kc * 32 + k8 + u) * 6144 + col);
#pragma unroll
        for (int u = 0; u < 8; ++u) {
          const int k = kc * 32 + k8 + u;
          const float s0 = siluf_(p.in[8][k]), s1 = siluf_(p.in[7][k]), s2 = siluf_(p.in[7][1024 + k]);
          a0.x += s0 * w[u].x; a0.y += s0 * w[u].y; a0.z += s0 * w[u].z; a0.w += s0 * w[u].w;
          a1.x += s1 * w[u].x; a1.y += s1 * w[u].y; a1.z += s1 * w[u].z; a1.w += s1 * w[u].w;
          a2.x += s2 * w[u].x; a2.y += s2 * w[u].y; a2.z += s2 * w[u].z; a2.w += s2 * w[u].w;
        }
      }
      float* dst = p.modp + (size_t)((l * 32 + kc) * 3) * 6144 + col;
      *reinterpret_cast<float4*>(dst) = a0;
      *reinterpret_cast<float4*>(dst + 6144) = a1;
      *reinterpret_cast<float4*>(dst + 2 * 6144) = a2;
    } else if (it < 1280) {
      const int ci = it - 768, b = ci / 256, l = (ci / 64) % 4, tg = ci % 64, t0 = tg * 8;
      {
        const float* ck = p.in[3] + ((size_t)(b * 4 + l) * 512 + t0) * 256 + tid;
        const float* cv = p.in[4] + ((size_t)(b * 4 + l) * 512 + t0) * 256 + tid;
        float v[8];
#pragma unroll
        for (int tt = 0; tt < 8; ++tt) {
          p.KNl[((size_t)((l * 2 + b) * 4 + (tid >> 6))) * 98304 + kf_off(t0 + tt, tid & 63)] = f2bf(ck[tt * 256]);
          v[tt] = cv[tt * 256];
        }
        pack44_store(p.VNtl + ((size_t)((l * 2 + b) * 4 + (tid >> 6))) * 98304, t0, tid & 63, v);
      }
      if (tid < 128) {
        const float* ck = p.in[5] + ((size_t)(b * 4 + l) * 512 + t0) * 128 + tid;
#pragma unroll
        for (int tt = 0; tt < 8; ++tt) p.KGl[((size_t)((l * 2 + b) * 2 + (tid >> 6))) * 98304 + kf_off(t0 + tt, tid & 63)] = f2bf(ck[tt * 128]);
      } else {
        const int c = tid - 128;
        const float* cv = p.in[6] + ((size_t)(b * 4 + l) * 512 + t0) * 128 + c;
        float v[8];
#pragma unroll
        for (int tt = 0; tt < 8; ++tt) v[tt] = cv[tt * 128];
        pack44_store(p.VGtl + ((size_t)((l * 2 + b) * 2 + (c >> 6))) * 98304, t0, c & 63, v);
      }
    } else {
      const int li = it - (768 + 512);
      if (li == 12) {
        for (int idx = tid; idx < 1024; idx += 256) {
          const int pos = idx >> 4, fi = idx & 15;
          const float ang = (float)pos * exp2f(-(float)fi * (13.287712379549449f / 16.f));
          p.rope[idx * 2] = cosf(ang); p.rope[idx * 2 + 1] = sinf(ang);
        }
      } else {
        const int l = li / 3, m = li % 3;
        u16* dst = p.loraT + (size_t)l * 98304 + m * 32768;
        if (m < 2) {
          const float* src = p.in[m == 0 ? 14 : 16] + (size_t)l * 32768;
          for (int i0 = tid; i0 < 32768; i0 += 256 * 16) {
            float v[16];
#pragma unroll
            for (int u = 0; u < 16; ++u) { const int idx = i0 + 256 * u; const int d = idx >> 14, cch = (idx >> 6) & 255, r = idx & 63; v[u] = src[(d * 64 + r) * 256 + cch]; }
#pragma unroll
            for (int u = 0; u < 16; ++u) dst[i0 + 256 * u] = f2bf(v[u]);
          }
        } else {
          const float* src = p.in[17] + (size_t)l * 32768;
          for (int i0 = tid; i0 < 32768; i0 += 256 * 16) {
            float v[16];
#pragma unroll
            for (int u = 0; u < 16; ++u) { const int idx = i0 + 256 * u; const int cch = idx >> 7, j = idx & 127; v[u] = src[j * 256 + cch]; }
#pragma unroll
            for (int u = 0; u < 16; ++u) dst[i0 + 256 * u] = f2bf(v[u]);
          }
        }
      }
    }
  }
  {
    float* tile = reinterpret_cast<float*>(smem);
    const int NT = 4 * 3040;
    float4 cur0, cur1, cur2, cur3;
    const float* src; u16* dst; int K, N, mat, k0, n0;
#define TR_DECODE(TR) { const int l_ = (TR) / 3040; int r_ = (TR) % 3040; int kt_, nt_; \
      if (r_ < 672) { mat = 0; K = 1024; N = 2688; src = p.in[11] + (size_t)l_ * K * N; dst = p.winT + (size_t)l_ * N * K; kt_ = r_ / 42; nt_ = r_ % 42; } \
      else if (r_ < 928) { r_ -= 672; mat = 1; K = 1024; N = 1024; src = p.in[26] + (size_t)l_ * K * N; dst = p.woutT + (size_t)l_ * N * K; kt_ = r_ / 16; nt_ = r_ % 16; } \
      else if (r_ < 2336) { r_ -= 928; mat = 2; K = 1024; N = 5632; src = p.in[29] + (size_t)l_ * K * N; dst = p.wfiT + (size_t)l_ * N * K; kt_ = r_ / 88; nt_ = r_ % 88; } \
      else { r_ -= 2336; mat = 3; K = 2816; N = 1024; src = p.in[30] + (size_t)l_ * K * N; dst = p.wfoT + (size_t)l_ * N * K; kt_ = r_ / 16; nt_ = r_ % 16; } \
      k0 = kt_ * 64; n0 = nt_ * 64; }
#define TR_LOAD(V, I) V = *reinterpret_cast<const float4*>(src + (size_t)(k0 + (tid >> 4) + 16 * (I)) * N + n0 + (tid & 15) * 4);
#define TR_PUT(V, I) { const int kr_ = (tid >> 4) + 16 * (I), c4_ = (tid & 15) * 4; \
      tile[kr_ * 65 + c4_ + 0] = V.x; tile[kr_ * 65 + c4_ + 1] = V.y; tile[kr_ * 65 + c4_ + 2] = V.z; tile[kr_ * 65 + c4_ + 3] = V.w; }
    int tr = bid;
    if (tr < NT) { TR_DECODE(tr) TR_LOAD(cur0, 0) TR_LOAD(cur1, 1) TR_LOAD(cur2, 2) TR_LOAD(cur3, 3) }
    for (; tr < NT; tr += nblk) {
      TR_PUT(cur0, 0) TR_PUT(cur1, 1) TR_PUT(cur2, 2) TR_PUT(cur3, 3)
      if (tr + nblk < NT) { TR_DECODE(tr + nblk) TR_LOAD(cur0, 0) TR_LOAD(cur1, 1) TR_LOAD(cur2, 2) TR_LOAD(cur3, 3) }
      TR_DECODE(tr)
      __syncthreads();
#pragma unroll
      for (int i = 0; i < 2; ++i) {
        const int idx = tid + 256 * i, nl = idx >> 3, kc = idx & 7;
        int n = n0 + nl;
        if (mat == 2) { const int isup = n >= DFF ? 1 : 0; const int j = n - isup * DFF; n = (j >> 4) * 32 + isup * 16 + (j & 15); }
        float v[8];
#pragma unroll
        for (int jj = 0; jj < 8; ++jj) v[jj] = tile[(kc * 8 + jj) * 65 + nl];
        pack8_store(dst + (size_t)n * K + k0 + kc * 8, v);
      }
      __syncthreads();
    }
#undef TR_DECODE
#undef TR_LOAD
#undef TR_PUT
  }
}

__device__ void modreduce_phase(const Params& p, int bid, int nblk, int tidx) {
  for (int idx = bid * 256 + tidx; idx < 18432; idx += nblk * 256) {
    const int l = idx / 4608, rem = idx % 4608, mr = rem / 1536, c4 = (rem % 1536) * 4;
    float4 a = *reinterpret_cast<const float4*>(p.in[10] + (size_t)l * 6144 + c4);
    for (int k8 = 0; k8 < 32; k8 += 8) {
      float4 v[8];
#pragma unroll
      for (int u = 0; u < 8; ++u) v[u] = *reinterpret_cast<const float4*>(p.modp + (size_t)((l * 32 + k8 + u) * 3 + mr) * 6144 + c4);
#pragma unroll
      for (int u = 0; u < 8; ++u) { a.x += v[u].x; a.y += v[u].y; a.z += v[u].z; a.w += v[u].w; }
    }
    *reinterpret_cast<float4*>(p.mod + (size_t)(l * 3 + mr) * 6144 + c4) = a;
  }
}

template <int MODE>
__device__ void ln_phase(const Params& p, int layer, int bid, int nblk, int tidx) {
  const int lane = tidx & 63, wid = tidx >> 6;
  const bool fin = (MODE == 2 && layer == 3);
  const float* lw = (MODE == 1 ? p.in[27] : p.in[31]) + (size_t)layer * DM;
  const float* lb = (MODE == 1 ? p.in[28] : p.in[32]) + (size_t)layer * DM;
  const int ml = (MODE == 2) ? (layer + 1 < 4 ? layer + 1 : 3) : layer;
  const int which = (MODE == 1) ? 3 : 0;
#define LN_SRC(ROW) (MODE == 0 ? ((ROW) < NCTX ? p.in[0] + (size_t)(ROW) * DM : p.in[1] + (size_t)((ROW) - NCTX) * DM) : p.Y + (size_t)(ROW) * DM)
  float4 nv0, nv1, nv2, nv3;
  int it = bid;
  if (it < NTOK / 4) {
    const float4* s4 = reinterpret_cast<const float4*>(LN_SRC(it * 4 + wid));
    nv0 = s4[lane]; nv1 = s4[lane + 64]; nv2 = s4[lane + 128]; nv3 = s4[lane + 192];
  }
  for (; it < NTOK / 4; it += nblk) {
    const int row = it * 4 + wid;
    float4 v[4] = {nv0, nv1, nv2, nv3};
    if (it + nblk < NTOK / 4) {
      const float4* s4 = reinterpret_cast<const float4*>(LN_SRC((it + nblk) * 4 + wid));
      nv0 = s4[lane]; nv1 = s4[lane + 64]; nv2 = s4[lane + 128]; nv3 = s4[lane + 192];
    }
    float4 w4[4], b4[4], s4v[4], c4v[4];
    const float* sh = p.mod + ((size_t)(ml * 3 + modrow_of(row)) * 6 + which) * 1024;
    const float* sc = sh + 1024;
#pragma unroll
    for (int i = 0; i < 4; ++i) {
      if (MODE != 0) { w4[i] = reinterpret_cast<const float4*>(lw)[lane + 64 * i]; b4[i] = reinterpret_cast<const float4*>(lb)[lane + 64 * i]; }
      if (!fin) { s4v[i] = reinterpret_cast<const float4*>(sh)[lane + 64 * i]; c4v[i] = reinterpret_cast<const float4*>(sc)[lane + 64 * i]; }
    }
    if (MODE != 0) {
      float s = 0.f;
#pragma unroll
      for (int i = 0; i < 4; ++i) s += v[i].x + v[i].y + v[i].z + v[i].w;
      const float mu = wave_sum(s) * (1.f / 1024.f);
      float q = 0.f;
#pragma unroll
      for (int i = 0; i < 4; ++i) {
        v[i].x -= mu; v[i].y -= mu; v[i].z -= mu; v[i].w -= mu;
        q += v[i].x * v[i].x + v[i].y * v[i].y + v[i].z * v[i].z + v[i].w * v[i].w;
      }
      const float rstd = rsqrtf(wave_sum(q) * (1.f / 1024.f) + 1e-5f);
#pragma unroll
      for (int i = 0; i < 4; ++i) {
        v[i].x = v[i].x * rstd * w4[i].x + b4[i].x; v[i].y = v[i].y * rstd * w4[i].y + b4[i].y;
        v[i].z = v[i].z * rstd * w4[i].z + b4[i].z; v[i].w = v[i].w * rstd * w4[i].w + b4[i].w;
      }
    }
    float* xdst = (MODE == 1 ? p.X1 : p.X) + (size_t)row * DM;
#pragma unroll
    for (int i = 0; i < 4; ++i) reinterpret_cast<float4*>(xdst)[lane + 64 * i] = v[i];
    if (fin) {
      float* o = row < NCTX ? p.out_yp + (size_t)row * DM : p.out_ys + (size_t)(row - NCTX) * DM;
#pragma unroll
      for (int i = 0; i < 4; ++i) reinterpret_cast<float4*>(o)[lane + 64 * i] = v[i];
    } else {
      u16* adst = p.A + (size_t)row * DM;
#pragma unroll
      for (int i = 0; i < 4; ++i) {
        uint2 pk;
        pk.x = pack2(v[i].x * (1.f + c4v[i].x) + s4v[i].x, v[i].y * (1.f + c4v[i].y) + s4v[i].y);
        pk.y = pack2(v[i].z * (1.f + c4v[i].z) + s4v[i].z, v[i].w * (1.f + c4v[i].w) + s4v[i].w);
        reinterpret_cast<uint2*>(adst)[lane + 64 * i] = pk;
      }
    }
  }
#undef LN_SRC
}

#define FLD 772
#define LLD 392
__device__ void prep_phase(const Params& p, int layer, char* smem, int bid, int nblk, int tidx, int rep) {
  const int pv_ = rep ? PREPVAR : 0;
  float* F = reinterpret_cast<float*>(smem);
  u16* LIb = reinterpret_cast<u16*>(smem + 16 * FLD * 4);
  const float* cw = p.in[12] + (size_t)layer * 3 * 1152;
  const u16* LW = p.loraT + (size_t)layer * 98304;
  for (int it = bid; it < NTOK / 16; it += nblk) {
    int tid = tidx;
    asm volatile("" : "+v"(tid));
    const int lane = tid & 63, wid = tid >> 6, fr = lane & 15, fq = lane >> 4;
    const int tok0 = it * 16;
    int b, tpos0, L;
    const bool isctx = tok0 < NCTX;
    if (isctx) { b = tok0 >> 8; tpos0 = tok0 & 255; L = 256; }
    else { const int tl = tok0 - NCTX; b = tl >> 10; tpos0 = tl & 1023; L = 1024; }
#pragma unroll 1
    for (int cg = tid; cg < 288; cg += 256) {
      const int c = cg * 4;
      const float4 w0 = *reinterpret_cast<const float4*>(cw + c);
      const float4 w1 = *reinterpret_cast<const float4*>(cw + 1152 + c);
      const float4 w2 = *reinterpret_cast<const float4*>(cw + 2304 + c);
      const float* pr = p.PROJ + (size_t)tok0 * DIN + c;
      float4 x[18];
#pragma unroll
      for (int i = 0; i < 18; ++i) {
        const int tpos = tpos0 + i - 1;
        x[i] = (tpos >= 0 && tpos < L) ? *reinterpret_cast<const float4*>(pr + (ptrdiff_t)(i - 1) * DIN) : make_float4(0.f, 0.f, 0.f, 0.f);
      }
#pragma unroll
      for (int tt = 0; tt < 16; ++tt) {
        float4 f;
        f.x = w0.x * x[tt].x + w1.x * x[tt + 1].x + w2.x * x[tt + 2].x;
        f.y = w0.y * x[tt].y + w1.y * x[tt + 1].y + w2.y * x[tt + 2].y;
        f.z = w0.z * x[tt].z + w1.z * x[tt + 1].z + w2.z * x[tt + 2].z;
        f.w = w0.w * x[tt].w + w1.w * x[tt + 1].w + w2.w * x[tt + 2].w;
        if (c < 768) { *reinterpret_cast<float4*>(F + tt * FLD + c) = f; }
        else {
          const int cc = c - 768;
          if (cc < 128) { f.x = tanhf(f.x); f.y = tanhf(f.y); f.z = tanhf(f.z); f.w = tanhf(f.w); }
          else if (cc >= 256) { f.x = sigmoidf_(f.x); f.y = sigmoidf_(f.y); f.z = sigmoidf_(f.z); f.w = sigmoidf_(f.w); }
          uint2 pk; pk.x = pack2(f.x, f.y); pk.y = pack2(f.z, f.w);
          *reinterpret_cast<uint2*>(LIb + tt * LLD + cc) = pk;
        }
      }
    }
    __syncthreads();
    f32x4 acc[5][4];
#pragma unroll
    for (int g = 0; g < 5; ++g)
#pragma unroll
      for (int nf = 0; nf < 4; ++nf) acc[g][nf] = (f32x4){0.f, 0.f, 0.f, 0.f};
    if (pv_ != 2 && pv_ != 3) {
#pragma unroll
    for (int g = 0; g < 4; ++g) {
      const u16* wt = LW + (size_t)g * 16384;
#pragma unroll
      for (int ks = 0; ks < 2; ++ks) {
        const bf16x8 xb = *reinterpret_cast<const bf16x8*>(LIb + fr * LLD + g * 64 + ks * 32 + fq * 8);
#pragma unroll
        for (int nf = 0; nf < 4; ++nf) {
          const bf16x8 wa = *reinterpret_cast<const bf16x8*>(wt + (size_t)(64 * wid + 16 * nf + fr) * 64 + ks * 32 + fq * 8);
          acc[g][nf] = __builtin_amdgcn_mfma_f32_16x16x32_bf16(wa, xb, acc[g][nf], 0, 0, 0);
        }
      }
      __builtin_amdgcn_sched_barrier(0);
    }
    {
      const u16* wt = LW + 65536;
#pragma unroll
      for (int ks = 0; ks < 4; ++ks) {
        const bf16x8 xb = *reinterpret_cast<const bf16x8*>(LIb + fr * LLD + 256 + ks * 32 + fq * 8);
#pragma unroll
        for (int nf = 0; nf < 4; ++nf) {
          const bf16x8 wa = *reinterpret_cast<const bf16x8*>(wt + (size_t)(64 * wid + 16 * nf + fr) * 128 + ks * 32 + fq * 8);
          acc[4][nf] = __builtin_amdgcn_mfma_f32_16x16x32_bf16(wa, xb, acc[4][nf], 0, 0, 0);
        }
        if (ks == 1) __builtin_amdgcn_sched_barrier(0);
      }
      __builtin_amdgcn_sched_barrier(0);
    }
    }
    if (pv_ != 2 && pv_ != 3) {
#ifndef NO_C
    {
      const int tok = tok0 + fr;
      float ss = 0.f, bs = 0.f;
#pragma unroll
      for (int nf = 0; nf < 4; ++nf) {
        const int c0 = 64 * wid + 16 * nf + 4 * fq;
        const float4 r4 = *reinterpret_cast<const float4*>(F + fr * FLD + c0);
        const float4 k4 = *reinterpret_cast<const float4*>(F + fr * FLD + 256 + c0);
        const float4 w00 = *reinterpret_cast<const float4*>(p.in[13] + (size_t)layer * 512 + c0);
        const float4 w01 = *reinterpret_cast<const float4*>(p.in[13] + (size_t)layer * 512 + 256 + c0);
        const float4 a00 = *reinterpret_cast<const float4*>(p.in[15] + (size_t)layer * 512 + c0);
        const float4 a01 = *reinterpret_cast<const float4*>(p.in[15] + (size_t)layer * 512 + 256 + c0);
        const float4 kkw = *reinterpret_cast<const float4*>(p.in[18] + (size_t)layer * 256 + c0);
        const float4 kaw = *reinterpret_cast<const float4*>(p.in[19] + (size_t)layer * 256 + c0);
        const float4 rkw = *reinterpret_cast<const float4*>(p.in[20] + (size_t)layer * 256 + c0);
        const float rr[4] = {r4.x, r4.y, r4.z, r4.w}, kk_[4] = {k4.x, k4.y, k4.z, k4.w};
        const float w0a[4] = {w00.x, w00.y, w00.z, w00.w}, w0b[4] = {w01.x, w01.y, w01.z, w01.w};
        const float a0a[4] = {a00.x, a00.y, a00.z, a00.w}, a0b[4] = {a01.x, a01.y, a01.z, a01.w};
        const float kkw_[4] = {kkw.x, kkw.y, kkw.z, kkw.w}, kaw_[4] = {kaw.x, kaw.y, kaw.z, kaw.w}, rkw_[4] = {rkw.x, rkw.y, rkw.z, rkw.w};
#pragma unroll
        for (int r = 0; r < 4; ++r) {
          {
            const float z = -(w0a[r] + acc[0][nf][r]);
            const float sp = fmaxf(z, 0.f) + log1pf(__expf(-fabsf(z)));
            acc[0][nf][r] = __expf(-__expf(-sp - 0.5f));
          }
          {
            const float z = -(w0b[r] + acc[1][nf][r]);
            const float sp = fmaxf(z, 0.f) + log1pf(__expf(-fabsf(z)));
            acc[1][nf][r] = __expf(-__expf(-sp - 0.5f));
          }
          const float av0 = sigmoidf_(a0a[r] + acc[2][nf][r]);
          const float av1 = sigmoidf_(a0b[r] + acc[3][nf][r]);
          acc[2][nf][r] = av0; acc[3][nf][r] = av1;
          const float k = kk_[r];
          const float kq = k * kkw_[r];
          ss += kq * kq;
          const float kd0 = k * (1.f + (av0 - 1.f) * kaw_[r]);
          const float kd1 = k * (1.f + (av1 - 1.f) * kaw_[r]);
          bs += rr[r] * (kd0 + kd1) * rkw_[r];
        }
        __builtin_amdgcn_sched_barrier(0);
      }
      ss += __shfl_xor(ss, 16); ss += __shfl_xor(ss, 32);
      bs += __shfl_xor(bs, 16); bs += __shfl_xor(bs, 32);
      const float inrm = 1.f / fmaxf(sqrtf(ss), 1e-12f);
#pragma unroll
      for (int nf = 0; nf < 4; ++nf) {
        const int c0 = 64 * wid + 16 * nf + 4 * fq, n0 = 16 * nf + 4 * fq;
        const float4 r4 = *reinterpret_cast<const float4*>(F + fr * FLD + c0);
        const float4 k4 = *reinterpret_cast<const float4*>(F + fr * FLD + 256 + c0);
        const float4 v4 = *reinterpret_cast<const float4*>(F + fr * FLD + 512 + c0);
        const float4 kkw = *reinterpret_cast<const float4*>(p.in[18] + (size_t)layer * 256 + c0);
        const float4 kaw = *reinterpret_cast<const float4*>(p.in[19] + (size_t)layer * 256 + c0);
        const float kk_[4] = {k4.x, k4.y, k4.z, k4.w}, kkw_[4] = {kkw.x, kkw.y, kkw.z, kkw.w}, kaw_[4] = {kaw.x, kaw.y, kaw.z, kaw.w};
        float* sc = p.SC + ((size_t)(tok * 4 + wid) * 9) * 64 + n0;
        float kn[4], kd0[4], kd1[4];
#pragma unroll
        for (int r = 0; r < 4; ++r) {
          kn[r] = kk_[r] * kkw_[r] * inrm;
          kd0[r] = kk_[r] * (1.f + (acc[2][nf][r] - 1.f) * kaw_[r]);
          kd1[r] = kk_[r] * (1.f + (acc[3][nf][r] - 1.f) * kaw_[r]);
        }
        *reinterpret_cast<float4*>(sc) = r4;
        *reinterpret_cast<float4*>(sc + 64) = make_float4(kn[0], kn[1], kn[2], kn[3]);
        *reinterpret_cast<float4*>(sc + 128) = v4;
        *reinterpret_cast<float4*>(sc + 192) = make_float4(acc[0][nf][0], acc[0][nf][1], acc[0][nf][2], acc[0][nf][3]);
        *reinterpret_cast<float4*>(sc + 256) = make_float4(acc[2][nf][0] * kn[0], acc[2][nf][1] * kn[1], acc[2][nf][2] * kn[2], acc[2][nf][3] * kn[3]);
        *reinterpret_cast<float4*>(sc + 320) = make_float4(kd0[0], kd0[1], kd0[2], kd0[3]);
        *reinterpret_cast<float4*>(sc + 384) = make_float4(acc[1][nf][0], acc[1][nf][1], acc[1][nf][2], acc[1][nf][3]);
        *reinterpret_cast<float4*>(sc + 448) = make_float4(acc[3][nf][0] * kn[0], acc[3][nf][1] * kn[1], acc[3][nf][2] * kn[2], acc[3][nf][3] * kn[3]);
        *reinterpret_cast<float4*>(sc + 512) = make_float4(kd1[0], kd1[1], kd1[2], kd1[3]);
        *reinterpret_cast<float4*>(p.G + (size_t)tok * 256 + c0) = make_float4(acc[4][nf][0], acc[4][nf][1], acc[4][nf][2], acc[4][nf][3]);
        *reinterpret_cast<float4*>(p.BV + (size_t)tok * 256 + c0) = make_float4(bs * v4.x, bs * v4.y, bs * v4.z, bs * v4.w);
        __builtin_amdgcn_sched_barrier(0);
      }
    }
#endif
    }
    if (pv_ != 1) {
#ifndef NO_D
    {
      const int tok = tid >> 4, g8 = tid & 15, tokg = tok0 + tok, tpos = tpos0 + tok;
      const int tkey = isctx ? tpos : 512 + tpos;
      const float* pr = p.PROJ + (size_t)tokg * DIN;
#pragma unroll
      for (int hh = 0; hh < 2; ++hh) {
        const int g = g8 + 16 * hh, c0 = g * 8, hd = c0 >> 6, d0 = c0 & 63;
        const float4 qa = *reinterpret_cast<const float4*>(pr + 1152 + c0), qb = *reinterpret_cast<const float4*>(pr + 1152 + c0 + 4);
        const float4 ka = *reinterpret_cast<const float4*>(pr + 1408 + c0), kb2 = *reinterpret_cast<const float4*>(pr + 1408 + c0 + 4);
        const float qv[8] = {qa.x * QSCALE, qa.y * QSCALE, qa.z * QSCALE, qa.w * QSCALE, qb.x * QSCALE, qb.y * QSCALE, qb.z * QSCALE, qb.w * QSCALE};
        const float kv[8] = {ka.x, ka.y, ka.z, ka.w, kb2.x, kb2.y, kb2.z, kb2.w};
        if (isctx) {
          float* ok = p.out_nak + ((size_t)(b * 4 + layer) * 256 + tpos) * 256 + c0;
          *reinterpret_cast<float4*>(ok) = ka; *reinterpret_cast<float4*>(ok + 4) = kb2;
          pack8_store(p.QNc + (size_t)tokg * 256 + c0, qv);
          pack8_store(p.KNc + (size_t)(b * 4 + hd) * 16384 + kf_off(tkey, d0), kv);
        } else {
          pack8_store(p.QNl + (size_t)(tokg - NCTX) * 256 + c0, qv);
          pack8_store(p.KNl + ((size_t)((layer * 2 + b) * 4 + hd)) * 98304 + kf_off(tkey, d0), kv);
        }
      }
#pragma unroll
      for (int hh = 0; hh < 5; ++hh) {
        const bool isk = (hh == 4);
        const int g = isk ? g8 : g8 + 16 * hh, d0 = (g & 7) * 8, hd = g >> 3;
        const float* src = pr + (isk ? 2432 : 1920) + g * 8;
        const float4 xa = *reinterpret_cast<const float4*>(src), xb = *reinterpret_cast<const float4*>(src + 4);
        const float* nw = (isk ? p.in[25] : p.in[24]) + (size_t)layer * 64 + d0;
        const float4 na = *reinterpret_cast<const float4*>(nw), nb = *reinterpret_cast<const float4*>(nw + 4);
        float x[8] = {xa.x, xa.y, xa.z, xa.w, xb.x, xb.y, xb.z, xb.w};
        const float nrm[8] = {na.x, na.y, na.z, na.w, nb.x, nb.y, nb.z, nb.w};
        float ss = 0.f;
#pragma unroll
        for (int e = 0; e < 8; ++e) ss += x[e] * x[e];
        ss += dpp_mov<0xB1>(ss); ss += dpp_mov<0x4E>(ss); ss += dpp_mov<0x141>(ss);
        const float rs = rsqrtf(ss * (1.f / 64.f) + 1e-6f);
#pragma unroll
        for (int e = 0; e < 8; ++e) x[e] = x[e] * rs * nrm[e];
        if (isk && isctx) {
          float* ok = p.out_gk + ((size_t)(b * 4 + layer) * 256 + tpos) * 128 + g * 8;
          *reinterpret_cast<float4*>(ok) = make_float4(x[0], x[1], x[2], x[3]);
          *reinterpret_cast<float4*>(ok + 4) = make_float4(x[4], x[5], x[6], x[7]);
        }
        if (!isctx) {
          const int pos = (d0 < 32) ? (tpos >> 6) : (tpos & 63);
          const float4* rt = reinterpret_cast<const float4*>(p.rope + (size_t)(pos * 16 + (d0 & 15)) * 2);
          const float4 r0 = rt[0], r1 = rt[1], r2 = rt[2], r3 = rt[3];
          const float cs[8] = {r0.x, r0.z, r1.x, r1.z, r2.x, r2.z, r3.x, r3.z};
          const float sn[8] = {r0.y, r0.w, r1.y, r1.w, r2.y, r2.w, r3.y, r3.w};
          const float sg = (d0 & 16) ? 1.f : -1.f;
#pragma unroll
          for (int e = 0; e < 8; ++e) { const float pe = dpp_mov<0x4E>(x[e]); x[e] = x[e] * cs[e] + sg * pe * sn[e]; }
        }
        if (!isk) {
#pragma unroll
          for (int e = 0; e < 8; ++e) x[e] *= QSCALE;
          if (isctx) pack8_store(p.QGc + (size_t)tokg * 512 + g * 8, x);
          else pack8_store(p.QGl + (size_t)(tokg - NCTX) * 512 + g * 8, x);
        } else {
          if (isctx) pack8_store(p.KGc + (size_t)(b * 2 + hd) * 16384 + kf_off(tkey, d0), x);
          else pack8_store(p.KGl + ((size_t)((layer * 2 + b) * 2 + hd)) * 98304 + kf_off(tkey, d0), x);
        }
      }
    }
    const int c = tid;
#pragma unroll
    for (int half = 0; half < 2; ++half) {
      float vv[8];
#pragma unroll
      for (int t8 = 0; t8 < 8; ++t8) {
        const int tt = half * 8 + t8, tokn = tok0 + tt;
        const float v = p.PROJ[(size_t)tokn * DIN + 1664 + c];
        vv[t8] = v;
        if (isctx) p.out_nav[((size_t)(b * 4 + layer) * 256 + tpos0 + tt) * 256 + c] = v;
      }
      if (isctx) pack44_store(p.VNtc + (size_t)(b * 4 + (c >> 6)) * 16384, tpos0 + half * 8, c & 63, vv);
      else pack44_store(p.VNtl + ((size_t)((layer * 2 + b) * 4 + (c >> 6))) * 98304, 512 + tpos0 + half * 8, c & 63, vv);
    }
    if (wid >= 2) {
      const int cv = c - 128;
#pragma unroll
      for (int half = 0; half < 2; ++half) {
        float vv[8];
#pragma unroll
        for (int t8 = 0; t8 < 8; ++t8) {
          const int tt = half * 8 + t8, tokn = tok0 + tt;
          const float v = p.PROJ[(size_t)tokn * DIN + 2560 + cv];
          vv[t8] = v;
          if (isctx) p.out_gv[((size_t)(b * 4 + layer) * 256 + tpos0 + tt) * 128 + cv] = v;
        }
        if (isctx) pack44_store(p.VGtc + (size_t)(b * 2 + (cv >> 6)) * 16384, tpos0 + half * 8, cv & 63, vv);
        else pack44_store(p.VGtl + ((size_t)((layer * 2 + b) * 2 + (cv >> 6))) * 98304, 512 + tpos0 + half * 8, cv & 63, vv);
      }
    }
#endif
    }
    __syncthreads();
  }
}

#define ATT_LOAD(KF, VF, CI) { \
    const int ci_ = min((CI), nt - 1); \
    int kb_; \
    if (ci_ < nd) kb_ = ci_ * 32; \
    else { const int e_ = ci_ - nd; const int j_ = (ncc == 2) ? (e_ >> 1) : e_; const int cc_ = cc0 + ((ncc == 2) ? (e_ & 1) : 0); kb_ = 512 + (rb + j_) * 64 + cc_ * 32; } \
    const u16* kp_ = Kb + (size_t)(kb_ >> 4) * 1024 + lane * 8; \
    KF##00 = *reinterpret_cast<const bf16x8*>(kp_); \
    KF##01 = *reinterpret_cast<const bf16x8*>(kp_ + 512); \
    KF##10 = *reinterpret_cast<const bf16x8*>(kp_ + 1024); \
    KF##11 = *reinterpret_cast<const bf16x8*>(kp_ + 1536); \
    const u16* vp_ = Vt + (size_t)(kb_ >> 5) * 2048 + lane * 8; \
    VF##0 = *reinterpret_cast<const bf16x8*>(vp_); \
    VF##1 = *reinterpret_cast<const bf16x8*>(vp_ + 512); \
    VF##2 = *reinterpret_cast<const bf16x8*>(vp_ + 1024); \
    VF##3 = *reinterpret_cast<const bf16x8*>(vp_ + 1536); }

#define ATT_PV(DT, VV) { \
    o[DT][0] *= alpha; o[DT][1] *= alpha; o[DT][2] *= alpha; o[DT][3] *= alpha; \
    o[DT] = __builtin_amdgcn_mfma_f32_16x16x32_bf16(VV, pf.v, o[DT], 0, 0, 0); }

#define ATT_COMPUTE(KF, VF, CI) { \
    const int ci_ = (CI); \
    f32x4 s0 = (f32x4){0.f, 0.f, 0.f, 0.f}, s1 = (f32x4){0.f, 0.f, 0.f, 0.f}; \
    s0 = __builtin_amdgcn_mfma_f32_16x16x32_bf16(KF##00, qf0, s0, 0, 0, 0); \
    s0 = __builtin_amdgcn_mfma_f32_16x16x32_bf16(KF##01, qf1, s0, 0, 0, 0); \
    s1 = __builtin_amdgcn_mfma_f32_16x16x32_bf16(KF##10, qf0, s1, 0, 0, 0); \
    s1 = __builtin_amdgcn_mfma_f32_16x16x32_bf16(KF##11, qf1, s1, 0, 0, 0); \
    float sv[8] = {s0[0], s0[1], s0[2], s0[3], s1[0], s1[1], s1[2], s1[3]}; \
    bool ok[8]; \
    _Pragma("unroll") for (int e = 0; e < 8; ++e) ok[e] = true; \
    if (ci_ >= nd) { \
      const int e_ = ci_ - nd; const int j_ = (ncc == 2) ? (e_ >> 1) : e_; const int cc_ = cc0 + ((ncc == 2) ? (e_ & 1) : 0); \
      const int dr_ = rb + j_ - grow + 7; \
      const int cq = cq0 + fr, c0 = min(max(cq - 8, 0), 48); \
      _Pragma("unroll") for (int e = 0; e < 8; ++e) { \
        const int ck = cc_ * 32 + 16 * (e >> 2) + 4 * fq + (e & 3); \
        ok[e] = (ck >= c0) && (ck < c0 + 16); \
        const int dc = min(max(ck - cq, -15), 15) + 15; \
        const float bias = rpb[dr_ * 31 + dc] * LOG2E; \
        sv[e] = ok[e] ? sv[e] + bias : -1e30f; \
      } \
    } \
    float mx = fmaxf(fmaxf(fmaxf(sv[0], sv[1]), fmaxf(sv[2], sv[3])), fmaxf(fmaxf(sv[4], sv[5]), fmaxf(sv[6], sv[7]))); \
    mx = fmaxf(mx, __shfl_xor(mx, 16)); \
    mx = fmaxf(mx, __shfl_xor(mx, 32)); \
    const float mn = fmaxf(m, mx); \
    const float alpha = exp2f(m - mn); \
    m = mn; \
    float ps = 0.f; \
    _Pragma("unroll") for (int e = 0; e < 8; ++e) { sv[e] = ok[e] ? exp2f(sv[e] - mn) : 0.f; ps += sv[e]; } \
    l = l * alpha + ps; \
    union { bf16x8 v; unsigned u[4]; } pf; \
    pf.u[0] = pack2(sv[0], sv[1]); pf.u[1] = pack2(sv[2], sv[3]); pf.u[2] = pack2(sv[4], sv[5]); pf.u[3] = pack2(sv[6], sv[7]); \
    ATT_PV(0, VF##0) ATT_PV(1, VF##1) ATT_PV(2, VF##2) ATT_PV(3, VF##3) }

__device__ __forceinline__ void attn_wave(const u16* __restrict__ Q, int ldq, const u16* __restrict__ Kb, int ldk,
                                          const u16* __restrict__ Vt, int ldv, int ndense, const bool NA,
                                          const float* __restrict__ rpb, int grow, int cq0,
                                          u16* __restrict__ out, int ldo, int tidx) {
  const int lane = tidx & 63, fr = lane & 15, fq = lane >> 4;
  const bf16x8 qf0 = *reinterpret_cast<const bf16x8*>(Q + (size_t)fr * ldq + fq * 8);
  const bf16x8 qf1 = *reinterpret_cast<const bf16x8*>(Q + (size_t)fr * ldq + 32 + fq * 8);
  f32x4 o[4];
#pragma unroll
  for (int dt = 0; dt < 4; ++dt) o[dt] = (f32x4){0.f, 0.f, 0.f, 0.f};
  float m = -1e30f, l = 0.f;
  const int nd = ndense >> 5;
  const int rb = min(max(grow - 4, 0), 8);
  const int ulo = min(max(cq0 - 8, 0), 48), uhi = min(max(cq0 + 15 - 8, 0), 48) + 16;
  const bool c0ok = ulo < 32, c1ok = uhi > 32;
  const int ncc = (c0ok && c1ok) ? 2 : 1, cc0 = c0ok ? 0 : 1;
  const int nt = nd + (NA ? 8 * ncc : 0);
  bf16x8 ka00, ka01, ka10, ka11, kb00, kb01, kb10, kb11;
  bf16x8 va0, va1, va2, va3, vb0, vb1, vb2, vb3;
  ATT_LOAD(ka, va, 0)
  for (int ci = 0; ci < nt; ci += 2) {
    ATT_LOAD(kb, vb, ci + 1)
    ATT_COMPUTE(ka, va, ci)
    if (ci + 1 < nt) {
      ATT_LOAD(ka, va, ci + 2)
      ATT_COMPUTE(kb, vb, ci + 1)
    }
  }
  l += __shfl_xor(l, 16);
  l += __shfl_xor(l, 32);
  const float il = 1.f / l;
#pragma unroll
  for (int dt = 0; dt < 4; ++dt) {
    uint2 pk; pk.x = pack2(o[dt][0] * il, o[dt][1] * il); pk.y = pack2(o[dt][2] * il, o[dt][3] * il);
    *reinterpret_cast<uint2*>(out + (size_t)fr * ldo + 16 * dt + 4 * fq) = pk;
  }
}

__device__ void scan_item(const Params& p, int layer, char* smem, bool lat, int b, int h, int dir, int qd, int tidx) {
  const int tid = tidx, lane = tid & 63, wid = tid >> 6, rr = lane >> 4, j = lane & 15;
  const int L = lat ? 1024 : 256, seqbase = lat ? NCTX + b * 1024 : b * 256;
  const int rowl = wid * 4 + rr, row = qd * 16 + rowl;
  float* cbuf = reinterpret_cast<float*>(smem);
  float* obuf = cbuf + 2 * 16 * 6 * 64;
  float4 S = make_float4(0.f, 0.f, 0.f, 0.f);
  if (lat) S = *reinterpret_cast<const float4*>(p.in[2] + ((((size_t)(b * 4 + layer) * 2 + dir) * 4 + h) * 64 + row) * 64 + 4 * j);
  v2f S01 = (v2f){S.x, S.y}, S23 = (v2f){S.z, S.w};
  const int nch = L / 16;
  float* odst = dir == 0 ? p.OF : p.OB;
  float4 pre0, pre1, pre2, pre3, pre4, pre5;
#define SC_GL1(PR, I, CH) { const int idx = tid + 256 * (I), tt_ = idx / 96, rem = idx % 96, vec = rem >> 4, f4 = rem & 15; \
    const int st_ = (CH) * 16 + tt_, t_ = dir == 0 ? st_ : L - 1 - st_; const int svec = vec < 3 ? vec : vec + 3 * dir; \
    PR = *reinterpret_cast<const float4*>(p.SC + ((size_t)((seqbase + t_) * 4 + h) * 9 + svec) * 64 + f4 * 4); }
#define gload(CH) { SC_GL1(pre0, 0, CH) SC_GL1(pre1, 1, CH) SC_GL1(pre2, 2, CH) SC_GL1(pre3, 3, CH) SC_GL1(pre4, 4, CH) SC_GL1(pre5, 5, CH) }
#define SC_LS1(PR, I, BUF) *reinterpret_cast<float4*>(cbuf + (BUF) * 6144 + (tid + 256 * (I)) * 4) = PR;
#define lstore(BUF) { SC_LS1(pre0, 0, BUF) SC_LS1(pre1, 1, BUF) SC_LS1(pre2, 2, BUF) SC_LS1(pre3, 3, BUF) SC_LS1(pre4, 4, BUF) SC_LS1(pre5, 5, BUF) }
  gload(0); lstore(0);
  __syncthreads();
#define SC_LD(R4, K4, VV, W4, A4, D4, TT) { const float* base_ = cb + (TT) * 384; \
    R4 = *reinterpret_cast<const float4*>(base_ + 4 * j); K4 = *reinterpret_cast<const float4*>(base_ + 64 + 4 * j); \
    VV = base_[128 + row]; W4 = *reinterpret_cast<const float4*>(base_ + 192 + 4 * j); \
    A4 = *reinterpret_cast<const float4*>(base_ + 256 + 4 * j); D4 = *reinterpret_cast<const float4*>(base_ + 320 + 4 * j); }
#if SCANVAR
  for (int pass_ = 0; pass_ < (lat ? 2 : 1); ++pass_) {
  int var_ = pass_ ? SCANVAR : 0;
  asm volatile("" : "+v"(var_)); var_ = __builtin_amdgcn_readfirstlane(var_);
#else
  const int var_ = 0;
#endif
  for (int ch = 0; ch < nch; ++ch) {
    if (ch + 1 < nch && var_ != 3) gload(ch + 1);
    const float* cb = cbuf + (ch & 1) * 6144;
    float osel = 0.f;
    float4 r4, kk4, w4, ak4, kd4; float vv;
    SC_LD(r4, kk4, vv, w4, ak4, kd4, 0)
    float ovp = 0.f;
    if (var_ != 2)
#pragma unroll 8
    for (int tt = 0; tt < 16; ++tt) {
      float4 r4n, kk4n, w4n, ak4n, kd4n; float vvn;
      SC_LD(r4n, kk4n, vvn, w4n, ak4n, kd4n, tt + 1)
      v2f p = S01 * (v2f){kk4.x, kk4.y};
      p = S23 * (v2f){kk4.z, kk4.w} + p;
      float sk = p.x + p.y;
      sk += dpp_mov<0xB1>(sk);  ovp += dpp_mov<0xB1>(ovp);
      sk += dpp_mov<0x4E>(sk);  ovp += dpp_mov<0x4E>(ovp);
      sk += dpp_mov<0x141>(sk); ovp += dpp_mov<0x141>(ovp);
      sk += dpp_mov<0x140>(sk); ovp += dpp_mov<0x140>(ovp);
      osel = (j == tt - 1) ? ovp : osel;
      const v2f vv2 = (v2f){vv, vv}, sk2 = (v2f){sk, sk};
      v2f t01 = (v2f){kd4.x, kd4.y} * vv2; t01 = t01 - (v2f){ak4.x, ak4.y} * sk2;
      v2f t23 = (v2f){kd4.z, kd4.w} * vv2; t23 = t23 - (v2f){ak4.z, ak4.w} * sk2;
      S01 = S01 * (v2f){w4.x, w4.y} + t01;
      S23 = S23 * (v2f){w4.z, w4.w} + t23;
      v2f q = S01 * (v2f){r4.x, r4.y};
      q = S23 * (v2f){r4.z, r4.w} + q;
      ovp = q.x + q.y;
      r4 = r4n; kk4 = kk4n; w4 = w4n; ak4 = ak4n; kd4 = kd4n; vv = vvn;
    }
    ovp = reduce16(ovp);
    osel = (j == 15) ? ovp : osel;
    if (var_ == 0) {
      const int st = ch * 16 + j, t = dir == 0 ? st : L - 1 - st;
      odst[(size_t)(seqbase + t) * 256 + h * 64 + row] = osel;
    } else asm volatile("" :: "v"(osel), "v"(S01), "v"(S23));
    if (ch + 1 < nch && var_ != 3) lstore((ch + 1) & 1);
    asm volatile("s_waitcnt lgkmcnt(0)" ::: "memory");
    __builtin_amdgcn_s_barrier();
  }
#if SCANVAR
  }
#endif
  if (!lat) *reinterpret_cast<float4*>(p.out_st + ((((size_t)(b * 4 + layer) * 2 + dir) * 4 + h) * 64 + row) * 64 + 4 * j) = make_float4(S01.x, S01.y, S23.x, S23.y);
  __syncthreads();
}

__device__ void mixer_phase(const Params& p, int layer_wq, char* smem, int tidx0) {
  const int layer = layer_wq & 3;
  int* slot = reinterpret_cast<int*>(smem + 60 * 1024);
  bool first = true;
  for (;;) {
    int tidx = tidx0;
    asm volatile("" : "+v"(tidx));
    const int tid = tidx, wid = tid >> 6;
    __syncthreads();
    if (tid == 0) *slot = first ? (int)blockIdx.x : (int)(gridDim.x + atomicAdd(&p.wq[layer_wq], 1u));
    first = false;
    __syncthreads();
    int it = *slot;
    if (it >= 1728) break;
    const bool is_scan = (it < 64) || (it >= 448 && it < 960);
#if REPMASK
    if ((p.pad == 1 && !is_scan) || (p.pad == 2 && is_scan) || ((p.pad == 3 || p.pad == 5 || p.pad == 6) && !(it < 64)) || (p.pad == 4 && !(it >= 64 && it < 320))) continue;
#endif
    if (is_scan) {
      const bool lat = it < 64;
      const int si = lat ? it : it - 448;
#ifndef NO_SCAN
      scan_item(p, layer, smem, lat, si / 32, (si / 8) % 4, (si / 4) % 2, si % 4, tidx);
#endif
      continue;
    }
    const u16 *Q, *Kb, *Vt; u16* out; int ldq, ldk, ldv, ndense, grow = 0, cq0 = 0; bool na = false;
    const float* rpb = p.in[23];
    if (it < 320) {
      it -= 64;
      const int b = it / 128, qh = (it / 16) % 8, qt = it % 16, kvh = qh >> 2;
      const int q0 = b * 1024 + qt * 64 + wid * 16;
      Q = p.QGl + (size_t)q0 * 512 + qh * 64; ldq = 512;
      Kb = p.KGl + (size_t)((layer * 2 + b) * 2 + kvh) * 98304; ldk = 0;
      Vt = p.VGtl + (size_t)((layer * 2 + b) * 2 + kvh) * 98304; ldv = 0; ndense = 1536;
      out = p.MIX + (size_t)(NCTX + q0) * DM + 512 + qh * 64;
    } else if (it < 448) {
      it -= 320;
      const int b = it / 64, h = (it / 16) % 4, r = it % 16;
      const int q0 = b * 1024 + r * 64 + wid * 16;
      Q = p.QNl + (size_t)q0 * 256 + h * 64; ldq = 256;
      Kb = p.KNl + (size_t)((layer * 2 + b) * 4 + h) * 98304; ldk = 0;
      Vt = p.VNtl + (size_t)((layer * 2 + b) * 4 + h) * 98304; ldv = 0; ndense = 512;
      rpb = p.in[23] + (size_t)(layer * 4 + h) * 15 * 31; grow = r; cq0 = wid * 16; na = true;
      out = p.MIX + (size_t)(NCTX + q0) * DM + 256 + h * 64;
    } else if (it < 1472) {
      it -= 960;
      const int b = it / 32, qh = (it / 4) % 8, qt = it % 4, kvh = qh >> 2;
      const int q0 = b * 256 + qt * 64 + wid * 16;
      Q = p.QGc + (size_t)q0 * 512 + qh * 64; ldq = 512;
      Kb = p.KGc + (size_t)(b * 2 + kvh) * 16384; ldk = 0;
      Vt = p.VGtc + (size_t)(b * 2 + kvh) * 16384; ldv = 0; ndense = 256;
      out = p.MIX + (size_t)q0 * DM + 512 + qh * 64;
    } else {
      it -= 1472;
      const int b = it / 16, h = (it / 4) % 4, qt = it % 4;
      const int q0 = b * 256 + qt * 64 + wid * 16;
      Q = p.QNc + (size_t)q0 * 256 + h * 64; ldq = 256;
      Kb = p.KNc + (size_t)(b * 4 + h) * 16384; ldk = 0;
      Vt = p.VNtc + (size_t)(b * 4 + h) * 16384; ldv = 0; ndense = 256;
      out = p.MIX + (size_t)q0 * DM + 256 + h * 64;
    }
#ifndef NO_ATT
    attn_wave(Q, ldq, Kb, ldk, Vt, ldv, ndense, na, rpb, grow, cq0, out, DM, tidx);
#endif
  }
}

__device__ void rwkv_fin_phase(const Params& p, int layer, int bid, int nblk, int tidx) {
  const int tid = tidx;
  const float lw = p.in[21][(size_t)layer * 256 + tid], lb = p.in[22][(size_t)layer * 256 + tid];
  for (int t4 = bid; t4 < NTOK / 4; t4 += nblk) {
    float of[4], ob[4], bv[4], gg[4];
#pragma unroll
    for (int u = 0; u < 4; ++u) {
      const size_t i = (size_t)(t4 * 4 + u) * 256 + tid;
      of[u] = p.OF[i]; ob[u] = p.OB[i]; bv[u] = p.BV[i]; gg[u] = p.G[i];
    }
#pragma unroll
    for (int u = 0; u < 4; ++u) {
      const float o = of[u] + ob[u];
      const float mu = wave_sum(o) * (1.f / 64.f);
      const float d = o - mu;
      const float var = wave_sum(d * d) * (1.f / 64.f);
      const float y = (d * rsqrtf(var + 64e-5f) * lw + lb + bv[u]) * gg[u];
      p.MIX[(size_t)(t4 * 4 + u) * DM + tid] = f2bf(y);
    }
  }
}

#ifndef ONLY_PH
#define ONLY_PH -1
#endif
#define PH_EN(x) (ONLY_PH < 0 || ONLY_PH == (x))
__device__ __forceinline__ void run_phase(const Params& p, int ph, char* smem, int bid, int nblk, int tidx, int rep = 0) {
  if (ph == 0) { if (PH_EN(0)) setup_phase(p, smem, bid, nblk, tidx); return; }
  if (ph == 1) { if (PH_EN(1)) modreduce_phase(p, bid, nblk, tidx); return; }
  if (ph == 2) { if (PH_EN(2)) ln_phase<0>(p, 0, bid, nblk, tidx); return; }
  const int layer = (ph - 3) / 9, s = (ph - 3) % 9;
  switch (s) {
    case 0: if (PH_EN(3)) gemm_phase<EPI_PROJ, 256, 3>(p, layer, p.A, p.winT + (size_t)layer * DIN * DM, DIN, DM, smem, bid, nblk, tidx); break;
    case 1: if (PH_EN(4)) prep_phase(p, layer, smem, bid, nblk, tidx, rep); break;
    case 2: if (PH_EN(5)) mixer_phase(p, layer + 4 * rep, smem, tidx); break;
    case 3: if (PH_EN(6)) rwkv_fin_phase(p, layer, bid, nblk, tidx); break;
    case 4: if (PH_EN(7)) gemm_phase<EPI_OUT, 192, 3>(p, layer, p.MIX, p.woutT + (size_t)layer * DM * DM, DM, DM, smem, bid, nblk, tidx); break;
    case 5: if (PH_EN(8)) ln_phase<1>(p, layer, bid, nblk, tidx); break;
    case 6: if (PH_EN(9)) gemm_phase<EPI_FFI, 192, 3>(p, layer, p.A, p.wfiT + (size_t)layer * 2 * DFF * DM, 2 * DFF, DM, smem, bid, nblk, tidx); break;
    case 7: if (PH_EN(10)) gemm_phase<EPI_FFO, 192, 3>(p, layer, p.ACT, p.wfoT + (size_t)layer * DM * DFF, DM, DFF, smem, bid, nblk, tidx); break;
    default: if (PH_EN(11)) ln_phase<2>(p, layer, bid, nblk, tidx); break;
  }
}

__global__ void __launch_bounds__(256, 2) fwd_kernel(Params p, int ph0, int ph1, int usebar) {
  __shared__ __attribute__((aligned(16))) char smem[73728 + 16];
  const int bid = blockIdx.x, nblk = gridDim.x;
  XcdBarrier xb;
  if (usebar && p.never) cg::this_grid().sync();
  if (usebar) {
    if (threadIdx.x == 0) *reinterpret_cast<uint4*>(smem + 73728) = make_uint4(0u, 0u, 0u, 0u);
    __syncthreads();
    xb = xcd_barrier_post(p.bar, (volatile LAS unsigned*)(smem + 73728));
  }
  int ph = ph0, rep = 0;
  while (ph < ph1) {
    int tidx = threadIdx.x;
    asm volatile("" : "+v"(tidx));
    run_phase(p, ph, smem, bid, nblk, tidx, rep);
#if REPSLOT >= 0
    if (((ph < 3 ? 9 + ph : (ph - 3) % 9) == REPSLOT) && rep == 0) rep = 1; else { rep = 0; ++ph; }
#else
    ++ph;
#endif
    if (usebar && ph < ph1) xcd_barrier(xb);
  }
}

static inline size_t al256(size_t x) { return (x + 255) & ~(size_t)255; }

extern "C" void kernel_launch(void* const* d_in, const int* in_sizes, int n_in, void* d_out, int out_size, void* d_ws, size_t ws_size,
                              hipStream_t stream) {
  Params p;
  memset(&p, 0, sizeof(p));
  for (int i = 0; i < 33; ++i) p.in[i] = (const float*)d_in[i];
  float* o = (float*)d_out;
  p.out_yp = o; o += 4194304;
  p.out_ys = o; o += 2097152;
  p.out_st = o; o += 2097152;
  p.out_nak = o; o += 4194304;
  p.out_nav = o; o += 4194304;
  p.out_gk = o; o += 2097152;
  p.out_gv = o;
  char* w = (char*)d_ws; size_t off = 0;
  auto take = [&](size_t bytes) { char* r = w + off; off += al256(bytes); return r; };
  p.bar = (unsigned*)take(16384);
  p.wq = p.bar + 3584;
  p.modp = (float*)take((size_t)4 * 32 * 3 * 6144 * 4);
  p.mod = (float*)take((size_t)4 * 3 * 6144 * 4);
  p.winT = (u16*)take((size_t)4 * DIN * DM * 2);
  p.woutT = (u16*)take((size_t)4 * DM * DM * 2);
  p.wfiT = (u16*)take((size_t)4 * 2 * DFF * DM * 2);
  p.wfoT = (u16*)take((size_t)4 * DM * DFF * 2);
  p.X = (float*)take((size_t)NTOK * DM * 4);
  p.PROJ = (float*)take((size_t)NTOK * DIN * 4);
  p.X1 = p.PROJ;
  p.Y = p.PROJ + (size_t)NTOK * DM;
  p.SC = (float*)take((size_t)NTOK * 4 * 9 * 64 * 4);
  p.ACT = (u16*)p.SC;
  p.G = (float*)take((size_t)NTOK * 256 * 4);
  p.BV = (float*)take((size_t)NTOK * 256 * 4);
  p.OF = (float*)take((size_t)NTOK * 256 * 4);
  p.OB = (float*)take((size_t)NTOK * 256 * 4);
  p.A = (u16*)take((size_t)NTOK * DM * 2);
  p.MIX = (u16*)take((size_t)NTOK * DM * 2);
  p.QNc = (u16*)take((size_t)NCTX * 256 * 2);
  p.KNc = (u16*)take((size_t)NCTX * 256 * 2);
  p.VNtc = (u16*)take((size_t)NCTX * 256 * 2);
  p.QGc = (u16*)take((size_t)NCTX * 512 * 2);
  p.KGc = (u16*)take((size_t)NCTX * 128 * 2);
  p.VGtc = (u16*)take((size_t)NCTX * 128 * 2);
  p.QNl = (u16*)take((size_t)2048 * 256 * 2);
  p.KNl = (u16*)take((size_t)4 * 2 * 1536 * 256 * 2);
  p.VNtl = (u16*)take((size_t)4 * 2 * 1536 * 256 * 2);
  p.QGl = (u16*)take((size_t)2048 * 512 * 2);
  p.KGl = (u16*)take((size_t)4 * 2 * 1536 * 128 * 2);
  p.VGtl = (u16*)take((size_t)4 * 2 * 1536 * 128 * 2);
  p.loraT = (u16*)take((size_t)4 * 98304 * 2);
  p.rope = (float*)take((size_t)64 * 16 * 2 * 4);
  if (off > ws_size) { fprintf(stderr, "workspace too small: need %zu have %zu\n", off, ws_size); return; }

  (void)hipMemsetAsync(p.bar, 0, 16384, stream);
#if MEGA
  static int grid_blocks = 0;
  if (!grid_blocks) {
    int dev = 0, cus = 0, per_cu = 0;
    hipGetDevice(&dev);
    hipDeviceGetAttribute(&cus, hipDeviceAttributeMultiprocessorCount, dev);
    hipOccupancyMaxActiveBlocksPerMultiprocessor(&per_cu, fwd_kernel, 256, 0);
    if (per_cu > 2) per_cu = 2;
    if (per_cu < 1) per_cu = 1;
    grid_blocks = cus * per_cu;
  }
  int ph0 = 0, ph1 = NPH, ub = 1;
  void* args[] = {&p, &ph0, &ph1, &ub};
  hipError_t e = hipLaunchCooperativeKernel((void*)fwd_kernel, dim3(grid_blocks), dim3(256), args, 0, stream);
  if (e != hipSuccess) fprintf(stderr, "cooperative launch failed: %s (grid %d)\n", hipGetErrorString(e), grid_blocks);
#else
  for (int ph = 0; ph < NPH; ++ph) fwd_kernel<<<512, 256, 0, stream>>>(p, ph, ph + 1, 0);
#endif
}
```

```cpp
#include <hip/hip_runtime.h>
#include <hip/hip_cooperative_groups.h>
#include <cstdio>
#include <cstdint>
#include <cstring>
namespace cg = cooperative_groups;

#ifndef REPMASK
#define REPMASK 0
#endif
#ifndef REPSLOT
#define REPSLOT -1
#endif
#ifndef PREPVAR
#define PREPVAR 0
#endif
#ifndef SCANVAR
#define SCANVAR 0
#endif
#ifndef REPVAR
#define REPVAR 0
#endif
#ifndef MEGA
#define MEGA 1
#endif

typedef unsigned short u16;
using bf16x8 = __attribute__((ext_vector_type(8))) short;
using f32x4 = __attribute__((ext_vector_type(4))) float;
using v2f = __attribute__((ext_vector_type(2))) float;

#define NTOK 6144
#define NCTX 4096
#define DM 1024
#define DIN 2688
#define DFF 2816
#define NPH 39
#define ALPHA 1.681792830507429f
#define LOG2E 1.4426950408889634f
#define QSCALE (0.125f * LOG2E)

struct Params {
  const float* in[33];
  float *out_yp, *out_ys, *out_st, *out_nak, *out_nav, *out_gk, *out_gv;
  unsigned *bar, *wq;
  float *modp, *mod;
  u16 *winT, *woutT, *wfiT, *wfoT;
  float *X, *X1, *Y, *PROJ, *SC, *G, *BV, *OF, *OB;
  u16 *A, *MIX, *ACT;
  u16 *QNc, *KNc, *VNtc, *QGc, *KGc, *VGtc;
  u16 *QNl, *KNl, *VNtl, *QGl, *KGl, *VGtl;
  u16* loraT; float* rope;
  int never; int pad;
};

__device__ __forceinline__ u16 f2bf(float f) {
  unsigned u = __float_as_uint(f);
  u += 0x7FFFu + ((u >> 16) & 1u);
  return (u16)(u >> 16);
}
__device__ __forceinline__ unsigned pack2(float a, float b) { return (unsigned)f2bf(a) | ((unsigned)f2bf(b) << 16); }
template <int CTRL> __device__ __forceinline__ float dpp_mov(float v) {
  return __int_as_float(__builtin_amdgcn_update_dpp(0, __float_as_int(v), CTRL, 0xF, 0xF, false));
}
__device__ __forceinline__ float reduce16(float v) {
  v += dpp_mov<0xB1>(v);
  v += dpp_mov<0x4E>(v);
  v += dpp_mov<0x141>(v);
  v += dpp_mov<0x140>(v);
  return v;
}
__device__ __forceinline__ float wave_sum(float v) {
  v = reduce16(v);
  v += __shfl_xor(v, 16);
  v += __shfl_xor(v, 32);
  return v;
}
__device__ __forceinline__ float sigmoidf_(float x) { return 1.f / (1.f + __expf(-x)); }
__device__ __forceinline__ float siluf_(float x) { return x / (1.f + __expf(-x)); }
__device__ __forceinline__ int modrow_of(int tok) { return tok < NCTX ? 0 : 1 + ((tok - NCTX) >> 10); }

#define XB_TMO      128
#define XB_XCNT(j)  (256  + 64 * (j))
#define XB_XSUB(j)  (1280 + 64 * (j))
#define XB_XGEN(j)  (2304 + 64 * (j))
#define XB_TOP      3328
#define XB_TOPGEN   3392
#define XCD_BAR_WORDS 3456
#define XB_SPIN_CAP (1u << 22)
#define LAS __attribute__((address_space(3)))
__device__ __forceinline__ unsigned xb_ld(unsigned* p) { return __hip_atomic_load(p, __ATOMIC_RELAXED, __HIP_MEMORY_SCOPE_AGENT); }
__device__ __forceinline__ unsigned xb_add(unsigned* p, unsigned v) { return __hip_atomic_fetch_add(p, v, __ATOMIC_RELAXED, __HIP_MEMORY_SCOPE_AGENT); }
__device__ __forceinline__ unsigned xb_xcc_id() { return (unsigned)__builtin_amdgcn_s_getreg((3 << 11) | 20) & 0xFu; }
#define XB_SPIN(cond, bar) do { unsigned _sp = 0; while (cond) { __builtin_amdgcn_s_sleep(1); \
    if ((++_sp & 255u) == 0u) { if (xb_ld(&(bar)[XB_TMO])) break; if (_sp > XB_SPIN_CAP) { atomicAdd(&(bar)[XB_TMO], 1u); break; } } } } while (0)
struct XcdBarrier { unsigned* bar; unsigned x; volatile LAS unsigned* st; };
__device__ __forceinline__ XcdBarrier xcd_barrier_post(unsigned* bar, volatile LAS unsigned* st) {
  XcdBarrier b; b.bar = bar; b.x = xb_xcc_id(); b.st = st;
  if (threadIdx.x == 0) (void)xb_add(&bar[XB_XCNT(b.x)], 1u);
  return b;
}
__device__ __forceinline__ void xcd_barrier_complete(unsigned* bar, unsigned x, unsigned& nloc, unsigned& nx) {
  const unsigned G = gridDim.x * gridDim.y * gridDim.z;
  unsigned sum, cnt, mine, sp = 0u;
  for (;;) {
    sum = 0u; cnt = 0u; mine = 0u;
#pragma unroll
    for (unsigned j = 0; j < 16; ++j) { const unsigned c = xb_ld(&bar[XB_XCNT(j)]); sum += c; cnt += (c > 0u) ? 1u : 0u; mine = (j == x) ? c : mine; }
    if (sum == G) break;
    __builtin_amdgcn_s_sleep(1);
    if ((++sp & 255u) == 0u) { if (xb_ld(&bar[XB_TMO])) break; if (sp > XB_SPIN_CAP) { atomicAdd(&bar[XB_TMO], 1u); break; } }
  }
  nloc = mine > 0u ? mine : 1u; nx = cnt > 0u ? cnt : 1u;
}
__device__ __forceinline__ void xcd_barrier(const XcdBarrier& b) {
  asm volatile("s_waitcnt vmcnt(0)" ::: "memory");
  __syncthreads();
  if (threadIdx.x == 0) {
    unsigned* bar = b.bar;
    asm volatile("" : "+s"(bar));
    __builtin_amdgcn_s_waitcnt(0);
    unsigned nloc = b.st[0], nx = b.st[1];
    if (nloc == 0u) { xcd_barrier_complete(bar, b.x, nloc, nx); b.st[0] = nloc; b.st[1] = nx; }
    const unsigned old = xb_add(&bar[XB_XSUB(b.x)], 1u);
    const unsigned gen = old / nloc;
    if (old + 1u == (gen + 1u) * nloc) {
      __builtin_amdgcn_fence(__ATOMIC_RELEASE, "agent");
      asm volatile("s_waitcnt vmcnt(0)" ::: "memory");
      const unsigned og = xb_add(&bar[XB_TOP], 1u);
      const unsigned tg = og / nx;
      if (og + 1u == (tg + 1u) * nx) xb_add(&bar[XB_TOPGEN], 1u);
      else XB_SPIN(xb_ld(&bar[XB_TOPGEN]) == tg, bar);
      __builtin_amdgcn_fence(__ATOMIC_ACQUIRE, "agent");
      xb_add(&bar[XB_XGEN(b.x)], 1u);
      asm volatile("s_waitcnt vmcnt(0)" ::: "memory");
    } else {
      XB_SPIN(xb_ld(&bar[XB_XGEN(b.x)]) == gen, bar);
      __builtin_amdgcn_fence(__ATOMIC_ACQUIRE, "agent");
      asm volatile("s_waitcnt vmcnt(0)" ::: "memory");
    }
  }
  __syncthreads();
}

__device__ __forceinline__ int lds_byte32(int r, int c) {
  const int ob = (r & 15) * 64 + c * 2;
  return (r >> 4) * 1024 + (ob ^ (((ob >> 9) & 1) << 5));
}
__device__ __forceinline__ void stage_rc32(int b, int& R, int& C) {
  const int sb = b & 1023, swz = sb ^ (((sb >> 9) & 1) << 5);
  R = (b >> 10) * 16 + (swz >> 6); C = (swz & 63) >> 1;
}
template <int ROWS>
__device__ __forceinline__ void stage_tile32(const u16* __restrict__ g, int ld, char* lds, int tidx) {
#pragma unroll
  for (int i = 0; i < (ROWS * 64 + 4095) / 4096; ++i) {
    const int b = tidx * 16 + i * 4096;
    if ((i + 1) * 4096 <= ROWS * 64 || tidx < (ROWS * 64 - i * 4096) / 16) {
      int R, C; stage_rc32(b, R, C);
      __builtin_amdgcn_global_load_lds((const unsigned*)(g + (size_t)R * ld + C), (unsigned LAS*)(lds + b), 16, 0, 0);
    }
  }
}
template <int N> __device__ __forceinline__ void wait_vmcnt() {
  if (N == 0) asm volatile("s_waitcnt vmcnt(0)" ::: "memory");
  else if (N == 3) asm volatile("s_waitcnt vmcnt(3)" ::: "memory");
  else if (N == 4) asm volatile("s_waitcnt vmcnt(4)" ::: "memory");
  else if (N == 5) asm volatile("s_waitcnt vmcnt(5)" ::: "memory");
  else if (N == 6) asm volatile("s_waitcnt vmcnt(6)" ::: "memory");
  else if (N == 8) asm volatile("s_waitcnt vmcnt(8)" ::: "memory");
  else if (N == 9) asm volatile("s_waitcnt vmcnt(9)" ::: "memory");
  else if (N == 10) asm volatile("s_waitcnt vmcnt(10)" ::: "memory");
  else if (N == 12) asm volatile("s_waitcnt vmcnt(12)" ::: "memory");
  else asm volatile("s_waitcnt vmcnt(0)" ::: "memory");
}

enum { EPI_PROJ = 0, EPI_OUT = 1, EPI_FFI = 2, EPI_FFO = 3 };

template <int EPI, int BM, int NST>
__device__ __forceinline__ void gemm_phase(const Params& p, int layer, const u16* __restrict__ A, const u16* __restrict__ Bt,
                                           int N, int K, char* smem, int bid, int nblk, int tidx) {
  constexpr int MF = BM / 32;
  const int tid = tidx, lane = tid & 63, wid = tid >> 6, wr = wid >> 1, wc = wid & 1, fr = lane & 15, fq = lane >> 4;
  const int nM = NTOK / BM, nN = N / 128, ntiles = nM * nN, nk = K / 32;
  constexpr int SB = (BM + 128) * 64;
  constexpr int LA = (BM * 64) / 4096;
  const bool extraA = (BM == 96) && (wid < 2);
  for (int tile = bid; tile < ntiles; tile += nblk) {
    const int pm = tile % nM, pn = tile / nM, m0 = pm * BM, n0 = pn * 128;
    f32x4 acc[MF][4];
#pragma unroll
    for (int m = 0; m < MF; ++m)
#pragma unroll
      for (int n = 0; n < 4; ++n) acc[m][n] = (f32x4){0.f, 0.f, 0.f, 0.f};
    const u16* Ag = A + (size_t)m0 * K;
    const u16* Bg = Bt + (size_t)n0 * K;
#pragma unroll
    for (int s_ = 0; s_ < NST - 1; ++s_) {
      stage_tile32<BM>(Ag + s_ * 32, K, smem + s_ * SB, tidx);
      stage_tile32<128>(Bg + s_ * 32, K, smem + s_ * SB + BM * 64, tidx);
    }
    int slot = 0, pslot = NST - 1;
    for (int kt = 0; kt < nk; ++kt) {
      if (kt + NST - 2 < nk) {
        if (BM == 96) { if (extraA) wait_vmcnt<(NST - 2) * 4>(); else wait_vmcnt<(NST - 2) * 3>(); }
        else wait_vmcnt<(NST - 2) * (LA + 2)>();
      } else {
        asm volatile("s_waitcnt vmcnt(0)" ::: "memory");
      }
      __builtin_amdgcn_s_barrier();
      if (kt + NST - 1 < nk) {
        char* nb = smem + pslot * SB;
        stage_tile32<BM>(Ag + (kt + NST - 1) * 32, K, nb, tidx);
        stage_tile32<128>(Bg + (kt + NST - 1) * 32, K, nb + BM * 64, tidx);
      }
      const char* sa = smem + slot * SB;
      const char* sb = sa + BM * 64;
      slot = (slot + 1 == NST) ? 0 : slot + 1;
      pslot = (pslot + 1 == NST) ? 0 : pslot + 1;
      bf16x8 af[MF], bfr[4];
#pragma unroll
      for (int m = 0; m < MF; ++m) af[m] = *reinterpret_cast<const bf16x8*>(sa + lds_byte32(wr * (BM / 2) + m * 16 + fr, fq * 8));
#pragma unroll
      for (int n = 0; n < 4; ++n) bfr[n] = *reinterpret_cast<const bf16x8*>(sb + lds_byte32(wc * 64 + n * 16 + fr, fq * 8));
#pragma unroll
      for (int m = 0; m < MF; ++m)
#pragma unroll
        for (int n = 0; n < 4; ++n) acc[m][n] = __builtin_amdgcn_mfma_f32_16x16x32_bf16(bfr[n], af[m], acc[m][n], 0, 0, 0);
    }
#pragma unroll
    for (int m = 0; m < MF; ++m) {
      const int row = m0 + wr * (BM / 2) + m * 16 + fr;
      if (EPI == EPI_PROJ) {
#pragma unroll
        for (int n = 0; n < 4; ++n) {
          const int col = n0 + wc * 64 + n * 16 + 4 * fq;
          *reinterpret_cast<float4*>(p.PROJ + (size_t)row * DIN + col) = make_float4(acc[m][n][0], acc[m][n][1], acc[m][n][2], acc[m][n][3]);
        }
      } else if (EPI == EPI_OUT || EPI == EPI_FFO) {
        const float* res = (EPI == EPI_OUT) ? p.X : p.X1;
        const float* gate = p.mod + ((size_t)(layer * 3 + modrow_of(row)) * 6 + (EPI == EPI_OUT ? 2 : 5)) * 1024;
#pragma unroll
        for (int n = 0; n < 4; ++n) {
          const int col = n0 + wc * 64 + n * 16 + 4 * fq;
          const float4 xr = *reinterpret_cast<const float4*>(res + (size_t)row * DM + col);
          const float4 gt = *reinterpret_cast<const float4*>(gate + col);
          float4 y;
          y.x = ALPHA * xr.x + gt.x * acc[m][n][0];
          y.y = ALPHA * xr.y + gt.y * acc[m][n][1];
          y.z = ALPHA * xr.z + gt.z * acc[m][n][2];
          y.w = ALPHA * xr.w + gt.w * acc[m][n][3];
          *reinterpret_cast<float4*>(p.Y + (size_t)row * DM + col) = y;
        }
      } else {
#pragma unroll
        for (int n2 = 0; n2 < 2; ++n2) {
          const int j0 = ((n0 + wc * 64) / 32 + n2) * 16 + 4 * fq;
          float a[4];
#pragma unroll
          for (int r = 0; r < 4; ++r) a[r] = siluf_(acc[m][2 * n2][r]) * acc[m][2 * n2 + 1][r];
          uint2 pk; pk.x = pack2(a[0], a[1]); pk.y = pack2(a[2], a[3]);
          *reinterpret_cast<uint2*>(p.ACT + (size_t)row * DFF + j0) = pk;
        }
      }
    }
    asm volatile("s_waitcnt lgkmcnt(0)" ::: "memory");
    __builtin_amdgcn_s_barrier();
  }
}

__device__ __forceinline__ int kf_off(int t, int d) { return (t >> 4) * 1024 + (d >> 5) * 512 + ((d & 31) >> 3) * 128 + (t & 15) * 8 + (d & 7); }
__device__ __forceinline__ int vf_off(int t, int d) { return (t >> 5) * 2048 + (d >> 4) * 512 + (((t & 15) >> 2) * 16 + (d & 15)) * 8 + ((t >> 4) & 1) * 4 + (t & 3); }
__device__ __forceinline__ void pack44_store(u16* base, int t0, int d, const float* v) {
  uint2 a, b; a.x = pack2(v[0], v[1]); a.y = pack2(v[2], v[3]); b.x = pack2(v[4], v[5]); b.y = pack2(v[6], v[7]);
  *reinterpret_cast<uint2*>(base + vf_off(t0, d)) = a;
  *reinterpret_cast<uint2*>(base + vf_off(t0 + 4, d)) = b;
}
__device__ __forceinline__ void pack8_store(u16* dst, const float* v) {
  uint4 pk; pk.x = pack2(v[0], v[1]); pk.y = pack2(v[2], v[3]); pk.z = pack2(v[4], v[5]); pk.w = pack2(v[6], v[7]);
  *reinterpret_cast<uint4*>(dst) = pk;
}

__device__ void setup_phase(const Params& p, char* smem, int bid, int nblk, int tidx) {
  const int tid = tidx;
  const int NI = 768 + 512 + 13;
  for (int it = bid; it < NI; it += nblk) {
    if (it < 768) {
      const int l = it / 192, nc = (it / 32) % 6, kc = it % 32;
      const int col = nc * 1024 + tid * 4;
      const float* wm = p.in[9] + (size_t)l * 1024 * 6144;
      float4 a0 = make_float4(0, 0, 0, 0), a1 = a0, a2 = a0;
      for (int k8 = 0; k8 < 32; k8 += 8) {
        float4 w[8];
#pragma unroll
        for (int u = 0; u < 8; ++u) w[u] = *reinterpret_cast<const float4*>(wm + (size_t)(kc * 32 + k8 + u) * 6144 + col);
#pragma unroll
        for (int u = 0; u < 8; ++u) {
          const int k = kc * 32 + k8 + u;
          const float s0 = siluf_(p.in[8][k]), s1 = siluf_(p.in[7][k]), s2 = siluf_(p.in[7][1024 + k]);
          a0.x += s0 * w[u].x; a0.y += s0 * w[u].y; a0.z += s0 * w[u].z; a0.w += s0 * w[u].w;
          a1.x += s1 * w[u].x; a1.y += s1 * w[u].y; a1.z += s1 * w[u].z; a1.w += s1 * w[u].w;
          a2.x += s2 * w[u].x; a2.y += s2 * w[u].y; a2.z += s2 * w[u].z; a2.w += s2 * w[u].w;
        }
      }
      float* dst = p.modp + (size_t)((l * 32 + kc) * 3) * 6144 + col;
      *reinterpret_cast<float4*>(dst) = a0;
      *reinterpret_cast<float4*>(dst + 6144) = a1;
      *reinterpret_cast<float4*>(dst + 2 * 6144) = a2;
    } else if (it < 1280) {
      const int ci = it - 768, b = ci / 256, l = (ci / 64) % 4, tg = ci % 64, t0 = tg * 8;
      {
        const float* ck = p.in[3] + ((size_t)(b * 4 + l) * 512 + t0) * 256 + tid;
        const float* cv = p.in[4] + ((size_t)(b * 4 + l) * 512 + t0) * 256 + tid;
        float v[8];
#pragma unroll
        for (int tt = 0; tt < 8; ++tt) {
          p.KNl[((size_t)((l * 2 + b) * 4 + (tid >> 6))) * 98304 + kf_off(t0 + tt, tid & 63)] = f2bf(ck[tt * 256]);
          v[tt] = cv[tt * 256];
        }
        pack44_store(p.VNtl + ((size_t)((l * 2 + b) * 4 + (tid >> 6))) * 98304, t0, tid & 63, v);
      }
      if (tid < 128) {
        const float* ck = p.in[5] + ((size_t)(b * 4 + l) * 512 + t0) * 128 + tid;
#pragma unroll
        for (int tt = 0; tt < 8; ++tt) p.KGl[((size_t)((l * 2 + b) * 2 + (tid >> 6))) * 98304 + kf_off(t0 + tt, tid & 63)] = f2bf(ck[tt * 128]);
      } else {
        const int c = tid - 128;
        const float* cv = p.in[6] + ((size_t)(b * 4 + l) * 512 + t0) * 128 + c;
        float v[8];
#pragma unroll
        for (int tt = 0; tt < 8; ++tt) v[tt] = cv[tt * 128];
        pack44_store(p.VGtl + ((size_t)((l * 2 + b) * 2 + (c >> 6))) * 98304, t0, c & 63, v);
      }
    } else {
      const int li = it - (768 + 512);
      if (li == 12) {
        for (int idx = tid; idx < 1024; idx += 256) {
          const int pos = idx >> 4, fi = idx & 15;
          const float ang = (float)pos * exp2f(-(float)fi * (13.287712379549449f / 16.f));
          p.rope[idx * 2] = cosf(ang); p.rope[idx * 2 + 1] = sinf(ang);
        }
      } else {
        const int l = li / 3, m = li % 3;
        u16* dst = p.loraT + (size_t)l * 98304 + m * 32768;
        if (m < 2) {
          const float* src = p.in[m == 0 ? 14 : 16] + (size_t)l * 32768;
          for (int i0 = tid; i0 < 32768; i0 += 256 * 16) {
            float v[16];
#pragma unroll
            for (int u = 0; u < 16; ++u) { const int idx = i0 + 256 * u; const int d = idx >> 14, cch = (idx >> 6) & 255, r = idx & 63; v[u] = src[(d * 64 + r) * 256 + cch]; }
#pragma unroll
            for (int u = 0; u < 16; ++u) dst[i0 + 256 * u] = f2bf(v[u]);
          }
        } else {
          const float* src = p.in[17] + (size_t)l * 32768;
          for (int i0 = tid; i0 < 32768; i0 += 256 * 16) {
            float v[16];
#pragma unroll
            for (int u = 0; u < 16; ++u) { const int idx = i0 + 256 * u; const int cch = idx >> 7, j = idx & 127; v[u] = src[j * 256 + cch]; }
#pragma unroll
            for (int u = 0; u < 16; ++u) dst[i0 + 256 * u] = f2bf(v[u]);
          }
        }
      }
    }
  }
  {
    float* tile = reinterpret_cast<float*>(smem);
    const int NT = 4 * 3040;
    float4 cur0, cur1, cur2, cur3;
    const float* src; u16* dst; int K, N, mat, k0, n0;
#define TR_DECODE(TR) { const int l_ = (TR) / 3040; int r_ = (TR) % 3040; int kt_, nt_; \
      if (r_ < 672) { mat = 0; K = 1024; N = 2688; src = p.in[11] + (size_t)l_ * K * N; dst = p.winT + (size_t)l_ * N * K; kt_ = r_ / 42; nt_ = r_ % 42; } \
      else if (r_ < 928) { r_ -= 672; mat = 1; K = 1024; N = 1024; src = p.in[26] + (size_t)l_ * K * N; dst = p.woutT + (size_t)l_ * N * K; kt_ = r_ / 16; nt_ = r_ % 16; } \
      else if (r_ < 2336) { r_ -= 928; mat = 2; K = 1024; N = 5632; src = p.in[29] + (size_t)l_ * K * N; dst = p.wfiT + (size_t)l_ * N * K; kt_ = r_ / 88; nt_ = r_ % 88; } \
      else { r_ -= 2336; mat = 3; K = 2816; N = 1024; src = p.in[30] + (size_t)l_ * K * N; dst = p.wfoT + (size_t)l_ * N * K; kt_ = r_ / 16; nt_ = r_ % 16; } \
      k0 = kt_ * 64; n0 = nt_ * 64; }
#define TR_LOAD(V, I) V = *reinterpret_cast<const float4*>(src + (size_t)(k0 + (tid >> 4) + 16 * (I)) * N + n0 + (tid & 15) * 4);
#define TR_PUT(V, I) { const int kr_ = (tid >> 4) + 16 * (I), c4_ = (tid & 15) * 4; \
      tile[kr_ * 65 + c4_ + 0] = V.x; tile[kr_ * 65 + c4_ + 1] = V.y; tile[kr_ * 65 + c4_ + 2] = V.z; tile[kr_ * 65 + c4_ + 3] = V.w; }
    int tr = bid;
    if (tr < NT) { TR_DECODE(tr) TR_LOAD(cur0, 0) TR_LOAD(cur1, 1) TR_LOAD(cur2, 2) TR_LOAD(cur3, 3) }
    for (; tr < NT; tr += nblk) {
      TR_PUT(cur0, 0) TR_PUT(cur1, 1) TR_PUT(cur2, 2) TR_PUT(cur3, 3)
      if (tr + nblk < NT) { TR_DECODE(tr + nblk) TR_LOAD(cur0, 0) TR_LOAD(cur1, 1) TR_LOAD(cur2, 2) TR_LOAD(cur3, 3) }
      TR_DECODE(tr)
      __syncthreads();
#pragma unroll
      for (int i = 0; i < 2; ++i) {
        const int idx = tid + 256 * i, nl = idx >> 3, kc = idx & 7;
        int n = n0 + nl;
        if (mat == 2) { const int isup = n >= DFF ? 1 : 0; const int j = n - isup * DFF; n = (j >> 4) * 32 + isup * 16 + (j & 15); }
        float v[8];
#pragma unroll
        for (int jj = 0; jj < 8; ++jj) v[jj] = tile[(kc * 8 + jj) * 65 + nl];
        pack8_store(dst + (size_t)n * K + k0 + kc * 8, v);
      }
      __syncthreads();
    }
#undef TR_DECODE
#undef TR_LOAD
#undef TR_PUT
  }
}

__device__ void modreduce_phase(const Params& p, int bid, int nblk, int tidx) {
  for (int idx = bid * 256 + tidx; idx < 18432; idx += nblk * 256) {
    const int l = idx / 4608, rem = idx % 4608, mr = rem / 1536, c4 = (rem % 1536) * 4;
    float4 a = *reinterpret_cast<const float4*>(p.in[10] + (size_t)l * 6144 + c4);
    for (int k8 = 0; k8 < 32; k8 += 8) {
      float4 v[8];
#pragma unroll
      for (int u = 0; u < 8; ++u) v[u] = *reinterpret_cast<const float4*>(p.modp + (size_t)((l * 32 + k8 + u) * 3 + mr) * 6144 + c4);
#pragma unroll
      for (int u = 0; u < 8; ++u) { a.x += v[u].x; a.y += v[u].y; a.z += v[u].z; a.w += v[u].w; }
    }
    *reinterpret_cast<float4*>(p.mod + (size_t)(l * 3 + mr) * 6144 + c4) = a;
  }
}

template <int MODE>
__device__ void ln_phase(const Params& p, int layer, int bid, int nblk, int tidx) {
  const int lane = tidx & 63, wid = tidx >> 6;
  const bool fin = (MODE == 2 && layer == 3);
  const float* lw = (MODE == 1 ? p.in[27] : p.in[31]) + (size_t)layer * DM;
  const float* lb = (MODE == 1 ? p.in[28] : p.in[32]) + (size_t)layer * DM;
  const int ml = (MODE == 2) ? (layer + 1 < 4 ? layer + 1 : 3) : layer;
  const int which = (MODE == 1) ? 3 : 0;
#define LN_SRC(ROW) (MODE == 0 ? ((ROW) < NCTX ? p.in[0] + (size_t)(ROW) * DM : p.in[1] + (size_t)((ROW) - NCTX) * DM) : p.Y + (size_t)(ROW) * DM)
  float4 nv0, nv1, nv2, nv3;
  int it = bid;
  if (it < NTOK / 4) {
    const float4* s4 = reinterpret_cast<const float4*>(LN_SRC(it * 4 + wid));
    nv0 = s4[lane]; nv1 = s4[lane + 64]; nv2 = s4[lane + 128]; nv3 = s4[lane + 192];
  }
  for (; it < NTOK / 4; it += nblk) {
    const int row = it * 4 + wid;
    float4 v[4] = {nv0, nv1, nv2, nv3};
    if (it + nblk < NTOK / 4) {
      const float4* s4 = reinterpret_cast<const float4*>(LN_SRC((it + nblk) * 4 + wid));
      nv0 = s4[lane]; nv1 = s4[lane + 64]; nv2 = s4[lane + 128]; nv3 = s4[lane + 192];
    }
    float4 w4[4], b4[4], s4v[4], c4v[4];
    const float* sh = p.mod + ((size_t)(ml * 3 + modrow_of(row)) * 6 + which) * 1024;
    const float* sc = sh + 1024;
#pragma unroll
    for (int i = 0; i < 4; ++i) {
      if (MODE != 0) { w4[i] = reinterpret_cast<const float4*>(lw)[lane + 64 * i]; b4[i] = reinterpret_cast<const float4*>(lb)[lane + 64 * i]; }
      if (!fin) { s4v[i] = reinterpret_cast<const float4*>(sh)[lane + 64 * i]; c4v[i] = reinterpret_cast<const float4*>(sc)[lane + 64 * i]; }
    }
    if (MODE != 0) {
      float s = 0.f;
#pragma unroll
      for (int i = 0; i < 4; ++i) s += v[i].x + v[i].y + v[i].z + v[i].w;
      const float mu = wave_sum(s) * (1.f / 1024.f);
      float q = 0.f;
#pragma unroll
      for (int i = 0; i < 4; ++i) {
        v[i].x -= mu; v[i].y -= mu; v[i].z -= mu; v[i].w -= mu;
        q += v[i].x * v[i].x + v[i].y * v[i].y + v[i].z * v[i].z + v[i].w * v[i].w;
      }
      const float rstd = rsqrtf(wave_sum(q) * (1.f / 1024.f) + 1e-5f);
#pragma unroll
      for (int i = 0; i < 4; ++i) {
        v[i].x = v[i].x * rstd * w4[i].x + b4[i].x; v[i].y = v[i].y * rstd * w4[i].y + b4[i].y;
        v[i].z = v[i].z * rstd * w4[i].z + b4[i].z; v[i].w = v[i].w * rstd * w4[i].w + b4[i].w;
      }
    }
    float* xdst = (MODE == 1 ? p.X1 : p.X) + (size_t)row * DM;
#pragma unroll
    for (int i = 0; i < 4; ++i) reinterpret_cast<float4*>(xdst)[lane + 64 * i] = v[i];
    if (fin) {
      float* o = row < NCTX ? p.out_yp + (size_t)row * DM : p.out_ys + (size_t)(row - NCTX) * DM;
#pragma unroll
      for (int i = 0; i < 4; ++i) reinterpret_cast<float4*>(o)[lane + 64 * i] = v[i];
    } else {
      u16* adst = p.A + (size_t)row * DM;
#pragma unroll
      for (int i = 0; i < 4; ++i) {
        uint2 pk;
        pk.x = pack2(v[i].x * (1.f + c4v[i].x) + s4v[i].x, v[i].y * (1.f + c4v[i].y) + s4v[i].y);
        pk.y = pack2(v[i].z * (1.f + c4v[i].z) + s4v[i].z, v[i].w * (1.f + c4v[i].w) + s4v[i].w);
        reinterpret_cast<uint2*>(adst)[lane + 64 * i] = pk;
      }
    }
  }
#undef LN_SRC
}

#define FLD 772
#define LLD 392
__device__ void prep_phase(const Params& p, int layer, char* smem, int bid, int nblk, int tidx, int rep) {
  const int pv_ = rep ? PREPVAR : 0;
  float* F = reinterpret_cast<float*>(smem);
  u16* LIb = reinterpret_cast<u16*>(smem + 16 * FLD * 4);
  const float* cw = p.in[12] + (size_t)layer * 3 * 1152;
  const u16* LW = p.loraT + (size_t)layer * 98304;
  for (int it2 = bid; it2 < 2 * (NTOK / 16); it2 += nblk) {
    const bool doR = it2 < NTOK / 16;
    const int it = doR ? it2 : it2 - NTOK / 16;
    int tid = tidx;
    asm volatile("" : "+v"(tid));
    const int lane = tid & 63, wid = tid >> 6, fr = lane & 15, fq = lane >> 4;
    const int tok0 = it * 16;
    int b, tpos0, L;
    const bool isctx = tok0 < NCTX;
    if (isctx) { b = tok0 >> 8; tpos0 = tok0 & 255; L = 256; }
    else { const int tl = tok0 - NCTX; b = tl >> 10; tpos0 = tl & 1023; L = 1024; }
    if (doR) {
    {
      float* PRM = reinterpret_cast<float*>(smem + 61952);
      PRM[tid] = p.in[13][(size_t)layer * 512 + tid]; PRM[256 + tid] = p.in[13][(size_t)layer * 512 + 256 + tid];
      PRM[512 + tid] = p.in[15][(size_t)layer * 512 + tid]; PRM[768 + tid] = p.in[15][(size_t)layer * 512 + 256 + tid];
      PRM[1024 + tid] = p.in[18][(size_t)layer * 256 + tid]; PRM[1280 + tid] = p.in[19][(size_t)layer * 256 + tid]; PRM[1536 + tid] = p.in[20][(size_t)layer * 256 + tid];
    }
#pragma unroll 1
    for (int cg = tid; cg < 288; cg += 256) {
      const int c = cg * 4;
      const float4 w0 = *reinterpret_cast<const float4*>(cw + c);
      const float4 w1 = *reinterpret_cast<const float4*>(cw + 1152 + c);
      const float4 w2 = *reinterpret_cast<const float4*>(cw + 2304 + c);
      const float* pr = p.PROJ + (size_t)tok0 * DIN + c;
      float4 x[18];
#pragma unroll
      for (int i = 0; i < 18; ++i) {
        const int tpos = tpos0 + i - 1;
        x[i] = (tpos >= 0 && tpos < L) ? *reinterpret_cast<const float4*>(pr + (ptrdiff_t)(i - 1) * DIN) : make_float4(0.f, 0.f, 0.f, 0.f);
      }
#pragma unroll
      for (int tt = 0; tt < 16; ++tt) {
        float4 f;
        f.x = w0.x * x[tt].x + w1.x * x[tt + 1].x + w2.x * x[tt + 2].x;
        f.y = w0.y * x[tt].y + w1.y * x[tt + 1].y + w2.y * x[tt + 2].y;
        f.z = w0.z * x[tt].z + w1.z * x[tt + 1].z + w2.z * x[tt + 2].z;
        f.w = w0.w * x[tt].w + w1.w * x[tt + 1].w + w2.w * x[tt + 2].w;
        if (c < 768) { *reinterpret_cast<float4*>(F + tt * FLD + c) = f; }
        else {
          const int cc = c - 768;
          if (cc < 128) { f.x = tanhf(f.x); f.y = tanhf(f.y); f.z = tanhf(f.z); f.w = tanhf(f.w); }
          else if (cc >= 256) { f.x = sigmoidf_(f.x); f.y = sigmoidf_(f.y); f.z = sigmoidf_(f.z); f.w = sigmoidf_(f.w); }
          uint2 pk; pk.x = pack2(f.x, f.y); pk.y = pack2(f.z, f.w);
          *reinterpret_cast<uint2*>(LIb + tt * LLD + cc) = pk;
        }
      }
    }
    __syncthreads();
    f32x4 acc[5][4];
#pragma unroll
    for (int g = 0; g < 5; ++g)
#pragma unroll
      for (int nf = 0; nf < 4; ++nf) acc[g][nf] = (f32x4){0.f, 0.f, 0.f, 0.f};
    if (pv_ != 2 && pv_ != 3) {
#define PB_LOAD(W, GI) { const u16* wt_ = (GI) < 4 ? LW + (size_t)(GI) * 16384 : LW + 65536; const int rs_ = (GI) < 4 ? 64 : 128; const int ko_ = (GI) < 4 ? 0 : ((GI) - 4) * 64; \
      _Pragma("unroll") for (int ks_ = 0; ks_ < 2; ++ks_) _Pragma("unroll") for (int nf_ = 0; nf_ < 4; ++nf_) \
        W[ks_ * 4 + nf_] = *reinterpret_cast<const bf16x8*>(wt_ + (size_t)(64 * wid + 16 * nf_ + fr) * rs_ + ko_ + ks_ * 32 + fq * 8); }
#define PB_MMA(W, GI) { const int ai_ = (GI) < 4 ? (GI) : 4; const int xo_ = (GI) < 4 ? (GI) * 64 : 256 + ((GI) - 4) * 64; \
      _Pragma("unroll") for (int ks_ = 0; ks_ < 2; ++ks_) { \
        const bf16x8 xb_ = *reinterpret_cast<const bf16x8*>(LIb + fr * LLD + xo_ + ks_ * 32 + fq * 8); \
        _Pragma("unroll") for (int nf_ = 0; nf_ < 4; ++nf_) acc[ai_][nf_] = __builtin_amdgcn_mfma_f32_16x16x32_bf16(W[ks_ * 4 + nf_], xb_, acc[ai_][nf_], 0, 0, 0); } \
      __builtin_amdgcn_sched_barrier(0); }
    {
      bf16x8 wA[8], wB[8];
      PB_LOAD(wA, 0)
      PB_LOAD(wB, 1) PB_MMA(wA, 0)
      PB_LOAD(wA, 2) PB_MMA(wB, 1)
      PB_LOAD(wB, 3) PB_MMA(wA, 2)
      PB_LOAD(wA, 4) PB_MMA(wB, 3)
      PB_LOAD(wB, 5) PB_MMA(wA, 4)
      PB_MMA(wB, 5)
    }
#undef PB_LOAD
#undef PB_MMA
    }
    if (pv_ != 2 && pv_ != 3) {
#ifndef NO_C
    const float* PRM = reinterpret_cast<const float*>(smem + 61952);
    {
      const int tok = tok0 + fr;
      float ss = 0.f, bs = 0.f;
#pragma unroll
      for (int nf = 0; nf < 4; ++nf) {
        const int c0 = 64 * wid + 16 * nf + 4 * fq;
        const float4 r4 = *reinterpret_cast<const float4*>(F + fr * FLD + c0);
        const float4 k4 = *reinterpret_cast<const float4*>(F + fr * FLD + 256 + c0);
        const float4 w00 = *reinterpret_cast<const float4*>(PRM + c0);
        const float4 w01 = *reinterpret_cast<const float4*>(PRM + 256 + c0);
        const float4 a00 = *reinterpret_cast<const float4*>(PRM + 512 + c0);
        const float4 a01 = *reinterpret_cast<const float4*>(PRM + 768 + c0);
        const float4 kkw = *reinterpret_cast<const float4*>(PRM + 1024 + c0);
        const float4 kaw = *reinterpret_cast<const float4*>(PRM + 1280 + c0);
        const float4 rkw = *reinterpret_cast<const float4*>(PRM + 1536 + c0);
        const float rr[4] = {r4.x, r4.y, r4.z, r4.w}, kk_[4] = {k4.x, k4.y, k4.z, k4.w};
        const float w0a[4] = {w00.x, w00.y, w00.z, w00.w}, w0b[4] = {w01.x, w01.y, w01.z, w01.w};
        const float a0a[4] = {a00.x, a00.y, a00.z, a00.w}, a0b[4] = {a01.x, a01.y, a01.z, a01.w};
        const float kkw_[4] = {kkw.x, kkw.y, kkw.z, kkw.w}, kaw_[4] = {kaw.x, kaw.y, kaw.z, kaw.w}, rkw_[4] = {rkw.x, rkw.y, rkw.z, rkw.w};
#pragma unroll
        for (int r = 0; r < 4; ++r) {
          {
            const float z = -(w0a[r] + acc[0][nf][r]);
            const float sp = fmaxf(z, 0.f) + log1pf(__expf(-fabsf(z)));
            acc[0][nf][r] = __expf(-__expf(-sp - 0.5f));
          }
          {
            const float z = -(w0b[r] + acc[1][nf][r]);
            const float sp = fmaxf(z, 0.f) + log1pf(__expf(-fabsf(z)));
            acc[1][nf][r] = __expf(-__expf(-sp - 0.5f));
          }
          const float av0 = sigmoidf_(a0a[r] + acc[2][nf][r]);
          const float av1 = sigmoidf_(a0b[r] + acc[3][nf][r]);
          acc[2][nf][r] = av0; acc[3][nf][r] = av1;
          const float k = kk_[r];
          const float kq = k * kkw_[r];
          ss += kq * kq;
          const float kd0 = k * (1.f + (av0 - 1.f) * kaw_[r]);
          const float kd1 = k * (1.f + (av1 - 1.f) * kaw_[r]);
          bs += rr[r] * (kd0 + kd1) * rkw_[r];
        }
        __builtin_amdgcn_sched_barrier(0);
      }
      ss += __shfl_xor(ss, 16); ss += __shfl_xor(ss, 32);
      bs += __shfl_xor(bs, 16); bs += __shfl_xor(bs, 32);
      const float inrm = 1.f / fmaxf(sqrtf(ss), 1e-12f);
#pragma unroll
      for (int nf = 0; nf < 4; ++nf) {
        const int c0 = 64 * wid + 16 * nf + 4 * fq, n0 = 16 * nf + 4 * fq;
        const float4 r4 = *reinterpret_cast<const float4*>(F + fr * FLD + c0);
        const float4 k4 = *reinterpret_cast<const float4*>(F + fr * FLD + 256 + c0);
        const float4 v4 = *reinterpret_cast<const float4*>(F + fr * FLD + 512 + c0);
        const float4 kkw = *reinterpret_cast<const float4*>(PRM + 1024 + c0);
        const float4 kaw = *reinterpret_cast<const float4*>(PRM + 1280 + c0);
        const float kk_[4] = {k4.x, k4.y, k4.z, k4.w}, kkw_[4] = {kkw.x, kkw.y, kkw.z, kkw.w}, kaw_[4] = {kaw.x, kaw.y, kaw.z, kaw.w};
        float* sc = p.SC + ((size_t)(tok * 4 + wid) * 9) * 64 + n0;
        float kn[4], kd0[4], kd1[4];
#pragma unroll
        for (int r = 0; r < 4; ++r) {
          kn[r] = kk_[r] * kkw_[r] * inrm;
          kd0[r] = kk_[r] * (1.f + (acc[2][nf][r] - 1.f) * kaw_[r]);
          kd1[r] = kk_[r] * (1.f + (acc[3][nf][r] - 1.f) * kaw_[r]);
        }
        *reinterpret_cast<float4*>(sc) = r4;
        *reinterpret_cast<float4*>(sc + 64) = make_float4(kn[0], kn[1], kn[2], kn[3]);
        *reinterpret_cast<float4*>(sc + 128) = v4;
        *reinterpret_cast<float4*>(sc + 192) = make_float4(acc[0][nf][0], acc[0][nf][1], acc[0][nf][2], acc[0][nf][3]);
        *reinterpret_cast<float4*>(sc + 256) = make_float4(acc[2][nf][0] * kn[0], acc[2][nf][1] * kn[1], acc[2][nf][2] * kn[2], acc[2][nf][3] * kn[3]);
        *reinterpret_cast<float4*>(sc + 320) = make_float4(kd0[0], kd0[1], kd0[2], kd0[3]);
        *reinterpret_cast<float4*>(sc + 384) = make_float4(acc[1][nf][0], acc[1][nf][1], acc[1][nf][2], acc[1][nf][3]);
        *reinterpret_cast<float4*>(sc + 448) = make_float4(acc[3][nf][0] * kn[0], acc[3][nf][1] * kn[1], acc[3][nf][2] * kn[2], acc[3][nf][3] * kn[3]);
        *reinterpret_cast<float4*>(sc + 512) = make_float4(kd1[0], kd1[1], kd1[2], kd1[3]);
        *reinterpret_cast<float4*>(p.G + (size_t)tok * 256 + c0) = make_float4(acc[4][nf][0], acc[4][nf][1], acc[4][nf][2], acc[4][nf][3]);
        *reinterpret_cast<float4*>(p.BV + (size_t)tok * 256 + c0) = make_float4(bs * v4.x, bs * v4.y, bs * v4.z, bs * v4.w);
        __builtin_amdgcn_sched_barrier(0);
      }
    }
#endif
    }
    }
    if (!doR && pv_ != 1) {
#ifndef NO_D
    {
      const int tok = tid >> 4, g8 = tid & 15, tokg = tok0 + tok, tpos = tpos0 + tok;
      const int tkey = isctx ? tpos : 512 + tpos;
      const float* pr = p.PROJ + (size_t)tokg * DIN;
#pragma unroll
      for (int hh = 0; hh < 2; ++hh) {
        const int g = g8 + 16 * hh, c0 = g * 8, hd = c0 >> 6, d0 = c0 & 63;
        const float4 qa = *reinterpret_cast<const float4*>(pr + 1152 + c0), qb = *reinterpret_cast<const float4*>(pr + 1152 + c0 + 4);
        const float4 ka = *reinterpret_cast<const float4*>(pr + 1408 + c0), kb2 = *reinterpret_cast<const float4*>(pr + 1408 + c0 + 4);
        const float qv[8] = {qa.x * QSCALE, qa.y * QSCALE, qa.z * QSCALE, qa.w * QSCALE, qb.x * QSCALE, qb.y * QSCALE, qb.z * QSCALE, qb.w * QSCALE};
        const float kv[8] = {ka.x, ka.y, ka.z, ka.w, kb2.x, kb2.y, kb2.z, kb2.w};
        if (isctx) {
          float* ok = p.out_nak + ((size_t)(b * 4 + layer) * 256 + tpos) * 256 + c0;
          *reinterpret_cast<float4*>(ok) = ka; *reinterpret_cast<float4*>(ok + 4) = kb2;
          pack8_store(p.QNc + (size_t)tokg * 256 + c0, qv);
          pack8_store(p.KNc + (size_t)(b * 4 + hd) * 16384 + kf_off(tkey, d0), kv);
        } else {
          pack8_store(p.QNl + (size_t)(tokg - NCTX) * 256 + c0, qv);
          pack8_store(p.KNl + ((size_t)((layer * 2 + b) * 4 + hd)) * 98304 + kf_off(tkey, d0), kv);
        }
      }
#pragma unroll
      for (int hh = 0; hh < 5; ++hh) {
        const bool isk = (hh == 4);
        const int g = isk ? g8 : g8 + 16 * hh, d0 = (g & 7) * 8, hd = g >> 3;
        const float* src = pr + (isk ? 2432 : 1920) + g * 8;
        const float4 xa = *reinterpret_cast<const float4*>(src), xb = *reinterpret_cast<const float4*>(src + 4);
        const float* nw = (isk ? p.in[25] : p.in[24]) + (size_t)layer * 64 + d0;
        const float4 na = *reinterpret_cast<const float4*>(nw), nb = *reinterpret_cast<const float4*>(nw + 4);
        float x[8] = {xa.x, xa.y, xa.z, xa.w, xb.x, xb.y, xb.z, xb.w};
        const float nrm[8] = {na.x, na.y, na.z, na.w, nb.x, nb.y, nb.z, nb.w};
        float ss = 0.f;
#pragma unroll
        for (int e = 0; e < 8; ++e) ss += x[e] * x[e];
        ss += dpp_mov<0xB1>(ss); ss += dpp_mov<0x4E>(ss); ss += dpp_mov<0x141>(ss);
        const float rs = rsqrtf(ss * (1.f / 64.f) + 1e-6f);
#pragma unroll
        for (int e = 0; e < 8; ++e) x[e] = x[e] * rs * nrm[e];
        if (isk && isctx) {
          float* ok = p.out_gk + ((size_t)(b * 4 + layer) * 256 + tpos) * 128 + g * 8;
          *reinterpret_cast<float4*>(ok) = make_float4(x[0], x[1], x[2], x[3]);
          *reinterpret_cast<float4*>(ok + 4) = make_float4(x[4], x[5], x[6], x[7]);
        }
        if (!isctx) {
          const int pos = (d0 < 32) ? (tpos >> 6) : (tpos & 63);
          const float4* rt = reinterpret_cast<const float4*>(p.rope + (size_t)(pos * 16 + (d0 & 15)) * 2);
          const float4 r0 = rt[0], r1 = rt[1], r2 = rt[2], r3 = rt[3];
          const float cs[8] = {r0.x, r0.z, r1.x, r1.z, r2.x, r2.z, r3.x, r3.z};
          const float sn[8] = {r0.y, r0.w, r1.y, r1.w, r2.y, r2.w, r3.y, r3.w};
          const float sg = (d0 & 16) ? 1.f : -1.f;
#pragma unroll
          for (int e = 0; e < 8; ++e) { const float pe = dpp_mov<0x4E>(x[e]); x[e] = x[e] * cs[e] + sg * pe * sn[e]; }
        }
        if (!isk) {
#pragma unroll
          for (int e = 0; e < 8; ++e) x[e] *= QSCALE;
          if (isctx) pack8_store(p.QGc + (size_t)tokg * 512 + g * 8, x);
          else pack8_store(p.QGl + (size_t)(tokg - NCTX) * 512 + g * 8, x);
        } else {
          if (isctx) pack8_store(p.KGc + (size_t)(b * 2 + hd) * 16384 + kf_off(tkey, d0), x);
          else pack8_store(p.KGl + ((size_t)((layer * 2 + b) * 2 + hd)) * 98304 + kf_off(tkey, d0), x);
        }
      }
    }
    const int c = tid;
#pragma unroll
    for (int half = 0; half < 2; ++half) {
      float vv[8];
#pragma unroll
      for (int t8 = 0; t8 < 8; ++t8) {
        const int tt = half * 8 + t8, tokn = tok0 + tt;
        const float v = p.PROJ[(size_t)tokn * DIN + 1664 + c];
        vv[t8] = v;
        if (isctx) p.out_nav[((size_t)(b * 4 + layer) * 256 + tpos0 + tt) * 256 + c] = v;
      }
      if (isctx) pack44_store(p.VNtc + (size_t)(b * 4 + (c >> 6)) * 16384, tpos0 + half * 8, c & 63, vv);
      else pack44_store(p.VNtl + ((size_t)((layer * 2 + b) * 4 + (c >> 6))) * 98304, 512 + tpos0 + half * 8, c & 63, vv);
    }
    if (wid >= 2) {
      const int cv = c - 128;
#pragma unroll
      for (int half = 0; half < 2; ++half) {
        float vv[8];
#pragma unroll
        for (int t8 = 0; t8 < 8; ++t8) {
          const int tt = half * 8 + t8, tokn = tok0 + tt;
          const float v = p.PROJ[(size_t)tokn * DIN + 2560 + cv];
          vv[t8] = v;
          if (isctx) p.out_gv[((size_t)(b * 4 + layer) * 256 + tpos0 + tt) * 128 + cv] = v;
        }
        if (isctx) pack44_store(p.VGtc + (size_t)(b * 2 + (cv >> 6)) * 16384, tpos0 + half * 8, cv & 63, vv);
        else pack44_store(p.VGtl + ((size_t)((layer * 2 + b) * 2 + (cv >> 6))) * 98304, 512 + tpos0 + half * 8, cv & 63, vv);
      }
    }
#endif
    }
    __syncthreads();
  }
}

#define ATT_LOAD(KF, VF, CI) { \
    const int ci_ = min((CI), nt - 1); \
    int kb_; \
    if (ci_ < nd) kb_ = ci_ * 32; \
    else { const int e_ = ci_ - nd; const int j_ = (ncc == 2) ? (e_ >> 1) : e_; const int cc_ = cc0 + ((ncc == 2) ? (e_ & 1) : 0); kb_ = 512 + (rb + j_) * 64 + cc_ * 32; } \
    const u16* kp_ = Kb + (size_t)(kb_ >> 4) * 1024 + lane * 8; \
    KF##00 = *reinterpret_cast<const bf16x8*>(kp_); \
    KF##01 = *reinterpret_cast<const bf16x8*>(kp_ + 512); \
    KF##10 = *reinterpret_cast<const bf16x8*>(kp_ + 1024); \
    KF##11 = *reinterpret_cast<const bf16x8*>(kp_ + 1536); \
    const u16* vp_ = Vt + (size_t)(kb_ >> 5) * 2048 + lane * 8; \
    VF##0 = *reinterpret_cast<const bf16x8*>(vp_); \
    VF##1 = *reinterpret_cast<const bf16x8*>(vp_ + 512); \
    VF##2 = *reinterpret_cast<const bf16x8*>(vp_ + 1024); \
    VF##3 = *reinterpret_cast<const bf16x8*>(vp_ + 1536); }

#define ATT_PV(DT, VV) { \
    o[DT][0] *= alpha; o[DT][1] *= alpha; o[DT][2] *= alpha; o[DT][3] *= alpha; \
    o[DT] = __builtin_amdgcn_mfma_f32_16x16x32_bf16(VV, pf.v, o[DT], 0, 0, 0); }

#define ATT_COMPUTE(KF, VF, CI) { \
    const int ci_ = (CI); \
    f32x4 s0 = (f32x4){0.f, 0.f, 0.f, 0.f}, s1 = (f32x4){0.f, 0.f, 0.f, 0.f}; \
    s0 = __builtin_amdgcn_mfma_f32_16x16x32_bf16(KF##00, qf0, s0, 0, 0, 0); \
    s0 = __builtin_amdgcn_mfma_f32_16x16x32_bf16(KF##01, qf1, s0, 0, 0, 0); \
    s1 = __builtin_amdgcn_mfma_f32_16x16x32_bf16(KF##10, qf0, s1, 0, 0, 0); \
    s1 = __builtin_amdgcn_mfma_f32_16x16x32_bf16(KF##11, qf1, s1, 0, 0, 0); \
    float sv[8] = {s0[0], s0[1], s0[2], s0[3], s1[0], s1[1], s1[2], s1[3]}; \
    bool ok[8]; \
    _Pragma("unroll") for (int e = 0; e < 8; ++e) ok[e] = true; \
    if (ci_ >= nd) { \
      const int e_ = ci_ - nd; const int j_ = (ncc == 2) ? (e_ >> 1) : e_; const int cc_ = cc0 + ((ncc == 2) ? (e_ & 1) : 0); \
      const int dr_ = rb + j_ - grow + 7; \
      const int cq = cq0 + fr, c0 = min(max(cq - 8, 0), 48); \
      _Pragma("unroll") for (int e = 0; e < 8; ++e) { \
        const int ck = cc_ * 32 + 16 * (e >> 2) + 4 * fq + (e & 3); \
        ok[e] = (ck >= c0) && (ck < c0 + 16); \
        const int dc = min(max(ck - cq, -15), 15) + 15; \
        const float bias = rpb[dr_ * 31 + dc] * LOG2E; \
        sv[e] = ok[e] ? sv[e] + bias : -1e30f; \
      } \
    } \
    float mx = fmaxf(fmaxf(fmaxf(sv[0], sv[1]), fmaxf(sv[2], sv[3])), fmaxf(fmaxf(sv[4], sv[5]), fmaxf(sv[6], sv[7]))); \
    mx = fmaxf(mx, __shfl_xor(mx, 16)); \
    mx = fmaxf(mx, __shfl_xor(mx, 32)); \
    const float mn = fmaxf(m, mx); \
    const float alpha = exp2f(m - mn); \
    m = mn; \
    float ps = 0.f; \
    _Pragma("unroll") for (int e = 0; e < 8; ++e) { sv[e] = ok[e] ? exp2f(sv[e] - mn) : 0.f; ps += sv[e]; } \
    l = l * alpha + ps; \
    union { bf16x8 v; unsigned u[4]; } pf; \
    pf.u[0] = pack2(sv[0], sv[1]); pf.u[1] = pack2(sv[2], sv[3]); pf.u[2] = pack2(sv[4], sv[5]); pf.u[3] = pack2(sv[6], sv[7]); \
    ATT_PV(0, VF##0) ATT_PV(1, VF##1) ATT_PV(2, VF##2) ATT_PV(3, VF##3) }

__device__ __forceinline__ void attn_wave(const u16* __restrict__ Q, int ldq, const u16* __restrict__ Kb, int ldk,
                                          const u16* __restrict__ Vt, int ldv, int ndense, const bool NA,
                                          const float* __restrict__ rpb, int grow, int cq0,
                                          u16* __restrict__ out, int ldo, int tidx) {
  const int lane = tidx & 63, fr = lane & 15, fq = lane >> 4;
  const bf16x8 qf0 = *reinterpret_cast<const bf16x8*>(Q + (size_t)fr * ldq + fq * 8);
  const bf16x8 qf1 = *reinterpret_cast<const bf16x8*>(Q + (size_t)fr * ldq + 32 + fq * 8);
  f32x4 o[4];
#pragma unroll
  for (int dt = 0; dt < 4; ++dt) o[dt] = (f32x4){0.f, 0.f, 0.f, 0.f};
  float m = -1e30f, l = 0.f;
  const int nd = ndense >> 5;
  const int rb = min(max(grow - 4, 0), 8);
  const int ulo = min(max(cq0 - 8, 0), 48), uhi = min(max(cq0 + 15 - 8, 0), 48) + 16;
  const bool c0ok = ulo < 32, c1ok = uhi > 32;
  const int ncc = (c0ok && c1ok) ? 2 : 1, cc0 = c0ok ? 0 : 1;
  const int nt = nd + (NA ? 8 * ncc : 0);
  bf16x8 ka00, ka01, ka10, ka11, kb00, kb01, kb10, kb11;
  bf16x8 va0, va1, va2, va3, vb0, vb1, vb2, vb3;
  ATT_LOAD(ka, va, 0)
  for (int ci = 0; ci < nt; ci += 2) {
    ATT_LOAD(kb, vb, ci + 1)
    ATT_COMPUTE(ka, va, ci)
    if (ci + 1 < nt) {
      ATT_LOAD(ka, va, ci + 2)
      ATT_COMPUTE(kb, vb, ci + 1)
    }
  }
  l += __shfl_xor(l, 16);
  l += __shfl_xor(l, 32);
  const float il = 1.f / l;
#pragma unroll
  for (int dt = 0; dt < 4; ++dt) {
    uint2 pk; pk.x = pack2(o[dt][0] * il, o[dt][1] * il); pk.y = pack2(o[dt][2] * il, o[dt][3] * il);
    *reinterpret_cast<uint2*>(out + (size_t)fr * ldo + 16 * dt + 4 * fq) = pk;
  }
}

__device__ void scan_item(const Params& p, int layer, char* smem, bool lat, int b, int h, int dir, int qd, int tidx) {
  const int tid = tidx, lane = tid & 63, wid = tid >> 6, rr = lane >> 4, j = lane & 15;
  const int L = lat ? 1024 : 256, seqbase = lat ? NCTX + b * 1024 : b * 256;
  const int rowl = wid * 4 + rr, row = qd * 16 + rowl;
  float* cbuf = reinterpret_cast<float*>(smem);
  float* obuf = cbuf + 2 * 16 * 6 * 64;
  float4 S = make_float4(0.f, 0.f, 0.f, 0.f);
  if (lat) S = *reinterpret_cast<const float4*>(p.in[2] + ((((size_t)(b * 4 + layer) * 2 + dir) * 4 + h) * 64 + row) * 64 + 4 * j);
  v2f S01 = (v2f){S.x, S.y}, S23 = (v2f){S.z, S.w};
  const int nch = L / 16;
  float* odst = dir == 0 ? p.OF : p.OB;
  float4 pre0, pre1, pre2, pre3, pre4, pre5;
#define SC_GL1(PR, I, CH) { const int idx = tid + 256 * (I), tt_ = idx / 96, rem = idx % 96, vec = rem >> 4, f4 = rem & 15; \
    const int st_ = (CH) * 16 + tt_, t_ = dir == 0 ? st_ : L - 1 - st_; const int svec = vec < 3 ? vec : vec + 3 * dir; \
    PR = *reinterpret_cast<const float4*>(p.SC + ((size_t)((seqbase + t_) * 4 + h) * 9 + svec) * 64 + f4 * 4); }
#define gload(CH) { SC_GL1(pre0, 0, CH) SC_GL1(pre1, 1, CH) SC_GL1(pre2, 2, CH) SC_GL1(pre3, 3, CH) SC_GL1(pre4, 4, CH) SC_GL1(pre5, 5, CH) }
#define SC_LS1(PR, I, BUF) *reinterpret_cast<float4*>(cbuf + (BUF) * 6144 + (tid + 256 * (I)) * 4) = PR;
#define lstore(BUF) { SC_LS1(pre0, 0, BUF) SC_LS1(pre1, 1, BUF) SC_LS1(pre2, 2, BUF) SC_LS1(pre3, 3, BUF) SC_LS1(pre4, 4, BUF) SC_LS1(pre5, 5, BUF) }
  gload(0); lstore(0);
  __syncthreads();
#define SC_LD(R4, K4, VV, W4, A4, D4, TT) { const float* base_ = cb + (TT) * 384; \
    R4 = *reinterpret_cast<const float4*>(base_ + 4 * j); K4 = *reinterpret_cast<const float4*>(base_ + 64 + 4 * j); \
    VV = base_[128 + row]; W4 = *reinterpret_cast<const float4*>(base_ + 192 + 4 * j); \
    A4 = *reinterpret_cast<const float4*>(base_ + 256 + 4 * j); D4 = *reinterpret_cast<const float4*>(base_ + 320 + 4 * j); }
#if SCANVAR
  for (int pass_ = 0; pass_ < (lat ? 2 : 1); ++pass_) {
  int var_ = pass_ ? SCANVAR : 0;
  asm volatile("" : "+v"(var_)); var_ = __builtin_amdgcn_readfirstlane(var_);
#else
  const int var_ = 0;
#endif
  for (int ch = 0; ch < nch; ++ch) {
    if (ch + 1 < nch && var_ != 3) gload(ch + 1);
    const float* cb = cbuf + (ch & 1) * 6144;
    float osel = 0.f;
    float4 r4, kk4, w4, ak4, kd4; float vv;
    SC_LD(r4, kk4, vv, w4, ak4, kd4, 0)
    float ovp = 0.f;
    if (var_ != 2)
#pragma unroll 8
    for (int tt = 0; tt < 16; ++tt) {
      float4 r4n, kk4n, w4n, ak4n, kd4n; float vvn;
      SC_LD(r4n, kk4n, vvn, w4n, ak4n, kd4n, tt + 1)
      v2f p = S01 * (v2f){kk4.x, kk4.y};
      p = S23 * (v2f){kk4.z, kk4.w} + p;
      float sk = p.x + p.y;
      sk += dpp_mov<0xB1>(sk);  ovp += dpp_mov<0xB1>(ovp);
      sk += dpp_mov<0x4E>(sk);  ovp += dpp_mov<0x4E>(ovp);
      sk += dpp_mov<0x141>(sk); ovp += dpp_mov<0x141>(ovp);
      sk += dpp_mov<0x140>(sk); ovp += dpp_mov<0x140>(ovp);
      osel = (j == tt - 1) ? ovp : osel;
      const v2f vv2 = (v2f){vv, vv}, sk2 = (v2f){sk, sk};
      v2f t01 = (v2f){kd4.x, kd4.y} * vv2; t01 = t01 - (v2f){ak4.x, ak4.y} * sk2;
      v2f t23 = (v2f){kd4.z, kd4.w} * vv2; t23 = t23 - (v2f){ak4.z, ak4.w} * sk2;
      S01 = S01 * (v2f){w4.x, w4.y} + t01;
      S23 = S23 * (v2f){w4.z, w4.w} + t23;
      v2f q = S01 * (v2f){r4.x, r4.y};
      q = S23 * (v2f){r4.z, r4.w} + q;
      ovp = q.x + q.y;
      r4 = r4n; kk4 = kk4n; w4 = w4n; ak4 = ak4n; kd4 = kd4n; vv = vvn;
    }
    ovp = reduce16(ovp);
    osel = (j == 15) ? ovp : osel;
    if (var_ == 0) {
      const int st = ch * 16 + j, t = dir == 0 ? st : L - 1 - st;
      odst[(size_t)(seqbase + t) * 256 + h * 64 + row] = osel;
    } else asm volatile("" :: "v"(osel), "v"(S01), "v"(S23));
    if (ch + 1 < nch && var_ != 3) lstore((ch + 1) & 1);
    asm volatile("s_waitcnt lgkmcnt(0)" ::: "memory");
    __builtin_amdgcn_s_barrier();
  }
#if SCANVAR
  }
#endif
  if (!lat) *reinterpret_cast<float4*>(p.out_st + ((((size_t)(b * 4 + layer) * 2 + dir) * 4 + h) * 64 + row) * 64 + 4 * j) = make_float4(S01.x, S01.y, S23.x, S23.y);
  __syncthreads();
}

__device__ void mixer_phase(const Params& p, int layer_wq, char* smem, int tidx0) {
  const int layer = layer_wq & 3;
  int* slot = reinterpret_cast<int*>(smem + 60 * 1024);
  bool first = true;
  for (;;) {
    int tidx = tidx0;
    asm volatile("" : "+v"(tidx));
    const int tid = tidx, wid = tid >> 6;
    __syncthreads();
    if (tid == 0) *slot = first ? (int)blockIdx.x : (int)(gridDim.x + atomicAdd(&p.wq[layer_wq], 1u));
    first = false;
    __syncthreads();
    int it = *slot;
    if (it >= 1728) break;
    const bool is_scan = (it < 64) || (it >= 448 && it < 960);
#if REPMASK
    if ((p.pad == 1 && !is_scan) || (p.pad == 2 && is_scan) || ((p.pad == 3 || p.pad == 5 || p.pad == 6) && !(it < 64)) || (p.pad == 4 && !(it >= 64 && it < 320))) continue;
#endif
    if (is_scan) {
      const bool lat = it < 64;
      const int si = lat ? it : it - 448;
#ifndef NO_SCAN
      scan_item(p, layer, smem, lat, si / 32, (si / 8) % 4, (si / 4) % 2, si % 4, tidx);
#endif
      continue;
    }
    const u16 *Q, *Kb, *Vt; u16* out; int ldq, ldk, ldv, ndense, grow = 0, cq0 = 0; bool na = false;
    const float* rpb = p.in[23];
    if (it < 320) {
      it -= 64;
      const int b = it / 128, qh = (it / 16) % 8, qt = it % 16, kvh = qh >> 2;
      const int q0 = b * 1024 + qt * 64 + wid * 16;
      Q = p.QGl + (size_t)q0 * 512 + qh * 64; ldq = 512;
      Kb = p.KGl + (size_t)((layer * 2 + b) * 2 + kvh) * 98304; ldk = 0;
      Vt = p.VGtl + (size_t)((layer * 2 + b) * 2 + kvh) * 98304; ldv = 0; ndense = 1536;
      out = p.MIX + (size_t)(NCTX + q0) * DM + 512 + qh * 64;
    } else if (it < 448) {
      it -= 320;
      const int b = it / 64, h = (it / 16) % 4, r = it % 16;
      const int q0 = b * 1024 + r * 64 + wid * 16;
      Q = p.QNl + (size_t)q0 * 256 + h * 64; ldq = 256;
      Kb = p.KNl + (size_t)((layer * 2 + b) * 4 + h) * 98304; ldk = 0;
      Vt = p.VNtl + (size_t)((layer * 2 + b) * 4 + h) * 98304; ldv = 0; ndense = 512;
      rpb = p.in[23] + (size_t)(layer * 4 + h) * 15 * 31; grow = r; cq0 = wid * 16; na = true;
      out = p.MIX + (size_t)(NCTX + q0) * DM + 256 + h * 64;
    } else if (it < 1472) {
      it -= 960;
      const int b = it / 32, qh = (it / 4) % 8, qt = it % 4, kvh = qh >> 2;
      const int q0 = b * 256 + qt * 64 + wid * 16;
      Q = p.QGc + (size_t)q0 * 512 + qh * 64; ldq = 512;
      Kb = p.KGc + (size_t)(b * 2 + kvh) * 16384; ldk = 0;
      Vt = p.VGtc + (size_t)(b * 2 + kvh) * 16384; ldv = 0; ndense = 256;
      out = p.MIX + (size_t)q0 * DM + 512 + qh * 64;
    } else {
      it -= 1472;
      const int b = it / 16, h = (it / 4) % 4, qt = it % 4;
      const int q0 = b * 256 + qt * 64 + wid * 16;
      Q = p.QNc + (size_t)q0 * 256 + h * 64; ldq = 256;
      Kb = p.KNc + (size_t)(b * 4 + h) * 16384; ldk = 0;
      Vt = p.VNtc + (size_t)(b * 4 + h) * 16384; ldv = 0; ndense = 256;
      out = p.MIX + (size_t)q0 * DM + 256 + h * 64;
    }
#ifndef NO_ATT
    attn_wave(Q, ldq, Kb, ldk, Vt, ldv, ndense, na, rpb, grow, cq0, out, DM, tidx);
#endif
  }
}

__device__ void rwkv_fin_phase(const Params& p, int layer, int bid, int nblk, int tidx) {
  const int tid = tidx;
  const float lw = p.in[21][(size_t)layer * 256 + tid], lb = p.in[22][(size_t)layer * 256 + tid];
  for (int t4 = bid; t4 < NTOK / 4; t4 += nblk) {
    float of[4], ob[4], bv[4], gg[4];
#pragma unroll
    for (int u = 0; u < 4; ++u) {
      const size_t i = (size_t)(t4 * 4 + u) * 256 + tid;
      of[u] = p.OF[i]; ob[u] = p.OB[i]; bv[u] = p.BV[i]; gg[u] = p.G[i];
    }
#pragma unroll
    for (int u = 0; u < 4; ++u) {
      const float o = of[u] + ob[u];
      const float mu = wave_sum(o) * (1.f / 64.f);
      const float d = o - mu;
      const float var = wave_sum(d * d) * (1.f / 64.f);
      const float y = (d * rsqrtf(var + 64e-5f) * lw + lb + bv[u]) * gg[u];
      p.MIX[(size_t)(t4 * 4 + u) * DM + tid] = f2bf(y);
    }
  }
}

#ifndef ONLY_PH
#define ONLY_PH -1
#endif
#define PH_EN(x) (ONLY_PH < 0 || ONLY_PH == (x))
__device__ __forceinline__ void run_phase(const Params& p, int ph, char* smem, int bid, int nblk, int tidx, int rep = 0) {
  if (ph == 0) { if (PH_EN(0)) setup_phase(p, smem, bid, nblk, tidx); return; }
  if (ph == 1) { if (PH_EN(1)) modreduce_phase(p, bid, nblk, tidx); return; }
  if (ph == 2) { if (PH_EN(2)) ln_phase<0>(p, 0, bid, nblk, tidx); return; }
  const int layer = (ph - 3) / 9, s = (ph - 3) % 9;
  switch (s) {
    case 0: if (PH_EN(3)) gemm_phase<EPI_PROJ, 256, 3>(p, layer, p.A, p.winT + (size_t)layer * DIN * DM, DIN, DM, smem, bid, nblk, tidx); break;
    case 1: if (PH_EN(4)) prep_phase(p, layer, smem, bid, nblk, tidx, rep); break;
    case 2: if (PH_EN(5)) mixer_phase(p, layer + 4 * rep, smem, tidx); break;
    case 3: if (PH_EN(6)) rwkv_fin_phase(p, layer, bid, nblk, tidx); break;
    case 4: if (PH_EN(7)) gemm_phase<EPI_OUT, 192, 3>(p, layer, p.MIX, p.woutT + (size_t)layer * DM * DM, DM, DM, smem, bid, nblk, tidx); break;
    case 5: if (PH_EN(8)) ln_phase<1>(p, layer, bid, nblk, tidx); break;
    case 6: if (PH_EN(9)) gemm_phase<EPI_FFI, 192, 3>(p, layer, p.A, p.wfiT + (size_t)layer * 2 * DFF * DM, 2 * DFF, DM, smem, bid, nblk, tidx); break;
    case 7: if (PH_EN(10)) gemm_phase<EPI_FFO, 192, 3>(p, layer, p.ACT, p.wfoT + (size_t)layer * DM * DFF, DM, DFF, smem, bid, nblk, tidx); break;
    default: if (PH_EN(11)) ln_phase<2>(p, layer, bid, nblk, tidx); break;
  }
}

__global__ void __launch_bounds__(256, 2) fwd_kernel(Params p, int ph0, int ph1, int usebar) {
  __shared__ __attribute__((aligned(16))) char smem[73728 + 16];
  const int bid = blockIdx.x, nblk = gridDim.x;
  XcdBarrier xb;
  if (usebar && p.never) cg::this_grid().sync();
  if (usebar) {
    if (threadIdx.x == 0) *reinterpret_cast<uint4*>(smem + 73728) = make_uint4(0u, 0u, 0u, 0u);
    __syncthreads();
    xb = xcd_barrier_post(p.bar, (volatile LAS unsigned*)(smem + 73728));
  }
  int ph = ph0, rep = 0;
  while (ph < ph1) {
    int tidx = threadIdx.x;
    asm volatile("" : "+v"(tidx));
    run_phase(p, ph, smem, bid, nblk, tidx, rep);
#if REPSLOT >= 0
    if (((ph < 3 ? 9 + ph : (ph - 3) % 9) == REPSLOT) && rep == 0) rep = 1; else { rep = 0; ++ph; }
#else
    ++ph;
#endif
    if (usebar && ph < ph1) xcd_barrier(xb);
  }
}

static inline size_t al256(size_t x) { return (x + 255) & ~(size_t)255; }

extern "C" void kernel_launch(void* const* d_in, const int* in_sizes, int n_in, void* d_out, int out_size, void* d_ws, size_t ws_size,
                              hipStream_t stream) {
  Params p;
  memset(&p, 0, sizeof(p));
  for (int i = 0; i < 33; ++i) p.in[i] = (const float*)d_in[i];
  float* o = (float*)d_out;
  p.out_yp = o; o += 4194304;
  p.out_ys = o; o += 2097152;
  p.out_st = o; o += 2097152;
  p.out_nak = o; o += 4194304;
  p.out_nav = o; o += 4194304;
  p.out_gk = o; o += 2097152;
  p.out_gv = o;
  char* w = (char*)d_ws; size_t off = 0;
  auto take = [&](size_t bytes) { char* r = w + off; off += al256(bytes); return r; };
  p.bar = (unsigned*)take(16384);
  p.wq = p.bar + 3584;
  p.modp = (float*)take((size_t)4 * 32 * 3 * 6144 * 4);
  p.mod = (float*)take((size_t)4 * 3 * 6144 * 4);
  p.winT = (u16*)take((size_t)4 * DIN * DM * 2);
  p.woutT = (u16*)take((size_t)4 * DM * DM * 2);
  p.wfiT = (u16*)take((size_t)4 * 2 * DFF * DM * 2);
  p.wfoT = (u16*)take((size_t)4 * DM * DFF * 2);
  p.X = (float*)take((size_t)NTOK * DM * 4);
  p.PROJ = (float*)take((size_t)NTOK * DIN * 4);
  p.X1 = p.PROJ;
  p.Y = p.PROJ + (size_t)NTOK * DM;
  p.SC = (float*)take((size_t)NTOK * 4 * 9 * 64 * 4);
  p.ACT = (u16*)p.SC;
  p.G = (float*)take((size_t)NTOK * 256 * 4);
  p.BV = (float*)take((size_t)NTOK * 256 * 4);
  p.OF = (float*)take((size_t)NTOK * 256 * 4);
  p.OB = (float*)take((size_t)NTOK * 256 * 4);
  p.A = (u16*)take((size_t)NTOK * DM * 2);
  p.MIX = (u16*)take((size_t)NTOK * DM * 2);
  p.QNc = (u16*)take((size_t)NCTX * 256 * 2);
  p.KNc = (u16*)take((size_t)NCTX * 256 * 2);
  p.VNtc = (u16*)take((size_t)NCTX * 256 * 2);
  p.QGc = (u16*)take((size_t)NCTX * 512 * 2);
  p.KGc = (u16*)take((size_t)NCTX * 128 * 2);
  p.VGtc = (u16*)take((size_t)NCTX * 128 * 2);
  p.QNl = (u16*)take((size_t)2048 * 256 * 2);
  p.KNl = (u16*)take((size_t)4 * 2 * 1536 * 256 * 2);
  p.VNtl = (u16*)take((size_t)4 * 2 * 1536 * 256 * 2);
  p.QGl = (u16*)take((size_t)2048 * 512 * 2);
  p.KGl = (u16*)take((size_t)4 * 2 * 1536 * 128 * 2);
  p.VGtl = (u16*)take((size_t)4 * 2 * 1536 * 128 * 2);
  p.loraT = (u16*)take((size_t)4 * 98304 * 2);
  p.rope = (float*)take((size_t)64 * 16 * 2 * 4);
  if (off > ws_size) { fprintf(stderr, "workspace too small: need %zu have %zu\n", off, ws_size); return; }

  (void)hipMemsetAsync(p.bar, 0, 16384, stream);
#if MEGA
  static int grid_blocks = 0;
  if (!grid_blocks) {
    int dev = 0, cus = 0, per_cu = 0;
    hipGetDevice(&dev);
    hipDeviceGetAttribute(&cus, hipDeviceAttributeMultiprocessorCount, dev);
    hipOccupancyMaxActiveBlocksPerMultiprocessor(&per_cu, fwd_kernel, 256, 0);
    if (per_cu > 2) per_cu = 2;
    if (per_cu < 1) per_cu = 1;
    grid_blocks = cus * per_cu;
  }
  int ph0 = 0, ph1 = NPH, ub = 1;
  void* args[] = {&p, &ph0, &ph1, &ub};
  hipError_t e = hipLaunchCooperativeKernel((void*)fwd_kernel, dim3(grid_blocks), dim3(256), args, 0, stream);
  if (e != hipSuccess) fprintf(stderr, "cooperative launch failed: %s (grid %d)\n", hipGetErrorString(e), grid_blocks);
#else
  for (int ph = 0; ph < NPH; ++ph) fwd_kernel<<<512, 256, 0, stream>>>(p, ph, ph + 1, 0);
#endif
}
```

```cpp
#include <hip/hip_runtime.h>
#include <hip/hip_cooperative_groups.h>
#include <cstdio>
#include <cstdint>
#include <cstring>
namespace cg = cooperative_groups;

#ifndef REPMASK
#define REPMASK 0
#endif
#ifndef REPSLOT
#define REPSLOT -1
#endif
#ifndef PREPVAR
#define PREPVAR 0
#endif
#ifndef SCANVAR
#define SCANVAR 0
#endif
#ifndef REPVAR
#define REPVAR 0
#endif
#ifndef MEGA
#define MEGA 1
#endif

typedef unsigned short u16;
using bf16x8 = __attribute__((ext_vector_type(8))) short;
using f32x4 = __attribute__((ext_vector_type(4))) float;
using v2f = __attribute__((ext_vector_type(2))) float;

#define NTOK 6144
#define NCTX 4096
#define DM 1024
#define DIN 2688
#define DFF 2816
#define NPH 39
#define ALPHA 1.681792830507429f
#define LOG2E 1.4426950408889634f
#define QSCALE (0.125f * LOG2E)

struct Params {
  const float* in[33];
  float *out_yp, *out_ys, *out_st, *out_nak, *out_nav, *out_gk, *out_gv;
  unsigned *bar, *wq;
  float *modp, *mod;
  u16 *winT, *woutT, *wfiT, *wfoT;
  float *X, *X1, *Y, *PROJ, *SC, *G, *BV, *OF, *OB;
  u16 *A, *MIX, *ACT;
  u16 *QNc, *KNc, *VNtc, *QGc, *KGc, *VGtc;
  u16 *QNl, *KNl, *VNtl, *QGl, *KGl, *VGtl;
  u16* loraT; float* rope;
  int never; int pad;
};

__device__ __forceinline__ u16 f2bf(float f) {
  unsigned u = __float_as_uint(f);
  u += 0x7FFFu + ((u >> 16) & 1u);
  return (u16)(u >> 16);
}
__device__ __forceinline__ unsigned pack2(float a, float b) { return (unsigned)f2bf(a) | ((unsigned)f2bf(b) << 16); }
template <int CTRL> __device__ __forceinline__ float dpp_mov(float v) {
  return __int_as_float(__builtin_amdgcn_update_dpp(0, __float_as_int(v), CTRL, 0xF, 0xF, false));
}
__device__ __forceinline__ float reduce16(float v) {
  v += dpp_mov<0xB1>(v);
  v += dpp_mov<0x4E>(v);
  v += dpp_mov<0x141>(v);
  v += dpp_mov<0x140>(v);
  return v;
}
__device__ __forceinline__ float wave_sum(float v) {
  v = reduce16(v);
  v += __shfl_xor(v, 16);
  v += __shfl_xor(v, 32);
  return v;
}
__device__ __forceinline__ float sigmoidf_(float x) { return 1.f / (1.f + __expf(-x)); }
__device__ __forceinline__ float siluf_(float x) { return x / (1.f + __expf(-x)); }
__device__ __forceinline__ int modrow_of(int tok) { return tok < NCTX ? 0 : 1 + ((tok - NCTX) >> 10); }

#define XB_TMO      128
#define XB_XCNT(j)  (256  + 64 * (j))
#define XB_XSUB(j)  (1280 + 64 * (j))
#define XB_XGEN(j)  (2304 + 64 * (j))
#define XB_TOP      3328
#define XB_TOPGEN   3392
#define XCD_BAR_WORDS 3456
#define XB_SPIN_CAP (1u << 22)
#define LAS __attribute__((address_space(3)))
__device__ __forceinline__ unsigned xb_ld(unsigned* p) { return __hip_atomic_load(p, __ATOMIC_RELAXED, __HIP_MEMORY_SCOPE_AGENT); }
__device__ __forceinline__ unsigned xb_add(unsigned* p, unsigned v) { return __hip_atomic_fetch_add(p, v, __ATOMIC_RELAXED, __HIP_MEMORY_SCOPE_AGENT); }
__device__ __forceinline__ unsigned xb_xcc_id() { return (unsigned)__builtin_amdgcn_s_getreg((3 << 11) | 20) & 0xFu; }
#define XB_SPIN(cond, bar) do { unsigned _sp = 0; while (cond) { __builtin_amdgcn_s_sleep(1); \
    if ((++_sp & 255u) == 0u) { if (xb_ld(&(bar)[XB_TMO])) break; if (_sp > XB_SPIN_CAP) { atomicAdd(&(bar)[XB_TMO], 1u); break; } } } } while (0)
struct XcdBarrier { unsigned* bar; unsigned x; volatile LAS unsigned* st; };
__device__ __forceinline__ XcdBarrier xcd_barrier_post(unsigned* bar, volatile LAS unsigned* st) {
  XcdBarrier b; b.bar = bar; b.x = xb_xcc_id(); b.st = st;
  if (threadIdx.x == 0) (void)xb_add(&bar[XB_XCNT(b.x)], 1u);
  return b;
}
__device__ __forceinline__ void xcd_barrier_complete(unsigned* bar, unsigned x, unsigned& nloc, unsigned& nx) {
  const unsigned G = gridDim.x * gridDim.y * gridDim.z;
  unsigned sum, cnt, mine, sp = 0u;
  for (;;) {
    sum = 0u; cnt = 0u; mine = 0u;
#pragma unroll
    for (unsigned j = 0; j < 16; ++j) { const unsigned c = xb_ld(&bar[XB_XCNT(j)]); sum += c; cnt += (c > 0u) ? 1u : 0u; mine = (j == x) ? c : mine; }
    if (sum == G) break;
    __builtin_amdgcn_s_sleep(1);
    if ((++sp & 255u) == 0u) { if (xb_ld(&bar[XB_TMO])) break; if (sp > XB_SPIN_CAP) { atomicAdd(&bar[XB_TMO], 1u); break; } }
  }
  nloc = mine > 0u ? mine : 1u; nx = cnt > 0u ? cnt : 1u;
}
__device__ __forceinline__ void xcd_barrier(const XcdBarrier& b) {
  asm volatile("s_waitcnt vmcnt(0)" ::: "memory");
  __syncthreads();
  if (threadIdx.x == 0) {
    unsigned* bar = b.bar;
    asm volatile("" : "+s"(bar));
    __builtin_amdgcn_s_waitcnt(0);
    unsigned nloc = b.st[0], nx = b.st[1];
    if (nloc == 0u) { xcd_barrier_complete(bar, b.x, nloc, nx); b.st[0] = nloc; b.st[1] = nx; }
    const unsigned old = xb_add(&bar[XB_XSUB(b.x)], 1u);
    const unsigned gen = old / nloc;
    if (old + 1u == (gen + 1u) * nloc) {
      __builtin_amdgcn_fence(__ATOMIC_RELEASE, "agent");
      asm volatile("s_waitcnt vmcnt(0)" ::: "memory");
      const unsigned og = xb_add(&bar[XB_TOP], 1u);
      const unsigned tg = og / nx;
      if (og + 1u == (tg + 1u) * nx) xb_add(&bar[XB_TOPGEN], 1u);
      else XB_SPIN(xb_ld(&bar[XB_TOPGEN]) == tg, bar);
      __builtin_amdgcn_fence(__ATOMIC_ACQUIRE, "agent");
      xb_add(&bar[XB_XGEN(b.x)], 1u);
      asm volatile("s_waitcnt vmcnt(0)" ::: "memory");
    } else {
      XB_SPIN(xb_ld(&bar[XB_XGEN(b.x)]) == gen, bar);
      __builtin_amdgcn_fence(__ATOMIC_ACQUIRE, "agent");
      asm volatile("s_waitcnt vmcnt(0)" ::: "memory");
    }
  }
  __syncthreads();
}

__device__ __forceinline__ int lds_byte32(int r, int c) {
  const int ob = (r & 15) * 64 + c * 2;
  return (r >> 4) * 1024 + (ob ^ (((ob >> 9) & 1) << 5));
}
__device__ __forceinline__ void stage_rc32(int b, int& R, int& C) {
  const int sb = b & 1023, swz = sb ^ (((sb >> 9) & 1) << 5);
  R = (b >> 10) * 16 + (swz >> 6); C = (swz & 63) >> 1;
}
template <int ROWS>
__device__ __forceinline__ void stage_tile32(const u16* __restrict__ g, int ld, char* lds, int tidx) {
#pragma unroll
  for (int i = 0; i < (ROWS * 64 + 4095) / 4096; ++i) {
    const int b = tidx * 16 + i * 4096;
    if ((i + 1) * 4096 <= ROWS * 64 || tidx < (ROWS * 64 - i * 4096) / 16) {
      int R, C; stage_rc32(b, R, C);
      __builtin_amdgcn_global_load_lds((const unsigned*)(g + (size_t)R * ld + C), (unsigned LAS*)(lds + b), 16, 0, 0);
    }
  }
}
template <int N> __device__ __forceinline__ void wait_vmcnt() {
  if (N == 0) asm volatile("s_waitcnt vmcnt(0)" ::: "memory");
  else if (N == 3) asm volatile("s_waitcnt vmcnt(3)" ::: "memory");
  else if (N == 4) asm volatile("s_waitcnt vmcnt(4)" ::: "memory");
  else if (N == 5) asm volatile("s_waitcnt vmcnt(5)" ::: "memory");
  else if (N == 6) asm volatile("s_waitcnt vmcnt(6)" ::: "memory");
  else if (N == 8) asm volatile("s_waitcnt vmcnt(8)" ::: "memory");
  else if (N == 9) asm volatile("s_waitcnt vmcnt(9)" ::: "memory");
  else if (N == 10) asm volatile("s_waitcnt vmcnt(10)" ::: "memory");
  else if (N == 12) asm volatile("s_waitcnt vmcnt(12)" ::: "memory");
  else asm volatile("s_waitcnt vmcnt(0)" ::: "memory");
}

enum { EPI_PROJ = 0, EPI_OUT = 1, EPI_FFI = 2, EPI_FFO = 3 };

template <int EPI, int BM, int NST>
__device__ __forceinline__ void gemm_phase(const Params& p, int layer, const u16* __restrict__ A, const u16* __restrict__ Bt,
                                           int N, int K, char* smem, int bid, int nblk, int tidx) {
  constexpr int MF = BM / 32;
  const int tid = tidx, lane = tid & 63, wid = tid >> 6, wr = wid >> 1, wc = wid & 1, fr = lane & 15, fq = lane >> 4;
  const int nM = NTOK / BM, nN = N / 128, ntiles = nM * nN, nk = K / 32;
  constexpr int SB = (BM + 128) * 64;
  constexpr int LA = (BM * 64) / 4096;
  const bool extraA = (BM == 96) && (wid < 2);
  for (int tile = bid; tile < ntiles; tile += nblk) {
    const int pm = tile % nM, pn = tile / nM, m0 = pm * BM, n0 = pn * 128;
    f32x4 acc[MF][4];
#pragma unroll
    for (int m = 0; m < MF; ++m)
#pragma unroll
      for (int n = 0; n < 4; ++n) acc[m][n] = (f32x4){0.f, 0.f, 0.f, 0.f};
    const u16* Ag = A + (size_t)m0 * K;
    const u16* Bg = Bt + (size_t)n0 * K;
#pragma unroll
    for (int s_ = 0; s_ < NST - 1; ++s_) {
      stage_tile32<BM>(Ag + s_ * 32, K, smem + s_ * SB, tidx);
      stage_tile32<128>(Bg + s_ * 32, K, smem + s_ * SB + BM * 64, tidx);
    }
    int slot = 0, pslot = NST - 1;
    for (int kt = 0; kt < nk; ++kt) {
      if (kt + NST - 2 < nk) {
        if (BM == 96) { if (extraA) wait_vmcnt<(NST - 2) * 4>(); else wait_vmcnt<(NST - 2) * 3>(); }
        else wait_vmcnt<(NST - 2) * (LA + 2)>();
      } else {
        asm volatile("s_waitcnt vmcnt(0)" ::: "memory");
      }
      __builtin_amdgcn_s_barrier();
      if (kt + NST - 1 < nk) {
        char* nb = smem + pslot * SB;
        stage_tile32<BM>(Ag + (kt + NST - 1) * 32, K, nb, tidx);
        stage_tile32<128>(Bg + (kt + NST - 1) * 32, K, nb + BM * 64, tidx);
      }
      const char* sa = smem + slot * SB;
      const char* sb = sa + BM * 64;
      slot = (slot + 1 == NST) ? 0 : slot + 1;
      pslot = (pslot + 1 == NST) ? 0 : pslot + 1;
      bf16x8 af[MF], bfr[4];
#pragma unroll
      for (int m = 0; m < MF; ++m) af[m] = *reinterpret_cast<const bf16x8*>(sa + lds_byte32(wr * (BM / 2) + m * 16 + fr, fq * 8));
#pragma unroll
      for (int n = 0; n < 4; ++n) bfr[n] = *reinterpret_cast<const bf16x8*>(sb + lds_byte32(wc * 64 + n * 16 + fr, fq * 8));
#pragma unroll
      for (int m = 0; m < MF; ++m)
#pragma unroll
        for (int n = 0; n < 4; ++n) acc[m][n] = __builtin_amdgcn_mfma_f32_16x16x32_bf16(bfr[n], af[m], acc[m][n], 0, 0, 0);
    }
#pragma unroll
    for (int m = 0; m < MF; ++m) {
      const int row = m0 + wr * (BM / 2) + m * 16 + fr;
      if (EPI == EPI_PROJ) {
#pragma unroll
        for (int n = 0; n < 4; ++n) {
          const int col = n0 + wc * 64 + n * 16 + 4 * fq;
          *reinterpret_cast<float4*>(p.PROJ + (size_t)row * DIN + col) = make_float4(acc[m][n][0], acc[m][n][1], acc[m][n][2], acc[m][n][3]);
        }
      } else if (EPI == EPI_OUT || EPI == EPI_FFO) {
        const float* res = (EPI == EPI_OUT) ? p.X : p.X1;
        const float* gate = p.mod + ((size_t)(layer * 3 + modrow_of(row)) * 6 + (EPI == EPI_OUT ? 2 : 5)) * 1024;
#pragma unroll
        for (int n = 0; n < 4; ++n) {
          const int col = n0 + wc * 64 + n * 16 + 4 * fq;
          const float4 xr = *reinterpret_cast<const float4*>(res + (size_t)row * DM + col);
          const float4 gt = *reinterpret_cast<const float4*>(gate + col);
          float4 y;
          y.x = ALPHA * xr.x + gt.x * acc[m][n][0];
          y.y = ALPHA * xr.y + gt.y * acc[m][n][1];
          y.z = ALPHA * xr.z + gt.z * acc[m][n][2];
          y.w = ALPHA * xr.w + gt.w * acc[m][n][3];
          *reinterpret_cast<float4*>(p.Y + (size_t)row * DM + col) = y;
        }
      } else {
#pragma unroll
        for (int n2 = 0; n2 < 2; ++n2) {
          const int j0 = ((n0 + wc * 64) / 32 + n2) * 16 + 4 * fq;
          float a[4];
#pragma unroll
          for (int r = 0; r < 4; ++r) a[r] = siluf_(acc[m][2 * n2][r]) * acc[m][2 * n2 + 1][r];
          uint2 pk; pk.x = pack2(a[0], a[1]); pk.y = pack2(a[2], a[3]);
          *reinterpret_cast<uint2*>(p.ACT + (size_t)row * DFF + j0) = pk;
        }
      }
    }
    asm volatile("s_waitcnt lgkmcnt(0)" ::: "memory");
    __builtin_amdgcn_s_barrier();
  }
}

__device__ __forceinline__ int kf_off(int t, int d) { return (t >> 4) * 1024 + (d >> 5) * 512 + ((d & 31) >> 3) * 128 + (t & 15) * 8 + (d & 7); }
__device__ __forceinline__ int vf_off(int t, int d) { return (t >> 5) * 2048 + (d >> 4) * 512 + (((t & 15) >> 2) * 16 + (d & 15)) * 8 + ((t >> 4) & 1) * 4 + (t & 3); }
__device__ __forceinline__ void pack44_store(u16* base, int t0, int d, const float* v) {
  uint2 a, b; a.x = pack2(v[0], v[1]); a.y = pack2(v[2], v[3]); b.x = pack2(v[4], v[5]); b.y = pack2(v[6], v[7]);
  *reinterpret_cast<uint2*>(base + vf_off(t0, d)) = a;
  *reinterpret_cast<uint2*>(base + vf_off(t0 + 4, d)) = b;
}
__device__ __forceinline__ void pack8_store(u16* dst, const float* v) {
  uint4 pk; pk.x = pack2(v[0], v[1]); pk.y = pack2(v[2], v[3]); pk.z = pack2(v[4], v[5]); pk.w = pack2(v[6], v[7]);
  *reinterpret_cast<uint4*>(dst) = pk;
}

__device__ void setup_phase(const Params& p, char* smem, int bid, int nblk, int tidx) {
  const int tid = tidx;
  const int NI = 768 + 512 + 13;
  for (int it = bid; it < NI; it += nblk) {
    if (it < 768) {
      const int l = it / 192, nc = (it / 32) % 6, kc = it % 32;
      const int col = nc * 1024 + tid * 4;
      const float* wm = p.in[9] + (size_t)l * 1024 * 6144;
      float4 a0 = make_float4(0, 0, 0, 0), a1 = a0, a2 = a0;
      for (int k8 = 0; k8 < 32; k8 += 8) {
        float4 w[8];
#pragma unroll
        for (int u = 0; u < 8; ++u) w[u] = *reinterpret_cast<const float4*>(wm + (size_t)(kc * 32 + k8 + u) * 6144 + col);
#pragma unroll
        for (int u = 0; u < 8; ++u) {
          const int k = kc * 32 + k8 + u;
          const float s0 = siluf_(p.in[8][k]), s1 = siluf_(p.in[7][k]), s2 = siluf_(p.in[7][1024 + k]);
          a0.x += s0 * w[u].x; a0.y += s0 * w[u].y; a0.z += s0 * w[u].z; a0.w += s0 * w[u].w;
          a1.x += s1 * w[u].x; a1.y += s1 * w[u].y; a1.z += s1 * w[u].z; a1.w += s1 * w[u].w;
          a2.x += s2 * w[u].x; a2.y += s2 * w[u].y; a2.z += s2 * w[u].z; a2.w += s2 * w[u].w;
        }
      }
      float* dst = p.modp + (size_t)((l * 32 + kc) * 3) * 6144 + col;
      *reinterpret_cast<float4*>(dst) = a0;
      *reinterpret_cast<float4*>(dst + 6144) = a1;
      *reinterpret_cast<float4*>(dst + 2 * 6144) = a2;
    } else if (it < 1280) {
      const int ci = it - 768, b = ci / 256, l = (ci / 64) % 4, tg = ci % 64, t0 = tg * 8;
      {
        const float* ck = p.in[3] + ((size_t)(b * 4 + l) * 512 + t0) * 256 + tid;
        const float* cv = p.in[4] + ((size_t)(b * 4 + l) * 512 + t0) * 256 + tid;
        float v[8];
#pragma unroll
        for (int tt = 0; tt < 8; ++tt) {
          p.KNl[((size_t)((l * 2 + b) * 4 + (tid >> 6))) * 98304 + kf_off(t0 + tt, tid & 63)] = f2bf(ck[tt * 256]);
          v[tt] = cv[tt * 256];
        }
        pack44_store(p.VNtl + ((size_t)((l * 2 + b) * 4 + (tid >> 6))) * 98304, t0, tid & 63, v);
      }
      if (tid < 128) {
        const float* ck = p.in[5] + ((size_t)(b * 4 + l) * 512 + t0) * 128 + tid;
#pragma unroll
        for (int tt = 0; tt < 8; ++tt) p.KGl[((size_t)((l * 2 + b) * 2 + (tid >> 6))) * 98304 + kf_off(t0 + tt, tid & 63)] = f2bf(ck[tt * 128]);
      } else {
        const int c = tid - 128;
        const float* cv = p.in[6] + ((size_t)(b * 4 + l) * 512 + t0) * 128 + c;
        float v[8];
#pragma unroll
        for (int tt = 0; tt < 8; ++tt) v[tt] = cv[tt * 128];
        pack44_store(p.VGtl + ((size_t)((l * 2 + b) * 2 + (c >> 6))) * 98304, t0, c & 63, v);
      }
    } else {
      const int li = it - (768 + 512);
      if (li == 12) {
        for (int idx = tid; idx < 1024; idx += 256) {
          const int pos = idx >> 4, fi = idx & 15;
          const float ang = (float)pos * exp2f(-(float)fi * (13.287712379549449f / 16.f));
          p.rope[idx * 2] = cosf(ang); p.rope[idx * 2 + 1] = sinf(ang);
        }
      } else {
        const int l = li / 3, m = li % 3;
        u16* dst = p.loraT + (size_t)l * 98304 + m * 32768;
        if (m < 2) {
          const float* src = p.in[m == 0 ? 14 : 16] + (size_t)l * 32768;
          for (int i0 = tid; i0 < 32768; i0 += 256 * 16) {
            float v[16];
#pragma unroll
            for (int u = 0; u < 16; ++u) { const int idx = i0 + 256 * u; const int d = idx >> 14, cch = (idx >> 6) & 255, r = idx & 63; v[u] = src[(d * 64 + r) * 256 + cch]; }
#pragma unroll
            for (int u = 0; u < 16; ++u) dst[i0 + 256 * u] = f2bf(v[u]);
          }
        } else {
          const float* src = p.in[17] + (size_t)l * 32768;
          for (int i0 = tid; i0 < 32768; i0 += 256 * 16) {
            float v[16];
#pragma unroll
            for (int u = 0; u < 16; ++u) { const int idx = i0 + 256 * u; const int cch = idx >> 7, j = idx & 127; v[u] = src[j * 256 + cch]; }
#pragma unroll
            for (int u = 0; u < 16; ++u) dst[i0 + 256 * u] = f2bf(v[u]);
          }
        }
      }
    }
  }
  {
    float* tile = reinterpret_cast<float*>(smem);
    const int NT = 4 * 3040;
    float4 cur0, cur1, cur2, cur3;
    const float* src; u16* dst; int K, N, mat, k0, n0;
#define TR_DECODE(TR) { const int l_ = (TR) / 3040; int r_ = (TR) % 3040; int kt_, nt_; \
      if (r_ < 672) { mat = 0; K = 1024; N = 2688; src = p.in[11] + (size_t)l_ * K * N; dst = p.winT + (size_t)l_ * N * K; kt_ = r_ / 42; nt_ = r_ % 42; } \
      else if (r_ < 928) { r_ -= 672; mat = 1; K = 1024; N = 1024; src = p.in[26] + (size_t)l_ * K * N; dst = p.woutT + (size_t)l_ * N * K; kt_ = r_ / 16; nt_ = r_ % 16; } \
      else if (r_ < 2336) { r_ -= 928; mat = 2; K = 1024; N = 5632; src = p.in[29] + (size_t)l_ * K * N; dst = p.wfiT + (size_t)l_ * N * K; kt_ = r_ / 88; nt_ = r_ % 88; } \
      else { r_ -= 2336; mat = 3; K = 2816; N = 1024; src = p.in[30] + (size_t)l_ * K * N; dst = p.wfoT + (size_t)l_ * N * K; kt_ = r_ / 16; nt_ = r_ % 16; } \
      k0 = kt_ * 64; n0 = nt_ * 64; }
#define TR_LOAD(V, I) V = *reinterpret_cast<const float4*>(src + (size_t)(k0 + (tid >> 4) + 16 * (I)) * N + n0 + (tid & 15) * 4);
#define TR_PUT(V, I) { const int kr_ = (tid >> 4) + 16 * (I), c4_ = (tid & 15) * 4; \
      tile[kr_ * 65 + c4_ + 0] = V.x; tile[kr_ * 65 + c4_ + 1] = V.y; tile[kr_ * 65 + c4_ + 2] = V.z; tile[kr_ * 65 + c4_ + 3] = V.w; }
    int tr = bid;
    if (tr < NT) { TR_DECODE(tr) TR_LOAD(cur0, 0) TR_LOAD(cur1, 1) TR_LOAD(cur2, 2) TR_LOAD(cur3, 3) }
    for (; tr < NT; tr += nblk) {
      TR_PUT(cur0, 0) TR_PUT(cur1, 1) TR_PUT(cur2, 2) TR_PUT(cur3, 3)
      if (tr + nblk < NT) { TR_DECODE(tr + nblk) TR_LOAD(cur0, 0) TR_LOAD(cur1, 1) TR_LOAD(cur2, 2) TR_LOAD(cur3, 3) }
      TR_DECODE(tr)
      __syncthreads();
#pragma unroll
      for (int i = 0; i < 2; ++i) {
        const int idx = tid + 256 * i, nl = idx >> 3, kc = idx & 7;
        int n = n0 + nl;
        if (mat == 2) { const int isup = n >= DFF ? 1 : 0; const int j = n - isup * DFF; n = (j >> 4) * 32 + isup * 16 + (j & 15); }
        float v[8];
#pragma unroll
        for (int jj = 0; jj < 8; ++jj) v[jj] = tile[(kc * 8 + jj) * 65 + nl];
        pack8_store(dst + (size_t)n * K + k0 + kc * 8, v);
      }
      __syncthreads();
    }
#undef TR_DECODE
#undef TR_LOAD
#undef TR_PUT
  }
}

__device__ void modreduce_phase(const Params& p, int bid, int nblk, int tidx) {
  for (int idx = bid * 256 + tidx; idx < 18432; idx += nblk * 256) {
    const int l = idx / 4608, rem = idx % 4608, mr = rem / 1536, c4 = (rem % 1536) * 4;
    float4 a = *reinterpret_cast<const float4*>(p.in[10] + (size_t)l * 6144 + c4);
    for (int k8 = 0; k8 < 32; k8 += 8) {
      float4 v[8];
#pragma unroll
      for (int u = 0; u < 8; ++u) v[u] = *reinterpret_cast<const float4*>(p.modp + (size_t)((l * 32 + k8 + u) * 3 + mr) * 6144 + c4);
#pragma unroll
      for (int u = 0; u < 8; ++u) { a.x += v[u].x; a.y += v[u].y; a.z += v[u].z; a.w += v[u].w; }
    }
    *reinterpret_cast<float4*>(p.mod + (size_t)(l * 3 + mr) * 6144 + c4) = a;
  }
}

template <int MODE>
__device__ void ln_phase(const Params& p, int layer, int bid, int nblk, int tidx) {
  const int lane = tidx & 63, wid = tidx >> 6;
  const bool fin = (MODE == 2 && layer == 3);
  const float* lw = (MODE == 1 ? p.in[27] : p.in[31]) + (size_t)layer * DM;
  const float* lb = (MODE == 1 ? p.in[28] : p.in[32]) + (size_t)layer * DM;
  const int ml = (MODE == 2) ? (layer + 1 < 4 ? layer + 1 : 3) : layer;
  const int which = (MODE == 1) ? 3 : 0;
#define LN_SRC(ROW) (MODE == 0 ? ((ROW) < NCTX ? p.in[0] + (size_t)(ROW) * DM : p.in[1] + (size_t)((ROW) - NCTX) * DM) : p.Y + (size_t)(ROW) * DM)
  float4 nv0, nv1, nv2, nv3;
  int it = bid;
  if (it < NTOK / 4) {
    const float4* s4 = reinterpret_cast<const float4*>(LN_SRC(it * 4 + wid));
    nv0 = s4[lane]; nv1 = s4[lane + 64]; nv2 = s4[lane + 128]; nv3 = s4[lane + 192];
  }
  for (; it < NTOK / 4; it += nblk) {
    const int row = it * 4 + wid;
    float4 v[4] = {nv0, nv1, nv2, nv3};
    if (it + nblk < NTOK / 4) {
      const float4* s4 = reinterpret_cast<const float4*>(LN_SRC((it + nblk) * 4 + wid));
      nv0 = s4[lane]; nv1 = s4[lane + 64]; nv2 = s4[lane + 128]; nv3 = s4[lane + 192];
    }
    float4 w4[4], b4[4], s4v[4], c4v[4];
    const float* sh = p.mod + ((size_t)(ml * 3 + modrow_of(row)) * 6 + which) * 1024;
    const float* sc = sh + 1024;
#pragma unroll
    for (int i = 0; i < 4; ++i) {
      if (MODE != 0) { w4[i] = reinterpret_cast<const float4*>(lw)[lane + 64 * i]; b4[i] = reinterpret_cast<const float4*>(lb)[lane + 64 * i]; }
      if (!fin) { s4v[i] = reinterpret_cast<const float4*>(sh)[lane + 64 * i]; c4v[i] = reinterpret_cast<const float4*>(sc)[lane + 64 * i]; }
    }
    if (MODE != 0) {
      float s = 0.f;
#pragma unroll
      for (int i = 0; i < 4; ++i) s += v[i].x + v[i].y + v[i].z + v[i].w;
      const float mu = wave_sum(s) * (1.f / 1024.f);
      float q = 0.f;
#pragma unroll
      for (int i = 0; i < 4; ++i) {
        v[i].x -= mu; v[i].y -= mu; v[i].z -= mu; v[i].w -= mu;
        q += v[i].x * v[i].x + v[i].y * v[i].y + v[i].z * v[i].z + v[i].w * v[i].w;
      }
      const float rstd = rsqrtf(wave_sum(q) * (1.f / 1024.f) + 1e-5f);
#pragma unroll
      for (int i = 0; i < 4; ++i) {
        v[i].x = v[i].x * rstd * w4[i].x + b4[i].x; v[i].y = v[i].y * rstd * w4[i].y + b4[i].y;
        v[i].z = v[i].z * rstd * w4[i].z + b4[i].z; v[i].w = v[i].w * rstd * w4[i].w + b4[i].w;
      }
    }
    float* xdst = (MODE == 1 ? p.X1 : p.X) + (size_t)row * DM;
#pragma unroll
    for (int i = 0; i < 4; ++i) reinterpret_cast<float4*>(xdst)[lane + 64 * i] = v[i];
    if (fin) {
      float* o = row < NCTX ? p.out_yp + (size_t)row * DM : p.out_ys + (size_t)(row - NCTX) * DM;
#pragma unroll
      for (int i = 0; i < 4; ++i) reinterpret_cast<float4*>(o)[lane + 64 * i] = v[i];
    } else {
      u16* adst = p.A + (size_t)row * DM;
#pragma unroll
      for (int i = 0; i < 4; ++i) {
        uint2 pk;
        pk.x = pack2(v[i].x * (1.f + c4v[i].x) + s4v[i].x, v[i].y * (1.f + c4v[i].y) + s4v[i].y);
        pk.y = pack2(v[i].z * (1.f + c4v[i].z) + s4v[i].z, v[i].w * (1.f + c4v[i].w) + s4v[i].w);
        reinterpret_cast<uint2*>(adst)[lane + 64 * i] = pk;
      }
    }
  }
#undef LN_SRC
}

#define FLD 772
#define LLD 392
__device__ void prep_phase(const Params& p, int layer, char* smem, int bid, int nblk, int tidx, int rep) {
  const int pv_ = rep ? PREPVAR : 0;
  float* F = reinterpret_cast<float*>(smem);
  u16* LIb = reinterpret_cast<u16*>(smem + 16 * FLD * 4);
  const float* cw = p.in[12] + (size_t)layer * 3 * 1152;
  const u16* LW = p.loraT + (size_t)layer * 98304;
  for (int it2 = bid; it2 < 2 * (NTOK / 16); it2 += nblk) {
    const bool doR = it2 < NTOK / 16;
    const int it = doR ? it2 : it2 - NTOK / 16;
    int tid = tidx;
    asm volatile("" : "+v"(tid));
    const int lane = tid & 63, wid = tid >> 6, fr = lane & 15, fq = lane >> 4;
    const int tok0 = it * 16;
    int b, tpos0, L;
    const bool isctx = tok0 < NCTX;
    if (isctx) { b = tok0 >> 8; tpos0 = tok0 & 255; L = 256; }
    else { const int tl = tok0 - NCTX; b = tl >> 10; tpos0 = tl & 1023; L = 1024; }
    if (doR) {
    {
      float* PRM = reinterpret_cast<float*>(smem + 61952);
      PRM[tid] = p.in[13][(size_t)layer * 512 + tid]; PRM[256 + tid] = p.in[13][(size_t)layer * 512 + 256 + tid];
      PRM[512 + tid] = p.in[15][(size_t)layer * 512 + tid]; PRM[768 + tid] = p.in[15][(size_t)layer * 512 + 256 + tid];
      PRM[1024 + tid] = p.in[18][(size_t)layer * 256 + tid]; PRM[1280 + tid] = p.in[19][(size_t)layer * 256 + tid]; PRM[1536 + tid] = p.in[20][(size_t)layer * 256 + tid];
    }
#pragma unroll 1
    for (int cg = tid; cg < 288; cg += 256) {
      const int c = cg * 4;
      const float4 w0 = *reinterpret_cast<const float4*>(cw + c);
      const float4 w1 = *reinterpret_cast<const float4*>(cw + 1152 + c);
      const float4 w2 = *reinterpret_cast<const float4*>(cw + 2304 + c);
      const float* pr = p.PROJ + (size_t)tok0 * DIN + c;
      float4 x[18];
#pragma unroll
      for (int i = 0; i < 18; ++i) {
        const int tpos = tpos0 + i - 1;
        x[i] = (tpos >= 0 && tpos < L) ? *reinterpret_cast<const float4*>(pr + (ptrdiff_t)(i - 1) * DIN) : make_float4(0.f, 0.f, 0.f, 0.f);
      }
#pragma unroll
      for (int tt = 0; tt < 16; ++tt) {
        float4 f;
        f.x = w0.x * x[tt].x + w1.x * x[tt + 1].x + w2.x * x[tt + 2].x;
        f.y = w0.y * x[tt].y + w1.y * x[tt + 1].y + w2.y * x[tt + 2].y;
        f.z = w0.z * x[tt].z + w1.z * x[tt + 1].z + w2.z * x[tt + 2].z;
        f.w = w0.w * x[tt].w + w1.w * x[tt + 1].w + w2.w * x[tt + 2].w;
        if (c < 768) { *reinterpret_cast<float4*>(F + tt * FLD + c) = f; }
        else {
          const int cc = c - 768;
          if (cc < 128) { f.x = tanhf(f.x); f.y = tanhf(f.y); f.z = tanhf(f.z); f.w = tanhf(f.w); }
          else if (cc >= 256) { f.x = sigmoidf_(f.x); f.y = sigmoidf_(f.y); f.z = sigmoidf_(f.z); f.w = sigmoidf_(f.w); }
          uint2 pk; pk.x = pack2(f.x, f.y); pk.y = pack2(f.z, f.w);
          *reinterpret_cast<uint2*>(LIb + tt * LLD + cc) = pk;
        }
      }
    }
    __syncthreads();
    f32x4 acc[5][4];
#pragma unroll
    for (int g = 0; g < 5; ++g)
#pragma unroll
      for (int nf = 0; nf < 4; ++nf) acc[g][nf] = (f32x4){0.f, 0.f, 0.f, 0.f};
    if (pv_ != 2 && pv_ != 3) {
#define PB_LOAD(W, GI) { const u16* wt_ = (GI) < 4 ? LW + (size_t)(GI) * 16384 : LW + 65536; const int rs_ = (GI) < 4 ? 64 : 128; const int ko_ = (GI) < 4 ? 0 : ((GI) - 4) * 64; \
      _Pragma("unroll") for (int ks_ = 0; ks_ < 2; ++ks_) _Pragma("unroll") for (int nf_ = 0; nf_ < 4; ++nf_) \
        W[ks_ * 4 + nf_] = *reinterpret_cast<const bf16x8*>(wt_ + (size_t)(64 * wid + 16 * nf_ + fr) * rs_ + ko_ + ks_ * 32 + fq * 8); }
#define PB_MMA(W, GI) { const int ai_ = (GI) < 4 ? (GI) : 4; const int xo_ = (GI) < 4 ? (GI) * 64 : 256 + ((GI) - 4) * 64; \
      _Pragma("unroll") for (int ks_ = 0; ks_ < 2; ++ks_) { \
        const bf16x8 xb_ = *reinterpret_cast<const bf16x8*>(LIb + fr * LLD + xo_ + ks_ * 32 + fq * 8); \
        _Pragma("unroll") for (int nf_ = 0; nf_ < 4; ++nf_) acc[ai_][nf_] = __builtin_amdgcn_mfma_f32_16x16x32_bf16(W[ks_ * 4 + nf_], xb_, acc[ai_][nf_], 0, 0, 0); } \
      __builtin_amdgcn_sched_barrier(0); }
    {
      bf16x8 wA[8], wB[8];
      PB_LOAD(wA, 0)
      PB_LOAD(wB, 1) PB_MMA(wA, 0)
      PB_LOAD(wA, 2) PB_MMA(wB, 1)
      PB_LOAD(wB, 3) PB_MMA(wA, 2)
      PB_LOAD(wA, 4) PB_MMA(wB, 3)
      PB_LOAD(wB, 5) PB_MMA(wA, 4)
      PB_MMA(wB, 5)
    }
#undef PB_LOAD
#undef PB_MMA
    }
    if (pv_ != 2 && pv_ != 3) {
#ifndef NO_C
    const float* PRM = reinterpret_cast<const float*>(smem + 61952);
    {
      const int tok = tok0 + fr;
      float ss = 0.f, bs = 0.f;
#pragma unroll
      for (int nf = 0; nf < 4; ++nf) {
        const int c0 = 64 * wid + 16 * nf + 4 * fq;
        const float4 r4 = *reinterpret_cast<const float4*>(F + fr * FLD + c0);
        const float4 k4 = *reinterpret_cast<const float4*>(F + fr * FLD + 256 + c0);
        const float4 w00 = *reinterpret_cast<const float4*>(PRM + c0);
        const float4 w01 = *reinterpret_cast<const float4*>(PRM + 256 + c0);
        const float4 a00 = *reinterpret_cast<const float4*>(PRM + 512 + c0);
        const float4 a01 = *reinterpret_cast<const float4*>(PRM + 768 + c0);
        const float4 kkw = *reinterpret_cast<const float4*>(PRM + 1024 + c0);
        const float4 kaw = *reinterpret_cast<const float4*>(PRM + 1280 + c0);
        const float4 rkw = *reinterpret_cast<const float4*>(PRM + 1536 + c0);
        const float rr[4] = {r4.x, r4.y, r4.z, r4.w}, kk_[4] = {k4.x, k4.y, k4.z, k4.w};
        const float w0a[4] = {w00.x, w00.y, w00.z, w00.w}, w0b[4] = {w01.x, w01.y, w01.z, w01.w};
        const float a0a[4] = {a00.x, a00.y, a00.z, a00.w}, a0b[4] = {a01.x, a01.y, a01.z, a01.w};
        const float kkw_[4] = {kkw.x, kkw.y, kkw.z, kkw.w}, kaw_[4] = {kaw.x, kaw.y, kaw.z, kaw.w}, rkw_[4] = {rkw.x, rkw.y, rkw.z, rkw.w};
#pragma unroll
        for (int r = 0; r < 4; ++r) {
          {
            const float z = -(w0a[r] + acc[0][nf][r]);
            const float sp = fmaxf(z, 0.f) + log1pf(__expf(-fabsf(z)));
            acc[0][nf][r] = __expf(-__expf(-sp - 0.5f));
          }
          {
            const float z = -(w0b[r] + acc[1][nf][r]);
            const float sp = fmaxf(z, 0.f) + log1pf(__expf(-fabsf(z)));
            acc[1][nf][r] = __expf(-__expf(-sp - 0.5f));
          }
          const float av0 = sigmoidf_(a0a[r] + acc[2][nf][r]);
          const float av1 = sigmoidf_(a0b[r] + acc[3][nf][r]);
          acc[2][nf][r] = av0; acc[3][nf][r] = av1;
          const float k = kk_[r];
          const float kq = k * kkw_[r];
          ss += kq * kq;
          const float kd0 = k * (1.f + (av0 - 1.f) * kaw_[r]);
          const float kd1 = k * (1.f + (av1 - 1.f) * kaw_[r]);
          bs += rr[r] * (kd0 + kd1) * rkw_[r];
        }
        __builtin_amdgcn_sched_barrier(0);
      }
      ss += __shfl_xor(ss, 16); ss += __shfl_xor(ss, 32);
      bs += __shfl_xor(bs, 16); bs += __shfl_xor(bs, 32);
      const float inrm = 1.f / fmaxf(sqrtf(ss), 1e-12f);
#pragma unroll
      for (int nf = 0; nf < 4; ++nf) {
        const int c0 = 64 * wid + 16 * nf + 4 * fq, n0 = 16 * nf + 4 * fq;
        const float4 r4 = *reinterpret_cast<const float4*>(F + fr * FLD + c0);
        const float4 k4 = *reinterpret_cast<const float4*>(F + fr * FLD + 256 + c0);
        const float4 v4 = *reinterpret_cast<const float4*>(F + fr * FLD + 512 + c0);
        const float4 kkw = *reinterpret_cast<const float4*>(PRM + 1024 + c0);
        const float4 kaw = *reinterpret_cast<const float4*>(PRM + 1280 + c0);
        const float kk_[4] = {k4.x, k4.y, k4.z, k4.w}, kkw_[4] = {kkw.x, kkw.y, kkw.z, kkw.w}, kaw_[4] = {kaw.x, kaw.y, kaw.z, kaw.w};
        float* sc = p.SC + ((size_t)(tok * 4 + wid) * 9) * 64 + n0;
        float kn[4], kd0[4], kd1[4];
#pragma unroll
        for (int r = 0; r < 4; ++r) {
          kn[r] = kk_[r] * kkw_[r] * inrm;
          kd0[r] = kk_[r] * (1.f + (acc[2][nf][r] - 1.f) * kaw_[r]);
          kd1[r] = kk_[r] * (1.f + (acc[3][nf][r] - 1.f) * kaw_[r]);
        }
        *reinterpret_cast<float4*>(sc) = r4;
        *reinterpret_cast<float4*>(sc + 64) = make_float4(kn[0], kn[1], kn[2], kn[3]);
        *reinterpret_cast<float4*>(sc + 128) = v4;
        *reinterpret_cast<float4*>(sc + 192) = make_float4(acc[0][nf][0], acc[0][nf][1], acc[0][nf][2], acc[0][nf][3]);
        *reinterpret_cast<float4*>(sc + 256) = make_float4(acc[2][nf][0] * kn[0], acc[2][nf][1] * kn[1], acc[2][nf][2] * kn[2], acc[2][nf][3] * kn[3]);
        *reinterpret_cast<float4*>(sc + 320) = make_float4(kd0[0], kd0[1], kd0[2], kd0[3]);
        *reinterpret_cast<float4*>(sc + 384) = make_float4(acc[1][nf][0], acc[1][nf][1], acc[1][nf][2], acc[1][nf][3]);
        *reinterpret_cast<float4*>(sc + 448) = make_float4(acc[3][nf][0] * kn[0], acc[3][nf][1] * kn[1], acc[3][nf][2] * kn[2], acc[3][nf][3] * kn[3]);
        *reinterpret_cast<float4*>(sc + 512) = make_float4(kd1[0], kd1[1], kd1[2], kd1[3]);
        *reinterpret_cast<float4*>(p.G + (size_t)tok * 256 + c0) = make_float4(acc[4][nf][0], acc[4][nf][1], acc[4][nf][2], acc[4][nf][3]);
        *reinterpret_cast<float4*>(p.BV + (size_t)tok * 256 + c0) = make_float4(bs * v4.x, bs * v4.y, bs * v4.z, bs * v4.w);
        __builtin_amdgcn_sched_barrier(0);
      }
    }
#endif
    }
    }
    if (!doR && pv_ != 1) {
#ifndef NO_D
    {
      const int tok = tid >> 4, g8 = tid & 15, tokg = tok0 + tok, tpos = tpos0 + tok;
      const int tkey = isctx ? tpos : 512 + tpos;
      const float* pr = p.PROJ + (size_t)tokg * DIN;
#pragma unroll
      for (int hh = 0; hh < 2; ++hh) {
        const int g = g8 + 16 * hh, c0 = g * 8, hd = c0 >> 6, d0 = c0 & 63;
        const float4 qa = *reinterpret_cast<const float4*>(pr + 1152 + c0), qb = *reinterpret_cast<const float4*>(pr + 1152 + c0 + 4);
        const float4 ka = *reinterpret_cast<const float4*>(pr + 1408 + c0), kb2 = *reinterpret_cast<const float4*>(pr + 1408 + c0 + 4);
        const float qv[8] = {qa.x * QSCALE, qa.y * QSCALE, qa.z * QSCALE, qa.w * QSCALE, qb.x * QSCALE, qb.y * QSCALE, qb.z * QSCALE, qb.w * QSCALE};
        const float kv[8] = {ka.x, ka.y, ka.z, ka.w, kb2.x, kb2.y, kb2.z, kb2.w};
        if (isctx) {
          float* ok = p.out_nak + ((size_t)(b * 4 + layer) * 256 + tpos) * 256 + c0;
          *reinterpret_cast<float4*>(ok) = ka; *reinterpret_cast<float4*>(ok + 4) = kb2;
          pack8_store(p.QNc + (size_t)tokg * 256 + c0, qv);
          pack8_store(p.KNc + (size_t)(b * 4 + hd) * 16384 + kf_off(tkey, d0), kv);
        } else {
          pack8_store(p.QNl + (size_t)(tokg - NCTX) * 256 + c0, qv);
          pack8_store(p.KNl + ((size_t)((layer * 2 + b) * 4 + hd)) * 98304 + kf_off(tkey, d0), kv);
        }
      }
#pragma unroll
      for (int hh = 0; hh < 5; ++hh) {
        const bool isk = (hh == 4);
        const int g = isk ? g8 : g8 + 16 * hh, d0 = (g & 7) * 8, hd = g >> 3;
        const float* src = pr + (isk ? 2432 : 1920) + g * 8;
        const float4 xa = *reinterpret_cast<const float4*>(src), xb = *reinterpret_cast<const float4*>(src + 4);
        const float* nw = (isk ? p.in[25] : p.in[24]) + (size_t)layer * 64 + d0;
        const float4 na = *reinterpret_cast<const float4*>(nw), nb = *reinterpret_cast<const float4*>(nw + 4);
        float x[8] = {xa.x, xa.y, xa.z, xa.w, xb.x, xb.y, xb.z, xb.w};
        const float nrm[8] = {na.x, na.y, na.z, na.w, nb.x, nb.y, nb.z, nb.w};
        float ss = 0.f;
#pragma unroll
        for (int e = 0; e < 8; ++e) ss += x[e] * x[e];
        ss += dpp_mov<0xB1>(ss); ss += dpp_mov<0x4E>(ss); ss += dpp_mov<0x141>(ss);
        const float rs = rsqrtf(ss * (1.f / 64.f) + 1e-6f);
#pragma unroll
        for (int e = 0; e < 8; ++e) x[e] = x[e] * rs * nrm[e];
        if (isk && isctx) {
          float* ok = p.out_gk + ((size_t)(b * 4 + layer) * 256 + tpos) * 128 + g * 8;
          *reinterpret_cast<float4*>(ok) = make_float4(x[0], x[1], x[2], x[3]);
          *reinterpret_cast<float4*>(ok + 4) = make_float4(x[4], x[5], x[6], x[7]);
        }
        if (!isctx) {
          const int pos = (d0 < 32) ? (tpos >> 6) : (tpos & 63);
          const float4* rt = reinterpret_cast<const float4*>(p.rope + (size_t)(pos * 16 + (d0 & 15)) * 2);
          const float4 r0 = rt[0], r1 = rt[1], r2 = rt[2], r3 = rt[3];
          const float cs[8] = {r0.x, r0.z, r1.x, r1.z, r2.x, r2.z, r3.x, r3.z};
          const float sn[8] = {r0.y, r0.w, r1.y, r1.w, r2.y, r2.w, r3.y, r3.w};
          const float sg = (d0 & 16) ? 1.f : -1.f;
#pragma unroll
          for (int e = 0; e < 8; ++e) { const float pe = dpp_mov<0x4E>(x[e]); x[e] = x[e] * cs[e] + sg * pe * sn[e]; }
        }
        if (!isk) {
#pragma unroll
          for (int e = 0; e < 8; ++e) x[e] *= QSCALE;
          if (isctx) pack8_store(p.QGc + (size_t)tokg * 512 + g * 8, x);
          else pack8_store(p.QGl + (size_t)(tokg - NCTX) * 512 + g * 8, x);
        } else {
          if (isctx) pack8_store(p.KGc + (size_t)(b * 2 + hd) * 16384 + kf_off(tkey, d0), x);
          else pack8_store(p.KGl + ((size_t)((layer * 2 + b) * 2 + hd)) * 98304 + kf_off(tkey, d0), x);
        }
      }
    }
    const int c = tid;
#pragma unroll
    for (int half = 0; half < 2; ++half) {
      float vv[8];
#pragma unroll
      for (int t8 = 0; t8 < 8; ++t8) {
        const int tt = half * 8 + t8, tokn = tok0 + tt;
        const float v = p.PROJ[(size_t)tokn * DIN + 1664 + c];
        vv[t8] = v;
        if (isctx) p.out_nav[((size_t)(b * 4 + layer) * 256 + tpos0 + tt) * 256 + c] = v;
      }
      if (isctx) pack44_store(p.VNtc + (size_t)(b * 4 + (c >> 6)) * 16384, tpos0 + half * 8, c & 63, vv);
      else pack44_store(p.VNtl + ((size_t)((layer * 2 + b) * 4 + (c >> 6))) * 98304, 512 + tpos0 + half * 8, c & 63, vv);
    }
    if (wid >= 2) {
      const int cv = c - 128;
#pragma unroll
      for (int half = 0; half < 2; ++half) {
        float vv[8];
#pragma unroll
        for (int t8 = 0; t8 < 8; ++t8) {
          const int tt = half * 8 + t8, tokn = tok0 + tt;
          const float v = p.PROJ[(size_t)tokn * DIN + 2560 + cv];
          vv[t8] = v;
          if (isctx) p.out_gv[((size_t)(b * 4 + layer) * 256 + tpos0 + tt) * 128 + cv] = v;
        }
        if (isctx) pack44_store(p.VGtc + (size_t)(b * 2 + (cv >> 6)) * 16384, tpos0 + half * 8, cv & 63, vv);
        else pack44_store(p.VGtl + ((size_t)((layer * 2 + b) * 2 + (cv >> 6))) * 98304, 512 + tpos0 + half * 8, cv & 63, vv);
      }
    }
#endif
    }
    __syncthreads();
  }
}

#define ATT_LOAD(KF, VF, CI) { \
    const int ci_ = min((CI), nt - 1); \
    int kb_; \
    if (ci_ < nd) kb_ = ci_ * 32; \
    else { const int e_ = ci_ - nd; const int j_ = (ncc == 2) ? (e_ >> 1) : e_; const int cc_ = cc0 + ((ncc == 2) ? (e_ & 1) : 0); kb_ = 512 + (rb + j_) * 64 + cc_ * 32; } \
    const u16* kp_ = Kb + (size_t)(kb_ >> 4) * 1024 + lane * 8; \
    KF##00 = *reinterpret_cast<const bf16x8*>(kp_); \
    KF##01 = *reinterpret_cast<const bf16x8*>(kp_ + 512); \
    KF##10 = *reinterpret_cast<const bf16x8*>(kp_ + 1024); \
    KF##11 = *reinterpret_cast<const bf16x8*>(kp_ + 1536); \
    const u16* vp_ = Vt + (size_t)(kb_ >> 5) * 2048 + lane * 8; \
    VF##0 = *reinterpret_cast<const bf16x8*>(vp_); \
    VF##1 = *reinterpret_cast<const bf16x8*>(vp_ + 512); \
    VF##2 = *reinterpret_cast<const bf16x8*>(vp_ + 1024); \
    VF##3 = *reinterpret_cast<const bf16x8*>(vp_ + 1536); }

#define ATT_PV(DT, VV) { \
    o[DT][0] *= alpha; o[DT][1] *= alpha; o[DT][2] *= alpha; o[DT][3] *= alpha; \
    o[DT] = __builtin_amdgcn_mfma_f32_16x16x32_bf16(VV, pf.v, o[DT], 0, 0, 0); }

#define ATT_COMPUTE(KF, VF, CI) { \
    const int ci_ = (CI); \
    f32x4 s0 = (f32x4){0.f, 0.f, 0.f, 0.f}, s1 = (f32x4){0.f, 0.f, 0.f, 0.f}; \
    s0 = __builtin_amdgcn_mfma_f32_16x16x32_bf16(KF##00, qf0, s0, 0, 0, 0); \
    s0 = __builtin_amdgcn_mfma_f32_16x16x32_bf16(KF##01, qf1, s0, 0, 0, 0); \
    s1 = __builtin_amdgcn_mfma_f32_16x16x32_bf16(KF##10, qf0, s1, 0, 0, 0); \
    s1 = __builtin_amdgcn_mfma_f32_16x16x32_bf16(KF##11, qf1, s1, 0, 0, 0); \
    float sv[8] = {s0[0], s0[1], s0[2], s0[3], s1[0], s1[1], s1[2], s1[3]}; \
    bool ok[8]; \
    _Pragma("unroll") for (int e = 0; e < 8; ++e) ok[e] = true; \
    if (ci_ >= nd) { \
      const int e_ = ci_ - nd; const int j_ = (ncc == 2) ? (e_ >> 1) : e_; const int cc_ = cc0 + ((ncc == 2) ? (e_ & 1) : 0); \
      const int dr_ = rb + j_ - grow + 7; \
      const int cq = cq0 + fr, c0 = min(max(cq - 8, 0), 48); \
      _Pragma("unroll") for (int e = 0; e < 8; ++e) { \
        const int ck = cc_ * 32 + 16 * (e >> 2) + 4 * fq + (e & 3); \
        ok[e] = (ck >= c0) && (ck < c0 + 16); \
        const int dc = min(max(ck - cq, -15), 15) + 15; \
        const float bias = rpb[dr_ * 31 + dc] * LOG2E; \
        sv[e] = ok[e] ? sv[e] + bias : -1e30f; \
      } \
    } \
    float mx = fmaxf(fmaxf(fmaxf(sv[0], sv[1]), fmaxf(sv[2], sv[3])), fmaxf(fmaxf(sv[4], sv[5]), fmaxf(sv[6], sv[7]))); \
    mx = fmaxf(mx, __shfl_xor(mx, 16)); \
    mx = fmaxf(mx, __shfl_xor(mx, 32)); \
    const float mn = fmaxf(m, mx); \
    const float alpha = exp2f(m - mn); \
    m = mn; \
    float ps = 0.f; \
    _Pragma("unroll") for (int e = 0; e < 8; ++e) { sv[e] = ok[e] ? exp2f(sv[e] - mn) : 0.f; ps += sv[e]; } \
    l = l * alpha + ps; \
    union { bf16x8 v; unsigned u[4]; } pf; \
    pf.u[0] = pack2(sv[0], sv[1]); pf.u[1] = pack2(sv[2], sv[3]); pf.u[2] = pack2(sv[4], sv[5]); pf.u[3] = pack2(sv[6], sv[7]); \
    ATT_PV(0, VF##0) ATT_PV(1, VF##1) ATT_PV(2, VF##2) ATT_PV(3, VF##3) }

__device__ __forceinline__ void attn_wave(const u16* __restrict__ Q, int ldq, const u16* __restrict__ Kb, int ldk,
                                          const u16* __restrict__ Vt, int ldv, int ndense, const bool NA,
                                          const float* __restrict__ rpb, int grow, int cq0,
                                          u16* __restrict__ out, int ldo, int tidx) {
  const int lane = tidx & 63, fr = lane & 15, fq = lane >> 4;
  const bf16x8 qf0 = *reinterpret_cast<const bf16x8*>(Q + (size_t)fr * ldq + fq * 8);
  const bf16x8 qf1 = *reinterpret_cast<const bf16x8*>(Q + (size_t)fr * ldq + 32 + fq * 8);
  f32x4 o[4];
#pragma unroll
  for (int dt = 0; dt < 4; ++dt) o[dt] = (f32x4){0.f, 0.f, 0.f, 0.f};
  float m = -1e30f, l = 0.f;
  const int nd = ndense >> 5;
  const int rb = min(max(grow - 4, 0), 8);
  const int ulo = min(max(cq0 - 8, 0), 48), uhi = min(max(cq0 + 15 - 8, 0), 48) + 16;
  const bool c0ok = ulo < 32, c1ok = uhi > 32;
  const int ncc = (c0ok && c1ok) ? 2 : 1, cc0 = c0ok ? 0 : 1;
  const int nt = nd + (NA ? 8 * ncc : 0);
  bf16x8 ka00, ka01, ka10, ka11, kb00, kb01, kb10, kb11;
  bf16x8 va0, va1, va2, va3, vb0, vb1, vb2, vb3;
  ATT_LOAD(ka, va, 0)
  for (int ci = 0; ci < nt; ci += 2) {
    ATT_LOAD(kb, vb, ci + 1)
    ATT_COMPUTE(ka, va, ci)
    if (ci + 1 < nt) {
      ATT_LOAD(ka, va, ci + 2)
      ATT_COMPUTE(kb, vb, ci + 1)
    }
  }
  l += __shfl_xor(l, 16);
  l += __shfl_xor(l, 32);
  const float il = 1.f / l;
#pragma unroll
  for (int dt = 0; dt < 4; ++dt) {
    uint2 pk; pk.x = pack2(o[dt][0] * il, o[dt][1] * il); pk.y = pack2(o[dt][2] * il, o[dt][3] * il);
    *reinterpret_cast<uint2*>(out + (size_t)fr * ldo + 16 * dt + 4 * fq) = pk;
  }
}

__device__ void scan_item(const Params& p, int layer, char* smem, bool lat, int b, int h, int dir, int qd, int tidx) {
  const int tid = tidx, lane = tid & 63, wid = tid >> 6, rr = lane >> 4, j = lane & 15;
  const int L = lat ? 1024 : 256, seqbase = lat ? NCTX + b * 1024 : b * 256;
  const int rowl = wid * 4 + rr, row = qd * 16 + rowl;
  float* cbuf = reinterpret_cast<float*>(smem);
  float* obuf = cbuf + 2 * 16 * 6 * 64;
  float4 S = make_float4(0.f, 0.f, 0.f, 0.f);
  if (lat) S = *reinterpret_cast<const float4*>(p.in[2] + ((((size_t)(b * 4 + layer) * 2 + dir) * 4 + h) * 64 + row) * 64 + 4 * j);
  v2f S01 = (v2f){S.x, S.y}, S23 = (v2f){S.z, S.w};
  const int nch = L / 16;
  float* odst = dir == 0 ? p.OF : p.OB;
  float4 pre0, pre1, pre2, pre3, pre4, pre5;
#define SC_GL1(PR, I, CH) { const int idx = tid + 256 * (I), tt_ = idx / 96, rem = idx % 96, vec = rem >> 4, f4 = rem & 15; \
    const int st_ = (CH) * 16 + tt_, t_ = dir == 0 ? st_ : L - 1 - st_; const int svec = vec < 3 ? vec : vec + 3 * dir; \
    PR = *reinterpret_cast<const float4*>(p.SC + ((size_t)((seqbase + t_) * 4 + h) * 9 + svec) * 64 + f4 * 4); }
#define gload(CH) { SC_GL1(pre0, 0, CH) SC_GL1(pre1, 1, CH) SC_GL1(pre2, 2, CH) SC_GL1(pre3, 3, CH) SC_GL1(pre4, 4, CH) SC_GL1(pre5, 5, CH) }
#define SC_LS1(PR, I, BUF) *reinterpret_cast<float4*>(cbuf + (BUF) * 6144 + (tid + 256 * (I)) * 4) = PR;
#define lstore(BUF) { SC_LS1(pre0, 0, BUF) SC_LS1(pre1, 1, BUF) SC_LS1(pre2, 2, BUF) SC_LS1(pre3, 3, BUF) SC_LS1(pre4, 4, BUF) SC_LS1(pre5, 5, BUF) }
  gload(0); lstore(0);
  __syncthreads();
#define SC_LD(R4, K4, VV, W4, A4, D4, TT) { const float* base_ = cb + (TT) * 384; \
    R4 = *reinterpret_cast<const float4*>(base_ + 4 * j); K4 = *reinterpret_cast<const float4*>(base_ + 64 + 4 * j); \
    VV = base_[128 + row]; W4 = *reinterpret_cast<const float4*>(base_ + 192 + 4 * j); \
    A4 = *reinterpret_cast<const float4*>(base_ + 256 + 4 * j); D4 = *reinterpret_cast<const float4*>(base_ + 320 + 4 * j); }
#if SCANVAR
  for (int pass_ = 0; pass_ < (lat ? 2 : 1); ++pass_) {
  int var_ = pass_ ? SCANVAR : 0;
  asm volatile("" : "+v"(var_)); var_ = __builtin_amdgcn_readfirstlane(var_);
#else
  const int var_ = 0;
#endif
  for (int ch = 0; ch < nch; ++ch) {
    if (ch + 1 < nch && var_ != 3) gload(ch + 1);
    const float* cb = cbuf + (ch & 1) * 6144;
    float osel = 0.f;
    float4 r4, kk4, w4, ak4, kd4; float vv;
    SC_LD(r4, kk4, vv, w4, ak4, kd4, 0)
    if (var_ != 2)
#pragma unroll 1
    for (int hf = 0; hf < 2; ++hf) {
      float oqA = 0.f, oqB = 0.f, ovp = 0.f;
#pragma unroll
      for (int u = 0; u < 8; ++u) {
        const int tt = hf * 8 + u;
        float4 r4n, kk4n, w4n, ak4n, kd4n; float vvn;
        SC_LD(r4n, kk4n, vvn, w4n, ak4n, kd4n, tt + 1)
        v2f p = S01 * (v2f){kk4.x, kk4.y};
        p = S23 * (v2f){kk4.z, kk4.w} + p;
        float sk = p.x + p.y;
        sk += dpp_mov<0xB1>(sk);  ovp += dpp_mov<0xB1>(ovp);
        sk += dpp_mov<0x4E>(sk);  ovp += dpp_mov<0x4E>(ovp);
        sk += dpp_mov<0x141>(sk);
        sk += dpp_mov<0x140>(sk);
        if (u > 0) {
          if (((u - 1) >> 2) == 0) oqA = ((j & 3) == ((u - 1) & 3)) ? ovp : oqA;
          else oqB = ((j & 3) == ((u - 1) & 3)) ? ovp : oqB;
        }
        const v2f vv2 = (v2f){vv, vv}, sk2 = (v2f){sk, sk};
        v2f t01 = (v2f){kd4.x, kd4.y} * vv2; t01 = t01 - (v2f){ak4.x, ak4.y} * sk2;
        v2f t23 = (v2f){kd4.z, kd4.w} * vv2; t23 = t23 - (v2f){ak4.z, ak4.w} * sk2;
        S01 = S01 * (v2f){w4.x, w4.y} + t01;
        S23 = S23 * (v2f){w4.z, w4.w} + t23;
        v2f q = S01 * (v2f){r4.x, r4.y};
        q = S23 * (v2f){r4.z, r4.w} + q;
        ovp = q.x + q.y;
        r4 = r4n; kk4 = kk4n; w4 = w4n; ak4 = ak4n; kd4 = kd4n; vv = vvn;
      }
      ovp += dpp_mov<0xB1>(ovp); ovp += dpp_mov<0x4E>(ovp);
      oqB = ((j & 3) == 3) ? ovp : oqB;
      oqA += dpp_mov<0x128>(oqA); oqB += dpp_mov<0x128>(oqB);
      oqA += dpp_mov<0x124>(oqA); oqB += dpp_mov<0x124>(oqB);
      if ((j >> 3) == hf) osel = ((j >> 2) & 1) ? oqB : oqA;
    }
    if (var_ == 0) {
      const int st = ch * 16 + j, t = dir == 0 ? st : L - 1 - st;
      odst[(size_t)(seqbase + t) * 256 + h * 64 + row] = osel;
    } else asm volatile("" :: "v"(osel), "v"(S01), "v"(S23));
    if (ch + 1 < nch && var_ != 3) lstore((ch + 1) & 1);
    asm volatile("s_waitcnt lgkmcnt(0)" ::: "memory");
    __builtin_amdgcn_s_barrier();
  }
#if SCANVAR
  }
#endif
  if (!lat) *reinterpret_cast<float4*>(p.out_st + ((((size_t)(b * 4 + layer) * 2 + dir) * 4 + h) * 64 + row) * 64 + 4 * j) = make_float4(S01.x, S01.y, S23.x, S23.y);
  __syncthreads();
}

__device__ void mixer_phase(const Params& p, int layer_wq, char* smem, int tidx0) {
  const int layer = layer_wq & 3;
  int* slot = reinterpret_cast<int*>(smem + 60 * 1024);
  bool first = true;
  for (;;) {
    int tidx = tidx0;
    asm volatile("" : "+v"(tidx));
    const int tid = tidx, wid = tid >> 6;
    __syncthreads();
    if (tid == 0) *slot = first ? (int)blockIdx.x : (int)(gridDim.x + atomicAdd(&p.wq[layer_wq], 1u));
    first = false;
    __syncthreads();
    int it = *slot;
    if (it >= 1728) break;
    const bool is_scan = (it < 64) || (it >= 448 && it < 960);
#if REPMASK
    if ((p.pad == 1 && !is_scan) || (p.pad == 2 && is_scan) || ((p.pad == 3 || p.pad == 5 || p.pad == 6) && !(it < 64)) || (p.pad == 4 && !(it >= 64 && it < 320))) continue;
#endif
    if (is_scan) {
      const bool lat = it < 64;
      const int si = lat ? it : it - 448;
#ifndef NO_SCAN
      scan_item(p, layer, smem, lat, si / 32, (si / 8) % 4, (si / 4) % 2, si % 4, tidx);
#endif
      continue;
    }
    const u16 *Q, *Kb, *Vt; u16* out; int ldq, ldk, ldv, ndense, grow = 0, cq0 = 0; bool na = false;
    const float* rpb = p.in[23];
    if (it < 320) {
      it -= 64;
      const int b = it / 128, qh = (it / 16) % 8, qt = it % 16, kvh = qh >> 2;
      const int q0 = b * 1024 + qt * 64 + wid * 16;
      Q = p.QGl + (size_t)q0 * 512 + qh * 64; ldq = 512;
      Kb = p.KGl + (size_t)((layer * 2 + b) * 2 + kvh) * 98304; ldk = 0;
      Vt = p.VGtl + (size_t)((layer * 2 + b) * 2 + kvh) * 98304; ldv = 0; ndense = 1536;
      out = p.MIX + (size_t)(NCTX + q0) * DM + 512 + qh * 64;
    } else if (it < 448) {
      it -= 320;
      const int b = it / 64, h = (it / 16) % 4, r = it % 16;
      const int q0 = b * 1024 + r * 64 + wid * 16;
      Q = p.QNl + (size_t)q0 * 256 + h * 64; ldq = 256;
      Kb = p.KNl + (size_t)((layer * 2 + b) * 4 + h) * 98304; ldk = 0;
      Vt = p.VNtl + (size_t)((layer * 2 + b) * 4 + h) * 98304; ldv = 0; ndense = 512;
      rpb = p.in[23] + (size_t)(layer * 4 + h) * 15 * 31; grow = r; cq0 = wid * 16; na = true;
      out = p.MIX + (size_t)(NCTX + q0) * DM + 256 + h * 64;
    } else if (it < 1472) {
      it -= 960;
      const int b = it / 32, qh = (it / 4) % 8, qt = it % 4, kvh = qh >> 2;
      const int q0 = b * 256 + qt * 64 + wid * 16;
      Q = p.QGc + (size_t)q0 * 512 + qh * 64; ldq = 512;
      Kb = p.KGc + (size_t)(b * 2 + kvh) * 16384; ldk = 0;
      Vt = p.VGtc + (size_t)(b * 2 + kvh) * 16384; ldv = 0; ndense = 256;
      out = p.MIX + (size_t)q0 * DM + 512 + qh * 64;
    } else {
      it -= 1472;
      const int b = it / 16, h = (it / 4) % 4, qt = it % 4;
      const int q0 = b * 256 + qt * 64 + wid * 16;
      Q = p.QNc + (size_t)q0 * 256 + h * 64; ldq = 256;
      Kb = p.KNc + (size_t)(b * 4 + h) * 16384; ldk = 0;
      Vt = p.VNtc + (size_t)(b * 4 + h) * 16384; ldv = 0; ndense = 256;
      out = p.MIX + (size_t)q0 * DM + 256 + h * 64;
    }
#ifndef NO_ATT
    attn_wave(Q, ldq, Kb, ldk, Vt, ldv, ndense, na, rpb, grow, cq0, out, DM, tidx);
#endif
  }
}

__device__ void rwkv_fin_phase(const Params& p, int layer, int bid, int nblk, int tidx) {
  const int tid = tidx;
  const float lw = p.in[21][(size_t)layer * 256 + tid], lb = p.in[22][(size_t)layer * 256 + tid];
  for (int t4 = bid; t4 < NTOK / 4; t4 += nblk) {
    float of[4], ob[4], bv[4], gg[4];
#pragma unroll
    for (int u = 0; u < 4; ++u) {
      const size_t i = (size_t)(t4 * 4 + u) * 256 + tid;
      of[u] = p.OF[i]; ob[u] = p.OB[i]; bv[u] = p.BV[i]; gg[u] = p.G[i];
    }
#pragma unroll
    for (int u = 0; u < 4; ++u) {
      const float o = of[u] + ob[u];
      const float mu = wave_sum(o) * (1.f / 64.f);
      const float d = o - mu;
      const float var = wave_sum(d * d) * (1.f / 64.f);
      const float y = (d * rsqrtf(var + 64e-5f) * lw + lb + bv[u]) * gg[u];
      p.MIX[(size_t)(t4 * 4 + u) * DM + tid] = f2bf(y);
    }
  }
}

#ifndef ONLY_PH
#define ONLY_PH -1
#endif
#define PH_EN(x) (ONLY_PH < 0 || ONLY_PH == (x))
__device__ __forceinline__ void run_phase(const Params& p, int ph, char* smem, int bid, int nblk, int tidx, int rep = 0) {
  if (ph == 0) { if (PH_EN(0)) setup_phase(p, smem, bid, nblk, tidx); return; }
  if (ph == 1) { if (PH_EN(1)) modreduce_phase(p, bid, nblk, tidx); return; }
  if (ph == 2) { if (PH_EN(2)) ln_phase<0>(p, 0, bid, nblk, tidx); return; }
  const int layer = (ph - 3) / 9, s = (ph - 3) % 9;
  switch (s) {
    case 0: if (PH_EN(3)) gemm_phase<EPI_PROJ, 256, 3>(p, layer, p.A, p.winT + (size_t)layer * DIN * DM, DIN, DM, smem, bid, nblk, tidx); break;
    case 1: if (PH_EN(4)) prep_phase(p, layer, smem, bid, nblk, tidx, rep); break;
    case 2: if (PH_EN(5)) mixer_phase(p, layer + 4 * rep, smem, tidx); break;
    case 3: if (PH_EN(6)) rwkv_fin_phase(p, layer, bid, nblk, tidx); break;
    case 4: if (PH_EN(7)) gemm_phase<EPI_OUT, 192, 3>(p, layer, p.MIX, p.woutT + (size_t)layer * DM * DM, DM, DM, smem, bid, nblk, tidx); break;
    case 5: if (PH_EN(8)) ln_phase<1>(p, layer, bid, nblk, tidx); break;
    case 6: if (PH_EN(9)) gemm_phase<EPI_FFI, 192, 3>(p, layer, p.A, p.wfiT + (size_t)layer * 2 * DFF * DM, 2 * DFF, DM, smem, bid, nblk, tidx); break;
    case 7: if (PH_EN(10)) gemm_phase<EPI_FFO, 192, 3>(p, layer, p.ACT, p.wfoT + (size_t)layer * DM * DFF, DM, DFF, smem, bid, nblk, tidx); break;
    default: if (PH_EN(11)) ln_phase<2>(p, layer, bid, nblk, tidx); break;
  }
}

__global__ void __launch_bounds__(256, 2) fwd_kernel(Params p, int ph0, int ph1, int usebar) {
  __shared__ __attribute__((aligned(16))) char smem[73728 + 16];
  const int bid = blockIdx.x, nblk = gridDim.x;
  XcdBarrier xb;
  if (usebar && p.never) cg::this_grid().sync();
  if (usebar) {
    if (threadIdx.x == 0) *reinterpret_cast<uint4*>(smem + 73728) = make_uint4(0u, 0u, 0u, 0u);
    __syncthreads();
    xb = xcd_barrier_post(p.bar, (volatile LAS unsigned*)(smem + 73728));
  }
  int ph = ph0, rep = 0;
  while (ph < ph1) {
    int tidx = threadIdx.x;
    asm volatile("" : "+v"(tidx));
    run_phase(p, ph, smem, bid, nblk, tidx, rep);
#if REPSLOT >= 0
    if (((ph < 3 ? 9 + ph : (ph - 3) % 9) == REPSLOT) && rep == 0) rep = 1; else { rep = 0; ++ph; }
#else
    ++ph;
#endif
    if (usebar && ph < ph1) xcd_barrier(xb);
  }
}

static inline size_t al256(size_t x) { return (x + 255) & ~(size_t)255; }

extern "C" void kernel_launch(void* const* d_in, const int* in_sizes, int n_in, void* d_out, int out_size, void* d_ws, size_t ws_size,
                              hipStream_t stream) {
  Params p;
  memset(&p, 0, sizeof(p));
  for (int i = 0; i < 33; ++i) p.in[i] = (const float*)d_in[i];
  float* o = (float*)d_out;
  p.out_yp = o; o += 4194304;
  p.out_ys = o; o += 2097152;
  p.out_st = o; o += 2097152;
  p.out_nak = o; o += 4194304;
  p.out_nav = o; o += 4194304;
  p.out_gk = o; o += 2097152;
  p.out_gv = o;
  char* w = (char*)d_ws; size_t off = 0;
  auto take = [&](size_t bytes) { char* r = w + off; off += al256(bytes); return r; };
  p.bar = (unsigned*)take(16384);
  p.wq = p.bar + 3584;
  p.modp = (float*)take((size_t)4 * 32 * 3 * 6144 * 4);
  p.mod = (float*)take((size_t)4 * 3 * 6144 * 4);
  p.winT = (u16*)take((size_t)4 * DIN * DM * 2);
  p.woutT = (u16*)take((size_t)4 * DM * DM * 2);
  p.wfiT = (u16*)take((size_t)4 * 2 * DFF * DM * 2);
  p.wfoT = (u16*)take((size_t)4 * DM * DFF * 2);
  p.X = (float*)take((size_t)NTOK * DM * 4);
  p.PROJ = (float*)take((size_t)NTOK * DIN * 4);
  p.X1 = p.PROJ;
  p.Y = p.PROJ + (size_t)NTOK * DM;
  p.SC = (float*)take((size_t)NTOK * 4 * 9 * 64 * 4);
  p.ACT = (u16*)p.SC;
  p.G = (float*)take((size_t)NTOK * 256 * 4);
  p.BV = (float*)take((size_t)NTOK * 256 * 4);
  p.OF = (float*)take((size_t)NTOK * 256 * 4);
  p.OB = (float*)take((size_t)NTOK * 256 * 4);
  p.A = (u16*)take((size_t)NTOK * DM * 2);
  p.MIX = (u16*)take((size_t)NTOK * DM * 2);
  p.QNc = (u16*)take((size_t)NCTX * 256 * 2);
  p.KNc = (u16*)take((size_t)NCTX * 256 * 2);
  p.VNtc = (u16*)take((size_t)NCTX * 256 * 2);
  p.QGc = (u16*)take((size_t)NCTX * 512 * 2);
  p.KGc = (u16*)take((size_t)NCTX * 128 * 2);
  p.VGtc = (u16*)take((size_t)NCTX * 128 * 2);
  p.QNl = (u16*)take((size_t)2048 * 256 * 2);
  p.KNl = (u16*)take((size_t)4 * 2 * 1536 * 256 * 2);
  p.VNtl = (u16*)take((size_t)4 * 2 * 1536 * 256 * 2);
  p.QGl = (u16*)take((size_t)2048 * 512 * 2);
  p.KGl = (u16*)take((size_t)4 * 2 * 1536 * 128 * 2);
  p.VGtl = (u16*)take((size_t)4 * 2 * 1536 * 128 * 2);
  p.loraT = (u16*)take((size_t)4 * 98304 * 2);
  p.rope = (float*)take((size_t)64 * 16 * 2 * 4);
  if (off > ws_size) { fprintf(stderr, "workspace too small: need %zu have %zu\n", off, ws_size); return; }

  (void)hipMemsetAsync(p.bar, 0, 16384, stream);
#if MEGA
  static int grid_blocks = 0;
  if (!grid_blocks) {
    int dev = 0, cus = 0, per_cu = 0;
    hipGetDevice(&dev);
    hipDeviceGetAttribute(&cus, hipDeviceAttributeMultiprocessorCount, dev);
    hipOccupancyMaxActiveBlocksPerMultiprocessor(&per_cu, fwd_kernel, 256, 0);
    if (per_cu > 2) per_cu = 2;
    if (per_cu < 1) per_cu = 1;
    grid_blocks = cus * per_cu;
  }
  int ph0 = 0, ph1 = NPH, ub = 1;
  void* args[] = {&p, &ph0, &ph1, &ub};
  hipError_t e = hipLaunchCooperativeKernel((void*)fwd_kernel, dim3(grid_blocks), dim3(256), args, 0, stream);
  if (e != hipSuccess) fprintf(stderr, "cooperative launch failed: %s (grid %d)\n", hipGetErrorString(e), grid_blocks);
#else
  for (int ph = 0; ph < NPH; ++ph) fwd_kernel<<<512, 256, 0, stream>>>(p, ph, ph + 1, 0);
#endif
}
```

```cpp
#include <hip/hip_runtime.h>
#include <hip/hip_cooperative_groups.h>
#include <cstdio>
#include <cstdint>
#include <cstring>
namespace cg = cooperative_groups;

#ifndef REPMASK
#define REPMASK 0
#endif
#ifndef REPSLOT
#define REPSLOT -1
#endif
#ifndef PREPVAR
#define PREPVAR 0
#endif
#ifndef SCANVAR
#define SCANVAR 0
#endif
#ifndef REPVAR
#define REPVAR 0
#endif
#ifndef MEGA
#define MEGA 1
#endif

typedef unsigned short u16;
using bf16x8 = __attribute__((ext_vector_type(8))) short;
using f32x4 = __attribute__((ext_vector_type(4))) float;
using v2f = __attribute__((ext_vector_type(2))) float;

#define NTOK 6144
#define NCTX 4096
#define DM 1024
#define DIN 2688
#define DFF 2816
#define NPH 39
#define ALPHA 1.681792830507429f
#define LOG2E 1.4426950408889634f
#define QSCALE (0.125f * LOG2E)

struct Params {
  const float* in[33];
  float *out_yp, *out_ys, *out_st, *out_nak, *out_nav, *out_gk, *out_gv;
  unsigned *bar, *wq;
  float *modp, *mod;
  u16 *winT, *woutT, *wfiT, *wfoT;
  float *X, *X1, *Y, *PROJ, *SC, *G, *BV, *OF, *OB;
  u16 *A, *MIX, *ACT;
  u16 *QNc, *KNc, *VNtc, *QGc, *KGc, *VGtc;
  u16 *QNl, *KNl, *VNtl, *QGl, *KGl, *VGtl;
  u16* loraT; float* rope;
  int never; int pad;
};

__device__ __forceinline__ u16 f2bf(float f) {
  unsigned u = __float_as_uint(f);
  u += 0x7FFFu + ((u >> 16) & 1u);
  return (u16)(u >> 16);
}
typedef __bf16 bf16v2 __attribute__((ext_vector_type(2)));
__device__ __forceinline__ unsigned pack2(float a, float b) {
  const bf16v2 r = __builtin_convertvector((v2f){a, b}, bf16v2);
  return __builtin_bit_cast(unsigned, r);
}
template <int CTRL> __device__ __forceinline__ float dpp_mov(float v) {
  return __int_as_float(__builtin_amdgcn_update_dpp(0, __float_as_int(v), CTRL, 0xF, 0xF, false));
}
__device__ __forceinline__ float reduce16(float v) {
  v += dpp_mov<0xB1>(v);
  v += dpp_mov<0x4E>(v);
  v += dpp_mov<0x141>(v);
  v += dpp_mov<0x140>(v);
  return v;
}
__device__ __forceinline__ float wave_sum(float v) {
  v = reduce16(v);
  v += __shfl_xor(v, 16);
  v += __shfl_xor(v, 32);
  return v;
}
__device__ __forceinline__ float tanhf_(float x) { const float e = __expf(-2.f * fabsf(x)); const float t = (1.f - e) / (1.f + e); return x < 0.f ? -t : t; }
__device__ __forceinline__ float sigmoidf_(float x) { return 1.f / (1.f + __expf(-x)); }
__device__ __forceinline__ float siluf_(float x) { return x / (1.f + __expf(-x)); }
__device__ __forceinline__ int modrow_of(int tok) { return tok < NCTX ? 0 : 1 + ((tok - NCTX) >> 10); }

#define XB_TMO      128
#define XB_XCNT(j)  (256  + 64 * (j))
#define XB_XSUB(j)  (1280 + 64 * (j))
#define XB_XGEN(j)  (2304 + 64 * (j))
#define XB_TOP      3328
#define XB_TOPGEN   3392
#define XCD_BAR_WORDS 3456
#define XB_SPIN_CAP (1u << 22)
#define LAS __attribute__((address_space(3)))
__device__ __forceinline__ unsigned xb_ld(unsigned* p) { return __hip_atomic_load(p, __ATOMIC_RELAXED, __HIP_MEMORY_SCOPE_AGENT); }
__device__ __forceinline__ unsigned xb_add(unsigned* p, unsigned v) { return __hip_atomic_fetch_add(p, v, __ATOMIC_RELAXED, __HIP_MEMORY_SCOPE_AGENT); }
__device__ __forceinline__ unsigned xb_xcc_id() { return (unsigned)__builtin_amdgcn_s_getreg((3 << 11) | 20) & 0xFu; }
#define XB_SPIN(cond, bar) do { unsigned _sp = 0; while (cond) { __builtin_amdgcn_s_sleep(1); \
    if ((++_sp & 255u) == 0u) { if (xb_ld(&(bar)[XB_TMO])) break; if (_sp > XB_SPIN_CAP) { atomicAdd(&(bar)[XB_TMO], 1u); break; } } } } while (0)
struct XcdBarrier { unsigned* bar; unsigned x; volatile LAS unsigned* st; };
__device__ __forceinline__ XcdBarrier xcd_barrier_post(unsigned* bar, volatile LAS unsigned* st) {
  XcdBarrier b; b.bar = bar; b.x = xb_xcc_id(); b.st = st;
  if (threadIdx.x == 0) (void)xb_add(&bar[XB_XCNT(b.x)], 1u);
  return b;
}
__device__ __forceinline__ void xcd_barrier_complete(unsigned* bar, unsigned x, unsigned& nloc, unsigned& nx) {
  const unsigned G = gridDim.x * gridDim.y * gridDim.z;
  unsigned sum, cnt, mine, sp = 0u;
  for (;;) {
    sum = 0u; cnt = 0u; mine = 0u;
#pragma unroll
    for (unsigned j = 0; j < 16; ++j) { const unsigned c = xb_ld(&bar[XB_XCNT(j)]); sum += c; cnt += (c > 0u) ? 1u : 0u; mine = (j == x) ? c : mine; }
    if (sum == G) break;
    __builtin_amdgcn_s_sleep(1);
    if ((++sp & 255u) == 0u) { if (xb_ld(&bar[XB_TMO])) break; if (sp > XB_SPIN_CAP) { atomicAdd(&bar[XB_TMO], 1u); break; } }
  }
  nloc = mine > 0u ? mine : 1u; nx = cnt > 0u ? cnt : 1u;
}
__device__ __forceinline__ void xcd_barrier(const XcdBarrier& b) {
  asm volatile("s_waitcnt vmcnt(0)" ::: "memory");
  __syncthreads();
  if (threadIdx.x == 0) {
    unsigned* bar = b.bar;
    asm volatile("" : "+s"(bar));
    __builtin_amdgcn_s_waitcnt(0);
    unsigned nloc = b.st[0], nx = b.st[1];
    if (nloc == 0u) { xcd_barrier_complete(bar, b.x, nloc, nx); b.st[0] = nloc; b.st[1] = nx; }
    const unsigned old = xb_add(&bar[XB_XSUB(b.x)], 1u);
    const unsigned gen = old / nloc;
    if (old + 1u == (gen + 1u) * nloc) {
      __builtin_amdgcn_fence(__ATOMIC_RELEASE, "agent");
      asm volatile("s_waitcnt vmcnt(0)" ::: "memory");
      const unsigned og = xb_add(&bar[XB_TOP], 1u);
      const unsigned tg = og / nx;
      if (og + 1u == (tg + 1u) * nx) xb_add(&bar[XB_TOPGEN], 1u);
      else XB_SPIN(xb_ld(&bar[XB_TOPGEN]) == tg, bar);
      __builtin_amdgcn_fence(__ATOMIC_ACQUIRE, "agent");
      xb_add(&bar[XB_XGEN(b.x)], 1u);
      asm volatile("s_waitcnt vmcnt(0)" ::: "memory");
    } else {
      XB_SPIN(xb_ld(&bar[XB_XGEN(b.x)]) == gen, bar);
      __builtin_amdgcn_fence(__ATOMIC_ACQUIRE, "agent");
      asm volatile("s_waitcnt vmcnt(0)" ::: "memory");
    }
  }
  __syncthreads();
}

__device__ __forceinline__ int lds_byte32(int r, int c) {
  const int ob = (r & 15) * 64 + c * 2;
  return (r >> 4) * 1024 + (ob ^ (((ob >> 9) & 1) << 5));
}
__device__ __forceinline__ void stage_rc32(int b, int& R, int& C) {
  const int sb = b & 1023, swz = sb ^ (((sb >> 9) & 1) << 5);
  R = (b >> 10) * 16 + (swz >> 6); C = (swz & 63) >> 1;
}
template <int ROWS>
__device__ __forceinline__ void stage_tile32(const u16* __restrict__ g, int ld, char* lds, int tidx) {
#pragma unroll
  for (int i = 0; i < (ROWS * 64 + 4095) / 4096; ++i) {
    const int b = tidx * 16 + i * 4096;
    if ((i + 1) * 4096 <= ROWS * 64 || tidx < (ROWS * 64 - i * 4096) / 16) {
      int R, C; stage_rc32(b, R, C);
      __builtin_amdgcn_global_load_lds((const unsigned*)(g + (size_t)R * ld + C), (unsigned LAS*)(lds + b), 16, 0, 0);
    }
  }
}
template <int N> __device__ __forceinline__ void wait_vmcnt() {
  if (N == 0) asm volatile("s_waitcnt vmcnt(0)" ::: "memory");
  else if (N == 3) asm volatile("s_waitcnt vmcnt(3)" ::: "memory");
  else if (N == 4) asm volatile("s_waitcnt vmcnt(4)" ::: "memory");
  else if (N == 5) asm volatile("s_waitcnt vmcnt(5)" ::: "memory");
  else if (N == 6) asm volatile("s_waitcnt vmcnt(6)" ::: "memory");
  else if (N == 8) asm volatile("s_waitcnt vmcnt(8)" ::: "memory");
  else if (N == 9) asm volatile("s_waitcnt vmcnt(9)" ::: "memory");
  else if (N == 10) asm volatile("s_waitcnt vmcnt(10)" ::: "memory");
  else if (N == 12) asm volatile("s_waitcnt vmcnt(12)" ::: "memory");
  else asm volatile("s_waitcnt vmcnt(0)" ::: "memory");
}

enum { EPI_PROJ = 0, EPI_OUT = 1, EPI_FFI = 2, EPI_FFO = 3 };

template <int EPI, int BM, int NST>
__device__ __forceinline__ void gemm_phase(const Params& p, int layer, const u16* __restrict__ A, const u16* __restrict__ Bt,
                                           int N, int K, char* smem, int bid, int nblk, int tidx) {
  constexpr int MF = BM / 32;
  const int tid = tidx, lane = tid & 63, wid = tid >> 6, wr = wid >> 1, wc = wid & 1, fr = lane & 15, fq = lane >> 4;
  const int nM = NTOK / BM, nN = N / 128, ntiles = nM * nN, nk = K / 32;
  constexpr int SB = (BM + 128) * 64;
  constexpr int LA = (BM * 64) / 4096;
  const bool extraA = (BM == 96) && (wid < 2);
  for (int tile = bid; tile < ntiles; tile += nblk) {
    const int pm = tile % nM, pn = tile / nM, m0 = pm * BM, n0 = pn * 128;
    f32x4 acc[MF][4];
#pragma unroll
    for (int m = 0; m < MF; ++m)
#pragma unroll
      for (int n = 0; n < 4; ++n) acc[m][n] = (f32x4){0.f, 0.f, 0.f, 0.f};
    const u16* Ag = A + (size_t)m0 * K;
    const u16* Bg = Bt + (size_t)n0 * K;
#pragma unroll
    for (int s_ = 0; s_ < NST - 1; ++s_) {
      stage_tile32<BM>(Ag + s_ * 32, K, smem + s_ * SB, tidx);
      stage_tile32<128>(Bg + s_ * 32, K, smem + s_ * SB + BM * 64, tidx);
    }
    int slot = 0, pslot = NST - 1;
    for (int kt = 0; kt < nk; ++kt) {
      if (kt + NST - 2 < nk) {
        if (BM == 96) { if (extraA) wait_vmcnt<(NST - 2) * 4>(); else wait_vmcnt<(NST - 2) * 3>(); }
        else wait_vmcnt<(NST - 2) * (LA + 2)>();
      } else {
        asm volatile("s_waitcnt vmcnt(0)" ::: "memory");
      }
      __builtin_amdgcn_s_barrier();
      if (kt + NST - 1 < nk) {
        char* nb = smem + pslot * SB;
        stage_tile32<BM>(Ag + (kt + NST - 1) * 32, K, nb, tidx);
        stage_tile32<128>(Bg + (kt + NST - 1) * 32, K, nb + BM * 64, tidx);
      }
      const char* sa = smem + slot * SB;
      const char* sb = sa + BM * 64;
      slot = (slot + 1 == NST) ? 0 : slot + 1;
      pslot = (pslot + 1 == NST) ? 0 : pslot + 1;
      bf16x8 af[MF], bfr[4];
#pragma unroll
      for (int m = 0; m < MF; ++m) af[m] = *reinterpret_cast<const bf16x8*>(sa + lds_byte32(wr * (BM / 2) + m * 16 + fr, fq * 8));
#pragma unroll
      for (int n = 0; n < 4; ++n) bfr[n] = *reinterpret_cast<const bf16x8*>(sb + lds_byte32(wc * 64 + n * 16 + fr, fq * 8));
#pragma unroll
      for (int m = 0; m < MF; ++m)
#pragma unroll
        for (int n = 0; n < 4; ++n) acc[m][n] = __builtin_amdgcn_mfma_f32_16x16x32_bf16(bfr[n], af[m], acc[m][n], 0, 0, 0);
    }
#pragma unroll
    for (int m = 0; m < MF; ++m) {
      const int row = m0 + wr * (BM / 2) + m * 16 + fr;
      if (EPI == EPI_PROJ) {
#pragma unroll
        for (int n = 0; n < 4; ++n) {
          const int col = n0 + wc * 64 + n * 16 + 4 * fq;
          *reinterpret_cast<float4*>(p.PROJ + (size_t)row * DIN + col) = make_float4(acc[m][n][0], acc[m][n][1], acc[m][n][2], acc[m][n][3]);
        }
      } else if (EPI == EPI_OUT || EPI == EPI_FFO) {
        const float* res = (EPI == EPI_OUT) ? p.X : p.X1;
        const float* gate = p.mod + ((size_t)(layer * 3 + modrow_of(row)) * 6 + (EPI == EPI_OUT ? 2 : 5)) * 1024;
#pragma unroll
        for (int n = 0; n < 4; ++n) {
          const int col = n0 + wc * 64 + n * 16 + 4 * fq;
          const float4 xr = *reinterpret_cast<const float4*>(res + (size_t)row * DM + col);
          const float4 gt = *reinterpret_cast<const float4*>(gate + col);
          float4 y;
          y.x = ALPHA * xr.x + gt.x * acc[m][n][0];
          y.y = ALPHA * xr.y + gt.y * acc[m][n][1];
          y.z = ALPHA * xr.z + gt.z * acc[m][n][2];
          y.w = ALPHA * xr.w + gt.w * acc[m][n][3];
          *reinterpret_cast<float4*>(p.Y + (size_t)row * DM + col) = y;
        }
      } else {
#pragma unroll
        for (int n2 = 0; n2 < 2; ++n2) {
          const int j0 = ((n0 + wc * 64) / 32 + n2) * 16 + 4 * fq;
          float a[4];
#pragma unroll
          for (int r = 0; r < 4; ++r) a[r] = siluf_(acc[m][2 * n2][r]) * acc[m][2 * n2 + 1][r];
          uint2 pk; pk.x = pack2(a[0], a[1]); pk.y = pack2(a[2], a[3]);
          *reinterpret_cast<uint2*>(p.ACT + (size_t)row * DFF + j0) = pk;
        }
      }
    }
    asm volatile("s_waitcnt lgkmcnt(0)" ::: "memory");
    __builtin_amdgcn_s_barrier();
  }
}

__device__ __forceinline__ int kf_off(int t, int d) { return (t >> 4) * 1024 + (d >> 5) * 512 + ((d & 31) >> 3) * 128 + (t & 15) * 8 + (d & 7); }
__device__ __forceinline__ int vf_off(int t, int d) { return (t >> 5) * 2048 + (d >> 4) * 512 + (((t & 15) >> 2) * 16 + (d & 15)) * 8 + ((t >> 4) & 1) * 4 + (t & 3); }
__device__ __forceinline__ void pack44_store(u16* base, int t0, int d, const float* v) {
  uint2 a, b; a.x = pack2(v[0], v[1]); a.y = pack2(v[2], v[3]); b.x = pack2(v[4], v[5]); b.y = pack2(v[6], v[7]);
  *reinterpret_cast<uint2*>(base + vf_off(t0, d)) = a;
  *reinterpret_cast<uint2*>(base + vf_off(t0 + 4, d)) = b;
}
__device__ __forceinline__ void pack8_store(u16* dst, const float* v) {
  uint4 pk; pk.x = pack2(v[0], v[1]); pk.y = pack2(v[2], v[3]); pk.z = pack2(v[4], v[5]); pk.w = pack2(v[6], v[7]);
  *reinterpret_cast<uint4*>(dst) = pk;
}

__device__ void setup_phase(const Params& p, char* smem, int bid, int nblk, int tidx) {
  const int tid = tidx;
  const int NI = 768 + 512 + 13;
  for (int it = bid; it < NI; it += nblk) {
    if (it < 768) {
      const int l = it / 192, nc = (it / 32) % 6, kc = it % 32;
      const int col = nc * 1024 + tid * 4;
      const float* wm = p.in[9] + (size_t)l * 1024 * 6144;
      float4 a0 = make_float4(0, 0, 0, 0), a1 = a0, a2 = a0;
      for (int k8 = 0; k8 < 32; k8 += 8) {
        float4 w[8];
#pragma unroll
        for (int u = 0; u < 8; ++u) w[u] = *reinterpret_cast<const float4*>(wm + (size_t)(kc * 32 + k8 + u) * 6144 + col);
#pragma unroll
        for (int u = 0; u < 8; ++u) {
          const int k = kc * 32 + k8 + u;
          const float s0 = siluf_(p.in[8][k]), s1 = siluf_(p.in[7][k]), s2 = siluf_(p.in[7][1024 + k]);
          a0.x += s0 * w[u].x; a0.y += s0 * w[u].y; a0.z += s0 * w[u].z; a0.w += s0 * w[u].w;
          a1.x += s1 * w[u].x; a1.y += s1 * w[u].y; a1.z += s1 * w[u].z; a1.w += s1 * w[u].w;
          a2.x += s2 * w[u].x; a2.y += s2 * w[u].y; a2.z += s2 * w[u].z; a2.w += s2 * w[u].w;
        }
      }
      float* dst = p.modp + (size_t)((l * 32 + kc) * 3) * 6144 + col;
      *reinterpret_cast<float4*>(dst) = a0;
      *reinterpret_cast<float4*>(dst + 6144) = a1;
      *reinterpret_cast<float4*>(dst + 2 * 6144) = a2;
    } else if (it < 1280) {
      const int ci = it - 768, b = ci / 256, l = (ci / 64) % 4, tg = ci % 64, t0 = tg * 8;
      {
        const float* ck = p.in[3] + ((size_t)(b * 4 + l) * 512 + t0) * 256 + tid;
        const float* cv = p.in[4] + ((size_t)(b * 4 + l) * 512 + t0) * 256 + tid;
        float v[8];
#pragma unroll
        for (int tt = 0; tt < 8; ++tt) {
          p.KNl[((size_t)((l * 2 + b) * 4 + (tid >> 6))) * 98304 + kf_off(t0 + tt, tid & 63)] = f2bf(ck[tt * 256]);
          v[tt] = cv[tt * 256];
        }
        pack44_store(p.VNtl + ((size_t)((l * 2 + b) * 4 + (tid >> 6))) * 98304, t0, tid & 63, v);
      }
      if (tid < 128) {
        const float* ck = p.in[5] + ((size_t)(b * 4 + l) * 512 + t0) * 128 + tid;
#pragma unroll
        for (int tt = 0; tt < 8; ++tt) p.KGl[((size_t)((l * 2 + b) * 2 + (tid >> 6))) * 98304 + kf_off(t0 + tt, tid & 63)] = f2bf(ck[tt * 128]);
      } else {
        const int c = tid - 128;
        const float* cv = p.in[6] + ((size_t)(b * 4 + l) * 512 + t0) * 128 + c;
        float v[8];
#pragma unroll
        for (int tt = 0; tt < 8; ++tt) v[tt] = cv[tt * 128];
        pack44_store(p.VGtl + ((size_t)((l * 2 + b) * 2 + (c >> 6))) * 98304, t0, c & 63, v);
      }
    } else {
      const int li = it - (768 + 512);
      if (li == 12) {
        for (int idx = tid; idx < 1024; idx += 256) {
          const int pos = idx >> 4, fi = idx & 15;
          const float ang = (float)pos * exp2f(-(float)fi * (13.287712379549449f / 16.f));
          p.rope[idx * 2] = cosf(ang); p.rope[idx * 2 + 1] = sinf(ang);
        }
      } else {
        const int l = li / 3, m = li % 3;
        u16* dst = p.loraT + (size_t)l * 98304 + m * 32768;
        if (m < 2) {
          const float* src = p.in[m == 0 ? 14 : 16] + (size_t)l * 32768;
          for (int i0 = tid; i0 < 32768; i0 += 256 * 16) {
            float v[16];
#pragma unroll
            for (int u = 0; u < 16; ++u) { const int idx = i0 + 256 * u; const int d = idx >> 14, cch = (idx >> 6) & 255, r = idx & 63; v[u] = src[(d * 64 + r) * 256 + cch]; }
#pragma unroll
            for (int u = 0; u < 16; ++u) dst[i0 + 256 * u] = f2bf(v[u]);
          }
        } else {
          const float* src = p.in[17] + (size_t)l * 32768;
          for (int i0 = tid; i0 < 32768; i0 += 256 * 16) {
            float v[16];
#pragma unroll
            for (int u = 0; u < 16; ++u) { const int idx = i0 + 256 * u; const int cch = idx >> 7, j = idx & 127; v[u] = src[j * 256 + cch]; }
#pragma unroll
            for (int u = 0; u < 16; ++u) dst[i0 + 256 * u] = f2bf(v[u]);
          }
        }
      }
    }
  }
  {
    float* tile = reinterpret_cast<float*>(smem);
    const int NT = 4 * 3040;
    float4 cur0, cur1, cur2, cur3;
    const float* src; u16* dst; int K, N, mat, k0, n0;
#define TR_DECODE(TR) { const int l_ = (TR) / 3040; int r_ = (TR) % 3040; int kt_, nt_; \
      if (r_ < 672) { mat = 0; K = 1024; N = 2688; src = p.in[11] + (size_t)l_ * K * N; dst = p.winT + (size_t)l_ * N * K; kt_ = r_ / 42; nt_ = r_ % 42; } \
      else if (r_ < 928) { r_ -= 672; mat = 1; K = 1024; N = 1024; src = p.in[26] + (size_t)l_ * K * N; dst = p.woutT + (size_t)l_ * N * K; kt_ = r_ / 16; nt_ = r_ % 16; } \
      else if (r_ < 2336) { r_ -= 928; mat = 2; K = 1024; N = 5632; src = p.in[29] + (size_t)l_ * K * N; dst = p.wfiT + (size_t)l_ * N * K; kt_ = r_ / 88; nt_ = r_ % 88; } \
      else { r_ -= 2336; mat = 3; K = 2816; N = 1024; src = p.in[30] + (size_t)l_ * K * N; dst = p.wfoT + (size_t)l_ * N * K; kt_ = r_ / 16; nt_ = r_ % 16; } \
      k0 = kt_ * 64; n0 = nt_ * 64; }
#define TR_LOAD(V, I) V = *reinterpret_cast<const float4*>(src + (size_t)(k0 + (tid >> 4) + 16 * (I)) * N + n0 + (tid & 15) * 4);
#define TR_PUT(V, I) { const int kr_ = (tid >> 4) + 16 * (I), c4_ = (tid & 15) * 4; \
      tile[kr_ * 65 + c4_ + 0] = V.x; tile[kr_ * 65 + c4_ + 1] = V.y; tile[kr_ * 65 + c4_ + 2] = V.z; tile[kr_ * 65 + c4_ + 3] = V.w; }
    int tr = bid;
    if (tr < NT) { TR_DECODE(tr) TR_LOAD(cur0, 0) TR_LOAD(cur1, 1) TR_LOAD(cur2, 2) TR_LOAD(cur3, 3) }
    for (; tr < NT; tr += nblk) {
      TR_PUT(cur0, 0) TR_PUT(cur1, 1) TR_PUT(cur2, 2) TR_PUT(cur3, 3)
      if (tr + nblk < NT) { TR_DECODE(tr + nblk) TR_LOAD(cur0, 0) TR_LOAD(cur1, 1) TR_LOAD(cur2, 2) TR_LOAD(cur3, 3) }
      TR_DECODE(tr)
      __syncthreads();
#pragma unroll
      for (int i = 0; i < 2; ++i) {
        const int idx = tid + 256 * i, nl = idx >> 3, kc = idx & 7;
        int n = n0 + nl;
        if (mat == 2) { const int isup = n >= DFF ? 1 : 0; const int j = n - isup * DFF; n = (j >> 4) * 32 + isup * 16 + (j & 15); }
        float v[8];
#pragma unroll
        for (int jj = 0; jj < 8; ++jj) v[jj] = tile[(kc * 8 + jj) * 65 + nl];
        pack8_store(dst + (size_t)n * K + k0 + kc * 8, v);
      }
      __syncthreads();
    }
#undef TR_DECODE
#undef TR_LOAD
#undef TR_PUT
  }
}

__device__ void modreduce_phase(const Params& p, int bid, int nblk, int tidx) {
  for (int idx = bid * 256 + tidx; idx < 18432; idx += nblk * 256) {
    const int l = idx / 4608, rem = idx % 4608, mr = rem / 1536, c4 = (rem % 1536) * 4;
    float4 a = *reinterpret_cast<const float4*>(p.in[10] + (size_t)l * 6144 + c4);
    for (int k8 = 0; k8 < 32; k8 += 8) {
      float4 v[8];
#pragma unroll
      for (int u = 0; u < 8; ++u) v[u] = *reinterpret_cast<const float4*>(p.modp + (size_t)((l * 32 + k8 + u) * 3 + mr) * 6144 + c4);
#pragma unroll
      for (int u = 0; u < 8; ++u) { a.x += v[u].x; a.y += v[u].y; a.z += v[u].z; a.w += v[u].w; }
    }
    *reinterpret_cast<float4*>(p.mod + (size_t)(l * 3 + mr) * 6144 + c4) = a;
  }
}

template <int MODE>
__device__ void ln_phase(const Params& p, int layer, int bid, int nblk, int tidx) {
  const int lane = tidx & 63, wid = tidx >> 6;
  const bool fin = (MODE == 2 && layer == 3);
  const float* lw = (MODE == 1 ? p.in[27] : p.in[31]) + (size_t)layer * DM;
  const float* lb = (MODE == 1 ? p.in[28] : p.in[32]) + (size_t)layer * DM;
  const int ml = (MODE == 2) ? (layer + 1 < 4 ? layer + 1 : 3) : layer;
  const int which = (MODE == 1) ? 3 : 0;
#define LN_SRC(ROW) (MODE == 0 ? ((ROW) < NCTX ? p.in[0] + (size_t)(ROW) * DM : p.in[1] + (size_t)((ROW) - NCTX) * DM) : p.Y + (size_t)(ROW) * DM)
  float4 nv0, nv1, nv2, nv3;
  int it = bid;
  if (it < NTOK / 4) {
    const float4* s4 = reinterpret_cast<const float4*>(LN_SRC(it * 4 + wid));
    nv0 = s4[lane]; nv1 = s4[lane + 64]; nv2 = s4[lane + 128]; nv3 = s4[lane + 192];
  }
  for (; it < NTOK / 4; it += nblk) {
    const int row = it * 4 + wid;
    float4 v[4] = {nv0, nv1, nv2, nv3};
    if (it + nblk < NTOK / 4) {
      const float4* s4 = reinterpret_cast<const float4*>(LN_SRC((it + nblk) * 4 + wid));
      nv0 = s4[lane]; nv1 = s4[lane + 64]; nv2 = s4[lane + 128]; nv3 = s4[lane + 192];
    }
    float4 w4[4], b4[4], s4v[4], c4v[4];
    const float* sh = p.mod + ((size_t)(ml * 3 + modrow_of(row)) * 6 + which) * 1024;
    const float* sc = sh + 1024;
#pragma unroll
    for (int i = 0; i < 4; ++i) {
      if (MODE != 0) { w4[i] = reinterpret_cast<const float4*>(lw)[lane + 64 * i]; b4[i] = reinterpret_cast<const float4*>(lb)[lane + 64 * i]; }
      if (!fin) { s4v[i] = reinterpret_cast<const float4*>(sh)[lane + 64 * i]; c4v[i] = reinterpret_cast<const float4*>(sc)[lane + 64 * i]; }
    }
    if (MODE != 0) {
      float s = 0.f;
#pragma unroll
      for (int i = 0; i < 4; ++i) s += v[i].x + v[i].y + v[i].z + v[i].w;
      const float mu = wave_sum(s) * (1.f / 1024.f);
      float q = 0.f;
#pragma unroll
      for (int i = 0; i < 4; ++i) {
        v[i].x -= mu; v[i].y -= mu; v[i].z -= mu; v[i].w -= mu;
        q += v[i].x * v[i].x + v[i].y * v[i].y + v[i].z * v[i].z + v[i].w * v[i].w;
      }
      const float rstd = rsqrtf(wave_sum(q) * (1.f / 1024.f) + 1e-5f);
#pragma unroll
      for (int i = 0; i < 4; ++i) {
        v[i].x = v[i].x * rstd * w4[i].x + b4[i].x; v[i].y = v[i].y * rstd * w4[i].y + b4[i].y;
        v[i].z = v[i].z * rstd * w4[i].z + b4[i].z; v[i].w = v[i].w * rstd * w4[i].w + b4[i].w;
      }
    }
    float* xdst = (MODE == 1 ? p.X1 : p.X) + (size_t)row * DM;
#pragma unroll
    for (int i = 0; i < 4; ++i) reinterpret_cast<float4*>(xdst)[lane + 64 * i] = v[i];
    if (fin) {
      float* o = row < NCTX ? p.out_yp + (size_t)row * DM : p.out_ys + (size_t)(row - NCTX) * DM;
#pragma unroll
      for (int i = 0; i < 4; ++i) reinterpret_cast<float4*>(o)[lane + 64 * i] = v[i];
    } else {
      u16* adst = p.A + (size_t)row * DM;
#pragma unroll
      for (int i = 0; i < 4; ++i) {
        uint2 pk;
        pk.x = pack2(v[i].x * (1.f + c4v[i].x) + s4v[i].x, v[i].y * (1.f + c4v[i].y) + s4v[i].y);
        pk.y = pack2(v[i].z * (1.f + c4v[i].z) + s4v[i].z, v[i].w * (1.f + c4v[i].w) + s4v[i].w);
        reinterpret_cast<uint2*>(adst)[lane + 64 * i] = pk;
      }
    }
  }
#undef LN_SRC
}

#define FLD 772
#define LLD 392
__device__ void prep_phase(const Params& p, int layer, char* smem, int bid, int nblk, int tidx, int rep) {
  const int pv_ = rep ? PREPVAR : 0;
  float* F = reinterpret_cast<float*>(smem);
  u16* LIb = reinterpret_cast<u16*>(smem + 16 * FLD * 4);
  const float* cw = p.in[12] + (size_t)layer * 3 * 1152;
  const u16* LW = p.loraT + (size_t)layer * 98304;
  for (int it2 = bid; it2 < 2 * (NTOK / 16); it2 += nblk) {
    const bool doR = it2 < NTOK / 16;
    const int it = doR ? it2 : it2 - NTOK / 16;
    int tid = tidx;
    asm volatile("" : "+v"(tid));
    const int lane = tid & 63, wid = tid >> 6, fr = lane & 15, fq = lane >> 4;
    const int tok0 = it * 16;
    int b, tpos0, L;
    const bool isctx = tok0 < NCTX;
    if (isctx) { b = tok0 >> 8; tpos0 = tok0 & 255; L = 256; }
    else { const int tl = tok0 - NCTX; b = tl >> 10; tpos0 = tl & 1023; L = 1024; }
    if (doR) {
    {
      float* PRM = reinterpret_cast<float*>(smem + 61952);
      PRM[tid] = p.in[13][(size_t)layer * 512 + tid]; PRM[256 + tid] = p.in[13][(size_t)layer * 512 + 256 + tid];
      PRM[512 + tid] = p.in[15][(size_t)layer * 512 + tid]; PRM[768 + tid] = p.in[15][(size_t)layer * 512 + 256 + tid];
      PRM[1024 + tid] = p.in[18][(size_t)layer * 256 + tid]; PRM[1280 + tid] = p.in[19][(size_t)layer * 256 + tid]; PRM[1536 + tid] = p.in[20][(size_t)layer * 256 + tid];
    }
#pragma unroll 1
    for (int cg = tid; cg < 288; cg += 256) {
      const int c = cg * 4;
      const float4 w0 = *reinterpret_cast<const float4*>(cw + c);
      const float4 w1 = *reinterpret_cast<const float4*>(cw + 1152 + c);
      const float4 w2 = *reinterpret_cast<const float4*>(cw + 2304 + c);
      const float* pr = p.PROJ + (size_t)tok0 * DIN + c;
      float4 x[18];
#pragma unroll
      for (int i = 0; i < 18; ++i) {
        const int tpos = tpos0 + i - 1;
        x[i] = (tpos >= 0 && tpos < L) ? *reinterpret_cast<const float4*>(pr + (ptrdiff_t)(i - 1) * DIN) : make_float4(0.f, 0.f, 0.f, 0.f);
      }
#pragma unroll
      for (int tt = 0; tt < 16; ++tt) {
        float4 f;
        f.x = w0.x * x[tt].x + w1.x * x[tt + 1].x + w2.x * x[tt + 2].x;
        f.y = w0.y * x[tt].y + w1.y * x[tt + 1].y + w2.y * x[tt + 2].y;
        f.z = w0.z * x[tt].z + w1.z * x[tt + 1].z + w2.z * x[tt + 2].z;
        f.w = w0.w * x[tt].w + w1.w * x[tt + 1].w + w2.w * x[tt + 2].w;
        if (c < 768) { *reinterpret_cast<float4*>(F + tt * FLD + c) = f; }
        else {
          const int cc = c - 768;
          if (cc < 128) { f.x = tanhf_(f.x); f.y = tanhf_(f.y); f.z = tanhf_(f.z); f.w = tanhf_(f.w); }
          else if (cc >= 256) { f.x = sigmoidf_(f.x); f.y = sigmoidf_(f.y); f.z = sigmoidf_(f.z); f.w = sigmoidf_(f.w); }
          uint2 pk; pk.x = pack2(f.x, f.y); pk.y = pack2(f.z, f.w);
          *reinterpret_cast<uint2*>(LIb + tt * LLD + cc) = pk;
        }
      }
    }
    __syncthreads();
    f32x4 acc[5][4];
#pragma unroll
    for (int g = 0; g < 5; ++g)
#pragma unroll
      for (int nf = 0; nf < 4; ++nf) acc[g][nf] = (f32x4){0.f, 0.f, 0.f, 0.f};
    if (pv_ != 2 && pv_ != 3) {
#define PB_LOAD(W, GI) { const u16* wt_ = (GI) < 4 ? LW + (size_t)(GI) * 16384 : LW + 65536; const int rs_ = (GI) < 4 ? 64 : 128; const int ko_ = (GI) < 4 ? 0 : ((GI) - 4) * 64; \
      _Pragma("unroll") for (int ks_ = 0; ks_ < 2; ++ks_) _Pragma("unroll") for (int nf_ = 0; nf_ < 4; ++nf_) \
        W[ks_ * 4 + nf_] = *reinterpret_cast<const bf16x8*>(wt_ + (size_t)(64 * wid + 16 * nf_ + fr) * rs_ + ko_ + ks_ * 32 + fq * 8); }
#define PB_MMA(W, GI) { const int ai_ = (GI) < 4 ? (GI) : 4; const int xo_ = (GI) < 4 ? (GI) * 64 : 256 + ((GI) - 4) * 64; \
      _Pragma("unroll") for (int ks_ = 0; ks_ < 2; ++ks_) { \
        const bf16x8 xb_ = *reinterpret_cast<const bf16x8*>(LIb + fr * LLD + xo_ + ks_ * 32 + fq * 8); \
        _Pragma("unroll") for (int nf_ = 0; nf_ < 4; ++nf_) acc[ai_][nf_] = __builtin_amdgcn_mfma_f32_16x16x32_bf16(W[ks_ * 4 + nf_], xb_, acc[ai_][nf_], 0, 0, 0); } \
      __builtin_amdgcn_sched_barrier(0); }
    {
      bf16x8 wA[8], wB[8];
      PB_LOAD(wA, 0)
      PB_LOAD(wB, 1) PB_MMA(wA, 0)
      PB_LOAD(wA, 2) PB_MMA(wB, 1)
      PB_LOAD(wB, 3) PB_MMA(wA, 2)
      PB_LOAD(wA, 4) PB_MMA(wB, 3)
      PB_LOAD(wB, 5) PB_MMA(wA, 4)
      PB_MMA(wB, 5)
    }
#undef PB_LOAD
#undef PB_MMA
    }
    if (pv_ != 2 && pv_ != 3) {
#ifndef NO_C
    const float* PRM = reinterpret_cast<const float*>(smem + 61952);
    {
      const int tok = tok0 + fr;
      float ss = 0.f, bs = 0.f;
#pragma unroll
      for (int nf = 0; nf < 4; ++nf) {
        const int c0 = 64 * wid + 16 * nf + 4 * fq;
        const float4 r4 = *reinterpret_cast<const float4*>(F + fr * FLD + c0);
        const float4 k4 = *reinterpret_cast<const float4*>(F + fr * FLD + 256 + c0);
        const float4 w00 = *reinterpret_cast<const float4*>(PRM + c0);
        const float4 w01 = *reinterpret_cast<const float4*>(PRM + 256 + c0);
        const float4 a00 = *reinterpret_cast<const float4*>(PRM + 512 + c0);
        const float4 a01 = *reinterpret_cast<const float4*>(PRM + 768 + c0);
        const float4 kkw = *reinterpret_cast<const float4*>(PRM + 1024 + c0);
        const float4 kaw = *reinterpret_cast<const float4*>(PRM + 1280 + c0);
        const float4 rkw = *reinterpret_cast<const float4*>(PRM + 1536 + c0);
        const float rr[4] = {r4.x, r4.y, r4.z, r4.w}, kk_[4] = {k4.x, k4.y, k4.z, k4.w};
        const float w0a[4] = {w00.x, w00.y, w00.z, w00.w}, w0b[4] = {w01.x, w01.y, w01.z, w01.w};
        const float a0a[4] = {a00.x, a00.y, a00.z, a00.w}, a0b[4] = {a01.x, a01.y, a01.z, a01.w};
        const float kkw_[4] = {kkw.x, kkw.y, kkw.z, kkw.w}, kaw_[4] = {kaw.x, kaw.y, kaw.z, kaw.w}, rkw_[4] = {rkw.x, rkw.y, rkw.z, rkw.w};
#pragma unroll
        for (int r = 0; r < 4; ++r) {
          {
            const float z = -(w0a[r] + acc[0][nf][r]);
            const float sp = fmaxf(z, 0.f) + __logf(1.f + __expf(-fabsf(z)));
            acc[0][nf][r] = __expf(-__expf(-sp - 0.5f));
          }
          {
            const float z = -(w0b[r] + acc[1][nf][r]);
            const float sp = fmaxf(z, 0.f) + __logf(1.f + __expf(-fabsf(z)));
            acc[1][nf][r] = __expf(-__expf(-sp - 0.5f));
          }
          const float av0 = sigmoidf_(a0a[r] + acc[2][nf][r]);
          const float av1 = sigmoidf_(a0b[r] + acc[3][nf][r]);
          acc[2][nf][r] = av0; acc[3][nf][r] = av1;
          const float k = kk_[r];
          const float kq = k * kkw_[r];
          ss += kq * kq;
          const float kd0 = k * (1.f + (av0 - 1.f) * kaw_[r]);
          const float kd1 = k * (1.f + (av1 - 1.f) * kaw_[r]);
          bs += rr[r] * (kd0 + kd1) * rkw_[r];
        }
        __builtin_amdgcn_sched_barrier(0);
      }
      ss += __shfl_xor(ss, 16); ss += __shfl_xor(ss, 32);
      bs += __shfl_xor(bs, 16); bs += __shfl_xor(bs, 32);
      const float inrm = 1.f / fmaxf(sqrtf(ss), 1e-12f);
#pragma unroll
      for (int nf = 0; nf < 4; ++nf) {
        const int c0 = 64 * wid + 16 * nf + 4 * fq, n0 = 16 * nf + 4 * fq;
        const float4 r4 = *reinterpret_cast<const float4*>(F + fr * FLD + c0);
        const float4 k4 = *reinterpret_cast<const float4*>(F + fr * FLD + 256 + c0);
        const float4 v4 = *reinterpret_cast<const float4*>(F + fr * FLD + 512 + c0);
        const float4 kkw = *reinterpret_cast<const float4*>(PRM + 1024 + c0);
        const float4 kaw = *reinterpret_cast<const float4*>(PRM + 1280 + c0);
        const float kk_[4] = {k4.x, k4.y, k4.z, k4.w}, kkw_[4] = {kkw.x, kkw.y, kkw.z, kkw.w}, kaw_[4] = {kaw.x, kaw.y, kaw.z, kaw.w};
        float* sc = p.SC + ((size_t)(tok * 4 + wid) * 9) * 64 + n0;
        float kn[4], kd0[4], kd1[4];
#pragma unroll
        for (int r = 0; r < 4; ++r) {
          kn[r] = kk_[r] * kkw_[r] * inrm;
          kd0[r] = kk_[r] * (1.f + (acc[2][nf][r] - 1.f) * kaw_[r]);
          kd1[r] = kk_[r] * (1.f + (acc[3][nf][r] - 1.f) * kaw_[r]);
        }
        *reinterpret_cast<float4*>(sc) = r4;
        *reinterpret_cast<float4*>(sc + 64) = make_float4(kn[0], kn[1], kn[2], kn[3]);
        *reinterpret_cast<float4*>(sc + 128) = v4;
        *reinterpret_cast<float4*>(sc + 192) = make_float4(acc[0][nf][0], acc[0][nf][1], acc[0][nf][2], acc[0][nf][3]);
        *reinterpret_cast<float4*>(sc + 256) = make_float4(acc[2][nf][0] * kn[0], acc[2][nf][1] * kn[1], acc[2][nf][2] * kn[2], acc[2][nf][3] * kn[3]);
        *reinterpret_cast<float4*>(sc + 320) = make_float4(kd0[0], kd0[1], kd0[2], kd0[3]);
        *reinterpret_cast<float4*>(sc + 384) = make_float4(acc[1][nf][0], acc[1][nf][1], acc[1][nf][2], acc[1][nf][3]);
        *reinterpret_cast<float4*>(sc + 448) = make_float4(acc[3][nf][0] * kn[0], acc[3][nf][1] * kn[1], acc[3][nf][2] * kn[2], acc[3][nf][3] * kn[3]);
        *reinterpret_cast<float4*>(sc + 512) = make_float4(kd1[0], kd1[1], kd1[2], kd1[3]);
        *reinterpret_cast<float4*>(p.G + (size_t)tok * 256 + c0) = make_float4(acc[4][nf][0], acc[4][nf][1], acc[4][nf][2], acc[4][nf][3]);
        *reinterpret_cast<float4*>(p.BV + (size_t)tok * 256 + c0) = make_float4(bs * v4.x, bs * v4.y, bs * v4.z, bs * v4.w);
        __builtin_amdgcn_sched_barrier(0);
      }
    }
#endif
    }
    }
    if (!doR && pv_ != 1) {
#ifndef NO_D
    {
      const int tok = tid >> 4, g8 = tid & 15, tokg = tok0 + tok, tpos = tpos0 + tok;
      const int tkey = isctx ? tpos : 512 + tpos;
      const float* pr = p.PROJ + (size_t)tokg * DIN;
#pragma unroll
      for (int hh = 0; hh < 2; ++hh) {
        const int g = g8 + 16 * hh, c0 = g * 8, hd = c0 >> 6, d0 = c0 & 63;
        const float4 qa = *reinterpret_cast<const float4*>(pr + 1152 + c0), qb = *reinterpret_cast<const float4*>(pr + 1152 + c0 + 4);
        const float4 ka = *reinterpret_cast<const float4*>(pr + 1408 + c0), kb2 = *reinterpret_cast<const float4*>(pr + 1408 + c0 + 4);
        const float qv[8] = {qa.x * QSCALE, qa.y * QSCALE, qa.z * QSCALE, qa.w * QSCALE, qb.x * QSCALE, qb.y * QSCALE, qb.z * QSCALE, qb.w * QSCALE};
        const float kv[8] = {ka.x, ka.y, ka.z, ka.w, kb2.x, kb2.y, kb2.z, kb2.w};
        if (isctx) {
          float* ok = p.out_nak + ((size_t)(b * 4 + layer) * 256 + tpos) * 256 + c0;
          *reinterpret_cast<float4*>(ok) = ka; *reinterpret_cast<float4*>(ok + 4) = kb2;
          pack8_store(p.QNc + (size_t)tokg * 256 + c0, qv);
          pack8_store(p.KNc + (size_t)(b * 4 + hd) * 16384 + kf_off(tkey, d0), kv);
        } else {
          pack8_store(p.QNl + (size_t)(tokg - NCTX) * 256 + c0, qv);
          pack8_store(p.KNl + ((size_t)((layer * 2 + b) * 4 + hd)) * 98304 + kf_off(tkey, d0), kv);
        }
      }
#pragma unroll
      for (int hh = 0; hh < 5; ++hh) {
        const bool isk = (hh == 4);
        const int g = isk ? g8 : g8 + 16 * hh, d0 = (g & 7) * 8, hd = g >> 3;
        const float* src = pr + (isk ? 2432 : 1920) + g * 8;
        const float4 xa = *reinterpret_cast<const float4*>(src), xb = *reinterpret_cast<const float4*>(src + 4);
        const float* nw = (isk ? p.in[25] : p.in[24]) + (size_t)layer * 64 + d0;
        const float4 na = *reinterpret_cast<const float4*>(nw), nb = *reinterpret_cast<const float4*>(nw + 4);
        float x[8] = {xa.x, xa.y, xa.z, xa.w, xb.x, xb.y, xb.z, xb.w};
        const float nrm[8] = {na.x, na.y, na.z, na.w, nb.x, nb.y, nb.z, nb.w};
        float ss = 0.f;
#pragma unroll
        for (int e = 0; e < 8; ++e) ss += x[e] * x[e];
        ss += dpp_mov<0xB1>(ss); ss += dpp_mov<0x4E>(ss); ss += dpp_mov<0x141>(ss);
        const float rs = rsqrtf(ss * (1.f / 64.f) + 1e-6f);
#pragma unroll
        for (int e = 0; e < 8; ++e) x[e] = x[e] * rs * nrm[e];
        if (isk && isctx) {
          float* ok = p.out_gk + ((size_t)(b * 4 + layer) * 256 + tpos) * 128 + g * 8;
          *reinterpret_cast<float4*>(ok) = make_float4(x[0], x[1], x[2], x[3]);
          *reinterpret_cast<float4*>(ok + 4) = make_float4(x[4], x[5], x[6], x[7]);
        }
        if (!isctx) {
          const int pos = (d0 < 32) ? (tpos >> 6) : (tpos & 63);
          const float4* rt = reinterpret_cast<const float4*>(p.rope + (size_t)(pos * 16 + (d0 & 15)) * 2);
          const float4 r0 = rt[0], r1 = rt[1], r2 = rt[2], r3 = rt[3];
          const float cs[8] = {r0.x, r0.z, r1.x, r1.z, r2.x, r2.z, r3.x, r3.z};
          const float sn[8] = {r0.y, r0.w, r1.y, r1.w, r2.y, r2.w, r3.y, r3.w};
          const float sg = (d0 & 16) ? 1.f : -1.f;
#pragma unroll
          for (int e = 0; e < 8; ++e) { const float pe = dpp_mov<0x4E>(x[e]); x[e] = x[e] * cs[e] + sg * pe * sn[e]; }
        }
        if (!isk) {
#pragma unroll
          for (int e = 0; e < 8; ++e) x[e] *= QSCALE;
          if (isctx) pack8_store(p.QGc + (size_t)tokg * 512 + g * 8, x);
          else pack8_store(p.QGl + (size_t)(tokg - NCTX) * 512 + g * 8, x);
        } else {
          if (isctx) pack8_store(p.KGc + (size_t)(b * 2 + hd) * 16384 + kf_off(tkey, d0), x);
          else pack8_store(p.KGl + ((size_t)((layer * 2 + b) * 2 + hd)) * 98304 + kf_off(tkey, d0), x);
        }
      }
    }
    const int c = tid;
#pragma unroll
    for (int half = 0; half < 2; ++half) {
      float vv[8];
#pragma unroll
      for (int t8 = 0; t8 < 8; ++t8) {
        const int tt = half * 8 + t8, tokn = tok0 + tt;
        const float v = p.PROJ[(size_t)tokn * DIN + 1664 + c];
        vv[t8] = v;
        if (isctx) p.out_nav[((size_t)(b * 4 + layer) * 256 + tpos0 + tt) * 256 + c] = v;
      }
      if (isctx) pack44_store(p.VNtc + (size_t)(b * 4 + (c >> 6)) * 16384, tpos0 + half * 8, c & 63, vv);
      else pack44_store(p.VNtl + ((size_t)((layer * 2 + b) * 4 + (c >> 6))) * 98304, 512 + tpos0 + half * 8, c & 63, vv);
    }
    if (wid >= 2) {
      const int cv = c - 128;
#pragma unroll
      for (int half = 0; half < 2; ++half) {
        float vv[8];
#pragma unroll
        for (int t8 = 0; t8 < 8; ++t8) {
          const int tt = half * 8 + t8, tokn = tok0 + tt;
          const float v = p.PROJ[(size_t)tokn * DIN + 2560 + cv];
          vv[t8] = v;
          if (isctx) p.out_gv[((size_t)(b * 4 + layer) * 256 + tpos0 + tt) * 128 + cv] = v;
        }
        if (isctx) pack44_store(p.VGtc + (size_t)(b * 2 + (cv >> 6)) * 16384, tpos0 + half * 8, cv & 63, vv);
        else pack44_store(p.VGtl + ((size_t)((layer * 2 + b) * 2 + (cv >> 6))) * 98304, 512 + tpos0 + half * 8, cv & 63, vv);
      }
    }
#endif
    }
    __syncthreads();
  }
}

#define ATT_LOAD(KF, VF, CI) { \
    const int ci_ = min((CI), nt - 1); \
    int kb_; \
    if (ci_ < nd) kb_ = ci_ * 32; \
    else { const int e_ = ci_ - nd; const int j_ = (ncc == 2) ? (e_ >> 1) : e_; const int cc_ = cc0 + ((ncc == 2) ? (e_ & 1) : 0); kb_ = 512 + (rb + j_) * 64 + cc_ * 32; } \
    const u16* kp_ = Kb + (size_t)(kb_ >> 4) * 1024 + lane * 8; \
    KF##00 = *reinterpret_cast<const bf16x8*>(kp_); \
    KF##01 = *reinterpret_cast<const bf16x8*>(kp_ + 512); \
    KF##10 = *reinterpret_cast<const bf16x8*>(kp_ + 1024); \
    KF##11 = *reinterpret_cast<const bf16x8*>(kp_ + 1536); \
    const u16* vp_ = Vt + (size_t)(kb_ >> 5) * 2048 + lane * 8; \
    VF##0 = *reinterpret_cast<const bf16x8*>(vp_); \
    VF##1 = *reinterpret_cast<const bf16x8*>(vp_ + 512); \
    VF##2 = *reinterpret_cast<const bf16x8*>(vp_ + 1024); \
    VF##3 = *reinterpret_cast<const bf16x8*>(vp_ + 1536); }

#define ATT_PV(DT, VV) { \
    o[DT][0] *= alpha; o[DT][1] *= alpha; o[DT][2] *= alpha; o[DT][3] *= alpha; \
    o[DT] = __builtin_amdgcn_mfma_f32_16x16x32_bf16(VV, pf.v, o[DT], 0, 0, 0); }

#define ATT_COMPUTE(KF, VF, CI) { \
    const int ci_ = (CI); \
    f32x4 s0 = (f32x4){0.f, 0.f, 0.f, 0.f}, s1 = (f32x4){0.f, 0.f, 0.f, 0.f}; \
    s0 = __builtin_amdgcn_mfma_f32_16x16x32_bf16(KF##00, qf0, s0, 0, 0, 0); \
    s0 = __builtin_amdgcn_mfma_f32_16x16x32_bf16(KF##01, qf1, s0, 0, 0, 0); \
    s1 = __builtin_amdgcn_mfma_f32_16x16x32_bf16(KF##10, qf0, s1, 0, 0, 0); \
    s1 = __builtin_amdgcn_mfma_f32_16x16x32_bf16(KF##11, qf1, s1, 0, 0, 0); \
    float sv[8] = {s0[0], s0[1], s0[2], s0[3], s1[0], s1[1], s1[2], s1[3]}; \
    bool ok[8]; \
    _Pragma("unroll") for (int e = 0; e < 8; ++e) ok[e] = true; \
    if (ci_ >= nd) { \
      const int e_ = ci_ - nd; const int j_ = (ncc == 2) ? (e_ >> 1) : e_; const int cc_ = cc0 + ((ncc == 2) ? (e_ & 1) : 0); \
      const int dr_ = rb + j_ - grow + 7; \
      const int cq = cq0 + fr, c0 = min(max(cq - 8, 0), 48); \
      _Pragma("unroll") for (int e = 0; e < 8; ++e) { \
        const int ck = cc_ * 32 + 16 * (e >> 2) + 4 * fq + (e & 3); \
        ok[e] = (ck >= c0) && (ck < c0 + 16); \
        const int dc = min(max(ck - cq, -15), 15) + 15; \
        const float bias = rpb[dr_ * 31 + dc] * LOG2E; \
        sv[e] = ok[e] ? sv[e] + bias : -1e30f; \
      } \
    } \
    float mx = fmaxf(fmaxf(fmaxf(sv[0], sv[1]), fmaxf(sv[2], sv[3])), fmaxf(fmaxf(sv[4], sv[5]), fmaxf(sv[6], sv[7]))); \
    mx = fmaxf(mx, __shfl_xor(mx, 16)); \
    mx = fmaxf(mx, __shfl_xor(mx, 32)); \
    const float mn = fmaxf(m, mx); \
    const float alpha = __builtin_amdgcn_exp2f(m - mn); \
    m = mn; \
    float ps = 0.f; \
    _Pragma("unroll") for (int e = 0; e < 8; ++e) { sv[e] = ok[e] ? __builtin_amdgcn_exp2f(sv[e] - mn) : 0.f; ps += sv[e]; } \
    l = l * alpha + ps; \
    union { bf16x8 v; unsigned u[4]; } pf; \
    pf.u[0] = pack2(sv[0], sv[1]); pf.u[1] = pack2(sv[2], sv[3]); pf.u[2] = pack2(sv[4], sv[5]); pf.u[3] = pack2(sv[6], sv[7]); \
    ATT_PV(0, VF##0) ATT_PV(1, VF##1) ATT_PV(2, VF##2) ATT_PV(3, VF##3) }

__device__ __forceinline__ void attn_wave(const u16* __restrict__ Q, int ldq, const u16* __restrict__ Kb, int ldk,
                                          const u16* __restrict__ Vt, int ldv, int ndense, const bool NA,
                                          const float* __restrict__ rpb, int grow, int cq0,
                                          u16* __restrict__ out, int ldo, int tidx) {
  const int lane = tidx & 63, fr = lane & 15, fq = lane >> 4;
  const bf16x8 qf0 = *reinterpret_cast<const bf16x8*>(Q + (size_t)fr * ldq + fq * 8);
  const bf16x8 qf1 = *reinterpret_cast<const bf16x8*>(Q + (size_t)fr * ldq + 32 + fq * 8);
  f32x4 o[4];
#pragma unroll
  for (int dt = 0; dt < 4; ++dt) o[dt] = (f32x4){0.f, 0.f, 0.f, 0.f};
  float m = -1e30f, l = 0.f;
  const int nd = ndense >> 5;
  const int rb = min(max(grow - 4, 0), 8);
  const int ulo = min(max(cq0 - 8, 0), 48), uhi = min(max(cq0 + 15 - 8, 0), 48) + 16;
  const bool c0ok = ulo < 32, c1ok = uhi > 32;
  const int ncc = (c0ok && c1ok) ? 2 : 1, cc0 = c0ok ? 0 : 1;
  const int nt = nd + (NA ? 8 * ncc : 0);
  bf16x8 ka00, ka01, ka10, ka11, kb00, kb01, kb10, kb11;
  bf16x8 va0, va1, va2, va3, vb0, vb1, vb2, vb3;
  ATT_LOAD(ka, va, 0)
  for (int ci = 0; ci < nt; ci += 2) {
    ATT_LOAD(kb, vb, ci + 1)
    ATT_COMPUTE(ka, va, ci)
    if (ci + 1 < nt) {
      ATT_LOAD(ka, va, ci + 2)
      ATT_COMPUTE(kb, vb, ci + 1)
    }
  }
  l += __shfl_xor(l, 16);
  l += __shfl_xor(l, 32);
  const float il = 1.f / l;
#pragma unroll
  for (int dt = 0; dt < 4; ++dt) {
    uint2 pk; pk.x = pack2(o[dt][0] * il, o[dt][1] * il); pk.y = pack2(o[dt][2] * il, o[dt][3] * il);
    *reinterpret_cast<uint2*>(out + (size_t)fr * ldo + 16 * dt + 4 * fq) = pk;
  }
}

__device__ void scan_item(const Params& p, int layer, char* smem, bool lat, int b, int h, int dir, int qd, int tidx) {
  const int tid = tidx, lane = tid & 63, wid = tid >> 6, rr = lane >> 4, j = lane & 15;
  const int L = lat ? 1024 : 256, seqbase = lat ? NCTX + b * 1024 : b * 256;
  const int rowl = wid * 4 + rr, row = qd * 16 + rowl;
  float* cbuf = reinterpret_cast<float*>(smem);
  float* obuf = cbuf + 2 * 16 * 6 * 64;
  float4 S = make_float4(0.f, 0.f, 0.f, 0.f);
  if (lat) S = *reinterpret_cast<const float4*>(p.in[2] + ((((size_t)(b * 4 + layer) * 2 + dir) * 4 + h) * 64 + row) * 64 + 4 * j);
  v2f S01 = (v2f){S.x, S.y}, S23 = (v2f){S.z, S.w};
  const int nch = L / 16;
  float* odst = dir == 0 ? p.OF : p.OB;
  float4 pre0, pre1, pre2, pre3, pre4, pre5;
#define SC_GL1(PR, I, CH) { const int idx = tid + 256 * (I), tt_ = idx / 96, rem = idx % 96, vec = rem >> 4, f4 = rem & 15; \
    const int st_ = (CH) * 16 + tt_, t_ = dir == 0 ? st_ : L - 1 - st_; const int svec = vec < 3 ? vec : vec + 3 * dir; \
    PR = *reinterpret_cast<const float4*>(p.SC + ((size_t)((seqbase + t_) * 4 + h) * 9 + svec) * 64 + f4 * 4); }
#define gload(CH) { SC_GL1(pre0, 0, CH) SC_GL1(pre1, 1, CH) SC_GL1(pre2, 2, CH) SC_GL1(pre3, 3, CH) SC_GL1(pre4, 4, CH) SC_GL1(pre5, 5, CH) }
#define SC_LS1(PR, I, BUF) *reinterpret_cast<float4*>(cbuf + (BUF) * 6144 + (tid + 256 * (I)) * 4) = PR;
#define lstore(BUF) { SC_LS1(pre0, 0, BUF) SC_LS1(pre1, 1, BUF) SC_LS1(pre2, 2, BUF) SC_LS1(pre3, 3, BUF) SC_LS1(pre4, 4, BUF) SC_LS1(pre5, 5, BUF) }
  gload(0); lstore(0);
  __syncthreads();
#define SC_LD(R4, K4, VV, W4, A4, D4, TT) { const float* base_ = cb + (TT) * 384; \
    R4 = *reinterpret_cast<const float4*>(base_ + 4 * j); K4 = *reinterpret_cast<const float4*>(base_ + 64 + 4 * j); \
    VV = base_[128 + row]; W4 = *reinterpret_cast<const float4*>(base_ + 192 + 4 * j); \
    A4 = *reinterpret_cast<const float4*>(base_ + 256 + 4 * j); D4 = *reinterpret_cast<const float4*>(base_ + 320 + 4 * j); }
#if SCANVAR
  for (int pass_ = 0; pass_ < (lat ? 2 : 1); ++pass_) {
  int var_ = pass_ ? SCANVAR : 0;
  asm volatile("" : "+v"(var_)); var_ = __builtin_amdgcn_readfirstlane(var_);
#else
  const int var_ = 0;
#endif
  for (int ch = 0; ch < nch; ++ch) {
    if (ch + 1 < nch && var_ != 3) gload(ch + 1);
    const float* cb = cbuf + (ch & 1) * 6144;
    float osel = 0.f;
    float4 r4, kk4, w4, ak4, kd4; float vv;
    SC_LD(r4, kk4, vv, w4, ak4, kd4, 0)
    if (var_ != 2)
#pragma unroll 1
    for (int hf = 0; hf < 2; ++hf) {
      float oqA = 0.f, oqB = 0.f, ovp = 0.f;
#pragma unroll
      for (int u = 0; u < 8; ++u) {
        const int tt = hf * 8 + u;
        float4 r4n, kk4n, w4n, ak4n, kd4n; float vvn;
        SC_LD(r4n, kk4n, vvn, w4n, ak4n, kd4n, tt + 1)
        v2f p = S01 * (v2f){kk4.x, kk4.y};
        p = S23 * (v2f){kk4.z, kk4.w} + p;
        float sk = p.x + p.y;
        sk += dpp_mov<0xB1>(sk);  ovp += dpp_mov<0xB1>(ovp);
        sk += dpp_mov<0x4E>(sk);  ovp += dpp_mov<0x4E>(ovp);
        sk += dpp_mov<0x141>(sk);
        sk += dpp_mov<0x140>(sk);
        if (u > 0) {
          if (((u - 1) >> 2) == 0) oqA = ((j & 3) == ((u - 1) & 3)) ? ovp : oqA;
          else oqB = ((j & 3) == ((u - 1) & 3)) ? ovp : oqB;
        }
        const v2f vv2 = (v2f){vv, vv}, sk2 = (v2f){sk, sk};
        v2f t01 = (v2f){kd4.x, kd4.y} * vv2; t01 = t01 - (v2f){ak4.x, ak4.y} * sk2;
        v2f t23 = (v2f){kd4.z, kd4.w} * vv2; t23 = t23 - (v2f){ak4.z, ak4.w} * sk2;
        S01 = S01 * (v2f){w4.x, w4.y} + t01;
        S23 = S23 * (v2f){w4.z, w4.w} + t23;
        v2f q = S01 * (v2f){r4.x, r4.y};
        q = S23 * (v2f){r4.z, r4.w} + q;
        ovp = q.x + q.y;
        r4 = r4n; kk4 = kk4n; w4 = w4n; ak4 = ak4n; kd4 = kd4n; vv = vvn;
      }
      ovp += dpp_mov<0xB1>(ovp); ovp += dpp_mov<0x4E>(ovp);
      oqB = ((j & 3) == 3) ? ovp : oqB;
      oqA += dpp_mov<0x128>(oqA); oqB += dpp_mov<0x128>(oqB);
      oqA += dpp_mov<0x124>(oqA); oqB += dpp_mov<0x124>(oqB);
      if ((j >> 3) == hf) osel = ((j >> 2) & 1) ? oqB : oqA;
    }
    if (var_ == 0) {
      const int st = ch * 16 + j, t = dir == 0 ? st : L - 1 - st;
      odst[(size_t)(seqbase + t) * 256 + h * 64 + row] = osel;
    } else asm volatile("" :: "v"(osel), "v"(S01), "v"(S23));
    if (ch + 1 < nch && var_ != 3) lstore((ch + 1) & 1);
    asm volatile("s_waitcnt lgkmcnt(0)" ::: "memory");
    __builtin_amdgcn_s_barrier();
  }
#if SCANVAR
  }
#endif
  if (!lat) *reinterpret_cast<float4*>(p.out_st + ((((size_t)(b * 4 + layer) * 2 + dir) * 4 + h) * 64 + row) * 64 + 4 * j) = make_float4(S01.x, S01.y, S23.x, S23.y);
  __syncthreads();
}

__device__ void mixer_phase(const Params& p, int layer_wq, char* smem, int tidx0) {
  const int layer = layer_wq & 3;
  int* slot = reinterpret_cast<int*>(smem + 60 * 1024);
  bool first = true;
  for (;;) {
    int tidx = tidx0;
    asm volatile("" : "+v"(tidx));
    const int tid = tidx, wid = tid >> 6;
    __syncthreads();
    if (tid == 0) *slot = first ? (int)blockIdx.x : (int)(gridDim.x + atomicAdd(&p.wq[layer_wq], 1u));
    first = false;
    __syncthreads();
    int it = *slot;
    if (it >= 1728) break;
    const bool is_scan = (it < 64) || (it >= 448 && it < 960);
#if REPMASK
    if ((p.pad == 1 && !is_scan) || (p.pad == 2 && is_scan) || ((p.pad == 3 || p.pad == 5 || p.pad == 6) && !(it < 64)) || (p.pad == 4 && !(it >= 64 && it < 320))) continue;
#endif
    if (is_scan) {
      const bool lat = it < 64;
      const int si = lat ? it : it - 448;
#ifndef NO_SCAN
      scan_item(p, layer, smem, lat, si / 32, (si / 8) % 4, (si / 4) % 2, si % 4, tidx);
#endif
      continue;
    }
    const u16 *Q, *Kb, *Vt; u16* out; int ldq, ldk, ldv, ndense, grow = 0, cq0 = 0; bool na = false;
    const float* rpb = p.in[23];
    if (it < 320) {
      it -= 64;
      const int b = it / 128, qh = (it / 16) % 8, qt = it % 16, kvh = qh >> 2;
      const int q0 = b * 1024 + qt * 64 + wid * 16;
      Q = p.QGl + (size_t)q0 * 512 + qh * 64; ldq = 512;
      Kb = p.KGl + (size_t)((layer * 2 + b) * 2 + kvh) * 98304; ldk = 0;
      Vt = p.VGtl + (size_t)((layer * 2 + b) * 2 + kvh) * 98304; ldv = 0; ndense = 1536;
      out = p.MIX + (size_t)(NCTX + q0) * DM + 512 + qh * 64;
    } else if (it < 448) {
      it -= 320;
      const int b = it / 64, h = (it / 16) % 4, r = it % 16;
      const int q0 = b * 1024 + r * 64 + wid * 16;
      Q = p.QNl + (size_t)q0 * 256 + h * 64; ldq = 256;
      Kb = p.KNl + (size_t)((layer * 2 + b) * 4 + h) * 98304; ldk = 0;
      Vt = p.VNtl + (size_t)((layer * 2 + b) * 4 + h) * 98304; ldv = 0; ndense = 512;
      rpb = p.in[23] + (size_t)(layer * 4 + h) * 15 * 31; grow = r; cq0 = wid * 16; na = true;
      out = p.MIX + (size_t)(NCTX + q0) * DM + 256 + h * 64;
    } else if (it < 1472) {
      it -= 960;
      const int b = it / 32, qh = (it / 4) % 8, qt = it % 4, kvh = qh >> 2;
      const int q0 = b * 256 + qt * 64 + wid * 16;
      Q = p.QGc + (size_t)q0 * 512 + qh * 64; ldq = 512;
      Kb = p.KGc + (size_t)(b * 2 + kvh) * 16384; ldk = 0;
      Vt = p.VGtc + (size_t)(b * 2 + kvh) * 16384; ldv = 0; ndense = 256;
      out = p.MIX + (size_t)q0 * DM + 512 + qh * 64;
    } else {
      it -= 1472;
      const int b = it / 16, h = (it / 4) % 4, qt = it % 4;
      const int q0 = b * 256 + qt * 64 + wid * 16;
      Q = p.QNc + (size_t)q0 * 256 + h * 64; ldq = 256;
      Kb = p.KNc + (size_t)(b * 4 + h) * 16384; ldk = 0;
      Vt = p.VNtc + (size_t)(b * 4 + h) * 16384; ldv = 0; ndense = 256;
      out = p.MIX + (size_t)q0 * DM + 256 + h * 64;
    }
#ifndef NO_ATT
    attn_wave(Q, ldq, Kb, ldk, Vt, ldv, ndense, na, rpb, grow, cq0, out, DM, tidx);
#endif
  }
}

__device__ void rwkv_fin_phase(const Params& p, int layer, int bid, int nblk, int tidx) {
  const int tid = tidx;
  const float lw = p.in[21][(size_t)layer * 256 + tid], lb = p.in[22][(size_t)layer * 256 + tid];
  for (int t4 = bid; t4 < NTOK / 4; t4 += nblk) {
    float of[4], ob[4], bv[4], gg[4];
#pragma unroll
    for (int u = 0; u < 4; ++u) {
      const size_t i = (size_t)(t4 * 4 + u) * 256 + tid;
      of[u] = p.OF[i]; ob[u] = p.OB[i]; bv[u] = p.BV[i]; gg[u] = p.G[i];
    }
#pragma unroll
    for (int u = 0; u < 4; ++u) {
      const float o = of[u] + ob[u];
      const float mu = wave_sum(o) * (1.f / 64.f);
      const float d = o - mu;
      const float var = wave_sum(d * d) * (1.f / 64.f);
      const float y = (d * rsqrtf(var + 64e-5f) * lw + lb + bv[u]) * gg[u];
      p.MIX[(size_t)(t4 * 4 + u) * DM + tid] = f2bf(y);
    }
  }
}

#ifndef ONLY_PH
#define ONLY_PH -1
#endif
#define PH_EN(x) (ONLY_PH < 0 || ONLY_PH == (x))
__device__ __forceinline__ void run_phase(const Params& p, int ph, char* smem, int bid, int nblk, int tidx, int rep = 0) {
  if (ph == 0) { if (PH_EN(0)) setup_phase(p, smem, bid, nblk, tidx); return; }
  if (ph == 1) { if (PH_EN(1)) modreduce_phase(p, bid, nblk, tidx); return; }
  if (ph == 2) { if (PH_EN(2)) ln_phase<0>(p, 0, bid, nblk, tidx); return; }
  const int layer = (ph - 3) / 9, s = (ph - 3) % 9;
  switch (s) {
    case 0: if (PH_EN(3)) gemm_phase<EPI_PROJ, 256, 3>(p, layer, p.A, p.winT + (size_t)layer * DIN * DM, DIN, DM, smem, bid, nblk, tidx); break;
    case 1: if (PH_EN(4)) prep_phase(p, layer, smem, bid, nblk, tidx, rep); break;
    case 2: if (PH_EN(5)) mixer_phase(p, layer + 4 * rep, smem, tidx); break;
    case 3: if (PH_EN(6)) rwkv_fin_phase(p, layer, bid, nblk, tidx); break;
    case 4: if (PH_EN(7)) gemm_phase<EPI_OUT, 192, 3>(p, layer, p.MIX, p.woutT + (size_t)layer * DM * DM, DM, DM, smem, bid, nblk, tidx); break;
    case 5: if (PH_EN(8)) ln_phase<1>(p, layer, bid, nblk, tidx); break;
    case 6: if (PH_EN(9)) gemm_phase<EPI_FFI, 192, 3>(p, layer, p.A, p.wfiT + (size_t)layer * 2 * DFF * DM, 2 * DFF, DM, smem, bid, nblk, tidx); break;
    case 7: if (PH_EN(10)) gemm_phase<EPI_FFO, 192, 3>(p, layer, p.ACT, p.wfoT + (size_t)layer * DM * DFF, DM, DFF, smem, bid, nblk, tidx); break;
    default: if (PH_EN(11)) ln_phase<2>(p, layer, bid, nblk, tidx); break;
  }
}

__global__ void __launch_bounds__(256, 2) fwd_kernel(Params p, int ph0, int ph1, int usebar) {
  __shared__ __attribute__((aligned(16))) char smem[73728 + 16];
  const int bid = blockIdx.x, nblk = gridDim.x;
  XcdBarrier xb;
  if (usebar && p.never) cg::this_grid().sync();
  if (usebar) {
    if (threadIdx.x == 0) *reinterpret_cast<uint4*>(smem + 73728) = make_uint4(0u, 0u, 0u, 0u);
    __syncthreads();
    xb = xcd_barrier_post(p.bar, (volatile LAS unsigned*)(smem + 73728));
  }
  int ph = ph0, rep = 0;
  while (ph < ph1) {
    int tidx = threadIdx.x;
    asm volatile("" : "+v"(tidx));
    run_phase(p, ph, smem, bid, nblk, tidx, rep);
#if REPSLOT >= 0
    if (((ph < 3 ? 9 + ph : (ph - 3) % 9) == REPSLOT) && rep == 0) rep = 1; else { rep = 0; ++ph; }
#else
    ++ph;
#endif
    if (usebar && ph < ph1) xcd_barrier(xb);
  }
}

static inline size_t al256(size_t x) { return (x + 255) & ~(size_t)255; }

extern "C" void kernel_launch(void* const* d_in, const int* in_sizes, int n_in, void* d_out, int out_size, void* d_ws, size_t ws_size,
                              hipStream_t stream) {
  Params p;
  memset(&p, 0, sizeof(p));
  for (int i = 0; i < 33; ++i) p.in[i] = (const float*)d_in[i];
  float* o = (float*)d_out;
  p.out_yp = o; o += 4194304;
  p.out_ys = o; o += 2097152;
  p.out_st = o; o += 2097152;
  p.out_nak = o; o += 4194304;
  p.out_nav = o; o += 4194304;
  p.out_gk = o; o += 2097152;
  p.out_gv = o;
  char* w = (char*)d_ws; size_t off = 0;
  auto take = [&](size_t bytes) { char* r = w + off; off += al256(bytes); return r; };
  p.bar = (unsigned*)take(16384);
  p.wq = p.bar + 3584;
  p.modp = (float*)take((size_t)4 * 32 * 3 * 6144 * 4);
  p.mod = (float*)take((size_t)4 * 3 * 6144 * 4);
  p.winT = (u16*)take((size_t)4 * DIN * DM * 2);
  p.woutT = (u16*)take((size_t)4 * DM * DM * 2);
  p.wfiT = (u16*)take((size_t)4 * 2 * DFF * DM * 2);
  p.wfoT = (u16*)take((size_t)4 * DM * DFF * 2);
  p.X = (float*)take((size_t)NTOK * DM * 4);
  p.PROJ = (float*)take((size_t)NTOK * DIN * 4);
  p.X1 = p.PROJ;
  p.Y = p.PROJ + (size_t)NTOK * DM;
  p.SC = (float*)take((size_t)NTOK * 4 * 9 * 64 * 4);
  p.ACT = (u16*)p.SC;
  p.G = (float*)take((size_t)NTOK * 256 * 4);
  p.BV = (float*)take((size_t)NTOK * 256 * 4);
  p.OF = (float*)take((size_t)NTOK * 256 * 4);
  p.OB = (float*)take((size_t)NTOK * 256 * 4);
  p.A = (u16*)take((size_t)NTOK * DM * 2);
  p.MIX = (u16*)take((size_t)NTOK * DM * 2);
  p.QNc = (u16*)take((size_t)NCTX * 256 * 2);
  p.KNc = (u16*)take((size_t)NCTX * 256 * 2);
  p.VNtc = (u16*)take((size_t)NCTX * 256 * 2);
  p.QGc = (u16*)take((size_t)NCTX * 512 * 2);
  p.KGc = (u16*)take((size_t)NCTX * 128 * 2);
  p.VGtc = (u16*)take((size_t)NCTX * 128 * 2);
  p.QNl = (u16*)take((size_t)2048 * 256 * 2);
  p.KNl = (u16*)take((size_t)4 * 2 * 1536 * 256 * 2);
  p.VNtl = (u16*)take((size_t)4 * 2 * 1536 * 256 * 2);
  p.QGl = (u16*)take((size_t)2048 * 512 * 2);
  p.KGl = (u16*)take((size_t)4 * 2 * 1536 * 128 * 2);
  p.VGtl = (u16*)take((size_t)4 * 2 * 1536 * 128 * 2);
  p.loraT = (u16*)take((size_t)4 * 98304 * 2);
  p.rope = (float*)take((size_t)64 * 16 * 2 * 4);
  if (off > ws_size) { fprintf(stderr, "workspace too small: need %zu have %zu\n", off, ws_size); return; }

  (void)hipMemsetAsync(p.bar, 0, 16384, stream);
#if MEGA
  static int grid_blocks = 0;
  if (!grid_blocks) {
    int dev = 0, cus = 0, per_cu = 0;
    hipGetDevice(&dev);
    hipDeviceGetAttribute(&cus, hipDeviceAttributeMultiprocessorCount, dev);
    hipOccupancyMaxActiveBlocksPerMultiprocessor(&per_cu, fwd_kernel, 256, 0);
    if (per_cu > 2) per_cu = 2;
    if (per_cu < 1) per_cu = 1;
    grid_blocks = cus * per_cu;
  }
  int ph0 = 0, ph1 = NPH, ub = 1;
  void* args[] = {&p, &ph0, &ph1, &ub};
  hipError_t e = hipLaunchCooperativeKernel((void*)fwd_kernel, dim3(grid_blocks), dim3(256), args, 0, stream);
  if (e != hipSuccess) fprintf(stderr, "cooperative launch failed: %s (grid %d)\n", hipGetErrorString(e), grid_blocks);
#else
  for (int ph = 0; ph < NPH; ++ph) fwd_kernel<<<512, 256, 0, stream>>>(p, ph, ph + 1, 0);
#endif
}
```

```cpp
#include <hip/hip_runtime.h>
#include <hip/hip_cooperative_groups.h>
#include <cstdio>
#include <cstdint>
#include <cstring>
namespace cg = cooperative_groups;

#ifndef REPMASK
#define REPMASK 0
#endif
#ifndef REPSLOT
#define REPSLOT -1
#endif
#ifndef PREPVAR
#define PREPVAR 0
#endif
#ifndef SCANVAR
#define SCANVAR 0
#endif
#ifndef REPVAR
#define REPVAR 0
#endif
#ifndef MEGA
#define MEGA 1
#endif

typedef unsigned short u16;
using bf16x8 = __attribute__((ext_vector_type(8))) short;
using f32x4 = __attribute__((ext_vector_type(4))) float;
using v2f = __attribute__((ext_vector_type(2))) float;

#define NTOK 6144
#define NCTX 4096
#define DM 1024
#define DIN 2688
#define DFF 2816
#define NPH 39
#define ALPHA 1.681792830507429f
#define LOG2E 1.4426950408889634f
#define QSCALE (0.125f * LOG2E)

struct Params {
  const float* in[33];
  float *out_yp, *out_ys, *out_st, *out_nak, *out_nav, *out_gk, *out_gv;
  unsigned *bar, *wq;
  float *modp, *mod;
  u16 *winT, *woutT, *wfiT, *wfoT;
  float *X, *X1, *Y, *PROJ, *SC, *G, *BV, *OF, *OB;
  u16 *A, *MIX, *ACT;
  u16 *QNc, *KNc, *VNtc, *QGc, *KGc, *VGtc;
  u16 *QNl, *KNl, *VNtl, *QGl, *KGl, *VGtl;
  u16* loraT; float* rope;
  int never; int pad;
};

__device__ __forceinline__ u16 f2bf(float f) {
  unsigned u = __float_as_uint(f);
  u += 0x7FFFu + ((u >> 16) & 1u);
  return (u16)(u >> 16);
}
typedef __bf16 bf16v2 __attribute__((ext_vector_type(2)));
__device__ __forceinline__ unsigned pack2(float a, float b) {
  const bf16v2 r = __builtin_convertvector((v2f){a, b}, bf16v2);
  return __builtin_bit_cast(unsigned, r);
}
template <int CTRL> __device__ __forceinline__ float dpp_mov(float v) {
  return __int_as_float(__builtin_amdgcn_update_dpp(0, __float_as_int(v), CTRL, 0xF, 0xF, false));
}
__device__ __forceinline__ float reduce16(float v) {
  v += dpp_mov<0xB1>(v);
  v += dpp_mov<0x4E>(v);
  v += dpp_mov<0x141>(v);
  v += dpp_mov<0x140>(v);
  return v;
}
__device__ __forceinline__ float wave_sum(float v) {
  v = reduce16(v);
  v += __shfl_xor(v, 16);
  v += __shfl_xor(v, 32);
  return v;
}
__device__ __forceinline__ float tanhf_(float x) { const float e = __expf(-2.f * fabsf(x)); const float t = (1.f - e) / (1.f + e); return x < 0.f ? -t : t; }
__device__ __forceinline__ float sigmoidf_(float x) { return 1.f / (1.f + __expf(-x)); }
__device__ __forceinline__ float siluf_(float x) { return x / (1.f + __expf(-x)); }
__device__ __forceinline__ int modrow_of(int tok) { return tok < NCTX ? 0 : 1 + ((tok - NCTX) >> 10); }

#define XB_TMO      128
#define XB_XCNT(j)  (256  + 64 * (j))
#define XB_XSUB(j)  (1280 + 64 * (j))
#define XB_XGEN(j)  (2304 + 64 * (j))
#define XB_TOP      3328
#define XB_TOPGEN   3392
#define XCD_BAR_WORDS 3456
#define XB_SPIN_CAP (1u << 22)
#define LAS __attribute__((address_space(3)))
__device__ __forceinline__ unsigned xb_ld(unsigned* p) { return __hip_atomic_load(p, __ATOMIC_RELAXED, __HIP_MEMORY_SCOPE_AGENT); }
__device__ __forceinline__ unsigned xb_add(unsigned* p, unsigned v) { return __hip_atomic_fetch_add(p, v, __ATOMIC_RELAXED, __HIP_MEMORY_SCOPE_AGENT); }
__device__ __forceinline__ unsigned xb_xcc_id() { return (unsigned)__builtin_amdgcn_s_getreg((3 << 11) | 20) & 0xFu; }
#define XB_SPIN(cond, bar) do { unsigned _sp = 0; while (cond) { __builtin_amdgcn_s_sleep(1); \
    if ((++_sp & 255u) == 0u) { if (xb_ld(&(bar)[XB_TMO])) break; if (_sp > XB_SPIN_CAP) { atomicAdd(&(bar)[XB_TMO], 1u); break; } } } } while (0)
struct XcdBarrier { unsigned* bar; unsigned x; volatile LAS unsigned* st; };
__device__ __forceinline__ XcdBarrier xcd_barrier_post(unsigned* bar, volatile LAS unsigned* st) {
  XcdBarrier b; b.bar = bar; b.x = xb_xcc_id(); b.st = st;
  if (threadIdx.x == 0) (void)xb_add(&bar[XB_XCNT(b.x)], 1u);
  return b;
}
__device__ __forceinline__ void xcd_barrier_complete(unsigned* bar, unsigned x, unsigned& nloc, unsigned& nx) {
  const unsigned G = gridDim.x * gridDim.y * gridDim.z;
  unsigned sum, cnt, mine, sp = 0u;
  for (;;) {
    sum = 0u; cnt = 0u; mine = 0u;
#pragma unroll
    for (unsigned j = 0; j < 16; ++j) { const unsigned c = xb_ld(&bar[XB_XCNT(j)]); sum += c; cnt += (c > 0u) ? 1u : 0u; mine = (j == x) ? c : mine; }
    if (sum == G) break;
    __builtin_amdgcn_s_sleep(1);
    if ((++sp & 255u) == 0u) { if (xb_ld(&bar[XB_TMO])) break; if (sp > XB_SPIN_CAP) { atomicAdd(&bar[XB_TMO], 1u); break; } }
  }
  nloc = mine > 0u ? mine : 1u; nx = cnt > 0u ? cnt : 1u;
}
__device__ __forceinline__ void xcd_barrier(const XcdBarrier& b) {
  asm volatile("s_waitcnt vmcnt(0)" ::: "memory");
  __syncthreads();
  if (threadIdx.x == 0) {
    unsigned* bar = b.bar;
    asm volatile("" : "+s"(bar));
    __builtin_amdgcn_s_waitcnt(0);
    unsigned nloc = b.st[0], nx = b.st[1];
    if (nloc == 0u) { xcd_barrier_complete(bar, b.x, nloc, nx); b.st[0] = nloc; b.st[1] = nx; }
    const unsigned old = xb_add(&bar[XB_XSUB(b.x)], 1u);
    const unsigned gen = old / nloc;
    if (old + 1u == (gen + 1u) * nloc) {
      __builtin_amdgcn_fence(__ATOMIC_RELEASE, "agent");
      asm volatile("s_waitcnt vmcnt(0)" ::: "memory");
      const unsigned og = xb_add(&bar[XB_TOP], 1u);
      const unsigned tg = og / nx;
      if (og + 1u == (tg + 1u) * nx) xb_add(&bar[XB_TOPGEN], 1u);
      else XB_SPIN(xb_ld(&bar[XB_TOPGEN]) == tg, bar);
      __builtin_amdgcn_fence(__ATOMIC_ACQUIRE, "agent");
      xb_add(&bar[XB_XGEN(b.x)], 1u);
      asm volatile("s_waitcnt vmcnt(0)" ::: "memory");
    } else {
      XB_SPIN(xb_ld(&bar[XB_XGEN(b.x)]) == gen, bar);
      __builtin_amdgcn_fence(__ATOMIC_ACQUIRE, "agent");
      asm volatile("s_waitcnt vmcnt(0)" ::: "memory");
    }
  }
  __syncthreads();
}

__device__ __forceinline__ int lds_byte32(int r, int c) {
  const int ob = (r & 15) * 64 + c * 2;
  return (r >> 4) * 1024 + (ob ^ (((ob >> 9) & 1) << 5));
}
__device__ __forceinline__ void stage_rc32(int b, int& R, int& C) {
  const int sb = b & 1023, swz = sb ^ (((sb >> 9) & 1) << 5);
  R = (b >> 10) * 16 + (swz >> 6); C = (swz & 63) >> 1;
}
template <int ROWS>
__device__ __forceinline__ void stage_tile32(const u16* __restrict__ g, int ld, char* lds, int tidx) {
#pragma unroll
  for (int i = 0; i < (ROWS * 64 + 4095) / 4096; ++i) {
    const int b = tidx * 16 + i * 4096;
    if ((i + 1) * 4096 <= ROWS * 64 || tidx < (ROWS * 64 - i * 4096) / 16) {
      int R, C; stage_rc32(b, R, C);
      __builtin_amdgcn_global_load_lds((const unsigned*)(g + (size_t)R * ld + C), (unsigned LAS*)(lds + b), 16, 0, 0);
    }
  }
}
template <int N> __device__ __forceinline__ void wait_vmcnt() {
  if (N == 0) asm volatile("s_waitcnt vmcnt(0)" ::: "memory");
  else if (N == 3) asm volatile("s_waitcnt vmcnt(3)" ::: "memory");
  else if (N == 4) asm volatile("s_waitcnt vmcnt(4)" ::: "memory");
  else if (N == 5) asm volatile("s_waitcnt vmcnt(5)" ::: "memory");
  else if (N == 6) asm volatile("s_waitcnt vmcnt(6)" ::: "memory");
  else if (N == 8) asm volatile("s_waitcnt vmcnt(8)" ::: "memory");
  else if (N == 9) asm volatile("s_waitcnt vmcnt(9)" ::: "memory");
  else if (N == 10) asm volatile("s_waitcnt vmcnt(10)" ::: "memory");
  else if (N == 12) asm volatile("s_waitcnt vmcnt(12)" ::: "memory");
  else asm volatile("s_waitcnt vmcnt(0)" ::: "memory");
}

enum { EPI_PROJ = 0, EPI_OUT = 1, EPI_FFI = 2, EPI_FFO = 3 };

template <int EPI, int BM, int NST>
__device__ __forceinline__ void gemm_phase(const Params& p, int layer, const u16* __restrict__ A, const u16* __restrict__ Bt,
                                           int N, int K, char* smem, int bid, int nblk, int tidx) {
  constexpr int MF = BM / 32;
  const int tid = tidx, lane = tid & 63, wid = tid >> 6, wr = wid >> 1, wc = wid & 1, fr = lane & 15, fq = lane >> 4;
  const int nM = NTOK / BM, nN = N / 128, ntiles = nM * nN, nk = K / 32;
  constexpr int SB = (BM + 128) * 64;
  constexpr int LA = (BM * 64) / 4096;
  const bool extraA = (BM == 96) && (wid < 2);
  for (int tile = bid; tile < ntiles; tile += nblk) {
    const int pm = tile % nM, pn = tile / nM, m0 = pm * BM, n0 = pn * 128;
    f32x4 acc[MF][4];
#pragma unroll
    for (int m = 0; m < MF; ++m)
#pragma unroll
      for (int n = 0; n < 4; ++n) acc[m][n] = (f32x4){0.f, 0.f, 0.f, 0.f};
    const u16* Ag = A + (size_t)m0 * K;
    const u16* Bg = Bt + (size_t)n0 * K;
#pragma unroll
    for (int s_ = 0; s_ < NST - 1; ++s_) {
      stage_tile32<BM>(Ag + s_ * 32, K, smem + s_ * SB, tidx);
      stage_tile32<128>(Bg + s_ * 32, K, smem + s_ * SB + BM * 64, tidx);
    }
    int slot = 0, pslot = NST - 1;
    for (int kt = 0; kt < nk; ++kt) {
      if (kt + NST - 2 < nk) {
        if (BM == 96) { if (extraA) wait_vmcnt<(NST - 2) * 4>(); else wait_vmcnt<(NST - 2) * 3>(); }
        else wait_vmcnt<(NST - 2) * (LA + 2)>();
      } else {
        asm volatile("s_waitcnt vmcnt(0)" ::: "memory");
      }
      __builtin_amdgcn_s_barrier();
      if (kt + NST - 1 < nk) {
        char* nb = smem + pslot * SB;
        stage_tile32<BM>(Ag + (kt + NST - 1) * 32, K, nb, tidx);
        stage_tile32<128>(Bg + (kt + NST - 1) * 32, K, nb + BM * 64, tidx);
      }
      const char* sa = smem + slot * SB;
      const char* sb = sa + BM * 64;
      slot = (slot + 1 == NST) ? 0 : slot + 1;
      pslot = (pslot + 1 == NST) ? 0 : pslot + 1;
      bf16x8 af[MF], bfr[4];
#pragma unroll
      for (int m = 0; m < MF; ++m) af[m] = *reinterpret_cast<const bf16x8*>(sa + lds_byte32(wr * (BM / 2) + m * 16 + fr, fq * 8));
#pragma unroll
      for (int n = 0; n < 4; ++n) bfr[n] = *reinterpret_cast<const bf16x8*>(sb + lds_byte32(wc * 64 + n * 16 + fr, fq * 8));
#pragma unroll
      for (int m = 0; m < MF; ++m)
#pragma unroll
        for (int n = 0; n < 4; ++n) acc[m][n] = __builtin_amdgcn_mfma_f32_16x16x32_bf16(bfr[n], af[m], acc[m][n], 0, 0, 0);
    }
#pragma unroll
    for (int m = 0; m < MF; ++m) {
      const int row = m0 + wr * (BM / 2) + m * 16 + fr;
      if (EPI == EPI_PROJ) {
#pragma unroll
        for (int n = 0; n < 4; ++n) {
          const int col = n0 + wc * 64 + n * 16 + 4 * fq;
          *reinterpret_cast<float4*>(p.PROJ + (size_t)row * DIN + col) = make_float4(acc[m][n][0], acc[m][n][1], acc[m][n][2], acc[m][n][3]);
        }
      } else if (EPI == EPI_OUT || EPI == EPI_FFO) {
        const float* res = (EPI == EPI_OUT) ? p.X : p.X1;
        const float* gate = p.mod + ((size_t)(layer * 3 + modrow_of(row)) * 6 + (EPI == EPI_OUT ? 2 : 5)) * 1024;
#pragma unroll
        for (int n = 0; n < 4; ++n) {
          const int col = n0 + wc * 64 + n * 16 + 4 * fq;
          const float4 xr = *reinterpret_cast<const float4*>(res + (size_t)row * DM + col);
          const float4 gt = *reinterpret_cast<const float4*>(gate + col);
          float4 y;
          y.x = ALPHA * xr.x + gt.x * acc[m][n][0];
          y.y = ALPHA * xr.y + gt.y * acc[m][n][1];
          y.z = ALPHA * xr.z + gt.z * acc[m][n][2];
          y.w = ALPHA * xr.w + gt.w * acc[m][n][3];
          *reinterpret_cast<float4*>(p.Y + (size_t)row * DM + col) = y;
        }
      } else {
#pragma unroll
        for (int n2 = 0; n2 < 2; ++n2) {
          const int j0 = ((n0 + wc * 64) / 32 + n2) * 16 + 4 * fq;
          float a[4];
#pragma unroll
          for (int r = 0; r < 4; ++r) a[r] = siluf_(acc[m][2 * n2][r]) * acc[m][2 * n2 + 1][r];
          uint2 pk; pk.x = pack2(a[0], a[1]); pk.y = pack2(a[2], a[3]);
          *reinterpret_cast<uint2*>(p.ACT + (size_t)row * DFF + j0) = pk;
        }
      }
    }
    asm volatile("s_waitcnt lgkmcnt(0)" ::: "memory");
    __builtin_amdgcn_s_barrier();
  }
}

__device__ __forceinline__ int kf_off(int t, int d) { return (t >> 4) * 1024 + (d >> 5) * 512 + ((d & 31) >> 3) * 128 + (t & 15) * 8 + (d & 7); }
__device__ __forceinline__ int vf_off(int t, int d) { return (t >> 5) * 2048 + (d >> 4) * 512 + (((t & 15) >> 2) * 16 + (d & 15)) * 8 + ((t >> 4) & 1) * 4 + (t & 3); }
__device__ __forceinline__ void pack44_store(u16* base, int t0, int d, const float* v) {
  uint2 a, b; a.x = pack2(v[0], v[1]); a.y = pack2(v[2], v[3]); b.x = pack2(v[4], v[5]); b.y = pack2(v[6], v[7]);
  *reinterpret_cast<uint2*>(base + vf_off(t0, d)) = a;
  *reinterpret_cast<uint2*>(base + vf_off(t0 + 4, d)) = b;
}
__device__ __forceinline__ void pack8_store(u16* dst, const float* v) {
  uint4 pk; pk.x = pack2(v[0], v[1]); pk.y = pack2(v[2], v[3]); pk.z = pack2(v[4], v[5]); pk.w = pack2(v[6], v[7]);
  *reinterpret_cast<uint4*>(dst) = pk;
}

__device__ void setup_phase(const Params& p, char* smem, int bid, int nblk, int tidx) {
  const int tid = tidx;
  const int NI = 768 + 512 + 13;
  for (int it = bid; it < NI; it += nblk) {
    if (it < 768) {
      const int l = it / 192, nc = (it / 32) % 6, kc = it % 32;
      const int col = nc * 1024 + tid * 4;
      const float* wm = p.in[9] + (size_t)l * 1024 * 6144;
      float4 a0 = make_float4(0, 0, 0, 0), a1 = a0, a2 = a0;
      for (int k8 = 0; k8 < 32; k8 += 8) {
        float4 w[8];
#pragma unroll
        for (int u = 0; u < 8; ++u) w[u] = *reinterpret_cast<const float4*>(wm + (size_t)(kc * 32 + k8 + u) * 6144 + col);
#pragma unroll
        for (int u = 0; u < 8; ++u) {
          const int k = kc * 32 + k8 + u;
          const float s0 = siluf_(p.in[8][k]), s1 = siluf_(p.in[7][k]), s2 = siluf_(p.in[7][1024 + k]);
          a0.x += s0 * w[u].x; a0.y += s0 * w[u].y; a0.z += s0 * w[u].z; a0.w += s0 * w[u].w;
          a1.x += s1 * w[u].x; a1.y += s1 * w[u].y; a1.z += s1 * w[u].z; a1.w += s1 * w[u].w;
          a2.x += s2 * w[u].x; a2.y += s2 * w[u].y; a2.z += s2 * w[u].z; a2.w += s2 * w[u].w;
        }
      }
      float* dst = p.modp + (size_t)((l * 32 + kc) * 3) * 6144 + col;
      *reinterpret_cast<float4*>(dst) = a0;
      *reinterpret_cast<float4*>(dst + 6144) = a1;
      *reinterpret_cast<float4*>(dst + 2 * 6144) = a2;
    } else if (it < 1280) {
      const int ci = it - 768, b = ci / 256, l = (ci / 64) % 4, tg = ci % 64, t0 = tg * 8;
      {
        const float* ck = p.in[3] + ((size_t)(b * 4 + l) * 512 + t0) * 256 + tid;
        const float* cv = p.in[4] + ((size_t)(b * 4 + l) * 512 + t0) * 256 + tid;
        float v[8];
#pragma unroll
        for (int tt = 0; tt < 8; ++tt) {
          p.KNl[((size_t)((l * 2 + b) * 4 + (tid >> 6))) * 98304 + kf_off(t0 + tt, tid & 63)] = f2bf(ck[tt * 256]);
          v[tt] = cv[tt * 256];
        }
        pack44_store(p.VNtl + ((size_t)((l * 2 + b) * 4 + (tid >> 6))) * 98304, t0, tid & 63, v);
      }
      if (tid < 128) {
        const float* ck = p.in[5] + ((size_t)(b * 4 + l) * 512 + t0) * 128 + tid;
#pragma unroll
        for (int tt = 0; tt < 8; ++tt) p.KGl[((size_t)((l * 2 + b) * 2 + (tid >> 6))) * 98304 + kf_off(t0 + tt, tid & 63)] = f2bf(ck[tt * 128]);
      } else {
        const int c = tid - 128;
        const float* cv = p.in[6] + ((size_t)(b * 4 + l) * 512 + t0) * 128 + c;
        float v[8];
#pragma unroll
        for (int tt = 0; tt < 8; ++tt) v[tt] = cv[tt * 128];
        pack44_store(p.VGtl + ((size_t)((l * 2 + b) * 2 + (c >> 6))) * 98304, t0, c & 63, v);
      }
    } else {
      const int li = it - (768 + 512);
      if (li == 12) {
        for (int idx = tid; idx < 1024; idx += 256) {
          const int pos = idx >> 4, fi = idx & 15;
          const float ang = (float)pos * exp2f(-(float)fi * (13.287712379549449f / 16.f));
          p.rope[idx * 2] = cosf(ang); p.rope[idx * 2 + 1] = sinf(ang);
        }
      } else {
        const int l = li / 3, m = li % 3;
        u16* dst = p.loraT + (size_t)l * 98304 + m * 32768;
        if (m < 2) {
          const float* src = p.in[m == 0 ? 14 : 16] + (size_t)l * 32768;
          for (int i0 = tid; i0 < 32768; i0 += 256 * 16) {
            float v[16];
#pragma unroll
            for (int u = 0; u < 16; ++u) { const int idx = i0 + 256 * u; const int d = idx >> 14, cch = (idx >> 6) & 255, r = idx & 63; v[u] = src[(d * 64 + r) * 256 + cch]; }
#pragma unroll
            for (int u = 0; u < 16; ++u) dst[i0 + 256 * u] = f2bf(v[u]);
          }
        } else {
          const float* src = p.in[17] + (size_t)l * 32768;
          for (int i0 = tid; i0 < 32768; i0 += 256 * 16) {
            float v[16];
#pragma unroll
            for (int u = 0; u < 16; ++u) { const int idx = i0 + 256 * u; const int cch = idx >> 7, j = idx & 127; v[u] = src[j * 256 + cch]; }
#pragma unroll
            for (int u = 0; u < 16; ++u) dst[i0 + 256 * u] = f2bf(v[u]);
          }
        }
      }
    }
  }
  {
    float* tile = reinterpret_cast<float*>(smem);
    const int NT = 4 * 3040;
    float4 cur0, cur1, cur2, cur3;
    const float* src; u16* dst; int K, N, mat, k0, n0;
#define TR_DECODE(TR) { const int l_ = (TR) / 3040; int r_ = (TR) % 3040; int kt_, nt_; \
      if (r_ < 672) { mat = 0; K = 1024; N = 2688; src = p.in[11] + (size_t)l_ * K * N; dst = p.winT + (size_t)l_ * N * K; kt_ = r_ / 42; nt_ = r_ % 42; } \
      else if (r_ < 928) { r_ -= 672; mat = 1; K = 1024; N = 1024; src = p.in[26] + (size_t)l_ * K * N; dst = p.woutT + (size_t)l_ * N * K; kt_ = r_ / 16; nt_ = r_ % 16; } \
      else if (r_ < 2336) { r_ -= 928; mat = 2; K = 1024; N = 5632; src = p.in[29] + (size_t)l_ * K * N; dst = p.wfiT + (size_t)l_ * N * K; kt_ = r_ / 88; nt_ = r_ % 88; } \
      else { r_ -= 2336; mat = 3; K = 2816; N = 1024; src = p.in[30] + (size_t)l_ * K * N; dst = p.wfoT + (size_t)l_ * N * K; kt_ = r_ / 16; nt_ = r_ % 16; } \
      k0 = kt_ * 64; n0 = nt_ * 64; }
#define TR_LOAD(V, I) V = *reinterpret_cast<const float4*>(src + (size_t)(k0 + (tid >> 4) + 16 * (I)) * N + n0 + (tid & 15) * 4);
#define TR_PUT(V, I) { const int kr_ = (tid >> 4) + 16 * (I), c4_ = (tid & 15) * 4; \
      tile[kr_ * 65 + c4_ + 0] = V.x; tile[kr_ * 65 + c4_ + 1] = V.y; tile[kr_ * 65 + c4_ + 2] = V.z; tile[kr_ * 65 + c4_ + 3] = V.w; }
    int tr = bid;
    if (tr < NT) { TR_DECODE(tr) TR_LOAD(cur0, 0) TR_LOAD(cur1, 1) TR_LOAD(cur2, 2) TR_LOAD(cur3, 3) }
    for (; tr < NT; tr += nblk) {
      TR_PUT(cur0, 0) TR_PUT(cur1, 1) TR_PUT(cur2, 2) TR_PUT(cur3, 3)
      if (tr + nblk < NT) { TR_DECODE(tr + nblk) TR_LOAD(cur0, 0) TR_LOAD(cur1, 1) TR_LOAD(cur2, 2) TR_LOAD(cur3, 3) }
      TR_DECODE(tr)
      __syncthreads();
#pragma unroll
      for (int i = 0; i < 2; ++i) {
        const int idx = tid + 256 * i, nl = idx >> 3, kc = idx & 7;
        int n = n0 + nl;
        if (mat == 2) { const int isup = n >= DFF ? 1 : 0; const int j = n - isup * DFF; n = (j >> 4) * 32 + isup * 16 + (j & 15); }
        float v[8];
#pragma unroll
        for (int jj = 0; jj < 8; ++jj) v[jj] = tile[(kc * 8 + jj) * 65 + nl];
        pack8_store(dst + (size_t)n * K + k0 + kc * 8, v);
      }
      __syncthreads();
    }
#undef TR_DECODE
#undef TR_LOAD
#undef TR_PUT
  }
}

__device__ void modreduce_phase(const Params& p, int bid, int nblk, int tidx) {
  for (int idx = bid * 256 + tidx; idx < 18432; idx += nblk * 256) {
    const int l = idx / 4608, rem = idx % 4608, mr = rem / 1536, c4 = (rem % 1536) * 4;
    float4 a = *reinterpret_cast<const float4*>(p.in[10] + (size_t)l * 6144 + c4);
    for (int k8 = 0; k8 < 32; k8 += 8) {
      float4 v[8];
#pragma unroll
      for (int u = 0; u < 8; ++u) v[u] = *reinterpret_cast<const float4*>(p.modp + (size_t)((l * 32 + k8 + u) * 3 + mr) * 6144 + c4);
#pragma unroll
      for (int u = 0; u < 8; ++u) { a.x += v[u].x; a.y += v[u].y; a.z += v[u].z; a.w += v[u].w; }
    }
    *reinterpret_cast<float4*>(p.mod + (size_t)(l * 3 + mr) * 6144 + c4) = a;
  }
}

template <int MODE>
__device__ void ln_phase(const Params& p, int layer, int bid, int nblk, int tidx) {
  const int lane = tidx & 63, wid = tidx >> 6;
  const bool fin = (MODE == 2 && layer == 3);
  const float* lw = (MODE == 1 ? p.in[27] : p.in[31]) + (size_t)layer * DM;
  const float* lb = (MODE == 1 ? p.in[28] : p.in[32]) + (size_t)layer * DM;
  const int ml = (MODE == 2) ? (layer + 1 < 4 ? layer + 1 : 3) : layer;
  const int which = (MODE == 1) ? 3 : 0;
#define LN_SRC(ROW) (MODE == 0 ? ((ROW) < NCTX ? p.in[0] + (size_t)(ROW) * DM : p.in[1] + (size_t)((ROW) - NCTX) * DM) : p.Y + (size_t)(ROW) * DM)
  float4 nv0, nv1, nv2, nv3;
  int it = bid;
  if (it < NTOK / 4) {
    const float4* s4 = reinterpret_cast<const float4*>(LN_SRC(it * 4 + wid));
    nv0 = s4[lane]; nv1 = s4[lane + 64]; nv2 = s4[lane + 128]; nv3 = s4[lane + 192];
  }
  for (; it < NTOK / 4; it += nblk) {
    const int row = it * 4 + wid;
    float4 v[4] = {nv0, nv1, nv2, nv3};
    if (it + nblk < NTOK / 4) {
      const float4* s4 = reinterpret_cast<const float4*>(LN_SRC((it + nblk) * 4 + wid));
      nv0 = s4[lane]; nv1 = s4[lane + 64]; nv2 = s4[lane + 128]; nv3 = s4[lane + 192];
    }
    float4 w4[4], b4[4], s4v[4], c4v[4];
    const float* sh = p.mod + ((size_t)(ml * 3 + modrow_of(row)) * 6 + which) * 1024;
    const float* sc = sh + 1024;
#pragma unroll
    for (int i = 0; i < 4; ++i) {
      if (MODE != 0) { w4[i] = reinterpret_cast<const float4*>(lw)[lane + 64 * i]; b4[i] = reinterpret_cast<const float4*>(lb)[lane + 64 * i]; }
      if (!fin) { s4v[i] = reinterpret_cast<const float4*>(sh)[lane + 64 * i]; c4v[i] = reinterpret_cast<const float4*>(sc)[lane + 64 * i]; }
    }
    if (MODE != 0) {
      float s = 0.f;
#pragma unroll
      for (int i = 0; i < 4; ++i) s += v[i].x + v[i].y + v[i].z + v[i].w;
      const float mu = wave_sum(s) * (1.f / 1024.f);
      float q = 0.f;
#pragma unroll
      for (int i = 0; i < 4; ++i) {
        v[i].x -= mu; v[i].y -= mu; v[i].z -= mu; v[i].w -= mu;
        q += v[i].x * v[i].x + v[i].y * v[i].y + v[i].z * v[i].z + v[i].w * v[i].w;
      }
      const float rstd = rsqrtf(wave_sum(q) * (1.f / 1024.f) + 1e-5f);
#pragma unroll
      for (int i = 0; i < 4; ++i) {
        v[i].x = v[i].x * rstd * w4[i].x + b4[i].x; v[i].y = v[i].y * rstd * w4[i].y + b4[i].y;
        v[i].z = v[i].z * rstd * w4[i].z + b4[i].z; v[i].w = v[i].w * rstd * w4[i].w + b4[i].w;
      }
    }
    float* xdst = (MODE == 1 ? p.X1 : p.X) + (size_t)row * DM;
#pragma unroll
    for (int i = 0; i < 4; ++i) reinterpret_cast<float4*>(xdst)[lane + 64 * i] = v[i];
    if (fin) {
      float* o = row < NCTX ? p.out_yp + (size_t)row * DM : p.out_ys + (size_t)(row - NCTX) * DM;
#pragma unroll
      for (int i = 0; i < 4; ++i) reinterpret_cast<float4*>(o)[lane + 64 * i] = v[i];
    } else {
      u16* adst = p.A + (size_t)row * DM;
#pragma unroll
      for (int i = 0; i < 4; ++i) {
        uint2 pk;
        pk.x = pack2(v[i].x * (1.f + c4v[i].x) + s4v[i].x, v[i].y * (1.f + c4v[i].y) + s4v[i].y);
        pk.y = pack2(v[i].z * (1.f + c4v[i].z) + s4v[i].z, v[i].w * (1.f + c4v[i].w) + s4v[i].w);
        reinterpret_cast<uint2*>(adst)[lane + 64 * i] = pk;
      }
    }
  }
#undef LN_SRC
}

#define FLD 772
#define LLD 392
__device__ void prep_phase(const Params& p, int layer, char* smem, int bid, int nblk, int tidx, int rep) {
  const int pv_ = rep ? PREPVAR : 0;
  float* F = reinterpret_cast<float*>(smem);
  u16* LIb = reinterpret_cast<u16*>(smem + 16 * FLD * 4);
  const float* cw = p.in[12] + (size_t)layer * 3 * 1152;
  const u16* LW = p.loraT + (size_t)layer * 98304;
  for (int it2 = bid; it2 < 2 * (NTOK / 16); it2 += nblk) {
    const bool doR = it2 < NTOK / 16;
    const int it = doR ? it2 : it2 - NTOK / 16;
    int tid = tidx;
    asm volatile("" : "+v"(tid));
    const int lane = tid & 63, wid = tid >> 6, fr = lane & 15, fq = lane >> 4;
    const int tok0 = it * 16;
    int b, tpos0, L;
    const bool isctx = tok0 < NCTX;
    if (isctx) { b = tok0 >> 8; tpos0 = tok0 & 255; L = 256; }
    else { const int tl = tok0 - NCTX; b = tl >> 10; tpos0 = tl & 1023; L = 1024; }
    if (doR) {
    {
      float* PRM = reinterpret_cast<float*>(smem + 61952);
      PRM[tid] = p.in[13][(size_t)layer * 512 + tid]; PRM[256 + tid] = p.in[13][(size_t)layer * 512 + 256 + tid];
      PRM[512 + tid] = p.in[15][(size_t)layer * 512 + tid]; PRM[768 + tid] = p.in[15][(size_t)layer * 512 + 256 + tid];
      PRM[1024 + tid] = p.in[18][(size_t)layer * 256 + tid]; PRM[1280 + tid] = p.in[19][(size_t)layer * 256 + tid]; PRM[1536 + tid] = p.in[20][(size_t)layer * 256 + tid];
    }
#pragma unroll 1
    for (int cg = tid; cg < 288; cg += 256) {
      const int c = cg * 4;
      const float4 w0 = *reinterpret_cast<const float4*>(cw + c);
      const float4 w1 = *reinterpret_cast<const float4*>(cw + 1152 + c);
      const float4 w2 = *reinterpret_cast<const float4*>(cw + 2304 + c);
      const float* pr = p.PROJ + (size_t)tok0 * DIN + c;
      float4 x[18];
#pragma unroll
      for (int i = 0; i < 18; ++i) {
        const int tpos = tpos0 + i - 1;
        x[i] = (tpos >= 0 && tpos < L) ? *reinterpret_cast<const float4*>(pr + (ptrdiff_t)(i - 1) * DIN) : make_float4(0.f, 0.f, 0.f, 0.f);
      }
#pragma unroll
      for (int tt = 0; tt < 16; ++tt) {
        float4 f;
        f.x = w0.x * x[tt].x + w1.x * x[tt + 1].x + w2.x * x[tt + 2].x;
        f.y = w0.y * x[tt].y + w1.y * x[tt + 1].y + w2.y * x[tt + 2].y;
        f.z = w0.z * x[tt].z + w1.z * x[tt + 1].z + w2.z * x[tt + 2].z;
        f.w = w0.w * x[tt].w + w1.w * x[tt + 1].w + w2.w * x[tt + 2].w;
        if (c < 768) { *reinterpret_cast<float4*>(F + tt * FLD + c) = f; }
        else {
          const int cc = c - 768;
          if (cc < 128) { f.x = tanhf_(f.x); f.y = tanhf_(f.y); f.z = tanhf_(f.z); f.w = tanhf_(f.w); }
          else if (cc >= 256) { f.x = sigmoidf_(f.x); f.y = sigmoidf_(f.y); f.z = sigmoidf_(f.z); f.w = sigmoidf_(f.w); }
          uint2 pk; pk.x = pack2(f.x, f.y); pk.y = pack2(f.z, f.w);
          *reinterpret_cast<uint2*>(LIb + tt * LLD + cc) = pk;
        }
      }
    }
    __syncthreads();
    f32x4 acc[5][4];
#pragma unroll
    for (int g = 0; g < 5; ++g)
#pragma unroll
      for (int nf = 0; nf < 4; ++nf) acc[g][nf] = (f32x4){0.f, 0.f, 0.f, 0.f};
    if (pv_ != 2 && pv_ != 3) {
#define PB_LOAD(W, GI) { const u16* wt_ = (GI) < 4 ? LW + (size_t)(GI) * 16384 : LW + 65536; const int rs_ = (GI) < 4 ? 64 : 128; const int ko_ = (GI) < 4 ? 0 : ((GI) - 4) * 64; \
      _Pragma("unroll") for (int ks_ = 0; ks_ < 2; ++ks_) _Pragma("unroll") for (int nf_ = 0; nf_ < 4; ++nf_) \
        W[ks_ * 4 + nf_] = *reinterpret_cast<const bf16x8*>(wt_ + (size_t)(64 * wid + 16 * nf_ + fr) * rs_ + ko_ + ks_ * 32 + fq * 8); }
#define PB_MMA(W, GI) { const int ai_ = (GI) < 4 ? (GI) : 4; const int xo_ = (GI) < 4 ? (GI) * 64 : 256 + ((GI) - 4) * 64; \
      _Pragma("unroll") for (int ks_ = 0; ks_ < 2; ++ks_) { \
        const bf16x8 xb_ = *reinterpret_cast<const bf16x8*>(LIb + fr * LLD + xo_ + ks_ * 32 + fq * 8); \
        _Pragma("unroll") for (int nf_ = 0; nf_ < 4; ++nf_) acc[ai_][nf_] = __builtin_amdgcn_mfma_f32_16x16x32_bf16(W[ks_ * 4 + nf_], xb_, acc[ai_][nf_], 0, 0, 0); } \
      __builtin_amdgcn_sched_barrier(0); }
    {
      bf16x8 wA[8], wB[8];
      PB_LOAD(wA, 0)
      PB_LOAD(wB, 1) PB_MMA(wA, 0)
      PB_LOAD(wA, 2) PB_MMA(wB, 1)
      PB_LOAD(wB, 3) PB_MMA(wA, 2)
      PB_LOAD(wA, 4) PB_MMA(wB, 3)
      PB_LOAD(wB, 5) PB_MMA(wA, 4)
      PB_MMA(wB, 5)
    }
#undef PB_LOAD
#undef PB_MMA
    }
    if (pv_ != 2 && pv_ != 3) {
#ifndef NO_C
    const float* PRM = reinterpret_cast<const float*>(smem + 61952);
    {
      const int tok = tok0 + fr;
      float ss = 0.f, bs = 0.f;
#pragma unroll
      for (int nf = 0; nf < 4; ++nf) {
        const int c0 = 64 * wid + 16 * nf + 4 * fq;
        const float4 r4 = *reinterpret_cast<const float4*>(F + fr * FLD + c0);
        const float4 k4 = *reinterpret_cast<const float4*>(F + fr * FLD + 256 + c0);
        const float4 w00 = *reinterpret_cast<const float4*>(PRM + c0);
        const float4 w01 = *reinterpret_cast<const float4*>(PRM + 256 + c0);
        const float4 a00 = *reinterpret_cast<const float4*>(PRM + 512 + c0);
        const float4 a01 = *reinterpret_cast<const float4*>(PRM + 768 + c0);
        const float4 kkw = *reinterpret_cast<const float4*>(PRM + 1024 + c0);
        const float4 kaw = *reinterpret_cast<const float4*>(PRM + 1280 + c0);
        const float4 rkw = *reinterpret_cast<const float4*>(PRM + 1536 + c0);
        const float rr[4] = {r4.x, r4.y, r4.z, r4.w}, kk_[4] = {k4.x, k4.y, k4.z, k4.w};
        const float w0a[4] = {w00.x, w00.y, w00.z, w00.w}, w0b[4] = {w01.x, w01.y, w01.z, w01.w};
        const float a0a[4] = {a00.x, a00.y, a00.z, a00.w}, a0b[4] = {a01.x, a01.y, a01.z, a01.w};
        const float kkw_[4] = {kkw.x, kkw.y, kkw.z, kkw.w}, kaw_[4] = {kaw.x, kaw.y, kaw.z, kaw.w}, rkw_[4] = {rkw.x, rkw.y, rkw.z, rkw.w};
#pragma unroll
        for (int r = 0; r < 4; ++r) {
          {
            const float z = -(w0a[r] + acc[0][nf][r]);
            const float sp = fmaxf(z, 0.f) + __logf(1.f + __expf(-fabsf(z)));
            acc[0][nf][r] = __expf(-__expf(-sp - 0.5f));
          }
          {
            const float z = -(w0b[r] + acc[1][nf][r]);
            const float sp = fmaxf(z, 0.f) + __logf(1.f + __expf(-fabsf(z)));
            acc[1][nf][r] = __expf(-__expf(-sp - 0.5f));
          }
          const float av0 = sigmoidf_(a0a[r] + acc[2][nf][r]);
          const float av1 = sigmoidf_(a0b[r] + acc[3][nf][r]);
          acc[2][nf][r] = av0; acc[3][nf][r] = av1;
          const float k = kk_[r];
          const float kq = k * kkw_[r];
          ss += kq * kq;
          const float kd0 = k * (1.f + (av0 - 1.f) * kaw_[r]);
          const float kd1 = k * (1.f + (av1 - 1.f) * kaw_[r]);
          bs += rr[r] * (kd0 + kd1) * rkw_[r];
        }
        __builtin_amdgcn_sched_barrier(0);
      }
      ss += __shfl_xor(ss, 16); ss += __shfl_xor(ss, 32);
      bs += __shfl_xor(bs, 16); bs += __shfl_xor(bs, 32);
      const float inrm = 1.f / fmaxf(sqrtf(ss), 1e-12f);
#pragma unroll
      for (int nf = 0; nf < 4; ++nf) {
        const int c0 = 64 * wid + 16 * nf + 4 * fq, n0 = 16 * nf + 4 * fq;
        const float4 r4 = *reinterpret_cast<const float4*>(F + fr * FLD + c0);
        const float4 k4 = *reinterpret_cast<const float4*>(F + fr * FLD + 256 + c0);
        const float4 v4 = *reinterpret_cast<const float4*>(F + fr * FLD + 512 + c0);
        const float4 kkw = *reinterpret_cast<const float4*>(PRM + 1024 + c0);
        const float4 kaw = *reinterpret_cast<const float4*>(PRM + 1280 + c0);
        const float kk_[4] = {k4.x, k4.y, k4.z, k4.w}, kkw_[4] = {kkw.x, kkw.y, kkw.z, kkw.w}, kaw_[4] = {kaw.x, kaw.y, kaw.z, kaw.w};
        float* sc = p.SC + ((size_t)(tok * 4 + wid) * 9) * 64 + n0;
        float kn[4], kd0[4], kd1[4];
#pragma unroll
        for (int r = 0; r < 4; ++r) {
          kn[r] = kk_[r] * kkw_[r] * inrm;
          kd0[r] = kk_[r] * (1.f + (acc[2][nf][r] - 1.f) * kaw_[r]);
          kd1[r] = kk_[r] * (1.f + (acc[3][nf][r] - 1.f) * kaw_[r]);
        }
        *reinterpret_cast<float4*>(sc) = r4;
        *reinterpret_cast<float4*>(sc + 64) = make_float4(kn[0], kn[1], kn[2], kn[3]);
        *reinterpret_cast<float4*>(sc + 128) = v4;
        *reinterpret_cast<float4*>(sc + 192) = make_float4(acc[0][nf][0], acc[0][nf][1], acc[0][nf][2], acc[0][nf][3]);
        *reinterpret_cast<float4*>(sc + 256) = make_float4(acc[2][nf][0] * kn[0], acc[2][nf][1] * kn[1], acc[2][nf][2] * kn[2], acc[2][nf][3] * kn[3]);
        *reinterpret_cast<float4*>(sc + 320) = make_float4(kd0[0], kd0[1], kd0[2], kd0[3]);
        *reinterpret_cast<float4*>(sc + 384) = make_float4(acc[1][nf][0], acc[1][nf][1], acc[1][nf][2], acc[1][nf][3]);
        *reinterpret_cast<float4*>(sc + 448) = make_float4(acc[3][nf][0] * kn[0], acc[3][nf][1] * kn[1], acc[3][nf][2] * kn[2], acc[3][nf][3] * kn[3]);
        *reinterpret_cast<float4*>(sc + 512) = make_float4(kd1[0], kd1[1], kd1[2], kd1[3]);
        *reinterpret_cast<float4*>(p.G + (size_t)tok * 256 + c0) = make_float4(acc[4][nf][0], acc[4][nf][1], acc[4][nf][2], acc[4][nf][3]);
        *reinterpret_cast<float4*>(p.BV + (size_t)tok * 256 + c0) = make_float4(bs * v4.x, bs * v4.y, bs * v4.z, bs * v4.w);
        __builtin_amdgcn_sched_barrier(0);
      }
    }
#endif
    }
    }
    if (!doR && pv_ != 1) {
#ifndef NO_D
    {
      const int tok = tid >> 4, g8 = tid & 15, tokg = tok0 + tok, tpos = tpos0 + tok;
      const int tkey = isctx ? tpos : 512 + tpos;
      const float* pr = p.PROJ + (size_t)tokg * DIN;
#pragma unroll
      for (int hh = 0; hh < 2; ++hh) {
        const int g = g8 + 16 * hh, c0 = g * 8, hd = c0 >> 6, d0 = c0 & 63;
        const float4 qa = *reinterpret_cast<const float4*>(pr + 1152 + c0), qb = *reinterpret_cast<const float4*>(pr + 1152 + c0 + 4);
        const float4 ka = *reinterpret_cast<const float4*>(pr + 1408 + c0), kb2 = *reinterpret_cast<const float4*>(pr + 1408 + c0 + 4);
        const float qv[8] = {qa.x * QSCALE, qa.y * QSCALE, qa.z * QSCALE, qa.w * QSCALE, qb.x * QSCALE, qb.y * QSCALE, qb.z * QSCALE, qb.w * QSCALE};
        const float kv[8] = {ka.x, ka.y, ka.z, ka.w, kb2.x, kb2.y, kb2.z, kb2.w};
        if (isctx) {
          float* ok = p.out_nak + ((size_t)(b * 4 + layer) * 256 + tpos) * 256 + c0;
          *reinterpret_cast<float4*>(ok) = ka; *reinterpret_cast<float4*>(ok + 4) = kb2;
          pack8_store(p.QNc + (size_t)tokg * 256 + c0, qv);
          pack8_store(p.KNc + (size_t)(b * 4 + hd) * 16384 + kf_off(tkey, d0), kv);
        } else {
          pack8_store(p.QNl + (size_t)(tokg - NCTX) * 256 + c0, qv);
          pack8_store(p.KNl + ((size_t)((layer * 2 + b) * 4 + hd)) * 98304 + kf_off(tkey, d0), kv);
        }
      }
#pragma unroll
      for (int hh = 0; hh < 5; ++hh) {
        const bool isk = (hh == 4);
        const int g = isk ? g8 : g8 + 16 * hh, d0 = (g & 7) * 8, hd = g >> 3;
        const float* src = pr + (isk ? 2432 : 1920) + g * 8;
        const float4 xa = *reinterpret_cast<const float4*>(src), xb = *reinterpret_cast<const float4*>(src + 4);
        const float* nw = (isk ? p.in[25] : p.in[24]) + (size_t)layer * 64 + d0;
        const float4 na = *reinterpret_cast<const float4*>(nw), nb = *reinterpret_cast<const float4*>(nw + 4);
        float x[8] = {xa.x, xa.y, xa.z, xa.w, xb.x, xb.y, xb.z, xb.w};
        const float nrm[8] = {na.x, na.y, na.z, na.w, nb.x, nb.y, nb.z, nb.w};
        float ss = 0.f;
#pragma unroll
        for (int e = 0; e < 8; ++e) ss += x[e] * x[e];
        ss += dpp_mov<0xB1>(ss); ss += dpp_mov<0x4E>(ss); ss += dpp_mov<0x141>(ss);
        const float rs = rsqrtf(ss * (1.f / 64.f) + 1e-6f);
#pragma unroll
        for (int e = 0; e < 8; ++e) x[e] = x[e] * rs * nrm[e];
        if (isk && isctx) {
          float* ok = p.out_gk + ((size_t)(b * 4 + layer) * 256 + tpos) * 128 + g * 8;
          *reinterpret_cast<float4*>(ok) = make_float4(x[0], x[1], x[2], x[3]);
          *reinterpret_cast<float4*>(ok + 4) = make_float4(x[4], x[5], x[6], x[7]);
        }
        if (!isctx) {
          const int pos = (d0 < 32) ? (tpos >> 6) : (tpos & 63);
          const float4* rt = reinterpret_cast<const float4*>(p.rope + (size_t)(pos * 16 + (d0 & 15)) * 2);
          const float4 r0 = rt[0], r1 = rt[1], r2 = rt[2], r3 = rt[3];
          const float cs[8] = {r0.x, r0.z, r1.x, r1.z, r2.x, r2.z, r3.x, r3.z};
          const float sn[8] = {r0.y, r0.w, r1.y, r1.w, r2.y, r2.w, r3.y, r3.w};
          const float sg = (d0 & 16) ? 1.f : -1.f;
#pragma unroll
          for (int e = 0; e < 8; ++e) { const float pe = dpp_mov<0x4E>(x[e]); x[e] = x[e] * cs[e] + sg * pe * sn[e]; }
        }
        if (!isk) {
#pragma unroll
          for (int e = 0; e < 8; ++e) x[e] *= QSCALE;
          if (isctx) pack8_store(p.QGc + (size_t)tokg * 512 + g * 8, x);
          else pack8_store(p.QGl + (size_t)(tokg - NCTX) * 512 + g * 8, x);
        } else {
          if (isctx) pack8_store(p.KGc + (size_t)(b * 2 + hd) * 16384 + kf_off(tkey, d0), x);
          else pack8_store(p.KGl + ((size_t)((layer * 2 + b) * 2 + hd)) * 98304 + kf_off(tkey, d0), x);
        }
      }
    }
    const int c = tid;
#pragma unroll
    for (int half = 0; half < 2; ++half) {
      float vv[8];
#pragma unroll
      for (int t8 = 0; t8 < 8; ++t8) {
        const int tt = half * 8 + t8, tokn = tok0 + tt;
        const float v = p.PROJ[(size_t)tokn * DIN + 1664 + c];
        vv[t8] = v;
        if (isctx) p.out_nav[((size_t)(b * 4 + layer) * 256 + tpos0 + tt) * 256 + c] = v;
      }
      if (isctx) pack44_store(p.VNtc + (size_t)(b * 4 + (c >> 6)) * 16384, tpos0 + half * 8, c & 63, vv);
      else pack44_store(p.VNtl + ((size_t)((layer * 2 + b) * 4 + (c >> 6))) * 98304, 512 + tpos0 + half * 8, c & 63, vv);
    }
    if (wid >= 2) {
      const int cv = c - 128;
#pragma unroll
      for (int half = 0; half < 2; ++half) {
        float vv[8];
#pragma unroll
        for (int t8 = 0; t8 < 8; ++t8) {
          const int tt = half * 8 + t8, tokn = tok0 + tt;
          const float v = p.PROJ[(size_t)tokn * DIN + 2560 + cv];
          vv[t8] = v;
          if (isctx) p.out_gv[((size_t)(b * 4 + layer) * 256 + tpos0 + tt) * 128 + cv] = v;
        }
        if (isctx) pack44_store(p.VGtc + (size_t)(b * 2 + (cv >> 6)) * 16384, tpos0 + half * 8, cv & 63, vv);
        else pack44_store(p.VGtl + ((size_t)((layer * 2 + b) * 2 + (cv >> 6))) * 98304, 512 + tpos0 + half * 8, cv & 63, vv);
      }
    }
#endif
    }
    __syncthreads();
  }
}

#define ATT_LOAD(KF, VF, CI) { \
    const int ci_ = min((CI), nt - 1); \
    int kb_; \
    if (ci_ < nd) kb_ = ci_ * 32; \
    else { const int e_ = ci_ - nd; const int j_ = (ncc == 2) ? (e_ >> 1) : e_; const int cc_ = cc0 + ((ncc == 2) ? (e_ & 1) : 0); kb_ = 512 + (rb + j_) * 64 + cc_ * 32; } \
    const u16* kp_ = Kb + (size_t)(kb_ >> 4) * 1024 + lane * 8; \
    KF##00 = *reinterpret_cast<const bf16x8*>(kp_); \
    KF##01 = *reinterpret_cast<const bf16x8*>(kp_ + 512); \
    KF##10 = *reinterpret_cast<const bf16x8*>(kp_ + 1024); \
    KF##11 = *reinterpret_cast<const bf16x8*>(kp_ + 1536); \
    const u16* vp_ = Vt + (size_t)(kb_ >> 5) * 2048 + lane * 8; \
    VF##0 = *reinterpret_cast<const bf16x8*>(vp_); \
    VF##1 = *reinterpret_cast<const bf16x8*>(vp_ + 512); \
    VF##2 = *reinterpret_cast<const bf16x8*>(vp_ + 1024); \
    VF##3 = *reinterpret_cast<const bf16x8*>(vp_ + 1536); }

#define ATT_PV(DT, VV) { \
    o[DT][0] *= alpha; o[DT][1] *= alpha; o[DT][2] *= alpha; o[DT][3] *= alpha; \
    o[DT] = __builtin_amdgcn_mfma_f32_16x16x32_bf16(VV, pf.v, o[DT], 0, 0, 0); }

#define ATT_COMPUTE(KF, VF, CI) { \
    const int ci_ = (CI); \
    f32x4 s0 = (f32x4){0.f, 0.f, 0.f, 0.f}, s1 = (f32x4){0.f, 0.f, 0.f, 0.f}; \
    s0 = __builtin_amdgcn_mfma_f32_16x16x32_bf16(KF##00, qf0, s0, 0, 0, 0); \
    s0 = __builtin_amdgcn_mfma_f32_16x16x32_bf16(KF##01, qf1, s0, 0, 0, 0); \
    s1 = __builtin_amdgcn_mfma_f32_16x16x32_bf16(KF##10, qf0, s1, 0, 0, 0); \
    s1 = __builtin_amdgcn_mfma_f32_16x16x32_bf16(KF##11, qf1, s1, 0, 0, 0); \
    float sv[8] = {s0[0], s0[1], s0[2], s0[3], s1[0], s1[1], s1[2], s1[3]}; \
    bool ok[8]; \
    _Pragma("unroll") for (int e = 0; e < 8; ++e) ok[e] = true; \
    if (ci_ >= nd) { \
      const int e_ = ci_ - nd; const int j_ = (ncc == 2) ? (e_ >> 1) : e_; const int cc_ = cc0 + ((ncc == 2) ? (e_ & 1) : 0); \
      const int dr_ = rb + j_ - grow + 7; \
      const int cq = cq0 + fr, c0 = min(max(cq - 8, 0), 48); \
      _Pragma("unroll") for (int e = 0; e < 8; ++e) { \
        const int ck = cc_ * 32 + 16 * (e >> 2) + 4 * fq + (e & 3); \
        ok[e] = (ck >= c0) && (ck < c0 + 16); \
        const int dc = min(max(ck - cq, -15), 15) + 15; \
        const float bias = rpb[dr_ * 31 + dc] * LOG2E; \
        sv[e] = ok[e] ? sv[e] + bias : -1e30f; \
      } \
    } \
    float mx = fmaxf(fmaxf(fmaxf(sv[0], sv[1]), fmaxf(sv[2], sv[3])), fmaxf(fmaxf(sv[4], sv[5]), fmaxf(sv[6], sv[7]))); \
    mx = fmaxf(mx, __shfl_xor(mx, 16)); \
    mx = fmaxf(mx, __shfl_xor(mx, 32)); \
    const float mn = fmaxf(m, mx); \
    const float alpha = __builtin_amdgcn_exp2f(m - mn); \
    m = mn; \
    float ps = 0.f; \
    _Pragma("unroll") for (int e = 0; e < 8; ++e) { sv[e] = ok[e] ? __builtin_amdgcn_exp2f(sv[e] - mn) : 0.f; ps += sv[e]; } \
    l = l * alpha + ps; \
    union { bf16x8 v; unsigned u[4]; } pf; \
    pf.u[0] = pack2(sv[0], sv[1]); pf.u[1] = pack2(sv[2], sv[3]); pf.u[2] = pack2(sv[4], sv[5]); pf.u[3] = pack2(sv[6], sv[7]); \
    ATT_PV(0, VF##0) ATT_PV(1, VF##1) ATT_PV(2, VF##2) ATT_PV(3, VF##3) }

__device__ __forceinline__ void attn_wave(const u16* __restrict__ Q, int ldq, const u16* __restrict__ Kb, int ldk,
                                          const u16* __restrict__ Vt, int ldv, int ndense, const bool NA,
                                          const float* __restrict__ rpb, int grow, int cq0,
                                          u16* __restrict__ out, int ldo, int tidx) {
  const int lane = tidx & 63, fr = lane & 15, fq = lane >> 4;
  const bf16x8 qf0 = *reinterpret_cast<const bf16x8*>(Q + (size_t)fr * ldq + fq * 8);
  const bf16x8 qf1 = *reinterpret_cast<const bf16x8*>(Q + (size_t)fr * ldq + 32 + fq * 8);
  f32x4 o[4];
#pragma unroll
  for (int dt = 0; dt < 4; ++dt) o[dt] = (f32x4){0.f, 0.f, 0.f, 0.f};
  float m = -1e30f, l = 0.f;
  const int nd = ndense >> 5;
  const int rb = min(max(grow - 4, 0), 8);
  const int ulo = min(max(cq0 - 8, 0), 48), uhi = min(max(cq0 + 15 - 8, 0), 48) + 16;
  const bool c0ok = ulo < 32, c1ok = uhi > 32;
  const int ncc = (c0ok && c1ok) ? 2 : 1, cc0 = c0ok ? 0 : 1;
  const int nt = nd + (NA ? 8 * ncc : 0);
  bf16x8 ka00, ka01, ka10, ka11, kb00, kb01, kb10, kb11;
  bf16x8 va0, va1, va2, va3, vb0, vb1, vb2, vb3;
  ATT_LOAD(ka, va, 0)
  for (int ci = 0; ci < nt; ci += 2) {
    ATT_LOAD(kb, vb, ci + 1)
    ATT_COMPUTE(ka, va, ci)
    if (ci + 1 < nt) {
      ATT_LOAD(ka, va, ci + 2)
      ATT_COMPUTE(kb, vb, ci + 1)
    }
  }
  l += __shfl_xor(l, 16);
  l += __shfl_xor(l, 32);
  const float il = 1.f / l;
#pragma unroll
  for (int dt = 0; dt < 4; ++dt) {
    uint2 pk; pk.x = pack2(o[dt][0] * il, o[dt][1] * il); pk.y = pack2(o[dt][2] * il, o[dt][3] * il);
    *reinterpret_cast<uint2*>(out + (size_t)fr * ldo + 16 * dt + 4 * fq) = pk;
  }
}

__device__ void scan_item(const Params& p, int layer, char* smem, bool lat, int b, int h, int dir, int qd, int tidx) {
  const int tid = tidx, lane = tid & 63, wid = tid >> 6, rr = lane >> 4, j = lane & 15;
  const int L = lat ? 1024 : 256, seqbase = lat ? NCTX + b * 1024 : b * 256;
  const int rowl = wid * 4 + rr, row = qd * 16 + rowl;
  float* cbuf = reinterpret_cast<float*>(smem);
  float* obuf = cbuf + 2 * 16 * 6 * 64;
  float4 S = make_float4(0.f, 0.f, 0.f, 0.f);
  if (lat) S = *reinterpret_cast<const float4*>(p.in[2] + ((((size_t)(b * 4 + layer) * 2 + dir) * 4 + h) * 64 + row) * 64 + 4 * j);
  v2f S01 = (v2f){S.x, S.y}, S23 = (v2f){S.z, S.w};
  const int nch = L / 16;
  float* odst = dir == 0 ? p.OF : p.OB;
  float4 pre0, pre1, pre2, pre3, pre4, pre5;
  const ptrdiff_t cstep = (dir == 0 ? 1 : -1) * (ptrdiff_t)(16 * 4 * 9 * 64);
  const float *gp0, *gp1, *gp2, *gp3, *gp4, *gp5;
#define SC_GP(GP, I) { const int idx = tid + 256 * (I), tt_ = idx / 96, rem = idx % 96, vec = rem >> 4, f4 = rem & 15; \
    const int t_ = dir == 0 ? tt_ : L - 1 - tt_; const int svec = vec < 3 ? vec : vec + 3 * dir; \
    GP = p.SC + ((size_t)((seqbase + t_) * 4 + h) * 9 + svec) * 64 + f4 * 4; }
  SC_GP(gp0, 0) SC_GP(gp1, 1) SC_GP(gp2, 2) SC_GP(gp3, 3) SC_GP(gp4, 4) SC_GP(gp5, 5)
#define SC_GL1(PR, GP, CH) PR = *reinterpret_cast<const float4*>(GP + (ptrdiff_t)(CH) * cstep);
#define gload(CH) { SC_GL1(pre0, gp0, CH) SC_GL1(pre1, gp1, CH) SC_GL1(pre2, gp2, CH) SC_GL1(pre3, gp3, CH) SC_GL1(pre4, gp4, CH) SC_GL1(pre5, gp5, CH) }
#define SC_LS1(PR, I, BUF) *reinterpret_cast<float4*>(cbuf + (BUF) * 6144 + (tid + 256 * (I)) * 4) = PR;
#define lstore(BUF) { SC_LS1(pre0, 0, BUF) SC_LS1(pre1, 1, BUF) SC_LS1(pre2, 2, BUF) SC_LS1(pre3, 3, BUF) SC_LS1(pre4, 4, BUF) SC_LS1(pre5, 5, BUF) }
  gload(0); lstore(0);
  __syncthreads();
#define SC_LD(R4, K4, VV, W4, A4, D4, TT) { const float* base_ = cb + (TT) * 384; \
    R4 = *reinterpret_cast<const float4*>(base_ + 4 * j); K4 = *reinterpret_cast<const float4*>(base_ + 64 + 4 * j); \
    VV = base_[128 + row]; W4 = *reinterpret_cast<const float4*>(base_ + 192 + 4 * j); \
    A4 = *reinterpret_cast<const float4*>(base_ + 256 + 4 * j); D4 = *reinterpret_cast<const float4*>(base_ + 320 + 4 * j); }
#if SCANVAR
  for (int pass_ = 0; pass_ < (lat ? 2 : 1); ++pass_) {
  int var_ = pass_ ? SCANVAR : 0;
  asm volatile("" : "+v"(var_)); var_ = __builtin_amdgcn_readfirstlane(var_);
#else
  const int var_ = 0;
#endif
  for (int ch = 0; ch < nch; ++ch) {
    if (ch + 1 < nch && var_ != 3) gload(ch + 1);
    const float* cb = cbuf + (ch & 1) * 6144;
    float osel = 0.f;
    float4 r4, kk4, w4, ak4, kd4; float vv;
    SC_LD(r4, kk4, vv, w4, ak4, kd4, 0)
    if (var_ != 2)
#pragma unroll 1
    for (int hf = 0; hf < 2; ++hf) {
      float oqA = 0.f, oqB = 0.f, ovp = 0.f;
#pragma unroll
      for (int u = 0; u < 8; ++u) {
        const int tt = hf * 8 + u;
        float4 r4n, kk4n, w4n, ak4n, kd4n; float vvn;
        SC_LD(r4n, kk4n, vvn, w4n, ak4n, kd4n, tt + 1)
        v2f p = S01 * (v2f){kk4.x, kk4.y};
        p = S23 * (v2f){kk4.z, kk4.w} + p;
        float sk = p.x + p.y;
        sk += dpp_mov<0xB1>(sk);  ovp += dpp_mov<0xB1>(ovp);
        sk += dpp_mov<0x4E>(sk);  ovp += dpp_mov<0x4E>(ovp);
        sk += dpp_mov<0x141>(sk);
        sk += dpp_mov<0x140>(sk);
        if (u > 0) {
          if (((u - 1) >> 2) == 0) oqA = ((j & 3) == ((u - 1) & 3)) ? ovp : oqA;
          else oqB = ((j & 3) == ((u - 1) & 3)) ? ovp : oqB;
        }
        const v2f vv2 = (v2f){vv, vv}, sk2 = (v2f){sk, sk};
        v2f t01 = (v2f){kd4.x, kd4.y} * vv2; t01 = t01 - (v2f){ak4.x, ak4.y} * sk2;
        v2f t23 = (v2f){kd4.z, kd4.w} * vv2; t23 = t23 - (v2f){ak4.z, ak4.w} * sk2;
        S01 = S01 * (v2f){w4.x, w4.y} + t01;
        S23 = S23 * (v2f){w4.z, w4.w} + t23;
        v2f q = S01 * (v2f){r4.x, r4.y};
        q = S23 * (v2f){r4.z, r4.w} + q;
        ovp = q.x + q.y;
        r4 = r4n; kk4 = kk4n; w4 = w4n; ak4 = ak4n; kd4 = kd4n; vv = vvn;
      }
      ovp += dpp_mov<0xB1>(ovp); ovp += dpp_mov<0x4E>(ovp);
      oqB = ((j & 3) == 3) ? ovp : oqB;
      oqA += dpp_mov<0x128>(oqA); oqB += dpp_mov<0x128>(oqB);
      oqA += dpp_mov<0x124>(oqA); oqB += dpp_mov<0x124>(oqB);
      if ((j >> 3) == hf) osel = ((j >> 2) & 1) ? oqB : oqA;
    }
    if (var_ == 0) {
      const int st = ch * 16 + j, t = dir == 0 ? st : L - 1 - st;
      odst[(size_t)(seqbase + t) * 256 + h * 64 + row] = osel;
    } else asm volatile("" :: "v"(osel), "v"(S01), "v"(S23));
    if (ch + 1 < nch && var_ != 3) lstore((ch + 1) & 1);
    asm volatile("s_waitcnt lgkmcnt(0)" ::: "memory");
    __builtin_amdgcn_s_barrier();
  }
#if SCANVAR
  }
#endif
  if (!lat) *reinterpret_cast<float4*>(p.out_st + ((((size_t)(b * 4 + layer) * 2 + dir) * 4 + h) * 64 + row) * 64 + 4 * j) = make_float4(S01.x, S01.y, S23.x, S23.y);
  __syncthreads();
}

__device__ void mixer_phase(const Params& p, int layer_wq, char* smem, int tidx0) {
  const int layer = layer_wq & 3;
  int* slot = reinterpret_cast<int*>(smem + 60 * 1024);
  bool first = true;
  for (;;) {
    int tidx = tidx0;
    asm volatile("" : "+v"(tidx));
    const int tid = tidx, wid = tid >> 6;
    __syncthreads();
    if (tid == 0) *slot = first ? (int)blockIdx.x : (int)(gridDim.x + atomicAdd(&p.wq[layer_wq], 1u));
    first = false;
    __syncthreads();
    int it = *slot;
    if (it >= 1728) break;
    const bool is_scan = (it < 64) || (it >= 448 && it < 960);
#if REPMASK
    if ((p.pad == 1 && !is_scan) || (p.pad == 2 && is_scan) || ((p.pad == 3 || p.pad == 5 || p.pad == 6) && !(it < 64)) || (p.pad == 4 && !(it >= 64 && it < 320))) continue;
#endif
    if (is_scan) {
      const bool lat = it < 64;
      const int si = lat ? it : it - 448;
#ifndef NO_SCAN
      scan_item(p, layer, smem, lat, si / 32, (si / 8) % 4, (si / 4) % 2, si % 4, tidx);
#endif
      continue;
    }
    const u16 *Q, *Kb, *Vt; u16* out; int ldq, ldk, ldv, ndense, grow = 0, cq0 = 0; bool na = false;
    const float* rpb = p.in[23];
    if (it < 320) {
      it -= 64;
      const int b = it / 128, qh = (it / 16) % 8, qt = it % 16, kvh = qh >> 2;
      const int q0 = b * 1024 + qt * 64 + wid * 16;
      Q = p.QGl + (size_t)q0 * 512 + qh * 64; ldq = 512;
      Kb = p.KGl + (size_t)((layer * 2 + b) * 2 + kvh) * 98304; ldk = 0;
      Vt = p.VGtl + (size_t)((layer * 2 + b) * 2 + kvh) * 98304; ldv = 0; ndense = 1536;
      out = p.MIX + (size_t)(NCTX + q0) * DM + 512 + qh * 64;
    } else if (it < 448) {
      it -= 320;
      const int b = it / 64, h = (it / 16) % 4, r = it % 16;
      const int q0 = b * 1024 + r * 64 + wid * 16;
      Q = p.QNl + (size_t)q0 * 256 + h * 64; ldq = 256;
      Kb = p.KNl + (size_t)((layer * 2 + b) * 4 + h) * 98304; ldk = 0;
      Vt = p.VNtl + (size_t)((layer * 2 + b) * 4 + h) * 98304; ldv = 0; ndense = 512;
      rpb = p.in[23] + (size_t)(layer * 4 + h) * 15 * 31; grow = r; cq0 = wid * 16; na = true;
      out = p.MIX + (size_t)(NCTX + q0) * DM + 256 + h * 64;
    } else if (it < 1472) {
      it -= 960;
      const int b = it / 32, qh = (it / 4) % 8, qt = it % 4, kvh = qh >> 2;
      const int q0 = b * 256 + qt * 64 + wid * 16;
      Q = p.QGc + (size_t)q0 * 512 + qh * 64; ldq = 512;
      Kb = p.KGc + (size_t)(b * 2 + kvh) * 16384; ldk = 0;
      Vt = p.VGtc + (size_t)(b * 2 + kvh) * 16384; ldv = 0; ndense = 256;
      out = p.MIX + (size_t)q0 * DM + 512 + qh * 64;
    } else {
      it -= 1472;
      const int b = it / 16, h = (it / 4) % 4, qt = it % 4;
      const int q0 = b * 256 + qt * 64 + wid * 16;
      Q = p.QNc + (size_t)q0 * 256 + h * 64; ldq = 256;
      Kb = p.KNc + (size_t)(b * 4 + h) * 16384; ldk = 0;
      Vt = p.VNtc + (size_t)(b * 4 + h) * 16384; ldv = 0; ndense = 256;
      out = p.MIX + (size_t)q0 * DM + 256 + h * 64;
    }
#ifndef NO_ATT
    attn_wave(Q, ldq, Kb, ldk, Vt, ldv, ndense, na, rpb, grow, cq0, out, DM, tidx);
#endif
  }
}

__device__ void rwkv_fin_phase(const Params& p, int layer, int bid, int nblk, int tidx) {
  const int tid = tidx;
  const float lw = p.in[21][(size_t)layer * 256 + tid], lb = p.in[22][(size_t)layer * 256 + tid];
  for (int t4 = bid; t4 < NTOK / 4; t4 += nblk) {
    float of[4], ob[4], bv[4], gg[4];
#pragma unroll
    for (int u = 0; u < 4; ++u) {
      const size_t i = (size_t)(t4 * 4 + u) * 256 + tid;
      of[u] = p.OF[i]; ob[u] = p.OB[i]; bv[u] = p.BV[i]; gg[u] = p.G[i];
    }
#pragma unroll
    for (int u = 0; u < 4; ++u) {
      const float o = of[u] + ob[u];
      const float mu = wave_sum(o) * (1.f / 64.f);
      const float d = o - mu;
      const float var = wave_sum(d * d) * (1.f / 64.f);
      const float y = (d * rsqrtf(var + 64e-5f) * lw + lb + bv[u]) * gg[u];
      p.MIX[(size_t)(t4 * 4 + u) * DM + tid] = f2bf(y);
    }
  }
}

#ifndef ONLY_PH
#define ONLY_PH -1
#endif
#define PH_EN(x) (ONLY_PH < 0 || ONLY_PH == (x))
__device__ __forceinline__ void run_phase(const Params& p, int ph, char* smem, int bid, int nblk, int tidx, int rep = 0) {
  if (ph == 0) { if (PH_EN(0)) setup_phase(p, smem, bid, nblk, tidx); return; }
  if (ph == 1) { if (PH_EN(1)) modreduce_phase(p, bid, nblk, tidx); return; }
  if (ph == 2) { if (PH_EN(2)) ln_phase<0>(p, 0, bid, nblk, tidx); return; }
  const int layer = (ph - 3) / 9, s = (ph - 3) % 9;
  switch (s) {
    case 0: if (PH_EN(3)) gemm_phase<EPI_PROJ, 256, 3>(p, layer, p.A, p.winT + (size_t)layer * DIN * DM, DIN, DM, smem, bid, nblk, tidx); break;
    case 1: if (PH_EN(4)) prep_phase(p, layer, smem, bid, nblk, tidx, rep); break;
    case 2: if (PH_EN(5)) mixer_phase(p, layer + 4 * rep, smem, tidx); break;
    case 3: if (PH_EN(6)) rwkv_fin_phase(p, layer, bid, nblk, tidx); break;
    case 4: if (PH_EN(7)) gemm_phase<EPI_OUT, 192, 3>(p, layer, p.MIX, p.woutT + (size_t)layer * DM * DM, DM, DM, smem, bid, nblk, tidx); break;
    case 5: if (PH_EN(8)) ln_phase<1>(p, layer, bid, nblk, tidx); break;
    case 6: if (PH_EN(9)) gemm_phase<EPI_FFI, 192, 3>(p, layer, p.A, p.wfiT + (size_t)layer * 2 * DFF * DM, 2 * DFF, DM, smem, bid, nblk, tidx); break;
    case 7: if (PH_EN(10)) gemm_phase<EPI_FFO, 192, 3>(p, layer, p.ACT, p.wfoT + (size_t)layer * DM * DFF, DM, DFF, smem, bid, nblk, tidx); break;
    default: if (PH_EN(11)) ln_phase<2>(p, layer, bid, nblk, tidx); break;
  }
}

__global__ void __launch_bounds__(256, 2) fwd_kernel(Params p, int ph0, int ph1, int usebar) {
  __shared__ __attribute__((aligned(16))) char smem[73728 + 16];
  const int bid = blockIdx.x, nblk = gridDim.x;
  XcdBarrier xb;
  if (usebar && p.never) cg::this_grid().sync();
  if (usebar) {
    if (threadIdx.x == 0) *reinterpret_cast<uint4*>(smem + 73728) = make_uint4(0u, 0u, 0u, 0u);
    __syncthreads();
    xb = xcd_barrier_post(p.bar, (volatile LAS unsigned*)(smem + 73728));
  }
  int ph = ph0, rep = 0;
  while (ph < ph1) {
    int tidx = threadIdx.x;
    asm volatile("" : "+v"(tidx));
    run_phase(p, ph, smem, bid, nblk, tidx, rep);
#if REPSLOT >= 0
    if (((ph < 3 ? 9 + ph : (ph - 3) % 9) == REPSLOT) && rep == 0) rep = 1; else { rep = 0; ++ph; }
#else
    ++ph;
#endif
    if (usebar && ph < ph1) xcd_barrier(xb);
  }
}

static inline size_t al256(size_t x) { return (x + 255) & ~(size_t)255; }

extern "C" void kernel_launch(void* const* d_in, const int* in_sizes, int n_in, void* d_out, int out_size, void* d_ws, size_t ws_size,
                              hipStream_t stream) {
  Params p;
  memset(&p, 0, sizeof(p));
  for (int i = 0; i < 33; ++i) p.in[i] = (const float*)d_in[i];
  float* o = (float*)d_out;
  p.out_yp = o; o += 4194304;
  p.out_ys = o; o += 2097152;
  p.out_st = o; o += 2097152;
  p.out_nak = o; o += 4194304;
  p.out_nav = o; o += 4194304;
  p.out_gk = o; o += 2097152;
  p.out_gv = o;
  char* w = (char*)d_ws; size_t off = 0;
  auto take = [&](size_t bytes) { char* r = w + off; off += al256(bytes); return r; };
  p.bar = (unsigned*)take(16384);
  p.wq = p.bar + 3584;
  p.modp = (float*)take((size_t)4 * 32 * 3 * 6144 * 4);
  p.mod = (float*)take((size_t)4 * 3 * 6144 * 4);
  p.winT = (u16*)take((size_t)4 * DIN * DM * 2);
  p.woutT = (u16*)take((size_t)4 * DM * DM * 2);
  p.wfiT = (u16*)take((size_t)4 * 2 * DFF * DM * 2);
  p.wfoT = (u16*)take((size_t)4 * DM * DFF * 2);
  p.X = (float*)take((size_t)NTOK * DM * 4);
  p.PROJ = (float*)take((size_t)NTOK * DIN * 4);
  p.X1 = p.PROJ;
  p.Y = p.PROJ + (size_t)NTOK * DM;
  p.SC = (float*)take((size_t)NTOK * 4 * 9 * 64 * 4);
  p.ACT = (u16*)p.SC;
  p.G = (float*)take((size_t)NTOK * 256 * 4);
  p.BV = (float*)take((size_t)NTOK * 256 * 4);
  p.OF = (float*)take((size_t)NTOK * 256 * 4);
  p.OB = (float*)take((size_t)NTOK * 256 * 4);
  p.A = (u16*)take((size_t)NTOK * DM * 2);
  p.MIX = (u16*)take((size_t)NTOK * DM * 2);
  p.QNc = (u16*)take((size_t)NCTX * 256 * 2);
  p.KNc = (u16*)take((size_t)NCTX * 256 * 2);
  p.VNtc = (u16*)take((size_t)NCTX * 256 * 2);
  p.QGc = (u16*)take((size_t)NCTX * 512 * 2);
  p.KGc = (u16*)take((size_t)NCTX * 128 * 2);
  p.VGtc = (u16*)take((size_t)NCTX * 128 * 2);
  p.QNl = (u16*)take((size_t)2048 * 256 * 2);
  p.KNl = (u16*)take((size_t)4 * 2 * 1536 * 256 * 2);
  p.VNtl = (u16*)take((size_t)4 * 2 * 1536 * 256 * 2);
  p.QGl = (u16*)take((size_t)2048 * 512 * 2);
  p.KGl = (u16*)take((size_t)4 * 2 * 1536 * 128 * 2);
  p.VGtl = (u16*)take((size_t)4 * 2 * 1536 * 128 * 2);
  p.loraT = (u16*)take((size_t)4 * 98304 * 2);
  p.rope = (float*)take((size_t)64 * 16 * 2 * 4);
  if (off > ws_size) { fprintf(stderr, "workspace too small: need %zu have %zu\n", off, ws_size); return; }

  (void)hipMemsetAsync(p.bar, 0, 16384, stream);
#if MEGA
  static int grid_blocks = 0;
  if (!grid_blocks) {
    int dev = 0, cus = 0, per_cu = 0;
    hipGetDevice(&dev);
    hipDeviceGetAttribute(&cus, hipDeviceAttributeMultiprocessorCount, dev);
    hipOccupancyMaxActiveBlocksPerMultiprocessor(&per_cu, fwd_kernel, 256, 0);
    if (per_cu > 2) per_cu = 2;
    if (per_cu < 1) per_cu = 1;
    grid_blocks = cus * per_cu;
  }
  int ph0 = 0, ph1 = NPH, ub = 1;
  void* args[] = {&p, &ph0, &ph1, &ub};
  hipError_t e = hipLaunchCooperativeKernel((void*)fwd_kernel, dim3(grid_blocks), dim3(256), args, 0, stream);
  if (e != hipSuccess) fprintf(stderr, "cooperative launch failed: %s (grid %d)\n", hipGetErrorString(e), grid_blocks);
#else
  for (int ph = 0; ph < NPH; ++ph) fwd_kernel<<<512, 256, 0, stream>>>(p, ph, ph + 1, 0);
#endif
}
```

```cpp
#include <hip/hip_runtime.h>
#include <hip/hip_cooperative_groups.h>
#include <cstdio>
#include <cstdint>
#include <cstring>
namespace cg = cooperative_groups;

#ifndef REPMASK
#define REPMASK 0
#endif
#ifndef REPSLOT
#define REPSLOT -1
#endif
#ifndef PREPVAR
#define PREPVAR 0
#endif
#ifndef SCANVAR
#define SCANVAR 0
#endif
#ifndef REPVAR
#define REPVAR 0
#endif
#ifndef MEGA
#define MEGA 1
#endif

typedef unsigned short u16;
using bf16x8 = __attribute__((ext_vector_type(8))) short;
using f32x4 = __attribute__((ext_vector_type(4))) float;
using v2f = __attribute__((ext_vector_type(2))) float;

#define NTOK 6144
#define NCTX 4096
#define DM 1024
#define DIN 2688
#define DFF 2816
#define NPH 39
#define ALPHA 1.681792830507429f
#define LOG2E 1.4426950408889634f
#define QSCALE (0.125f * LOG2E)

struct Params {
  const float* in[33];
  float *out_yp, *out_ys, *out_st, *out_nak, *out_nav, *out_gk, *out_gv;
  unsigned *bar, *wq;
  float *modp, *mod;
  u16 *winT, *woutT, *wfiT, *wfoT;
  float *X, *X1, *Y, *PROJ, *SC, *G, *BV, *OF, *OB;
  u16 *A, *MIX, *ACT;
  u16 *QNc, *KNc, *VNtc, *QGc, *KGc, *VGtc;
  u16 *QNl, *KNl, *VNtl, *QGl, *KGl, *VGtl;
  u16* loraT; float* rope;
  int never; int pad;
};

__device__ __forceinline__ u16 f2bf(float f) {
  unsigned u = __float_as_uint(f);
  u += 0x7FFFu + ((u >> 16) & 1u);
  return (u16)(u >> 16);
}
typedef __bf16 bf16v2 __attribute__((ext_vector_type(2)));
__device__ __forceinline__ unsigned pack2(float a, float b) {
  const bf16v2 r = __builtin_convertvector((v2f){a, b}, bf16v2);
  return __builtin_bit_cast(unsigned, r);
}
template <int CTRL> __device__ __forceinline__ float dpp_mov(float v) {
  return __int_as_float(__builtin_amdgcn_update_dpp(0, __float_as_int(v), CTRL, 0xF, 0xF, false));
}
__device__ __forceinline__ float reduce16(float v) {
  v += dpp_mov<0xB1>(v);
  v += dpp_mov<0x4E>(v);
  v += dpp_mov<0x141>(v);
  v += dpp_mov<0x140>(v);
  return v;
}
__device__ __forceinline__ float wave_sum(float v) {
  v = reduce16(v);
  v += __shfl_xor(v, 16);
  v += __shfl_xor(v, 32);
  return v;
}
__device__ __forceinline__ float tanhf_(float x) { const float e = __expf(-2.f * fabsf(x)); const float t = (1.f - e) / (1.f + e); return x < 0.f ? -t : t; }
__device__ __forceinline__ float sigmoidf_(float x) { return 1.f / (1.f + __expf(-x)); }
__device__ __forceinline__ float siluf_(float x) { return x / (1.f + __expf(-x)); }
__device__ __forceinline__ int modrow_of(int tok) { return tok < NCTX ? 0 : 1 + ((tok - NCTX) >> 10); }

#define XB_TMO      128
#define XB_XCNT(j)  (256  + 64 * (j))
#define XB_XSUB(j)  (1280 + 64 * (j))
#define XB_XGEN(j)  (2304 + 64 * (j))
#define XB_TOP      3328
#define XB_TOPGEN   3392
#define XCD_BAR_WORDS 3456
#define XB_SPIN_CAP (1u << 22)
#define LAS __attribute__((address_space(3)))
__device__ __forceinline__ unsigned xb_ld(unsigned* p) { return __hip_atomic_load(p, __ATOMIC_RELAXED, __HIP_MEMORY_SCOPE_AGENT); }
__device__ __forceinline__ unsigned xb_add(unsigned* p, unsigned v) { return __hip_atomic_fetch_add(p, v, __ATOMIC_RELAXED, __HIP_MEMORY_SCOPE_AGENT); }
__device__ __forceinline__ unsigned xb_xcc_id() { return (unsigned)__builtin_amdgcn_s_getreg((3 << 11) | 20) & 0xFu; }
#define XB_SPIN(cond, bar) do { unsigned _sp = 0; while (cond) { __builtin_amdgcn_s_sleep(1); \
    if ((++_sp & 255u) == 0u) { if (xb_ld(&(bar)[XB_TMO])) break; if (_sp > XB_SPIN_CAP) { atomicAdd(&(bar)[XB_TMO], 1u); break; } } } } while (0)
struct XcdBarrier { unsigned* bar; unsigned x; volatile LAS unsigned* st; };
__device__ __forceinline__ XcdBarrier xcd_barrier_post(unsigned* bar, volatile LAS unsigned* st) {
  XcdBarrier b; b.bar = bar; b.x = xb_xcc_id(); b.st = st;
  if (threadIdx.x == 0) (void)xb_add(&bar[XB_XCNT(b.x)], 1u);
  return b;
}
__device__ __forceinline__ void xcd_barrier_complete(unsigned* bar, unsigned x, unsigned& nloc, unsigned& nx) {
  const unsigned G = gridDim.x * gridDim.y * gridDim.z;
  unsigned sum, cnt, mine, sp = 0u;
  for (;;) {
    sum = 0u; cnt = 0u; mine = 0u;
#pragma unroll
    for (unsigned j = 0; j < 16; ++j) { const unsigned c = xb_ld(&bar[XB_XCNT(j)]); sum += c; cnt += (c > 0u) ? 1u : 0u; mine = (j == x) ? c : mine; }
    if (sum == G) break;
    __builtin_amdgcn_s_sleep(1);
    if ((++sp & 255u) == 0u) { if (xb_ld(&bar[XB_TMO])) break; if (sp > XB_SPIN_CAP) { atomicAdd(&bar[XB_TMO], 1u); break; } }
  }
  nloc = mine > 0u ? mine : 1u; nx = cnt > 0u ? cnt : 1u;
}
__device__ __forceinline__ void xcd_barrier(const XcdBarrier& b) {
  asm volatile("s_waitcnt vmcnt(0)" ::: "memory");
  __syncthreads();
  if (threadIdx.x == 0) {
    unsigned* bar = b.bar;
    asm volatile("" : "+s"(bar));
    __builtin_amdgcn_s_waitcnt(0);
    unsigned nloc = b.st[0], nx = b.st[1];
    if (nloc == 0u) { xcd_barrier_complete(bar, b.x, nloc, nx); b.st[0] = nloc; b.st[1] = nx; }
    const unsigned old = xb_add(&bar[XB_XSUB(b.x)], 1u);
    const unsigned gen = old / nloc;
    if (old + 1u == (gen + 1u) * nloc) {
      __builtin_amdgcn_fence(__ATOMIC_RELEASE, "agent");
      asm volatile("s_waitcnt vmcnt(0)" ::: "memory");
      const unsigned og = xb_add(&bar[XB_TOP], 1u);
      const unsigned tg = og / nx;
      if (og + 1u == (tg + 1u) * nx) xb_add(&bar[XB_TOPGEN], 1u);
      else XB_SPIN(xb_ld(&bar[XB_TOPGEN]) == tg, bar);
      __builtin_amdgcn_fence(__ATOMIC_ACQUIRE, "agent");
      xb_add(&bar[XB_XGEN(b.x)], 1u);
      asm volatile("s_waitcnt vmcnt(0)" ::: "memory");
    } else {
      XB_SPIN(xb_ld(&bar[XB_XGEN(b.x)]) == gen, bar);
      __builtin_amdgcn_fence(__ATOMIC_ACQUIRE, "agent");
      asm volatile("s_waitcnt vmcnt(0)" ::: "memory");
    }
  }
  __syncthreads();
}

__device__ __forceinline__ int lds_byte32(int r, int c) {
  const int ob = (r & 15) * 64 + c * 2;
  return (r >> 4) * 1024 + (ob ^ (((ob >> 9) & 1) << 5));
}
__device__ __forceinline__ void stage_rc32(int b, int& R, int& C) {
  const int sb = b & 1023, swz = sb ^ (((sb >> 9) & 1) << 5);
  R = (b >> 10) * 16 + (swz >> 6); C = (swz & 63) >> 1;
}
template <int ROWS>
__device__ __forceinline__ void stage_tile32(const u16* __restrict__ g, int ld, char* lds, int tidx) {
#pragma unroll
  for (int i = 0; i < (ROWS * 64 + 4095) / 4096; ++i) {
    const int b = tidx * 16 + i * 4096;
    if ((i + 1) * 4096 <= ROWS * 64 || tidx < (ROWS * 64 - i * 4096) / 16) {
      int R, C; stage_rc32(b, R, C);
      __builtin_amdgcn_global_load_lds((const unsigned*)(g + (size_t)R * ld + C), (unsigned LAS*)(lds + b), 16, 0, 0);
    }
  }
}
template <int N> __device__ __forceinline__ void wait_vmcnt() {
  if (N == 0) asm volatile("s_waitcnt vmcnt(0)" ::: "memory");
  else if (N == 3) asm volatile("s_waitcnt vmcnt(3)" ::: "memory");
  else if (N == 4) asm volatile("s_waitcnt vmcnt(4)" ::: "memory");
  else if (N == 5) asm volatile("s_waitcnt vmcnt(5)" ::: "memory");
  else if (N == 6) asm volatile("s_waitcnt vmcnt(6)" ::: "memory");
  else if (N == 8) asm volatile("s_waitcnt vmcnt(8)" ::: "memory");
  else if (N == 9) asm volatile("s_waitcnt vmcnt(9)" ::: "memory");
  else if (N == 10) asm volatile("s_waitcnt vmcnt(10)" ::: "memory");
  else if (N == 12) asm volatile("s_waitcnt vmcnt(12)" ::: "memory");
  else asm volatile("s_waitcnt vmcnt(0)" ::: "memory");
}

enum { EPI_PROJ = 0, EPI_OUT = 1, EPI_FFI = 2, EPI_FFO = 3 };

template <int EPI, int BM, int NST>
__device__ __forceinline__ void gemm_phase(const Params& p, int layer, const u16* __restrict__ A, const u16* __restrict__ Bt,
                                           int N, int K, char* smem, int bid, int nblk, int tidx) {
  constexpr int MF = BM / 32;
  const int tid = tidx, lane = tid & 63, wid = tid >> 6, wr = wid >> 1, wc = wid & 1, fr = lane & 15, fq = lane >> 4;
  const int nM = NTOK / BM, nN = N / 128, ntiles = nM * nN, nk = K / 32;
  constexpr int SB = (BM + 128) * 64;
  constexpr int LA = (BM * 64) / 4096;
  const bool extraA = (BM == 96) && (wid < 2);
  for (int tile = bid; tile < ntiles; tile += nblk) {
    const int pm = tile % nM, pn = tile / nM, m0 = pm * BM, n0 = pn * 128;
    f32x4 acc[MF][4];
#pragma unroll
    for (int m = 0; m < MF; ++m)
#pragma unroll
      for (int n = 0; n < 4; ++n) acc[m][n] = (f32x4){0.f, 0.f, 0.f, 0.f};
    const u16* Ag = A + (size_t)m0 * K;
    const u16* Bg = Bt + (size_t)n0 * K;
#pragma unroll
    for (int s_ = 0; s_ < NST - 1; ++s_) {
      stage_tile32<BM>(Ag + s_ * 32, K, smem + s_ * SB, tidx);
      stage_tile32<128>(Bg + s_ * 32, K, smem + s_ * SB + BM * 64, tidx);
    }
    int slot = 0, pslot = NST - 1;
    for (int kt = 0; kt < nk; ++kt) {
      if (kt + NST - 2 < nk) {
        if (BM == 96) { if (extraA) wait_vmcnt<(NST - 2) * 4>(); else wait_vmcnt<(NST - 2) * 3>(); }
        else wait_vmcnt<(NST - 2) * (LA + 2)>();
      } else {
        asm volatile("s_waitcnt vmcnt(0)" ::: "memory");
      }
      __builtin_amdgcn_s_barrier();
      if (kt + NST - 1 < nk) {
        char* nb = smem + pslot * SB;
        stage_tile32<BM>(Ag + (kt + NST - 1) * 32, K, nb, tidx);
        stage_tile32<128>(Bg + (kt + NST - 1) * 32, K, nb + BM * 64, tidx);
      }
      const char* sa = smem + slot * SB;
      const char* sb = sa + BM * 64;
      slot = (slot + 1 == NST) ? 0 : slot + 1;
      pslot = (pslot + 1 == NST) ? 0 : pslot + 1;
      bf16x8 af[MF], bfr[4];
#pragma unroll
      for (int m = 0; m < MF; ++m) af[m] = *reinterpret_cast<const bf16x8*>(sa + lds_byte32(wr * (BM / 2) + m * 16 + fr, fq * 8));
#pragma unroll
      for (int n = 0; n < 4; ++n) bfr[n] = *reinterpret_cast<const bf16x8*>(sb + lds_byte32(wc * 64 + n * 16 + fr, fq * 8));
#pragma unroll
      for (int m = 0; m < MF; ++m)
#pragma unroll
        for (int n = 0; n < 4; ++n) acc[m][n] = __builtin_amdgcn_mfma_f32_16x16x32_bf16(bfr[n], af[m], acc[m][n], 0, 0, 0);
    }
#pragma unroll
    for (int m = 0; m < MF; ++m) {
      const int row = m0 + wr * (BM / 2) + m * 16 + fr;
      if (EPI == EPI_PROJ) {
#pragma unroll
        for (int n = 0; n < 4; ++n) {
          const int col = n0 + wc * 64 + n * 16 + 4 * fq;
          *reinterpret_cast<float4*>(p.PROJ + (size_t)row * DIN + col) = make_float4(acc[m][n][0], acc[m][n][1], acc[m][n][2], acc[m][n][3]);
        }
      } else if (EPI == EPI_OUT || EPI == EPI_FFO) {
        const float* res = (EPI == EPI_OUT) ? p.X : p.X1;
        const float* gate = p.mod + ((size_t)(layer * 3 + modrow_of(row)) * 6 + (EPI == EPI_OUT ? 2 : 5)) * 1024;
#pragma unroll
        for (int n = 0; n < 4; ++n) {
          const int col = n0 + wc * 64 + n * 16 + 4 * fq;
          const float4 xr = *reinterpret_cast<const float4*>(res + (size_t)row * DM + col);
          const float4 gt = *reinterpret_cast<const float4*>(gate + col);
          float4 y;
          y.x = ALPHA * xr.x + gt.x * acc[m][n][0];
          y.y = ALPHA * xr.y + gt.y * acc[m][n][1];
          y.z = ALPHA * xr.z + gt.z * acc[m][n][2];
          y.w = ALPHA * xr.w + gt.w * acc[m][n][3];
          *reinterpret_cast<float4*>(p.Y + (size_t)row * DM + col) = y;
        }
      } else {
#pragma unroll
        for (int n2 = 0; n2 < 2; ++n2) {
          const int j0 = ((n0 + wc * 64) / 32 + n2) * 16 + 4 * fq;
          float a[4];
#pragma unroll
          for (int r = 0; r < 4; ++r) a[r] = siluf_(acc[m][2 * n2][r]) * acc[m][2 * n2 + 1][r];
          uint2 pk; pk.x = pack2(a[0], a[1]); pk.y = pack2(a[2], a[3]);
          *reinterpret_cast<uint2*>(p.ACT + (size_t)row * DFF + j0) = pk;
        }
      }
    }
    asm volatile("s_waitcnt lgkmcnt(0)" ::: "memory");
    __builtin_amdgcn_s_barrier();
  }
}

__device__ __forceinline__ int kf_off(int t, int d) { return (t >> 4) * 1024 + (d >> 5) * 512 + ((d & 31) >> 3) * 128 + (t & 15) * 8 + (d & 7); }
__device__ __forceinline__ int vf_off(int t, int d) { return (t >> 5) * 2048 + (d >> 4) * 512 + (((t & 15) >> 2) * 16 + (d & 15)) * 8 + ((t >> 4) & 1) * 4 + (t & 3); }
__device__ __forceinline__ void pack44_store(u16* base, int t0, int d, const float* v) {
  uint2 a, b; a.x = pack2(v[0], v[1]); a.y = pack2(v[2], v[3]); b.x = pack2(v[4], v[5]); b.y = pack2(v[6], v[7]);
  *reinterpret_cast<uint2*>(base + vf_off(t0, d)) = a;
  *reinterpret_cast<uint2*>(base + vf_off(t0 + 4, d)) = b;
}
__device__ __forceinline__ void pack8_store(u16* dst, const float* v) {
  uint4 pk; pk.x = pack2(v[0], v[1]); pk.y = pack2(v[2], v[3]); pk.z = pack2(v[4], v[5]); pk.w = pack2(v[6], v[7]);
  *reinterpret_cast<uint4*>(dst) = pk;
}

__device__ void setup_phase(const Params& p, char* smem, int bid, int nblk, int tidx) {
  const int tid = tidx;
  const int NI = 768 + 512 + 13;
  for (int it = bid; it < NI; it += nblk) {
    if (it < 768) {
      const int l = it / 192, nc = (it / 32) % 6, kc = it % 32;
      const int col = nc * 1024 + tid * 4;
      const float* wm = p.in[9] + (size_t)l * 1024 * 6144;
      float4 a0 = make_float4(0, 0, 0, 0), a1 = a0, a2 = a0;
      for (int k8 = 0; k8 < 32; k8 += 8) {
        float4 w[8];
#pragma unroll
        for (int u = 0; u < 8; ++u) w[u] = *reinterpret_cast<const float4*>(wm + (size_t)(kc * 32 + k8 + u) * 6144 + col);
#pragma unroll
        for (int u = 0; u < 8; ++u) {
          const int k = kc * 32 + k8 + u;
          const float s0 = siluf_(p.in[8][k]), s1 = siluf_(p.in[7][k]), s2 = siluf_(p.in[7][1024 + k]);
          a0.x += s0 * w[u].x; a0.y += s0 * w[u].y; a0.z += s0 * w[u].z; a0.w += s0 * w[u].w;
          a1.x += s1 * w[u].x; a1.y += s1 * w[u].y; a1.z += s1 * w[u].z; a1.w += s1 * w[u].w;
          a2.x += s2 * w[u].x; a2.y += s2 * w[u].y; a2.z += s2 * w[u].z; a2.w += s2 * w[u].w;
        }
      }
      float* dst = p.modp + (size_t)((l * 32 + kc) * 3) * 6144 + col;
      *reinterpret_cast<float4*>(dst) = a0;
      *reinterpret_cast<float4*>(dst + 6144) = a1;
      *reinterpret_cast<float4*>(dst + 2 * 6144) = a2;
    } else if (it < 1280) {
      const int ci = it - 768, b = ci / 256, l = (ci / 64) % 4, tg = ci % 64, t0 = tg * 8;
      {
        const float* ck = p.in[3] + ((size_t)(b * 4 + l) * 512 + t0) * 256 + tid;
        const float* cv = p.in[4] + ((size_t)(b * 4 + l) * 512 + t0) * 256 + tid;
        float v[8];
#pragma unroll
        for (int tt = 0; tt < 8; ++tt) {
          p.KNl[((size_t)((l * 2 + b) * 4 + (tid >> 6))) * 98304 + kf_off(t0 + tt, tid & 63)] = f2bf(ck[tt * 256]);
          v[tt] = cv[tt * 256];
        }
        pack44_store(p.VNtl + ((size_t)((l * 2 + b) * 4 + (tid >> 6))) * 98304, t0, tid & 63, v);
      }
      if (tid < 128) {
        const float* ck = p.in[5] + ((size_t)(b * 4 + l) * 512 + t0) * 128 + tid;
#pragma unroll
        for (int tt = 0; tt < 8; ++tt) p.KGl[((size_t)((l * 2 + b) * 2 + (tid >> 6))) * 98304 + kf_off(t0 + tt, tid & 63)] = f2bf(ck[tt * 128]);
      } else {
        const int c = tid - 128;
        const float* cv = p.in[6] + ((size_t)(b * 4 + l) * 512 + t0) * 128 + c;
        float v[8];
#pragma unroll
        for (int tt = 0; tt < 8; ++tt) v[tt] = cv[tt * 128];
        pack44_store(p.VGtl + ((size_t)((l * 2 + b) * 2 + (c >> 6))) * 98304, t0, c & 63, v);
      }
    } else {
      const int li = it - (768 + 512);
      if (li == 12) {
        for (int idx = tid; idx < 1024; idx += 256) {
          const int pos = idx >> 4, fi = idx & 15;
          const float ang = (float)pos * exp2f(-(float)fi * (13.287712379549449f / 16.f));
          p.rope[idx * 2] = cosf(ang); p.rope[idx * 2 + 1] = sinf(ang);
        }
      } else {
        const int l = li / 3, m = li % 3;
        u16* dst = p.loraT + (size_t)l * 98304 + m * 32768;
        if (m < 2) {
          const float* src = p.in[m == 0 ? 14 : 16] + (size_t)l * 32768;
          for (int i0 = tid; i0 < 32768; i0 += 256 * 16) {
            float v[16];
#pragma unroll
            for (int u = 0; u < 16; ++u) { const int idx = i0 + 256 * u; const int d = idx >> 14, cch = (idx >> 6) & 255, r = idx & 63; v[u] = src[(d * 64 + r) * 256 + cch]; }
#pragma unroll
            for (int u = 0; u < 16; ++u) dst[i0 + 256 * u] = f2bf(v[u]);
          }
        } else {
          const float* src = p.in[17] + (size_t)l * 32768;
          for (int i0 = tid; i0 < 32768; i0 += 256 * 16) {
            float v[16];
#pragma unroll
            for (int u = 0; u < 16; ++u) { const int idx = i0 + 256 * u; const int cch = idx >> 7, j = idx & 127; v[u] = src[j * 256 + cch]; }
#pragma unroll
            for (int u = 0; u < 16; ++u) dst[i0 + 256 * u] = f2bf(v[u]);
          }
        }
      }
    }
  }
  {
    float* tile = reinterpret_cast<float*>(smem);
    const int NT = 4 * 3040;
    float4 cur0, cur1, cur2, cur3;
    const float* src; u16* dst; int K, N, mat, k0, n0;
#define TR_DECODE(TR) { const int l_ = (TR) / 3040; int r_ = (TR) % 3040; int kt_, nt_; \
      if (r_ < 672) { mat = 0; K = 1024; N = 2688; src = p.in[11] + (size_t)l_ * K * N; dst = p.winT + (size_t)l_ * N * K; kt_ = r_ / 42; nt_ = r_ % 42; } \
      else if (r_ < 928) { r_ -= 672; mat = 1; K = 1024; N = 1024; src = p.in[26] + (size_t)l_ * K * N; dst = p.woutT + (size_t)l_ * N * K; kt_ = r_ / 16; nt_ = r_ % 16; } \
      else if (r_ < 2336) { r_ -= 928; mat = 2; K = 1024; N = 5632; src = p.in[29] + (size_t)l_ * K * N; dst = p.wfiT + (size_t)l_ * N * K; kt_ = r_ / 88; nt_ = r_ % 88; } \
      else { r_ -= 2336; mat = 3; K = 2816; N = 1024; src = p.in[30] + (size_t)l_ * K * N; dst = p.wfoT + (size_t)l_ * N * K; kt_ = r_ / 16; nt_ = r_ % 16; } \
      k0 = kt_ * 64; n0 = nt_ * 64; }
#define TR_LOAD(V, I) V = *reinterpret_cast<const float4*>(src + (size_t)(k0 + (tid >> 4) + 16 * (I)) * N + n0 + (tid & 15) * 4);
#define TR_PUT(V, I) { const int kr_ = (tid >> 4) + 16 * (I), c4_ = (tid & 15) * 4; \
      tile[kr_ * 65 + c4_ + 0] = V.x; tile[kr_ * 65 + c4_ + 1] = V.y; tile[kr_ * 65 + c4_ + 2] = V.z; tile[kr_ * 65 + c4_ + 3] = V.w; }
    int tr = bid;
    if (tr < NT) { TR_DECODE(tr) TR_LOAD(cur0, 0) TR_LOAD(cur1, 1) TR_LOAD(cur2, 2) TR_LOAD(cur3, 3) }
    for (; tr < NT; tr += nblk) {
      TR_PUT(cur0, 0) TR_PUT(cur1, 1) TR_PUT(cur2, 2) TR_PUT(cur3, 3)
      if (tr + nblk < NT) { TR_DECODE(tr + nblk) TR_LOAD(cur0, 0) TR_LOAD(cur1, 1) TR_LOAD(cur2, 2) TR_LOAD(cur3, 3) }
      TR_DECODE(tr)
      __syncthreads();
#pragma unroll
      for (int i = 0; i < 2; ++i) {
        const int idx = tid + 256 * i, nl = idx >> 3, kc = idx & 7;
        int n = n0 + nl;
        if (mat == 2) { const int isup = n >= DFF ? 1 : 0; const int j = n - isup * DFF; n = (j >> 4) * 32 + isup * 16 + (j & 15); }
        float v[8];
#pragma unroll
        for (int jj = 0; jj < 8; ++jj) v[jj] = tile[(kc * 8 + jj) * 65 + nl];
        pack8_store(dst + (size_t)n * K + k0 + kc * 8, v);
      }
      __syncthreads();
    }
#undef TR_DECODE
#undef TR_LOAD
#undef TR_PUT
  }
}

__device__ void modreduce_phase(const Params& p, int bid, int nblk, int tidx) {
  for (int idx = bid * 256 + tidx; idx < 18432; idx += nblk * 256) {
    const int l = idx / 4608, rem = idx % 4608, mr = rem / 1536, c4 = (rem % 1536) * 4;
    float4 a = *reinterpret_cast<const float4*>(p.in[10] + (size_t)l * 6144 + c4);
    for (int k8 = 0; k8 < 32; k8 += 8) {
      float4 v[8];
#pragma unroll
      for (int u = 0; u < 8; ++u) v[u] = *reinterpret_cast<const float4*>(p.modp + (size_t)((l * 32 + k8 + u) * 3 + mr) * 6144 + c4);
#pragma unroll
      for (int u = 0; u < 8; ++u) { a.x += v[u].x; a.y += v[u].y; a.z += v[u].z; a.w += v[u].w; }
    }
    *reinterpret_cast<float4*>(p.mod + (size_t)(l * 3 + mr) * 6144 + c4) = a;
  }
}

template <int MODE>
__device__ void ln_phase(const Params& p, int layer, int bid, int nblk, int tidx) {
  const int lane = tidx & 63, wid = tidx >> 6;
  const bool fin = (MODE == 2 && layer == 3);
  const float* lw = (MODE == 1 ? p.in[27] : p.in[31]) + (size_t)layer * DM;
  const float* lb = (MODE == 1 ? p.in[28] : p.in[32]) + (size_t)layer * DM;
  const int ml = (MODE == 2) ? (layer + 1 < 4 ? layer + 1 : 3) : layer;
  const int which = (MODE == 1) ? 3 : 0;
#define LN_SRC(ROW) (MODE == 0 ? ((ROW) < NCTX ? p.in[0] + (size_t)(ROW) * DM : p.in[1] + (size_t)((ROW) - NCTX) * DM) : p.Y + (size_t)(ROW) * DM)
  float4 nv0, nv1, nv2, nv3;
  int it = bid;
  if (it < NTOK / 4) {
    const float4* s4 = reinterpret_cast<const float4*>(LN_SRC(it * 4 + wid));
    nv0 = s4[lane]; nv1 = s4[lane + 64]; nv2 = s4[lane + 128]; nv3 = s4[lane + 192];
  }
  for (; it < NTOK / 4; it += nblk) {
    const int row = it * 4 + wid;
    float4 v[4] = {nv0, nv1, nv2, nv3};
    if (it + nblk < NTOK / 4) {
      const float4* s4 = reinterpret_cast<const float4*>(LN_SRC((it + nblk) * 4 + wid));
      nv0 = s4[lane]; nv1 = s4[lane + 64]; nv2 = s4[lane + 128]; nv3 = s4[lane + 192];
    }
    float4 w4[4], b4[4], s4v[4], c4v[4];
    const float* sh = p.mod + ((size_t)(ml * 3 + modrow_of(row)) * 6 + which) * 1024;
    const float* sc = sh + 1024;
#pragma unroll
    for (int i = 0; i < 4; ++i) {
      if (MODE != 0) { w4[i] = reinterpret_cast<const float4*>(lw)[lane + 64 * i]; b4[i] = reinterpret_cast<const float4*>(lb)[lane + 64 * i]; }
      if (!fin) { s4v[i] = reinterpret_cast<const float4*>(sh)[lane + 64 * i]; c4v[i] = reinterpret_cast<const float4*>(sc)[lane + 64 * i]; }
    }
    if (MODE != 0) {
      float s = 0.f;
#pragma unroll
      for (int i = 0; i < 4; ++i) s += v[i].x + v[i].y + v[i].z + v[i].w;
      const float mu = wave_sum(s) * (1.f / 1024.f);
      float q = 0.f;
#pragma unroll
      for (int i = 0; i < 4; ++i) {
        v[i].x -= mu; v[i].y -= mu; v[i].z -= mu; v[i].w -= mu;
        q += v[i].x * v[i].x + v[i].y * v[i].y + v[i].z * v[i].z + v[i].w * v[i].w;
      }
      const float rstd = rsqrtf(wave_sum(q) * (1.f / 1024.f) + 1e-5f);
#pragma unroll
      for (int i = 0; i < 4; ++i) {
        v[i].x = v[i].x * rstd * w4[i].x + b4[i].x; v[i].y = v[i].y * rstd * w4[i].y + b4[i].y;
        v[i].z = v[i].z * rstd * w4[i].z + b4[i].z; v[i].w = v[i].w * rstd * w4[i].w + b4[i].w;
      }
    }
    float* xdst = (MODE == 1 ? p.X1 : p.X) + (size_t)row * DM;
#pragma unroll
    for (int i = 0; i < 4; ++i) reinterpret_cast<float4*>(xdst)[lane + 64 * i] = v[i];
    if (fin) {
      float* o = row < NCTX ? p.out_yp + (size_t)row * DM : p.out_ys + (size_t)(row - NCTX) * DM;
#pragma unroll
      for (int i = 0; i < 4; ++i) reinterpret_cast<float4*>(o)[lane + 64 * i] = v[i];
    } else {
      u16* adst = p.A + (size_t)row * DM;
#pragma unroll
      for (int i = 0; i < 4; ++i) {
        uint2 pk;
        pk.x = pack2(v[i].x * (1.f + c4v[i].x) + s4v[i].x, v[i].y * (1.f + c4v[i].y) + s4v[i].y);
        pk.y = pack2(v[i].z * (1.f + c4v[i].z) + s4v[i].z, v[i].w * (1.f + c4v[i].w) + s4v[i].w);
        reinterpret_cast<uint2*>(adst)[lane + 64 * i] = pk;
      }
    }
  }
#undef LN_SRC
}

#define FLD 772
#define LLD 392
__device__ void prep_phase(const Params& p, int layer, char* smem, int bid, int nblk, int tidx, int rep) {
  const int pv_ = rep ? PREPVAR : 0;
  float* F = reinterpret_cast<float*>(smem);
  u16* LIb = reinterpret_cast<u16*>(smem + 16 * FLD * 4);
  const float* cw = p.in[12] + (size_t)layer * 3 * 1152;
  const u16* LW = p.loraT + (size_t)layer * 98304;
  for (int it2 = bid; it2 < 2 * (NTOK / 16); it2 += nblk) {
    const bool doR = it2 < NTOK / 16;
    const int it = doR ? it2 : it2 - NTOK / 16;
    int tid = tidx;
    asm volatile("" : "+v"(tid));
    const int lane = tid & 63, wid = tid >> 6, fr = lane & 15, fq = lane >> 4;
    const int tok0 = it * 16;
    int b, tpos0, L;
    const bool isctx = tok0 < NCTX;
    if (isctx) { b = tok0 >> 8; tpos0 = tok0 & 255; L = 256; }
    else { const int tl = tok0 - NCTX; b = tl >> 10; tpos0 = tl & 1023; L = 1024; }
    if (doR) {
    {
      float* PRM = reinterpret_cast<float*>(smem + 61952);
      PRM[tid] = p.in[13][(size_t)layer * 512 + tid]; PRM[256 + tid] = p.in[13][(size_t)layer * 512 + 256 + tid];
      PRM[512 + tid] = p.in[15][(size_t)layer * 512 + tid]; PRM[768 + tid] = p.in[15][(size_t)layer * 512 + 256 + tid];
      PRM[1024 + tid] = p.in[18][(size_t)layer * 256 + tid]; PRM[1280 + tid] = p.in[19][(size_t)layer * 256 + tid]; PRM[1536 + tid] = p.in[20][(size_t)layer * 256 + tid];
    }
#pragma unroll 1
    for (int cg = tid; cg < 288; cg += 256) {
      const int c = cg * 4;
      const float4 w0 = *reinterpret_cast<const float4*>(cw + c);
      const float4 w1 = *reinterpret_cast<const float4*>(cw + 1152 + c);
      const float4 w2 = *reinterpret_cast<const float4*>(cw + 2304 + c);
      const float* pr = p.PROJ + (size_t)tok0 * DIN + c;
      float4 x[18];
#pragma unroll
      for (int i = 0; i < 18; ++i) {
        const int tpos = tpos0 + i - 1;
        x[i] = (tpos >= 0 && tpos < L) ? *reinterpret_cast<const float4*>(pr + (ptrdiff_t)(i - 1) * DIN) : make_float4(0.f, 0.f, 0.f, 0.f);
      }
#pragma unroll
      for (int tt = 0; tt < 16; ++tt) {
        float4 f;
        f.x = w0.x * x[tt].x + w1.x * x[tt + 1].x + w2.x * x[tt + 2].x;
        f.y = w0.y * x[tt].y + w1.y * x[tt + 1].y + w2.y * x[tt + 2].y;
        f.z = w0.z * x[tt].z + w1.z * x[tt + 1].z + w2.z * x[tt + 2].z;
        f.w = w0.w * x[tt].w + w1.w * x[tt + 1].w + w2.w * x[tt + 2].w;
        if (c < 768) { *reinterpret_cast<float4*>(F + tt * FLD + c) = f; }
        else {
          const int cc = c - 768;
          if (cc < 128) { f.x = tanhf_(f.x); f.y = tanhf_(f.y); f.z = tanhf_(f.z); f.w = tanhf_(f.w); }
          else if (cc >= 256) { f.x = sigmoidf_(f.x); f.y = sigmoidf_(f.y); f.z = sigmoidf_(f.z); f.w = sigmoidf_(f.w); }
          uint2 pk; pk.x = pack2(f.x, f.y); pk.y = pack2(f.z, f.w);
          *reinterpret_cast<uint2*>(LIb + tt * LLD + cc) = pk;
        }
      }
    }
    __syncthreads();
    f32x4 acc[5][4];
#pragma unroll
    for (int g = 0; g < 5; ++g)
#pragma unroll
      for (int nf = 0; nf < 4; ++nf) acc[g][nf] = (f32x4){0.f, 0.f, 0.f, 0.f};
    if (pv_ != 2 && pv_ != 3) {
#define PB_LOAD(W, GI) { const u16* wt_ = (GI) < 4 ? LW + (size_t)(GI) * 16384 : LW + 65536; const int rs_ = (GI) < 4 ? 64 : 128; const int ko_ = (GI) < 4 ? 0 : ((GI) - 4) * 64; \
      _Pragma("unroll") for (int ks_ = 0; ks_ < 2; ++ks_) _Pragma("unroll") for (int nf_ = 0; nf_ < 4; ++nf_) \
        W[ks_ * 4 + nf_] = *reinterpret_cast<const bf16x8*>(wt_ + (size_t)(64 * wid + 16 * nf_ + fr) * rs_ + ko_ + ks_ * 32 + fq * 8); }
#define PB_MMA(W, GI) { const int ai_ = (GI) < 4 ? (GI) : 4; const int xo_ = (GI) < 4 ? (GI) * 64 : 256 + ((GI) - 4) * 64; \
      _Pragma("unroll") for (int ks_ = 0; ks_ < 2; ++ks_) { \
        const bf16x8 xb_ = *reinterpret_cast<const bf16x8*>(LIb + fr * LLD + xo_ + ks_ * 32 + fq * 8); \
        _Pragma("unroll") for (int nf_ = 0; nf_ < 4; ++nf_) acc[ai_][nf_] = __builtin_amdgcn_mfma_f32_16x16x32_bf16(W[ks_ * 4 + nf_], xb_, acc[ai_][nf_], 0, 0, 0); } \
      __builtin_amdgcn_sched_barrier(0); }
    {
      bf16x8 wA[8], wB[8];
      PB_LOAD(wA, 0)
      PB_LOAD(wB, 1) PB_MMA(wA, 0)
      PB_LOAD(wA, 2) PB_MMA(wB, 1)
      PB_LOAD(wB, 3) PB_MMA(wA, 2)
      PB_LOAD(wA, 4) PB_MMA(wB, 3)
      PB_LOAD(wB, 5) PB_MMA(wA, 4)
      PB_MMA(wB, 5)
    }
#undef PB_LOAD
#undef PB_MMA
    }
    if (pv_ != 2 && pv_ != 3) {
#ifndef NO_C
    const float* PRM = reinterpret_cast<const float*>(smem + 61952);
    {
      const int tok = tok0 + fr;
      float ss = 0.f, bs = 0.f;
#pragma unroll
      for (int nf = 0; nf < 4; ++nf) {
        const int c0 = 64 * wid + 16 * nf + 4 * fq;
        const float4 r4 = *reinterpret_cast<const float4*>(F + fr * FLD + c0);
        const float4 k4 = *reinterpret_cast<const float4*>(F + fr * FLD + 256 + c0);
        const float4 w00 = *reinterpret_cast<const float4*>(PRM + c0);
        const float4 w01 = *reinterpret_cast<const float4*>(PRM + 256 + c0);
        const float4 a00 = *reinterpret_cast<const float4*>(PRM + 512 + c0);
        const float4 a01 = *reinterpret_cast<const float4*>(PRM + 768 + c0);
        const float4 kkw = *reinterpret_cast<const float4*>(PRM + 1024 + c0);
        const float4 kaw = *reinterpret_cast<const float4*>(PRM + 1280 + c0);
        const float4 rkw = *reinterpret_cast<const float4*>(PRM + 1536 + c0);
        const float rr[4] = {r4.x, r4.y, r4.z, r4.w}, kk_[4] = {k4.x, k4.y, k4.z, k4.w};
        const float w0a[4] = {w00.x, w00.y, w00.z, w00.w}, w0b[4] = {w01.x, w01.y, w01.z, w01.w};
        const float a0a[4] = {a00.x, a00.y, a00.z, a00.w}, a0b[4] = {a01.x, a01.y, a01.z, a01.w};
        const float kkw_[4] = {kkw.x, kkw.y, kkw.z, kkw.w}, kaw_[4] = {kaw.x, kaw.y, kaw.z, kaw.w}, rkw_[4] = {rkw.x, rkw.y, rkw.z, rkw.w};
#pragma unroll
        for (int r = 0; r < 4; ++r) {
          {
            const float z = -(w0a[r] + acc[0][nf][r]);
            const float sp = fmaxf(z, 0.f) + __logf(1.f + __expf(-fabsf(z)));
            acc[0][nf][r] = __expf(-__expf(-sp - 0.5f));
          }
          {
            const float z = -(w0b[r] + acc[1][nf][r]);
            const float sp = fmaxf(z, 0.f) + __logf(1.f + __expf(-fabsf(z)));
            acc[1][nf][r] = __expf(-__expf(-sp - 0.5f));
          }
          const float av0 = sigmoidf_(a0a[r] + acc[2][nf][r]);
          const float av1 = sigmoidf_(a0b[r] + acc[3][nf][r]);
          acc[2][nf][r] = av0; acc[3][nf][r] = av1;
          const float k = kk_[r];
          const float kq = k * kkw_[r];
          ss += kq * kq;
          const float kd0 = k * (1.f + (av0 - 1.f) * kaw_[r]);
          const float kd1 = k * (1.f + (av1 - 1.f) * kaw_[r]);
          bs += rr[r] * (kd0 + kd1) * rkw_[r];
        }
        __builtin_amdgcn_sched_barrier(0);
      }
      ss += __shfl_xor(ss, 16); ss += __shfl_xor(ss, 32);
      bs += __shfl_xor(bs, 16); bs += __shfl_xor(bs, 32);
      const float inrm = 1.f / fmaxf(sqrtf(ss), 1e-12f);
#pragma unroll
      for (int nf = 0; nf < 4; ++nf) {
        const int c0 = 64 * wid + 16 * nf + 4 * fq, n0 = 16 * nf + 4 * fq;
        const float4 r4 = *reinterpret_cast<const float4*>(F + fr * FLD + c0);
        const float4 k4 = *reinterpret_cast<const float4*>(F + fr * FLD + 256 + c0);
        const float4 v4 = *reinterpret_cast<const float4*>(F + fr * FLD + 512 + c0);
        const float4 kkw = *reinterpret_cast<const float4*>(PRM + 1024 + c0);
        const float4 kaw = *reinterpret_cast<const float4*>(PRM + 1280 + c0);
        const float kk_[4] = {k4.x, k4.y, k4.z, k4.w}, kkw_[4] = {kkw.x, kkw.y, kkw.z, kkw.w}, kaw_[4] = {kaw.x, kaw.y, kaw.z, kaw.w};
        float* sc = p.SC + ((size_t)(tok * 4 + wid) * 9) * 64 + n0;
        float kn[4], kd0[4], kd1[4];
#pragma unroll
        for (int r = 0; r < 4; ++r) {
          kn[r] = kk_[r] * kkw_[r] * inrm;
          kd0[r] = kk_[r] * (1.f + (acc[2][nf][r] - 1.f) * kaw_[r]);
          kd1[r] = kk_[r] * (1.f + (acc[3][nf][r] - 1.f) * kaw_[r]);
        }
        *reinterpret_cast<float4*>(sc) = r4;
        *reinterpret_cast<float4*>(sc + 64) = make_float4(kn[0], kn[1], kn[2], kn[3]);
        *reinterpret_cast<float4*>(sc + 128) = v4;
        *reinterpret_cast<float4*>(sc + 192) = make_float4(acc[0][nf][0], acc[0][nf][1], acc[0][nf][2], acc[0][nf][3]);
        *reinterpret_cast<float4*>(sc + 256) = make_float4(acc[2][nf][0] * kn[0], acc[2][nf][1] * kn[1], acc[2][nf][2] * kn[2], acc[2][nf][3] * kn[3]);
        *reinterpret_cast<float4*>(sc + 320) = make_float4(kd0[0], kd0[1], kd0[2], kd0[3]);
        *reinterpret_cast<float4*>(sc + 384) = make_float4(acc[1][nf][0], acc[1][nf][1], acc[1][nf][2], acc[1][nf][3]);
        *reinterpret_cast<float4*>(sc + 448) = make_float4(acc[3][nf][0] * kn[0], acc[3][nf][1] * kn[1], acc[3][nf][2] * kn[2], acc[3][nf][3] * kn[3]);
        *reinterpret_cast<float4*>(sc + 512) = make_float4(kd1[0], kd1[1], kd1[2], kd1[3]);
        *reinterpret_cast<float4*>(p.G + (size_t)tok * 256 + c0) = make_float4(acc[4][nf][0], acc[4][nf][1], acc[4][nf][2], acc[4][nf][3]);
        *reinterpret_cast<float4*>(p.BV + (size_t)tok * 256 + c0) = make_float4(bs * v4.x, bs * v4.y, bs * v4.z, bs * v4.w);
        __builtin_amdgcn_sched_barrier(0);
      }
    }
#endif
    }
    }
    if (!doR && pv_ != 1) {
#ifndef NO_D
    {
      const int tok = tid >> 4, g8 = tid & 15, tokg = tok0 + tok, tpos = tpos0 + tok;
      const int tkey = isctx ? tpos : 512 + tpos;
      const float* pr = p.PROJ + (size_t)tokg * DIN;
#pragma unroll
      for (int hh = 0; hh < 2; ++hh) {
        const int g = g8 + 16 * hh, c0 = g * 8, hd = c0 >> 6, d0 = c0 & 63;
        const float4 qa = *reinterpret_cast<const float4*>(pr + 1152 + c0), qb = *reinterpret_cast<const float4*>(pr + 1152 + c0 + 4);
        const float4 ka = *reinterpret_cast<const float4*>(pr + 1408 + c0), kb2 = *reinterpret_cast<const float4*>(pr + 1408 + c0 + 4);
        const float qv[8] = {qa.x * QSCALE, qa.y * QSCALE, qa.z * QSCALE, qa.w * QSCALE, qb.x * QSCALE, qb.y * QSCALE, qb.z * QSCALE, qb.w * QSCALE};
        const float kv[8] = {ka.x, ka.y, ka.z, ka.w, kb2.x, kb2.y, kb2.z, kb2.w};
        if (isctx) {
          float* ok = p.out_nak + ((size_t)(b * 4 + layer) * 256 + tpos) * 256 + c0;
          *reinterpret_cast<float4*>(ok) = ka; *reinterpret_cast<float4*>(ok + 4) = kb2;
          pack8_store(p.QNc + (size_t)tokg * 256 + c0, qv);
          pack8_store(p.KNc + (size_t)(b * 4 + hd) * 16384 + kf_off(tkey, d0), kv);
        } else {
          pack8_store(p.QNl + (size_t)(tokg - NCTX) * 256 + c0, qv);
          pack8_store(p.KNl + ((size_t)((layer * 2 + b) * 4 + hd)) * 98304 + kf_off(tkey, d0), kv);
        }
      }
#pragma unroll
      for (int hh = 0; hh < 5; ++hh) {
        const bool isk = (hh == 4);
        const int g = isk ? g8 : g8 + 16 * hh, d0 = (g & 7) * 8, hd = g >> 3;
        const float* src = pr + (isk ? 2432 : 1920) + g * 8;
        const float4 xa = *reinterpret_cast<const float4*>(src), xb = *reinterpret_cast<const float4*>(src + 4);
        const float* nw = (isk ? p.in[25] : p.in[24]) + (size_t)layer * 64 + d0;
        const float4 na = *reinterpret_cast<const float4*>(nw), nb = *reinterpret_cast<const float4*>(nw + 4);
        float x[8] = {xa.x, xa.y, xa.z, xa.w, xb.x, xb.y, xb.z, xb.w};
        const float nrm[8] = {na.x, na.y, na.z, na.w, nb.x, nb.y, nb.z, nb.w};
        float ss = 0.f;
#pragma unroll
        for (int e = 0; e < 8; ++e) ss += x[e] * x[e];
        ss += dpp_mov<0xB1>(ss); ss += dpp_mov<0x4E>(ss); ss += dpp_mov<0x141>(ss);
        const float rs = rsqrtf(ss * (1.f / 64.f) + 1e-6f);
#pragma unroll
        for (int e = 0; e < 8; ++e) x[e] = x[e] * rs * nrm[e];
        if (isk && isctx) {
          float* ok = p.out_gk + ((size_t)(b * 4 + layer) * 256 + tpos) * 128 + g * 8;
          *reinterpret_cast<float4*>(ok) = make_float4(x[0], x[1], x[2], x[3]);
          *reinterpret_cast<float4*>(ok + 4) = make_float4(x[4], x[5], x[6], x[7]);
        }
        if (!isctx) {
          const int pos = (d0 < 32) ? (tpos >> 6) : (tpos & 63);
          const float4* rt = reinterpret_cast<const float4*>(p.rope + (size_t)(pos * 16 + (d0 & 15)) * 2);
          const float4 r0 = rt[0], r1 = rt[1], r2 = rt[2], r3 = rt[3];
          const float cs[8] = {r0.x, r0.z, r1.x, r1.z, r2.x, r2.z, r3.x, r3.z};
          const float sn[8] = {r0.y, r0.w, r1.y, r1.w, r2.y, r2.w, r3.y, r3.w};
          const float sg = (d0 & 16) ? 1.f : -1.f;
#pragma unroll
          for (int e = 0; e < 8; ++e) { const float pe = dpp_mov<0x4E>(x[e]); x[e] = x[e] * cs[e] + sg * pe * sn[e]; }
        }
        if (!isk) {
#pragma unroll
          for (int e = 0; e < 8; ++e) x[e] *= QSCALE;
          if (isctx) pack8_store(p.QGc + (size_t)tokg * 512 + g * 8, x);
          else pack8_store(p.QGl + (size_t)(tokg - NCTX) * 512 + g * 8, x);
        } else {
          if (isctx) pack8_store(p.KGc + (size_t)(b * 2 + hd) * 16384 + kf_off(tkey, d0), x);
          else pack8_store(p.KGl + ((size_t)((layer * 2 + b) * 2 + hd)) * 98304 + kf_off(tkey, d0), x);
        }
      }
    }
    const int c = tid;
#pragma unroll
    for (int half = 0; half < 2; ++half) {
      float vv[8];
#pragma unroll
      for (int t8 = 0; t8 < 8; ++t8) {
        const int tt = half * 8 + t8, tokn = tok0 + tt;
        const float v = p.PROJ[(size_t)tokn * DIN + 1664 + c];
        vv[t8] = v;
        if (isctx) p.out_nav[((size_t)(b * 4 + layer) * 256 + tpos0 + tt) * 256 + c] = v;
      }
      if (isctx) pack44_store(p.VNtc + (size_t)(b * 4 + (c >> 6)) * 16384, tpos0 + half * 8, c & 63, vv);
      else pack44_store(p.VNtl + ((size_t)((layer * 2 + b) * 4 + (c >> 6))) * 98304, 512 + tpos0 + half * 8, c & 63, vv);
    }
    if (wid >= 2) {
      const int cv = c - 128;
#pragma unroll
      for (int half = 0; half < 2; ++half) {
        float vv[8];
#pragma unroll
        for (int t8 = 0; t8 < 8; ++t8) {
          const int tt = half * 8 + t8, tokn = tok0 + tt;
          const float v = p.PROJ[(size_t)tokn * DIN + 2560 + cv];
          vv[t8] = v;
          if (isctx) p.out_gv[((size_t)(b * 4 + layer) * 256 + tpos0 + tt) * 128 + cv] = v;
        }
        if (isctx) pack44_store(p.VGtc + (size_t)(b * 2 + (cv >> 6)) * 16384, tpos0 + half * 8, cv & 63, vv);
        else pack44_store(p.VGtl + ((size_t)((layer * 2 + b) * 2 + (cv >> 6))) * 98304, 512 + tpos0 + half * 8, cv & 63, vv);
      }
    }
#endif
    }
    __syncthreads();
  }
}

#define ATT_LOAD(KF, VF, CI) { \
    const int ci_ = min((CI), nt - 1); \
    int kb_; \
    if (ci_ < nd) kb_ = ci_ * 32; \
    else { const int e_ = ci_ - nd; const int j_ = (ncc == 2) ? (e_ >> 1) : e_; const int cc_ = cc0 + ((ncc == 2) ? (e_ & 1) : 0); kb_ = 512 + (rb + j_) * 64 + cc_ * 32; } \
    const u16* kp_ = Kb + (size_t)(kb_ >> 4) * 1024 + lane * 8; \
    KF##00 = *reinterpret_cast<const bf16x8*>(kp_); \
    KF##01 = *reinterpret_cast<const bf16x8*>(kp_ + 512); \
    KF##10 = *reinterpret_cast<const bf16x8*>(kp_ + 1024); \
    KF##11 = *reinterpret_cast<const bf16x8*>(kp_ + 1536); \
    const u16* vp_ = Vt + (size_t)(kb_ >> 5) * 2048 + lane * 8; \
    VF##0 = *reinterpret_cast<const bf16x8*>(vp_); \
    VF##1 = *reinterpret_cast<const bf16x8*>(vp_ + 512); \
    VF##2 = *reinterpret_cast<const bf16x8*>(vp_ + 1024); \
    VF##3 = *reinterpret_cast<const bf16x8*>(vp_ + 1536); }

#define ATT_PV(DT, VV) { \
    o[DT][0] *= alpha; o[DT][1] *= alpha; o[DT][2] *= alpha; o[DT][3] *= alpha; \
    o[DT] = __builtin_amdgcn_mfma_f32_16x16x32_bf16(VV, pf.v, o[DT], 0, 0, 0); }

#define ATT_COMPUTE(KF, VF, CI) { \
    const int ci_ = (CI); \
    f32x4 s0 = (f32x4){0.f, 0.f, 0.f, 0.f}, s1 = (f32x4){0.f, 0.f, 0.f, 0.f}; \
    s0 = __builtin_amdgcn_mfma_f32_16x16x32_bf16(KF##00, qf0, s0, 0, 0, 0); \
    s0 = __builtin_amdgcn_mfma_f32_16x16x32_bf16(KF##01, qf1, s0, 0, 0, 0); \
    s1 = __builtin_amdgcn_mfma_f32_16x16x32_bf16(KF##10, qf0, s1, 0, 0, 0); \
    s1 = __builtin_amdgcn_mfma_f32_16x16x32_bf16(KF##11, qf1, s1, 0, 0, 0); \
    float sv[8] = {s0[0], s0[1], s0[2], s0[3], s1[0], s1[1], s1[2], s1[3]}; \
    bool ok[8]; \
    _Pragma("unroll") for (int e = 0; e < 8; ++e) ok[e] = true; \
    if (ci_ >= nd) { \
      const int e_ = ci_ - nd; const int j_ = (ncc == 2) ? (e_ >> 1) : e_; const int cc_ = cc0 + ((ncc == 2) ? (e_ & 1) : 0); \
      const int dr_ = rb + j_ - grow + 7; \
      const int cq = cq0 + fr, c0 = min(max(cq - 8, 0), 48); \
      _Pragma("unroll") for (int e = 0; e < 8; ++e) { \
        const int ck = cc_ * 32 + 16 * (e >> 2) + 4 * fq + (e & 3); \
        ok[e] = (ck >= c0) && (ck < c0 + 16); \
        const int dc = min(max(ck - cq, -15), 15) + 15; \
        const float bias = rpb[dr_ * 31 + dc] * LOG2E; \
        sv[e] = ok[e] ? sv[e] + bias : -1e30f; \
      } \
    } \
    float mx = fmaxf(fmaxf(fmaxf(sv[0], sv[1]), fmaxf(sv[2], sv[3])), fmaxf(fmaxf(sv[4], sv[5]), fmaxf(sv[6], sv[7]))); \
    mx = fmaxf(mx, __shfl_xor(mx, 16)); \
    mx = fmaxf(mx, __shfl_xor(mx, 32)); \
    const float mn = fmaxf(m, mx); \
    const float alpha = __builtin_amdgcn_exp2f(m - mn); \
    m = mn; \
    float ps = 0.f; \
    _Pragma("unroll") for (int e = 0; e < 8; ++e) { sv[e] = ok[e] ? __builtin_amdgcn_exp2f(sv[e] - mn) : 0.f; ps += sv[e]; } \
    l = l * alpha + ps; \
    union { bf16x8 v; unsigned u[4]; } pf; \
    pf.u[0] = pack2(sv[0], sv[1]); pf.u[1] = pack2(sv[2], sv[3]); pf.u[2] = pack2(sv[4], sv[5]); pf.u[3] = pack2(sv[6], sv[7]); \
    ATT_PV(0, VF##0) ATT_PV(1, VF##1) ATT_PV(2, VF##2) ATT_PV(3, VF##3) }

__device__ __forceinline__ void attn_wave(const u16* __restrict__ Q, int ldq, const u16* __restrict__ Kb, int ldk,
                                          const u16* __restrict__ Vt, int ldv, int ndense, const bool NA,
                                          const float* __restrict__ rpb, int grow, int cq0,
                                          u16* __restrict__ out, int ldo, int tidx) {
  const int lane = tidx & 63, fr = lane & 15, fq = lane >> 4;
  const bf16x8 qf0 = *reinterpret_cast<const bf16x8*>(Q + (size_t)fr * ldq + fq * 8);
  const bf16x8 qf1 = *reinterpret_cast<const bf16x8*>(Q + (size_t)fr * ldq + 32 + fq * 8);
  f32x4 o[4];
#pragma unroll
  for (int dt = 0; dt < 4; ++dt) o[dt] = (f32x4){0.f, 0.f, 0.f, 0.f};
  float m = -1e30f, l = 0.f;
  const int nd = ndense >> 5;
  const int rb = min(max(grow - 4, 0), 8);
  const int ulo = min(max(cq0 - 8, 0), 48), uhi = min(max(cq0 + 15 - 8, 0), 48) + 16;
  const bool c0ok = ulo < 32, c1ok = uhi > 32;
  const int ncc = (c0ok && c1ok) ? 2 : 1, cc0 = c0ok ? 0 : 1;
  const int nt = nd + (NA ? 8 * ncc : 0);
  bf16x8 ka00, ka01, ka10, ka11, kb00, kb01, kb10, kb11;
  bf16x8 va0, va1, va2, va3, vb0, vb1, vb2, vb3;
  ATT_LOAD(ka, va, 0)
  for (int ci = 0; ci < nt; ci += 2) {
    ATT_LOAD(kb, vb, ci + 1)
    ATT_COMPUTE(ka, va, ci)
    if (ci + 1 < nt) {
      ATT_LOAD(ka, va, ci + 2)
      ATT_COMPUTE(kb, vb, ci + 1)
    }
  }
  l += __shfl_xor(l, 16);
  l += __shfl_xor(l, 32);
  const float il = 1.f / l;
#pragma unroll
  for (int dt = 0; dt < 4; ++dt) {
    uint2 pk; pk.x = pack2(o[dt][0] * il, o[dt][1] * il); pk.y = pack2(o[dt][2] * il, o[dt][3] * il);
    *reinterpret_cast<uint2*>(out + (size_t)fr * ldo + 16 * dt + 4 * fq) = pk;
  }
}

__device__ void scan_item(const Params& p, int layer, char* smem, bool lat, int b, int h, int dir, int qd, int tidx) {
  const int tid = tidx, lane = tid & 63, wid = tid >> 6, rr = lane >> 4, j = lane & 15;
  const int L = lat ? 1024 : 256, seqbase = lat ? NCTX + b * 1024 : b * 256;
  const int rowl = wid * 4 + rr, row = qd * 16 + rowl;
  float* cbuf = reinterpret_cast<float*>(smem);
  float* obuf = cbuf + 2 * 16 * 6 * 64;
  float4 S = make_float4(0.f, 0.f, 0.f, 0.f);
  if (lat) S = *reinterpret_cast<const float4*>(p.in[2] + ((((size_t)(b * 4 + layer) * 2 + dir) * 4 + h) * 64 + row) * 64 + 4 * j);
  v2f S01 = (v2f){S.x, S.y}, S23 = (v2f){S.z, S.w};
  const int nch = L / 16;
  float* odst = dir == 0 ? p.OF : p.OB;
  float4 pre0, pre1, pre2, pre3, pre4, pre5;
  const ptrdiff_t cstep = (dir == 0 ? 1 : -1) * (ptrdiff_t)(16 * 4 * 9 * 64);
  const float *gp0, *gp1, *gp2, *gp3, *gp4, *gp5;
#define SC_GP(GP, I) { const int idx = tid + 256 * (I), tt_ = idx / 96, rem = idx % 96, vec = rem >> 4, f4 = rem & 15; \
    const int t_ = dir == 0 ? tt_ : L - 1 - tt_; const int svec = vec < 3 ? vec : vec + 3 * dir; \
    GP = p.SC + ((size_t)((seqbase + t_) * 4 + h) * 9 + svec) * 64 + f4 * 4; }
  SC_GP(gp0, 0) SC_GP(gp1, 1) SC_GP(gp2, 2) SC_GP(gp3, 3) SC_GP(gp4, 4) SC_GP(gp5, 5)
#define SC_GL1(PR, GP, CH) PR = *reinterpret_cast<const float4*>(GP + (ptrdiff_t)(CH) * cstep);
#define gload(CH) { SC_GL1(pre0, gp0, CH) SC_GL1(pre1, gp1, CH) SC_GL1(pre2, gp2, CH) SC_GL1(pre3, gp3, CH) SC_GL1(pre4, gp4, CH) SC_GL1(pre5, gp5, CH) }
#define SC_LS1(PR, I, BUF) *reinterpret_cast<float4*>(cbuf + (BUF) * 6144 + (tid + 256 * (I)) * 4) = PR;
#define lstore(BUF) { SC_LS1(pre0, 0, BUF) SC_LS1(pre1, 1, BUF) SC_LS1(pre2, 2, BUF) SC_LS1(pre3, 3, BUF) SC_LS1(pre4, 4, BUF) SC_LS1(pre5, 5, BUF) }
  gload(0); lstore(0);
  __syncthreads();
#define SC_LD(R4, K4, VV, W4, A4, D4, TT) { const float* base_ = cb + (TT) * 384; \
    R4 = *reinterpret_cast<const float4*>(base_ + 4 * j); K4 = *reinterpret_cast<const float4*>(base_ + 64 + 4 * j); \
    VV = base_[128 + row]; W4 = *reinterpret_cast<const float4*>(base_ + 192 + 4 * j); \
    A4 = *reinterpret_cast<const float4*>(base_ + 256 + 4 * j); D4 = *reinterpret_cast<const float4*>(base_ + 320 + 4 * j); }
#if SCANVAR
  for (int pass_ = 0; pass_ < (lat ? 2 : 1); ++pass_) {
  int var_ = pass_ ? SCANVAR : 0;
  asm volatile("" : "+v"(var_)); var_ = __builtin_amdgcn_readfirstlane(var_);
#else
  const int var_ = 0;
#endif
  for (int ch = 0; ch < nch; ++ch) {
    if (ch + 1 < nch && var_ != 3) gload(ch + 1);
    const float* cb = cbuf + (ch & 1) * 6144;
    float osel = 0.f;
    float4 r4, kk4, w4, ak4, kd4; float vv;
    SC_LD(r4, kk4, vv, w4, ak4, kd4, 0)
    if (var_ != 2)
#pragma unroll
    for (int hf = 0; hf < 2; ++hf) {
      float oqA = 0.f, oqB = 0.f, ovp = 0.f;
#pragma unroll
      for (int u = 0; u < 8; ++u) {
        const int tt = hf * 8 + u;
        float4 r4n, kk4n, w4n, ak4n, kd4n; float vvn;
        SC_LD(r4n, kk4n, vvn, w4n, ak4n, kd4n, tt + 1)
        v2f p = S01 * (v2f){kk4.x, kk4.y};
        p = S23 * (v2f){kk4.z, kk4.w} + p;
        float sk = p.x + p.y;
        sk += dpp_mov<0xB1>(sk);  ovp += dpp_mov<0xB1>(ovp);
        sk += dpp_mov<0x4E>(sk);  ovp += dpp_mov<0x4E>(ovp);
        sk += dpp_mov<0x141>(sk);
        sk += dpp_mov<0x140>(sk);
        if (u > 0) {
          if (((u - 1) >> 2) == 0) oqA = ((j & 3) == ((u - 1) & 3)) ? ovp : oqA;
          else oqB = ((j & 3) == ((u - 1) & 3)) ? ovp : oqB;
        }
        const v2f vv2 = (v2f){vv, vv}, sk2 = (v2f){sk, sk};
        v2f t01 = (v2f){kd4.x, kd4.y} * vv2; t01 = t01 - (v2f){ak4.x, ak4.y} * sk2;
        v2f t23 = (v2f){kd4.z, kd4.w} * vv2; t23 = t23 - (v2f){ak4.z, ak4.w} * sk2;
        S01 = S01 * (v2f){w4.x, w4.y} + t01;
        S23 = S23 * (v2f){w4.z, w4.w} + t23;
        v2f q = S01 * (v2f){r4.x, r4.y};
        q = S23 * (v2f){r4.z, r4.w} + q;
        ovp = q.x + q.y;
        r4 = r4n; kk4 = kk4n; w4 = w4n; ak4 = ak4n; kd4 = kd4n; vv = vvn;
      }
      ovp += dpp_mov<0xB1>(ovp); ovp += dpp_mov<0x4E>(ovp);
      oqB = ((j & 3) == 3) ? ovp : oqB;
      oqA += dpp_mov<0x128>(oqA); oqB += dpp_mov<0x128>(oqB);
      oqA += dpp_mov<0x124>(oqA); oqB += dpp_mov<0x124>(oqB);
      if ((j >> 3) == hf) osel = ((j >> 2) & 1) ? oqB : oqA;
    }
    if (var_ == 0) {
      const int st = ch * 16 + j, t = dir == 0 ? st : L - 1 - st;
      odst[(size_t)(seqbase + t) * 256 + h * 64 + row] = osel;
    } else asm volatile("" :: "v"(osel), "v"(S01), "v"(S23));
    if (ch + 1 < nch && var_ != 3) lstore((ch + 1) & 1);
    asm volatile("s_waitcnt lgkmcnt(0)" ::: "memory");
    __builtin_amdgcn_s_barrier();
  }
#if SCANVAR
  }
#endif
  if (!lat) *reinterpret_cast<float4*>(p.out_st + ((((size_t)(b * 4 + layer) * 2 + dir) * 4 + h) * 64 + row) * 64 + 4 * j) = make_float4(S01.x, S01.y, S23.x, S23.y);
  __syncthreads();
}

__device__ void mixer_phase(const Params& p, int layer_wq, char* smem, int tidx0) {
  const int layer = layer_wq & 3;
  int* slot = reinterpret_cast<int*>(smem + 60 * 1024);
  bool first = true;
  for (;;) {
    int tidx = tidx0;
    asm volatile("" : "+v"(tidx));
    const int tid = tidx, wid = tid >> 6;
    __syncthreads();
    if (tid == 0) *slot = first ? (int)blockIdx.x : (int)(gridDim.x + atomicAdd(&p.wq[layer_wq], 1u));
    first = false;
    __syncthreads();
    int it = *slot;
    if (it >= 1728) break;
    const bool is_scan = (it < 64) || (it >= 448 && it < 960);
#if REPMASK
    if ((p.pad == 1 && !is_scan) || (p.pad == 2 && is_scan) || ((p.pad == 3 || p.pad == 5 || p.pad == 6) && !(it < 64)) || (p.pad == 4 && !(it >= 64 && it < 320))) continue;
#endif
    if (is_scan) {
      const bool lat = it < 64;
      const int si = lat ? it : it - 448;
#ifndef NO_SCAN
      scan_item(p, layer, smem, lat, si / 32, (si / 8) % 4, (si / 4) % 2, si % 4, tidx);
#endif
      continue;
    }
    const u16 *Q, *Kb, *Vt; u16* out; int ldq, ldk, ldv, ndense, grow = 0, cq0 = 0; bool na = false;
    const float* rpb = p.in[23];
    if (it < 320) {
      it -= 64;
      const int b = it / 128, qh = (it / 16) % 8, qt = it % 16, kvh = qh >> 2;
      const int q0 = b * 1024 + qt * 64 + wid * 16;
      Q = p.QGl + (size_t)q0 * 512 + qh * 64; ldq = 512;
      Kb = p.KGl + (size_t)((layer * 2 + b) * 2 + kvh) * 98304; ldk = 0;
      Vt = p.VGtl + (size_t)((layer * 2 + b) * 2 + kvh) * 98304; ldv = 0; ndense = 1536;
      out = p.MIX + (size_t)(NCTX + q0) * DM + 512 + qh * 64;
    } else if (it < 448) {
      it -= 320;
      const int b = it / 64, h = (it / 16) % 4, r = it % 16;
      const int q0 = b * 1024 + r * 64 + wid * 16;
      Q = p.QNl + (size_t)q0 * 256 + h * 64; ldq = 256;
      Kb = p.KNl + (size_t)((layer * 2 + b) * 4 + h) * 98304; ldk = 0;
      Vt = p.VNtl + (size_t)((layer * 2 + b) * 4 + h) * 98304; ldv = 0; ndense = 512;
      rpb = p.in[23] + (size_t)(layer * 4 + h) * 15 * 31; grow = r; cq0 = wid * 16; na = true;
      out = p.MIX + (size_t)(NCTX + q0) * DM + 256 + h * 64;
    } else if (it < 1472) {
      it -= 960;
      const int b = it / 32, qh = (it / 4) % 8, qt = it % 4, kvh = qh >> 2;
      const int q0 = b * 256 + qt * 64 + wid * 16;
      Q = p.QGc + (size_t)q0 * 512 + qh * 64; ldq = 512;
      Kb = p.KGc + (size_t)(b * 2 + kvh) * 16384; ldk = 0;
      Vt = p.VGtc + (size_t)(b * 2 + kvh) * 16384; ldv = 0; ndense = 256;
      out = p.MIX + (size_t)q0 * DM + 512 + qh * 64;
    } else {
      it -= 1472;
      const int b = it / 16, h = (it / 4) % 4, qt = it % 4;
      const int q0 = b * 256 + qt * 64 + wid * 16;
      Q = p.QNc + (size_t)q0 * 256 + h * 64; ldq = 256;
      Kb = p.KNc + (size_t)(b * 4 + h) * 16384; ldk = 0;
      Vt = p.VNtc + (size_t)(b * 4 + h) * 16384; ldv = 0; ndense = 256;
      out = p.MIX + (size_t)q0 * DM + 256 + h * 64;
    }
#ifndef NO_ATT
    attn_wave(Q, ldq, Kb, ldk, Vt, ldv, ndense, na, rpb, grow, cq0, out, DM, tidx);
#endif
  }
}

__device__ void rwkv_fin_phase(const Params& p, int layer, int bid, int nblk, int tidx) {
  const int tid = tidx;
  const float lw = p.in[21][(size_t)layer * 256 + tid], lb = p.in[22][(size_t)layer * 256 + tid];
  for (int t4 = bid; t4 < NTOK / 4; t4 += nblk) {
    float of[4], ob[4], bv[4], gg[4];
#pragma unroll
    for (int u = 0; u < 4; ++u) {
      const size_t i = (size_t)(t4 * 4 + u) * 256 + tid;
      of[u] = p.OF[i]; ob[u] = p.OB[i]; bv[u] = p.BV[i]; gg[u] = p.G[i];
    }
#pragma unroll
    for (int u = 0; u < 4; ++u) {
      const float o = of[u] + ob[u];
      const float mu = wave_sum(o) * (1.f / 64.f);
      const float d = o - mu;
      const float var = wave_sum(d * d) * (1.f / 64.f);
      const float y = (d * rsqrtf(var + 64e-5f) * lw + lb + bv[u]) * gg[u];
      p.MIX[(size_t)(t4 * 4 + u) * DM + tid] = f2bf(y);
    }
  }
}

#ifndef ONLY_PH
#define ONLY_PH -1
#endif
#define PH_EN(x) (ONLY_PH < 0 || ONLY_PH == (x))
__device__ __forceinline__ void run_phase(const Params& p, int ph, char* smem, int bid, int nblk, int tidx, int rep = 0) {
  if (ph == 0) { if (PH_EN(0)) setup_phase(p, smem, bid, nblk, tidx); return; }
  if (ph == 1) { if (PH_EN(1)) modreduce_phase(p, bid, nblk, tidx); return; }
  if (ph == 2) { if (PH_EN(2)) ln_phase<0>(p, 0, bid, nblk, tidx); return; }
  const int layer = (ph - 3) / 9, s = (ph - 3) % 9;
  switch (s) {
    case 0: if (PH_EN(3)) gemm_phase<EPI_PROJ, 256, 3>(p, layer, p.A, p.winT + (size_t)layer * DIN * DM, DIN, DM, smem, bid, nblk, tidx); break;
    case 1: if (PH_EN(4)) prep_phase(p, layer, smem, bid, nblk, tidx, rep); break;
    case 2: if (PH_EN(5)) mixer_phase(p, layer + 4 * rep, smem, tidx); break;
    case 3: if (PH_EN(6)) rwkv_fin_phase(p, layer, bid, nblk, tidx); break;
    case 4: if (PH_EN(7)) gemm_phase<EPI_OUT, 192, 3>(p, layer, p.MIX, p.woutT + (size_t)layer * DM * DM, DM, DM, smem, bid, nblk, tidx); break;
    case 5: if (PH_EN(8)) ln_phase<1>(p, layer, bid, nblk, tidx); break;
    case 6: if (PH_EN(9)) gemm_phase<EPI_FFI, 192, 3>(p, layer, p.A, p.wfiT + (size_t)layer * 2 * DFF * DM, 2 * DFF, DM, smem, bid, nblk, tidx); break;
    case 7: if (PH_EN(10)) gemm_phase<EPI_FFO, 192, 3>(p, layer, p.ACT, p.wfoT + (size_t)layer * DM * DFF, DM, DFF, smem, bid, nblk, tidx); break;
    default: if (PH_EN(11)) ln_phase<2>(p, layer, bid, nblk, tidx); break;
  }
}

__global__ void __launch_bounds__(256, 2) fwd_kernel(Params p, int ph0, int ph1, int usebar) {
  __shared__ __attribute__((aligned(16))) char smem[73728 + 16];
  const int bid = blockIdx.x, nblk = gridDim.x;
  XcdBarrier xb;
  if (usebar && p.never) cg::this_grid().sync();
  if (usebar) {
    if (threadIdx.x == 0) *reinterpret_cast<uint4*>(smem + 73728) = make_uint4(0u, 0u, 0u, 0u);
    __syncthreads();
    xb = xcd_barrier_post(p.bar, (volatile LAS unsigned*)(smem + 73728));
  }
  int ph = ph0, rep = 0;
  while (ph < ph1) {
    int tidx = threadIdx.x;
    asm volatile("" : "+v"(tidx));
    run_phase(p, ph, smem, bid, nblk, tidx, rep);
#if REPSLOT >= 0
    if (((ph < 3 ? 9 + ph : (ph - 3) % 9) == REPSLOT) && rep == 0) rep = 1; else { rep = 0; ++ph; }
#else
    ++ph;
#endif
    if (usebar && ph < ph1) xcd_barrier(xb);
  }
}

static inline size_t al256(size_t x) { return (x + 255) & ~(size_t)255; }

extern "C" void kernel_launch(void* const* d_in, const int* in_sizes, int n_in, void* d_out, int out_size, void* d_ws, size_t ws_size,
                              hipStream_t stream) {
  Params p;
  memset(&p, 0, sizeof(p));
  for (int i = 0; i < 33; ++i) p.in[i] = (const float*)d_in[i];
  float* o = (float*)d_out;
  p.out_yp = o; o += 4194304;
  p.out_ys = o; o += 2097152;
  p.out_st = o; o += 2097152;
  p.out_nak = o; o += 4194304;
  p.out_nav = o; o += 4194304;
  p.out_gk = o; o += 2097152;
  p.out_gv = o;
  char* w = (char*)d_ws; size_t off = 0;
  auto take = [&](size_t bytes) { char* r = w + off; off += al256(bytes); return r; };
  p.bar = (unsigned*)take(16384);
  p.wq = p.bar + 3584;
  p.modp = (float*)take((size_t)4 * 32 * 3 * 6144 * 4);
  p.mod = (float*)take((size_t)4 * 3 * 6144 * 4);
  p.winT = (u16*)take((size_t)4 * DIN * DM * 2);
  p.woutT = (u16*)take((size_t)4 * DM * DM * 2);
  p.wfiT = (u16*)take((size_t)4 * 2 * DFF * DM * 2);
  p.wfoT = (u16*)take((size_t)4 * DM * DFF * 2);
  p.X = (float*)take((size_t)NTOK * DM * 4);
  p.PROJ = (float*)take((size_t)NTOK * DIN * 4);
  p.X1 = p.PROJ;
  p.Y = p.PROJ + (size_t)NTOK * DM;
  p.SC = (float*)take((size_t)NTOK * 4 * 9 * 64 * 4);
  p.ACT = (u16*)p.SC;
  p.G = (float*)take((size_t)NTOK * 256 * 4);
  p.BV = (float*)take((size_t)NTOK * 256 * 4);
  p.OF = (float*)take((size_t)NTOK * 256 * 4);
  p.OB = (float*)take((size_t)NTOK * 256 * 4);
  p.A = (u16*)take((size_t)NTOK * DM * 2);
  p.MIX = (u16*)take((size_t)NTOK * DM * 2);
  p.QNc = (u16*)take((size_t)NCTX * 256 * 2);
  p.KNc = (u16*)take((size_t)NCTX * 256 * 2);
  p.VNtc = (u16*)take((size_t)NCTX * 256 * 2);
  p.QGc = (u16*)take((size_t)NCTX * 512 * 2);
  p.KGc = (u16*)take((size_t)NCTX * 128 * 2);
  p.VGtc = (u16*)take((size_t)NCTX * 128 * 2);
  p.QNl = (u16*)take((size_t)2048 * 256 * 2);
  p.KNl = (u16*)take((size_t)4 * 2 * 1536 * 256 * 2);
  p.VNtl = (u16*)take((size_t)4 * 2 * 1536 * 256 * 2);
  p.QGl = (u16*)take((size_t)2048 * 512 * 2);
  p.KGl = (u16*)take((size_t)4 * 2 * 1536 * 128 * 2);
  p.VGtl = (u16*)take((size_t)4 * 2 * 1536 * 128 * 2);
  p.loraT = (u16*)take((size_t)4 * 98304 * 2);
  p.rope = (float*)take((size_t)64 * 16 * 2 * 4);
  if (off > ws_size) { fprintf(stderr, "workspace too small: need %zu have %zu\n", off, ws_size); return; }

  (void)hipMemsetAsync(p.bar, 0, 16384, stream);
#if MEGA
  static int grid_blocks = 0;
  if (!grid_blocks) {
    int dev = 0, cus = 0, per_cu = 0;
    hipGetDevice(&dev);
    hipDeviceGetAttribute(&cus, hipDeviceAttributeMultiprocessorCount, dev);
    hipOccupancyMaxActiveBlocksPerMultiprocessor(&per_cu, fwd_kernel, 256, 0);
    if (per_cu > 2) per_cu = 2;
    if (per_cu < 1) per_cu = 1;
    grid_blocks = cus * per_cu;
  }
  int ph0 = 0, ph1 = NPH, ub = 1;
  void* args[] = {&p, &ph0, &ph1, &ub};
  hipError_t e = hipLaunchCooperativeKernel((void*)fwd_kernel, dim3(grid_blocks), dim3(256), args, 0, stream);
  if (e != hipSuccess) fprintf(stderr, "cooperative launch failed: %s (grid %d)\n", hipGetErrorString(e), grid_blocks);
#else
  for (int ph = 0; ph < NPH; ++ph) fwd_kernel<<<512, 256, 0, stream>>>(p, ph, ph + 1, 0);
#endif
}
```

```cpp
#include <hip/hip_runtime.h>
#include <hip/hip_cooperative_groups.h>
#include <cstdio>
#include <cstdint>
#include <cstring>
namespace cg = cooperative_groups;

#ifndef REPMASK
#define REPMASK 0
#endif
#ifndef REPSLOT
#define REPSLOT -1
#endif
#ifndef PREPVAR
#define PREPVAR 0
#endif
#ifndef SCANVAR
#define SCANVAR 0
#endif
#ifndef REPVAR
#define REPVAR 0
#endif
#ifndef MEGA
#define MEGA 1
#endif

typedef unsigned short u16;
using bf16x8 = __attribute__((ext_vector_type(8))) short;
using f32x4 = __attribute__((ext_vector_type(4))) float;
using v2f = __attribute__((ext_vector_type(2))) float;

#define NTOK 6144
#define NCTX 4096
#define DM 1024
#define DIN 2688
#define DFF 2816
#define NPH 39
#define ALPHA 1.681792830507429f
#define LOG2E 1.4426950408889634f
#define QSCALE (0.125f * LOG2E)

struct Params {
  const float* in[33];
  float *out_yp, *out_ys, *out_st, *out_nak, *out_nav, *out_gk, *out_gv;
  unsigned *bar, *wq;
  float *modp, *mod;
  u16 *winT, *woutT, *wfiT, *wfoT;
  float *X, *X1, *Y, *PROJ, *SC, *G, *BV, *OF, *OB;
  u16 *A, *MIX, *ACT;
  u16 *QNc, *KNc, *VNtc, *QGc, *KGc, *VGtc;
  u16 *QNl, *KNl, *VNtl, *QGl, *KGl, *VGtl;
  u16* loraT; float* rope;
  int never; int pad;
};

__device__ __forceinline__ u16 f2bf(float f) {
  unsigned u = __float_as_uint(f);
  u += 0x7FFFu + ((u >> 16) & 1u);
  return (u16)(u >> 16);
}
typedef __bf16 bf16v2 __attribute__((ext_vector_type(2)));
__device__ __forceinline__ unsigned pack2(float a, float b) {
  const bf16v2 r = __builtin_convertvector((v2f){a, b}, bf16v2);
  return __builtin_bit_cast(unsigned, r);
}
template <int CTRL> __device__ __forceinline__ float dpp_mov(float v) {
  return __int_as_float(__builtin_amdgcn_update_dpp(0, __float_as_int(v), CTRL, 0xF, 0xF, false));
}
__device__ __forceinline__ float reduce16(float v) {
  v += dpp_mov<0xB1>(v);
  v += dpp_mov<0x4E>(v);
  v += dpp_mov<0x141>(v);
  v += dpp_mov<0x140>(v);
  return v;
}
__device__ __forceinline__ float wave_sum(float v) {
  v = reduce16(v);
  v += __shfl_xor(v, 16);
  v += __shfl_xor(v, 32);
  return v;
}
__device__ __forceinline__ float tanhf_(float x) { const float e = __expf(-2.f * fabsf(x)); const float t = (1.f - e) / (1.f + e); return x < 0.f ? -t : t; }
__device__ __forceinline__ float sigmoidf_(float x) { return 1.f / (1.f + __expf(-x)); }
__device__ __forceinline__ float siluf_(float x) { return x / (1.f + __expf(-x)); }
__device__ __forceinline__ int modrow_of(int tok) { return tok < NCTX ? 0 : 1 + ((tok - NCTX) >> 10); }

#define XB_TMO      128
#define XB_XCNT(j)  (256  + 64 * (j))
#define XB_XSUB(j)  (1280 + 64 * (j))
#define XB_XGEN(j)  (2304 + 64 * (j))
#define XB_TOP      3328
#define XB_TOPGEN   3392
#define XCD_BAR_WORDS 3456
#define XB_SPIN_CAP (1u << 22)
#define LAS __attribute__((address_space(3)))
__device__ __forceinline__ unsigned xb_ld(unsigned* p) { return __hip_atomic_load(p, __ATOMIC_RELAXED, __HIP_MEMORY_SCOPE_AGENT); }
__device__ __forceinline__ unsigned xb_add(unsigned* p, unsigned v) { return __hip_atomic_fetch_add(p, v, __ATOMIC_RELAXED, __HIP_MEMORY_SCOPE_AGENT); }
__device__ __forceinline__ unsigned xb_xcc_id() { return (unsigned)__builtin_amdgcn_s_getreg((3 << 11) | 20) & 0xFu; }
#define XB_SPIN(cond, bar) do { unsigned _sp = 0; while (cond) { __builtin_amdgcn_s_sleep(1); \
    if ((++_sp & 255u) == 0u) { if (xb_ld(&(bar)[XB_TMO])) break; if (_sp > XB_SPIN_CAP) { atomicAdd(&(bar)[XB_TMO], 1u); break; } } } } while (0)
struct XcdBarrier { unsigned* bar; unsigned x; volatile LAS unsigned* st; };
__device__ __forceinline__ XcdBarrier xcd_barrier_post(unsigned* bar, volatile LAS unsigned* st) {
  XcdBarrier b; b.bar = bar; b.x = xb_xcc_id(); b.st = st;
  if (threadIdx.x == 0) (void)xb_add(&bar[XB_XCNT(b.x)], 1u);
  return b;
}
__device__ __forceinline__ void xcd_barrier_complete(unsigned* bar, unsigned x, unsigned& nloc, unsigned& nx) {
  const unsigned G = gridDim.x * gridDim.y * gridDim.z;
  unsigned sum, cnt, mine, sp = 0u;
  for (;;) {
    sum = 0u; cnt = 0u; mine = 0u;
#pragma unroll
    for (unsigned j = 0; j < 16; ++j) { const unsigned c = xb_ld(&bar[XB_XCNT(j)]); sum += c; cnt += (c > 0u) ? 1u : 0u; mine = (j == x) ? c : mine; }
    if (sum == G) break;
    __builtin_amdgcn_s_sleep(1);
    if ((++sp & 255u) == 0u) { if (xb_ld(&bar[XB_TMO])) break; if (sp > XB_SPIN_CAP) { atomicAdd(&bar[XB_TMO], 1u); break; } }
  }
  nloc = mine > 0u ? mine : 1u; nx = cnt > 0u ? cnt : 1u;
}
__device__ __forceinline__ void xcd_barrier(const XcdBarrier& b) {
  asm volatile("s_waitcnt vmcnt(0)" ::: "memory");
  __syncthreads();
  if (threadIdx.x == 0) {
    unsigned* bar = b.bar;
    asm volatile("" : "+s"(bar));
    __builtin_amdgcn_s_waitcnt(0);
    unsigned nloc = b.st[0], nx = b.st[1];
    if (nloc == 0u) { xcd_barrier_complete(bar, b.x, nloc, nx); b.st[0] = nloc; b.st[1] = nx; }
    const unsigned old = xb_add(&bar[XB_XSUB(b.x)], 1u);
    const unsigned gen = old / nloc;
    if (old + 1u == (gen + 1u) * nloc) {
      __builtin_amdgcn_fence(__ATOMIC_RELEASE, "agent");
      asm volatile("s_waitcnt vmcnt(0)" ::: "memory");
      const unsigned og = xb_add(&bar[XB_TOP], 1u);
      const unsigned tg = og / nx;
      if (og + 1u == (tg + 1u) * nx) xb_add(&bar[XB_TOPGEN], 1u);
      else XB_SPIN(xb_ld(&bar[XB_TOPGEN]) == tg, bar);
      __builtin_amdgcn_fence(__ATOMIC_ACQUIRE, "agent");
      xb_add(&bar[XB_XGEN(b.x)], 1u);
      asm volatile("s_waitcnt vmcnt(0)" ::: "memory");
    } else {
      XB_SPIN(xb_ld(&bar[XB_XGEN(b.x)]) == gen, bar);
      __builtin_amdgcn_fence(__ATOMIC_ACQUIRE, "agent");
      asm volatile("s_waitcnt vmcnt(0)" ::: "memory");
    }
  }
  __syncthreads();
}

__device__ __forceinline__ int lds_byte32(int r, int c) {
  const int ob = (r & 15) * 64 + c * 2;
  return (r >> 4) * 1024 + (ob ^ (((ob >> 9) & 1) << 5));
}
__device__ __forceinline__ void stage_rc32(int b, int& R, int& C) {
  const int sb = b & 1023, swz = sb ^ (((sb >> 9) & 1) << 5);
  R = (b >> 10) * 16 + (swz >> 6); C = (swz & 63) >> 1;
}
template <int ROWS>
__device__ __forceinline__ void stage_tile32(const u16* __restrict__ g, int ld, char* lds, int tidx) {
#pragma unroll
  for (int i = 0; i < (ROWS * 64 + 4095) / 4096; ++i) {
    const int b = tidx * 16 + i * 4096;
    if ((i + 1) * 4096 <= ROWS * 64 || tidx < (ROWS * 64 - i * 4096) / 16) {
      int R, C; stage_rc32(b, R, C);
      __builtin_amdgcn_global_load_lds((const unsigned*)(g + (size_t)R * ld + C), (unsigned LAS*)(lds + b), 16, 0, 0);
    }
  }
}
template <int N> __device__ __forceinline__ void wait_vmcnt() {
  if (N == 0) asm volatile("s_waitcnt vmcnt(0)" ::: "memory");
  else if (N == 3) asm volatile("s_waitcnt vmcnt(3)" ::: "memory");
  else if (N == 4) asm volatile("s_waitcnt vmcnt(4)" ::: "memory");
  else if (N == 5) asm volatile("s_waitcnt vmcnt(5)" ::: "memory");
  else if (N == 6) asm volatile("s_waitcnt vmcnt(6)" ::: "memory");
  else if (N == 8) asm volatile("s_waitcnt vmcnt(8)" ::: "memory");
  else if (N == 9) asm volatile("s_waitcnt vmcnt(9)" ::: "memory");
  else if (N == 10) asm volatile("s_waitcnt vmcnt(10)" ::: "memory");
  else if (N == 12) asm volatile("s_waitcnt vmcnt(12)" ::: "memory");
  else asm volatile("s_waitcnt vmcnt(0)" ::: "memory");
}

enum { EPI_PROJ = 0, EPI_OUT = 1, EPI_FFI = 2, EPI_FFO = 3 };

template <int EPI, int BM, int NST>
__device__ __forceinline__ void gemm_phase(const Params& p, int layer, const u16* __restrict__ A, const u16* __restrict__ Bt,
                                           int N, int K, char* smem, int bid, int nblk, int tidx) {
  constexpr int MF = BM / 32;
  const int tid = tidx, lane = tid & 63, wid = tid >> 6, wr = wid >> 1, wc = wid & 1, fr = lane & 15, fq = lane >> 4;
  const int nM = NTOK / BM, nN = N / 128, ntiles = nM * nN, nk = K / 32;
  constexpr int SB = (BM + 128) * 64;
  constexpr int LA = (BM * 64) / 4096;
  const bool extraA = (BM == 96) && (wid < 2);
  for (int tile = bid; tile < ntiles; tile += nblk) {
    const int pm = tile % nM, pn = tile / nM, m0 = pm * BM, n0 = pn * 128;
    f32x4 acc[MF][4];
#pragma unroll
    for (int m = 0; m < MF; ++m)
#pragma unroll
      for (int n = 0; n < 4; ++n) acc[m][n] = (f32x4){0.f, 0.f, 0.f, 0.f};
    const u16* Ag = A + (size_t)m0 * K;
    const u16* Bg = Bt + (size_t)n0 * K;
#pragma unroll
    for (int s_ = 0; s_ < NST - 1; ++s_) {
      stage_tile32<BM>(Ag + s_ * 32, K, smem + s_ * SB, tidx);
      stage_tile32<128>(Bg + s_ * 32, K, smem + s_ * SB + BM * 64, tidx);
    }
    int slot = 0, pslot = NST - 1;
    for (int kt = 0; kt < nk; ++kt) {
      if (kt + NST - 2 < nk) {
        if (BM == 96) { if (extraA) wait_vmcnt<(NST - 2) * 4>(); else wait_vmcnt<(NST - 2) * 3>(); }
        else wait_vmcnt<(NST - 2) * (LA + 2)>();
      } else {
        asm volatile("s_waitcnt vmcnt(0)" ::: "memory");
      }
      __builtin_amdgcn_s_barrier();
      if (kt + NST - 1 < nk) {
        char* nb = smem + pslot * SB;
        stage_tile32<BM>(Ag + (kt + NST - 1) * 32, K, nb, tidx);
        stage_tile32<128>(Bg + (kt + NST - 1) * 32, K, nb + BM * 64, tidx);
      }
      const char* sa = smem + slot * SB;
      const char* sb = sa + BM * 64;
      slot = (slot + 1 == NST) ? 0 : slot + 1;
      pslot = (pslot + 1 == NST) ? 0 : pslot + 1;
      bf16x8 af[MF], bfr[4];
#pragma unroll
      for (int m = 0; m < MF; ++m) af[m] = *reinterpret_cast<const bf16x8*>(sa + lds_byte32(wr * (BM / 2) + m * 16 + fr, fq * 8));
#pragma unroll
      for (int n = 0; n < 4; ++n) bfr[n] = *reinterpret_cast<const bf16x8*>(sb + lds_byte32(wc * 64 + n * 16 + fr, fq * 8));
#pragma unroll
      for (int m = 0; m < MF; ++m)
#pragma unroll
        for (int n = 0; n < 4; ++n) acc[m][n] = __builtin_amdgcn_mfma_f32_16x16x32_bf16(bfr[n], af[m], acc[m][n], 0, 0, 0);
    }
#pragma unroll
    for (int m = 0; m < MF; ++m) {
      const int row = m0 + wr * (BM / 2) + m * 16 + fr;
      if (EPI == EPI_PROJ) {
#pragma unroll
        for (int n = 0; n < 4; ++n) {
          const int col = n0 + wc * 64 + n * 16 + 4 * fq;
          *reinterpret_cast<float4*>(p.PROJ + (size_t)row * DIN + col) = make_float4(acc[m][n][0], acc[m][n][1], acc[m][n][2], acc[m][n][3]);
        }
      } else if (EPI == EPI_OUT || EPI == EPI_FFO) {
        const float* res = (EPI == EPI_OUT) ? p.X : p.X1;
        const float* gate = p.mod + ((size_t)(layer * 3 + modrow_of(row)) * 6 + (EPI == EPI_OUT ? 2 : 5)) * 1024;
#pragma unroll
        for (int n = 0; n < 4; ++n) {
          const int col = n0 + wc * 64 + n * 16 + 4 * fq;
          const float4 xr = *reinterpret_cast<const float4*>(res + (size_t)row * DM + col);
          const float4 gt = *reinterpret_cast<const float4*>(gate + col);
          float4 y;
          y.x = ALPHA * xr.x + gt.x * acc[m][n][0];
          y.y = ALPHA * xr.y + gt.y * acc[m][n][1];
          y.z = ALPHA * xr.z + gt.z * acc[m][n][2];
          y.w = ALPHA * xr.w + gt.w * acc[m][n][3];
          *reinterpret_cast<float4*>(p.Y + (size_t)row * DM + col) = y;
        }
      } else {
#pragma unroll
        for (int n2 = 0; n2 < 2; ++n2) {
          const int j0 = ((n0 + wc * 64) / 32 + n2) * 16 + 4 * fq;
          float a[4];
#pragma unroll
          for (int r = 0; r < 4; ++r) a[r] = siluf_(acc[m][2 * n2][r]) * acc[m][2 * n2 + 1][r];
          uint2 pk; pk.x = pack2(a[0], a[1]); pk.y = pack2(a[2], a[3]);
          *reinterpret_cast<uint2*>(p.ACT + (size_t)row * DFF + j0) = pk;
        }
      }
    }
    asm volatile("s_waitcnt lgkmcnt(0)" ::: "memory");
    __builtin_amdgcn_s_barrier();
  }
}

__device__ __forceinline__ int kf_off(int t, int d) { return (t >> 4) * 1024 + (d >> 5) * 512 + ((d & 31) >> 3) * 128 + (t & 15) * 8 + (d & 7); }
__device__ __forceinline__ int vf_off(int t, int d) { return (t >> 5) * 2048 + (d >> 4) * 512 + (((t & 15) >> 2) * 16 + (d & 15)) * 8 + ((t >> 4) & 1) * 4 + (t & 3); }
__device__ __forceinline__ void pack44_store(u16* base, int t0, int d, const float* v) {
  uint2 a, b; a.x = pack2(v[0], v[1]); a.y = pack2(v[2], v[3]); b.x = pack2(v[4], v[5]); b.y = pack2(v[6], v[7]);
  *reinterpret_cast<uint2*>(base + vf_off(t0, d)) = a;
  *reinterpret_cast<uint2*>(base + vf_off(t0 + 4, d)) = b;
}
__device__ __forceinline__ void pack8_store(u16* dst, const float* v) {
  uint4 pk; pk.x = pack2(v[0], v[1]); pk.y = pack2(v[2], v[3]); pk.z = pack2(v[4], v[5]); pk.w = pack2(v[6], v[7]);
  *reinterpret_cast<uint4*>(dst) = pk;
}

__device__ void setup_phase(const Params& p, char* smem, int bid, int nblk, int tidx) {
  const int tid = tidx;
  const int NI = 768 + 512 + 13;
  for (int it = bid; it < NI; it += nblk) {
    if (it < 768) {
      const int l = it / 192, nc = (it / 32) % 6, kc = it % 32;
      const int col = nc * 1024 + tid * 4;
      const float* wm = p.in[9] + (size_t)l * 1024 * 6144;
      float4 a0 = make_float4(0, 0, 0, 0), a1 = a0, a2 = a0;
      for (int k8 = 0; k8 < 32; k8 += 8) {
        float4 w[8];
#pragma unroll
        for (int u = 0; u < 8; ++u) w[u] = *reinterpret_cast<const float4*>(wm + (size_t)(kc * 32 + k8 + u) * 6144 + col);
#pragma unroll
        for (int u = 0; u < 8; ++u) {
          const int k = kc * 32 + k8 + u;
          const float s0 = siluf_(p.in[8][k]), s1 = siluf_(p.in[7][k]), s2 = siluf_(p.in[7][1024 + k]);
          a0.x += s0 * w[u].x; a0.y += s0 * w[u].y; a0.z += s0 * w[u].z; a0.w += s0 * w[u].w;
          a1.x += s1 * w[u].x; a1.y += s1 * w[u].y; a1.z += s1 * w[u].z; a1.w += s1 * w[u].w;
          a2.x += s2 * w[u].x; a2.y += s2 * w[u].y; a2.z += s2 * w[u].z; a2.w += s2 * w[u].w;
        }
      }
      float* dst = p.modp + (size_t)((l * 32 + kc) * 3) * 6144 + col;
      *reinterpret_cast<float4*>(dst) = a0;
      *reinterpret_cast<float4*>(dst + 6144) = a1;
      *reinterpret_cast<float4*>(dst + 2 * 6144) = a2;
    } else if (it < 1280) {
      const int ci = it - 768, b = ci / 256, l = (ci / 64) % 4, tg = ci % 64, t0 = tg * 8;
      {
        const float* ck = p.in[3] + ((size_t)(b * 4 + l) * 512 + t0) * 256 + tid;
        const float* cv = p.in[4] + ((size_t)(b * 4 + l) * 512 + t0) * 256 + tid;
        float v[8];
#pragma unroll
        for (int tt = 0; tt < 8; ++tt) {
          p.KNl[((size_t)((l * 2 + b) * 4 + (tid >> 6))) * 98304 + kf_off(t0 + tt, tid & 63)] = f2bf(ck[tt * 256]);
          v[tt] = cv[tt * 256];
        }
        pack44_store(p.VNtl + ((size_t)((l * 2 + b) * 4 + (tid >> 6))) * 98304, t0, tid & 63, v);
      }
      if (tid < 128) {
        const float* ck = p.in[5] + ((size_t)(b * 4 + l) * 512 + t0) * 128 + tid;
#pragma unroll
        for (int tt = 0; tt < 8; ++tt) p.KGl[((size_t)((l * 2 + b) * 2 + (tid >> 6))) * 98304 + kf_off(t0 + tt, tid & 63)] = f2bf(ck[tt * 128]);
      } else {
        const int c = tid - 128;
        const float* cv = p.in[6] + ((size_t)(b * 4 + l) * 512 + t0) * 128 + c;
        float v[8];
#pragma unroll
        for (int tt = 0; tt < 8; ++tt) v[tt] = cv[tt * 128];
        pack44_store(p.VGtl + ((size_t)((l * 2 + b) * 2 + (c >> 6))) * 98304, t0, c & 63, v);
      }
    } else {
      const int li = it - (768 + 512);
      if (li == 12) {
        for (int idx = tid; idx < 1024; idx += 256) {
          const int pos = idx >> 4, fi = idx & 15;
          const float ang = (float)pos * exp2f(-(float)fi * (13.287712379549449f / 16.f));
          p.rope[idx * 2] = cosf(ang); p.rope[idx * 2 + 1] = sinf(ang);
        }
      } else {
        const int l = li / 3, m = li % 3;
        u16* dst = p.loraT + (size_t)l * 98304 + m * 32768;
        if (m < 2) {
          const float* src = p.in[m == 0 ? 14 : 16] + (size_t)l * 32768;
          for (int i0 = tid; i0 < 32768; i0 += 256 * 16) {
            float v[16];
#pragma unroll
            for (int u = 0; u < 16; ++u) { const int idx = i0 + 256 * u; const int d = idx >> 14, cch = (idx >> 6) & 255, r = idx & 63; v[u] = src[(d * 64 + r) * 256 + cch]; }
#pragma unroll
            for (int u = 0; u < 16; ++u) dst[i0 + 256 * u] = f2bf(v[u]);
          }
        } else {
          const float* src = p.in[17] + (size_t)l * 32768;
          for (int i0 = tid; i0 < 32768; i0 += 256 * 16) {
            float v[16];
#pragma unroll
            for (int u = 0; u < 16; ++u) { const int idx = i0 + 256 * u; const int cch = idx >> 7, j = idx & 127; v[u] = src[j * 256 + cch]; }
#pragma unroll
            for (int u = 0; u < 16; ++u) dst[i0 + 256 * u] = f2bf(v[u]);
          }
        }
      }
    }
  }
}

__device__ void weight_convert(const Params& p, char* smem, int tid, int w, int nw, int tr_begin, int NT) {
    float* tile = reinterpret_cast<float*>(smem);
    float4 cur0, cur1, cur2, cur3;
    const float* src; u16* dst; int K, N, mat, k0, n0;
#define TR_DECODE(TR) { const int l_ = (TR) / 3040; int r_ = (TR) % 3040; int kt_, nt_; \
      if (r_ < 672) { mat = 0; K = 1024; N = 2688; src = p.in[11] + (size_t)l_ * K * N; dst = p.winT + (size_t)l_ * N * K; kt_ = r_ / 42; nt_ = r_ % 42; } \
      else if (r_ < 928) { r_ -= 672; mat = 1; K = 1024; N = 1024; src = p.in[26] + (size_t)l_ * K * N; dst = p.woutT + (size_t)l_ * N * K; kt_ = r_ / 16; nt_ = r_ % 16; } \
      else if (r_ < 2336) { r_ -= 928; mat = 2; K = 1024; N = 5632; src = p.in[29] + (size_t)l_ * K * N; dst = p.wfiT + (size_t)l_ * N * K; kt_ = r_ / 88; nt_ = r_ % 88; } \
      else { r_ -= 2336; mat = 3; K = 2816; N = 1024; src = p.in[30] + (size_t)l_ * K * N; dst = p.wfoT + (size_t)l_ * N * K; kt_ = r_ / 16; nt_ = r_ % 16; } \
      k0 = kt_ * 64; n0 = nt_ * 64; }
#define TR_LOAD(V, I) V = *reinterpret_cast<const float4*>(src + (size_t)(k0 + (tid >> 4) + 16 * (I)) * N + n0 + (tid & 15) * 4);
#define TR_PUT(V, I) { const int kr_ = (tid >> 4) + 16 * (I), c4_ = (tid & 15) * 4; \
      tile[kr_ * 65 + c4_ + 0] = V.x; tile[kr_ * 65 + c4_ + 1] = V.y; tile[kr_ * 65 + c4_ + 2] = V.z; tile[kr_ * 65 + c4_ + 3] = V.w; }
    int tr = tr_begin + w;
    if (tr < NT) { TR_DECODE(tr) TR_LOAD(cur0, 0) TR_LOAD(cur1, 1) TR_LOAD(cur2, 2) TR_LOAD(cur3, 3) }
    for (; tr < NT; tr += nw) {
      TR_PUT(cur0, 0) TR_PUT(cur1, 1) TR_PUT(cur2, 2) TR_PUT(cur3, 3)
      if (tr + nw < NT) { TR_DECODE(tr + nw) TR_LOAD(cur0, 0) TR_LOAD(cur1, 1) TR_LOAD(cur2, 2) TR_LOAD(cur3, 3) }
      TR_DECODE(tr)
      __syncthreads();
#pragma unroll
      for (int i = 0; i < 2; ++i) {
        const int idx = tid + 256 * i, nl = idx >> 3, kc = idx & 7;
        int n = n0 + nl;
        if (mat == 2) { const int isup = n >= DFF ? 1 : 0; const int j = n - isup * DFF; n = (j >> 4) * 32 + isup * 16 + (j & 15); }
        float v[8];
#pragma unroll
        for (int jj = 0; jj < 8; ++jj) v[jj] = tile[(kc * 8 + jj) * 65 + nl];
        pack8_store(dst + (size_t)n * K + k0 + kc * 8, v);
      }
      __syncthreads();
    }
#undef TR_DECODE
#undef TR_LOAD
#undef TR_PUT
}

__device__ void modreduce_phase(const Params& p, int bid, int nblk, int tidx) {
  for (int idx = bid * 256 + tidx; idx < 18432; idx += nblk * 256) {
    const int l = idx / 4608, rem = idx % 4608, mr = rem / 1536, c4 = (rem % 1536) * 4;
    float4 a = *reinterpret_cast<const float4*>(p.in[10] + (size_t)l * 6144 + c4);
    for (int k8 = 0; k8 < 32; k8 += 8) {
      float4 v[8];
#pragma unroll
      for (int u = 0; u < 8; ++u) v[u] = *reinterpret_cast<const float4*>(p.modp + (size_t)((l * 32 + k8 + u) * 3 + mr) * 6144 + c4);
#pragma unroll
      for (int u = 0; u < 8; ++u) { a.x += v[u].x; a.y += v[u].y; a.z += v[u].z; a.w += v[u].w; }
    }
    *reinterpret_cast<float4*>(p.mod + (size_t)(l * 3 + mr) * 6144 + c4) = a;
  }
}

template <int MODE>
__device__ void ln_phase(const Params& p, int layer, int bid, int nblk, int tidx) {
  const int lane = tidx & 63, wid = tidx >> 6;
  const bool fin = (MODE == 2 && layer == 3);
  const float* lw = (MODE == 1 ? p.in[27] : p.in[31]) + (size_t)layer * DM;
  const float* lb = (MODE == 1 ? p.in[28] : p.in[32]) + (size_t)layer * DM;
  const int ml = (MODE == 2) ? (layer + 1 < 4 ? layer + 1 : 3) : layer;
  const int which = (MODE == 1) ? 3 : 0;
#define LN_SRC(ROW) (MODE == 0 ? ((ROW) < NCTX ? p.in[0] + (size_t)(ROW) * DM : p.in[1] + (size_t)((ROW) - NCTX) * DM) : p.Y + (size_t)(ROW) * DM)
  float4 nv0, nv1, nv2, nv3;
  int it = bid;
  if (it < NTOK / 4) {
    const float4* s4 = reinterpret_cast<const float4*>(LN_SRC(it * 4 + wid));
    nv0 = s4[lane]; nv1 = s4[lane + 64]; nv2 = s4[lane + 128]; nv3 = s4[lane + 192];
  }
  for (; it < NTOK / 4; it += nblk) {
    const int row = it * 4 + wid;
    float4 v[4] = {nv0, nv1, nv2, nv3};
    if (it + nblk < NTOK / 4) {
      const float4* s4 = reinterpret_cast<const float4*>(LN_SRC((it + nblk) * 4 + wid));
      nv0 = s4[lane]; nv1 = s4[lane + 64]; nv2 = s4[lane + 128]; nv3 = s4[lane + 192];
    }
    float4 w4[4], b4[4], s4v[4], c4v[4];
    const float* sh = p.mod + ((size_t)(ml * 3 + modrow_of(row)) * 6 + which) * 1024;
    const float* sc = sh + 1024;
#pragma unroll
    for (int i = 0; i < 4; ++i) {
      if (MODE != 0) { w4[i] = reinterpret_cast<const float4*>(lw)[lane + 64 * i]; b4[i] = reinterpret_cast<const float4*>(lb)[lane + 64 * i]; }
      if (!fin) { s4v[i] = reinterpret_cast<const float4*>(sh)[lane + 64 * i]; c4v[i] = reinterpret_cast<const float4*>(sc)[lane + 64 * i]; }
    }
    if (MODE != 0) {
      float s = 0.f;
#pragma unroll
      for (int i = 0; i < 4; ++i) s += v[i].x + v[i].y + v[i].z + v[i].w;
      const float mu = wave_sum(s) * (1.f / 1024.f);
      float q = 0.f;
#pragma unroll
      for (int i = 0; i < 4; ++i) {
        v[i].x -= mu; v[i].y -= mu; v[i].z -= mu; v[i].w -= mu;
        q += v[i].x * v[i].x + v[i].y * v[i].y + v[i].z * v[i].z + v[i].w * v[i].w;
      }
      const float rstd = rsqrtf(wave_sum(q) * (1.f / 1024.f) + 1e-5f);
#pragma unroll
      for (int i = 0; i < 4; ++i) {
        v[i].x = v[i].x * rstd * w4[i].x + b4[i].x; v[i].y = v[i].y * rstd * w4[i].y + b4[i].y;
        v[i].z = v[i].z * rstd * w4[i].z + b4[i].z; v[i].w = v[i].w * rstd * w4[i].w + b4[i].w;
      }
    }
    float* xdst = (MODE == 1 ? p.X1 : p.X) + (size_t)row * DM;
#pragma unroll
    for (int i = 0; i < 4; ++i) reinterpret_cast<float4*>(xdst)[lane + 64 * i] = v[i];
    if (fin) {
      float* o = row < NCTX ? p.out_yp + (size_t)row * DM : p.out_ys + (size_t)(row - NCTX) * DM;
#pragma unroll
      for (int i = 0; i < 4; ++i) reinterpret_cast<float4*>(o)[lane + 64 * i] = v[i];
    } else {
      u16* adst = p.A + (size_t)row * DM;
#pragma unroll
      for (int i = 0; i < 4; ++i) {
        uint2 pk;
        pk.x = pack2(v[i].x * (1.f + c4v[i].x) + s4v[i].x, v[i].y * (1.f + c4v[i].y) + s4v[i].y);
        pk.y = pack2(v[i].z * (1.f + c4v[i].z) + s4v[i].z, v[i].w * (1.f + c4v[i].w) + s4v[i].w);
        reinterpret_cast<uint2*>(adst)[lane + 64 * i] = pk;
      }
    }
  }
#undef LN_SRC
}

#define FLD 772
#define LLD 392
__device__ void prep_phase(const Params& p, int layer, char* smem, int bid, int nblk, int tidx, int rep) {
  const int pv_ = rep ? PREPVAR : 0;
  float* F = reinterpret_cast<float*>(smem);
  u16* LIb = reinterpret_cast<u16*>(smem + 16 * FLD * 4);
  const float* cw = p.in[12] + (size_t)layer * 3 * 1152;
  const u16* LW = p.loraT + (size_t)layer * 98304;
  for (int it2 = bid; it2 < 2 * (NTOK / 16); it2 += nblk) {
    const bool doR = it2 < NTOK / 16;
    const int it = doR ? it2 : it2 - NTOK / 16;
    int tid = tidx;
    asm volatile("" : "+v"(tid));
    const int lane = tid & 63, wid = tid >> 6, fr = lane & 15, fq = lane >> 4;
    const int tok0 = it * 16;
    int b, tpos0, L;
    const bool isctx = tok0 < NCTX;
    if (isctx) { b = tok0 >> 8; tpos0 = tok0 & 255; L = 256; }
    else { const int tl = tok0 - NCTX; b = tl >> 10; tpos0 = tl & 1023; L = 1024; }
    if (doR) {
    {
      float* PRM = reinterpret_cast<float*>(smem + 61952);
      PRM[tid] = p.in[13][(size_t)layer * 512 + tid]; PRM[256 + tid] = p.in[13][(size_t)layer * 512 + 256 + tid];
      PRM[512 + tid] = p.in[15][(size_t)layer * 512 + tid]; PRM[768 + tid] = p.in[15][(size_t)layer * 512 + 256 + tid];
      PRM[1024 + tid] = p.in[18][(size_t)layer * 256 + tid]; PRM[1280 + tid] = p.in[19][(size_t)layer * 256 + tid]; PRM[1536 + tid] = p.in[20][(size_t)layer * 256 + tid];
    }
#pragma unroll 1
    for (int cg = tid; cg < 288; cg += 256) {
      const int c = cg * 4;
      const float4 w0 = *reinterpret_cast<const float4*>(cw + c);
      const float4 w1 = *reinterpret_cast<const float4*>(cw + 1152 + c);
      const float4 w2 = *reinterpret_cast<const float4*>(cw + 2304 + c);
      const float* pr = p.PROJ + (size_t)tok0 * DIN + c;
      float4 x[18];
#pragma unroll
      for (int i = 0; i < 18; ++i) {
        const int tpos = tpos0 + i - 1;
        x[i] = (tpos >= 0 && tpos < L) ? *reinterpret_cast<const float4*>(pr + (ptrdiff_t)(i - 1) * DIN) : make_float4(0.f, 0.f, 0.f, 0.f);
      }
#pragma unroll
      for (int tt = 0; tt < 16; ++tt) {
        float4 f;
        f.x = w0.x * x[tt].x + w1.x * x[tt + 1].x + w2.x * x[tt + 2].x;
        f.y = w0.y * x[tt].y + w1.y * x[tt + 1].y + w2.y * x[tt + 2].y;
        f.z = w0.z * x[tt].z + w1.z * x[tt + 1].z + w2.z * x[tt + 2].z;
        f.w = w0.w * x[tt].w + w1.w * x[tt + 1].w + w2.w * x[tt + 2].w;
        if (c < 768) { *reinterpret_cast<float4*>(F + tt * FLD + c) = f; }
        else {
          const int cc = c - 768;
          if (cc < 128) { f.x = tanhf_(f.x); f.y = tanhf_(f.y); f.z = tanhf_(f.z); f.w = tanhf_(f.w); }
          else if (cc >= 256) { f.x = sigmoidf_(f.x); f.y = sigmoidf_(f.y); f.z = sigmoidf_(f.z); f.w = sigmoidf_(f.w); }
          uint2 pk; pk.x = pack2(f.x, f.y); pk.y = pack2(f.z, f.w);
          *reinterpret_cast<uint2*>(LIb + tt * LLD + cc) = pk;
        }
      }
    }
    __syncthreads();
    f32x4 acc[5][4];
#pragma unroll
    for (int g = 0; g < 5; ++g)
#pragma unroll
      for (int nf = 0; nf < 4; ++nf) acc[g][nf] = (f32x4){0.f, 0.f, 0.f, 0.f};
    if (pv_ != 2 && pv_ != 3) {
#define PB_LOAD(W, GI) { const u16* wt_ = (GI) < 4 ? LW + (size_t)(GI) * 16384 : LW + 65536; const int rs_ = (GI) < 4 ? 64 : 128; const int ko_ = (GI) < 4 ? 0 : ((GI) - 4) * 64; \
      _Pragma("unroll") for (int ks_ = 0; ks_ < 2; ++ks_) _Pragma("unroll") for (int nf_ = 0; nf_ < 4; ++nf_) \
        W[ks_ * 4 + nf_] = *reinterpret_cast<const bf16x8*>(wt_ + (size_t)(64 * wid + 16 * nf_ + fr) * rs_ + ko_ + ks_ * 32 + fq * 8); }
#define PB_MMA(W, GI) { const int ai_ = (GI) < 4 ? (GI) : 4; const int xo_ = (GI) < 4 ? (GI) * 64 : 256 + ((GI) - 4) * 64; \
      _Pragma("unroll") for (int ks_ = 0; ks_ < 2; ++ks_) { \
        const bf16x8 xb_ = *reinterpret_cast<const bf16x8*>(LIb + fr * LLD + xo_ + ks_ * 32 + fq * 8); \
        _Pragma("unroll") for (int nf_ = 0; nf_ < 4; ++nf_) acc[ai_][nf_] = __builtin_amdgcn_mfma_f32_16x16x32_bf16(W[ks_ * 4 + nf_], xb_, acc[ai_][nf_], 0, 0, 0); } \
      __builtin_amdgcn_sched_barrier(0); }
    {
      bf16x8 wA[8], wB[8];
      PB_LOAD(wA, 0)
      PB_LOAD(wB, 1) PB_MMA(wA, 0)
      PB_LOAD(wA, 2) PB_MMA(wB, 1)
      PB_LOAD(wB, 3) PB_MMA(wA, 2)
      PB_LOAD(wA, 4) PB_MMA(wB, 3)
      PB_LOAD(wB, 5) PB_MMA(wA, 4)
      PB_MMA(wB, 5)
    }
#undef PB_LOAD
#undef PB_MMA
    }
    if (pv_ != 2 && pv_ != 3) {
#ifndef NO_C
    const float* PRM = reinterpret_cast<const float*>(smem + 61952);
    {
      const int tok = tok0 + fr;
      float ss = 0.f, bs = 0.f;
#pragma unroll
      for (int nf = 0; nf < 4; ++nf) {
        const int c0 = 64 * wid + 16 * nf + 4 * fq;
        const float4 r4 = *reinterpret_cast<const float4*>(F + fr * FLD + c0);
        const float4 k4 = *reinterpret_cast<const float4*>(F + fr * FLD + 256 + c0);
        const float4 w00 = *reinterpret_cast<const float4*>(PRM + c0);
        const float4 w01 = *reinterpret_cast<const float4*>(PRM + 256 + c0);
        const float4 a00 = *reinterpret_cast<const float4*>(PRM + 512 + c0);
        const float4 a01 = *reinterpret_cast<const float4*>(PRM + 768 + c0);
        const float4 kkw = *reinterpret_cast<const float4*>(PRM + 1024 + c0);
        const float4 kaw = *reinterpret_cast<const float4*>(PRM + 1280 + c0);
        const float4 rkw = *reinterpret_cast<const float4*>(PRM + 1536 + c0);
        const float rr[4] = {r4.x, r4.y, r4.z, r4.w}, kk_[4] = {k4.x, k4.y, k4.z, k4.w};
        const float w0a[4] = {w00.x, w00.y, w00.z, w00.w}, w0b[4] = {w01.x, w01.y, w01.z, w01.w};
        const float a0a[4] = {a00.x, a00.y, a00.z, a00.w}, a0b[4] = {a01.x, a01.y, a01.z, a01.w};
        const float kkw_[4] = {kkw.x, kkw.y, kkw.z, kkw.w}, kaw_[4] = {kaw.x, kaw.y, kaw.z, kaw.w}, rkw_[4] = {rkw.x, rkw.y, rkw.z, rkw.w};
#pragma unroll
        for (int r = 0; r < 4; ++r) {
          {
            const float z = -(w0a[r] + acc[0][nf][r]);
            const float sp = fmaxf(z, 0.f) + __logf(1.f + __expf(-fabsf(z)));
            acc[0][nf][r] = __expf(-__expf(-sp - 0.5f));
          }
          {
            const float z = -(w0b[r] + acc[1][nf][r]);
            const float sp = fmaxf(z, 0.f) + __logf(1.f + __expf(-fabsf(z)));
            acc[1][nf][r] = __expf(-__expf(-sp - 0.5f));
          }
          const float av0 = sigmoidf_(a0a[r] + acc[2][nf][r]);
          const float av1 = sigmoidf_(a0b[r] + acc[3][nf][r]);
          acc[2][nf][r] = av0; acc[3][nf][r] = av1;
          const float k = kk_[r];
          const float kq = k * kkw_[r];
          ss += kq * kq;
          const float kd0 = k * (1.f + (av0 - 1.f) * kaw_[r]);
          const float kd1 = k * (1.f + (av1 - 1.f) * kaw_[r]);
          bs += rr[r] * (kd0 + kd1) * rkw_[r];
        }
        __builtin_amdgcn_sched_barrier(0);
      }
      ss += __shfl_xor(ss, 16); ss += __shfl_xor(ss, 32);
      bs += __shfl_xor(bs, 16); bs += __shfl_xor(bs, 32);
      const float inrm = 1.f / fmaxf(sqrtf(ss), 1e-12f);
#pragma unroll
      for (int nf = 0; nf < 4; ++nf) {
        const int c0 = 64 * wid + 16 * nf + 4 * fq, n0 = 16 * nf + 4 * fq;
        const float4 r4 = *reinterpret_cast<const float4*>(F + fr * FLD + c0);
        const float4 k4 = *reinterpret_cast<const float4*>(F + fr * FLD + 256 + c0);
        const float4 v4 = *reinterpret_cast<const float4*>(F + fr * FLD + 512 + c0);
        const float4 kkw = *reinterpret_cast<const float4*>(PRM + 1024 + c0);
        const float4 kaw = *reinterpret_cast<const float4*>(PRM + 1280 + c0);
        const float kk_[4] = {k4.x, k4.y, k4.z, k4.w}, kkw_[4] = {kkw.x, kkw.y, kkw.z, kkw.w}, kaw_[4] = {kaw.x, kaw.y, kaw.z, kaw.w};
        float* sc = p.SC + ((size_t)(tok * 4 + wid) * 9) * 64 + n0;
        float kn[4], kd0[4], kd1[4];
#pragma unroll
        for (int r = 0; r < 4; ++r) {
          kn[r] = kk_[r] * kkw_[r] * inrm;
          kd0[r] = kk_[r] * (1.f + (acc[2][nf][r] - 1.f) * kaw_[r]);
          kd1[r] = kk_[r] * (1.f + (acc[3][nf][r] - 1.f) * kaw_[r]);
        }
        *reinterpret_cast<float4*>(sc) = r4;
        *reinterpret_cast<float4*>(sc + 64) = make_float4(kn[0], kn[1], kn[2], kn[3]);
        *reinterpret_cast<float4*>(sc + 128) = v4;
        *reinterpret_cast<float4*>(sc + 192) = make_float4(acc[0][nf][0], acc[0][nf][1], acc[0][nf][2], acc[0][nf][3]);
        *reinterpret_cast<float4*>(sc + 256) = make_float4(acc[2][nf][0] * kn[0], acc[2][nf][1] * kn[1], acc[2][nf][2] * kn[2], acc[2][nf][3] * kn[3]);
        *reinterpret_cast<float4*>(sc + 320) = make_float4(kd0[0], kd0[1], kd0[2], kd0[3]);
        *reinterpret_cast<float4*>(sc + 384) = make_float4(acc[1][nf][0], acc[1][nf][1], acc[1][nf][2], acc[1][nf][3]);
        *reinterpret_cast<float4*>(sc + 448) = make_float4(acc[3][nf][0] * kn[0], acc[3][nf][1] * kn[1], acc[3][nf][2] * kn[2], acc[3][nf][3] * kn[3]);
        *reinterpret_cast<float4*>(sc + 512) = make_float4(kd1[0], kd1[1], kd1[2], kd1[3]);
        *reinterpret_cast<float4*>(p.G + (size_t)tok * 256 + c0) = make_float4(acc[4][nf][0], acc[4][nf][1], acc[4][nf][2], acc[4][nf][3]);
        *reinterpret_cast<float4*>(p.BV + (size_t)tok * 256 + c0) = make_float4(bs * v4.x, bs * v4.y, bs * v4.z, bs * v4.w);
        __builtin_amdgcn_sched_barrier(0);
      }
    }
#endif
    }
    }
    if (!doR && pv_ != 1) {
#ifndef NO_D
    {
      const int tok = tid >> 4, g8 = tid & 15, tokg = tok0 + tok, tpos = tpos0 + tok;
      const int tkey = isctx ? tpos : 512 + tpos;
      const float* pr = p.PROJ + (size_t)tokg * DIN;
#pragma unroll
      for (int hh = 0; hh < 2; ++hh) {
        const int g = g8 + 16 * hh, c0 = g * 8, hd = c0 >> 6, d0 = c0 & 63;
        const float4 qa = *reinterpret_cast<const float4*>(pr + 1152 + c0), qb = *reinterpret_cast<const float4*>(pr + 1152 + c0 + 4);
        const float4 ka = *reinterpret_cast<const float4*>(pr + 1408 + c0), kb2 = *reinterpret_cast<const float4*>(pr + 1408 + c0 + 4);
        const float qv[8] = {qa.x * QSCALE, qa.y * QSCALE, qa.z * QSCALE, qa.w * QSCALE, qb.x * QSCALE, qb.y * QSCALE, qb.z * QSCALE, qb.w * QSCALE};
        const float kv[8] = {ka.x, ka.y, ka.z, ka.w, kb2.x, kb2.y, kb2.z, kb2.w};
        if (isctx) {
          float* ok = p.out_nak + ((size_t)(b * 4 + layer) * 256 + tpos) * 256 + c0;
          *reinterpret_cast<float4*>(ok) = ka; *reinterpret_cast<float4*>(ok + 4) = kb2;
          pack8_store(p.QNc + (size_t)tokg * 256 + c0, qv);
          pack8_store(p.KNc + (size_t)(b * 4 + hd) * 16384 + kf_off(tkey, d0), kv);
        } else {
          pack8_store(p.QNl + (size_t)(tokg - NCTX) * 256 + c0, qv);
          pack8_store(p.KNl + ((size_t)((layer * 2 + b) * 4 + hd)) * 98304 + kf_off(tkey, d0), kv);
        }
      }
#pragma unroll
      for (int hh = 0; hh < 5; ++hh) {
        const bool isk = (hh == 4);
        const int g = isk ? g8 : g8 + 16 * hh, d0 = (g & 7) * 8, hd = g >> 3;
        const float* src = pr + (isk ? 2432 : 1920) + g * 8;
        const float4 xa = *reinterpret_cast<const float4*>(src), xb = *reinterpret_cast<const float4*>(src + 4);
        const float* nw = (isk ? p.in[25] : p.in[24]) + (size_t)layer * 64 + d0;
        const float4 na = *reinterpret_cast<const float4*>(nw), nb = *reinterpret_cast<const float4*>(nw + 4);
        float x[8] = {xa.x, xa.y, xa.z, xa.w, xb.x, xb.y, xb.z, xb.w};
        const float nrm[8] = {na.x, na.y, na.z, na.w, nb.x, nb.y, nb.z, nb.w};
        float ss = 0.f;
#pragma unroll
        for (int e = 0; e < 8; ++e) ss += x[e] * x[e];
        ss += dpp_mov<0xB1>(ss); ss += dpp_mov<0x4E>(ss); ss += dpp_mov<0x141>(ss);
        const float rs = rsqrtf(ss * (1.f / 64.f) + 1e-6f);
#pragma unroll
        for (int e = 0; e < 8; ++e) x[e] = x[e] * rs * nrm[e];
        if (isk && isctx) {
          float* ok = p.out_gk + ((size_t)(b * 4 + layer) * 256 + tpos) * 128 + g * 8;
          *reinterpret_cast<float4*>(ok) = make_float4(x[0], x[1], x[2], x[3]);
          *reinterpret_cast<float4*>(ok + 4) = make_float4(x[4], x[5], x[6], x[7]);
        }
        if (!isctx) {
          const int pos = (d0 < 32) ? (tpos >> 6) : (tpos & 63);
          const float4* rt = reinterpret_cast<const float4*>(p.rope + (size_t)(pos * 16 + (d0 & 15)) * 2);
          const float4 r0 = rt[0], r1 = rt[1], r2 = rt[2], r3 = rt[3];
          const float cs[8] = {r0.x, r0.z, r1.x, r1.z, r2.x, r2.z, r3.x, r3.z};
          const float sn[8] = {r0.y, r0.w, r1.y, r1.w, r2.y, r2.w, r3.y, r3.w};
          const float sg = (d0 & 16) ? 1.f : -1.f;
#pragma unroll
          for (int e = 0; e < 8; ++e) { const float pe = dpp_mov<0x4E>(x[e]); x[e] = x[e] * cs[e] + sg * pe * sn[e]; }
        }
        if (!isk) {
#pragma unroll
          for (int e = 0; e < 8; ++e) x[e] *= QSCALE;
          if (isctx) pack8_store(p.QGc + (size_t)tokg * 512 + g * 8, x);
          else pack8_store(p.QGl + (size_t)(tokg - NCTX) * 512 + g * 8, x);
        } else {
          if (isctx) pack8_store(p.KGc + (size_t)(b * 2 + hd) * 16384 + kf_off(tkey, d0), x);
          else pack8_store(p.KGl + ((size_t)((layer * 2 + b) * 2 + hd)) * 98304 + kf_off(tkey, d0), x);
        }
      }
    }
    const int c = tid;
#pragma unroll
    for (int half = 0; half < 2; ++half) {
      float vv[8];
#pragma unroll
      for (int t8 = 0; t8 < 8; ++t8) {
        const int tt = half * 8 + t8, tokn = tok0 + tt;
        const float v = p.PROJ[(size_t)tokn * DIN + 1664 + c];
        vv[t8] = v;
        if (isctx) p.out_nav[((size_t)(b * 4 + layer) * 256 + tpos0 + tt) * 256 + c] = v;
      }
      if (isctx) pack44_store(p.VNtc + (size_t)(b * 4 + (c >> 6)) * 16384, tpos0 + half * 8, c & 63, vv);
      else pack44_store(p.VNtl + ((size_t)((layer * 2 + b) * 4 + (c >> 6))) * 98304, 512 + tpos0 + half * 8, c & 63, vv);
    }
    if (wid >= 2) {
      const int cv = c - 128;
#pragma unroll
      for (int half = 0; half < 2; ++half) {
        float vv[8];
#pragma unroll
        for (int t8 = 0; t8 < 8; ++t8) {
          const int tt = half * 8 + t8, tokn = tok0 + tt;
          const float v = p.PROJ[(size_t)tokn * DIN + 2560 + cv];
          vv[t8] = v;
          if (isctx) p.out_gv[((size_t)(b * 4 + layer) * 256 + tpos0 + tt) * 128 + cv] = v;
        }
        if (isctx) pack44_store(p.VGtc + (size_t)(b * 2 + (cv >> 6)) * 16384, tpos0 + half * 8, cv & 63, vv);
        else pack44_store(p.VGtl + ((size_t)((layer * 2 + b) * 2 + (cv >> 6))) * 98304, 512 + tpos0 + half * 8, cv & 63, vv);
      }
    }
#endif
    }
    __syncthreads();
  }
}

#define ATT_LOAD(KF, VF, CI) { \
    const int ci_ = min((CI), nt - 1); \
    int kb_; \
    if (ci_ < nd) kb_ = ci_ * 32; \
    else { const int e_ = ci_ - nd; const int j_ = (ncc == 2) ? (e_ >> 1) : e_; const int cc_ = cc0 + ((ncc == 2) ? (e_ & 1) : 0); kb_ = 512 + (rb + j_) * 64 + cc_ * 32; } \
    const u16* kp_ = Kb + (size_t)(kb_ >> 4) * 1024 + lane * 8; \
    KF##00 = *reinterpret_cast<const bf16x8*>(kp_); \
    KF##01 = *reinterpret_cast<const bf16x8*>(kp_ + 512); \
    KF##10 = *reinterpret_cast<const bf16x8*>(kp_ + 1024); \
    KF##11 = *reinterpret_cast<const bf16x8*>(kp_ + 1536); \
    const u16* vp_ = Vt + (size_t)(kb_ >> 5) * 2048 + lane * 8; \
    VF##0 = *reinterpret_cast<const bf16x8*>(vp_); \
    VF##1 = *reinterpret_cast<const bf16x8*>(vp_ + 512); \
    VF##2 = *reinterpret_cast<const bf16x8*>(vp_ + 1024); \
    VF##3 = *reinterpret_cast<const bf16x8*>(vp_ + 1536); }

#define ATT_PV(DT, VV) { \
    o[DT][0] *= alpha; o[DT][1] *= alpha; o[DT][2] *= alpha; o[DT][3] *= alpha; \
    o[DT] = __builtin_amdgcn_mfma_f32_16x16x32_bf16(VV, pf.v, o[DT], 0, 0, 0); }

#define ATT_COMPUTE(KF, VF, CI) { \
    const int ci_ = (CI); \
    f32x4 s0 = (f32x4){0.f, 0.f, 0.f, 0.f}, s1 = (f32x4){0.f, 0.f, 0.f, 0.f}; \
    s0 = __builtin_amdgcn_mfma_f32_16x16x32_bf16(KF##00, qf0, s0, 0, 0, 0); \
    s0 = __builtin_amdgcn_mfma_f32_16x16x32_bf16(KF##01, qf1, s0, 0, 0, 0); \
    s1 = __builtin_amdgcn_mfma_f32_16x16x32_bf16(KF##10, qf0, s1, 0, 0, 0); \
    s1 = __builtin_amdgcn_mfma_f32_16x16x32_bf16(KF##11, qf1, s1, 0, 0, 0); \
    float sv[8] = {s0[0], s0[1], s0[2], s0[3], s1[0], s1[1], s1[2], s1[3]}; \
    bool ok[8]; \
    _Pragma("unroll") for (int e = 0; e < 8; ++e) ok[e] = true; \
    if (ci_ >= nd) { \
      const int e_ = ci_ - nd; const int j_ = (ncc == 2) ? (e_ >> 1) : e_; const int cc_ = cc0 + ((ncc == 2) ? (e_ & 1) : 0); \
      const int dr_ = rb + j_ - grow + 7; \
      const int cq = cq0 + fr, c0 = min(max(cq - 8, 0), 48); \
      _Pragma("unroll") for (int e = 0; e < 8; ++e) { \
        const int ck = cc_ * 32 + 16 * (e >> 2) + 4 * fq + (e & 3); \
        ok[e] = (ck >= c0) && (ck < c0 + 16); \
        const int dc = min(max(ck - cq, -15), 15) + 15; \
        const float bias = rpb[dr_ * 31 + dc] * LOG2E; \
        sv[e] = ok[e] ? sv[e] + bias : -1e30f; \
      } \
    } \
    float mx = fmaxf(fmaxf(fmaxf(sv[0], sv[1]), fmaxf(sv[2], sv[3])), fmaxf(fmaxf(sv[4], sv[5]), fmaxf(sv[6], sv[7]))); \
    mx = fmaxf(mx, __shfl_xor(mx, 16)); \
    mx = fmaxf(mx, __shfl_xor(mx, 32)); \
    const float mn = fmaxf(m, mx); \
    const float alpha = __builtin_amdgcn_exp2f(m - mn); \
    m = mn; \
    float ps = 0.f; \
    _Pragma("unroll") for (int e = 0; e < 8; ++e) { sv[e] = ok[e] ? __builtin_amdgcn_exp2f(sv[e] - mn) : 0.f; ps += sv[e]; } \
    l = l * alpha + ps; \
    union { bf16x8 v; unsigned u[4]; } pf; \
    pf.u[0] = pack2(sv[0], sv[1]); pf.u[1] = pack2(sv[2], sv[3]); pf.u[2] = pack2(sv[4], sv[5]); pf.u[3] = pack2(sv[6], sv[7]); \
    ATT_PV(0, VF##0) ATT_PV(1, VF##1) ATT_PV(2, VF##2) ATT_PV(3, VF##3) }

__device__ __forceinline__ void attn_wave(const u16* __restrict__ Q, int ldq, const u16* __restrict__ Kb, int ldk,
                                          const u16* __restrict__ Vt, int ldv, int ndense, const bool NA,
                                          const float* __restrict__ rpb, int grow, int cq0,
                                          u16* __restrict__ out, int ldo, int tidx) {
  const int lane = tidx & 63, fr = lane & 15, fq = lane >> 4;
  const bf16x8 qf0 = *reinterpret_cast<const bf16x8*>(Q + (size_t)fr * ldq + fq * 8);
  const bf16x8 qf1 = *reinterpret_cast<const bf16x8*>(Q + (size_t)fr * ldq + 32 + fq * 8);
  f32x4 o[4];
#pragma unroll
  for (int dt = 0; dt < 4; ++dt) o[dt] = (f32x4){0.f, 0.f, 0.f, 0.f};
  float m = -1e30f, l = 0.f;
  const int nd = ndense >> 5;
  const int rb = min(max(grow - 4, 0), 8);
  const int ulo = min(max(cq0 - 8, 0), 48), uhi = min(max(cq0 + 15 - 8, 0), 48) + 16;
  const bool c0ok = ulo < 32, c1ok = uhi > 32;
  const int ncc = (c0ok && c1ok) ? 2 : 1, cc0 = c0ok ? 0 : 1;
  const int nt = nd + (NA ? 8 * ncc : 0);
  bf16x8 ka00, ka01, ka10, ka11, kb00, kb01, kb10, kb11;
  bf16x8 va0, va1, va2, va3, vb0, vb1, vb2, vb3;
  ATT_LOAD(ka, va, 0)
  for (int ci = 0; ci < nt; ci += 2) {
    ATT_LOAD(kb, vb, ci + 1)
    ATT_COMPUTE(ka, va, ci)
    if (ci + 1 < nt) {
      ATT_LOAD(ka, va, ci + 2)
      ATT_COMPUTE(kb, vb, ci + 1)
    }
  }
  l += __shfl_xor(l, 16);
  l += __shfl_xor(l, 32);
  const float il = 1.f / l;
#pragma unroll
  for (int dt = 0; dt < 4; ++dt) {
    uint2 pk; pk.x = pack2(o[dt][0] * il, o[dt][1] * il); pk.y = pack2(o[dt][2] * il, o[dt][3] * il);
    *reinterpret_cast<uint2*>(out + (size_t)fr * ldo + 16 * dt + 4 * fq) = pk;
  }
}

__device__ void scan_item(const Params& p, int layer, char* smem, bool lat, int b, int h, int dir, int qd, int tidx) {
  const int tid = tidx, lane = tid & 63, wid = tid >> 6, rr = lane >> 4, j = lane & 15;
  const int L = lat ? 1024 : 256, seqbase = lat ? NCTX + b * 1024 : b * 256;
  const int rowl = wid * 4 + rr, row = qd * 16 + rowl;
  float* cbuf = reinterpret_cast<float*>(smem);
  float* obuf = cbuf + 2 * 16 * 6 * 64;
  float4 S = make_float4(0.f, 0.f, 0.f, 0.f);
  if (lat) S = *reinterpret_cast<const float4*>(p.in[2] + ((((size_t)(b * 4 + layer) * 2 + dir) * 4 + h) * 64 + row) * 64 + 4 * j);
  v2f S01 = (v2f){S.x, S.y}, S23 = (v2f){S.z, S.w};
  const int nch = L / 16;
  float* odst = dir == 0 ? p.OF : p.OB;
  float4 pre0, pre1, pre2, pre3, pre4, pre5;
  const ptrdiff_t cstep = (dir == 0 ? 1 : -1) * (ptrdiff_t)(16 * 4 * 9 * 64);
  const float *gp0, *gp1, *gp2, *gp3, *gp4, *gp5;
#define SC_GP(GP, I) { const int idx = tid + 256 * (I), tt_ = idx / 96, rem = idx % 96, vec = rem >> 4, f4 = rem & 15; \
    const int t_ = dir == 0 ? tt_ : L - 1 - tt_; const int svec = vec < 3 ? vec : vec + 3 * dir; \
    GP = p.SC + ((size_t)((seqbase + t_) * 4 + h) * 9 + svec) * 64 + f4 * 4; }
  SC_GP(gp0, 0) SC_GP(gp1, 1) SC_GP(gp2, 2) SC_GP(gp3, 3) SC_GP(gp4, 4) SC_GP(gp5, 5)
#define SC_GL1(PR, GP, CH) PR = *reinterpret_cast<const float4*>(GP + (ptrdiff_t)(CH) * cstep);
#define gload(CH) { SC_GL1(pre0, gp0, CH) SC_GL1(pre1, gp1, CH) SC_GL1(pre2, gp2, CH) SC_GL1(pre3, gp3, CH) SC_GL1(pre4, gp4, CH) SC_GL1(pre5, gp5, CH) }
#define SC_LS1(PR, I, BUF) *reinterpret_cast<float4*>(cbuf + (BUF) * 6144 + (tid + 256 * (I)) * 4) = PR;
#define lstore(BUF) { SC_LS1(pre0, 0, BUF) SC_LS1(pre1, 1, BUF) SC_LS1(pre2, 2, BUF) SC_LS1(pre3, 3, BUF) SC_LS1(pre4, 4, BUF) SC_LS1(pre5, 5, BUF) }
  gload(0); lstore(0);
  __syncthreads();
#define SC_LD(R4, K4, VV, W4, A4, D4, TT) { const float* base_ = cb + (TT) * 384; \
    R4 = *reinterpret_cast<const float4*>(base_ + 4 * j); K4 = *reinterpret_cast<const float4*>(base_ + 64 + 4 * j); \
    VV = base_[128 + row]; W4 = *reinterpret_cast<const float4*>(base_ + 192 + 4 * j); \
    A4 = *reinterpret_cast<const float4*>(base_ + 256 + 4 * j); D4 = *reinterpret_cast<const float4*>(base_ + 320 + 4 * j); }
#if SCANVAR
  for (int pass_ = 0; pass_ < (lat ? 2 : 1); ++pass_) {
  int var_ = pass_ ? SCANVAR : 0;
  asm volatile("" : "+v"(var_)); var_ = __builtin_amdgcn_readfirstlane(var_);
#else
  const int var_ = 0;
#endif
  for (int ch = 0; ch < nch; ++ch) {
    if (ch + 1 < nch && var_ != 3) gload(ch + 1);
    const float* cb = cbuf + (ch & 1) * 6144;
    float osel = 0.f;
    float4 r4, kk4, w4, ak4, kd4; float vv;
    SC_LD(r4, kk4, vv, w4, ak4, kd4, 0)
    if (var_ != 2)
#pragma unroll
    for (int hf = 0; hf < 2; ++hf) {
      float oqA = 0.f, oqB = 0.f, ovp = 0.f;
#pragma unroll
      for (int u = 0; u < 8; ++u) {
        const int tt = hf * 8 + u;
        float4 r4n, kk4n, w4n, ak4n, kd4n; float vvn;
        SC_LD(r4n, kk4n, vvn, w4n, ak4n, kd4n, tt + 1)
        v2f p = S01 * (v2f){kk4.x, kk4.y};
        p = S23 * (v2f){kk4.z, kk4.w} + p;
        float sk = p.x + p.y;
        sk += dpp_mov<0xB1>(sk);  ovp += dpp_mov<0xB1>(ovp);
        sk += dpp_mov<0x4E>(sk);  ovp += dpp_mov<0x4E>(ovp);
        sk += dpp_mov<0x141>(sk);
        sk += dpp_mov<0x140>(sk);
        if (u > 0) {
          if (((u - 1) >> 2) == 0) oqA = ((j & 3) == ((u - 1) & 3)) ? ovp : oqA;
          else oqB = ((j & 3) == ((u - 1) & 3)) ? ovp : oqB;
        }
        const v2f vv2 = (v2f){vv, vv}, sk2 = (v2f){sk, sk};
        v2f t01 = (v2f){kd4.x, kd4.y} * vv2; t01 = t01 - (v2f){ak4.x, ak4.y} * sk2;
        v2f t23 = (v2f){kd4.z, kd4.w} * vv2; t23 = t23 - (v2f){ak4.z, ak4.w} * sk2;
        S01 = S01 * (v2f){w4.x, w4.y} + t01;
        S23 = S23 * (v2f){w4.z, w4.w} + t23;
        v2f q = S01 * (v2f){r4.x, r4.y};
        q = S23 * (v2f){r4.z, r4.w} + q;
        ovp = q.x + q.y;
        r4 = r4n; kk4 = kk4n; w4 = w4n; ak4 = ak4n; kd4 = kd4n; vv = vvn;
      }
      ovp += dpp_mov<0xB1>(ovp); ovp += dpp_mov<0x4E>(ovp);
      oqB = ((j & 3) == 3) ? ovp : oqB;
      oqA += dpp_mov<0x128>(oqA); oqB += dpp_mov<0x128>(oqB);
      oqA += dpp_mov<0x124>(oqA); oqB += dpp_mov<0x124>(oqB);
      if ((j >> 3) == hf) osel = ((j >> 2) & 1) ? oqB : oqA;
    }
    if (var_ == 0) {
      const int st = ch * 16 + j, t = dir == 0 ? st : L - 1 - st;
      odst[(size_t)(seqbase + t) * 256 + h * 64 + row] = osel;
    } else asm volatile("" :: "v"(osel), "v"(S01), "v"(S23));
    if (ch + 1 < nch && var_ != 3) lstore((ch + 1) & 1);
    asm volatile("s_waitcnt lgkmcnt(0)" ::: "memory");
    __builtin_amdgcn_s_barrier();
  }
#if SCANVAR
  }
#endif
  if (!lat) *reinterpret_cast<float4*>(p.out_st + ((((size_t)(b * 4 + layer) * 2 + dir) * 4 + h) * 64 + row) * 64 + 4 * j) = make_float4(S01.x, S01.y, S23.x, S23.y);
  __syncthreads();
}

__device__ void mixer_phase(const Params& p, int layer_wq, char* smem, int tidx0) {
  const int layer = layer_wq & 3;
  int* slot = reinterpret_cast<int*>(smem + 60 * 1024);
  bool first = true;
  for (;;) {
    int tidx = tidx0;
    asm volatile("" : "+v"(tidx));
    const int tid = tidx, wid = tid >> 6;
    __syncthreads();
    if (tid == 0) *slot = first ? (int)blockIdx.x : (int)(gridDim.x + atomicAdd(&p.wq[layer_wq], 1u));
    first = false;
    __syncthreads();
    int it = *slot;
    if (it >= 1728) break;
    const bool is_scan = (it < 64) || (it >= 448 && it < 960);
#if REPMASK
    if ((p.pad == 1 && !is_scan) || (p.pad == 2 && is_scan) || ((p.pad == 3 || p.pad == 5 || p.pad == 6) && !(it < 64)) || (p.pad == 4 && !(it >= 64 && it < 320))) continue;
#endif
    if (is_scan) {
      const bool lat = it < 64;
      const int si = lat ? it : it - 448;
#ifndef NO_SCAN
      scan_item(p, layer, smem, lat, si / 32, (si / 8) % 4, (si / 4) % 2, si % 4, tidx);
#endif
      continue;
    }
    const u16 *Q, *Kb, *Vt; u16* out; int ldq, ldk, ldv, ndense, grow = 0, cq0 = 0; bool na = false;
    const float* rpb = p.in[23];
    if (it < 320) {
      it -= 64;
      const int b = it / 128, qh = (it / 16) % 8, qt = it % 16, kvh = qh >> 2;
      const int q0 = b * 1024 + qt * 64 + wid * 16;
      Q = p.QGl + (size_t)q0 * 512 + qh * 64; ldq = 512;
      Kb = p.KGl + (size_t)((layer * 2 + b) * 2 + kvh) * 98304; ldk = 0;
      Vt = p.VGtl + (size_t)((layer * 2 + b) * 2 + kvh) * 98304; ldv = 0; ndense = 1536;
      out = p.MIX + (size_t)(NCTX + q0) * DM + 512 + qh * 64;
    } else if (it < 448) {
      it -= 320;
      const int b = it / 64, h = (it / 16) % 4, r = it % 16;
      const int q0 = b * 1024 + r * 64 + wid * 16;
      Q = p.QNl + (size_t)q0 * 256 + h * 64; ldq = 256;
      Kb = p.KNl + (size_t)((layer * 2 + b) * 4 + h) * 98304; ldk = 0;
      Vt = p.VNtl + (size_t)((layer * 2 + b) * 4 + h) * 98304; ldv = 0; ndense = 512;
      rpb = p.in[23] + (size_t)(layer * 4 + h) * 15 * 31; grow = r; cq0 = wid * 16; na = true;
      out = p.MIX + (size_t)(NCTX + q0) * DM + 256 + h * 64;
    } else if (it < 1472) {
      it -= 960;
      const int b = it / 32, qh = (it / 4) % 8, qt = it % 4, kvh = qh >> 2;
      const int q0 = b * 256 + qt * 64 + wid * 16;
      Q = p.QGc + (size_t)q0 * 512 + qh * 64; ldq = 512;
      Kb = p.KGc + (size_t)(b * 2 + kvh) * 16384; ldk = 0;
      Vt = p.VGtc + (size_t)(b * 2 + kvh) * 16384; ldv = 0; ndense = 256;
      out = p.MIX + (size_t)q0 * DM + 512 + qh * 64;
    } else {
      it -= 1472;
      const int b = it / 16, h = (it / 4) % 4, qt = it % 4;
      const int q0 = b * 256 + qt * 64 + wid * 16;
      Q = p.QNc + (size_t)q0 * 256 + h * 64; ldq = 256;
      Kb = p.KNc + (size_t)(b * 4 + h) * 16384; ldk = 0;
      Vt = p.VNtc + (size_t)(b * 4 + h) * 16384; ldv = 0; ndense = 256;
      out = p.MIX + (size_t)q0 * DM + 256 + h * 64;
    }
#ifndef NO_ATT
    attn_wave(Q, ldq, Kb, ldk, Vt, ldv, ndense, na, rpb, grow, cq0, out, DM, tidx);
#endif
  }
}

__device__ void rwkv_fin_phase(const Params& p, int layer, int bid, int nblk, int tidx) {
  const int tid = tidx;
  const float lw = p.in[21][(size_t)layer * 256 + tid], lb = p.in[22][(size_t)layer * 256 + tid];
  for (int t4 = bid; t4 < NTOK / 4; t4 += nblk) {
    float of[4], ob[4], bv[4], gg[4];
#pragma unroll
    for (int u = 0; u < 4; ++u) {
      const size_t i = (size_t)(t4 * 4 + u) * 256 + tid;
      of[u] = p.OF[i]; ob[u] = p.OB[i]; bv[u] = p.BV[i]; gg[u] = p.G[i];
    }
#pragma unroll
    for (int u = 0; u < 4; ++u) {
      const float o = of[u] + ob[u];
      const float mu = wave_sum(o) * (1.f / 64.f);
      const float d = o - mu;
      const float var = wave_sum(d * d) * (1.f / 64.f);
      const float y = (d * rsqrtf(var + 64e-5f) * lw + lb + bv[u]) * gg[u];
      p.MIX[(size_t)(t4 * 4 + u) * DM + tid] = f2bf(y);
    }
  }
}

#ifndef ONLY_PH
#define ONLY_PH -1
#endif
#define PH_EN(x) (ONLY_PH < 0 || ONLY_PH == (x))
__device__ __forceinline__ void run_phase(const Params& p, int ph, char* smem, int bid, int nblk, int tidx, int rep = 0) {
  const bool defer = (nblk == 512);
  if (ph == 0) {
    if (PH_EN(0)) { setup_phase(p, smem, bid, nblk, tidx); weight_convert(p, smem, tidx, bid, nblk, 0, defer ? 3040 : 4 * 3040); }
    return;
  }
  if (ph == 1) { if (PH_EN(1)) modreduce_phase(p, bid, nblk, tidx); return; }
  if (ph == 2) { if (PH_EN(2)) ln_phase<0>(p, 0, bid, nblk, tidx); return; }
  const int layer = (ph - 3) / 9, s = (ph - 3) % 9;
  switch (s) {
    case 0: if (PH_EN(3)) gemm_phase<EPI_PROJ, 256, 3>(p, layer, p.A, p.winT + (size_t)layer * DIN * DM, DIN, DM, smem, bid, nblk, tidx); break;
    case 1: if (PH_EN(4)) prep_phase(p, layer, smem, bid, nblk, tidx, rep); break;
    case 2: if (PH_EN(5)) mixer_phase(p, layer + 4 * rep, smem, tidx); break;
    case 3: if (PH_EN(6)) rwkv_fin_phase(p, layer, bid, nblk, tidx); break;
    case 4: if (PH_EN(7)) gemm_phase<EPI_OUT, 192, 3>(p, layer, p.MIX, p.woutT + (size_t)layer * DM * DM, DM, DM, smem, bid, nblk, tidx); break;
    case 5: if (PH_EN(8)) ln_phase<1>(p, layer, bid, nblk, tidx); break;
    case 6: if (PH_EN(9)) gemm_phase<EPI_FFI, 192, 3>(p, layer, p.A, p.wfiT + (size_t)layer * 2 * DFF * DM, 2 * DFF, DM, smem, bid, nblk, tidx); break;
    case 7:
      if (PH_EN(10)) {
        if (defer && bid >= 256) { if (layer < 3) weight_convert(p, smem, tidx, bid - 256, 256, 3040 * (layer + 1), 3040 * (layer + 2)); }
        else gemm_phase<EPI_FFO, 192, 3>(p, layer, p.ACT, p.wfoT + (size_t)layer * DM * DFF, DM, DFF, smem, bid, nblk, tidx);
      }
      break;
    default: if (PH_EN(11)) ln_phase<2>(p, layer, bid, nblk, tidx); break;
  }
}

__global__ void __launch_bounds__(256, 2) fwd_kernel(Params p, int ph0, int ph1, int usebar) {
  __shared__ __attribute__((aligned(16))) char smem[73728 + 16];
  const int bid = blockIdx.x, nblk = gridDim.x;
  XcdBarrier xb;
  if (usebar && p.never) cg::this_grid().sync();
  if (usebar) {
    if (threadIdx.x == 0) *reinterpret_cast<uint4*>(smem + 73728) = make_uint4(0u, 0u, 0u, 0u);
    __syncthreads();
    xb = xcd_barrier_post(p.bar, (volatile LAS unsigned*)(smem + 73728));
  }
  int ph = ph0, rep = 0;
  while (ph < ph1) {
    int tidx = threadIdx.x;
    asm volatile("" : "+v"(tidx));
    run_phase(p, ph, smem, bid, nblk, tidx, rep);
#if REPSLOT >= 0
    if (((ph < 3 ? 9 + ph : (ph - 3) % 9) == REPSLOT) && rep == 0) rep = 1; else { rep = 0; ++ph; }
#else
    ++ph;
#endif
    if (usebar && ph < ph1) xcd_barrier(xb);
  }
}

static inline size_t al256(size_t x) { return (x + 255) & ~(size_t)255; }

extern "C" void kernel_launch(void* const* d_in, const int* in_sizes, int n_in, void* d_out, int out_size, void* d_ws, size_t ws_size,
                              hipStream_t stream) {
  Params p;
  memset(&p, 0, sizeof(p));
  for (int i = 0; i < 33; ++i) p.in[i] = (const float*)d_in[i];
  float* o = (float*)d_out;
  p.out_yp = o; o += 4194304;
  p.out_ys = o; o += 2097152;
  p.out_st = o; o += 2097152;
  p.out_nak = o; o += 4194304;
  p.out_nav = o; o += 4194304;
  p.out_gk = o; o += 2097152;
  p.out_gv = o;
  char* w = (char*)d_ws; size_t off = 0;
  auto take = [&](size_t bytes) { char* r = w + off; off += al256(bytes); return r; };
  p.bar = (unsigned*)take(16384);
  p.wq = p.bar + 3584;
  p.modp = (float*)take((size_t)4 * 32 * 3 * 6144 * 4);
  p.mod = (float*)take((size_t)4 * 3 * 6144 * 4);
  p.winT = (u16*)take((size_t)4 * DIN * DM * 2);
  p.woutT = (u16*)take((size_t)4 * DM * DM * 2);
  p.wfiT = (u16*)take((size_t)4 * 2 * DFF * DM * 2);
  p.wfoT = (u16*)take((size_t)4 * DM * DFF * 2);
  p.X = (float*)take((size_t)NTOK * DM * 4);
  p.PROJ = (float*)take((size_t)NTOK * DIN * 4);
  p.X1 = p.PROJ;
  p.Y = p.PROJ + (size_t)NTOK * DM;
  p.SC = (float*)take((size_t)NTOK * 4 * 9 * 64 * 4);
  p.ACT = (u16*)p.SC;
  p.G = (float*)take((size_t)NTOK * 256 * 4);
  p.BV = (float*)take((size_t)NTOK * 256 * 4);
  p.OF = (float*)take((size_t)NTOK * 256 * 4);
  p.OB = (float*)take((size_t)NTOK * 256 * 4);
  p.A = (u16*)take((size_t)NTOK * DM * 2);
  p.MIX = (u16*)take((size_t)NTOK * DM * 2);
  p.QNc = (u16*)take((size_t)NCTX * 256 * 2);
  p.KNc = (u16*)take((size_t)NCTX * 256 * 2);
  p.VNtc = (u16*)take((size_t)NCTX * 256 * 2);
  p.QGc = (u16*)take((size_t)NCTX * 512 * 2);
  p.KGc = (u16*)take((size_t)NCTX * 128 * 2);
  p.VGtc = (u16*)take((size_t)NCTX * 128 * 2);
  p.QNl = (u16*)take((size_t)2048 * 256 * 2);
  p.KNl = (u16*)take((size_t)4 * 2 * 1536 * 256 * 2);
  p.VNtl = (u16*)take((size_t)4 * 2 * 1536 * 256 * 2);
  p.QGl = (u16*)take((size_t)2048 * 512 * 2);
  p.KGl = (u16*)take((size_t)4 * 2 * 1536 * 128 * 2);
  p.VGtl = (u16*)take((size_t)4 * 2 * 1536 * 128 * 2);
  p.loraT = (u16*)take((size_t)4 * 98304 * 2);
  p.rope = (float*)take((size_t)64 * 16 * 2 * 4);
  if (off > ws_size) { fprintf(stderr, "workspace too small: need %zu have %zu\n", off, ws_size); return; }

  (void)hipMemsetAsync(p.bar, 0, 16384, stream);
#if MEGA
  static int grid_blocks = 0;
  if (!grid_blocks) {
    int dev = 0, cus = 0, per_cu = 0;
    hipGetDevice(&dev);
    hipDeviceGetAttribute(&cus, hipDeviceAttributeMultiprocessorCount, dev);
    hipOccupancyMaxActiveBlocksPerMultiprocessor(&per_cu, fwd_kernel, 256, 0);
    if (per_cu > 2) per_cu = 2;
    if (per_cu < 1) per_cu = 1;
    grid_blocks = cus * per_cu;
  }
  int ph0 = 0, ph1 = NPH, ub = 1;
  void* args[] = {&p, &ph0, &ph1, &ub};
  hipError_t e = hipLaunchCooperativeKernel((void*)fwd_kernel, dim3(grid_blocks), dim3(256), args, 0, stream);
  if (e != hipSuccess) fprintf(stderr, "cooperative launch failed: %s (grid %d)\n", hipGetErrorString(e), grid_blocks);
#else
  for (int ph = 0; ph < NPH; ++ph) fwd_kernel<<<512, 256, 0, stream>>>(p, ph, ph + 1, 0);
#endif
}
```

```cpp
#include <hip/hip_runtime.h>
#include <hip/hip_cooperative_groups.h>
#include <cstdio>
#include <cstdint>
#include <cstring>
namespace cg = cooperative_groups;

#ifndef REPMASK
#define REPMASK 0
#endif
#ifndef REPSLOT
#define REPSLOT -1
#endif
#ifndef PREPVAR
#define PREPVAR 0
#endif
#ifndef SCANVAR
#define SCANVAR 0
#endif
#ifndef REPVAR
#define REPVAR 0
#endif
#ifndef MEGA
#define MEGA 1
#endif

typedef unsigned short u16;
using bf16x8 = __attribute__((ext_vector_type(8))) short;
using f32x4 = __attribute__((ext_vector_type(4))) float;
using v2f = __attribute__((ext_vector_type(2))) float;

#define NTOK 6144
#define NCTX 4096
#define DM 1024
#define DIN 2688
#define DFF 2816
#define NPH 39
#define ALPHA 1.681792830507429f
#define LOG2E 1.4426950408889634f
#define QSCALE (0.125f * LOG2E)

struct Params {
  const float* in[33];
  float *out_yp, *out_ys, *out_st, *out_nak, *out_nav, *out_gk, *out_gv;
  unsigned *bar, *wq;
  float *modp, *mod;
  u16 *winT, *woutT, *wfiT, *wfoT;
  float *X, *X1, *Y, *PROJ, *SC, *G, *BV, *OF, *OB;
  u16 *A, *MIX, *ACT;
  u16 *QNc, *KNc, *VNtc, *QGc, *KGc, *VGtc;
  u16 *QNl, *KNl, *VNtl, *QGl, *KGl, *VGtl;
  u16* loraT; float* rope;
  int never; int pad;
};

__device__ __forceinline__ u16 f2bf(float f) {
  unsigned u = __float_as_uint(f);
  u += 0x7FFFu + ((u >> 16) & 1u);
  return (u16)(u >> 16);
}
typedef __bf16 bf16v2 __attribute__((ext_vector_type(2)));
__device__ __forceinline__ unsigned pack2(float a, float b) {
  const bf16v2 r = __builtin_convertvector((v2f){a, b}, bf16v2);
  return __builtin_bit_cast(unsigned, r);
}
template <int CTRL> __device__ __forceinline__ float dpp_mov(float v) {
  return __int_as_float(__builtin_amdgcn_update_dpp(0, __float_as_int(v), CTRL, 0xF, 0xF, false));
}
__device__ __forceinline__ float reduce16(float v) {
  v += dpp_mov<0xB1>(v);
  v += dpp_mov<0x4E>(v);
  v += dpp_mov<0x141>(v);
  v += dpp_mov<0x140>(v);
  return v;
}
__device__ __forceinline__ float wave_sum(float v) {
  v = reduce16(v);
  v += __shfl_xor(v, 16);
  v += __shfl_xor(v, 32);
  return v;
}
__device__ __forceinline__ float tanhf_(float x) { const float e = __expf(-2.f * fabsf(x)); const float t = (1.f - e) / (1.f + e); return x < 0.f ? -t : t; }
__device__ __forceinline__ float sigmoidf_(float x) { return 1.f / (1.f + __expf(-x)); }
__device__ __forceinline__ float siluf_(float x) { return x / (1.f + __expf(-x)); }
__device__ __forceinline__ int modrow_of(int tok) { return tok < NCTX ? 0 : 1 + ((tok - NCTX) >> 10); }

#define XB_TMO      128
#define XB_XCNT(j)  (256  + 64 * (j))
#define XB_XSUB(j)  (1280 + 64 * (j))
#define XB_XGEN(j)  (2304 + 64 * (j))
#define XB_TOP      3328
#define XB_TOPGEN   3392
#define XCD_BAR_WORDS 3456
#define XB_SPIN_CAP (1u << 22)
#define LAS __attribute__((address_space(3)))
__device__ __forceinline__ unsigned xb_ld(unsigned* p) { return __hip_atomic_load(p, __ATOMIC_RELAXED, __HIP_MEMORY_SCOPE_AGENT); }
__device__ __forceinline__ unsigned xb_add(unsigned* p, unsigned v) { return __hip_atomic_fetch_add(p, v, __ATOMIC_RELAXED, __HIP_MEMORY_SCOPE_AGENT); }
__device__ __forceinline__ unsigned xb_xcc_id() { return (unsigned)__builtin_amdgcn_s_getreg((3 << 11) | 20) & 0xFu; }
#define XB_SPIN(cond, bar) do { unsigned _sp = 0; while (cond) { __builtin_amdgcn_s_sleep(1); \
    if ((++_sp & 255u) == 0u) { if (xb_ld(&(bar)[XB_TMO])) break; if (_sp > XB_SPIN_CAP) { atomicAdd(&(bar)[XB_TMO], 1u); break; } } } } while (0)
struct XcdBarrier { unsigned* bar; unsigned x; volatile LAS unsigned* st; };
__device__ __forceinline__ XcdBarrier xcd_barrier_post(unsigned* bar, volatile LAS unsigned* st) {
  XcdBarrier b; b.bar = bar; b.x = xb_xcc_id(); b.st = st;
  if (threadIdx.x == 0) (void)xb_add(&bar[XB_XCNT(b.x)], 1u);
  return b;
}
__device__ __forceinline__ void xcd_barrier_complete(unsigned* bar, unsigned x, unsigned& nloc, unsigned& nx) {
  const unsigned G = gridDim.x * gridDim.y * gridDim.z;
  unsigned sum, cnt, mine, sp = 0u;
  for (;;) {
    sum = 0u; cnt = 0u; mine = 0u;
#pragma unroll
    for (unsigned j = 0; j < 16; ++j) { const unsigned c = xb_ld(&bar[XB_XCNT(j)]); sum += c; cnt += (c > 0u) ? 1u : 0u; mine = (j == x) ? c : mine; }
    if (sum == G) break;
    __builtin_amdgcn_s_sleep(1);
    if ((++sp & 255u) == 0u) { if (xb_ld(&bar[XB_TMO])) break; if (sp > XB_SPIN_CAP) { atomicAdd(&bar[XB_TMO], 1u); break; } }
  }
  nloc = mine > 0u ? mine : 1u; nx = cnt > 0u ? cnt : 1u;
}
__device__ __forceinline__ void xcd_barrier(const XcdBarrier& b) {
  asm volatile("s_waitcnt vmcnt(0)" ::: "memory");
  __syncthreads();
  if (threadIdx.x == 0) {
    unsigned* bar = b.bar;
    asm volatile("" : "+s"(bar));
    __builtin_amdgcn_s_waitcnt(0);
    unsigned nloc = b.st[0], nx = b.st[1];
    if (nloc == 0u) { xcd_barrier_complete(bar, b.x, nloc, nx); b.st[0] = nloc; b.st[1] = nx; }
    const unsigned old = xb_add(&bar[XB_XSUB(b.x)], 1u);
    const unsigned gen = old / nloc;
    if (old + 1u == (gen + 1u) * nloc) {
      __builtin_amdgcn_fence(__ATOMIC_RELEASE, "agent");
      asm volatile("s_waitcnt vmcnt(0)" ::: "memory");
      const unsigned og = xb_add(&bar[XB_TOP], 1u);
      const unsigned tg = og / nx;
      if (og + 1u == (tg + 1u) * nx) xb_add(&bar[XB_TOPGEN], 1u);
      else XB_SPIN(xb_ld(&bar[XB_TOPGEN]) == tg, bar);
      __builtin_amdgcn_fence(__ATOMIC_ACQUIRE, "agent");
      xb_add(&bar[XB_XGEN(b.x)], 1u);
      asm volatile("s_waitcnt vmcnt(0)" ::: "memory");
    } else {
      XB_SPIN(xb_ld(&bar[XB_XGEN(b.x)]) == gen, bar);
      __builtin_amdgcn_fence(__ATOMIC_ACQUIRE, "agent");
      asm volatile("s_waitcnt vmcnt(0)" ::: "memory");
    }
  }
  __syncthreads();
}

__device__ __forceinline__ int lds_byte32(int r, int c) {
  const int ob = (r & 15) * 64 + c * 2;
  return (r >> 4) * 1024 + (ob ^ (((ob >> 9) & 1) << 5));
}
__device__ __forceinline__ void stage_rc32(int b, int& R, int& C) {
  const int sb = b & 1023, swz = sb ^ (((sb >> 9) & 1) << 5);
  R = (b >> 10) * 16 + (swz >> 6); C = (swz & 63) >> 1;
}
template <int ROWS>
__device__ __forceinline__ void stage_tile32(const u16* __restrict__ g, int ld, char* lds, int tidx) {
#pragma unroll
  for (int i = 0; i < (ROWS * 64 + 4095) / 4096; ++i) {
    const int b = tidx * 16 + i * 4096;
    if ((i + 1) * 4096 <= ROWS * 64 || tidx < (ROWS * 64 - i * 4096) / 16) {
      int R, C; stage_rc32(b, R, C);
      __builtin_amdgcn_global_load_lds((const unsigned*)(g + (size_t)R * ld + C), (unsigned LAS*)(lds + b), 16, 0, 0);
    }
  }
}
template <int N> __device__ __forceinline__ void wait_vmcnt() {
  if (N == 0) asm volatile("s_waitcnt vmcnt(0)" ::: "memory");
  else if (N == 3) asm volatile("s_waitcnt vmcnt(3)" ::: "memory");
  else if (N == 4) asm volatile("s_waitcnt vmcnt(4)" ::: "memory");
  else if (N == 5) asm volatile("s_waitcnt vmcnt(5)" ::: "memory");
  else if (N == 6) asm volatile("s_waitcnt vmcnt(6)" ::: "memory");
  else if (N == 8) asm volatile("s_waitcnt vmcnt(8)" ::: "memory");
  else if (N == 9) asm volatile("s_waitcnt vmcnt(9)" ::: "memory");
  else if (N == 10) asm volatile("s_waitcnt vmcnt(10)" ::: "memory");
  else if (N == 12) asm volatile("s_waitcnt vmcnt(12)" ::: "memory");
  else asm volatile("s_waitcnt vmcnt(0)" ::: "memory");
}

enum { EPI_PROJ = 0, EPI_OUT = 1, EPI_FFI = 2, EPI_FFO = 3 };

template <int EPI, int BM, int NST>
__device__ __forceinline__ void gemm_phase(const Params& p, int layer, const u16* __restrict__ A, const u16* __restrict__ Bt,
                                           int N, int K, char* smem, int bid, int nblk, int tidx) {
  constexpr int MF = BM / 32;
  const int tid = tidx, lane = tid & 63, wid = tid >> 6, wr = wid >> 1, wc = wid & 1, fr = lane & 15, fq = lane >> 4;
  const int nM = NTOK / BM, nN = N / 128, ntiles = nM * nN, nk = K / 32;
  constexpr int SB = (BM + 128) * 64;
  constexpr int LA = (BM * 64) / 4096;
  const bool extraA = (BM == 96) && (wid < 2);
  for (int tile = bid; tile < ntiles; tile += nblk) {
    const int pm = tile % nM, pn = tile / nM, m0 = pm * BM, n0 = pn * 128;
    f32x4 acc[MF][4];
#pragma unroll
    for (int m = 0; m < MF; ++m)
#pragma unroll
      for (int n = 0; n < 4; ++n) acc[m][n] = (f32x4){0.f, 0.f, 0.f, 0.f};
    const u16* Ag = A + (size_t)m0 * K;
    const u16* Bg = Bt + (size_t)n0 * K;
#pragma unroll
    for (int s_ = 0; s_ < NST - 1; ++s_) {
      stage_tile32<BM>(Ag + s_ * 32, K, smem + s_ * SB, tidx);
      stage_tile32<128>(Bg + s_ * 32, K, smem + s_ * SB + BM * 64, tidx);
    }
    int slot = 0, pslot = NST - 1;
    for (int kt = 0; kt < nk; ++kt) {
      if (kt + NST - 2 < nk) {
        if (BM == 96) { if (extraA) wait_vmcnt<(NST - 2) * 4>(); else wait_vmcnt<(NST - 2) * 3>(); }
        else wait_vmcnt<(NST - 2) * (LA + 2)>();
      } else {
        asm volatile("s_waitcnt vmcnt(0)" ::: "memory");
      }
      __builtin_amdgcn_s_barrier();
      if (kt + NST - 1 < nk) {
        char* nb = smem + pslot * SB;
        stage_tile32<BM>(Ag + (kt + NST - 1) * 32, K, nb, tidx);
        stage_tile32<128>(Bg + (kt + NST - 1) * 32, K, nb + BM * 64, tidx);
      }
      const char* sa = smem + slot * SB;
      const char* sb = sa + BM * 64;
      slot = (slot + 1 == NST) ? 0 : slot + 1;
      pslot = (pslot + 1 == NST) ? 0 : pslot + 1;
      bf16x8 af[MF], bfr[4];
#pragma unroll
      for (int m = 0; m < MF; ++m) af[m] = *reinterpret_cast<const bf16x8*>(sa + lds_byte32(wr * (BM / 2) + m * 16 + fr, fq * 8));
#pragma unroll
      for (int n = 0; n < 4; ++n) bfr[n] = *reinterpret_cast<const bf16x8*>(sb + lds_byte32(wc * 64 + n * 16 + fr, fq * 8));
#pragma unroll
      for (int m = 0; m < MF; ++m)
#pragma unroll
        for (int n = 0; n < 4; ++n) acc[m][n] = __builtin_amdgcn_mfma_f32_16x16x32_bf16(bfr[n], af[m], acc[m][n], 0, 0, 0);
    }
#pragma unroll
    for (int m = 0; m < MF; ++m) {
      const int row = m0 + wr * (BM / 2) + m * 16 + fr;
      if (EPI == EPI_PROJ) {
#pragma unroll
        for (int n = 0; n < 4; ++n) {
          const int col = n0 + wc * 64 + n * 16 + 4 * fq;
          *reinterpret_cast<float4*>(p.PROJ + (size_t)row * DIN + col) = make_float4(acc[m][n][0], acc[m][n][1], acc[m][n][2], acc[m][n][3]);
        }
      } else if (EPI == EPI_OUT || EPI == EPI_FFO) {
        const float* res = (EPI == EPI_OUT) ? p.X : p.X1;
        const float* gate = p.mod + ((size_t)(layer * 3 + modrow_of(row)) * 6 + (EPI == EPI_OUT ? 2 : 5)) * 1024;
#pragma unroll
        for (int n = 0; n < 4; ++n) {
          const int col = n0 + wc * 64 + n * 16 + 4 * fq;
          const float4 xr = *reinterpret_cast<const float4*>(res + (size_t)row * DM + col);
          const float4 gt = *reinterpret_cast<const float4*>(gate + col);
          float4 y;
          y.x = ALPHA * xr.x + gt.x * acc[m][n][0];
          y.y = ALPHA * xr.y + gt.y * acc[m][n][1];
          y.z = ALPHA * xr.z + gt.z * acc[m][n][2];
          y.w = ALPHA * xr.w + gt.w * acc[m][n][3];
          *reinterpret_cast<float4*>(p.Y + (size_t)row * DM + col) = y;
        }
      } else {
#pragma unroll
        for (int n2 = 0; n2 < 2; ++n2) {
          const int j0 = ((n0 + wc * 64) / 32 + n2) * 16 + 4 * fq;
          float a[4];
#pragma unroll
          for (int r = 0; r < 4; ++r) a[r] = siluf_(acc[m][2 * n2][r]) * acc[m][2 * n2 + 1][r];
          uint2 pk; pk.x = pack2(a[0], a[1]); pk.y = pack2(a[2], a[3]);
          *reinterpret_cast<uint2*>(p.ACT + (size_t)row * DFF + j0) = pk;
        }
      }
    }
    asm volatile("s_waitcnt lgkmcnt(0)" ::: "memory");
    __builtin_amdgcn_s_barrier();
  }
}

__device__ __forceinline__ int kf_off(int t, int d) { return (t >> 4) * 1024 + (d >> 5) * 512 + ((d & 31) >> 3) * 128 + (t & 15) * 8 + (d & 7); }
__device__ __forceinline__ int vf_off(int t, int d) { return (t >> 5) * 2048 + (d >> 4) * 512 + (((t & 15) >> 2) * 16 + (d & 15)) * 8 + ((t >> 4) & 1) * 4 + (t & 3); }
__device__ __forceinline__ void pack44_store(u16* base, int t0, int d, const float* v) {
  uint2 a, b; a.x = pack2(v[0], v[1]); a.y = pack2(v[2], v[3]); b.x = pack2(v[4], v[5]); b.y = pack2(v[6], v[7]);
  *reinterpret_cast<uint2*>(base + vf_off(t0, d)) = a;
  *reinterpret_cast<uint2*>(base + vf_off(t0 + 4, d)) = b;
}
__device__ __forceinline__ void pack8_store(u16* dst, const float* v) {
  uint4 pk; pk.x = pack2(v[0], v[1]); pk.y = pack2(v[2], v[3]); pk.z = pack2(v[4], v[5]); pk.w = pack2(v[6], v[7]);
  *reinterpret_cast<uint4*>(dst) = pk;
}

__device__ void setup_phase(const Params& p, char* smem, int bid, int nblk, int tidx, int mod_lo, int mod_hi, bool rest) {
  const int tid = tidx;
  const int nm = mod_hi - mod_lo;
  const int NV = nm + (rest ? 512 + 13 : 0);
  for (int v_ = bid; v_ < NV; v_ += nblk) {
    const int it = v_ < nm ? mod_lo + v_ : 768 + (v_ - nm);
    if (it < 768) {
      const int l = it / 192, nc = (it / 32) % 6, kc = it % 32;
      const int col = nc * 1024 + tid * 4;
      const float* wm = p.in[9] + (size_t)l * 1024 * 6144;
      float4 a0 = make_float4(0, 0, 0, 0), a1 = a0, a2 = a0;
      for (int k8 = 0; k8 < 32; k8 += 8) {
        float4 w[8];
#pragma unroll
        for (int u = 0; u < 8; ++u) w[u] = *reinterpret_cast<const float4*>(wm + (size_t)(kc * 32 + k8 + u) * 6144 + col);
#pragma unroll
        for (int u = 0; u < 8; ++u) {
          const int k = kc * 32 + k8 + u;
          const float s0 = siluf_(p.in[8][k]), s1 = siluf_(p.in[7][k]), s2 = siluf_(p.in[7][1024 + k]);
          a0.x += s0 * w[u].x; a0.y += s0 * w[u].y; a0.z += s0 * w[u].z; a0.w += s0 * w[u].w;
          a1.x += s1 * w[u].x; a1.y += s1 * w[u].y; a1.z += s1 * w[u].z; a1.w += s1 * w[u].w;
          a2.x += s2 * w[u].x; a2.y += s2 * w[u].y; a2.z += s2 * w[u].z; a2.w += s2 * w[u].w;
        }
      }
      float* dst = p.modp + (size_t)((l * 32 + kc) * 3) * 6144 + col;
      *reinterpret_cast<float4*>(dst) = a0;
      *reinterpret_cast<float4*>(dst + 6144) = a1;
      *reinterpret_cast<float4*>(dst + 2 * 6144) = a2;
    } else if (it < 1280) {
      const int ci = it - 768, b = ci / 256, l = (ci / 64) % 4, tg = ci % 64, t0 = tg * 8;
      {
        const float* ck = p.in[3] + ((size_t)(b * 4 + l) * 512 + t0) * 256 + tid;
        const float* cv = p.in[4] + ((size_t)(b * 4 + l) * 512 + t0) * 256 + tid;
        float v[8];
#pragma unroll
        for (int tt = 0; tt < 8; ++tt) {
          p.KNl[((size_t)((l * 2 + b) * 4 + (tid >> 6))) * 98304 + kf_off(t0 + tt, tid & 63)] = f2bf(ck[tt * 256]);
          v[tt] = cv[tt * 256];
        }
        pack44_store(p.VNtl + ((size_t)((l * 2 + b) * 4 + (tid >> 6))) * 98304, t0, tid & 63, v);
      }
      if (tid < 128) {
        const float* ck = p.in[5] + ((size_t)(b * 4 + l) * 512 + t0) * 128 + tid;
#pragma unroll
        for (int tt = 0; tt < 8; ++tt) p.KGl[((size_t)((l * 2 + b) * 2 + (tid >> 6))) * 98304 + kf_off(t0 + tt, tid & 63)] = f2bf(ck[tt * 128]);
      } else {
        const int c = tid - 128;
        const float* cv = p.in[6] + ((size_t)(b * 4 + l) * 512 + t0) * 128 + c;
        float v[8];
#pragma unroll
        for (int tt = 0; tt < 8; ++tt) v[tt] = cv[tt * 128];
        pack44_store(p.VGtl + ((size_t)((l * 2 + b) * 2 + (c >> 6))) * 98304, t0, c & 63, v);
      }
    } else {
      const int li = it - (768 + 512);
      if (li == 12) {
        for (int idx = tid; idx < 1024; idx += 256) {
          const int pos = idx >> 4, fi = idx & 15;
          const float ang = (float)pos * exp2f(-(float)fi * (13.287712379549449f / 16.f));
          p.rope[idx * 2] = cosf(ang); p.rope[idx * 2 + 1] = sinf(ang);
        }
      } else {
        const int l = li / 3, m = li % 3;
        u16* dst = p.loraT + (size_t)l * 98304 + m * 32768;
        if (m < 2) {
          const float* src = p.in[m == 0 ? 14 : 16] + (size_t)l * 32768;
          for (int i0 = tid; i0 < 32768; i0 += 256 * 16) {
            float v[16];
#pragma unroll
            for (int u = 0; u < 16; ++u) { const int idx = i0 + 256 * u; const int d = idx >> 14, cch = (idx >> 6) & 255, r = idx & 63; v[u] = src[(d * 64 + r) * 256 + cch]; }
#pragma unroll
            for (int u = 0; u < 16; ++u) dst[i0 + 256 * u] = f2bf(v[u]);
          }
        } else {
          const float* src = p.in[17] + (size_t)l * 32768;
          for (int i0 = tid; i0 < 32768; i0 += 256 * 16) {
            float v[16];
#pragma unroll
            for (int u = 0; u < 16; ++u) { const int idx = i0 + 256 * u; const int cch = idx >> 7, j = idx & 127; v[u] = src[j * 256 + cch]; }
#pragma unroll
            for (int u = 0; u < 16; ++u) dst[i0 + 256 * u] = f2bf(v[u]);
          }
        }
      }
    }
  }
}

__device__ void weight_convert(const Params& p, char* smem, int tid, int w, int nw, int tr_begin, int NT) {
    float* tile = reinterpret_cast<float*>(smem);
    float4 cur0, cur1, cur2, cur3;
    const float* src; u16* dst; int K, N, mat, k0, n0;
#define TR_DECODE(TR) { const int l_ = (TR) / 3040; int r_ = (TR) % 3040; int kt_, nt_; \
      if (r_ < 672) { mat = 0; K = 1024; N = 2688; src = p.in[11] + (size_t)l_ * K * N; dst = p.winT + (size_t)l_ * N * K; kt_ = r_ / 42; nt_ = r_ % 42; } \
      else if (r_ < 928) { r_ -= 672; mat = 1; K = 1024; N = 1024; src = p.in[26] + (size_t)l_ * K * N; dst = p.woutT + (size_t)l_ * N * K; kt_ = r_ / 16; nt_ = r_ % 16; } \
      else if (r_ < 2336) { r_ -= 928; mat = 2; K = 1024; N = 5632; src = p.in[29] + (size_t)l_ * K * N; dst = p.wfiT + (size_t)l_ * N * K; kt_ = r_ / 88; nt_ = r_ % 88; } \
      else { r_ -= 2336; mat = 3; K = 2816; N = 1024; src = p.in[30] + (size_t)l_ * K * N; dst = p.wfoT + (size_t)l_ * N * K; kt_ = r_ / 16; nt_ = r_ % 16; } \
      k0 = kt_ * 64; n0 = nt_ * 64; }
#define TR_LOAD(V, I) V = *reinterpret_cast<const float4*>(src + (size_t)(k0 + (tid >> 4) + 16 * (I)) * N + n0 + (tid & 15) * 4);
#define TR_PUT(V, I) { const int kr_ = (tid >> 4) + 16 * (I), c4_ = (tid & 15) * 4; \
      tile[kr_ * 65 + c4_ + 0] = V.x; tile[kr_ * 65 + c4_ + 1] = V.y; tile[kr_ * 65 + c4_ + 2] = V.z; tile[kr_ * 65 + c4_ + 3] = V.w; }
    int tr = tr_begin + w;
    if (tr < NT) { TR_DECODE(tr) TR_LOAD(cur0, 0) TR_LOAD(cur1, 1) TR_LOAD(cur2, 2) TR_LOAD(cur3, 3) }
    for (; tr < NT; tr += nw) {
      TR_PUT(cur0, 0) TR_PUT(cur1, 1) TR_PUT(cur2, 2) TR_PUT(cur3, 3)
      if (tr + nw < NT) { TR_DECODE(tr + nw) TR_LOAD(cur0, 0) TR_LOAD(cur1, 1) TR_LOAD(cur2, 2) TR_LOAD(cur3, 3) }
      TR_DECODE(tr)
      __syncthreads();
#pragma unroll
      for (int i = 0; i < 2; ++i) {
        const int idx = tid + 256 * i, nl = idx >> 3, kc = idx & 7;
        int n = n0 + nl;
        if (mat == 2) { const int isup = n >= DFF ? 1 : 0; const int j = n - isup * DFF; n = (j >> 4) * 32 + isup * 16 + (j & 15); }
        float v[8];
#pragma unroll
        for (int jj = 0; jj < 8; ++jj) v[jj] = tile[(kc * 8 + jj) * 65 + nl];
        pack8_store(dst + (size_t)n * K + k0 + kc * 8, v);
      }
      __syncthreads();
    }
#undef TR_DECODE
#undef TR_LOAD
#undef TR_PUT
}

__device__ void modreduce_phase(const Params& p, int bid, int nblk, int tidx, int idx_lo, int idx_hi) {
  for (int idx = idx_lo + bid * 256 + tidx; idx < idx_hi; idx += nblk * 256) {
    const int l = idx / 4608, rem = idx % 4608, mr = rem / 1536, c4 = (rem % 1536) * 4;
    float4 a = *reinterpret_cast<const float4*>(p.in[10] + (size_t)l * 6144 + c4);
    for (int k8 = 0; k8 < 32; k8 += 8) {
      float4 v[8];
#pragma unroll
      for (int u = 0; u < 8; ++u) v[u] = *reinterpret_cast<const float4*>(p.modp + (size_t)((l * 32 + k8 + u) * 3 + mr) * 6144 + c4);
#pragma unroll
      for (int u = 0; u < 8; ++u) { a.x += v[u].x; a.y += v[u].y; a.z += v[u].z; a.w += v[u].w; }
    }
    *reinterpret_cast<float4*>(p.mod + (size_t)(l * 3 + mr) * 6144 + c4) = a;
  }
}

template <int MODE>
__device__ void ln_phase(const Params& p, int layer, int bid, int nblk, int tidx) {
  const int lane = tidx & 63, wid = tidx >> 6;
  const bool fin = (MODE == 2 && layer == 3);
  const float* lw = (MODE == 1 ? p.in[27] : p.in[31]) + (size_t)layer * DM;
  const float* lb = (MODE == 1 ? p.in[28] : p.in[32]) + (size_t)layer * DM;
  const int ml = (MODE == 2) ? (layer + 1 < 4 ? layer + 1 : 3) : layer;
  const int which = (MODE == 1) ? 3 : 0;
#define LN_SRC(ROW) (MODE == 0 ? ((ROW) < NCTX ? p.in[0] + (size_t)(ROW) * DM : p.in[1] + (size_t)((ROW) - NCTX) * DM) : p.Y + (size_t)(ROW) * DM)
  float4 nv0, nv1, nv2, nv3;
  int it = bid;
  if (it < NTOK / 4) {
    const float4* s4 = reinterpret_cast<const float4*>(LN_SRC(it * 4 + wid));
    nv0 = s4[lane]; nv1 = s4[lane + 64]; nv2 = s4[lane + 128]; nv3 = s4[lane + 192];
  }
  for (; it < NTOK / 4; it += nblk) {
    const int row = it * 4 + wid;
    float4 v[4] = {nv0, nv1, nv2, nv3};
    if (it + nblk < NTOK / 4) {
      const float4* s4 = reinterpret_cast<const float4*>(LN_SRC((it + nblk) * 4 + wid));
      nv0 = s4[lane]; nv1 = s4[lane + 64]; nv2 = s4[lane + 128]; nv3 = s4[lane + 192];
    }
    float4 w4[4], b4[4], s4v[4], c4v[4];
    const float* sh = p.mod + ((size_t)(ml * 3 + modrow_of(row)) * 6 + which) * 1024;
    const float* sc = sh + 1024;
#pragma unroll
    for (int i = 0; i < 4; ++i) {
      if (MODE != 0) { w4[i] = reinterpret_cast<const float4*>(lw)[lane + 64 * i]; b4[i] = reinterpret_cast<const float4*>(lb)[lane + 64 * i]; }
      if (!fin) { s4v[i] = reinterpret_cast<const float4*>(sh)[lane + 64 * i]; c4v[i] = reinterpret_cast<const float4*>(sc)[lane + 64 * i]; }
    }
    if (MODE != 0) {
      float s = 0.f;
#pragma unroll
      for (int i = 0; i < 4; ++i) s += v[i].x + v[i].y + v[i].z + v[i].w;
      const float mu = wave_sum(s) * (1.f / 1024.f);
      float q = 0.f;
#pragma unroll
      for (int i = 0; i < 4; ++i) {
        v[i].x -= mu; v[i].y -= mu; v[i].z -= mu; v[i].w -= mu;
        q += v[i].x * v[i].x + v[i].y * v[i].y + v[i].z * v[i].z + v[i].w * v[i].w;
      }
      const float rstd = rsqrtf(wave_sum(q) * (1.f / 1024.f) + 1e-5f);
#pragma unroll
      for (int i = 0; i < 4; ++i) {
        v[i].x = v[i].x * rstd * w4[i].x + b4[i].x; v[i].y = v[i].y * rstd * w4[i].y + b4[i].y;
        v[i].z = v[i].z * rstd * w4[i].z + b4[i].z; v[i].w = v[i].w * rstd * w4[i].w + b4[i].w;
      }
    }
    float* xdst = (MODE == 1 ? p.X1 : p.X) + (size_t)row * DM;
#pragma unroll
    for (int i = 0; i < 4; ++i) reinterpret_cast<float4*>(xdst)[lane + 64 * i] = v[i];
    if (fin) {
      float* o = row < NCTX ? p.out_yp + (size_t)row * DM : p.out_ys + (size_t)(row - NCTX) * DM;
#pragma unroll
      for (int i = 0; i < 4; ++i) reinterpret_cast<float4*>(o)[lane + 64 * i] = v[i];
    } else {
      u16* adst = p.A + (size_t)row * DM;
#pragma unroll
      for (int i = 0; i < 4; ++i) {
        uint2 pk;
        pk.x = pack2(v[i].x * (1.f + c4v[i].x) + s4v[i].x, v[i].y * (1.f + c4v[i].y) + s4v[i].y);
        pk.y = pack2(v[i].z * (1.f + c4v[i].z) + s4v[i].z, v[i].w * (1.f + c4v[i].w) + s4v[i].w);
        reinterpret_cast<uint2*>(adst)[lane + 64 * i] = pk;
      }
    }
  }
#undef LN_SRC
}

#define FLD 772
#define LLD 392
__device__ void prep_phase(const Params& p, int layer, char* smem, int bid, int nblk, int tidx, int rep) {
  const int pv_ = rep ? PREPVAR : 0;
  float* F = reinterpret_cast<float*>(smem);
  u16* LIb = reinterpret_cast<u16*>(smem + 16 * FLD * 4);
  const float* cw = p.in[12] + (size_t)layer * 3 * 1152;
  const u16* LW = p.loraT + (size_t)layer * 98304;
  for (int it2 = bid; it2 < 2 * (NTOK / 16); it2 += nblk) {
    const bool doR = it2 < NTOK / 16;
    const int it = doR ? it2 : it2 - NTOK / 16;
    int tid = tidx;
    asm volatile("" : "+v"(tid));
    const int lane = tid & 63, wid = tid >> 6, fr = lane & 15, fq = lane >> 4;
    const int tok0 = it * 16;
    int b, tpos0, L;
    const bool isctx = tok0 < NCTX;
    if (isctx) { b = tok0 >> 8; tpos0 = tok0 & 255; L = 256; }
    else { const int tl = tok0 - NCTX; b = tl >> 10; tpos0 = tl & 1023; L = 1024; }
    if (doR) {
    {
      float* PRM = reinterpret_cast<float*>(smem + 61952);
      PRM[tid] = p.in[13][(size_t)layer * 512 + tid]; PRM[256 + tid] = p.in[13][(size_t)layer * 512 + 256 + tid];
      PRM[512 + tid] = p.in[15][(size_t)layer * 512 + tid]; PRM[768 + tid] = p.in[15][(size_t)layer * 512 + 256 + tid];
      PRM[1024 + tid] = p.in[18][(size_t)layer * 256 + tid]; PRM[1280 + tid] = p.in[19][(size_t)layer * 256 + tid]; PRM[1536 + tid] = p.in[20][(size_t)layer * 256 + tid];
    }
#pragma unroll 1
    for (int cg = tid; cg < 288; cg += 256) {
      const int c = cg * 4;
      const float4 w0 = *reinterpret_cast<const float4*>(cw + c);
      const float4 w1 = *reinterpret_cast<const float4*>(cw + 1152 + c);
      const float4 w2 = *reinterpret_cast<const float4*>(cw + 2304 + c);
      const float* pr = p.PROJ + (size_t)tok0 * DIN + c;
      float4 x[18];
#pragma unroll
      for (int i = 0; i < 18; ++i) {
        const int tpos = tpos0 + i - 1;
        x[i] = (tpos >= 0 && tpos < L) ? *reinterpret_cast<const float4*>(pr + (ptrdiff_t)(i - 1) * DIN) : make_float4(0.f, 0.f, 0.f, 0.f);
      }
#pragma unroll
      for (int tt = 0; tt < 16; ++tt) {
        float4 f;
        f.x = w0.x * x[tt].x + w1.x * x[tt + 1].x + w2.x * x[tt + 2].x;
        f.y = w0.y * x[tt].y + w1.y * x[tt + 1].y + w2.y * x[tt + 2].y;
        f.z = w0.z * x[tt].z + w1.z * x[tt + 1].z + w2.z * x[tt + 2].z;
        f.w = w0.w * x[tt].w + w1.w * x[tt + 1].w + w2.w * x[tt + 2].w;
        if (c < 768) { *reinterpret_cast<float4*>(F + tt * FLD + c) = f; }
        else {
          const int cc = c - 768;
          if (cc < 128) { f.x = tanhf_(f.x); f.y = tanhf_(f.y); f.z = tanhf_(f.z); f.w = tanhf_(f.w); }
          else if (cc >= 256) { f.x = sigmoidf_(f.x); f.y = sigmoidf_(f.y); f.z = sigmoidf_(f.z); f.w = sigmoidf_(f.w); }
          uint2 pk; pk.x = pack2(f.x, f.y); pk.y = pack2(f.z, f.w);
          *reinterpret_cast<uint2*>(LIb + tt * LLD + cc) = pk;
        }
      }
    }
    __syncthreads();
    f32x4 acc[5][4];
#pragma unroll
    for (int g = 0; g < 5; ++g)
#pragma unroll
      for (int nf = 0; nf < 4; ++nf) acc[g][nf] = (f32x4){0.f, 0.f, 0.f, 0.f};
    if (pv_ != 2 && pv_ != 3) {
#define PB_LOAD(W, GI) { const u16* wt_ = (GI) < 4 ? LW + (size_t)(GI) * 16384 : LW + 65536; const int rs_ = (GI) < 4 ? 64 : 128; const int ko_ = (GI) < 4 ? 0 : ((GI) - 4) * 64; \
      _Pragma("unroll") for (int ks_ = 0; ks_ < 2; ++ks_) _Pragma("unroll") for (int nf_ = 0; nf_ < 4; ++nf_) \
        W[ks_ * 4 + nf_] = *reinterpret_cast<const bf16x8*>(wt_ + (size_t)(64 * wid + 16 * nf_ + fr) * rs_ + ko_ + ks_ * 32 + fq * 8); }
#define PB_MMA(W, GI) { const int ai_ = (GI) < 4 ? (GI) : 4; const int xo_ = (GI) < 4 ? (GI) * 64 : 256 + ((GI) - 4) * 64; \
      _Pragma("unroll") for (int ks_ = 0; ks_ < 2; ++ks_) { \
        const bf16x8 xb_ = *reinterpret_cast<const bf16x8*>(LIb + fr * LLD + xo_ + ks_ * 32 + fq * 8); \
        _Pragma("unroll") for (int nf_ = 0; nf_ < 4; ++nf_) acc[ai_][nf_] = __builtin_amdgcn_mfma_f32_16x16x32_bf16(W[ks_ * 4 + nf_], xb_, acc[ai_][nf_], 0, 0, 0); } \
      __builtin_amdgcn_sched_barrier(0); }
    {
      bf16x8 wA[8], wB[8];
      PB_LOAD(wA, 0)
      PB_LOAD(wB, 1) PB_MMA(wA, 0)
      PB_LOAD(wA, 2) PB_MMA(wB, 1)
      PB_LOAD(wB, 3) PB_MMA(wA, 2)
      PB_LOAD(wA, 4) PB_MMA(wB, 3)
      PB_LOAD(wB, 5) PB_MMA(wA, 4)
      PB_MMA(wB, 5)
    }
#undef PB_LOAD
#undef PB_MMA
    }
    if (pv_ != 2 && pv_ != 3) {
#ifndef NO_C
    const float* PRM = reinterpret_cast<const float*>(smem + 61952);
    {
      const int tok = tok0 + fr;
      float ss = 0.f, bs = 0.f;
#pragma unroll
      for (int nf = 0; nf < 4; ++nf) {
        const int c0 = 64 * wid + 16 * nf + 4 * fq;
        const float4 r4 = *reinterpret_cast<const float4*>(F + fr * FLD + c0);
        const float4 k4 = *reinterpret_cast<const float4*>(F + fr * FLD + 256 + c0);
        const float4 w00 = *reinterpret_cast<const float4*>(PRM + c0);
        const float4 w01 = *reinterpret_cast<const float4*>(PRM + 256 + c0);
        const float4 a00 = *reinterpret_cast<const float4*>(PRM + 512 + c0);
        const float4 a01 = *reinterpret_cast<const float4*>(PRM + 768 + c0);
        const float4 kkw = *reinterpret_cast<const float4*>(PRM + 1024 + c0);
        const float4 kaw = *reinterpret_cast<const float4*>(PRM + 1280 + c0);
        const float4 rkw = *reinterpret_cast<const float4*>(PRM + 1536 + c0);
        const float rr[4] = {r4.x, r4.y, r4.z, r4.w}, kk_[4] = {k4.x, k4.y, k4.z, k4.w};
        const float w0a[4] = {w00.x, w00.y, w00.z, w00.w}, w0b[4] = {w01.x, w01.y, w01.z, w01.w};
        const float a0a[4] = {a00.x, a00.y, a00.z, a00.w}, a0b[4] = {a01.x, a01.y, a01.z, a01.w};
        const float kkw_[4] = {kkw.x, kkw.y, kkw.z, kkw.w}, kaw_[4] = {kaw.x, kaw.y, kaw.z, kaw.w}, rkw_[4] = {rkw.x, rkw.y, rkw.z, rkw.w};
#pragma unroll
        for (int r = 0; r < 4; ++r) {
          {
            const float z = -(w0a[r] + acc[0][nf][r]);
            const float sp = fmaxf(z, 0.f) + __logf(1.f + __expf(-fabsf(z)));
            acc[0][nf][r] = __expf(-__expf(-sp - 0.5f));
          }
          {
            const float z = -(w0b[r] + acc[1][nf][r]);
            const float sp = fmaxf(z, 0.f) + __logf(1.f + __expf(-fabsf(z)));
            acc[1][nf][r] = __expf(-__expf(-sp - 0.5f));
          }
          const float av0 = sigmoidf_(a0a[r] + acc[2][nf][r]);
          const float av1 = sigmoidf_(a0b[r] + acc[3][nf][r]);
          acc[2][nf][r] = av0; acc[3][nf][r] = av1;
          const float k = kk_[r];
          const float kq = k * kkw_[r];
          ss += kq * kq;
          const float kd0 = k * (1.f + (av0 - 1.f) * kaw_[r]);
          const float kd1 = k * (1.f + (av1 - 1.f) * kaw_[r]);
          bs += rr[r] * (kd0 + kd1) * rkw_[r];
        }
        __builtin_amdgcn_sched_barrier(0);
      }
      ss += __shfl_xor(ss, 16); ss += __shfl_xor(ss, 32);
      bs += __shfl_xor(bs, 16); bs += __shfl_xor(bs, 32);
      const float inrm = 1.f / fmaxf(sqrtf(ss), 1e-12f);
#pragma unroll
      for (int nf = 0; nf < 4; ++nf) {
        const int c0 = 64 * wid + 16 * nf + 4 * fq, n0 = 16 * nf + 4 * fq;
        const float4 r4 = *reinterpret_cast<const float4*>(F + fr * FLD + c0);
        const float4 k4 = *reinterpret_cast<const float4*>(F + fr * FLD + 256 + c0);
        const float4 v4 = *reinterpret_cast<const float4*>(F + fr * FLD + 512 + c0);
        const float4 kkw = *reinterpret_cast<const float4*>(PRM + 1024 + c0);
        const float4 kaw = *reinterpret_cast<const float4*>(PRM + 1280 + c0);
        const float kk_[4] = {k4.x, k4.y, k4.z, k4.w}, kkw_[4] = {kkw.x, kkw.y, kkw.z, kkw.w}, kaw_[4] = {kaw.x, kaw.y, kaw.z, kaw.w};
        float* sc = p.SC + ((size_t)(tok * 4 + wid) * 9) * 64 + n0;
        float kn[4], kd0[4], kd1[4];
#pragma unroll
        for (int r = 0; r < 4; ++r) {
          kn[r] = kk_[r] * kkw_[r] * inrm;
          kd0[r] = kk_[r] * (1.f + (acc[2][nf][r] - 1.f) * kaw_[r]);
          kd1[r] = kk_[r] * (1.f + (acc[3][nf][r] - 1.f) * kaw_[r]);
        }
        *reinterpret_cast<float4*>(sc) = r4;
        *reinterpret_cast<float4*>(sc + 64) = make_float4(kn[0], kn[1], kn[2], kn[3]);
        *reinterpret_cast<float4*>(sc + 128) = v4;
        *reinterpret_cast<float4*>(sc + 192) = make_float4(acc[0][nf][0], acc[0][nf][1], acc[0][nf][2], acc[0][nf][3]);
        *reinterpret_cast<float4*>(sc + 256) = make_float4(acc[2][nf][0] * kn[0], acc[2][nf][1] * kn[1], acc[2][nf][2] * kn[2], acc[2][nf][3] * kn[3]);
        *reinterpret_cast<float4*>(sc + 320) = make_float4(kd0[0], kd0[1], kd0[2], kd0[3]);
        *reinterpret_cast<float4*>(sc + 384) = make_float4(acc[1][nf][0], acc[1][nf][1], acc[1][nf][2], acc[1][nf][3]);
        *reinterpret_cast<float4*>(sc + 448) = make_float4(acc[3][nf][0] * kn[0], acc[3][nf][1] * kn[1], acc[3][nf][2] * kn[2], acc[3][nf][3] * kn[3]);
        *reinterpret_cast<float4*>(sc + 512) = make_float4(kd1[0], kd1[1], kd1[2], kd1[3]);
        *reinterpret_cast<float4*>(p.G + (size_t)tok * 256 + c0) = make_float4(acc[4][nf][0], acc[4][nf][1], acc[4][nf][2], acc[4][nf][3]);
        *reinterpret_cast<float4*>(p.BV + (size_t)tok * 256 + c0) = make_float4(bs * v4.x, bs * v4.y, bs * v4.z, bs * v4.w);
        __builtin_amdgcn_sched_barrier(0);
      }
    }
#endif
    }
    }
    if (!doR && pv_ != 1) {
#ifndef NO_D
    {
      const int tok = tid >> 4, g8 = tid & 15, tokg = tok0 + tok, tpos = tpos0 + tok;
      const int tkey = isctx ? tpos : 512 + tpos;
      const float* pr = p.PROJ + (size_t)tokg * DIN;
#pragma unroll
      for (int hh = 0; hh < 2; ++hh) {
        const int g = g8 + 16 * hh, c0 = g * 8, hd = c0 >> 6, d0 = c0 & 63;
        const float4 qa = *reinterpret_cast<const float4*>(pr + 1152 + c0), qb = *reinterpret_cast<const float4*>(pr + 1152 + c0 + 4);
        const float4 ka = *reinterpret_cast<const float4*>(pr + 1408 + c0), kb2 = *reinterpret_cast<const float4*>(pr + 1408 + c0 + 4);
        const float qv[8] = {qa.x * QSCALE, qa.y * QSCALE, qa.z * QSCALE, qa.w * QSCALE, qb.x * QSCALE, qb.y * QSCALE, qb.z * QSCALE, qb.w * QSCALE};
        const float kv[8] = {ka.x, ka.y, ka.z, ka.w, kb2.x, kb2.y, kb2.z, kb2.w};
        if (isctx) {
          float* ok = p.out_nak + ((size_t)(b * 4 + layer) * 256 + tpos) * 256 + c0;
          *reinterpret_cast<float4*>(ok) = ka; *reinterpret_cast<float4*>(ok + 4) = kb2;
          pack8_store(p.QNc + (size_t)tokg * 256 + c0, qv);
          pack8_store(p.KNc + (size_t)(b * 4 + hd) * 16384 + kf_off(tkey, d0), kv);
        } else {
          pack8_store(p.QNl + (size_t)(tokg - NCTX) * 256 + c0, qv);
          pack8_store(p.KNl + ((size_t)((layer * 2 + b) * 4 + hd)) * 98304 + kf_off(tkey, d0), kv);
        }
      }
#pragma unroll
      for (int hh = 0; hh < 5; ++hh) {
        const bool isk = (hh == 4);
        const int g = isk ? g8 : g8 + 16 * hh, d0 = (g & 7) * 8, hd = g >> 3;
        const float* src = pr + (isk ? 2432 : 1920) + g * 8;
        const float4 xa = *reinterpret_cast<const float4*>(src), xb = *reinterpret_cast<const float4*>(src + 4);
        const float* nw = (isk ? p.in[25] : p.in[24]) + (size_t)layer * 64 + d0;
        const float4 na = *reinterpret_cast<const float4*>(nw), nb = *reinterpret_cast<const float4*>(nw + 4);
        float x[8] = {xa.x, xa.y, xa.z, xa.w, xb.x, xb.y, xb.z, xb.w};
        const float nrm[8] = {na.x, na.y, na.z, na.w, nb.x, nb.y, nb.z, nb.w};
        float ss = 0.f;
#pragma unroll
        for (int e = 0; e < 8; ++e) ss += x[e] * x[e];
        ss += dpp_mov<0xB1>(ss); ss += dpp_mov<0x4E>(ss); ss += dpp_mov<0x141>(ss);
        const float rs = rsqrtf(ss * (1.f / 64.f) + 1e-6f);
#pragma unroll
        for (int e = 0; e < 8; ++e) x[e] = x[e] * rs * nrm[e];
        if (isk && isctx) {
          float* ok = p.out_gk + ((size_t)(b * 4 + layer) * 256 + tpos) * 128 + g * 8;
          *reinterpret_cast<float4*>(ok) = make_float4(x[0], x[1], x[2], x[3]);
          *reinterpret_cast<float4*>(ok + 4) = make_float4(x[4], x[5], x[6], x[7]);
        }
        if (!isctx) {
          const int pos = (d0 < 32) ? (tpos >> 6) : (tpos & 63);
          const float4* rt = reinterpret_cast<const float4*>(p.rope + (size_t)(pos * 16 + (d0 & 15)) * 2);
          const float4 r0 = rt[0], r1 = rt[1], r2 = rt[2], r3 = rt[3];
          const float cs[8] = {r0.x, r0.z, r1.x, r1.z, r2.x, r2.z, r3.x, r3.z};
          const float sn[8] = {r0.y, r0.w, r1.y, r1.w, r2.y, r2.w, r3.y, r3.w};
          const float sg = (d0 & 16) ? 1.f : -1.f;
#pragma unroll
          for (int e = 0; e < 8; ++e) { const float pe = dpp_mov<0x4E>(x[e]); x[e] = x[e] * cs[e] + sg * pe * sn[e]; }
        }
        if (!isk) {
#pragma unroll
          for (int e = 0; e < 8; ++e) x[e] *= QSCALE;
          if (isctx) pack8_store(p.QGc + (size_t)tokg * 512 + g * 8, x);
          else pack8_store(p.QGl + (size_t)(tokg - NCTX) * 512 + g * 8, x);
        } else {
          if (isctx) pack8_store(p.KGc + (size_t)(b * 2 + hd) * 16384 + kf_off(tkey, d0), x);
          else pack8_store(p.KGl + ((size_t)((layer * 2 + b) * 2 + hd)) * 98304 + kf_off(tkey, d0), x);
        }
      }
    }
    const int c = tid;
#pragma unroll
    for (int half = 0; half < 2; ++half) {
      float vv[8];
#pragma unroll
      for (int t8 = 0; t8 < 8; ++t8) {
        const int tt = half * 8 + t8, tokn = tok0 + tt;
        const float v = p.PROJ[(size_t)tokn * DIN + 1664 + c];
        vv[t8] = v;
        if (isctx) p.out_nav[((size_t)(b * 4 + layer) * 256 + tpos0 + tt) * 256 + c] = v;
      }
      if (isctx) pack44_store(p.VNtc + (size_t)(b * 4 + (c >> 6)) * 16384, tpos0 + half * 8, c & 63, vv);
      else pack44_store(p.VNtl + ((size_t)((layer * 2 + b) * 4 + (c >> 6))) * 98304, 512 + tpos0 + half * 8, c & 63, vv);
    }
    if (wid >= 2) {
      const int cv = c - 128;
#pragma unroll
      for (int half = 0; half < 2; ++half) {
        float vv[8];
#pragma unroll
        for (int t8 = 0; t8 < 8; ++t8) {
          const int tt = half * 8 + t8, tokn = tok0 + tt;
          const float v = p.PROJ[(size_t)tokn * DIN + 2560 + cv];
          vv[t8] = v;
          if (isctx) p.out_gv[((size_t)(b * 4 + layer) * 256 + tpos0 + tt) * 128 + cv] = v;
        }
        if (isctx) pack44_store(p.VGtc + (size_t)(b * 2 + (cv >> 6)) * 16384, tpos0 + half * 8, cv & 63, vv);
        else pack44_store(p.VGtl + ((size_t)((layer * 2 + b) * 2 + (cv >> 6))) * 98304, 512 + tpos0 + half * 8, cv & 63, vv);
      }
    }
#endif
    }
    __syncthreads();
  }
}

#define ATT_LOAD(KF, VF, CI) { \
    const int ci_ = min((CI), nt - 1); \
    int kb_; \
    if (ci_ < nd) kb_ = ci_ * 32; \
    else { const int e_ = ci_ - nd; const int j_ = (ncc == 2) ? (e_ >> 1) : e_; const int cc_ = cc0 + ((ncc == 2) ? (e_ & 1) : 0); kb_ = 512 + (rb + j_) * 64 + cc_ * 32; } \
    const u16* kp_ = Kb + (size_t)(kb_ >> 4) * 1024 + lane * 8; \
    KF##00 = *reinterpret_cast<const bf16x8*>(kp_); \
    KF##01 = *reinterpret_cast<const bf16x8*>(kp_ + 512); \
    KF##10 = *reinterpret_cast<const bf16x8*>(kp_ + 1024); \
    KF##11 = *reinterpret_cast<const bf16x8*>(kp_ + 1536); \
    const u16* vp_ = Vt + (size_t)(kb_ >> 5) * 2048 + lane * 8; \
    VF##0 = *reinterpret_cast<const bf16x8*>(vp_); \
    VF##1 = *reinterpret_cast<const bf16x8*>(vp_ + 512); \
    VF##2 = *reinterpret_cast<const bf16x8*>(vp_ + 1024); \
    VF##3 = *reinterpret_cast<const bf16x8*>(vp_ + 1536); }

#define ATT_PV(DT, VV) { \
    o[DT][0] *= alpha; o[DT][1] *= alpha; o[DT][2] *= alpha; o[DT][3] *= alpha; \
    o[DT] = __builtin_amdgcn_mfma_f32_16x16x32_bf16(VV, pf.v, o[DT], 0, 0, 0); }

#define ATT_COMPUTE(KF, VF, CI) { \
    const int ci_ = (CI); \
    f32x4 s0 = (f32x4){0.f, 0.f, 0.f, 0.f}, s1 = (f32x4){0.f, 0.f, 0.f, 0.f}; \
    s0 = __builtin_amdgcn_mfma_f32_16x16x32_bf16(KF##00, qf0, s0, 0, 0, 0); \
    s0 = __builtin_amdgcn_mfma_f32_16x16x32_bf16(KF##01, qf1, s0, 0, 0, 0); \
    s1 = __builtin_amdgcn_mfma_f32_16x16x32_bf16(KF##10, qf0, s1, 0, 0, 0); \
    s1 = __builtin_amdgcn_mfma_f32_16x16x32_bf16(KF##11, qf1, s1, 0, 0, 0); \
    float sv[8] = {s0[0], s0[1], s0[2], s0[3], s1[0], s1[1], s1[2], s1[3]}; \
    bool ok[8]; \
    _Pragma("unroll") for (int e = 0; e < 8; ++e) ok[e] = true; \
    if (ci_ >= nd) { \
      const int e_ = ci_ - nd; const int j_ = (ncc == 2) ? (e_ >> 1) : e_; const int cc_ = cc0 + ((ncc == 2) ? (e_ & 1) : 0); \
      const int dr_ = rb + j_ - grow + 7; \
      const int cq = cq0 + fr, c0 = min(max(cq - 8, 0), 48); \
      _Pragma("unroll") for (int e = 0; e < 8; ++e) { \
        const int ck = cc_ * 32 + 16 * (e >> 2) + 4 * fq + (e & 3); \
        ok[e] = (ck >= c0) && (ck < c0 + 16); \
        const int dc = min(max(ck - cq, -15), 15) + 15; \
        const float bias = rpb[dr_ * 31 + dc] * LOG2E; \
        sv[e] = ok[e] ? sv[e] + bias : -1e30f; \
      } \
    } \
    float mx = fmaxf(fmaxf(fmaxf(sv[0], sv[1]), fmaxf(sv[2], sv[3])), fmaxf(fmaxf(sv[4], sv[5]), fmaxf(sv[6], sv[7]))); \
    mx = fmaxf(mx, __shfl_xor(mx, 16)); \
    mx = fmaxf(mx, __shfl_xor(mx, 32)); \
    const float mn = fmaxf(m, mx); \
    const float alpha = __builtin_amdgcn_exp2f(m - mn); \
    m = mn; \
    float ps = 0.f; \
    _Pragma("unroll") for (int e = 0; e < 8; ++e) { sv[e] = ok[e] ? __builtin_amdgcn_exp2f(sv[e] - mn) : 0.f; ps += sv[e]; } \
    l = l * alpha + ps; \
    union { bf16x8 v; unsigned u[4]; } pf; \
    pf.u[0] = pack2(sv[0], sv[1]); pf.u[1] = pack2(sv[2], sv[3]); pf.u[2] = pack2(sv[4], sv[5]); pf.u[3] = pack2(sv[6], sv[7]); \
    ATT_PV(0, VF##0) ATT_PV(1, VF##1) ATT_PV(2, VF##2) ATT_PV(3, VF##3) }

__device__ __forceinline__ void attn_wave(const u16* __restrict__ Q, int ldq, const u16* __restrict__ Kb, int ldk,
                                          const u16* __restrict__ Vt, int ldv, int ndense, const bool NA,
                                          const float* __restrict__ rpb, int grow, int cq0,
                                          u16* __restrict__ out, int ldo, int tidx) {
  const int lane = tidx & 63, fr = lane & 15, fq = lane >> 4;
  const bf16x8 qf0 = *reinterpret_cast<const bf16x8*>(Q + (size_t)fr * ldq + fq * 8);
  const bf16x8 qf1 = *reinterpret_cast<const bf16x8*>(Q + (size_t)fr * ldq + 32 + fq * 8);
  f32x4 o[4];
#pragma unroll
  for (int dt = 0; dt < 4; ++dt) o[dt] = (f32x4){0.f, 0.f, 0.f, 0.f};
  float m = -1e30f, l = 0.f;
  const int nd = ndense >> 5;
  const int rb = min(max(grow - 4, 0), 8);
  const int ulo = min(max(cq0 - 8, 0), 48), uhi = min(max(cq0 + 15 - 8, 0), 48) + 16;
  const bool c0ok = ulo < 32, c1ok = uhi > 32;
  const int ncc = (c0ok && c1ok) ? 2 : 1, cc0 = c0ok ? 0 : 1;
  const int nt = nd + (NA ? 8 * ncc : 0);
  bf16x8 ka00, ka01, ka10, ka11, kb00, kb01, kb10, kb11;
  bf16x8 va0, va1, va2, va3, vb0, vb1, vb2, vb3;
  ATT_LOAD(ka, va, 0)
  for (int ci = 0; ci < nt; ci += 2) {
    ATT_LOAD(kb, vb, ci + 1)
    ATT_COMPUTE(ka, va, ci)
    if (ci + 1 < nt) {
      ATT_LOAD(ka, va, ci + 2)
      ATT_COMPUTE(kb, vb, ci + 1)
    }
  }
  l += __shfl_xor(l, 16);
  l += __shfl_xor(l, 32);
  const float il = 1.f / l;
#pragma unroll
  for (int dt = 0; dt < 4; ++dt) {
    uint2 pk; pk.x = pack2(o[dt][0] * il, o[dt][1] * il); pk.y = pack2(o[dt][2] * il, o[dt][3] * il);
    *reinterpret_cast<uint2*>(out + (size_t)fr * ldo + 16 * dt + 4 * fq) = pk;
  }
}

__device__ void scan_item(const Params& p, int layer, char* smem, bool lat, int b, int h, int dir, int qd, int tidx) {
  const int tid = tidx, lane = tid & 63, wid = tid >> 6, rr = lane >> 4, j = lane & 15;
  const int L = lat ? 1024 : 256, seqbase = lat ? NCTX + b * 1024 : b * 256;
  const int rowl = wid * 4 + rr, row = qd * 16 + rowl;
  float* cbuf = reinterpret_cast<float*>(smem);
  float* obuf = cbuf + 2 * 16 * 6 * 64;
  float4 S = make_float4(0.f, 0.f, 0.f, 0.f);
  if (lat) S = *reinterpret_cast<const float4*>(p.in[2] + ((((size_t)(b * 4 + layer) * 2 + dir) * 4 + h) * 64 + row) * 64 + 4 * j);
  v2f S01 = (v2f){S.x, S.y}, S23 = (v2f){S.z, S.w};
  const int nch = L / 16;
  float* odst = dir == 0 ? p.OF : p.OB;
  float4 pre0, pre1, pre2, pre3, pre4, pre5;
  const ptrdiff_t cstep = (dir == 0 ? 1 : -1) * (ptrdiff_t)(16 * 4 * 9 * 64);
  const float *gp0, *gp1, *gp2, *gp3, *gp4, *gp5;
#define SC_GP(GP, I) { const int idx = tid + 256 * (I), tt_ = idx / 96, rem = idx % 96, vec = rem >> 4, f4 = rem & 15; \
    const int t_ = dir == 0 ? tt_ : L - 1 - tt_; const int svec = vec < 3 ? vec : vec + 3 * dir; \
    GP = p.SC + ((size_t)((seqbase + t_) * 4 + h) * 9 + svec) * 64 + f4 * 4; }
  SC_GP(gp0, 0) SC_GP(gp1, 1) SC_GP(gp2, 2) SC_GP(gp3, 3) SC_GP(gp4, 4) SC_GP(gp5, 5)
#define SC_GL1(PR, GP, CH) PR = *reinterpret_cast<const float4*>(GP + (ptrdiff_t)(CH) * cstep);
#define gload(CH) { SC_GL1(pre0, gp0, CH) SC_GL1(pre1, gp1, CH) SC_GL1(pre2, gp2, CH) SC_GL1(pre3, gp3, CH) SC_GL1(pre4, gp4, CH) SC_GL1(pre5, gp5, CH) }
#define SC_LS1(PR, I, BUF) *reinterpret_cast<float4*>(cbuf + (BUF) * 6144 + (tid + 256 * (I)) * 4) = PR;
#define lstore(BUF) { SC_LS1(pre0, 0, BUF) SC_LS1(pre1, 1, BUF) SC_LS1(pre2, 2, BUF) SC_LS1(pre3, 3, BUF) SC_LS1(pre4, 4, BUF) SC_LS1(pre5, 5, BUF) }
  gload(0); lstore(0);
  __syncthreads();
#define SC_LD(R4, K4, VV, W4, A4, D4, TT) { const float* base_ = cb + (TT) * 384; \
    R4 = *reinterpret_cast<const float4*>(base_ + 4 * j); K4 = *reinterpret_cast<const float4*>(base_ + 64 + 4 * j); \
    VV = base_[128 + row]; W4 = *reinterpret_cast<const float4*>(base_ + 192 + 4 * j); \
    A4 = *reinterpret_cast<const float4*>(base_ + 256 + 4 * j); D4 = *reinterpret_cast<const float4*>(base_ + 320 + 4 * j); }
#if SCANVAR
  for (int pass_ = 0; pass_ < (lat ? 2 : 1); ++pass_) {
  int var_ = pass_ ? SCANVAR : 0;
  asm volatile("" : "+v"(var_)); var_ = __builtin_amdgcn_readfirstlane(var_);
#else
  const int var_ = 0;
#endif
  for (int ch = 0; ch < nch; ++ch) {
    if (ch + 1 < nch && var_ != 3) gload(ch + 1);
    const float* cb = cbuf + (ch & 1) * 6144;
    float osel = 0.f;
    float4 r4, kk4, w4, ak4, kd4; float vv;
    SC_LD(r4, kk4, vv, w4, ak4, kd4, 0)
    if (var_ != 2)
#pragma unroll
    for (int hf = 0; hf < 2; ++hf) {
      float oqA = 0.f, oqB = 0.f, ovp = 0.f;
#pragma unroll
      for (int u = 0; u < 8; ++u) {
        const int tt = hf * 8 + u;
        float4 r4n, kk4n, w4n, ak4n, kd4n; float vvn;
        SC_LD(r4n, kk4n, vvn, w4n, ak4n, kd4n, tt + 1)
        v2f p = S01 * (v2f){kk4.x, kk4.y};
        p = S23 * (v2f){kk4.z, kk4.w} + p;
        float sk = p.x + p.y;
        sk += dpp_mov<0xB1>(sk);  ovp += dpp_mov<0xB1>(ovp);
        sk += dpp_mov<0x4E>(sk);  ovp += dpp_mov<0x4E>(ovp);
        sk += dpp_mov<0x141>(sk);
        sk += dpp_mov<0x140>(sk);
        if (u > 0) {
          if (((u - 1) >> 2) == 0) oqA = ((j & 3) == ((u - 1) & 3)) ? ovp : oqA;
          else oqB = ((j & 3) == ((u - 1) & 3)) ? ovp : oqB;
        }
        const v2f vv2 = (v2f){vv, vv}, sk2 = (v2f){sk, sk};
        v2f t01 = (v2f){kd4.x, kd4.y} * vv2; t01 = t01 - (v2f){ak4.x, ak4.y} * sk2;
        v2f t23 = (v2f){kd4.z, kd4.w} * vv2; t23 = t23 - (v2f){ak4.z, ak4.w} * sk2;
        S01 = S01 * (v2f){w4.x, w4.y} + t01;
        S23 = S23 * (v2f){w4.z, w4.w} + t23;
        v2f q = S01 * (v2f){r4.x, r4.y};
        q = S23 * (v2f){r4.z, r4.w} + q;
        ovp = q.x + q.y;
        r4 = r4n; kk4 = kk4n; w4 = w4n; ak4 = ak4n; kd4 = kd4n; vv = vvn;
      }
      ovp += dpp_mov<0xB1>(ovp); ovp += dpp_mov<0x4E>(ovp);
      oqB = ((j & 3) == 3) ? ovp : oqB;
      oqA += dpp_mov<0x128>(oqA); oqB += dpp_mov<0x128>(oqB);
      oqA += dpp_mov<0x124>(oqA); oqB += dpp_mov<0x124>(oqB);
      if ((j >> 3) == hf) osel = ((j >> 2) & 1) ? oqB : oqA;
    }
    if (var_ == 0) {
      const int st = ch * 16 + j, t = dir == 0 ? st : L - 1 - st;
      odst[(size_t)(seqbase + t) * 256 + h * 64 + row] = osel;
    } else asm volatile("" :: "v"(osel), "v"(S01), "v"(S23));
    if (ch + 1 < nch && var_ != 3) lstore((ch + 1) & 1);
    asm volatile("s_waitcnt lgkmcnt(0)" ::: "memory");
    __builtin_amdgcn_s_barrier();
  }
#if SCANVAR
  }
#endif
  if (!lat) *reinterpret_cast<float4*>(p.out_st + ((((size_t)(b * 4 + layer) * 2 + dir) * 4 + h) * 64 + row) * 64 + 4 * j) = make_float4(S01.x, S01.y, S23.x, S23.y);
  __syncthreads();
}

__device__ void mixer_phase(const Params& p, int layer_wq, char* smem, int tidx0) {
  const int layer = layer_wq & 3;
  int* slot = reinterpret_cast<int*>(smem + 60 * 1024);
  bool first = true;
  for (;;) {
    int tidx = tidx0;
    asm volatile("" : "+v"(tidx));
    const int tid = tidx, wid = tid >> 6;
    __syncthreads();
    if (tid == 0) *slot = first ? (int)blockIdx.x : (int)(gridDim.x + atomicAdd(&p.wq[layer_wq], 1u));
    first = false;
    __syncthreads();
    int it = *slot;
    if (it >= 1728) break;
    const bool is_scan = (it < 64) || (it >= 448 && it < 960);
#if REPMASK
    if ((p.pad == 1 && !is_scan) || (p.pad == 2 && is_scan) || ((p.pad == 3 || p.pad == 5 || p.pad == 6) && !(it < 64)) || (p.pad == 4 && !(it >= 64 && it < 320))) continue;
#endif
    if (is_scan) {
      const bool lat = it < 64;
      const int si = lat ? it : it - 448;
#ifndef NO_SCAN
      scan_item(p, layer, smem, lat, si / 32, (si / 8) % 4, (si / 4) % 2, si % 4, tidx);
#endif
      continue;
    }
    const u16 *Q, *Kb, *Vt; u16* out; int ldq, ldk, ldv, ndense, grow = 0, cq0 = 0; bool na = false;
    const float* rpb = p.in[23];
    if (it < 320) {
      it -= 64;
      const int b = it / 128, qh = (it / 16) % 8, qt = it % 16, kvh = qh >> 2;
      const int q0 = b * 1024 + qt * 64 + wid * 16;
      Q = p.QGl + (size_t)q0 * 512 + qh * 64; ldq = 512;
      Kb = p.KGl + (size_t)((layer * 2 + b) * 2 + kvh) * 98304; ldk = 0;
      Vt = p.VGtl + (size_t)((layer * 2 + b) * 2 + kvh) * 98304; ldv = 0; ndense = 1536;
      out = p.MIX + (size_t)(NCTX + q0) * DM + 512 + qh * 64;
    } else if (it < 448) {
      it -= 320;
      const int b = it / 64, h = (it / 16) % 4, r = it % 16;
      const int q0 = b * 1024 + r * 64 + wid * 16;
      Q = p.QNl + (size_t)q0 * 256 + h * 64; ldq = 256;
      Kb = p.KNl + (size_t)((layer * 2 + b) * 4 + h) * 98304; ldk = 0;
      Vt = p.VNtl + (size_t)((layer * 2 + b) * 4 + h) * 98304; ldv = 0; ndense = 512;
      rpb = p.in[23] + (size_t)(layer * 4 + h) * 15 * 31; grow = r; cq0 = wid * 16; na = true;
      out = p.MIX + (size_t)(NCTX + q0) * DM + 256 + h * 64;
    } else if (it < 1472) {
      it -= 960;
      const int b = it / 32, qh = (it / 4) % 8, qt = it % 4, kvh = qh >> 2;
      const int q0 = b * 256 + qt * 64 + wid * 16;
      Q = p.QGc + (size_t)q0 * 512 + qh * 64; ldq = 512;
      Kb = p.KGc + (size_t)(b * 2 + kvh) * 16384; ldk = 0;
      Vt = p.VGtc + (size_t)(b * 2 + kvh) * 16384; ldv = 0; ndense = 256;
      out = p.MIX + (size_t)q0 * DM + 512 + qh * 64;
    } else {
      it -= 1472;
      const int b = it / 16, h = (it / 4) % 4, qt = it % 4;
      const int q0 = b * 256 + qt * 64 + wid * 16;
      Q = p.QNc + (size_t)q0 * 256 + h * 64; ldq = 256;
      Kb = p.KNc + (size_t)(b * 4 + h) * 16384; ldk = 0;
      Vt = p.VNtc + (size_t)(b * 4 + h) * 16384; ldv = 0; ndense = 256;
      out = p.MIX + (size_t)q0 * DM + 256 + h * 64;
    }
#ifndef NO_ATT
    attn_wave(Q, ldq, Kb, ldk, Vt, ldv, ndense, na, rpb, grow, cq0, out, DM, tidx);
#endif
  }
}

__device__ void rwkv_fin_phase(const Params& p, int layer, int bid, int nblk, int tidx) {
  const int tid = tidx;
  const float lw = p.in[21][(size_t)layer * 256 + tid], lb = p.in[22][(size_t)layer * 256 + tid];
  for (int t4 = bid; t4 < NTOK / 4; t4 += nblk) {
    float of[4], ob[4], bv[4], gg[4];
#pragma unroll
    for (int u = 0; u < 4; ++u) {
      const size_t i = (size_t)(t4 * 4 + u) * 256 + tid;
      of[u] = p.OF[i]; ob[u] = p.OB[i]; bv[u] = p.BV[i]; gg[u] = p.G[i];
    }
#pragma unroll
    for (int u = 0; u < 4; ++u) {
      const float o = of[u] + ob[u];
      const float mu = wave_sum(o) * (1.f / 64.f);
      const float d = o - mu;
      const float var = wave_sum(d * d) * (1.f / 64.f);
      const float y = (d * rsqrtf(var + 64e-5f) * lw + lb + bv[u]) * gg[u];
      p.MIX[(size_t)(t4 * 4 + u) * DM + tid] = f2bf(y);
    }
  }
}

#ifndef ONLY_PH
#define ONLY_PH -1
#endif
#define PH_EN(x) (ONLY_PH < 0 || ONLY_PH == (x))
__device__ __forceinline__ void run_phase(const Params& p, int ph, char* smem, int bid, int nblk, int tidx, int rep = 0) {
  const bool defer = (nblk == 512);
  if (ph == 0) {
    if (PH_EN(0)) { setup_phase(p, smem, bid, nblk, tidx, 0, defer ? 192 : 768, true); weight_convert(p, smem, tidx, bid, nblk, 0, defer ? 2336 : 4 * 3040); }
    return;
  }
  if (ph == 1) { if (PH_EN(1)) modreduce_phase(p, bid, nblk, tidx, 0, defer ? 4608 : 18432); return; }
  if (ph == 2) { if (PH_EN(2)) ln_phase<0>(p, 0, bid, nblk, tidx); return; }
  const int layer = (ph - 3) / 9, s = (ph - 3) % 9;
  switch (s) {
    case 0: if (PH_EN(3)) gemm_phase<EPI_PROJ, 256, 3>(p, layer, p.A, p.winT + (size_t)layer * DIN * DM, DIN, DM, smem, bid, nblk, tidx); break;
    case 1: if (PH_EN(4)) prep_phase(p, layer, smem, bid, nblk, tidx, rep); break;
    case 2: if (PH_EN(5)) mixer_phase(p, layer + 4 * rep, smem, tidx); break;
    case 3: if (PH_EN(6)) rwkv_fin_phase(p, layer, bid, nblk, tidx); break;
    case 4:
      if (PH_EN(7)) {
        if (defer && bid >= 256) {
          if (layer == 0) { setup_phase(p, smem, bid - 256, 256, tidx, 192, 768, false); weight_convert(p, smem, tidx, bid - 256, 256, 2336, 3040); }
        } else gemm_phase<EPI_OUT, 192, 3>(p, layer, p.MIX, p.woutT + (size_t)layer * DM * DM, DM, DM, smem, bid, nblk, tidx);
      }
      break;
    case 5: if (PH_EN(8)) ln_phase<1>(p, layer, bid, nblk, tidx); break;
    case 6: if (PH_EN(9)) gemm_phase<EPI_FFI, 192, 3>(p, layer, p.A, p.wfiT + (size_t)layer * 2 * DFF * DM, 2 * DFF, DM, smem, bid, nblk, tidx); break;
    case 7:
      if (PH_EN(10)) {
        if (defer && bid >= 256) {
          if (layer < 3) weight_convert(p, smem, tidx, bid - 256, 256, 3040 * (layer + 1), 3040 * (layer + 2));
          if (layer == 0) modreduce_phase(p, bid - 256, 256, tidx, 4608, 18432);
        }
        else gemm_phase<EPI_FFO, 192, 3>(p, layer, p.ACT, p.wfoT + (size_t)layer * DM * DFF, DM, DFF, smem, bid, nblk, tidx);
      }
      break;
    default: if (PH_EN(11)) ln_phase<2>(p, layer, bid, nblk, tidx); break;
  }
}

__global__ void __launch_bounds__(256, 2) fwd_kernel(Params p, int ph0, int ph1, int usebar) {
  __shared__ __attribute__((aligned(16))) char smem[73728 + 16];
  const int bid = blockIdx.x, nblk = gridDim.x;
  XcdBarrier xb;
  if (usebar && p.never) cg::this_grid().sync();
  if (usebar) {
    if (threadIdx.x == 0) *reinterpret_cast<uint4*>(smem + 73728) = make_uint4(0u, 0u, 0u, 0u);
    __syncthreads();
    xb = xcd_barrier_post(p.bar, (volatile LAS unsigned*)(smem + 73728));
  }
  int ph = ph0, rep = 0;
  while (ph < ph1) {
    int tidx = threadIdx.x;
    asm volatile("" : "+v"(tidx));
    run_phase(p, ph, smem, bid, nblk, tidx, rep);
#if REPSLOT >= 0
    if (((ph < 3 ? 9 + ph : (ph - 3) % 9) == REPSLOT) && rep == 0) rep = 1; else { rep = 0; ++ph; }
#else
    ++ph;
#endif
    if (usebar && ph < ph1) xcd_barrier(xb);
  }
}

static inline size_t al256(size_t x) { return (x + 255) & ~(size_t)255; }

extern "C" void kernel_launch(void* const* d_in, const int* in_sizes, int n_in, void* d_out, int out_size, void* d_ws, size_t ws_size,
                              hipStream_t stream) {
  Params p;
  memset(&p, 0, sizeof(p));
  for (int i = 0; i < 33; ++i) p.in[i] = (const float*)d_in[i];
  float* o = (float*)d_out;
  p.out_yp = o; o += 4194304;
  p.out_ys = o; o += 2097152;
  p.out_st = o; o += 2097152;
  p.out_nak = o; o += 4194304;
  p.out_nav = o; o += 4194304;
  p.out_gk = o; o += 2097152;
  p.out_gv = o;
  char* w = (char*)d_ws; size_t off = 0;
  auto take = [&](size_t bytes) { char* r = w + off; off += al256(bytes); return r; };
  p.bar = (unsigned*)take(16384);
  p.wq = p.bar + 3584;
  p.modp = (float*)take((size_t)4 * 32 * 3 * 6144 * 4);
  p.mod = (float*)take((size_t)4 * 3 * 6144 * 4);
  p.winT = (u16*)take((size_t)4 * DIN * DM * 2);
  p.woutT = (u16*)take((size_t)4 * DM * DM * 2);
  p.wfiT = (u16*)take((size_t)4 * 2 * DFF * DM * 2);
  p.wfoT = (u16*)take((size_t)4 * DM * DFF * 2);
  p.X = (float*)take((size_t)NTOK * DM * 4);
  p.PROJ = (float*)take((size_t)NTOK * DIN * 4);
  p.X1 = p.PROJ;
  p.Y = p.PROJ + (size_t)NTOK * DM;
  p.SC = (float*)take((size_t)NTOK * 4 * 9 * 64 * 4);
  p.ACT = (u16*)p.SC;
  p.G = (float*)take((size_t)NTOK * 256 * 4);
  p.BV = (float*)take((size_t)NTOK * 256 * 4);
  p.OF = (float*)take((size_t)NTOK * 256 * 4);
  p.OB = (float*)take((size_t)NTOK * 256 * 4);
  p.A = (u16*)take((size_t)NTOK * DM * 2);
  p.MIX = (u16*)take((size_t)NTOK * DM * 2);
  p.QNc = (u16*)take((size_t)NCTX * 256 * 2);
  p.KNc = (u16*)take((size_t)NCTX * 256 * 2);
  p.VNtc = (u16*)take((size_t)NCTX * 256 * 2);
  p.QGc = (u16*)take((size_t)NCTX * 512 * 2);
  p.KGc = (u16*)take((size_t)NCTX * 128 * 2);
  p.VGtc = (u16*)take((size_t)NCTX * 128 * 2);
  p.QNl = (u16*)take((size_t)2048 * 256 * 2);
  p.KNl = (u16*)take((size_t)4 * 2 * 1536 * 256 * 2);
  p.VNtl = (u16*)take((size_t)4 * 2 * 1536 * 256 * 2);
  p.QGl = (u16*)take((size_t)2048 * 512 * 2);
  p.KGl = (u16*)take((size_t)4 * 2 * 1536 * 128 * 2);
  p.VGtl = (u16*)take((size_t)4 * 2 * 1536 * 128 * 2);
  p.loraT = (u16*)take((size_t)4 * 98304 * 2);
  p.rope = (float*)take((size_t)64 * 16 * 2 * 4);
  if (off > ws_size) { fprintf(stderr, "workspace too small: need %zu have %zu\n", off, ws_size); return; }

  (void)hipMemsetAsync(p.bar, 0, 16384, stream);
#if MEGA
  static int grid_blocks = 0;
  if (!grid_blocks) {
    int dev = 0, cus = 0, per_cu = 0;
    hipGetDevice(&dev);
    hipDeviceGetAttribute(&cus, hipDeviceAttributeMultiprocessorCount, dev);
    hipOccupancyMaxActiveBlocksPerMultiprocessor(&per_cu, fwd_kernel, 256, 0);
    if (per_cu > 2) per_cu = 2;
    if (per_cu < 1) per_cu = 1;
    grid_blocks = cus * per_cu;
  }
  int ph0 = 0, ph1 = NPH, ub = 1;
  void* args[] = {&p, &ph0, &ph1, &ub};
  hipError_t e = hipLaunchCooperativeKernel((void*)fwd_kernel, dim3(grid_blocks), dim3(256), args, 0, stream);
  if (e != hipSuccess) fprintf(stderr, "cooperative launch failed: %s (grid %d)\n", hipGetErrorString(e), grid_blocks);
#else
  for (int ph = 0; ph < NPH; ++ph) fwd_kernel<<<512, 256, 0, stream>>>(p, ph, ph + 1, 0);
#endif
}
```

```cpp
#include <hip/hip_runtime.h>
#include <hip/hip_cooperative_groups.h>
#include <cstdio>
#include <cstdint>
#include <cstring>
namespace cg = cooperative_groups;

#ifndef REPMASK
#define REPMASK 0
#endif
#ifndef REPSLOT
#define REPSLOT -1
#endif
#ifndef PREPVAR
#define PREPVAR 0
#endif
#ifndef SCANVAR
#define SCANVAR 0
#endif
#ifndef REPVAR
#define REPVAR 0
#endif
#ifndef MEGA
#define MEGA 1
#endif

typedef unsigned short u16;
using bf16x8 = __attribute__((ext_vector_type(8))) short;
using f32x4 = __attribute__((ext_vector_type(4))) float;
using v2f = __attribute__((ext_vector_type(2))) float;

#define NTOK 6144
#define NCTX 4096
#define DM 1024
#define DIN 2688
#define DFF 2816
#define NPH 39
#define ALPHA 1.681792830507429f
#define LOG2E 1.4426950408889634f
#define QSCALE (0.125f * LOG2E)

struct Params {
  const float* in[33];
  float *out_yp, *out_ys, *out_st, *out_nak, *out_nav, *out_gk, *out_gv;
  unsigned *bar, *wq;
  float *modp, *mod;
  u16 *winT, *woutT, *wfiT, *wfoT;
  float *X, *X1, *Y, *PROJ, *SC, *G, *BV, *OF, *OB;
  u16 *A, *MIX, *ACT;
  u16 *QNc, *KNc, *VNtc, *QGc, *KGc, *VGtc;
  u16 *QNl, *KNl, *VNtl, *QGl, *KGl, *VGtl;
  u16* loraT; float* rope;
  int never; int pad;
};

__device__ __forceinline__ u16 f2bf(float f) {
  unsigned u = __float_as_uint(f);
  u += 0x7FFFu + ((u >> 16) & 1u);
  return (u16)(u >> 16);
}
typedef __bf16 bf16v2 __attribute__((ext_vector_type(2)));
__device__ __forceinline__ unsigned pack2(float a, float b) {
  const bf16v2 r = __builtin_convertvector((v2f){a, b}, bf16v2);
  return __builtin_bit_cast(unsigned, r);
}
template <int CTRL> __device__ __forceinline__ float dpp_mov(float v) {
  return __int_as_float(__builtin_amdgcn_update_dpp(0, __float_as_int(v), CTRL, 0xF, 0xF, false));
}
__device__ __forceinline__ float reduce16(float v) {
  v += dpp_mov<0xB1>(v);
  v += dpp_mov<0x4E>(v);
  v += dpp_mov<0x141>(v);
  v += dpp_mov<0x140>(v);
  return v;
}
__device__ __forceinline__ float wave_sum(float v) {
  v = reduce16(v);
  v += __shfl_xor(v, 16);
  v += __shfl_xor(v, 32);
  return v;
}
__device__ __forceinline__ float tanhf_(float x) { const float e = __expf(-2.f * fabsf(x)); const float t = (1.f - e) / (1.f + e); return x < 0.f ? -t : t; }
__device__ __forceinline__ float sigmoidf_(float x) { return 1.f / (1.f + __expf(-x)); }
__device__ __forceinline__ float siluf_(float x) { return x / (1.f + __expf(-x)); }
__device__ __forceinline__ int modrow_of(int tok) { return tok < NCTX ? 0 : 1 + ((tok - NCTX) >> 10); }

#define XB_TMO      128
#define XB_XCNT(j)  (256  + 64 * (j))
#define XB_XSUB(j)  (1280 + 64 * (j))
#define XB_XGEN(j)  (2304 + 64 * (j))
#define XB_TOP      3328
#define XB_TOPGEN   3392
#define XCD_BAR_WORDS 3456
#define XB_SPIN_CAP (1u << 22)
#define LAS __attribute__((address_space(3)))
__device__ __forceinline__ unsigned xb_ld(unsigned* p) { return __hip_atomic_load(p, __ATOMIC_RELAXED, __HIP_MEMORY_SCOPE_AGENT); }
__device__ __forceinline__ unsigned xb_add(unsigned* p, unsigned v) { return __hip_atomic_fetch_add(p, v, __ATOMIC_RELAXED, __HIP_MEMORY_SCOPE_AGENT); }
__device__ __forceinline__ unsigned xb_xcc_id() { return (unsigned)__builtin_amdgcn_s_getreg((3 << 11) | 20) & 0xFu; }
#define XB_SPIN(cond, bar) do { unsigned _sp = 0; while (cond) { __builtin_amdgcn_s_sleep(1); \
    if ((++_sp & 255u) == 0u) { if (xb_ld(&(bar)[XB_TMO])) break; if (_sp > XB_SPIN_CAP) { atomicAdd(&(bar)[XB_TMO], 1u); break; } } } } while (0)
struct XcdBarrier { unsigned* bar; unsigned x; volatile LAS unsigned* st; };
__device__ __forceinline__ XcdBarrier xcd_barrier_post(unsigned* bar, volatile LAS unsigned* st) {
  XcdBarrier b; b.bar = bar; b.x = xb_xcc_id(); b.st = st;
  if (threadIdx.x == 0) (void)xb_add(&bar[XB_XCNT(b.x)], 1u);
  return b;
}
__device__ __forceinline__ void xcd_barrier_complete(unsigned* bar, unsigned x, unsigned& nloc, unsigned& nx) {
  const unsigned G = gridDim.x * gridDim.y * gridDim.z;
  unsigned sum, cnt, mine, sp = 0u;
  for (;;) {
    sum = 0u; cnt = 0u; mine = 0u;
#pragma unroll
    for (unsigned j = 0; j < 16; ++j) { const unsigned c = xb_ld(&bar[XB_XCNT(j)]); sum += c; cnt += (c > 0u) ? 1u : 0u; mine = (j == x) ? c : mine; }
    if (sum == G) break;
    __builtin_amdgcn_s_sleep(1);
    if ((++sp & 255u) == 0u) { if (xb_ld(&bar[XB_TMO])) break; if (sp > XB_SPIN_CAP) { atomicAdd(&bar[XB_TMO], 1u); break; } }
  }
  nloc = mine > 0u ? mine : 1u; nx = cnt > 0u ? cnt : 1u;
}
__device__ __forceinline__ void xcd_barrier(const XcdBarrier& b) {
  asm volatile("s_waitcnt vmcnt(0)" ::: "memory");
  __syncthreads();
  if (threadIdx.x == 0) {
    unsigned* bar = b.bar;
    asm volatile("" : "+s"(bar));
    __builtin_amdgcn_s_waitcnt(0);
    unsigned nloc = b.st[0], nx = b.st[1];
    if (nloc == 0u) { xcd_barrier_complete(bar, b.x, nloc, nx); b.st[0] = nloc; b.st[1] = nx; }
    const unsigned old = xb_add(&bar[XB_XSUB(b.x)], 1u);
    const unsigned gen = old / nloc;
    if (old + 1u == (gen + 1u) * nloc) {
      __builtin_amdgcn_fence(__ATOMIC_RELEASE, "agent");
      asm volatile("s_waitcnt vmcnt(0)" ::: "memory");
      const unsigned og = xb_add(&bar[XB_TOP], 1u);
      const unsigned tg = og / nx;
      if (og + 1u == (tg + 1u) * nx) xb_add(&bar[XB_TOPGEN], 1u);
      else XB_SPIN(xb_ld(&bar[XB_TOPGEN]) == tg, bar);
      __builtin_amdgcn_fence(__ATOMIC_ACQUIRE, "agent");
      xb_add(&bar[XB_XGEN(b.x)], 1u);
      asm volatile("s_waitcnt vmcnt(0)" ::: "memory");
    } else {
      XB_SPIN(xb_ld(&bar[XB_XGEN(b.x)]) == gen, bar);
      __builtin_amdgcn_fence(__ATOMIC_ACQUIRE, "agent");
      asm volatile("s_waitcnt vmcnt(0)" ::: "memory");
    }
  }
  __syncthreads();
}

__device__ __forceinline__ int lds_byte32(int r, int c) {
  const int ob = (r & 15) * 64 + c * 2;
  return (r >> 4) * 1024 + (ob ^ (((ob >> 9) & 1) << 5));
}
__device__ __forceinline__ void stage_rc32(int b, int& R, int& C) {
  const int sb = b & 1023, swz = sb ^ (((sb >> 9) & 1) << 5);
  R = (b >> 10) * 16 + (swz >> 6); C = (swz & 63) >> 1;
}
template <int ROWS>
__device__ __forceinline__ void stage_tile32(const u16* __restrict__ g, int ld, char* lds, int tidx) {
#pragma unroll
  for (int i = 0; i < (ROWS * 64 + 4095) / 4096; ++i) {
    const int b = tidx * 16 + i * 4096;
    if ((i + 1) * 4096 <= ROWS * 64 || tidx < (ROWS * 64 - i * 4096) / 16) {
      int R, C; stage_rc32(b, R, C);
      __builtin_amdgcn_global_load_lds((const unsigned*)(g + (size_t)R * ld + C), (unsigned LAS*)(lds + b), 16, 0, 0);
    }
  }
}
template <int N> __device__ __forceinline__ void wait_vmcnt() {
  if (N == 0) asm volatile("s_waitcnt vmcnt(0)" ::: "memory");
  else if (N == 3) asm volatile("s_waitcnt vmcnt(3)" ::: "memory");
  else if (N == 4) asm volatile("s_waitcnt vmcnt(4)" ::: "memory");
  else if (N == 5) asm volatile("s_waitcnt vmcnt(5)" ::: "memory");
  else if (N == 6) asm volatile("s_waitcnt vmcnt(6)" ::: "memory");
  else if (N == 8) asm volatile("s_waitcnt vmcnt(8)" ::: "memory");
  else if (N == 9) asm volatile("s_waitcnt vmcnt(9)" ::: "memory");
  else if (N == 10) asm volatile("s_waitcnt vmcnt(10)" ::: "memory");
  else if (N == 12) asm volatile("s_waitcnt vmcnt(12)" ::: "memory");
  else asm volatile("s_waitcnt vmcnt(0)" ::: "memory");
}

enum { EPI_PROJ = 0, EPI_OUT = 1, EPI_FFI = 2, EPI_FFO = 3 };

template <int EPI, int BM, int NST>
__device__ __forceinline__ void gemm_phase(const Params& p, int layer, const u16* __restrict__ A, const u16* __restrict__ Bt,
                                           int N, int K, char* smem, int bid, int nblk, int tidx) {
  constexpr int MF = BM / 32;
  const int tid = tidx, lane = tid & 63, wid = tid >> 6, wr = wid >> 1, wc = wid & 1, fr = lane & 15, fq = lane >> 4;
  const int nM = NTOK / BM, nN = N / 128, ntiles = nM * nN, nk = K / 32;
  constexpr int SB = (BM + 128) * 64;
  constexpr int LA = (BM * 64) / 4096;
  const bool extraA = (BM == 96) && (wid < 2);
  for (int tile = bid; tile < ntiles; tile += nblk) {
    const int pm = tile % nM, pn = tile / nM, m0 = pm * BM, n0 = pn * 128;
    f32x4 acc[MF][4];
#pragma unroll
    for (int m = 0; m < MF; ++m)
#pragma unroll
      for (int n = 0; n < 4; ++n) acc[m][n] = (f32x4){0.f, 0.f, 0.f, 0.f};
    const u16* Ag = A + (size_t)m0 * K;
    const u16* Bg = Bt + (size_t)n0 * K;
#pragma unroll
    for (int s_ = 0; s_ < NST - 1; ++s_) {
      stage_tile32<BM>(Ag + s_ * 32, K, smem + s_ * SB, tidx);
      stage_tile32<128>(Bg + s_ * 32, K, smem + s_ * SB + BM * 64, tidx);
    }
    int slot = 0, pslot = NST - 1;
    for (int kt = 0; kt < nk; ++kt) {
      if (kt + NST - 2 < nk) {
        if (BM == 96) { if (extraA) wait_vmcnt<(NST - 2) * 4>(); else wait_vmcnt<(NST - 2) * 3>(); }
        else wait_vmcnt<(NST - 2) * (LA + 2)>();
      } else {
        asm volatile("s_waitcnt vmcnt(0)" ::: "memory");
      }
      __builtin_amdgcn_s_barrier();
      if (kt + NST - 1 < nk) {
        char* nb = smem + pslot * SB;
        stage_tile32<BM>(Ag + (kt + NST - 1) * 32, K, nb, tidx);
        stage_tile32<128>(Bg + (kt + NST - 1) * 32, K, nb + BM * 64, tidx);
      }
      const char* sa = smem + slot * SB;
      const char* sb = sa + BM * 64;
      slot = (slot + 1 == NST) ? 0 : slot + 1;
      pslot = (pslot + 1 == NST) ? 0 : pslot + 1;
      bf16x8 af[MF], bfr[4];
#pragma unroll
      for (int m = 0; m < MF; ++m) af[m] = *reinterpret_cast<const bf16x8*>(sa + lds_byte32(wr * (BM / 2) + m * 16 + fr, fq * 8));
#pragma unroll
      for (int n = 0; n < 4; ++n) bfr[n] = *reinterpret_cast<const bf16x8*>(sb + lds_byte32(wc * 64 + n * 16 + fr, fq * 8));
#pragma unroll
      for (int m = 0; m < MF; ++m)
#pragma unroll
        for (int n = 0; n < 4; ++n) acc[m][n] = __builtin_amdgcn_mfma_f32_16x16x32_bf16(bfr[n], af[m], acc[m][n], 0, 0, 0);
    }
#pragma unroll
    for (int m = 0; m < MF; ++m) {
      const int row = m0 + wr * (BM / 2) + m * 16 + fr;
      if (EPI == EPI_PROJ) {
#pragma unroll
        for (int n = 0; n < 4; ++n) {
          const int col = n0 + wc * 64 + n * 16 + 4 * fq;
          *reinterpret_cast<float4*>(p.PROJ + (size_t)row * DIN + col) = make_float4(acc[m][n][0], acc[m][n][1], acc[m][n][2], acc[m][n][3]);
        }
      } else if (EPI == EPI_OUT || EPI == EPI_FFO) {
        const float* res = (EPI == EPI_OUT) ? p.X : p.X1;
        const float* gate = p.mod + ((size_t)(layer * 3 + modrow_of(row)) * 6 + (EPI == EPI_OUT ? 2 : 5)) * 1024;
#pragma unroll
        for (int n = 0; n < 4; ++n) {
          const int col = n0 + wc * 64 + n * 16 + 4 * fq;
          const float4 xr = *reinterpret_cast<const float4*>(res + (size_t)row * DM + col);
          const float4 gt = *reinterpret_cast<const float4*>(gate + col);
          float4 y;
          y.x = ALPHA * xr.x + gt.x * acc[m][n][0];
          y.y = ALPHA * xr.y + gt.y * acc[m][n][1];
          y.z = ALPHA * xr.z + gt.z * acc[m][n][2];
          y.w = ALPHA * xr.w + gt.w * acc[m][n][3];
          *reinterpret_cast<float4*>(p.Y + (size_t)row * DM + col) = y;
        }
      } else {
#pragma unroll
        for (int n2 = 0; n2 < 2; ++n2) {
          const int j0 = ((n0 + wc * 64) / 32 + n2) * 16 + 4 * fq;
          float a[4];
#pragma unroll
          for (int r = 0; r < 4; ++r) a[r] = siluf_(acc[m][2 * n2][r]) * acc[m][2 * n2 + 1][r];
          uint2 pk; pk.x = pack2(a[0], a[1]); pk.y = pack2(a[2], a[3]);
          *reinterpret_cast<uint2*>(p.ACT + (size_t)row * DFF + j0) = pk;
        }
      }
    }
    asm volatile("s_waitcnt lgkmcnt(0)" ::: "memory");
    __builtin_amdgcn_s_barrier();
  }
}

__device__ __forceinline__ int kf_off(int t, int d) { return (t >> 4) * 1024 + (d >> 5) * 512 + ((d & 31) >> 3) * 128 + (t & 15) * 8 + (d & 7); }
__device__ __forceinline__ int vf_off(int t, int d) { return (t >> 5) * 2048 + (d >> 4) * 512 + (((t & 15) >> 2) * 16 + (d & 15)) * 8 + ((t >> 4) & 1) * 4 + (t & 3); }
__device__ __forceinline__ void pack44_store(u16* base, int t0, int d, const float* v) {
  uint2 a, b; a.x = pack2(v[0], v[1]); a.y = pack2(v[2], v[3]); b.x = pack2(v[4], v[5]); b.y = pack2(v[6], v[7]);
  *reinterpret_cast<uint2*>(base + vf_off(t0, d)) = a;
  *reinterpret_cast<uint2*>(base + vf_off(t0 + 4, d)) = b;
}
__device__ __forceinline__ void pack8_store(u16* dst, const float* v) {
  uint4 pk; pk.x = pack2(v[0], v[1]); pk.y = pack2(v[2], v[3]); pk.z = pack2(v[4], v[5]); pk.w = pack2(v[6], v[7]);
  *reinterpret_cast<uint4*>(dst) = pk;
}

__device__ void setup_phase(const Params& p, char* smem, int bid, int nblk, int tidx, int mod_lo, int mod_hi, bool rest) {
  const int tid = tidx;
  const int nm = mod_hi - mod_lo;
  const int NV = nm + (rest ? 512 + 13 : 0);
  for (int v_ = bid; v_ < NV; v_ += nblk) {
    const int it = v_ < nm ? mod_lo + v_ : 768 + (v_ - nm);
    if (it < 768) {
      const int l = it / 192, nc = (it / 32) % 6, kc = it % 32;
      const int col = nc * 1024 + tid * 4;
      const float* wm = p.in[9] + (size_t)l * 1024 * 6144;
      float4 a0 = make_float4(0, 0, 0, 0), a1 = a0, a2 = a0;
      for (int k8 = 0; k8 < 32; k8 += 8) {
        float4 w[8];
#pragma unroll
        for (int u = 0; u < 8; ++u) w[u] = *reinterpret_cast<const float4*>(wm + (size_t)(kc * 32 + k8 + u) * 6144 + col);
#pragma unroll
        for (int u = 0; u < 8; ++u) {
          const int k = kc * 32 + k8 + u;
          const float s0 = siluf_(p.in[8][k]), s1 = siluf_(p.in[7][k]), s2 = siluf_(p.in[7][1024 + k]);
          a0.x += s0 * w[u].x; a0.y += s0 * w[u].y; a0.z += s0 * w[u].z; a0.w += s0 * w[u].w;
          a1.x += s1 * w[u].x; a1.y += s1 * w[u].y; a1.z += s1 * w[u].z; a1.w += s1 * w[u].w;
          a2.x += s2 * w[u].x; a2.y += s2 * w[u].y; a2.z += s2 * w[u].z; a2.w += s2 * w[u].w;
        }
      }
      float* dst = p.modp + (size_t)((l * 32 + kc) * 3) * 6144 + col;
      *reinterpret_cast<float4*>(dst) = a0;
      *reinterpret_cast<float4*>(dst + 6144) = a1;
      *reinterpret_cast<float4*>(dst + 2 * 6144) = a2;
    } else if (it < 1280) {
      const int ci = it - 768, b = ci / 256, l = (ci / 64) % 4, tg = ci % 64, t0 = tg * 8;
      {
        const float* ck = p.in[3] + ((size_t)(b * 4 + l) * 512 + t0) * 256 + tid;
        const float* cv = p.in[4] + ((size_t)(b * 4 + l) * 512 + t0) * 256 + tid;
        float v[8];
#pragma unroll
        for (int tt = 0; tt < 8; ++tt) {
          p.KNl[((size_t)((l * 2 + b) * 4 + (tid >> 6))) * 98304 + kf_off(t0 + tt, tid & 63)] = f2bf(ck[tt * 256]);
          v[tt] = cv[tt * 256];
        }
        pack44_store(p.VNtl + ((size_t)((l * 2 + b) * 4 + (tid >> 6))) * 98304, t0, tid & 63, v);
      }
      if (tid < 128) {
        const float* ck = p.in[5] + ((size_t)(b * 4 + l) * 512 + t0) * 128 + tid;
#pragma unroll
        for (int tt = 0; tt < 8; ++tt) p.KGl[((size_t)((l * 2 + b) * 2 + (tid >> 6))) * 98304 + kf_off(t0 + tt, tid & 63)] = f2bf(ck[tt * 128]);
      } else {
        const int c = tid - 128;
        const float* cv = p.in[6] + ((size_t)(b * 4 + l) * 512 + t0) * 128 + c;
        float v[8];
#pragma unroll
        for (int tt = 0; tt < 8; ++tt) v[tt] = cv[tt * 128];
        pack44_store(p.VGtl + ((size_t)((l * 2 + b) * 2 + (c >> 6))) * 98304, t0, c & 63, v);
      }
    } else {
      const int li = it - (768 + 512);
      if (li == 12) {
        for (int idx = tid; idx < 1024; idx += 256) {
          const int pos = idx >> 4, fi = idx & 15;
          const float ang = (float)pos * exp2f(-(float)fi * (13.287712379549449f / 16.f));
          p.rope[idx * 2] = cosf(ang); p.rope[idx * 2 + 1] = sinf(ang);
        }
      } else {
        const int l = li / 3, m = li % 3;
        u16* dst = p.loraT + (size_t)l * 98304 + m * 32768;
        if (m < 2) {
          const float* src = p.in[m == 0 ? 14 : 16] + (size_t)l * 32768;
          for (int i0 = tid; i0 < 32768; i0 += 256 * 16) {
            float v[16];
#pragma unroll
            for (int u = 0; u < 16; ++u) { const int idx = i0 + 256 * u; const int d = idx >> 14, cch = (idx >> 6) & 255, r = idx & 63; v[u] = src[(d * 64 + r) * 256 + cch]; }
#pragma unroll
            for (int u = 0; u < 16; ++u) dst[i0 + 256 * u] = f2bf(v[u]);
          }
        } else {
          const float* src = p.in[17] + (size_t)l * 32768;
          for (int i0 = tid; i0 < 32768; i0 += 256 * 16) {
            float v[16];
#pragma unroll
            for (int u = 0; u < 16; ++u) { const int idx = i0 + 256 * u; const int cch = idx >> 7, j = idx & 127; v[u] = src[j * 256 + cch]; }
#pragma unroll
            for (int u = 0; u < 16; ++u) dst[i0 + 256 * u] = f2bf(v[u]);
          }
        }
      }
    }
  }
}

__device__ void weight_convert(const Params& p, char* smem, int tid, int w, int nw, int tr_begin, int NT) {
    float* tile = reinterpret_cast<float*>(smem);
    float4 cur0, cur1, cur2, cur3;
    const float* src; u16* dst; int K, N, mat, k0, n0;
#define TR_DECODE(TR) { const int l_ = (TR) / 3040; int r_ = (TR) % 3040; int kt_, nt_; \
      if (r_ < 672) { mat = 0; K = 1024; N = 2688; src = p.in[11] + (size_t)l_ * K * N; dst = p.winT + (size_t)l_ * N * K; kt_ = r_ / 42; nt_ = r_ % 42; } \
      else if (r_ < 928) { r_ -= 672; mat = 1; K = 1024; N = 1024; src = p.in[26] + (size_t)l_ * K * N; dst = p.woutT + (size_t)l_ * N * K; kt_ = r_ / 16; nt_ = r_ % 16; } \
      else if (r_ < 2336) { r_ -= 928; mat = 2; K = 1024; N = 5632; src = p.in[29] + (size_t)l_ * K * N; dst = p.wfiT + (size_t)l_ * N * K; kt_ = r_ / 88; nt_ = r_ % 88; } \
      else { r_ -= 2336; mat = 3; K = 2816; N = 1024; src = p.in[30] + (size_t)l_ * K * N; dst = p.wfoT + (size_t)l_ * N * K; kt_ = r_ / 16; nt_ = r_ % 16; } \
      k0 = kt_ * 64; n0 = nt_ * 64; }
#define TR_LOAD(V, I) V = *reinterpret_cast<const float4*>(src + (size_t)(k0 + (tid >> 4) + 16 * (I)) * N + n0 + (tid & 15) * 4);
#define TR_PUT(V, I) { const int kr_ = (tid >> 4) + 16 * (I), c4_ = (tid & 15) * 4; \
      tile[kr_ * 65 + c4_ + 0] = V.x; tile[kr_ * 65 + c4_ + 1] = V.y; tile[kr_ * 65 + c4_ + 2] = V.z; tile[kr_ * 65 + c4_ + 3] = V.w; }
    int tr = tr_begin + w;
    if (tr < NT) { TR_DECODE(tr) TR_LOAD(cur0, 0) TR_LOAD(cur1, 1) TR_LOAD(cur2, 2) TR_LOAD(cur3, 3) }
    for (; tr < NT; tr += nw) {
      TR_PUT(cur0, 0) TR_PUT(cur1, 1) TR_PUT(cur2, 2) TR_PUT(cur3, 3)
      if (tr + nw < NT) { TR_DECODE(tr + nw) TR_LOAD(cur0, 0) TR_LOAD(cur1, 1) TR_LOAD(cur2, 2) TR_LOAD(cur3, 3) }
      TR_DECODE(tr)
      __syncthreads();
#pragma unroll
      for (int i = 0; i < 2; ++i) {
        const int idx = tid + 256 * i, nl = idx >> 3, kc = idx & 7;
        int n = n0 + nl;
        if (mat == 2) { const int isup = n >= DFF ? 1 : 0; const int j = n - isup * DFF; n = (j >> 4) * 32 + isup * 16 + (j & 15); }
        float v[8];
#pragma unroll
        for (int jj = 0; jj < 8; ++jj) v[jj] = tile[(kc * 8 + jj) * 65 + nl];
        pack8_store(dst + (size_t)n * K + k0 + kc * 8, v);
      }
      __syncthreads();
    }
#undef TR_DECODE
#undef TR_LOAD
#undef TR_PUT
}

__device__ void modreduce_phase(const Params& p, int bid, int nblk, int tidx, int idx_lo, int idx_hi) {
  for (int idx = idx_lo + bid * 256 + tidx; idx < idx_hi; idx += nblk * 256) {
    const int l = idx / 4608, rem = idx % 4608, mr = rem / 1536, c4 = (rem % 1536) * 4;
    float4 a = *reinterpret_cast<const float4*>(p.in[10] + (size_t)l * 6144 + c4);
    for (int k8 = 0; k8 < 32; k8 += 8) {
      float4 v[8];
#pragma unroll
      for (int u = 0; u < 8; ++u) v[u] = *reinterpret_cast<const float4*>(p.modp + (size_t)((l * 32 + k8 + u) * 3 + mr) * 6144 + c4);
#pragma unroll
      for (int u = 0; u < 8; ++u) { a.x += v[u].x; a.y += v[u].y; a.z += v[u].z; a.w += v[u].w; }
    }
    *reinterpret_cast<float4*>(p.mod + (size_t)(l * 3 + mr) * 6144 + c4) = a;
  }
}

template <int MODE>
__device__ void ln_phase(const Params& p, int layer, int bid, int nblk, int tidx) {
  const int lane = tidx & 63, wid = tidx >> 6;
  const bool fin = (MODE == 2 && layer == 3);
  const float* lw = (MODE == 1 ? p.in[27] : p.in[31]) + (size_t)layer * DM;
  const float* lb = (MODE == 1 ? p.in[28] : p.in[32]) + (size_t)layer * DM;
  const int ml = (MODE == 2) ? (layer + 1 < 4 ? layer + 1 : 3) : layer;
  const int which = (MODE == 1) ? 3 : 0;
#define LN_SRC(ROW) (MODE == 0 ? ((ROW) < NCTX ? p.in[0] + (size_t)(ROW) * DM : p.in[1] + (size_t)((ROW) - NCTX) * DM) : p.Y + (size_t)(ROW) * DM)
  float4 nv0, nv1, nv2, nv3;
  int it = bid;
  if (it < NTOK / 4) {
    const float4* s4 = reinterpret_cast<const float4*>(LN_SRC(it * 4 + wid));
    nv0 = s4[lane]; nv1 = s4[lane + 64]; nv2 = s4[lane + 128]; nv3 = s4[lane + 192];
  }
  for (; it < NTOK / 4; it += nblk) {
    const int row = it * 4 + wid;
    float4 v[4] = {nv0, nv1, nv2, nv3};
    if (it + nblk < NTOK / 4) {
      const float4* s4 = reinterpret_cast<const float4*>(LN_SRC((it + nblk) * 4 + wid));
      nv0 = s4[lane]; nv1 = s4[lane + 64]; nv2 = s4[lane + 128]; nv3 = s4[lane + 192];
    }
    float4 w4[4], b4[4], s4v[4], c4v[4];
    const float* sh = p.mod + ((size_t)(ml * 3 + modrow_of(row)) * 6 + which) * 1024;
    const float* sc = sh + 1024;
#pragma unroll
    for (int i = 0; i < 4; ++i) {
      if (MODE != 0) { w4[i] = reinterpret_cast<const float4*>(lw)[lane + 64 * i]; b4[i] = reinterpret_cast<const float4*>(lb)[lane + 64 * i]; }
      if (!fin) { s4v[i] = reinterpret_cast<const float4*>(sh)[lane + 64 * i]; c4v[i] = reinterpret_cast<const float4*>(sc)[lane + 64 * i]; }
    }
    if (MODE != 0) {
      float s = 0.f;
#pragma unroll
      for (int i = 0; i < 4; ++i) s += v[i].x + v[i].y + v[i].z + v[i].w;
      const float mu = wave_sum(s) * (1.f / 1024.f);
      float q = 0.f;
#pragma unroll
      for (int i = 0; i < 4; ++i) {
        v[i].x -= mu; v[i].y -= mu; v[i].z -= mu; v[i].w -= mu;
        q += v[i].x * v[i].x + v[i].y * v[i].y + v[i].z * v[i].z + v[i].w * v[i].w;
      }
      const float rstd = rsqrtf(wave_sum(q) * (1.f / 1024.f) + 1e-5f);
#pragma unroll
      for (int i = 0; i < 4; ++i) {
        v[i].x = v[i].x * rstd * w4[i].x + b4[i].x; v[i].y = v[i].y * rstd * w4[i].y + b4[i].y;
        v[i].z = v[i].z * rstd * w4[i].z + b4[i].z; v[i].w = v[i].w * rstd * w4[i].w + b4[i].w;
      }
    }
    float* xdst = (MODE == 1 ? p.X1 : p.X) + (size_t)row * DM;
#pragma unroll
    for (int i = 0; i < 4; ++i) reinterpret_cast<float4*>(xdst)[lane + 64 * i] = v[i];
    if (fin) {
      float* o = row < NCTX ? p.out_yp + (size_t)row * DM : p.out_ys + (size_t)(row - NCTX) * DM;
#pragma unroll
      for (int i = 0; i < 4; ++i) reinterpret_cast<float4*>(o)[lane + 64 * i] = v[i];
    } else {
      u16* adst = p.A + (size_t)row * DM;
#pragma unroll
      for (int i = 0; i < 4; ++i) {
        uint2 pk;
        pk.x = pack2(v[i].x * (1.f + c4v[i].x) + s4v[i].x, v[i].y * (1.f + c4v[i].y) + s4v[i].y);
        pk.y = pack2(v[i].z * (1.f + c4v[i].z) + s4v[i].z, v[i].w * (1.f + c4v[i].w) + s4v[i].w);
        reinterpret_cast<uint2*>(adst)[lane + 64 * i] = pk;
      }
    }
  }
#undef LN_SRC
}

#define FLD 772
#define LLD 392
__device__ void prep_phase(const Params& p, int layer, char* smem, int bid, int nblk, int tidx, int rep) {
  const int pv_ = rep ? PREPVAR : 0;
  float* F = reinterpret_cast<float*>(smem);
  u16* LIb = reinterpret_cast<u16*>(smem + 16 * FLD * 4);
  const float* cw = p.in[12] + (size_t)layer * 3 * 1152;
  const u16* LW = p.loraT + (size_t)layer * 98304;
  for (int it2 = bid; it2 < 2 * (NTOK / 16); it2 += nblk) {
    const bool doR = it2 < NTOK / 16;
    const int it = doR ? it2 : it2 - NTOK / 16;
    int tid = tidx;
    asm volatile("" : "+v"(tid));
    const int lane = tid & 63, wid = tid >> 6, fr = lane & 15, fq = lane >> 4;
    const int tok0 = it * 16;
    int b, tpos0, L;
    const bool isctx = tok0 < NCTX;
    if (isctx) { b = tok0 >> 8; tpos0 = tok0 & 255; L = 256; }
    else { const int tl = tok0 - NCTX; b = tl >> 10; tpos0 = tl & 1023; L = 1024; }
    if (doR) {
    {
      float* PRM = reinterpret_cast<float*>(smem + 61952);
      PRM[tid] = p.in[13][(size_t)layer * 512 + tid]; PRM[256 + tid] = p.in[13][(size_t)layer * 512 + 256 + tid];
      PRM[512 + tid] = p.in[15][(size_t)layer * 512 + tid]; PRM[768 + tid] = p.in[15][(size_t)layer * 512 + 256 + tid];
      PRM[1024 + tid] = p.in[18][(size_t)layer * 256 + tid]; PRM[1280 + tid] = p.in[19][(size_t)layer * 256 + tid]; PRM[1536 + tid] = p.in[20][(size_t)layer * 256 + tid];
    }
#pragma unroll 1
    for (int cg = tid; cg < 288; cg += 256) {
      const int c = cg * 4;
      const float4 w0 = *reinterpret_cast<const float4*>(cw + c);
      const float4 w1 = *reinterpret_cast<const float4*>(cw + 1152 + c);
      const float4 w2 = *reinterpret_cast<const float4*>(cw + 2304 + c);
      const float* pr = p.PROJ + (size_t)tok0 * DIN + c;
      float4 x[18];
#pragma unroll
      for (int i = 0; i < 18; ++i) {
        const int tpos = tpos0 + i - 1;
        x[i] = (tpos >= 0 && tpos < L) ? *reinterpret_cast<const float4*>(pr + (ptrdiff_t)(i - 1) * DIN) : make_float4(0.f, 0.f, 0.f, 0.f);
      }
#pragma unroll
      for (int tt = 0; tt < 16; ++tt) {
        float4 f;
        f.x = w0.x * x[tt].x + w1.x * x[tt + 1].x + w2.x * x[tt + 2].x;
        f.y = w0.y * x[tt].y + w1.y * x[tt + 1].y + w2.y * x[tt + 2].y;
        f.z = w0.z * x[tt].z + w1.z * x[tt + 1].z + w2.z * x[tt + 2].z;
        f.w = w0.w * x[tt].w + w1.w * x[tt + 1].w + w2.w * x[tt + 2].w;
        if (c < 768) { *reinterpret_cast<float4*>(F + tt * FLD + c) = f; }
        else {
          const int cc = c - 768;
          if (cc < 128) { f.x = tanhf_(f.x); f.y = tanhf_(f.y); f.z = tanhf_(f.z); f.w = tanhf_(f.w); }
          else if (cc >= 256) { f.x = sigmoidf_(f.x); f.y = sigmoidf_(f.y); f.z = sigmoidf_(f.z); f.w = sigmoidf_(f.w); }
          uint2 pk; pk.x = pack2(f.x, f.y); pk.y = pack2(f.z, f.w);
          *reinterpret_cast<uint2*>(LIb + tt * LLD + cc) = pk;
        }
      }
    }
    __syncthreads();
    f32x4 acc[5][4];
#pragma unroll
    for (int g = 0; g < 5; ++g)
#pragma unroll
      for (int nf = 0; nf < 4; ++nf) acc[g][nf] = (f32x4){0.f, 0.f, 0.f, 0.f};
    if (pv_ != 2 && pv_ != 3) {
#define PB_LOAD(W, GI) { const u16* wt_ = (GI) < 4 ? LW + (size_t)(GI) * 16384 : LW + 65536; const int rs_ = (GI) < 4 ? 64 : 128; const int ko_ = (GI) < 4 ? 0 : ((GI) - 4) * 64; \
      _Pragma("unroll") for (int ks_ = 0; ks_ < 2; ++ks_) _Pragma("unroll") for (int nf_ = 0; nf_ < 4; ++nf_) \
        W[ks_ * 4 + nf_] = *reinterpret_cast<const bf16x8*>(wt_ + (size_t)(64 * wid + 16 * nf_ + fr) * rs_ + ko_ + ks_ * 32 + fq * 8); }
#define PB_MMA(W, GI) { const int ai_ = (GI) < 4 ? (GI) : 4; const int xo_ = (GI) < 4 ? (GI) * 64 : 256 + ((GI) - 4) * 64; \
      _Pragma("unroll") for (int ks_ = 0; ks_ < 2; ++ks_) { \
        const bf16x8 xb_ = *reinterpret_cast<const bf16x8*>(LIb + fr * LLD + xo_ + ks_ * 32 + fq * 8); \
        _Pragma("unroll") for (int nf_ = 0; nf_ < 4; ++nf_) acc[ai_][nf_] = __builtin_amdgcn_mfma_f32_16x16x32_bf16(W[ks_ * 4 + nf_], xb_, acc[ai_][nf_], 0, 0, 0); } \
      __builtin_amdgcn_sched_barrier(0); }
    {
      bf16x8 wA[8], wB[8];
      PB_LOAD(wA, 0)
      PB_LOAD(wB, 1) PB_MMA(wA, 0)
      PB_LOAD(wA, 2) PB_MMA(wB, 1)
      PB_LOAD(wB, 3) PB_MMA(wA, 2)
      PB_LOAD(wA, 4) PB_MMA(wB, 3)
      PB_LOAD(wB, 5) PB_MMA(wA, 4)
      PB_MMA(wB, 5)
    }
#undef PB_LOAD
#undef PB_MMA
    }
    if (pv_ != 2 && pv_ != 3) {
#ifndef NO_C
    const float* PRM = reinterpret_cast<const float*>(smem + 61952);
    {
      const int tok = tok0 + fr;
      float ss = 0.f, bs = 0.f;
#pragma unroll
      for (int nf = 0; nf < 4; ++nf) {
        const int c0 = 64 * wid + 16 * nf + 4 * fq;
        const float4 r4 = *reinterpret_cast<const float4*>(F + fr * FLD + c0);
        const float4 k4 = *reinterpret_cast<const float4*>(F + fr * FLD + 256 + c0);
        const float4 w00 = *reinterpret_cast<const float4*>(PRM + c0);
        const float4 w01 = *reinterpret_cast<const float4*>(PRM + 256 + c0);
        const float4 a00 = *reinterpret_cast<const float4*>(PRM + 512 + c0);
        const float4 a01 = *reinterpret_cast<const float4*>(PRM + 768 + c0);
        const float4 kkw = *reinterpret_cast<const float4*>(PRM + 1024 + c0);
        const float4 kaw = *reinterpret_cast<const float4*>(PRM + 1280 + c0);
        const float4 rkw = *reinterpret_cast<const float4*>(PRM + 1536 + c0);
        const float rr[4] = {r4.x, r4.y, r4.z, r4.w}, kk_[4] = {k4.x, k4.y, k4.z, k4.w};
        const float w0a[4] = {w00.x, w00.y, w00.z, w00.w}, w0b[4] = {w01.x, w01.y, w01.z, w01.w};
        const float a0a[4] = {a00.x, a00.y, a00.z, a00.w}, a0b[4] = {a01.x, a01.y, a01.z, a01.w};
        const float kkw_[4] = {kkw.x, kkw.y, kkw.z, kkw.w}, kaw_[4] = {kaw.x, kaw.y, kaw.z, kaw.w}, rkw_[4] = {rkw.x, rkw.y, rkw.z, rkw.w};
#pragma unroll
        for (int r = 0; r < 4; ++r) {
          {
            const float z = -(w0a[r] + acc[0][nf][r]);
            const float sp = fmaxf(z, 0.f) + __logf(1.f + __expf(-fabsf(z)));
            acc[0][nf][r] = __expf(-__expf(-sp - 0.5f));
          }
          {
            const float z = -(w0b[r] + acc[1][nf][r]);
            const float sp = fmaxf(z, 0.f) + __logf(1.f + __expf(-fabsf(z)));
            acc[1][nf][r] = __expf(-__expf(-sp - 0.5f));
          }
          const float av0 = sigmoidf_(a0a[r] + acc[2][nf][r]);
          const float av1 = sigmoidf_(a0b[r] + acc[3][nf][r]);
          acc[2][nf][r] = av0; acc[3][nf][r] = av1;
          const float k = kk_[r];
          const float kq = k * kkw_[r];
          ss += kq * kq;
          const float kd0 = k * (1.f + (av0 - 1.f) * kaw_[r]);
          const float kd1 = k * (1.f + (av1 - 1.f) * kaw_[r]);
          bs += rr[r] * (kd0 + kd1) * rkw_[r];
        }
        __builtin_amdgcn_sched_barrier(0);
      }
      ss += __shfl_xor(ss, 16); ss += __shfl_xor(ss, 32);
      bs += __shfl_xor(bs, 16); bs += __shfl_xor(bs, 32);
      const float inrm = 1.f / fmaxf(sqrtf(ss), 1e-12f);
#pragma unroll
      for (int nf = 0; nf < 4; ++nf) {
        const int c0 = 64 * wid + 16 * nf + 4 * fq, n0 = 16 * nf + 4 * fq;
        const float4 r4 = *reinterpret_cast<const float4*>(F + fr * FLD + c0);
        const float4 k4 = *reinterpret_cast<const float4*>(F + fr * FLD + 256 + c0);
        const float4 v4 = *reinterpret_cast<const float4*>(F + fr * FLD + 512 + c0);
        const float4 kkw = *reinterpret_cast<const float4*>(PRM + 1024 + c0);
        const float4 kaw = *reinterpret_cast<const float4*>(PRM + 1280 + c0);
        const float kk_[4] = {k4.x, k4.y, k4.z, k4.w}, kkw_[4] = {kkw.x, kkw.y, kkw.z, kkw.w}, kaw_[4] = {kaw.x, kaw.y, kaw.z, kaw.w};
        float* sc = p.SC + ((size_t)(tok * 4 + wid) * 9) * 64 + n0;
        float kn[4], kd0[4], kd1[4];
#pragma unroll
        for (int r = 0; r < 4; ++r) {
          kn[r] = kk_[r] * kkw_[r] * inrm;
          kd0[r] = kk_[r] * (1.f + (acc[2][nf][r] - 1.f) * kaw_[r]);
          kd1[r] = kk_[r] * (1.f + (acc[3][nf][r] - 1.f) * kaw_[r]);
        }
        *reinterpret_cast<float4*>(sc) = r4;
        *reinterpret_cast<float4*>(sc + 64) = make_float4(kn[0], kn[1], kn[2], kn[3]);
        *reinterpret_cast<float4*>(sc + 128) = v4;
        *reinterpret_cast<float4*>(sc + 192) = make_float4(acc[0][nf][0], acc[0][nf][1], acc[0][nf][2], acc[0][nf][3]);
        *reinterpret_cast<float4*>(sc + 256) = make_float4(acc[2][nf][0] * kn[0], acc[2][nf][1] * kn[1], acc[2][nf][2] * kn[2], acc[2][nf][3] * kn[3]);
        *reinterpret_cast<float4*>(sc + 320) = make_float4(kd0[0], kd0[1], kd0[2], kd0[3]);
        *reinterpret_cast<float4*>(sc + 384) = make_float4(acc[1][nf][0], acc[1][nf][1], acc[1][nf][2], acc[1][nf][3]);
        *reinterpret_cast<float4*>(sc + 448) = make_float4(acc[3][nf][0] * kn[0], acc[3][nf][1] * kn[1], acc[3][nf][2] * kn[2], acc[3][nf][3] * kn[3]);
        *reinterpret_cast<float4*>(sc + 512) = make_float4(kd1[0], kd1[1], kd1[2], kd1[3]);
        *reinterpret_cast<float4*>(p.G + (size_t)tok * 256 + c0) = make_float4(acc[4][nf][0], acc[4][nf][1], acc[4][nf][2], acc[4][nf][3]);
        *reinterpret_cast<float4*>(p.BV + (size_t)tok * 256 + c0) = make_float4(bs * v4.x, bs * v4.y, bs * v4.z, bs * v4.w);
        __builtin_amdgcn_sched_barrier(0);
      }
    }
#endif
    }
    }
    if (!doR && pv_ != 1) {
#ifndef NO_D
    {
      const int tok = tid >> 4, g8 = tid & 15, tokg = tok0 + tok, tpos = tpos0 + tok;
      const int tkey = isctx ? tpos : 512 + tpos;
      const float* pr = p.PROJ + (size_t)tokg * DIN;
#pragma unroll
      for (int hh = 0; hh < 2; ++hh) {
        const int g = g8 + 16 * hh, c0 = g * 8, hd = c0 >> 6, d0 = c0 & 63;
        const float4 qa = *reinterpret_cast<const float4*>(pr + 1152 + c0), qb = *reinterpret_cast<const float4*>(pr + 1152 + c0 + 4);
        const float4 ka = *reinterpret_cast<const float4*>(pr + 1408 + c0), kb2 = *reinterpret_cast<const float4*>(pr + 1408 + c0 + 4);
        const float qv[8] = {qa.x * QSCALE, qa.y * QSCALE, qa.z * QSCALE, qa.w * QSCALE, qb.x * QSCALE, qb.y * QSCALE, qb.z * QSCALE, qb.w * QSCALE};
        const float kv[8] = {ka.x, ka.y, ka.z, ka.w, kb2.x, kb2.y, kb2.z, kb2.w};
        if (isctx) {
          float* ok = p.out_nak + ((size_t)(b * 4 + layer) * 256 + tpos) * 256 + c0;
          *reinterpret_cast<float4*>(ok) = ka; *reinterpret_cast<float4*>(ok + 4) = kb2;
          pack8_store(p.QNc + (size_t)tokg * 256 + c0, qv);
          pack8_store(p.KNc + (size_t)(b * 4 + hd) * 16384 + kf_off(tkey, d0), kv);
        } else {
          pack8_store(p.QNl + (size_t)(tokg - NCTX) * 256 + c0, qv);
          pack8_store(p.KNl + ((size_t)((layer * 2 + b) * 4 + hd)) * 98304 + kf_off(tkey, d0), kv);
        }
      }
#pragma unroll
      for (int hh = 0; hh < 5; ++hh) {
        const bool isk = (hh == 4);
        const int g = isk ? g8 : g8 + 16 * hh, d0 = (g & 7) * 8, hd = g >> 3;
        const float* src = pr + (isk ? 2432 : 1920) + g * 8;
        const float4 xa = *reinterpret_cast<const float4*>(src), xb = *reinterpret_cast<const float4*>(src + 4);
        const float* nw = (isk ? p.in[25] : p.in[24]) + (size_t)layer * 64 + d0;
        const float4 na = *reinterpret_cast<const float4*>(nw), nb = *reinterpret_cast<const float4*>(nw + 4);
        float x[8] = {xa.x, xa.y, xa.z, xa.w, xb.x, xb.y, xb.z, xb.w};
        const float nrm[8] = {na.x, na.y, na.z, na.w, nb.x, nb.y, nb.z, nb.w};
        float ss = 0.f;
#pragma unroll
        for (int e = 0; e < 8; ++e) ss += x[e] * x[e];
        ss += dpp_mov<0xB1>(ss); ss += dpp_mov<0x4E>(ss); ss += dpp_mov<0x141>(ss);
        const float rs = rsqrtf(ss * (1.f / 64.f) + 1e-6f);
#pragma unroll
        for (int e = 0; e < 8; ++e) x[e] = x[e] * rs * nrm[e];
        if (isk && isctx) {
          float* ok = p.out_gk + ((size_t)(b * 4 + layer) * 256 + tpos) * 128 + g * 8;
          *reinterpret_cast<float4*>(ok) = make_float4(x[0], x[1], x[2], x[3]);
          *reinterpret_cast<float4*>(ok + 4) = make_float4(x[4], x[5], x[6], x[7]);
        }
        if (!isctx) {
          const int pos = (d0 < 32) ? (tpos >> 6) : (tpos & 63);
          const float4* rt = reinterpret_cast<const float4*>(p.rope + (size_t)(pos * 16 + (d0 & 15)) * 2);
          const float4 r0 = rt[0], r1 = rt[1], r2 = rt[2], r3 = rt[3];
          const float cs[8] = {r0.x, r0.z, r1.x, r1.z, r2.x, r2.z, r3.x, r3.z};
          const float sn[8] = {r0.y, r0.w, r1.y, r1.w, r2.y, r2.w, r3.y, r3.w};
          const float sg = (d0 & 16) ? 1.f : -1.f;
#pragma unroll
          for (int e = 0; e < 8; ++e) { const float pe = dpp_mov<0x4E>(x[e]); x[e] = x[e] * cs[e] + sg * pe * sn[e]; }
        }
        if (!isk) {
#pragma unroll
          for (int e = 0; e < 8; ++e) x[e] *= QSCALE;
          if (isctx) pack8_store(p.QGc + (size_t)tokg * 512 + g * 8, x);
          else pack8_store(p.QGl + (size_t)(tokg - NCTX) * 512 + g * 8, x);
        } else {
          if (isctx) pack8_store(p.KGc + (size_t)(b * 2 + hd) * 16384 + kf_off(tkey, d0), x);
          else pack8_store(p.KGl + ((size_t)((layer * 2 + b) * 2 + hd)) * 98304 + kf_off(tkey, d0), x);
        }
      }
    }
    const int c = tid;
#pragma unroll
    for (int half = 0; half < 2; ++half) {
      float vv[8];
#pragma unroll
      for (int t8 = 0; t8 < 8; ++t8) {
        const int tt = half * 8 + t8, tokn = tok0 + tt;
        const float v = p.PROJ[(size_t)tokn * DIN + 1664 + c];
        vv[t8] = v;
        if (isctx) p.out_nav[((size_t)(b * 4 + layer) * 256 + tpos0 + tt) * 256 + c] = v;
      }
      if (isctx) pack44_store(p.VNtc + (size_t)(b * 4 + (c >> 6)) * 16384, tpos0 + half * 8, c & 63, vv);
      else pack44_store(p.VNtl + ((size_t)((layer * 2 + b) * 4 + (c >> 6))) * 98304, 512 + tpos0 + half * 8, c & 63, vv);
    }
    if (wid >= 2) {
      const int cv = c - 128;
#pragma unroll
      for (int half = 0; half < 2; ++half) {
        float vv[8];
#pragma unroll
        for (int t8 = 0; t8 < 8; ++t8) {
          const int tt = half * 8 + t8, tokn = tok0 + tt;
          const float v = p.PROJ[(size_t)tokn * DIN + 2560 + cv];
          vv[t8] = v;
          if (isctx) p.out_gv[((size_t)(b * 4 + layer) * 256 + tpos0 + tt) * 128 + cv] = v;
        }
        if (isctx) pack44_store(p.VGtc + (size_t)(b * 2 + (cv >> 6)) * 16384, tpos0 + half * 8, cv & 63, vv);
        else pack44_store(p.VGtl + ((size_t)((layer * 2 + b) * 2 + (cv >> 6))) * 98304, 512 + tpos0 + half * 8, cv & 63, vv);
      }
    }
#endif
    }
    __syncthreads();
  }
}

#define ATT_LOAD(KF, VF, CI) { \
    const int ci_ = min((CI), nt - 1); \
    int kb_; \
    if (ci_ < nd) kb_ = ci_ * 32; \
    else { const int e_ = ci_ - nd; const int j_ = (ncc == 2) ? (e_ >> 1) : e_; const int cc_ = cc0 + ((ncc == 2) ? (e_ & 1) : 0); kb_ = 512 + (rb + j_) * 64 + cc_ * 32; } \
    const u16* kp_ = Kb + (size_t)(kb_ >> 4) * 1024 + lane * 8; \
    KF##00 = *reinterpret_cast<const bf16x8*>(kp_); \
    KF##01 = *reinterpret_cast<const bf16x8*>(kp_ + 512); \
    KF##10 = *reinterpret_cast<const bf16x8*>(kp_ + 1024); \
    KF##11 = *reinterpret_cast<const bf16x8*>(kp_ + 1536); \
    const u16* vp_ = Vt + (size_t)(kb_ >> 5) * 2048 + lane * 8; \
    VF##0 = *reinterpret_cast<const bf16x8*>(vp_); \
    VF##1 = *reinterpret_cast<const bf16x8*>(vp_ + 512); \
    VF##2 = *reinterpret_cast<const bf16x8*>(vp_ + 1024); \
    VF##3 = *reinterpret_cast<const bf16x8*>(vp_ + 1536); }

#define ATT_PV(DT, VV) { \
    o[DT][0] *= alpha; o[DT][1] *= alpha; o[DT][2] *= alpha; o[DT][3] *= alpha; \
    o[DT] = __builtin_amdgcn_mfma_f32_16x16x32_bf16(VV, pf.v, o[DT], 0, 0, 0); }

#define ATT_COMPUTE(KF, VF, CI) { \
    const int ci_ = (CI); \
    f32x4 s0 = (f32x4){0.f, 0.f, 0.f, 0.f}, s1 = (f32x4){0.f, 0.f, 0.f, 0.f}; \
    s0 = __builtin_amdgcn_mfma_f32_16x16x32_bf16(KF##00, qf0, s0, 0, 0, 0); \
    s0 = __builtin_amdgcn_mfma_f32_16x16x32_bf16(KF##01, qf1, s0, 0, 0, 0); \
    s1 = __builtin_amdgcn_mfma_f32_16x16x32_bf16(KF##10, qf0, s1, 0, 0, 0); \
    s1 = __builtin_amdgcn_mfma_f32_16x16x32_bf16(KF##11, qf1, s1, 0, 0, 0); \
    float sv[8] = {s0[0], s0[1], s0[2], s0[3], s1[0], s1[1], s1[2], s1[3]}; \
    bool ok[8]; \
    _Pragma("unroll") for (int e = 0; e < 8; ++e) ok[e] = true; \
    if (ci_ >= nd) { \
      const int e_ = ci_ - nd; const int j_ = (ncc == 2) ? (e_ >> 1) : e_; const int cc_ = cc0 + ((ncc == 2) ? (e_ & 1) : 0); \
      const int dr_ = rb + j_ - grow + 7; \
      const int cq = cq0 + fr, c0 = min(max(cq - 8, 0), 48); \
      _Pragma("unroll") for (int e = 0; e < 8; ++e) { \
        const int ck = cc_ * 32 + 16 * (e >> 2) + 4 * fq + (e & 3); \
        ok[e] = (ck >= c0) && (ck < c0 + 16); \
        const int dc = min(max(ck - cq, -15), 15) + 15; \
        const float bias = rpb[dr_ * 31 + dc] * LOG2E; \
        sv[e] = ok[e] ? sv[e] + bias : -1e30f; \
      } \
    } \
    float mx = fmaxf(fmaxf(fmaxf(sv[0], sv[1]), fmaxf(sv[2], sv[3])), fmaxf(fmaxf(sv[4], sv[5]), fmaxf(sv[6], sv[7]))); \
    mx = fmaxf(mx, __shfl_xor(mx, 16)); \
    mx = fmaxf(mx, __shfl_xor(mx, 32)); \
    const float mn = fmaxf(m, mx); \
    const float alpha = __builtin_amdgcn_exp2f(m - mn); \
    m = mn; \
    float ps = 0.f; \
    _Pragma("unroll") for (int e = 0; e < 8; ++e) { sv[e] = ok[e] ? __builtin_amdgcn_exp2f(sv[e] - mn) : 0.f; ps += sv[e]; } \
    l = l * alpha + ps; \
    union { bf16x8 v; unsigned u[4]; } pf; \
    pf.u[0] = pack2(sv[0], sv[1]); pf.u[1] = pack2(sv[2], sv[3]); pf.u[2] = pack2(sv[4], sv[5]); pf.u[3] = pack2(sv[6], sv[7]); \
    ATT_PV(0, VF##0) ATT_PV(1, VF##1) ATT_PV(2, VF##2) ATT_PV(3, VF##3) }

__device__ __forceinline__ void attn_wave(const u16* __restrict__ Q, int ldq, const u16* __restrict__ Kb, int ldk,
                                          const u16* __restrict__ Vt, int ldv, int ndense, const bool NA,
                                          const float* __restrict__ rpb, int grow, int cq0,
                                          u16* __restrict__ out, int ldo, int tidx) {
  const int lane = tidx & 63, fr = lane & 15, fq = lane >> 4;
  const bf16x8 qf0 = *reinterpret_cast<const bf16x8*>(Q + (size_t)fr * ldq + fq * 8);
  const bf16x8 qf1 = *reinterpret_cast<const bf16x8*>(Q + (size_t)fr * ldq + 32 + fq * 8);
  f32x4 o[4];
#pragma unroll
  for (int dt = 0; dt < 4; ++dt) o[dt] = (f32x4){0.f, 0.f, 0.f, 0.f};
  float m = -1e30f, l = 0.f;
  const int nd = ndense >> 5;
  const int rb = min(max(grow - 4, 0), 8);
  const int ulo = min(max(cq0 - 8, 0), 48), uhi = min(max(cq0 + 15 - 8, 0), 48) + 16;
  const bool c0ok = ulo < 32, c1ok = uhi > 32;
  const int ncc = (c0ok && c1ok) ? 2 : 1, cc0 = c0ok ? 0 : 1;
  const int nt = nd + (NA ? 8 * ncc : 0);
  bf16x8 ka00, ka01, ka10, ka11, kb00, kb01, kb10, kb11;
  bf16x8 va0, va1, va2, va3, vb0, vb1, vb2, vb3;
  ATT_LOAD(ka, va, 0)
  for (int ci = 0; ci < nt; ci += 2) {
    ATT_LOAD(kb, vb, ci + 1)
    ATT_COMPUTE(ka, va, ci)
    if (ci + 1 < nt) {
      ATT_LOAD(ka, va, ci + 2)
      ATT_COMPUTE(kb, vb, ci + 1)
    }
  }
  l += __shfl_xor(l, 16);
  l += __shfl_xor(l, 32);
  const float il = 1.f / l;
#pragma unroll
  for (int dt = 0; dt < 4; ++dt) {
    uint2 pk; pk.x = pack2(o[dt][0] * il, o[dt][1] * il); pk.y = pack2(o[dt][2] * il, o[dt][3] * il);
    *reinterpret_cast<uint2*>(out + (size_t)fr * ldo + 16 * dt + 4 * fq) = pk;
  }
}

__device__ void scan_item(const Params& p, int layer, char* smem, bool lat, int b, int h, int dir, int qd, int tidx) {
  const int tid = tidx, lane = tid & 63, wid = tid >> 6, rr = lane >> 4, j = lane & 15;
  const int L = lat ? 1024 : 256, seqbase = lat ? NCTX + b * 1024 : b * 256;
  const int rowl = wid * 4 + rr, row = qd * 16 + rowl;
  float* cbuf = reinterpret_cast<float*>(smem);
  float* obuf = cbuf + 2 * 16 * 6 * 64;
  float4 S = make_float4(0.f, 0.f, 0.f, 0.f);
  if (lat) S = *reinterpret_cast<const float4*>(p.in[2] + ((((size_t)(b * 4 + layer) * 2 + dir) * 4 + h) * 64 + row) * 64 + 4 * j);
  v2f S01 = (v2f){S.x, S.y}, S23 = (v2f){S.z, S.w};
  const int nch = L / 16;
  float* odst = dir == 0 ? p.OF : p.OB;
  float4 pre0, pre1, pre2, pre3, pre4, pre5;
  const ptrdiff_t cstep = (dir == 0 ? 1 : -1) * (ptrdiff_t)(16 * 4 * 9 * 64);
  const float *gp0, *gp1, *gp2, *gp3, *gp4, *gp5;
#define SC_GP(GP, I) { const int idx = tid + 256 * (I), tt_ = idx / 96, rem = idx % 96, vec = rem >> 4, f4 = rem & 15; \
    const int t_ = dir == 0 ? tt_ : L - 1 - tt_; const int svec = vec < 3 ? vec : vec + 3 * dir; \
    GP = p.SC + ((size_t)((seqbase + t_) * 4 + h) * 9 + svec) * 64 + f4 * 4; }
  SC_GP(gp0, 0) SC_GP(gp1, 1) SC_GP(gp2, 2) SC_GP(gp3, 3) SC_GP(gp4, 4) SC_GP(gp5, 5)
#define SC_GL1(PR, GP, CH) PR = *reinterpret_cast<const float4*>(GP + (ptrdiff_t)(CH) * cstep);
#define gload(CH) { SC_GL1(pre0, gp0, CH) SC_GL1(pre1, gp1, CH) SC_GL1(pre2, gp2, CH) SC_GL1(pre3, gp3, CH) SC_GL1(pre4, gp4, CH) SC_GL1(pre5, gp5, CH) }
#define SC_LS1(PR, I, BUF) *reinterpret_cast<float4*>(cbuf + (BUF) * 6144 + (tid + 256 * (I)) * 4) = PR;
#define lstore(BUF) { SC_LS1(pre0, 0, BUF) SC_LS1(pre1, 1, BUF) SC_LS1(pre2, 2, BUF) SC_LS1(pre3, 3, BUF) SC_LS1(pre4, 4, BUF) SC_LS1(pre5, 5, BUF) }
  gload(0); lstore(0);
  __syncthreads();
#define SC_LD(R4, K4, VV, W4, A4, D4, TT) { const float* base_ = cb + (TT) * 384; \
    R4 = *reinterpret_cast<const float4*>(base_ + 4 * j); K4 = *reinterpret_cast<const float4*>(base_ + 64 + 4 * j); \
    VV = base_[128 + row]; W4 = *reinterpret_cast<const float4*>(base_ + 192 + 4 * j); \
    A4 = *reinterpret_cast<const float4*>(base_ + 256 + 4 * j); D4 = *reinterpret_cast<const float4*>(base_ + 320 + 4 * j); }
#if SCANVAR
  for (int pass_ = 0; pass_ < (lat ? 2 : 1); ++pass_) {
  int var_ = pass_ ? SCANVAR : 0;
  asm volatile("" : "+v"(var_)); var_ = __builtin_amdgcn_readfirstlane(var_);
#else
  const int var_ = 0;
#endif
  for (int ch = 0; ch < nch; ++ch) {
    if (ch + 1 < nch && var_ != 3) gload(ch + 1);
    const float* cb = cbuf + (ch & 1) * 6144;
    float osel = 0.f;
    float4 r4, kk4, w4, ak4, kd4; float vv;
    SC_LD(r4, kk4, vv, w4, ak4, kd4, 0)
    if (var_ != 2)
#pragma unroll
    for (int hf = 0; hf < 2; ++hf) {
      float oqA = 0.f, oqB = 0.f, ovp = 0.f;
#pragma unroll
      for (int u = 0; u < 8; ++u) {
        const int tt = hf * 8 + u;
        float4 r4n, kk4n, w4n, ak4n, kd4n; float vvn;
        SC_LD(r4n, kk4n, vvn, w4n, ak4n, kd4n, tt + 1)
        v2f p = S01 * (v2f){kk4.x, kk4.y};
        p = S23 * (v2f){kk4.z, kk4.w} + p;
        float sk = p.x + p.y;
        sk += dpp_mov<0xB1>(sk);  ovp += dpp_mov<0xB1>(ovp);
        sk += dpp_mov<0x4E>(sk);  ovp += dpp_mov<0x4E>(ovp);
        sk += dpp_mov<0x141>(sk);
        sk += dpp_mov<0x140>(sk);
        if (u > 0) {
          if (((u - 1) >> 2) == 0) oqA = ((j & 3) == ((u - 1) & 3)) ? ovp : oqA;
          else oqB = ((j & 3) == ((u - 1) & 3)) ? ovp : oqB;
        }
        const v2f vv2 = (v2f){vv, vv}, sk2 = (v2f){sk, sk};
        v2f t01 = (v2f){kd4.x, kd4.y} * vv2; t01 = t01 - (v2f){ak4.x, ak4.y} * sk2;
        v2f t23 = (v2f){kd4.z, kd4.w} * vv2; t23 = t23 - (v2f){ak4.z, ak4.w} * sk2;
        S01 = S01 * (v2f){w4.x, w4.y} + t01;
        S23 = S23 * (v2f){w4.z, w4.w} + t23;
        v2f q = S01 * (v2f){r4.x, r4.y};
        q = S23 * (v2f){r4.z, r4.w} + q;
        ovp = q.x + q.y;
        r4 = r4n; kk4 = kk4n; w4 = w4n; ak4 = ak4n; kd4 = kd4n; vv = vvn;
      }
      ovp += dpp_mov<0xB1>(ovp); ovp += dpp_mov<0x4E>(ovp);
      oqB = ((j & 3) == 3) ? ovp : oqB;
      oqA += dpp_mov<0x128>(oqA); oqB += dpp_mov<0x128>(oqB);
      oqA += dpp_mov<0x124>(oqA); oqB += dpp_mov<0x124>(oqB);
      if ((j >> 3) == hf) osel = ((j >> 2) & 1) ? oqB : oqA;
    }
    if (var_ == 0) {
      const int st = ch * 16 + j, t = dir == 0 ? st : L - 1 - st;
      odst[(size_t)(seqbase + t) * 256 + h * 64 + row] = osel;
    } else asm volatile("" :: "v"(osel), "v"(S01), "v"(S23));
    if (ch + 1 < nch && var_ != 3) lstore((ch + 1) & 1);
    asm volatile("s_waitcnt lgkmcnt(0)" ::: "memory");
    __builtin_amdgcn_s_barrier();
  }
#if SCANVAR
  }
#endif
  if (!lat) *reinterpret_cast<float4*>(p.out_st + ((((size_t)(b * 4 + layer) * 2 + dir) * 4 + h) * 64 + row) * 64 + 4 * j) = make_float4(S01.x, S01.y, S23.x, S23.y);
  __syncthreads();
}

__device__ void mixer_phase(const Params& p, int layer_wq, char* smem, int tidx0) {
  const int layer = layer_wq & 3;
  int* slot = reinterpret_cast<int*>(smem + 60 * 1024);
  bool first = true;
  for (;;) {
    int tidx = tidx0;
    asm volatile("" : "+v"(tidx));
    const int tid = tidx, wid = tid >> 6;
    __syncthreads();
    if (tid == 0) {
      int nx;
      const int bx = (int)blockIdx.x;
      if (gridDim.x != 512) nx = first ? bx : (int)(gridDim.x + atomicAdd(&p.wq[layer_wq], 1u));
      else if (first) nx = (bx >= 256 && bx < 320) ? 1728 : bx;
      else { const int d = (int)atomicAdd(&p.wq[layer_wq], 1u); nx = d < 64 ? 256 + d : 448 + d; }
      *slot = nx;
    }
    first = false;
    __syncthreads();
    int it = *slot;
    if (it >= 1728) break;
    const bool is_scan = (it < 64) || (it >= 448 && it < 960);
#if REPMASK
    if ((p.pad == 1 && !is_scan) || (p.pad == 2 && is_scan) || ((p.pad == 3 || p.pad == 5 || p.pad == 6) && !(it < 64)) || (p.pad == 4 && !(it >= 64 && it < 320))) continue;
#endif
    if (is_scan) {
      const bool lat = it < 64;
      const int si = lat ? it : it - 448;
#ifndef NO_SCAN
      scan_item(p, layer, smem, lat, si / 32, (si / 8) % 4, (si / 4) % 2, si % 4, tidx);
#endif
      continue;
    }
    const u16 *Q, *Kb, *Vt; u16* out; int ldq, ldk, ldv, ndense, grow = 0, cq0 = 0; bool na = false;
    const float* rpb = p.in[23];
    if (it < 320) {
      it -= 64;
      const int b = it / 128, qh = (it / 16) % 8, qt = it % 16, kvh = qh >> 2;
      const int q0 = b * 1024 + qt * 64 + wid * 16;
      Q = p.QGl + (size_t)q0 * 512 + qh * 64; ldq = 512;
      Kb = p.KGl + (size_t)((layer * 2 + b) * 2 + kvh) * 98304; ldk = 0;
      Vt = p.VGtl + (size_t)((layer * 2 + b) * 2 + kvh) * 98304; ldv = 0; ndense = 1536;
      out = p.MIX + (size_t)(NCTX + q0) * DM + 512 + qh * 64;
    } else if (it < 448) {
      it -= 320;
      const int b = it / 64, h = (it / 16) % 4, r = it % 16;
      const int q0 = b * 1024 + r * 64 + wid * 16;
      Q = p.QNl + (size_t)q0 * 256 + h * 64; ldq = 256;
      Kb = p.KNl + (size_t)((layer * 2 + b) * 4 + h) * 98304; ldk = 0;
      Vt = p.VNtl + (size_t)((layer * 2 + b) * 4 + h) * 98304; ldv = 0; ndense = 512;
      rpb = p.in[23] + (size_t)(layer * 4 + h) * 15 * 31; grow = r; cq0 = wid * 16; na = true;
      out = p.MIX + (size_t)(NCTX + q0) * DM + 256 + h * 64;
    } else if (it < 1472) {
      it -= 960;
      const int b = it / 32, qh = (it / 4) % 8, qt = it % 4, kvh = qh >> 2;
      const int q0 = b * 256 + qt * 64 + wid * 16;
      Q = p.QGc + (size_t)q0 * 512 + qh * 64; ldq = 512;
      Kb = p.KGc + (size_t)(b * 2 + kvh) * 16384; ldk = 0;
      Vt = p.VGtc + (size_t)(b * 2 + kvh) * 16384; ldv = 0; ndense = 256;
      out = p.MIX + (size_t)q0 * DM + 512 + qh * 64;
    } else {
      it -= 1472;
      const int b = it / 16, h = (it / 4) % 4, qt = it % 4;
      const int q0 = b * 256 + qt * 64 + wid * 16;
      Q = p.QNc + (size_t)q0 * 256 + h * 64; ldq = 256;
      Kb = p.KNc + (size_t)(b * 4 + h) * 16384; ldk = 0;
      Vt = p.VNtc + (size_t)(b * 4 + h) * 16384; ldv = 0; ndense = 256;
      out = p.MIX + (size_t)q0 * DM + 256 + h * 64;
    }
#ifndef NO_ATT
    attn_wave(Q, ldq, Kb, ldk, Vt, ldv, ndense, na, rpb, grow, cq0, out, DM, tidx);
#endif
  }
}

__device__ void rwkv_fin_phase(const Params& p, int layer, int bid, int nblk, int tidx) {
  const int tid = tidx;
  const float lw = p.in[21][(size_t)layer * 256 + tid], lb = p.in[22][(size_t)layer * 256 + tid];
  for (int t4 = bid; t4 < NTOK / 4; t4 += nblk) {
    float of[4], ob[4], bv[4], gg[4];
#pragma unroll
    for (int u = 0; u < 4; ++u) {
      const size_t i = (size_t)(t4 * 4 + u) * 256 + tid;
      of[u] = p.OF[i]; ob[u] = p.OB[i]; bv[u] = p.BV[i]; gg[u] = p.G[i];
    }
#pragma unroll
    for (int u = 0; u < 4; ++u) {
      const float o = of[u] + ob[u];
      const float mu = wave_sum(o) * (1.f / 64.f);
      const float d = o - mu;
      const float var = wave_sum(d * d) * (1.f / 64.f);
      const float y = (d * rsqrtf(var + 64e-5f) * lw + lb + bv[u]) * gg[u];
      p.MIX[(size_t)(t4 * 4 + u) * DM + tid] = f2bf(y);
    }
  }
}

#ifndef ONLY_PH
#define ONLY_PH -1
#endif
#define PH_EN(x) (ONLY_PH < 0 || ONLY_PH == (x))
__device__ __forceinline__ void run_phase(const Params& p, int ph, char* smem, int bid, int nblk, int tidx, int rep = 0) {
  const bool defer = (nblk == 512);
  if (ph == 0) {
    if (PH_EN(0)) { setup_phase(p, smem, bid, nblk, tidx, 0, defer ? 192 : 768, true); weight_convert(p, smem, tidx, bid, nblk, 0, defer ? 2336 : 4 * 3040); }
    return;
  }
  if (ph == 1) { if (PH_EN(1)) modreduce_phase(p, bid, nblk, tidx, 0, defer ? 4608 : 18432); return; }
  if (ph == 2) { if (PH_EN(2)) ln_phase<0>(p, 0, bid, nblk, tidx); return; }
  const int layer = (ph - 3) / 9, s = (ph - 3) % 9;
  switch (s) {
    case 0: if (PH_EN(3)) gemm_phase<EPI_PROJ, 256, 3>(p, layer, p.A, p.winT + (size_t)layer * DIN * DM, DIN, DM, smem, bid, nblk, tidx); break;
    case 1: if (PH_EN(4)) prep_phase(p, layer, smem, bid, nblk, tidx, rep); break;
    case 2: if (PH_EN(5)) mixer_phase(p, layer + 4 * rep, smem, tidx); break;
    case 3: if (PH_EN(6)) rwkv_fin_phase(p, layer, bid, nblk, tidx); break;
    case 4:
      if (PH_EN(7)) {
        if (defer && bid >= 256) {
          if (layer == 0) { setup_phase(p, smem, bid - 256, 256, tidx, 192, 768, false); weight_convert(p, smem, tidx, bid - 256, 256, 2336, 3040); }
        } else gemm_phase<EPI_OUT, 192, 3>(p, layer, p.MIX, p.woutT + (size_t)layer * DM * DM, DM, DM, smem, bid, nblk, tidx);
      }
      break;
    case 5: if (PH_EN(8)) ln_phase<1>(p, layer, bid, nblk, tidx); break;
    case 6: if (PH_EN(9)) gemm_phase<EPI_FFI, 192, 3>(p, layer, p.A, p.wfiT + (size_t)layer * 2 * DFF * DM, 2 * DFF, DM, smem, bid, nblk, tidx); break;
    case 7:
      if (PH_EN(10)) {
        if (defer && bid >= 256) {
          if (layer < 3) weight_convert(p, smem, tidx, bid - 256, 256, 3040 * (layer + 1), 3040 * (layer + 2));
          if (layer == 0) modreduce_phase(p, bid - 256, 256, tidx, 4608, 18432);
        }
        else gemm_phase<EPI_FFO, 192, 3>(p, layer, p.ACT, p.wfoT + (size_t)layer * DM * DFF, DM, DFF, smem, bid, nblk, tidx);
      }
      break;
    default: if (PH_EN(11)) ln_phase<2>(p, layer, bid, nblk, tidx); break;
  }
}

__global__ void __launch_bounds__(256, 2) fwd_kernel(Params p, int ph0, int ph1, int usebar) {
  __shared__ __attribute__((aligned(16))) char smem[73728 + 16];
  const int bid = blockIdx.x, nblk = gridDim.x;
  XcdBarrier xb;
  if (usebar && p.never) cg::this_grid().sync();
  if (usebar) {
    if (threadIdx.x == 0) *reinterpret_cast<uint4*>(smem + 73728) = make_uint4(0u, 0u, 0u, 0u);
    __syncthreads();
    xb = xcd_barrier_post(p.bar, (volatile LAS unsigned*)(smem + 73728));
  }
  int ph = ph0, rep = 0;
  while (ph < ph1) {
    int tidx = threadIdx.x;
    asm volatile("" : "+v"(tidx));
    run_phase(p, ph, smem, bid, nblk, tidx, rep);
#if REPSLOT >= 0
    if (((ph < 3 ? 9 + ph : (ph - 3) % 9) == REPSLOT) && rep == 0) rep = 1; else { rep = 0; ++ph; }
#else
    ++ph;
#endif
    if (usebar && ph < ph1) xcd_barrier(xb);
  }
}

static inline size_t al256(size_t x) { return (x + 255) & ~(size_t)255; }

extern "C" void kernel_launch(void* const* d_in, const int* in_sizes, int n_in, void* d_out, int out_size, void* d_ws, size_t ws_size,
                              hipStream_t stream) {
  Params p;
  memset(&p, 0, sizeof(p));
  for (int i = 0; i < 33; ++i) p.in[i] = (const float*)d_in[i];
  float* o = (float*)d_out;
  p.out_yp = o; o += 4194304;
  p.out_ys = o; o += 2097152;
  p.out_st = o; o += 2097152;
  p.out_nak = o; o += 4194304;
  p.out_nav = o; o += 4194304;
  p.out_gk = o; o += 2097152;
  p.out_gv = o;
  char* w = (char*)d_ws; size_t off = 0;
  auto take = [&](size_t bytes) { char* r = w + off; off += al256(bytes); return r; };
  p.bar = (unsigned*)take(16384);
  p.wq = p.bar + 3584;
  p.modp = (float*)take((size_t)4 * 32 * 3 * 6144 * 4);
  p.mod = (float*)take((size_t)4 * 3 * 6144 * 4);
  p.winT = (u16*)take((size_t)4 * DIN * DM * 2);
  p.woutT = (u16*)take((size_t)4 * DM * DM * 2);
  p.wfiT = (u16*)take((size_t)4 * 2 * DFF * DM * 2);
  p.wfoT = (u16*)take((size_t)4 * DM * DFF * 2);
  p.X = (float*)take((size_t)NTOK * DM * 4);
  p.PROJ = (float*)take((size_t)NTOK * DIN * 4);
  p.X1 = p.PROJ;
  p.Y = p.PROJ + (size_t)NTOK * DM;
  p.SC = (float*)take((size_t)NTOK * 4 * 9 * 64 * 4);
  p.ACT = (u16*)p.SC;
  p.G = (float*)take((size_t)NTOK * 256 * 4);
  p.BV = (float*)take((size_t)NTOK * 256 * 4);
  p.OF = (float*)take((size_t)NTOK * 256 * 4);
  p.OB = (float*)take((size_t)NTOK * 256 * 4);
  p.A = (u16*)take((size_t)NTOK * DM * 2);
  p.MIX = (u16*)take((size_t)NTOK * DM * 2);
  p.QNc = (u16*)take((size_t)NCTX * 256 * 2);
  p.KNc = (u16*)take((size_t)NCTX * 256 * 2);
  p.VNtc = (u16*)take((size_t)NCTX * 256 * 2);
  p.QGc = (u16*)take((size_t)NCTX * 512 * 2);
  p.KGc = (u16*)take((size_t)NCTX * 128 * 2);
  p.VGtc = (u16*)take((size_t)NCTX * 128 * 2);
  p.QNl = (u16*)take((size_t)2048 * 256 * 2);
  p.KNl = (u16*)take((size_t)4 * 2 * 1536 * 256 * 2);
  p.VNtl = (u16*)take((size_t)4 * 2 * 1536 * 256 * 2);
  p.QGl = (u16*)take((size_t)2048 * 512 * 2);
  p.KGl = (u16*)take((size_t)4 * 2 * 1536 * 128 * 2);
  p.VGtl = (u16*)take((size_t)4 * 2 * 1536 * 128 * 2);
  p.loraT = (u16*)take((size_t)4 * 98304 * 2);
  p.rope = (float*)take((size_t)64 * 16 * 2 * 4);
  if (off > ws_size) { fprintf(stderr, "workspace too small: need %zu have %zu\n", off, ws_size); return; }

  (void)hipMemsetAsync(p.bar, 0, 16384, stream);
#if MEGA
  static int grid_blocks = 0;
  if (!grid_blocks) {
    int dev = 0, cus = 0, per_cu = 0;
    hipGetDevice(&dev);
    hipDeviceGetAttribute(&cus, hipDeviceAttributeMultiprocessorCount, dev);
    hipOccupancyMaxActiveBlocksPerMultiprocessor(&per_cu, fwd_kernel, 256, 0);
    if (per_cu > 2) per_cu = 2;
    if (per_cu < 1) per_cu = 1;
    grid_blocks = cus * per_cu;
  }
  int ph0 = 0, ph1 = NPH, ub = 1;
  void* args[] = {&p, &ph0, &ph1, &ub};
  hipError_t e = hipLaunchCooperativeKernel((void*)fwd_kernel, dim3(grid_blocks), dim3(256), args, 0, stream);
  if (e != hipSuccess) fprintf(stderr, "cooperative launch failed: %s (grid %d)\n", hipGetErrorString(e), grid_blocks);
#else
  for (int ph = 0; ph < NPH; ++ph) fwd_kernel<<<512, 256, 0, stream>>>(p, ph, ph + 1, 0);
#endif
}
```

```cpp
#include <hip/hip_runtime.h>
#include <hip/hip_cooperative_groups.h>
#include <cstdio>
#include <cstdint>
#include <cstring>
namespace cg = cooperative_groups;

#ifndef REPMASK
#define REPMASK 0
#endif
#ifndef REPSLOT
#define REPSLOT -1
#endif
#ifndef PREPVAR
#define PREPVAR 0
#endif
#ifndef SCANVAR
#define SCANVAR 0
#endif
#ifndef REPVAR
#define REPVAR 0
#endif
#ifndef MEGA
#define MEGA 1
#endif

typedef unsigned short u16;
using bf16x8 = __attribute__((ext_vector_type(8))) short;
using f32x4 = __attribute__((ext_vector_type(4))) float;
using v2f = __attribute__((ext_vector_type(2))) float;

#define NTOK 6144
#define NCTX 4096
#define DM 1024
#define DIN 2688
#define DFF 2816
#define NPH 39
#define ALPHA 1.681792830507429f
#define LOG2E 1.4426950408889634f
#define QSCALE (0.125f * LOG2E)

struct Params {
  const float* in[33];
  float *out_yp, *out_ys, *out_st, *out_nak, *out_nav, *out_gk, *out_gv;
  unsigned *bar, *wq;
  float *modp, *mod;
  u16 *winT, *woutT, *wfiT, *wfoT;
  float *X, *X1, *Y, *PROJ, *SC, *G, *BV, *OF, *OB;
  u16 *A, *MIX, *ACT;
  u16 *QNc, *KNc, *VNtc, *QGc, *KGc, *VGtc;
  u16 *QNl, *KNl, *VNtl, *QGl, *KGl, *VGtl;
  u16* loraT; float* rope;
  int never; int pad;
};

__device__ __forceinline__ u16 f2bf(float f) {
  unsigned u = __float_as_uint(f);
  u += 0x7FFFu + ((u >> 16) & 1u);
  return (u16)(u >> 16);
}
typedef __bf16 bf16v2 __attribute__((ext_vector_type(2)));
__device__ __forceinline__ unsigned pack2(float a, float b) {
  const bf16v2 r = __builtin_convertvector((v2f){a, b}, bf16v2);
  return __builtin_bit_cast(unsigned, r);
}
template <int CTRL> __device__ __forceinline__ float dpp_mov(float v) {
  return __int_as_float(__builtin_amdgcn_update_dpp(0, __float_as_int(v), CTRL, 0xF, 0xF, false));
}
__device__ __forceinline__ float reduce16(float v) {
  v += dpp_mov<0xB1>(v);
  v += dpp_mov<0x4E>(v);
  v += dpp_mov<0x141>(v);
  v += dpp_mov<0x140>(v);
  return v;
}
__device__ __forceinline__ float wave_sum(float v) {
  v = reduce16(v);
  v += __shfl_xor(v, 16);
  v += __shfl_xor(v, 32);
  return v;
}
__device__ __forceinline__ float tanhf_(float x) { const float e = __expf(-2.f * fabsf(x)); const float t = (1.f - e) / (1.f + e); return x < 0.f ? -t : t; }
__device__ __forceinline__ float sigmoidf_(float x) { return 1.f / (1.f + __expf(-x)); }
__device__ __forceinline__ float siluf_(float x) { return x / (1.f + __expf(-x)); }
__device__ __forceinline__ int modrow_of(int tok) { return tok < NCTX ? 0 : 1 + ((tok - NCTX) >> 10); }

#define XB_TMO      128
#define XB_XCNT(j)  (256  + 64 * (j))
#define XB_XSUB(j)  (1280 + 64 * (j))
#define XB_XGEN(j)  (2304 + 64 * (j))
#define XB_TOP      3328
#define XB_TOPGEN   3392
#define XCD_BAR_WORDS 3456
#define XB_SPIN_CAP (1u << 22)
#define LAS __attribute__((address_space(3)))
__device__ __forceinline__ unsigned xb_ld(unsigned* p) { return __hip_atomic_load(p, __ATOMIC_RELAXED, __HIP_MEMORY_SCOPE_AGENT); }
__device__ __forceinline__ unsigned xb_add(unsigned* p, unsigned v) { return __hip_atomic_fetch_add(p, v, __ATOMIC_RELAXED, __HIP_MEMORY_SCOPE_AGENT); }
__device__ __forceinline__ unsigned xb_xcc_id() { return (unsigned)__builtin_amdgcn_s_getreg((3 << 11) | 20) & 0xFu; }
#define XB_SPIN(cond, bar) do { unsigned _sp = 0; while (cond) { __builtin_amdgcn_s_sleep(1); \
    if ((++_sp & 255u) == 0u) { if (xb_ld(&(bar)[XB_TMO])) break; if (_sp > XB_SPIN_CAP) { atomicAdd(&(bar)[XB_TMO], 1u); break; } } } } while (0)
struct XcdBarrier { unsigned* bar; unsigned x; volatile LAS unsigned* st; };
__device__ __forceinline__ XcdBarrier xcd_barrier_post(unsigned* bar, volatile LAS unsigned* st) {
  XcdBarrier b; b.bar = bar; b.x = xb_xcc_id(); b.st = st;
  if (threadIdx.x == 0) (void)xb_add(&bar[XB_XCNT(b.x)], 1u);
  return b;
}
__device__ __forceinline__ void xcd_barrier_complete(unsigned* bar, unsigned x, unsigned& nloc, unsigned& nx) {
  const unsigned G = gridDim.x * gridDim.y * gridDim.z;
  unsigned sum, cnt, mine, sp = 0u;
  for (;;) {
    sum = 0u; cnt = 0u; mine = 0u;
#pragma unroll
    for (unsigned j = 0; j < 16; ++j) { const unsigned c = xb_ld(&bar[XB_XCNT(j)]); sum += c; cnt += (c > 0u) ? 1u : 0u; mine = (j == x) ? c : mine; }
    if (sum == G) break;
    __builtin_amdgcn_s_sleep(1);
    if ((++sp & 255u) == 0u) { if (xb_ld(&bar[XB_TMO])) break; if (sp > XB_SPIN_CAP) { atomicAdd(&bar[XB_TMO], 1u); break; } }
  }
  nloc = mine > 0u ? mine : 1u; nx = cnt > 0u ? cnt : 1u;
}
__device__ __forceinline__ void xcd_barrier(const XcdBarrier& b) {
  asm volatile("s_waitcnt vmcnt(0)" ::: "memory");
  __syncthreads();
  if (threadIdx.x == 0) {
    unsigned* bar = b.bar;
    asm volatile("" : "+s"(bar));
    __builtin_amdgcn_s_waitcnt(0);
    unsigned nloc = b.st[0], nx = b.st[1];
    if (nloc == 0u) { xcd_barrier_complete(bar, b.x, nloc, nx); b.st[0] = nloc; b.st[1] = nx; }
    const unsigned old = xb_add(&bar[XB_XSUB(b.x)], 1u);
    const unsigned gen = old / nloc;
    if (old + 1u == (gen + 1u) * nloc) {
      __builtin_amdgcn_fence(__ATOMIC_RELEASE, "agent");
      asm volatile("s_waitcnt vmcnt(0)" ::: "memory");
      const unsigned og = xb_add(&bar[XB_TOP], 1u);
      const unsigned tg = og / nx;
      if (og + 1u == (tg + 1u) * nx) xb_add(&bar[XB_TOPGEN], 1u);
      else XB_SPIN(xb_ld(&bar[XB_TOPGEN]) == tg, bar);
      __builtin_amdgcn_fence(__ATOMIC_ACQUIRE, "agent");
      xb_add(&bar[XB_XGEN(b.x)], 1u);
      asm volatile("s_waitcnt vmcnt(0)" ::: "memory");
    } else {
      XB_SPIN(xb_ld(&bar[XB_XGEN(b.x)]) == gen, bar);
      __builtin_amdgcn_fence(__ATOMIC_ACQUIRE, "agent");
      asm volatile("s_waitcnt vmcnt(0)" ::: "memory");
    }
  }
  __syncthreads();
}

__device__ __forceinline__ int lds_byte32(int r, int c) {
  const int ob = (r & 15) * 64 + c * 2;
  return (r >> 4) * 1024 + (ob ^ (((ob >> 9) & 1) << 5));
}
__device__ __forceinline__ void stage_rc32(int b, int& R, int& C) {
  const int sb = b & 1023, swz = sb ^ (((sb >> 9) & 1) << 5);
  R = (b >> 10) * 16 + (swz >> 6); C = (swz & 63) >> 1;
}
template <int ROWS>
__device__ __forceinline__ void stage_tile32(const u16* __restrict__ g, int ld, char* lds, int tidx) {
#pragma unroll
  for (int i = 0; i < (ROWS * 64 + 4095) / 4096; ++i) {
    const int b = tidx * 16 + i * 4096;
    if ((i + 1) * 4096 <= ROWS * 64 || tidx < (ROWS * 64 - i * 4096) / 16) {
      int R, C; stage_rc32(b, R, C);
      __builtin_amdgcn_global_load_lds((const unsigned*)(g + (size_t)R * ld + C), (unsigned LAS*)(lds + b), 16, 0, 0);
    }
  }
}
template <int N> __device__ __forceinline__ void wait_vmcnt() {
  if (N == 0) asm volatile("s_waitcnt vmcnt(0)" ::: "memory");
  else if (N == 3) asm volatile("s_waitcnt vmcnt(3)" ::: "memory");
  else if (N == 4) asm volatile("s_waitcnt vmcnt(4)" ::: "memory");
  else if (N == 5) asm volatile("s_waitcnt vmcnt(5)" ::: "memory");
  else if (N == 6) asm volatile("s_waitcnt vmcnt(6)" ::: "memory");
  else if (N == 8) asm volatile("s_waitcnt vmcnt(8)" ::: "memory");
  else if (N == 9) asm volatile("s_waitcnt vmcnt(9)" ::: "memory");
  else if (N == 10) asm volatile("s_waitcnt vmcnt(10)" ::: "memory");
  else if (N == 12) asm volatile("s_waitcnt vmcnt(12)" ::: "memory");
  else asm volatile("s_waitcnt vmcnt(0)" ::: "memory");
}

enum { EPI_PROJ = 0, EPI_OUT = 1, EPI_FFI = 2, EPI_FFO = 3 };

template <int EPI, int BM, int NST>
__device__ __forceinline__ void gemm_phase(const Params& p, int layer, const u16* __restrict__ A, const u16* __restrict__ Bt,
                                           int N, int K, char* smem, int bid, int nblk, int tidx) {
  constexpr int MF = BM / 32;
  const int tid = tidx, lane = tid & 63, wid = tid >> 6, wr = wid >> 1, wc = wid & 1, fr = lane & 15, fq = lane >> 4;
  const int nM = NTOK / BM, nN = N / 128, ntiles = nM * nN, nk = K / 32;
  constexpr int SB = (BM + 128) * 64;
  constexpr int LA = (BM * 64) / 4096;
  const bool extraA = (BM == 96) && (wid < 2);
  for (int tile = bid; tile < ntiles; tile += nblk) {
    const int pm = tile % nM, pn = tile / nM, m0 = pm * BM, n0 = pn * 128;
    f32x4 acc[MF][4];
#pragma unroll
    for (int m = 0; m < MF; ++m)
#pragma unroll
      for (int n = 0; n < 4; ++n) acc[m][n] = (f32x4){0.f, 0.f, 0.f, 0.f};
    const u16* Ag = A + (size_t)m0 * K;
    const u16* Bg = Bt + (size_t)n0 * K;
#pragma unroll
    for (int s_ = 0; s_ < NST - 1; ++s_) {
      stage_tile32<BM>(Ag + s_ * 32, K, smem + s_ * SB, tidx);
      stage_tile32<128>(Bg + s_ * 32, K, smem + s_ * SB + BM * 64, tidx);
    }
    int slot = 0, pslot = NST - 1;
    for (int kt = 0; kt < nk; ++kt) {
      if (kt + NST - 2 < nk) {
        if (BM == 96) { if (extraA) wait_vmcnt<(NST - 2) * 4>(); else wait_vmcnt<(NST - 2) * 3>(); }
        else wait_vmcnt<(NST - 2) * (LA + 2)>();
      } else {
        asm volatile("s_waitcnt vmcnt(0)" ::: "memory");
      }
      __builtin_amdgcn_s_barrier();
      if (kt + NST - 1 < nk) {
        char* nb = smem + pslot * SB;
        stage_tile32<BM>(Ag + (kt + NST - 1) * 32, K, nb, tidx);
        stage_tile32<128>(Bg + (kt + NST - 1) * 32, K, nb + BM * 64, tidx);
      }
      const char* sa = smem + slot * SB;
      const char* sb = sa + BM * 64;
      slot = (slot + 1 == NST) ? 0 : slot + 1;
      pslot = (pslot + 1 == NST) ? 0 : pslot + 1;
      bf16x8 af[MF], bfr[4];
#pragma unroll
      for (int m = 0; m < MF; ++m) af[m] = *reinterpret_cast<const bf16x8*>(sa + lds_byte32(wr * (BM / 2) + m * 16 + fr, fq * 8));
#pragma unroll
      for (int n = 0; n < 4; ++n) bfr[n] = *reinterpret_cast<const bf16x8*>(sb + lds_byte32(wc * 64 + n * 16 + fr, fq * 8));
#pragma unroll
      for (int m = 0; m < MF; ++m)
#pragma unroll
        for (int n = 0; n < 4; ++n) acc[m][n] = __builtin_amdgcn_mfma_f32_16x16x32_bf16(bfr[n], af[m], acc[m][n], 0, 0, 0);
    }
#pragma unroll
    for (int m = 0; m < MF; ++m) {
      const int row = m0 + wr * (BM / 2) + m * 16 + fr;
      if (EPI == EPI_PROJ) {
#pragma unroll
        for (int n = 0; n < 4; ++n) {
          const int col = n0 + wc * 64 + n * 16 + 4 * fq;
          *reinterpret_cast<float4*>(p.PROJ + (size_t)row * DIN + col) = make_float4(acc[m][n][0], acc[m][n][1], acc[m][n][2], acc[m][n][3]);
        }
      } else if (EPI == EPI_OUT || EPI == EPI_FFO) {
        const float* res = (EPI == EPI_OUT) ? p.X : p.X1;
        const float* gate = p.mod + ((size_t)(layer * 3 + modrow_of(row)) * 6 + (EPI == EPI_OUT ? 2 : 5)) * 1024;
#pragma unroll
        for (int n = 0; n < 4; ++n) {
          const int col = n0 + wc * 64 + n * 16 + 4 * fq;
          const float4 xr = *reinterpret_cast<const float4*>(res + (size_t)row * DM + col);
          const float4 gt = *reinterpret_cast<const float4*>(gate + col);
          float4 y;
          y.x = ALPHA * xr.x + gt.x * acc[m][n][0];
          y.y = ALPHA * xr.y + gt.y * acc[m][n][1];
          y.z = ALPHA * xr.z + gt.z * acc[m][n][2];
          y.w = ALPHA * xr.w + gt.w * acc[m][n][3];
          *reinterpret_cast<float4*>(p.Y + (size_t)row * DM + col) = y;
        }
      } else {
#pragma unroll
        for (int n2 = 0; n2 < 2; ++n2) {
          const int j0 = ((n0 + wc * 64) / 32 + n2) * 16 + 4 * fq;
          float a[4];
#pragma unroll
          for (int r = 0; r < 4; ++r) a[r] = siluf_(acc[m][2 * n2][r]) * acc[m][2 * n2 + 1][r];
          uint2 pk; pk.x = pack2(a[0], a[1]); pk.y = pack2(a[2], a[3]);
          *reinterpret_cast<uint2*>(p.ACT + (size_t)row * DFF + j0) = pk;
        }
      }
    }
    asm volatile("s_waitcnt lgkmcnt(0)" ::: "memory");
    __builtin_amdgcn_s_barrier();
  }
}

__device__ __forceinline__ int kf_off(int t, int d) { return (t >> 4) * 1024 + (d >> 5) * 512 + ((d & 31) >> 3) * 128 + (t & 15) * 8 + (d & 7); }
__device__ __forceinline__ int vf_off(int t, int d) { return (t >> 5) * 2048 + (d >> 4) * 512 + (((t & 15) >> 2) * 16 + (d & 15)) * 8 + ((t >> 4) & 1) * 4 + (t & 3); }
__device__ __forceinline__ void pack44_store(u16* base, int t0, int d, const float* v) {
  uint2 a, b; a.x = pack2(v[0], v[1]); a.y = pack2(v[2], v[3]); b.x = pack2(v[4], v[5]); b.y = pack2(v[6], v[7]);
  *reinterpret_cast<uint2*>(base + vf_off(t0, d)) = a;
  *reinterpret_cast<uint2*>(base + vf_off(t0 + 4, d)) = b;
}
__device__ __forceinline__ void pack8_store(u16* dst, const float* v) {
  uint4 pk; pk.x = pack2(v[0], v[1]); pk.y = pack2(v[2], v[3]); pk.z = pack2(v[4], v[5]); pk.w = pack2(v[6], v[7]);
  *reinterpret_cast<uint4*>(dst) = pk;
}

__device__ void setup_phase(const Params& p, char* smem, int bid, int nblk, int tidx, int mod_lo, int mod_hi, bool rest) {
  const int tid = tidx;
  const int nm = mod_hi - mod_lo;
  const int NV = nm + (rest ? 512 + 13 : 0);
  for (int v_ = bid; v_ < NV; v_ += nblk) {
    const int it = v_ < nm ? mod_lo + v_ : 768 + (v_ - nm);
    if (it < 768) {
      const int l = it / 192, nc = (it / 32) % 6, kc = it % 32;
      const int col = nc * 1024 + tid * 4;
      const float* wm = p.in[9] + (size_t)l * 1024 * 6144;
      float4 a0 = make_float4(0, 0, 0, 0), a1 = a0, a2 = a0;
      for (int k8 = 0; k8 < 32; k8 += 8) {
        float4 w[8];
#pragma unroll
        for (int u = 0; u < 8; ++u) w[u] = *reinterpret_cast<const float4*>(wm + (size_t)(kc * 32 + k8 + u) * 6144 + col);
#pragma unroll
        for (int u = 0; u < 8; ++u) {
          const int k = kc * 32 + k8 + u;
          const float s0 = siluf_(p.in[8][k]), s1 = siluf_(p.in[7][k]), s2 = siluf_(p.in[7][1024 + k]);
          a0.x += s0 * w[u].x; a0.y += s0 * w[u].y; a0.z += s0 * w[u].z; a0.w += s0 * w[u].w;
          a1.x += s1 * w[u].x; a1.y += s1 * w[u].y; a1.z += s1 * w[u].z; a1.w += s1 * w[u].w;
          a2.x += s2 * w[u].x; a2.y += s2 * w[u].y; a2.z += s2 * w[u].z; a2.w += s2 * w[u].w;
        }
      }
      float* dst = p.modp + (size_t)((l * 32 + kc) * 3) * 6144 + col;
      *reinterpret_cast<float4*>(dst) = a0;
      *reinterpret_cast<float4*>(dst + 6144) = a1;
      *reinterpret_cast<float4*>(dst + 2 * 6144) = a2;
    } else if (it < 1280) {
      const int ci = it - 768, b = ci / 256, l = (ci / 64) % 4, tg = ci % 64, t0 = tg * 8;
      {
        const float* ck = p.in[3] + ((size_t)(b * 4 + l) * 512 + t0) * 256 + tid;
        const float* cv = p.in[4] + ((size_t)(b * 4 + l) * 512 + t0) * 256 + tid;
        float v[8];
#pragma unroll
        for (int tt = 0; tt < 8; ++tt) {
          p.KNl[((size_t)((l * 2 + b) * 4 + (tid >> 6))) * 98304 + kf_off(t0 + tt, tid & 63)] = f2bf(ck[tt * 256]);
          v[tt] = cv[tt * 256];
        }
        pack44_store(p.VNtl + ((size_t)((l * 2 + b) * 4 + (tid >> 6))) * 98304, t0, tid & 63, v);
      }
      if (tid < 128) {
        const float* ck = p.in[5] + ((size_t)(b * 4 + l) * 512 + t0) * 128 + tid;
#pragma unroll
        for (int tt = 0; tt < 8; ++tt) p.KGl[((size_t)((l * 2 + b) * 2 + (tid >> 6))) * 98304 + kf_off(t0 + tt, tid & 63)] = f2bf(ck[tt * 128]);
      } else {
        const int c = tid - 128;
        const float* cv = p.in[6] + ((size_t)(b * 4 + l) * 512 + t0) * 128 + c;
        float v[8];
#pragma unroll
        for (int tt = 0; tt < 8; ++tt) v[tt] = cv[tt * 128];
        pack44_store(p.VGtl + ((size_t)((l * 2 + b) * 2 + (c >> 6))) * 98304, t0, c & 63, v);
      }
    } else {
      const int li = it - (768 + 512);
      if (li == 12) {
        for (int idx = tid; idx < 1024; idx += 256) {
          const int pos = idx >> 4, fi = idx & 15;
          const float ang = (float)pos * exp2f(-(float)fi * (13.287712379549449f / 16.f));
          p.rope[idx * 2] = cosf(ang); p.rope[idx * 2 + 1] = sinf(ang);
        }
      } else {
        const int l = li / 3, m = li % 3;
        u16* dst = p.loraT + (size_t)l * 98304 + m * 32768;
        if (m < 2) {
          const float* src = p.in[m == 0 ? 14 : 16] + (size_t)l * 32768;
          for (int i0 = tid; i0 < 32768; i0 += 256 * 16) {
            float v[16];
#pragma unroll
            for (int u = 0; u < 16; ++u) { const int idx = i0 + 256 * u; const int d = idx >> 14, cch = (idx >> 6) & 255, r = idx & 63; v[u] = src[(d * 64 + r) * 256 + cch]; }
#pragma unroll
            for (int u = 0; u < 16; ++u) dst[i0 + 256 * u] = f2bf(v[u]);
          }
        } else {
          const float* src = p.in[17] + (size_t)l * 32768;
          for (int i0 = tid; i0 < 32768; i0 += 256 * 16) {
            float v[16];
#pragma unroll
            for (int u = 0; u < 16; ++u) { const int idx = i0 + 256 * u; const int cch = idx >> 7, j = idx & 127; v[u] = src[j * 256 + cch]; }
#pragma unroll
            for (int u = 0; u < 16; ++u) dst[i0 + 256 * u] = f2bf(v[u]);
          }
        }
      }
    }
  }
}

__device__ void weight_convert(const Params& p, char* smem, int tid, int w, int nw, int tr_begin, int NT) {
    float* tile = reinterpret_cast<float*>(smem);
    float4 cur0, cur1, cur2, cur3;
    const float* src; u16* dst; int K, N, mat, k0, n0;
#define TR_DECODE(TR) { const int l_ = (TR) / 3040; int r_ = (TR) % 3040; int kt_, nt_; \
      if (r_ < 672) { mat = 0; K = 1024; N = 2688; src = p.in[11] + (size_t)l_ * K * N; dst = p.winT + (size_t)l_ * N * K; kt_ = r_ / 42; nt_ = r_ % 42; } \
      else if (r_ < 928) { r_ -= 672; mat = 1; K = 1024; N = 1024; src = p.in[26] + (size_t)l_ * K * N; dst = p.woutT + (size_t)l_ * N * K; kt_ = r_ / 16; nt_ = r_ % 16; } \
      else if (r_ < 2336) { r_ -= 928; mat = 2; K = 1024; N = 5632; src = p.in[29] + (size_t)l_ * K * N; dst = p.wfiT + (size_t)l_ * N * K; kt_ = r_ / 88; nt_ = r_ % 88; } \
      else { r_ -= 2336; mat = 3; K = 2816; N = 1024; src = p.in[30] + (size_t)l_ * K * N; dst = p.wfoT + (size_t)l_ * N * K; kt_ = r_ / 16; nt_ = r_ % 16; } \
      k0 = kt_ * 64; n0 = nt_ * 64; }
#define TR_LOAD(V, I) V = *reinterpret_cast<const float4*>(src + (size_t)(k0 + (tid >> 4) + 16 * (I)) * N + n0 + (tid & 15) * 4);
#define TR_PUT(V, I) { const int kr_ = (tid >> 4) + 16 * (I), c4_ = (tid & 15) * 4; \
      tile[kr_ * 65 + c4_ + 0] = V.x; tile[kr_ * 65 + c4_ + 1] = V.y; tile[kr_ * 65 + c4_ + 2] = V.z; tile[kr_ * 65 + c4_ + 3] = V.w; }
    int tr = tr_begin + w;
    if (tr < NT) { TR_DECODE(tr) TR_LOAD(cur0, 0) TR_LOAD(cur1, 1) TR_LOAD(cur2, 2) TR_LOAD(cur3, 3) }
    for (; tr < NT; tr += nw) {
      TR_PUT(cur0, 0) TR_PUT(cur1, 1) TR_PUT(cur2, 2) TR_PUT(cur3, 3)
      if (tr + nw < NT) { TR_DECODE(tr + nw) TR_LOAD(cur0, 0) TR_LOAD(cur1, 1) TR_LOAD(cur2, 2) TR_LOAD(cur3, 3) }
      TR_DECODE(tr)
      __syncthreads();
#pragma unroll
      for (int i = 0; i < 2; ++i) {
        const int idx = tid + 256 * i, nl = idx >> 3, kc = idx & 7;
        int n = n0 + nl;
        if (mat == 2) { const int isup = n >= DFF ? 1 : 0; const int j = n - isup * DFF; n = (j >> 4) * 32 + isup * 16 + (j & 15); }
        float v[8];
#pragma unroll
        for (int jj = 0; jj < 8; ++jj) v[jj] = tile[(kc * 8 + jj) * 65 + nl];
        pack8_store(dst + (size_t)n * K + k0 + kc * 8, v);
      }
      __syncthreads();
    }
#undef TR_DECODE
#undef TR_LOAD
#undef TR_PUT
}

__device__ void modreduce_phase(const Params& p, int bid, int nblk, int tidx, int idx_lo, int idx_hi) {
  for (int idx = idx_lo + bid * 256 + tidx; idx < idx_hi; idx += nblk * 256) {
    const int l = idx / 4608, rem = idx % 4608, mr = rem / 1536, c4 = (rem % 1536) * 4;
    float4 a = *reinterpret_cast<const float4*>(p.in[10] + (size_t)l * 6144 + c4);
    for (int k8 = 0; k8 < 32; k8 += 8) {
      float4 v[8];
#pragma unroll
      for (int u = 0; u < 8; ++u) v[u] = *reinterpret_cast<const float4*>(p.modp + (size_t)((l * 32 + k8 + u) * 3 + mr) * 6144 + c4);
#pragma unroll
      for (int u = 0; u < 8; ++u) { a.x += v[u].x; a.y += v[u].y; a.z += v[u].z; a.w += v[u].w; }
    }
    *reinterpret_cast<float4*>(p.mod + (size_t)(l * 3 + mr) * 6144 + c4) = a;
  }
}

template <int MODE>
__device__ void ln_phase(const Params& p, int layer, int bid, int nblk, int tidx) {
  const int lane = tidx & 63, wid = tidx >> 6;
  const bool fin = (MODE == 2 && layer == 3);
  const float* lw = (MODE == 1 ? p.in[27] : p.in[31]) + (size_t)layer * DM;
  const float* lb = (MODE == 1 ? p.in[28] : p.in[32]) + (size_t)layer * DM;
  const int ml = (MODE == 2) ? (layer + 1 < 4 ? layer + 1 : 3) : layer;
  const int which = (MODE == 1) ? 3 : 0;
#define LN_SRC(ROW) (MODE == 0 ? ((ROW) < NCTX ? p.in[0] + (size_t)(ROW) * DM : p.in[1] + (size_t)((ROW) - NCTX) * DM) : p.Y + (size_t)(ROW) * DM)
  float4 nv0, nv1, nv2, nv3;
  int it = bid;
  if (it < NTOK / 4) {
    const float4* s4 = reinterpret_cast<const float4*>(LN_SRC(it * 4 + wid));
    nv0 = s4[lane]; nv1 = s4[lane + 64]; nv2 = s4[lane + 128]; nv3 = s4[lane + 192];
  }
  for (; it < NTOK / 4; it += nblk) {
    const int row = it * 4 + wid;
    float4 v[4] = {nv0, nv1, nv2, nv3};
    if (it + nblk < NTOK / 4) {
      const float4* s4 = reinterpret_cast<const float4*>(LN_SRC((it + nblk) * 4 + wid));
      nv0 = s4[lane]; nv1 = s4[lane + 64]; nv2 = s4[lane + 128]; nv3 = s4[lane + 192];
    }
    float4 w4[4], b4[4], s4v[4], c4v[4];
    const float* sh = p.mod + ((size_t)(ml * 3 + modrow_of(row)) * 6 + which) * 1024;
    const float* sc = sh + 1024;
#pragma unroll
    for (int i = 0; i < 4; ++i) {
      if (MODE != 0) { w4[i] = reinterpret_cast<const float4*>(lw)[lane + 64 * i]; b4[i] = reinterpret_cast<const float4*>(lb)[lane + 64 * i]; }
      if (!fin) { s4v[i] = reinterpret_cast<const float4*>(sh)[lane + 64 * i]; c4v[i] = reinterpret_cast<const float4*>(sc)[lane + 64 * i]; }
    }
    if (MODE != 0) {
      float s = 0.f;
#pragma unroll
      for (int i = 0; i < 4; ++i) s += v[i].x + v[i].y + v[i].z + v[i].w;
      const float mu = wave_sum(s) * (1.f / 1024.f);
      float q = 0.f;
#pragma unroll
      for (int i = 0; i < 4; ++i) {
        v[i].x -= mu; v[i].y -= mu; v[i].z -= mu; v[i].w -= mu;
        q += v[i].x * v[i].x + v[i].y * v[i].y + v[i].z * v[i].z + v[i].w * v[i].w;
      }
      const float rstd = rsqrtf(wave_sum(q) * (1.f / 1024.f) + 1e-5f);
#pragma unroll
      for (int i = 0; i < 4; ++i) {
        v[i].x = v[i].x * rstd * w4[i].x + b4[i].x; v[i].y = v[i].y * rstd * w4[i].y + b4[i].y;
        v[i].z = v[i].z * rstd * w4[i].z + b4[i].z; v[i].w = v[i].w * rstd * w4[i].w + b4[i].w;
      }
    }
    float* xdst = (MODE == 1 ? p.X1 : p.X) + (size_t)row * DM;
#pragma unroll
    for (int i = 0; i < 4; ++i) reinterpret_cast<float4*>(xdst)[lane + 64 * i] = v[i];
    if (fin) {
      float* o = row < NCTX ? p.out_yp + (size_t)row * DM : p.out_ys + (size_t)(row - NCTX) * DM;
#pragma unroll
      for (int i = 0; i < 4; ++i) reinterpret_cast<float4*>(o)[lane + 64 * i] = v[i];
    } else {
      u16* adst = p.A + (size_t)row * DM;
#pragma unroll
      for (int i = 0; i < 4; ++i) {
        uint2 pk;
        pk.x = pack2(v[i].x * (1.f + c4v[i].x) + s4v[i].x, v[i].y * (1.f + c4v[i].y) + s4v[i].y);
        pk.y = pack2(v[i].z * (1.f + c4v[i].z) + s4v[i].z, v[i].w * (1.f + c4v[i].w) + s4v[i].w);
        reinterpret_cast<uint2*>(adst)[lane + 64 * i] = pk;
      }
    }
  }
#undef LN_SRC
}

#define FLD 772
#define LLD 392
__device__ void prep_phase(const Params& p, int layer, char* smem, int bid, int nblk, int tidx, int rep) {
  const int pv_ = rep ? PREPVAR : 0;
  float* F = reinterpret_cast<float*>(smem);
  u16* LIb = reinterpret_cast<u16*>(smem + 16 * FLD * 4);
  const float* cw = p.in[12] + (size_t)layer * 3 * 1152;
  const u16* LW = p.loraT + (size_t)layer * 98304;
  for (int it2 = bid; it2 < 2 * (NTOK / 16); it2 += nblk) {
    const bool doR = it2 < NTOK / 16;
    const int it = doR ? it2 : it2 - NTOK / 16;
    int tid = tidx;
    asm volatile("" : "+v"(tid));
    const int lane = tid & 63, wid = tid >> 6, fr = lane & 15, fq = lane >> 4;
    const int tok0 = it * 16;
    int b, tpos0, L;
    const bool isctx = tok0 < NCTX;
    if (isctx) { b = tok0 >> 8; tpos0 = tok0 & 255; L = 256; }
    else { const int tl = tok0 - NCTX; b = tl >> 10; tpos0 = tl & 1023; L = 1024; }
    if (doR) {
    {
      float* PRM = reinterpret_cast<float*>(smem + 61952);
      PRM[tid] = p.in[13][(size_t)layer * 512 + tid]; PRM[256 + tid] = p.in[13][(size_t)layer * 512 + 256 + tid];
      PRM[512 + tid] = p.in[15][(size_t)layer * 512 + tid]; PRM[768 + tid] = p.in[15][(size_t)layer * 512 + 256 + tid];
      PRM[1024 + tid] = p.in[18][(size_t)layer * 256 + tid]; PRM[1280 + tid] = p.in[19][(size_t)layer * 256 + tid]; PRM[1536 + tid] = p.in[20][(size_t)layer * 256 + tid];
    }
#pragma unroll 1
    for (int cg = tid; cg < 288; cg += 256) {
      const int c = cg * 4;
      const float4 w0 = *reinterpret_cast<const float4*>(cw + c);
      const float4 w1 = *reinterpret_cast<const float4*>(cw + 1152 + c);
      const float4 w2 = *reinterpret_cast<const float4*>(cw + 2304 + c);
      const float* pr = p.PROJ + (size_t)tok0 * DIN + c;
      float4 x[18];
#pragma unroll
      for (int i = 0; i < 18; ++i) {
        const int tpos = tpos0 + i - 1;
        x[i] = (tpos >= 0 && tpos < L) ? *reinterpret_cast<const float4*>(pr + (ptrdiff_t)(i - 1) * DIN) : make_float4(0.f, 0.f, 0.f, 0.f);
      }
#pragma unroll
      for (int tt = 0; tt < 16; ++tt) {
        float4 f;
        f.x = w0.x * x[tt].x + w1.x * x[tt + 1].x + w2.x * x[tt + 2].x;
        f.y = w0.y * x[tt].y + w1.y * x[tt + 1].y + w2.y * x[tt + 2].y;
        f.z = w0.z * x[tt].z + w1.z * x[tt + 1].z + w2.z * x[tt + 2].z;
        f.w = w0.w * x[tt].w + w1.w * x[tt + 1].w + w2.w * x[tt + 2].w;
        if (c < 768) { *reinterpret_cast<float4*>(F + tt * FLD + c) = f; }
        else {
          const int cc = c - 768;
          if (cc < 128) { f.x = tanhf_(f.x); f.y = tanhf_(f.y); f.z = tanhf_(f.z); f.w = tanhf_(f.w); }
          else if (cc >= 256) { f.x = sigmoidf_(f.x); f.y = sigmoidf_(f.y); f.z = sigmoidf_(f.z); f.w = sigmoidf_(f.w); }
          uint2 pk; pk.x = pack2(f.x, f.y); pk.y = pack2(f.z, f.w);
          *reinterpret_cast<uint2*>(LIb + tt * LLD + cc) = pk;
        }
      }
    }
    __syncthreads();
    f32x4 acc[5][4];
#pragma unroll
    for (int g = 0; g < 5; ++g)
#pragma unroll
      for (int nf = 0; nf < 4; ++nf) acc[g][nf] = (f32x4){0.f, 0.f, 0.f, 0.f};
    if (pv_ != 2 && pv_ != 3) {
#define PB_LOAD(W, GI) { const u16* wt_ = (GI) < 4 ? LW + (size_t)(GI) * 16384 : LW + 65536; const int rs_ = (GI) < 4 ? 64 : 128; const int ko_ = (GI) < 4 ? 0 : ((GI) - 4) * 64; \
      _Pragma("unroll") for (int ks_ = 0; ks_ < 2; ++ks_) _Pragma("unroll") for (int nf_ = 0; nf_ < 4; ++nf_) \
        W[ks_ * 4 + nf_] = *reinterpret_cast<const bf16x8*>(wt_ + (size_t)(64 * wid + 16 * nf_ + fr) * rs_ + ko_ + ks_ * 32 + fq * 8); }
#define PB_MMA(W, GI) { const int ai_ = (GI) < 4 ? (GI) : 4; const int xo_ = (GI) < 4 ? (GI) * 64 : 256 + ((GI) - 4) * 64; \
      _Pragma("unroll") for (int ks_ = 0; ks_ < 2; ++ks_) { \
        const bf16x8 xb_ = *reinterpret_cast<const bf16x8*>(LIb + fr * LLD + xo_ + ks_ * 32 + fq * 8); \
        _Pragma("unroll") for (int nf_ = 0; nf_ < 4; ++nf_) acc[ai_][nf_] = __builtin_amdgcn_mfma_f32_16x16x32_bf16(W[ks_ * 4 + nf_], xb_, acc[ai_][nf_], 0, 0, 0); } \
      __builtin_amdgcn_sched_barrier(0); }
    {
      bf16x8 wA[8], wB[8];
      PB_LOAD(wA, 0)
      PB_LOAD(wB, 1) PB_MMA(wA, 0)
      PB_LOAD(wA, 2) PB_MMA(wB, 1)
      PB_LOAD(wB, 3) PB_MMA(wA, 2)
      PB_LOAD(wA, 4) PB_MMA(wB, 3)
      PB_LOAD(wB, 5) PB_MMA(wA, 4)
      PB_MMA(wB, 5)
    }
#undef PB_LOAD
#undef PB_MMA
    }
    if (pv_ != 2 && pv_ != 3) {
#ifndef NO_C
    const float* PRM = reinterpret_cast<const float*>(smem + 61952);
    {
      const int tok = tok0 + fr;
      float ss = 0.f, bs = 0.f;
#pragma unroll
      for (int nf = 0; nf < 4; ++nf) {
        const int c0 = 64 * wid + 16 * nf + 4 * fq;
        const float4 r4 = *reinterpret_cast<const float4*>(F + fr * FLD + c0);
        const float4 k4 = *reinterpret_cast<const float4*>(F + fr * FLD + 256 + c0);
        const float4 w00 = *reinterpret_cast<const float4*>(PRM + c0);
        const float4 w01 = *reinterpret_cast<const float4*>(PRM + 256 + c0);
        const float4 a00 = *reinterpret_cast<const float4*>(PRM + 512 + c0);
        const float4 a01 = *reinterpret_cast<const float4*>(PRM + 768 + c0);
        const float4 kkw = *reinterpret_cast<const float4*>(PRM + 1024 + c0);
        const float4 kaw = *reinterpret_cast<const float4*>(PRM + 1280 + c0);
        const float4 rkw = *reinterpret_cast<const float4*>(PRM + 1536 + c0);
        const float rr[4] = {r4.x, r4.y, r4.z, r4.w}, kk_[4] = {k4.x, k4.y, k4.z, k4.w};
        const float w0a[4] = {w00.x, w00.y, w00.z, w00.w}, w0b[4] = {w01.x, w01.y, w01.z, w01.w};
        const float a0a[4] = {a00.x, a00.y, a00.z, a00.w}, a0b[4] = {a01.x, a01.y, a01.z, a01.w};
        const float kkw_[4] = {kkw.x, kkw.y, kkw.z, kkw.w}, kaw_[4] = {kaw.x, kaw.y, kaw.z, kaw.w}, rkw_[4] = {rkw.x, rkw.y, rkw.z, rkw.w};
#pragma unroll
        for (int r = 0; r < 4; ++r) {
          {
            const float z = -(w0a[r] + acc[0][nf][r]);
            const float sp = fmaxf(z, 0.f) + __logf(1.f + __expf(-fabsf(z)));
            acc[0][nf][r] = __expf(-__expf(-sp - 0.5f));
          }
          {
            const float z = -(w0b[r] + acc[1][nf][r]);
            const float sp = fmaxf(z, 0.f) + __logf(1.f + __expf(-fabsf(z)));
            acc[1][nf][r] = __expf(-__expf(-sp - 0.5f));
          }
          const float av0 = sigmoidf_(a0a[r] + acc[2][nf][r]);
          const float av1 = sigmoidf_(a0b[r] + acc[3][nf][r]);
          acc[2][nf][r] = av0; acc[3][nf][r] = av1;
          const float k = kk_[r];
          const float kq = k * kkw_[r];
          ss += kq * kq;
          const float kd0 = k * (1.f + (av0 - 1.f) * kaw_[r]);
          const float kd1 = k * (1.f + (av1 - 1.f) * kaw_[r]);
          bs += rr[r] * (kd0 + kd1) * rkw_[r];
        }
        __builtin_amdgcn_sched_barrier(0);
      }
      ss += __shfl_xor(ss, 16); ss += __shfl_xor(ss, 32);
      bs += __shfl_xor(bs, 16); bs += __shfl_xor(bs, 32);
      const float inrm = 1.f / fmaxf(sqrtf(ss), 1e-12f);
#pragma unroll
      for (int nf = 0; nf < 4; ++nf) {
        const int c0 = 64 * wid + 16 * nf + 4 * fq, n0 = 16 * nf + 4 * fq;
        const float4 r4 = *reinterpret_cast<const float4*>(F + fr * FLD + c0);
        const float4 k4 = *reinterpret_cast<const float4*>(F + fr * FLD + 256 + c0);
        const float4 v4 = *reinterpret_cast<const float4*>(F + fr * FLD + 512 + c0);
        const float4 kkw = *reinterpret_cast<const float4*>(PRM + 1024 + c0);
        const float4 kaw = *reinterpret_cast<const float4*>(PRM + 1280 + c0);
        const float kk_[4] = {k4.x, k4.y, k4.z, k4.w}, kkw_[4] = {kkw.x, kkw.y, kkw.z, kkw.w}, kaw_[4] = {kaw.x, kaw.y, kaw.z, kaw.w};
        float* sc = p.SC + ((size_t)(tok * 4 + wid) * 9) * 64 + n0;
        float kn[4], kd0[4], kd1[4];
#pragma unroll
        for (int r = 0; r < 4; ++r) {
          kn[r] = kk_[r] * kkw_[r] * inrm;
          kd0[r] = kk_[r] * (1.f + (acc[2][nf][r] - 1.f) * kaw_[r]);
          kd1[r] = kk_[r] * (1.f + (acc[3][nf][r] - 1.f) * kaw_[r]);
        }
        *reinterpret_cast<float4*>(sc) = r4;
        *reinterpret_cast<float4*>(sc + 64) = make_float4(kn[0], kn[1], kn[2], kn[3]);
        *reinterpret_cast<float4*>(sc + 128) = v4;
        *reinterpret_cast<float4*>(sc + 192) = make_float4(acc[0][nf][0], acc[0][nf][1], acc[0][nf][2], acc[0][nf][3]);
        *reinterpret_cast<float4*>(sc + 256) = make_float4(acc[2][nf][0] * kn[0], acc[2][nf][1] * kn[1], acc[2][nf][2] * kn[2], acc[2][nf][3] * kn[3]);
        *reinterpret_cast<float4*>(sc + 320) = make_float4(kd0[0], kd0[1], kd0[2], kd0[3]);
        *reinterpret_cast<float4*>(sc + 384) = make_float4(acc[1][nf][0], acc[1][nf][1], acc[1][nf][2], acc[1][nf][3]);
        *reinterpret_cast<float4*>(sc + 448) = make_float4(acc[3][nf][0] * kn[0], acc[3][nf][1] * kn[1], acc[3][nf][2] * kn[2], acc[3][nf][3] * kn[3]);
        *reinterpret_cast<float4*>(sc + 512) = make_float4(kd1[0], kd1[1], kd1[2], kd1[3]);
        *reinterpret_cast<float4*>(p.G + (size_t)tok * 256 + c0) = make_float4(acc[4][nf][0], acc[4][nf][1], acc[4][nf][2], acc[4][nf][3]);
        *reinterpret_cast<float4*>(p.BV + (size_t)tok * 256 + c0) = make_float4(bs * v4.x, bs * v4.y, bs * v4.z, bs * v4.w);
        __builtin_amdgcn_sched_barrier(0);
      }
    }
#endif
    }
    }
    if (!doR && pv_ != 1) {
#ifndef NO_D
    {
      const int tok = tid >> 4, g8 = tid & 15, tokg = tok0 + tok, tpos = tpos0 + tok;
      const int tkey = isctx ? tpos : 512 + tpos;
      const float* pr = p.PROJ + (size_t)tokg * DIN;
#pragma unroll
      for (int hh = 0; hh < 2; ++hh) {
        const int g = g8 + 16 * hh, c0 = g * 8, hd = c0 >> 6, d0 = c0 & 63;
        const float4 qa = *reinterpret_cast<const float4*>(pr + 1152 + c0), qb = *reinterpret_cast<const float4*>(pr + 1152 + c0 + 4);
        const float4 ka = *reinterpret_cast<const float4*>(pr + 1408 + c0), kb2 = *reinterpret_cast<const float4*>(pr + 1408 + c0 + 4);
        const float qv[8] = {qa.x * QSCALE, qa.y * QSCALE, qa.z * QSCALE, qa.w * QSCALE, qb.x * QSCALE, qb.y * QSCALE, qb.z * QSCALE, qb.w * QSCALE};
        const float kv[8] = {ka.x, ka.y, ka.z, ka.w, kb2.x, kb2.y, kb2.z, kb2.w};
        if (isctx) {
          float* ok = p.out_nak + ((size_t)(b * 4 + layer) * 256 + tpos) * 256 + c0;
          *reinterpret_cast<float4*>(ok) = ka; *reinterpret_cast<float4*>(ok + 4) = kb2;
          pack8_store(p.QNc + (size_t)tokg * 256 + c0, qv);
          pack8_store(p.KNc + (size_t)(b * 4 + hd) * 16384 + kf_off(tkey, d0), kv);
        } else {
          pack8_store(p.QNl + (size_t)(tokg - NCTX) * 256 + c0, qv);
          pack8_store(p.KNl + ((size_t)((layer * 2 + b) * 4 + hd)) * 98304 + kf_off(tkey, d0), kv);
        }
      }
#pragma unroll
      for (int hh = 0; hh < 5; ++hh) {
        const bool isk = (hh == 4);
        const int g = isk ? g8 : g8 + 16 * hh, d0 = (g & 7) * 8, hd = g >> 3;
        const float* src = pr + (isk ? 2432 : 1920) + g * 8;
        const float4 xa = *reinterpret_cast<const float4*>(src), xb = *reinterpret_cast<const float4*>(src + 4);
        const float* nw = (isk ? p.in[25] : p.in[24]) + (size_t)layer * 64 + d0;
        const float4 na = *reinterpret_cast<const float4*>(nw), nb = *reinterpret_cast<const float4*>(nw + 4);
        float x[8] = {xa.x, xa.y, xa.z, xa.w, xb.x, xb.y, xb.z, xb.w};
        const float nrm[8] = {na.x, na.y, na.z, na.w, nb.x, nb.y, nb.z, nb.w};
        float ss = 0.f;
#pragma unroll
        for (int e = 0; e < 8; ++e) ss += x[e] * x[e];
        ss += dpp_mov<0xB1>(ss); ss += dpp_mov<0x4E>(ss); ss += dpp_mov<0x141>(ss);
        const float rs = rsqrtf(ss * (1.f / 64.f) + 1e-6f);
#pragma unroll
        for (int e = 0; e < 8; ++e) x[e] = x[e] * rs * nrm[e];
        if (isk && isctx) {
          float* ok = p.out_gk + ((size_t)(b * 4 + layer) * 256 + tpos) * 128 + g * 8;
          *reinterpret_cast<float4*>(ok) = make_float4(x[0], x[1], x[2], x[3]);
          *reinterpret_cast<float4*>(ok + 4) = make_float4(x[4], x[5], x[6], x[7]);
        }
        if (!isctx) {
          const int pos = (d0 < 32) ? (tpos >> 6) : (tpos & 63);
          const float4* rt = reinterpret_cast<const float4*>(p.rope + (size_t)(pos * 16 + (d0 & 15)) * 2);
          const float4 r0 = rt[0], r1 = rt[1], r2 = rt[2], r3 = rt[3];
          const float cs[8] = {r0.x, r0.z, r1.x, r1.z, r2.x, r2.z, r3.x, r3.z};
          const float sn[8] = {r0.y, r0.w, r1.y, r1.w, r2.y, r2.w, r3.y, r3.w};
          const float sg = (d0 & 16) ? 1.f : -1.f;
#pragma unroll
          for (int e = 0; e < 8; ++e) { const float pe = dpp_mov<0x4E>(x[e]); x[e] = x[e] * cs[e] + sg * pe * sn[e]; }
        }
        if (!isk) {
#pragma unroll
          for (int e = 0; e < 8; ++e) x[e] *= QSCALE;
          if (isctx) pack8_store(p.QGc + (size_t)tokg * 512 + g * 8, x);
          else pack8_store(p.QGl + (size_t)(tokg - NCTX) * 512 + g * 8, x);
        } else {
          if (isctx) pack8_store(p.KGc + (size_t)(b * 2 + hd) * 16384 + kf_off(tkey, d0), x);
          else pack8_store(p.KGl + ((size_t)((layer * 2 + b) * 2 + hd)) * 98304 + kf_off(tkey, d0), x);
        }
      }
    }
    const int c = tid;
#pragma unroll
    for (int half = 0; half < 2; ++half) {
      float vv[8];
#pragma unroll
      for (int t8 = 0; t8 < 8; ++t8) {
        const int tt = half * 8 + t8, tokn = tok0 + tt;
        const float v = p.PROJ[(size_t)tokn * DIN + 1664 + c];
        vv[t8] = v;
        if (isctx) p.out_nav[((size_t)(b * 4 + layer) * 256 + tpos0 + tt) * 256 + c] = v;
      }
      if (isctx) pack44_store(p.VNtc + (size_t)(b * 4 + (c >> 6)) * 16384, tpos0 + half * 8, c & 63, vv);
      else pack44_store(p.VNtl + ((size_t)((layer * 2 + b) * 4 + (c >> 6))) * 98304, 512 + tpos0 + half * 8, c & 63, vv);
    }
    if (wid >= 2) {
      const int cv = c - 128;
#pragma unroll
      for (int half = 0; half < 2; ++half) {
        float vv[8];
#pragma unroll
        for (int t8 = 0; t8 < 8; ++t8) {
          const int tt = half * 8 + t8, tokn = tok0 + tt;
          const float v = p.PROJ[(size_t)tokn * DIN + 2560 + cv];
          vv[t8] = v;
          if (isctx) p.out_gv[((size_t)(b * 4 + layer) * 256 + tpos0 + tt) * 128 + cv] = v;
        }
        if (isctx) pack44_store(p.VGtc + (size_t)(b * 2 + (cv >> 6)) * 16384, tpos0 + half * 8, cv & 63, vv);
        else pack44_store(p.VGtl + ((size_t)((layer * 2 + b) * 2 + (cv >> 6))) * 98304, 512 + tpos0 + half * 8, cv & 63, vv);
      }
    }
#endif
    }
    __syncthreads();
  }
}

#define ATT_LOAD(KF, VF, CI) { \
    const int ci_ = min((CI), nt - 1); \
    int kb_; \
    if (ci_ < nd) kb_ = ci_ * 32; \
    else { const int e_ = ci_ - nd; const int j_ = (ncc == 2) ? (e_ >> 1) : e_; const int cc_ = cc0 + ((ncc == 2) ? (e_ & 1) : 0); kb_ = 512 + (rb + j_) * 64 + cc_ * 32; } \
    const u16* kp_ = Kb + (size_t)(kb_ >> 4) * 1024 + lane * 8; \
    KF##00 = *reinterpret_cast<const bf16x8*>(kp_); \
    KF##01 = *reinterpret_cast<const bf16x8*>(kp_ + 512); \
    KF##10 = *reinterpret_cast<const bf16x8*>(kp_ + 1024); \
    KF##11 = *reinterpret_cast<const bf16x8*>(kp_ + 1536); \
    const u16* vp_ = Vt + (size_t)(kb_ >> 5) * 2048 + lane * 8; \
    VF##0 = *reinterpret_cast<const bf16x8*>(vp_); \
    VF##1 = *reinterpret_cast<const bf16x8*>(vp_ + 512); \
    VF##2 = *reinterpret_cast<const bf16x8*>(vp_ + 1024); \
    VF##3 = *reinterpret_cast<const bf16x8*>(vp_ + 1536); }

#define ATT_PV(DT, VV) { \
    o[DT][0] *= alpha; o[DT][1] *= alpha; o[DT][2] *= alpha; o[DT][3] *= alpha; \
    o[DT] = __builtin_amdgcn_mfma_f32_16x16x32_bf16(VV, pf.v, o[DT], 0, 0, 0); }

#define ATT_COMPUTE(KF, VF, CI) { \
    const int ci_ = (CI); \
    f32x4 s0 = (f32x4){0.f, 0.f, 0.f, 0.f}, s1 = (f32x4){0.f, 0.f, 0.f, 0.f}; \
    s0 = __builtin_amdgcn_mfma_f32_16x16x32_bf16(KF##00, qf0, s0, 0, 0, 0); \
    s0 = __builtin_amdgcn_mfma_f32_16x16x32_bf16(KF##01, qf1, s0, 0, 0, 0); \
    s1 = __builtin_amdgcn_mfma_f32_16x16x32_bf16(KF##10, qf0, s1, 0, 0, 0); \
    s1 = __builtin_amdgcn_mfma_f32_16x16x32_bf16(KF##11, qf1, s1, 0, 0, 0); \
    float sv[8] = {s0[0], s0[1], s0[2], s0[3], s1[0], s1[1], s1[2], s1[3]}; \
    bool ok[8]; \
    _Pragma("unroll") for (int e = 0; e < 8; ++e) ok[e] = true; \
    if (ci_ >= nd) { \
      const int e_ = ci_ - nd; const int j_ = (ncc == 2) ? (e_ >> 1) : e_; const int cc_ = cc0 + ((ncc == 2) ? (e_ & 1) : 0); \
      const int dr_ = rb + j_ - grow + 7; \
      const int cq = cq0 + fr, c0 = min(max(cq - 8, 0), 48); \
      _Pragma("unroll") for (int e = 0; e < 8; ++e) { \
        const int ck = cc_ * 32 + 16 * (e >> 2) + 4 * fq + (e & 3); \
        ok[e] = (ck >= c0) && (ck < c0 + 16); \
        const int dc = min(max(ck - cq, -15), 15) + 15; \
        const float bias = rpb[dr_ * 31 + dc] * LOG2E; \
        sv[e] = ok[e] ? sv[e] + bias : -1e30f; \
      } \
    } \
    float mx = fmaxf(fmaxf(fmaxf(sv[0], sv[1]), fmaxf(sv[2], sv[3])), fmaxf(fmaxf(sv[4], sv[5]), fmaxf(sv[6], sv[7]))); \
    mx = fmaxf(mx, __shfl_xor(mx, 16)); \
    mx = fmaxf(mx, __shfl_xor(mx, 32)); \
    const float mn = fmaxf(m, mx); \
    const float alpha = __builtin_amdgcn_exp2f(m - mn); \
    m = mn; \
    float ps = 0.f; \
    _Pragma("unroll") for (int e = 0; e < 8; ++e) { sv[e] = ok[e] ? __builtin_amdgcn_exp2f(sv[e] - mn) : 0.f; ps += sv[e]; } \
    l = l * alpha + ps; \
    union { bf16x8 v; unsigned u[4]; } pf; \
    pf.u[0] = pack2(sv[0], sv[1]); pf.u[1] = pack2(sv[2], sv[3]); pf.u[2] = pack2(sv[4], sv[5]); pf.u[3] = pack2(sv[6], sv[7]); \
    ATT_PV(0, VF##0) ATT_PV(1, VF##1) ATT_PV(2, VF##2) ATT_PV(3, VF##3) }

__device__ __forceinline__ void attn_wave(const u16* __restrict__ Q, int ldq, const u16* __restrict__ Kb, int ldk,
                                          const u16* __restrict__ Vt, int ldv, int ndense, const bool NA,
                                          const float* __restrict__ rpb, int grow, int cq0,
                                          u16* __restrict__ out, int ldo, int tidx) {
  const int lane = tidx & 63, fr = lane & 15, fq = lane >> 4;
  const bf16x8 qf0 = *reinterpret_cast<const bf16x8*>(Q + (size_t)fr * ldq + fq * 8);
  const bf16x8 qf1 = *reinterpret_cast<const bf16x8*>(Q + (size_t)fr * ldq + 32 + fq * 8);
  f32x4 o[4];
#pragma unroll
  for (int dt = 0; dt < 4; ++dt) o[dt] = (f32x4){0.f, 0.f, 0.f, 0.f};
  float m = -1e30f, l = 0.f;
  const int nd = ndense >> 5;
  const int rb = min(max(grow - 4, 0), 8);
  const int ulo = min(max(cq0 - 8, 0), 48), uhi = min(max(cq0 + 15 - 8, 0), 48) + 16;
  const bool c0ok = ulo < 32, c1ok = uhi > 32;
  const int ncc = (c0ok && c1ok) ? 2 : 1, cc0 = c0ok ? 0 : 1;
  const int nt = nd + (NA ? 8 * ncc : 0);
  bf16x8 ka00, ka01, ka10, ka11, kb00, kb01, kb10, kb11;
  bf16x8 va0, va1, va2, va3, vb0, vb1, vb2, vb3;
  ATT_LOAD(ka, va, 0)
  for (int ci = 0; ci < nt; ci += 2) {
    ATT_LOAD(kb, vb, ci + 1)
    ATT_COMPUTE(ka, va, ci)
    if (ci + 1 < nt) {
      ATT_LOAD(ka, va, ci + 2)
      ATT_COMPUTE(kb, vb, ci + 1)
    }
  }
  l += __shfl_xor(l, 16);
  l += __shfl_xor(l, 32);
  const float il = 1.f / l;
#pragma unroll
  for (int dt = 0; dt < 4; ++dt) {
    uint2 pk; pk.x = pack2(o[dt][0] * il, o[dt][1] * il); pk.y = pack2(o[dt][2] * il, o[dt][3] * il);
    *reinterpret_cast<uint2*>(out + (size_t)fr * ldo + 16 * dt + 4 * fq) = pk;
  }
}

__device__ void scan_item(const Params& p, int layer, char* smem, bool lat, int b, int h, int dir, int qd, int tidx) {
  const int tid = tidx, lane = tid & 63, wid = tid >> 6, rr = lane >> 4, j = lane & 15;
  const int L = lat ? 1024 : 256, seqbase = lat ? NCTX + b * 1024 : b * 256;
  const int rowl = wid * 4 + rr, row = qd * 16 + rowl;
  float* cbuf = reinterpret_cast<float*>(smem);
  float* obuf = cbuf + 2 * 16 * 6 * 64;
  float4 S = make_float4(0.f, 0.f, 0.f, 0.f);
  if (lat) S = *reinterpret_cast<const float4*>(p.in[2] + ((((size_t)(b * 4 + layer) * 2 + dir) * 4 + h) * 64 + row) * 64 + 4 * j);
  v2f S01 = (v2f){S.x, S.y}, S23 = (v2f){S.z, S.w};
  const int nch = L / 16;
  float* odst = dir == 0 ? p.OF : p.OB;
  float4 pre0, pre1, pre2, pre3, pre4, pre5;
  const ptrdiff_t cstep = (dir == 0 ? 1 : -1) * (ptrdiff_t)(16 * 4 * 9 * 64);
  const float *gp0, *gp1, *gp2, *gp3, *gp4, *gp5;
#define SC_GP(GP, I) { const int idx = tid + 256 * (I), tt_ = idx / 96, rem = idx % 96, vec = rem >> 4, f4 = rem & 15; \
    const int t_ = dir == 0 ? tt_ : L - 1 - tt_; const int svec = vec < 3 ? vec : vec + 3 * dir; \
    GP = p.SC + ((size_t)((seqbase + t_) * 4 + h) * 9 + svec) * 64 + f4 * 4; }
  SC_GP(gp0, 0) SC_GP(gp1, 1) SC_GP(gp2, 2) SC_GP(gp3, 3) SC_GP(gp4, 4) SC_GP(gp5, 5)
#define SC_GL1(PR, GP, CH) PR = *reinterpret_cast<const float4*>(GP + (ptrdiff_t)(CH) * cstep);
#define gload(CH) { SC_GL1(pre0, gp0, CH) SC_GL1(pre1, gp1, CH) SC_GL1(pre2, gp2, CH) SC_GL1(pre3, gp3, CH) SC_GL1(pre4, gp4, CH) SC_GL1(pre5, gp5, CH) }
#define SC_LS1(PR, I, BUF) *reinterpret_cast<float4*>(cbuf + (BUF) * 6144 + (tid + 256 * (I)) * 4) = PR;
#define lstore(BUF) { SC_LS1(pre0, 0, BUF) SC_LS1(pre1, 1, BUF) SC_LS1(pre2, 2, BUF) SC_LS1(pre3, 3, BUF) SC_LS1(pre4, 4, BUF) SC_LS1(pre5, 5, BUF) }
  gload(0); lstore(0);
  __syncthreads();
#define SC_LD(R4, K4, VV, W4, A4, D4, TT) { const float* base_ = cb + (TT) * 384; \
    R4 = *reinterpret_cast<const float4*>(base_ + 4 * j); K4 = *reinterpret_cast<const float4*>(base_ + 64 + 4 * j); \
    VV = base_[128 + row]; W4 = *reinterpret_cast<const float4*>(base_ + 192 + 4 * j); \
    A4 = *reinterpret_cast<const float4*>(base_ + 256 + 4 * j); D4 = *reinterpret_cast<const float4*>(base_ + 320 + 4 * j); }
#if SCANVAR
  for (int pass_ = 0; pass_ < (lat ? 2 : 1); ++pass_) {
  int var_ = pass_ ? SCANVAR : 0;
  asm volatile("" : "+v"(var_)); var_ = __builtin_amdgcn_readfirstlane(var_);
#else
  const int var_ = 0;
#endif
  for (int ch = 0; ch < nch; ++ch) {
    if (ch + 1 < nch && var_ != 3) gload(ch + 1);
    const float* cb = cbuf + (ch & 1) * 6144;
    float osel = 0.f;
    float4 r4, kk4, w4, ak4, kd4; float vv;
    SC_LD(r4, kk4, vv, w4, ak4, kd4, 0)
    if (var_ != 2)
#pragma unroll
    for (int hf = 0; hf < 2; ++hf) {
      float oqA = 0.f, oqB = 0.f, ovp = 0.f;
#pragma unroll
      for (int u = 0; u < 8; ++u) {
        const int tt = hf * 8 + u;
        float4 r4n, kk4n, w4n, ak4n, kd4n; float vvn;
        SC_LD(r4n, kk4n, vvn, w4n, ak4n, kd4n, tt + 1)
        v2f p = S01 * (v2f){kk4.x, kk4.y};
        p = S23 * (v2f){kk4.z, kk4.w} + p;
        float sk = p.x + p.y;
        sk += dpp_mov<0xB1>(sk);  ovp += dpp_mov<0xB1>(ovp);
        sk += dpp_mov<0x4E>(sk);  ovp += dpp_mov<0x4E>(ovp);
        sk += dpp_mov<0x141>(sk);
        sk += dpp_mov<0x140>(sk);
        if (u > 0) {
          if (((u - 1) >> 2) == 0) oqA = ((j & 3) == ((u - 1) & 3)) ? ovp : oqA;
          else oqB = ((j & 3) == ((u - 1) & 3)) ? ovp : oqB;
        }
        const v2f vv2 = (v2f){vv, vv}, sk2 = (v2f){sk, sk};
        v2f t01 = (v2f){kd4.x, kd4.y} * vv2; t01 = t01 - (v2f){ak4.x, ak4.y} * sk2;
        v2f t23 = (v2f){kd4.z, kd4.w} * vv2; t23 = t23 - (v2f){ak4.z, ak4.w} * sk2;
        S01 = S01 * (v2f){w4.x, w4.y} + t01;
        S23 = S23 * (v2f){w4.z, w4.w} + t23;
        v2f q = S01 * (v2f){r4.x, r4.y};
        q = S23 * (v2f){r4.z, r4.w} + q;
        ovp = q.x + q.y;
        r4 = r4n; kk4 = kk4n; w4 = w4n; ak4 = ak4n; kd4 = kd4n; vv = vvn;
      }
      ovp += dpp_mov<0xB1>(ovp); ovp += dpp_mov<0x4E>(ovp);
      oqB = ((j & 3) == 3) ? ovp : oqB;
      oqA += dpp_mov<0x128>(oqA); oqB += dpp_mov<0x128>(oqB);
      oqA += dpp_mov<0x124>(oqA); oqB += dpp_mov<0x124>(oqB);
      if ((j >> 3) == hf) osel = ((j >> 2) & 1) ? oqB : oqA;
    }
    if (var_ == 0) {
      const int st = ch * 16 + j, t = dir == 0 ? st : L - 1 - st;
      odst[(size_t)(seqbase + t) * 256 + h * 64 + row] = osel;
    } else asm volatile("" :: "v"(osel), "v"(S01), "v"(S23));
    if (ch + 1 < nch && var_ != 3) lstore((ch + 1) & 1);
    asm volatile("s_waitcnt lgkmcnt(0)" ::: "memory");
    __builtin_amdgcn_s_barrier();
  }
#if SCANVAR
  }
#endif
  if (!lat) *reinterpret_cast<float4*>(p.out_st + ((((size_t)(b * 4 + layer) * 2 + dir) * 4 + h) * 64 + row) * 64 + 4 * j) = make_float4(S01.x, S01.y, S23.x, S23.y);
  __syncthreads();
}

__device__ void mixer_phase(const Params& p, int layer_wq, char* smem, int tidx0) {
  const int layer = layer_wq & 3;
  int* slot = reinterpret_cast<int*>(smem + 60 * 1024);
  bool first = true;
  for (;;) {
    int tidx = tidx0;
    asm volatile("" : "+v"(tidx));
    const int tid = tidx, wid = tid >> 6;
    __syncthreads();
    if (tid == 0) {
      int nx;
      const int bx = (int)blockIdx.x;
      if (gridDim.x != 512) nx = first ? bx : (int)(gridDim.x + atomicAdd(&p.wq[layer_wq], 1u));
      else if (first) nx = (bx >= 256 && bx < 320) ? 1728 : (bx >= 448 ? 256 + (bx - 448) : bx);
      else nx = 448 + (int)atomicAdd(&p.wq[layer_wq], 1u);
      *slot = nx;
    }
    first = false;
    __syncthreads();
    int it = *slot;
    if (it >= 1728) break;
    const bool is_scan = (it < 64) || (it >= 448 && it < 960);
#if REPMASK
    if ((p.pad == 1 && !is_scan) || (p.pad == 2 && is_scan) || ((p.pad == 3 || p.pad == 5 || p.pad == 6) && !(it < 64)) || (p.pad == 4 && !(it >= 64 && it < 320))) continue;
#endif
    if (is_scan) {
      const bool lat = it < 64;
      const int si = lat ? it : it - 448;
#ifndef NO_SCAN
      scan_item(p, layer, smem, lat, si / 32, (si / 8) % 4, (si / 4) % 2, si % 4, tidx);
#endif
      continue;
    }
    const u16 *Q, *Kb, *Vt; u16* out; int ldq, ldk, ldv, ndense, grow = 0, cq0 = 0; bool na = false;
    const float* rpb = p.in[23];
    if (it < 320) {
      it -= 64;
      const int b = it / 128, qh = (it / 16) % 8, qt = it % 16, kvh = qh >> 2;
      const int q0 = b * 1024 + qt * 64 + wid * 16;
      Q = p.QGl + (size_t)q0 * 512 + qh * 64; ldq = 512;
      Kb = p.KGl + (size_t)((layer * 2 + b) * 2 + kvh) * 98304; ldk = 0;
      Vt = p.VGtl + (size_t)((layer * 2 + b) * 2 + kvh) * 98304; ldv = 0; ndense = 1536;
      out = p.MIX + (size_t)(NCTX + q0) * DM + 512 + qh * 64;
    } else if (it < 448) {
      it -= 320;
      const int b = it / 64, h = (it / 16) % 4, r = it % 16;
      const int q0 = b * 1024 + r * 64 + wid * 16;
      Q = p.QNl + (size_t)q0 * 256 + h * 64; ldq = 256;
      Kb = p.KNl + (size_t)((layer * 2 + b) * 4 + h) * 98304; ldk = 0;
      Vt = p.VNtl + (size_t)((layer * 2 + b) * 4 + h) * 98304; ldv = 0; ndense = 512;
      rpb = p.in[23] + (size_t)(layer * 4 + h) * 15 * 31; grow = r; cq0 = wid * 16; na = true;
      out = p.MIX + (size_t)(NCTX + q0) * DM + 256 + h * 64;
    } else if (it < 1472) {
      it -= 960;
      const int b = it / 32, qh = (it / 4) % 8, qt = it % 4, kvh = qh >> 2;
      const int q0 = b * 256 + qt * 64 + wid * 16;
      Q = p.QGc + (size_t)q0 * 512 + qh * 64; ldq = 512;
      Kb = p.KGc + (size_t)(b * 2 + kvh) * 16384; ldk = 0;
      Vt = p.VGtc + (size_t)(b * 2 + kvh) * 16384; ldv = 0; ndense = 256;
      out = p.MIX + (size_t)q0 * DM + 512 + qh * 64;
    } else {
      it -= 1472;
      const int b = it / 16, h = (it / 4) % 4, qt = it % 4;
      const int q0 = b * 256 + qt * 64 + wid * 16;
      Q = p.QNc + (size_t)q0 * 256 + h * 64; ldq = 256;
      Kb = p.KNc + (size_t)(b * 4 + h) * 16384; ldk = 0;
      Vt = p.VNtc + (size_t)(b * 4 + h) * 16384; ldv = 0; ndense = 256;
      out = p.MIX + (size_t)q0 * DM + 256 + h * 64;
    }
#ifndef NO_ATT
    attn_wave(Q, ldq, Kb, ldk, Vt, ldv, ndense, na, rpb, grow, cq0, out, DM, tidx);
#endif
  }
}

__device__ void rwkv_fin_phase(const Params& p, int layer, int bid, int nblk, int tidx) {
  const int tid = tidx;
  const float lw = p.in[21][(size_t)layer * 256 + tid], lb = p.in[22][(size_t)layer * 256 + tid];
  for (int t4 = bid; t4 < NTOK / 4; t4 += nblk) {
    float of[4], ob[4], bv[4], gg[4];
#pragma unroll
    for (int u = 0; u < 4; ++u) {
      const size_t i = (size_t)(t4 * 4 + u) * 256 + tid;
      of[u] = p.OF[i]; ob[u] = p.OB[i]; bv[u] = p.BV[i]; gg[u] = p.G[i];
    }
#pragma unroll
    for (int u = 0; u < 4; ++u) {
      const float o = of[u] + ob[u];
      const float mu = wave_sum(o) * (1.f / 64.f);
      const float d = o - mu;
      const float var = wave_sum(d * d) * (1.f / 64.f);
      const float y = (d * rsqrtf(var + 64e-5f) * lw + lb + bv[u]) * gg[u];
      p.MIX[(size_t)(t4 * 4 + u) * DM + tid] = f2bf(y);
    }
  }
}

#ifndef ONLY_PH
#define ONLY_PH -1
#endif
#define PH_EN(x) (ONLY_PH < 0 || ONLY_PH == (x))
__device__ __forceinline__ void run_phase(const Params& p, int ph, char* smem, int bid, int nblk, int tidx, int rep = 0) {
  const bool defer = (nblk == 512);
  if (ph == 0) {
    if (PH_EN(0)) { setup_phase(p, smem, bid, nblk, tidx, 0, defer ? 192 : 768, true); weight_convert(p, smem, tidx, bid, nblk, 0, defer ? 2336 : 4 * 3040); }
    return;
  }
  if (ph == 1) { if (PH_EN(1)) modreduce_phase(p, bid, nblk, tidx, 0, defer ? 4608 : 18432); return; }
  if (ph == 2) { if (PH_EN(2)) ln_phase<0>(p, 0, bid, nblk, tidx); return; }
  const int layer = (ph - 3) / 9, s = (ph - 3) % 9;
  switch (s) {
    case 0: if (PH_EN(3)) gemm_phase<EPI_PROJ, 256, 3>(p, layer, p.A, p.winT + (size_t)layer * DIN * DM, DIN, DM, smem, bid, nblk, tidx); break;
    case 1: if (PH_EN(4)) prep_phase(p, layer, smem, bid, nblk, tidx, rep); break;
    case 2: if (PH_EN(5)) mixer_phase(p, layer + 4 * rep, smem, tidx); break;
    case 3: if (PH_EN(6)) rwkv_fin_phase(p, layer, bid, nblk, tidx); break;
    case 4:
      if (PH_EN(7)) {
        if (defer && bid >= 256) {
          if (layer == 0) { setup_phase(p, smem, bid - 256, 256, tidx, 192, 768, false); weight_convert(p, smem, tidx, bid - 256, 256, 2336, 3040); }
        } else gemm_phase<EPI_OUT, 192, 3>(p, layer, p.MIX, p.woutT + (size_t)layer * DM * DM, DM, DM, smem, bid, nblk, tidx);
      }
      break;
    case 5: if (PH_EN(8)) ln_phase<1>(p, layer, bid, nblk, tidx); break;
    case 6: if (PH_EN(9)) gemm_phase<EPI_FFI, 192, 3>(p, layer, p.A, p.wfiT + (size_t)layer * 2 * DFF * DM, 2 * DFF, DM, smem, bid, nblk, tidx); break;
    case 7:
      if (PH_EN(10)) {
        if (defer && bid >= 256) {
          if (layer < 3) weight_convert(p, smem, tidx, bid - 256, 256, 3040 * (layer + 1), 3040 * (layer + 2));
          if (layer == 0) modreduce_phase(p, bid - 256, 256, tidx, 4608, 18432);
        }
        else gemm_phase<EPI_FFO, 192, 3>(p, layer, p.ACT, p.wfoT + (size_t)layer * DM * DFF, DM, DFF, smem, bid, nblk, tidx);
      }
      break;
    default: if (PH_EN(11)) ln_phase<2>(p, layer, bid, nblk, tidx); break;
  }
}

__global__ void __launch_bounds__(256, 2) fwd_kernel(Params p, int ph0, int ph1, int usebar) {
  __shared__ __attribute__((aligned(16))) char smem[73728 + 16];
  const int bid = blockIdx.x, nblk = gridDim.x;
  XcdBarrier xb;
  if (usebar && p.never) cg::this_grid().sync();
  if (usebar) {
    if (threadIdx.x == 0) *reinterpret_cast<uint4*>(smem + 73728) = make_uint4(0u, 0u, 0u, 0u);
    __syncthreads();
    xb = xcd_barrier_post(p.bar, (volatile LAS unsigned*)(smem + 73728));
  }
  int ph = ph0, rep = 0;
  while (ph < ph1) {
    int tidx = threadIdx.x;
    asm volatile("" : "+v"(tidx));
    run_phase(p, ph, smem, bid, nblk, tidx, rep);
#if REPSLOT >= 0
    if (((ph < 3 ? 9 + ph : (ph - 3) % 9) == REPSLOT) && rep == 0) rep = 1; else { rep = 0; ++ph; }
#else
    ++ph;
#endif
    if (usebar && ph < ph1) xcd_barrier(xb);
  }
}

static inline size_t al256(size_t x) { return (x + 255) & ~(size_t)255; }

extern "C" void kernel_launch(void* const* d_in, const int* in_sizes, int n_in, void* d_out, int out_size, void* d_ws, size_t ws_size,
                              hipStream_t stream) {
  Params p;
  memset(&p, 0, sizeof(p));
  for (int i = 0; i < 33; ++i) p.in[i] = (const float*)d_in[i];
  float* o = (float*)d_out;
  p.out_yp = o; o += 4194304;
  p.out_ys = o; o += 2097152;
  p.out_st = o; o += 2097152;
  p.out_nak = o; o += 4194304;
  p.out_nav = o; o += 4194304;
  p.out_gk = o; o += 2097152;
  p.out_gv = o;
  char* w = (char*)d_ws; size_t off = 0;
  auto take = [&](size_t bytes) { char* r = w + off; off += al256(bytes); return r; };
  p.bar = (unsigned*)take(16384);
  p.wq = p.bar + 3584;
  p.modp = (float*)take((size_t)4 * 32 * 3 * 6144 * 4);
  p.mod = (float*)take((size_t)4 * 3 * 6144 * 4);
  p.winT = (u16*)take((size_t)4 * DIN * DM * 2);
  p.woutT = (u16*)take((size_t)4 * DM * DM * 2);
  p.wfiT = (u16*)take((size_t)4 * 2 * DFF * DM * 2);
  p.wfoT = (u16*)take((size_t)4 * DM * DFF * 2);
  p.X = (float*)take((size_t)NTOK * DM * 4);
  p.PROJ = (float*)take((size_t)NTOK * DIN * 4);
  p.X1 = p.PROJ;
  p.Y = p.PROJ + (size_t)NTOK * DM;
  p.SC = (float*)take((size_t)NTOK * 4 * 9 * 64 * 4);
  p.ACT = (u16*)p.SC;
  p.G = (float*)take((size_t)NTOK * 256 * 4);
  p.BV = (float*)take((size_t)NTOK * 256 * 4);
  p.OF = (float*)take((size_t)NTOK * 256 * 4);
  p.OB = (float*)take((size_t)NTOK * 256 * 4);
  p.A = (u16*)take((size_t)NTOK * DM * 2);
  p.MIX = (u16*)take((size_t)NTOK * DM * 2);
  p.QNc = (u16*)take((size_t)NCTX * 256 * 2);
  p.KNc = (u16*)take((size_t)NCTX * 256 * 2);
  p.VNtc = (u16*)take((size_t)NCTX * 256 * 2);
  p.QGc = (u16*)take((size_t)NCTX * 512 * 2);
  p.KGc = (u16*)take((size_t)NCTX * 128 * 2);
  p.VGtc = (u16*)take((size_t)NCTX * 128 * 2);
  p.QNl = (u16*)take((size_t)2048 * 256 * 2);
  p.KNl = (u16*)take((size_t)4 * 2 * 1536 * 256 * 2);
  p.VNtl = (u16*)take((size_t)4 * 2 * 1536 * 256 * 2);
  p.QGl = (u16*)take((size_t)2048 * 512 * 2);
  p.KGl = (u16*)take((size_t)4 * 2 * 1536 * 128 * 2);
  p.VGtl = (u16*)take((size_t)4 * 2 * 1536 * 128 * 2);
  p.loraT = (u16*)take((size_t)4 * 98304 * 2);
  p.rope = (float*)take((size_t)64 * 16 * 2 * 4);
  if (off > ws_size) { fprintf(stderr, "workspace too small: need %zu have %zu\n", off, ws_size); return; }

  (void)hipMemsetAsync(p.bar, 0, 16384, stream);
#if MEGA
  static int grid_blocks = 0;
  if (!grid_blocks) {
    int dev = 0, cus = 0, per_cu = 0;
    hipGetDevice(&dev);
    hipDeviceGetAttribute(&cus, hipDeviceAttributeMultiprocessorCount, dev);
    hipOccupancyMaxActiveBlocksPerMultiprocessor(&per_cu, fwd_kernel, 256, 0);
    if (per_cu > 2) per_cu = 2;
    if (per_cu < 1) per_cu = 1;
    grid_blocks = cus * per_cu;
  }
  int ph0 = 0, ph1 = NPH, ub = 1;
  void* args[] = {&p, &ph0, &ph1, &ub};
  hipError_t e = hipLaunchCooperativeKernel((void*)fwd_kernel, dim3(grid_blocks), dim3(256), args, 0, stream);
  if (e != hipSuccess) fprintf(stderr, "cooperative launch failed: %s (grid %d)\n", hipGetErrorString(e), grid_blocks);
#else
  for (int ph = 0; ph < NPH; ++ph) fwd_kernel<<<512, 256, 0, stream>>>(p, ph, ph + 1, 0);
#endif
}
```

```cpp
#include <hip/hip_runtime.h>
#include <hip/hip_cooperative_groups.h>
#include <cstdio>
#include <cstdint>
#include <cstring>
namespace cg = cooperative_groups;

#ifndef REPMASK
#define REPMASK 0
#endif
#ifndef REPSLOT
#define REPSLOT -1
#endif
#ifndef PREPVAR
#define PREPVAR 0
#endif
#ifndef SCANVAR
#define SCANVAR 0
#endif
#ifndef REPVAR
#define REPVAR 0
#endif
#ifndef MEGA
#define MEGA 1
#endif

typedef unsigned short u16;
using bf16x8 = __attribute__((ext_vector_type(8))) short;
using f32x4 = __attribute__((ext_vector_type(4))) float;
using v2f = __attribute__((ext_vector_type(2))) float;

#define NTOK 6144
#define NCTX 4096
#define DM 1024
#define DIN 2688
#define DFF 2816
#define NPH 39
#define ALPHA 1.681792830507429f
#define LOG2E 1.4426950408889634f
#define QSCALE (0.125f * LOG2E)

struct Params {
  const float* in[33];
  float *out_yp, *out_ys, *out_st, *out_nak, *out_nav, *out_gk, *out_gv;
  unsigned *bar, *wq;
  float *modp, *mod;
  u16 *winT, *woutT, *wfiT, *wfoT;
  float *X, *X1, *Y, *PROJ, *SC, *G, *BV, *OF, *OB;
  u16 *A, *MIX, *ACT;
  u16 *QNc, *KNc, *VNtc, *QGc, *KGc, *VGtc;
  u16 *QNl, *KNl, *VNtl, *QGl, *KGl, *VGtl;
  u16* loraT; float* rope;
  int never; int pad;
};

__device__ __forceinline__ u16 f2bf(float f) {
  unsigned u = __float_as_uint(f);
  u += 0x7FFFu + ((u >> 16) & 1u);
  return (u16)(u >> 16);
}
typedef __bf16 bf16v2 __attribute__((ext_vector_type(2)));
__device__ __forceinline__ unsigned pack2(float a, float b) {
  const bf16v2 r = __builtin_convertvector((v2f){a, b}, bf16v2);
  return __builtin_bit_cast(unsigned, r);
}
template <int CTRL> __device__ __forceinline__ float dpp_mov(float v) {
  return __int_as_float(__builtin_amdgcn_update_dpp(0, __float_as_int(v), CTRL, 0xF, 0xF, false));
}
__device__ __forceinline__ float reduce16(float v) {
  v += dpp_mov<0xB1>(v);
  v += dpp_mov<0x4E>(v);
  v += dpp_mov<0x141>(v);
  v += dpp_mov<0x140>(v);
  return v;
}
__device__ __forceinline__ float wave_sum(float v) {
  v = reduce16(v);
  v += __shfl_xor(v, 16);
  v += __shfl_xor(v, 32);
  return v;
}
__device__ __forceinline__ float tanhf_(float x) { const float e = __expf(-2.f * fabsf(x)); const float t = (1.f - e) / (1.f + e); return x < 0.f ? -t : t; }
__device__ __forceinline__ float sigmoidf_(float x) { return 1.f / (1.f + __expf(-x)); }
__device__ __forceinline__ float siluf_(float x) { return x / (1.f + __expf(-x)); }
__device__ __forceinline__ int modrow_of(int tok) { return tok < NCTX ? 0 : 1 + ((tok - NCTX) >> 10); }

#define XB_TMO      128
#define XB_XCNT(j)  (256  + 64 * (j))
#define XB_XSUB(j)  (1280 + 64 * (j))
#define XB_XGEN(j)  (2304 + 64 * (j))
#define XB_TOP      3328
#define XB_TOPGEN   3392
#define XCD_BAR_WORDS 3456
#define XB_SPIN_CAP (1u << 22)
#define LAS __attribute__((address_space(3)))
__device__ __forceinline__ unsigned xb_ld(unsigned* p) { return __hip_atomic_load(p, __ATOMIC_RELAXED, __HIP_MEMORY_SCOPE_AGENT); }
__device__ __forceinline__ unsigned xb_add(unsigned* p, unsigned v) { return __hip_atomic_fetch_add(p, v, __ATOMIC_RELAXED, __HIP_MEMORY_SCOPE_AGENT); }
__device__ __forceinline__ unsigned xb_xcc_id() { return (unsigned)__builtin_amdgcn_s_getreg((3 << 11) | 20) & 0xFu; }
#define XB_SPIN(cond, bar) do { unsigned _sp = 0; while (cond) { __builtin_amdgcn_s_sleep(1); \
    if ((++_sp & 255u) == 0u) { if (xb_ld(&(bar)[XB_TMO])) break; if (_sp > XB_SPIN_CAP) { atomicAdd(&(bar)[XB_TMO], 1u); break; } } } } while (0)
struct XcdBarrier { unsigned* bar; unsigned x; volatile LAS unsigned* st; };
__device__ __forceinline__ XcdBarrier xcd_barrier_post(unsigned* bar, volatile LAS unsigned* st) {
  XcdBarrier b; b.bar = bar; b.x = xb_xcc_id(); b.st = st;
  if (threadIdx.x == 0) (void)xb_add(&bar[XB_XCNT(b.x)], 1u);
  return b;
}
__device__ __forceinline__ void xcd_barrier_complete(unsigned* bar, unsigned x, unsigned& nloc, unsigned& nx) {
  const unsigned G = gridDim.x * gridDim.y * gridDim.z;
  unsigned sum, cnt, mine, sp = 0u;
  for (;;) {
    sum = 0u; cnt = 0u; mine = 0u;
#pragma unroll
    for (unsigned j = 0; j < 16; ++j) { const unsigned c = xb_ld(&bar[XB_XCNT(j)]); sum += c; cnt += (c > 0u) ? 1u : 0u; mine = (j == x) ? c : mine; }
    if (sum == G) break;
    __builtin_amdgcn_s_sleep(1);
    if ((++sp & 255u) == 0u) { if (xb_ld(&bar[XB_TMO])) break; if (sp > XB_SPIN_CAP) { atomicAdd(&bar[XB_TMO], 1u); break; } }
  }
  nloc = mine > 0u ? mine : 1u; nx = cnt > 0u ? cnt : 1u;
}
__device__ __forceinline__ void xcd_barrier(const XcdBarrier& b) {
  asm volatile("s_waitcnt vmcnt(0)" ::: "memory");
  __syncthreads();
  if (threadIdx.x == 0) {
    unsigned* bar = b.bar;
    asm volatile("" : "+s"(bar));
    __builtin_amdgcn_s_waitcnt(0);
    unsigned nloc = b.st[0], nx = b.st[1];
    if (nloc == 0u) { xcd_barrier_complete(bar, b.x, nloc, nx); b.st[0] = nloc; b.st[1] = nx; }
    const unsigned old = xb_add(&bar[XB_XSUB(b.x)], 1u);
    const unsigned gen = old / nloc;
    if (old + 1u == (gen + 1u) * nloc) {
      __builtin_amdgcn_fence(__ATOMIC_RELEASE, "agent");
      asm volatile("s_waitcnt vmcnt(0)" ::: "memory");
      const unsigned og = xb_add(&bar[XB_TOP], 1u);
      const unsigned tg = og / nx;
      if (og + 1u == (tg + 1u) * nx) xb_add(&bar[XB_TOPGEN], 1u);
      else XB_SPIN(xb_ld(&bar[XB_TOPGEN]) == tg, bar);
      __builtin_amdgcn_fence(__ATOMIC_ACQUIRE, "agent");
      xb_add(&bar[XB_XGEN(b.x)], 1u);
      asm volatile("s_waitcnt vmcnt(0)" ::: "memory");
    } else {
      XB_SPIN(xb_ld(&bar[XB_XGEN(b.x)]) == gen, bar);
      __builtin_amdgcn_fence(__ATOMIC_ACQUIRE, "agent");
      asm volatile("s_waitcnt vmcnt(0)" ::: "memory");
    }
  }
  __syncthreads();
}

__device__ __forceinline__ int lds_byte32(int r, int c) {
  const int ob = (r & 15) * 64 + c * 2;
  return (r >> 4) * 1024 + (ob ^ (((ob >> 9) & 1) << 5));
}
__device__ __forceinline__ void stage_rc32(int b, int& R, int& C) {
  const int sb = b & 1023, swz = sb ^ (((sb >> 9) & 1) << 5);
  R = (b >> 10) * 16 + (swz >> 6); C = (swz & 63) >> 1;
}
template <int ROWS>
__device__ __forceinline__ void stage_tile32(const u16* __restrict__ g, int ld, char* lds, int tidx) {
#pragma unroll
  for (int i = 0; i < (ROWS * 64 + 4095) / 4096; ++i) {
    const int b = tidx * 16 + i * 4096;
    if ((i + 1) * 4096 <= ROWS * 64 || tidx < (ROWS * 64 - i * 4096) / 16) {
      int R, C; stage_rc32(b, R, C);
      __builtin_amdgcn_global_load_lds((const unsigned*)(g + (size_t)R * ld + C), (unsigned LAS*)(lds + b), 16, 0, 0);
    }
  }
}
template <int N> __device__ __forceinline__ void wait_vmcnt() {
  if (N == 0) asm volatile("s_waitcnt vmcnt(0)" ::: "memory");
  else if (N == 3) asm volatile("s_waitcnt vmcnt(3)" ::: "memory");
  else if (N == 4) asm volatile("s_waitcnt vmcnt(4)" ::: "memory");
  else if (N == 5) asm volatile("s_waitcnt vmcnt(5)" ::: "memory");
  else if (N == 6) asm volatile("s_waitcnt vmcnt(6)" ::: "memory");
  else if (N == 8) asm volatile("s_waitcnt vmcnt(8)" ::: "memory");
  else if (N == 9) asm volatile("s_waitcnt vmcnt(9)" ::: "memory");
  else if (N == 10) asm volatile("s_waitcnt vmcnt(10)" ::: "memory");
  else if (N == 12) asm volatile("s_waitcnt vmcnt(12)" ::: "memory");
  else asm volatile("s_waitcnt vmcnt(0)" ::: "memory");
}

enum { EPI_PROJ = 0, EPI_OUT = 1, EPI_FFI = 2, EPI_FFO = 3 };

template <int EPI, int BM, int NST>
__device__ __forceinline__ void gemm_phase(const Params& p, int layer, const u16* __restrict__ A, const u16* __restrict__ Bt,
                                           int N, int K, char* smem, int bid, int nblk, int tidx) {
  constexpr int MF = BM / 32;
  const int tid = tidx, lane = tid & 63, wid = tid >> 6, wr = wid >> 1, wc = wid & 1, fr = lane & 15, fq = lane >> 4;
  const int nM = NTOK / BM, nN = N / 128, ntiles = nM * nN, nk = K / 32;
  constexpr int SB = (BM + 128) * 64;
  constexpr int LA = (BM * 64) / 4096;
  const bool extraA = (BM == 96) && (wid < 2);
  for (int tile = bid; tile < ntiles; tile += nblk) {
    const int pm = tile % nM, pn = tile / nM, m0 = pm * BM, n0 = pn * 128;
    f32x4 acc[MF][4];
#pragma unroll
    for (int m = 0; m < MF; ++m)
#pragma unroll
      for (int n = 0; n < 4; ++n) acc[m][n] = (f32x4){0.f, 0.f, 0.f, 0.f};
    const u16* Ag = A + (size_t)m0 * K;
    const u16* Bg = Bt + (size_t)n0 * K;
#pragma unroll
    for (int s_ = 0; s_ < NST - 1; ++s_) {
      stage_tile32<BM>(Ag + s_ * 32, K, smem + s_ * SB, tidx);
      stage_tile32<128>(Bg + s_ * 32, K, smem + s_ * SB + BM * 64, tidx);
    }
    int slot = 0, pslot = NST - 1;
    for (int kt = 0; kt < nk; ++kt) {
      if (kt + NST - 2 < nk) {
        if (BM == 96) { if (extraA) wait_vmcnt<(NST - 2) * 4>(); else wait_vmcnt<(NST - 2) * 3>(); }
        else wait_vmcnt<(NST - 2) * (LA + 2)>();
      } else {
        asm volatile("s_waitcnt vmcnt(0)" ::: "memory");
      }
      __builtin_amdgcn_s_barrier();
      if (kt + NST - 1 < nk) {
        char* nb = smem + pslot * SB;
        stage_tile32<BM>(Ag + (kt + NST - 1) * 32, K, nb, tidx);
        stage_tile32<128>(Bg + (kt + NST - 1) * 32, K, nb + BM * 64, tidx);
      }
      const char* sa = smem + slot * SB;
      const char* sb = sa + BM * 64;
      slot = (slot + 1 == NST) ? 0 : slot + 1;
      pslot = (pslot + 1 == NST) ? 0 : pslot + 1;
      bf16x8 af[MF], bfr[4];
#pragma unroll
      for (int m = 0; m < MF; ++m) af[m] = *reinterpret_cast<const bf16x8*>(sa + lds_byte32(wr * (BM / 2) + m * 16 + fr, fq * 8));
#pragma unroll
      for (int n = 0; n < 4; ++n) bfr[n] = *reinterpret_cast<const bf16x8*>(sb + lds_byte32(wc * 64 + n * 16 + fr, fq * 8));
#pragma unroll
      for (int m = 0; m < MF; ++m)
#pragma unroll
        for (int n = 0; n < 4; ++n) acc[m][n] = __builtin_amdgcn_mfma_f32_16x16x32_bf16(bfr[n], af[m], acc[m][n], 0, 0, 0);
    }
#pragma unroll
    for (int m = 0; m < MF; ++m) {
      const int row = m0 + wr * (BM / 2) + m * 16 + fr;
      if (EPI == EPI_PROJ) {
#pragma unroll
        for (int n = 0; n < 4; ++n) {
          const int col = n0 + wc * 64 + n * 16 + 4 * fq;
          *reinterpret_cast<float4*>(p.PROJ + (size_t)row * DIN + col) = make_float4(acc[m][n][0], acc[m][n][1], acc[m][n][2], acc[m][n][3]);
        }
      } else if (EPI == EPI_OUT || EPI == EPI_FFO) {
        const float* res = (EPI == EPI_OUT) ? p.X : p.X1;
        const float* gate = p.mod + ((size_t)(layer * 3 + modrow_of(row)) * 6 + (EPI == EPI_OUT ? 2 : 5)) * 1024;
#pragma unroll
        for (int n = 0; n < 4; ++n) {
          const int col = n0 + wc * 64 + n * 16 + 4 * fq;
          const float4 xr = *reinterpret_cast<const float4*>(res + (size_t)row * DM + col);
          const float4 gt = *reinterpret_cast<const float4*>(gate + col);
          float4 y;
          y.x = ALPHA * xr.x + gt.x * acc[m][n][0];
          y.y = ALPHA * xr.y + gt.y * acc[m][n][1];
          y.z = ALPHA * xr.z + gt.z * acc[m][n][2];
          y.w = ALPHA * xr.w + gt.w * acc[m][n][3];
          *reinterpret_cast<float4*>(p.Y + (size_t)row * DM + col) = y;
        }
      } else {
#pragma unroll
        for (int n2 = 0; n2 < 2; ++n2) {
          const int j0 = ((n0 + wc * 64) / 32 + n2) * 16 + 4 * fq;
          float a[4];
#pragma unroll
          for (int r = 0; r < 4; ++r) a[r] = siluf_(acc[m][2 * n2][r]) * acc[m][2 * n2 + 1][r];
          uint2 pk; pk.x = pack2(a[0], a[1]); pk.y = pack2(a[2], a[3]);
          *reinterpret_cast<uint2*>(p.ACT + (size_t)row * DFF + j0) = pk;
        }
      }
    }
    asm volatile("s_waitcnt lgkmcnt(0)" ::: "memory");
    __builtin_amdgcn_s_barrier();
  }
}

__device__ __forceinline__ int kf_off(int t, int d) { return (t >> 4) * 1024 + (d >> 5) * 512 + ((d & 31) >> 3) * 128 + (t & 15) * 8 + (d & 7); }
__device__ __forceinline__ int vf_off(int t, int d) { return (t >> 5) * 2048 + (d >> 4) * 512 + (((t & 15) >> 2) * 16 + (d & 15)) * 8 + ((t >> 4) & 1) * 4 + (t & 3); }
__device__ __forceinline__ void pack44_store(u16* base, int t0, int d, const float* v) {
  uint2 a, b; a.x = pack2(v[0], v[1]); a.y = pack2(v[2], v[3]); b.x = pack2(v[4], v[5]); b.y = pack2(v[6], v[7]);
  *reinterpret_cast<uint2*>(base + vf_off(t0, d)) = a;
  *reinterpret_cast<uint2*>(base + vf_off(t0 + 4, d)) = b;
}
__device__ __forceinline__ void pack8_store(u16* dst, const float* v) {
  uint4 pk; pk.x = pack2(v[0], v[1]); pk.y = pack2(v[2], v[3]); pk.z = pack2(v[4], v[5]); pk.w = pack2(v[6], v[7]);
  *reinterpret_cast<uint4*>(dst) = pk;
}

__device__ void setup_phase(const Params& p, char* smem, int bid, int nblk, int tidx, int mod_lo, int mod_hi, bool rest) {
  const int tid = tidx;
  const int nm = mod_hi - mod_lo;
  const int NV = nm + (rest ? 512 + 13 : 0);
  for (int v_ = bid; v_ < NV; v_ += nblk) {
    const int it = v_ < nm ? mod_lo + v_ : 768 + (v_ - nm);
    if (it < 768) {
      const int l = it / 192, nc = (it / 32) % 6, kc = it % 32;
      const int col = nc * 1024 + tid * 4;
      const float* wm = p.in[9] + (size_t)l * 1024 * 6144;
      float4 a0 = make_float4(0, 0, 0, 0), a1 = a0, a2 = a0;
      for (int k8 = 0; k8 < 32; k8 += 8) {
        float4 w[8];
#pragma unroll
        for (int u = 0; u < 8; ++u) w[u] = *reinterpret_cast<const float4*>(wm + (size_t)(kc * 32 + k8 + u) * 6144 + col);
#pragma unroll
        for (int u = 0; u < 8; ++u) {
          const int k = kc * 32 + k8 + u;
          const float s0 = siluf_(p.in[8][k]), s1 = siluf_(p.in[7][k]), s2 = siluf_(p.in[7][1024 + k]);
          a0.x += s0 * w[u].x; a0.y += s0 * w[u].y; a0.z += s0 * w[u].z; a0.w += s0 * w[u].w;
          a1.x += s1 * w[u].x; a1.y += s1 * w[u].y; a1.z += s1 * w[u].z; a1.w += s1 * w[u].w;
          a2.x += s2 * w[u].x; a2.y += s2 * w[u].y; a2.z += s2 * w[u].z; a2.w += s2 * w[u].w;
        }
      }
      float* dst = p.modp + (size_t)((l * 32 + kc) * 3) * 6144 + col;
      *reinterpret_cast<float4*>(dst) = a0;
      *reinterpret_cast<float4*>(dst + 6144) = a1;
      *reinterpret_cast<float4*>(dst + 2 * 6144) = a2;
    } else if (it < 1280) {
      const int ci = it - 768, b = ci / 256, l = (ci / 64) % 4, tg = ci % 64, t0 = tg * 8;
      {
        const float* ck = p.in[3] + ((size_t)(b * 4 + l) * 512 + t0) * 256 + tid;
        const float* cv = p.in[4] + ((size_t)(b * 4 + l) * 512 + t0) * 256 + tid;
        float v[8];
#pragma unroll
        for (int tt = 0; tt < 8; ++tt) {
          p.KNl[((size_t)((l * 2 + b) * 4 + (tid >> 6))) * 98304 + kf_off(t0 + tt, tid & 63)] = f2bf(ck[tt * 256]);
          v[tt] = cv[tt * 256];
        }
        pack44_store(p.VNtl + ((size_t)((l * 2 + b) * 4 + (tid >> 6))) * 98304, t0, tid & 63, v);
      }
      if (tid < 128) {
        const float* ck = p.in[5] + ((size_t)(b * 4 + l) * 512 + t0) * 128 + tid;
#pragma unroll
        for (int tt = 0; tt < 8; ++tt) p.KGl[((size_t)((l * 2 + b) * 2 + (tid >> 6))) * 98304 + kf_off(t0 + tt, tid & 63)] = f2bf(ck[tt * 128]);
      } else {
        const int c = tid - 128;
        const float* cv = p.in[6] + ((size_t)(b * 4 + l) * 512 + t0) * 128 + c;
        float v[8];
#pragma unroll
        for (int tt = 0; tt < 8; ++tt) v[tt] = cv[tt * 128];
        pack44_store(p.VGtl + ((size_t)((l * 2 + b) * 2 + (c >> 6))) * 98304, t0, c & 63, v);
      }
    } else {
      const int li = it - (768 + 512);
      if (li == 12) {
        for (int idx = tid; idx < 1024; idx += 256) {
          const int pos = idx >> 4, fi = idx & 15;
          const float ang = (float)pos * exp2f(-(float)fi * (13.287712379549449f / 16.f));
          p.rope[idx * 2] = cosf(ang); p.rope[idx * 2 + 1] = sinf(ang);
        }
      } else {
        const int l = li / 3, m = li % 3;
        u16* dst = p.loraT + (size_t)l * 98304 + m * 32768;
        if (m < 2) {
          const float* src = p.in[m == 0 ? 14 : 16] + (size_t)l * 32768;
          for (int i0 = tid; i0 < 32768; i0 += 256 * 16) {
            float v[16];
#pragma unroll
            for (int u = 0; u < 16; ++u) { const int idx = i0 + 256 * u; const int d = idx >> 14, cch = (idx >> 6) & 255, r = idx & 63; v[u] = src[(d * 64 + r) * 256 + cch]; }
#pragma unroll
            for (int u = 0; u < 16; ++u) dst[i0 + 256 * u] = f2bf(v[u]);
          }
        } else {
          const float* src = p.in[17] + (size_t)l * 32768;
          for (int i0 = tid; i0 < 32768; i0 += 256 * 16) {
            float v[16];
#pragma unroll
            for (int u = 0; u < 16; ++u) { const int idx = i0 + 256 * u; const int cch = idx >> 7, j = idx & 127; v[u] = src[j * 256 + cch]; }
#pragma unroll
            for (int u = 0; u < 16; ++u) dst[i0 + 256 * u] = f2bf(v[u]);
          }
        }
      }
    }
  }
}

__device__ void weight_convert(const Params& p, char* smem, int tid, int w, int nw, int tr_begin, int NT) {
    float* tile = reinterpret_cast<float*>(smem);
    float4 cur0, cur1, cur2, cur3;
    const float* src; u16* dst; int K, N, mat, k0, n0;
#define TR_DECODE(TR) { const int l_ = (TR) / 3040; int r_ = (TR) % 3040; int kt_, nt_; \
      if (r_ < 672) { mat = 0; K = 1024; N = 2688; src = p.in[11] + (size_t)l_ * K * N; dst = p.winT + (size_t)l_ * N * K; kt_ = r_ / 42; nt_ = r_ % 42; } \
      else if (r_ < 928) { r_ -= 672; mat = 1; K = 1024; N = 1024; src = p.in[26] + (size_t)l_ * K * N; dst = p.woutT + (size_t)l_ * N * K; kt_ = r_ / 16; nt_ = r_ % 16; } \
      else if (r_ < 2336) { r_ -= 928; mat = 2; K = 1024; N = 5632; src = p.in[29] + (size_t)l_ * K * N; dst = p.wfiT + (size_t)l_ * N * K; kt_ = r_ / 88; nt_ = r_ % 88; } \
      else { r_ -= 2336; mat = 3; K = 2816; N = 1024; src = p.in[30] + (size_t)l_ * K * N; dst = p.wfoT + (size_t)l_ * N * K; kt_ = r_ / 16; nt_ = r_ % 16; } \
      k0 = kt_ * 64; n0 = nt_ * 64; }
#define TR_LOAD(V, I) V = *reinterpret_cast<const float4*>(src + (size_t)(k0 + (tid >> 4) + 16 * (I)) * N + n0 + (tid & 15) * 4);
#define TR_PUT(V, I) { const int kr_ = (tid >> 4) + 16 * (I), c4_ = (tid & 15) * 4; \
      tile[kr_ * 65 + c4_ + 0] = V.x; tile[kr_ * 65 + c4_ + 1] = V.y; tile[kr_ * 65 + c4_ + 2] = V.z; tile[kr_ * 65 + c4_ + 3] = V.w; }
    int tr = tr_begin + w;
    if (tr < NT) { TR_DECODE(tr) TR_LOAD(cur0, 0) TR_LOAD(cur1, 1) TR_LOAD(cur2, 2) TR_LOAD(cur3, 3) }
    for (; tr < NT; tr += nw) {
      TR_PUT(cur0, 0) TR_PUT(cur1, 1) TR_PUT(cur2, 2) TR_PUT(cur3, 3)
      if (tr + nw < NT) { TR_DECODE(tr + nw) TR_LOAD(cur0, 0) TR_LOAD(cur1, 1) TR_LOAD(cur2, 2) TR_LOAD(cur3, 3) }
      TR_DECODE(tr)
      __syncthreads();
#pragma unroll
      for (int i = 0; i < 2; ++i) {
        const int idx = tid + 256 * i, nl = idx >> 3, kc = idx & 7;
        int n = n0 + nl;
        if (mat == 2) { const int isup = n >= DFF ? 1 : 0; const int j = n - isup * DFF; n = (j >> 4) * 32 + isup * 16 + (j & 15); }
        float v[8];
#pragma unroll
        for (int jj = 0; jj < 8; ++jj) v[jj] = tile[(kc * 8 + jj) * 65 + nl];
        pack8_store(dst + (size_t)n * K + k0 + kc * 8, v);
      }
      __syncthreads();
    }
#undef TR_DECODE
#undef TR_LOAD
#undef TR_PUT
}

__device__ void modreduce_phase(const Params& p, int bid, int nblk, int tidx, int idx_lo, int idx_hi) {
  for (int idx = idx_lo + bid * 256 + tidx; idx < idx_hi; idx += nblk * 256) {
    const int l = idx / 4608, rem = idx % 4608, mr = rem / 1536, c4 = (rem % 1536) * 4;
    float4 a = *reinterpret_cast<const float4*>(p.in[10] + (size_t)l * 6144 + c4);
    for (int k8 = 0; k8 < 32; k8 += 8) {
      float4 v[8];
#pragma unroll
      for (int u = 0; u < 8; ++u) v[u] = *reinterpret_cast<const float4*>(p.modp + (size_t)((l * 32 + k8 + u) * 3 + mr) * 6144 + c4);
#pragma unroll
      for (int u = 0; u < 8; ++u) { a.x += v[u].x; a.y += v[u].y; a.z += v[u].z; a.w += v[u].w; }
    }
    *reinterpret_cast<float4*>(p.mod + (size_t)(l * 3 + mr) * 6144 + c4) = a;
  }
}

template <int MODE>
__device__ void ln_phase(const Params& p, int layer, int bid, int nblk, int tidx) {
  const int lane = tidx & 63, wid = tidx >> 6;
  const bool fin = (MODE == 2 && layer == 3);
  const float* lw = (MODE == 1 ? p.in[27] : p.in[31]) + (size_t)layer * DM;
  const float* lb = (MODE == 1 ? p.in[28] : p.in[32]) + (size_t)layer * DM;
  const int ml = (MODE == 2) ? (layer + 1 < 4 ? layer + 1 : 3) : layer;
  const int which = (MODE == 1) ? 3 : 0;
#define LN_SRC(ROW) (MODE == 0 ? ((ROW) < NCTX ? p.in[0] + (size_t)(ROW) * DM : p.in[1] + (size_t)((ROW) - NCTX) * DM) : p.Y + (size_t)(ROW) * DM)
  float4 nv0, nv1, nv2, nv3;
  int it = bid;
  if (it < NTOK / 4) {
    const float4* s4 = reinterpret_cast<const float4*>(LN_SRC(it * 4 + wid));
    nv0 = s4[lane]; nv1 = s4[lane + 64]; nv2 = s4[lane + 128]; nv3 = s4[lane + 192];
  }
  for (; it < NTOK / 4; it += nblk) {
    const int row = it * 4 + wid;
    float4 v[4] = {nv0, nv1, nv2, nv3};
    if (it + nblk < NTOK / 4) {
      const float4* s4 = reinterpret_cast<const float4*>(LN_SRC((it + nblk) * 4 + wid));
      nv0 = s4[lane]; nv1 = s4[lane + 64]; nv2 = s4[lane + 128]; nv3 = s4[lane + 192];
    }
    float4 w4[4], b4[4], s4v[4], c4v[4];
    const float* sh = p.mod + ((size_t)(ml * 3 + modrow_of(row)) * 6 + which) * 1024;
    const float* sc = sh + 1024;
#pragma unroll
    for (int i = 0; i < 4; ++i) {
      if (MODE != 0) { w4[i] = reinterpret_cast<const float4*>(lw)[lane + 64 * i]; b4[i] = reinterpret_cast<const float4*>(lb)[lane + 64 * i]; }
      if (!fin) { s4v[i] = reinterpret_cast<const float4*>(sh)[lane + 64 * i]; c4v[i] = reinterpret_cast<const float4*>(sc)[lane + 64 * i]; }
    }
    if (MODE != 0) {
      float s = 0.f;
#pragma unroll
      for (int i = 0; i < 4; ++i) s += v[i].x + v[i].y + v[i].z + v[i].w;
      const float mu = wave_sum(s) * (1.f / 1024.f);
      float q = 0.f;
#pragma unroll
      for (int i = 0; i < 4; ++i) {
        v[i].x -= mu; v[i].y -= mu; v[i].z -= mu; v[i].w -= mu;
        q += v[i].x * v[i].x + v[i].y * v[i].y + v[i].z * v[i].z + v[i].w * v[i].w;
      }
      const float rstd = rsqrtf(wave_sum(q) * (1.f / 1024.f) + 1e-5f);
#pragma unroll
      for (int i = 0; i < 4; ++i) {
        v[i].x = v[i].x * rstd * w4[i].x + b4[i].x; v[i].y = v[i].y * rstd * w4[i].y + b4[i].y;
        v[i].z = v[i].z * rstd * w4[i].z + b4[i].z; v[i].w = v[i].w * rstd * w4[i].w + b4[i].w;
      }
    }
    float* xdst = (MODE == 1 ? p.X1 : p.X) + (size_t)row * DM;
#pragma unroll
    for (int i = 0; i < 4; ++i) reinterpret_cast<float4*>(xdst)[lane + 64 * i] = v[i];
    if (fin) {
      float* o = row < NCTX ? p.out_yp + (size_t)row * DM : p.out_ys + (size_t)(row - NCTX) * DM;
#pragma unroll
      for (int i = 0; i < 4; ++i) reinterpret_cast<float4*>(o)[lane + 64 * i] = v[i];
    } else {
      u16* adst = p.A + (size_t)row * DM;
#pragma unroll
      for (int i = 0; i < 4; ++i) {
        uint2 pk;
        pk.x = pack2(v[i].x * (1.f + c4v[i].x) + s4v[i].x, v[i].y * (1.f + c4v[i].y) + s4v[i].y);
        pk.y = pack2(v[i].z * (1.f + c4v[i].z) + s4v[i].z, v[i].w * (1.f + c4v[i].w) + s4v[i].w);
        reinterpret_cast<uint2*>(adst)[lane + 64 * i] = pk;
      }
    }
  }
#undef LN_SRC
}

#define FLD 772
#define LLD 392
__device__ void prep_phase(const Params& p, int layer, char* smem, int bid, int nblk, int tidx, int rep) {
  const int pv_ = rep ? PREPVAR : 0;
  float* F = reinterpret_cast<float*>(smem);
  u16* LIb = reinterpret_cast<u16*>(smem + 16 * FLD * 4);
  const float* cw = p.in[12] + (size_t)layer * 3 * 1152;
  const u16* LW = p.loraT + (size_t)layer * 98304;
  for (int k_ = 0;; ++k_) {
    int it2;
    if (nblk != 512) it2 = bid + k_ * nblk;
    else if (k_ >= 2) it2 = 1 << 20;
    else if (bid >= 384) it2 = 384 + 2 * (bid - 384) + k_;
    else if (k_ == 0) it2 = bid;
    else it2 = (bid >= 128 && bid < 256) ? 512 + bid : (1 << 20);
    if (it2 >= 2 * (NTOK / 16)) break;
    const bool doR = it2 < NTOK / 16;
    const int it = doR ? it2 : it2 - NTOK / 16;
    int tid = tidx;
    asm volatile("" : "+v"(tid));
    const int lane = tid & 63, wid = tid >> 6, fr = lane & 15, fq = lane >> 4;
    const int tok0 = it * 16;
    int b, tpos0, L;
    const bool isctx = tok0 < NCTX;
    if (isctx) { b = tok0 >> 8; tpos0 = tok0 & 255; L = 256; }
    else { const int tl = tok0 - NCTX; b = tl >> 10; tpos0 = tl & 1023; L = 1024; }
    if (doR) {
    {
      float* PRM = reinterpret_cast<float*>(smem + 61952);
      PRM[tid] = p.in[13][(size_t)layer * 512 + tid]; PRM[256 + tid] = p.in[13][(size_t)layer * 512 + 256 + tid];
      PRM[512 + tid] = p.in[15][(size_t)layer * 512 + tid]; PRM[768 + tid] = p.in[15][(size_t)layer * 512 + 256 + tid];
      PRM[1024 + tid] = p.in[18][(size_t)layer * 256 + tid]; PRM[1280 + tid] = p.in[19][(size_t)layer * 256 + tid]; PRM[1536 + tid] = p.in[20][(size_t)layer * 256 + tid];
    }
#pragma unroll 1
    for (int cg = tid; cg < 288; cg += 256) {
      const int c = cg * 4;
      const float4 w0 = *reinterpret_cast<const float4*>(cw + c);
      const float4 w1 = *reinterpret_cast<const float4*>(cw + 1152 + c);
      const float4 w2 = *reinterpret_cast<const float4*>(cw + 2304 + c);
      const float* pr = p.PROJ + (size_t)tok0 * DIN + c;
      float4 x[18];
#pragma unroll
      for (int i = 0; i < 18; ++i) {
        const int tpos = tpos0 + i - 1;
        x[i] = (tpos >= 0 && tpos < L) ? *reinterpret_cast<const float4*>(pr + (ptrdiff_t)(i - 1) * DIN) : make_float4(0.f, 0.f, 0.f, 0.f);
      }
#pragma unroll
      for (int tt = 0; tt < 16; ++tt) {
        float4 f;
        f.x = w0.x * x[tt].x + w1.x * x[tt + 1].x + w2.x * x[tt + 2].x;
        f.y = w0.y * x[tt].y + w1.y * x[tt + 1].y + w2.y * x[tt + 2].y;
        f.z = w0.z * x[tt].z + w1.z * x[tt + 1].z + w2.z * x[tt + 2].z;
        f.w = w0.w * x[tt].w + w1.w * x[tt + 1].w + w2.w * x[tt + 2].w;
        if (c < 768) { *reinterpret_cast<float4*>(F + tt * FLD + c) = f; }
        else {
          const int cc = c - 768;
          if (cc < 128) { f.x = tanhf_(f.x); f.y = tanhf_(f.y); f.z = tanhf_(f.z); f.w = tanhf_(f.w); }
          else if (cc >= 256) { f.x = sigmoidf_(f.x); f.y = sigmoidf_(f.y); f.z = sigmoidf_(f.z); f.w = sigmoidf_(f.w); }
          uint2 pk; pk.x = pack2(f.x, f.y); pk.y = pack2(f.z, f.w);
          *reinterpret_cast<uint2*>(LIb + tt * LLD + cc) = pk;
        }
      }
    }
    __syncthreads();
    f32x4 acc[5][4];
#pragma unroll
    for (int g = 0; g < 5; ++g)
#pragma unroll
      for (int nf = 0; nf < 4; ++nf) acc[g][nf] = (f32x4){0.f, 0.f, 0.f, 0.f};
    if (pv_ != 2 && pv_ != 3) {
#define PB_LOAD(W, GI) { const u16* wt_ = (GI) < 4 ? LW + (size_t)(GI) * 16384 : LW + 65536; const int rs_ = (GI) < 4 ? 64 : 128; const int ko_ = (GI) < 4 ? 0 : ((GI) - 4) * 64; \
      _Pragma("unroll") for (int ks_ = 0; ks_ < 2; ++ks_) _Pragma("unroll") for (int nf_ = 0; nf_ < 4; ++nf_) \
        W[ks_ * 4 + nf_] = *reinterpret_cast<const bf16x8*>(wt_ + (size_t)(64 * wid + 16 * nf_ + fr) * rs_ + ko_ + ks_ * 32 + fq * 8); }
#define PB_MMA(W, GI) { const int ai_ = (GI) < 4 ? (GI) : 4; const int xo_ = (GI) < 4 ? (GI) * 64 : 256 + ((GI) - 4) * 64; \
      _Pragma("unroll") for (int ks_ = 0; ks_ < 2; ++ks_) { \
        const bf16x8 xb_ = *reinterpret_cast<const bf16x8*>(LIb + fr * LLD + xo_ + ks_ * 32 + fq * 8); \
        _Pragma("unroll") for (int nf_ = 0; nf_ < 4; ++nf_) acc[ai_][nf_] = __builtin_amdgcn_mfma_f32_16x16x32_bf16(W[ks_ * 4 + nf_], xb_, acc[ai_][nf_], 0, 0, 0); } \
      __builtin_amdgcn_sched_barrier(0); }
    {
      bf16x8 wA[8], wB[8];
      PB_LOAD(wA, 0)
      PB_LOAD(wB, 1) PB_MMA(wA, 0)
      PB_LOAD(wA, 2) PB_MMA(wB, 1)
      PB_LOAD(wB, 3) PB_MMA(wA, 2)
      PB_LOAD(wA, 4) PB_MMA(wB, 3)
      PB_LOAD(wB, 5) PB_MMA(wA, 4)
      PB_MMA(wB, 5)
    }
#undef PB_LOAD
#undef PB_MMA
    }
    if (pv_ != 2 && pv_ != 3) {
#ifndef NO_C
    const float* PRM = reinterpret_cast<const float*>(smem + 61952);
    {
      const int tok = tok0 + fr;
      float ss = 0.f, bs = 0.f;
#pragma unroll
      for (int nf = 0; nf < 4; ++nf) {
        const int c0 = 64 * wid + 16 * nf + 4 * fq;
        const float4 r4 = *reinterpret_cast<const float4*>(F + fr * FLD + c0);
        const float4 k4 = *reinterpret_cast<const float4*>(F + fr * FLD + 256 + c0);
        const float4 w00 = *reinterpret_cast<const float4*>(PRM + c0);
        const float4 w01 = *reinterpret_cast<const float4*>(PRM + 256 + c0);
        const float4 a00 = *reinterpret_cast<const float4*>(PRM + 512 + c0);
        const float4 a01 = *reinterpret_cast<const float4*>(PRM + 768 + c0);
        const float4 kkw = *reinterpret_cast<const float4*>(PRM + 1024 + c0);
        const float4 kaw = *reinterpret_cast<const float4*>(PRM + 1280 + c0);
        const float4 rkw = *reinterpret_cast<const float4*>(PRM + 1536 + c0);
        const float rr[4] = {r4.x, r4.y, r4.z, r4.w}, kk_[4] = {k4.x, k4.y, k4.z, k4.w};
        const float w0a[4] = {w00.x, w00.y, w00.z, w00.w}, w0b[4] = {w01.x, w01.y, w01.z, w01.w};
        const float a0a[4] = {a00.x, a00.y, a00.z, a00.w}, a0b[4] = {a01.x, a01.y, a01.z, a01.w};
        const float kkw_[4] = {kkw.x, kkw.y, kkw.z, kkw.w}, kaw_[4] = {kaw.x, kaw.y, kaw.z, kaw.w}, rkw_[4] = {rkw.x, rkw.y, rkw.z, rkw.w};
#pragma unroll
        for (int r = 0; r < 4; ++r) {
          {
            const float z = -(w0a[r] + acc[0][nf][r]);
            const float sp = fmaxf(z, 0.f) + __logf(1.f + __expf(-fabsf(z)));
            acc[0][nf][r] = __expf(-__expf(-sp - 0.5f));
          }
          {
            const float z = -(w0b[r] + acc[1][nf][r]);
            const float sp = fmaxf(z, 0.f) + __logf(1.f + __expf(-fabsf(z)));
            acc[1][nf][r] = __expf(-__expf(-sp - 0.5f));
          }
          const float av0 = sigmoidf_(a0a[r] + acc[2][nf][r]);
          const float av1 = sigmoidf_(a0b[r] + acc[3][nf][r]);
          acc[2][nf][r] = av0; acc[3][nf][r] = av1;
          const float k = kk_[r];
          const float kq = k * kkw_[r];
          ss += kq * kq;
          const float kd0 = k * (1.f + (av0 - 1.f) * kaw_[r]);
          const float kd1 = k * (1.f + (av1 - 1.f) * kaw_[r]);
          bs += rr[r] * (kd0 + kd1) * rkw_[r];
        }
        __builtin_amdgcn_sched_barrier(0);
      }
      ss += __shfl_xor(ss, 16); ss += __shfl_xor(ss, 32);
      bs += __shfl_xor(bs, 16); bs += __shfl_xor(bs, 32);
      const float inrm = 1.f / fmaxf(sqrtf(ss), 1e-12f);
#pragma unroll
      for (int nf = 0; nf < 4; ++nf) {
        const int c0 = 64 * wid + 16 * nf + 4 * fq, n0 = 16 * nf + 4 * fq;
        const float4 r4 = *reinterpret_cast<const float4*>(F + fr * FLD + c0);
        const float4 k4 = *reinterpret_cast<const float4*>(F + fr * FLD + 256 + c0);
        const float4 v4 = *reinterpret_cast<const float4*>(F + fr * FLD + 512 + c0);
        const float4 kkw = *reinterpret_cast<const float4*>(PRM + 1024 + c0);
        const float4 kaw = *reinterpret_cast<const float4*>(PRM + 1280 + c0);
        const float kk_[4] = {k4.x, k4.y, k4.z, k4.w}, kkw_[4] = {kkw.x, kkw.y, kkw.z, kkw.w}, kaw_[4] = {kaw.x, kaw.y, kaw.z, kaw.w};
        float* sc = p.SC + ((size_t)(tok * 4 + wid) * 9) * 64 + n0;
        float kn[4], kd0[4], kd1[4];
#pragma unroll
        for (int r = 0; r < 4; ++r) {
          kn[r] = kk_[r] * kkw_[r] * inrm;
          kd0[r] = kk_[r] * (1.f + (acc[2][nf][r] - 1.f) * kaw_[r]);
          kd1[r] = kk_[r] * (1.f + (acc[3][nf][r] - 1.f) * kaw_[r]);
        }
        *reinterpret_cast<float4*>(sc) = r4;
        *reinterpret_cast<float4*>(sc + 64) = make_float4(kn[0], kn[1], kn[2], kn[3]);
        *reinterpret_cast<float4*>(sc + 128) = v4;
        *reinterpret_cast<float4*>(sc + 192) = make_float4(acc[0][nf][0], acc[0][nf][1], acc[0][nf][2], acc[0][nf][3]);
        *reinterpret_cast<float4*>(sc + 256) = make_float4(acc[2][nf][0] * kn[0], acc[2][nf][1] * kn[1], acc[2][nf][2] * kn[2], acc[2][nf][3] * kn[3]);
        *reinterpret_cast<float4*>(sc + 320) = make_float4(kd0[0], kd0[1], kd0[2], kd0[3]);
        *reinterpret_cast<float4*>(sc + 384) = make_float4(acc[1][nf][0], acc[1][nf][1], acc[1][nf][2], acc[1][nf][3]);
        *reinterpret_cast<float4*>(sc + 448) = make_float4(acc[3][nf][0] * kn[0], acc[3][nf][1] * kn[1], acc[3][nf][2] * kn[2], acc[3][nf][3] * kn[3]);
        *reinterpret_cast<float4*>(sc + 512) = make_float4(kd1[0], kd1[1], kd1[2], kd1[3]);
        *reinterpret_cast<float4*>(p.G + (size_t)tok * 256 + c0) = make_float4(acc[4][nf][0], acc[4][nf][1], acc[4][nf][2], acc[4][nf][3]);
        *reinterpret_cast<float4*>(p.BV + (size_t)tok * 256 + c0) = make_float4(bs * v4.x, bs * v4.y, bs * v4.z, bs * v4.w);
        __builtin_amdgcn_sched_barrier(0);
      }
    }
#endif
    }
    }
    if (!doR && pv_ != 1) {
#ifndef NO_D
    {
      const int tok = tid >> 4, g8 = tid & 15, tokg = tok0 + tok, tpos = tpos0 + tok;
      const int tkey = isctx ? tpos : 512 + tpos;
      const float* pr = p.PROJ + (size_t)tokg * DIN;
#pragma unroll
      for (int hh = 0; hh < 2; ++hh) {
        const int g = g8 + 16 * hh, c0 = g * 8, hd = c0 >> 6, d0 = c0 & 63;
        const float4 qa = *reinterpret_cast<const float4*>(pr + 1152 + c0), qb = *reinterpret_cast<const float4*>(pr + 1152 + c0 + 4);
        const float4 ka = *reinterpret_cast<const float4*>(pr + 1408 + c0), kb2 = *reinterpret_cast<const float4*>(pr + 1408 + c0 + 4);
        const float qv[8] = {qa.x * QSCALE, qa.y * QSCALE, qa.z * QSCALE, qa.w * QSCALE, qb.x * QSCALE, qb.y * QSCALE, qb.z * QSCALE, qb.w * QSCALE};
        const float kv[8] = {ka.x, ka.y, ka.z, ka.w, kb2.x, kb2.y, kb2.z, kb2.w};
        if (isctx) {
          float* ok = p.out_nak + ((size_t)(b * 4 + layer) * 256 + tpos) * 256 + c0;
          *reinterpret_cast<float4*>(ok) = ka; *reinterpret_cast<float4*>(ok + 4) = kb2;
          pack8_store(p.QNc + (size_t)tokg * 256 + c0, qv);
          pack8_store(p.KNc + (size_t)(b * 4 + hd) * 16384 + kf_off(tkey, d0), kv);
        } else {
          pack8_store(p.QNl + (size_t)(tokg - NCTX) * 256 + c0, qv);
          pack8_store(p.KNl + ((size_t)((layer * 2 + b) * 4 + hd)) * 98304 + kf_off(tkey, d0), kv);
        }
      }
#pragma unroll
      for (int hh = 0; hh < 5; ++hh) {
        const bool isk = (hh == 4);
        const int g = isk ? g8 : g8 + 16 * hh, d0 = (g & 7) * 8, hd = g >> 3;
        const float* src = pr + (isk ? 2432 : 1920) + g * 8;
        const float4 xa = *reinterpret_cast<const float4*>(src), xb = *reinterpret_cast<const float4*>(src + 4);
        const float* nw = (isk ? p.in[25] : p.in[24]) + (size_t)layer * 64 + d0;
        const float4 na = *reinterpret_cast<const float4*>(nw), nb = *reinterpret_cast<const float4*>(nw + 4);
        float x[8] = {xa.x, xa.y, xa.z, xa.w, xb.x, xb.y, xb.z, xb.w};
        const float nrm[8] = {na.x, na.y, na.z, na.w, nb.x, nb.y, nb.z, nb.w};
        float ss = 0.f;
#pragma unroll
        for (int e = 0; e < 8; ++e) ss += x[e] * x[e];
        ss += dpp_mov<0xB1>(ss); ss += dpp_mov<0x4E>(ss); ss += dpp_mov<0x141>(ss);
        const float rs = rsqrtf(ss * (1.f / 64.f) + 1e-6f);
#pragma unroll
        for (int e = 0; e < 8; ++e) x[e] = x[e] * rs * nrm[e];
        if (isk && isctx) {
          float* ok = p.out_gk + ((size_t)(b * 4 + layer) * 256 + tpos) * 128 + g * 8;
          *reinterpret_cast<float4*>(ok) = make_float4(x[0], x[1], x[2], x[3]);
          *reinterpret_cast<float4*>(ok + 4) = make_float4(x[4], x[5], x[6], x[7]);
        }
        if (!isctx) {
          const int pos = (d0 < 32) ? (tpos >> 6) : (tpos & 63);
          const float4* rt = reinterpret_cast<const float4*>(p.rope + (size_t)(pos * 16 + (d0 & 15)) * 2);
          const float4 r0 = rt[0], r1 = rt[1], r2 = rt[2], r3 = rt[3];
          const float cs[8] = {r0.x, r0.z, r1.x, r1.z, r2.x, r2.z, r3.x, r3.z};
          const float sn[8] = {r0.y, r0.w, r1.y, r1.w, r2.y, r2.w, r3.y, r3.w};
          const float sg = (d0 & 16) ? 1.f : -1.f;
#pragma unroll
          for (int e = 0; e < 8; ++e) { const float pe = dpp_mov<0x4E>(x[e]); x[e] = x[e] * cs[e] + sg * pe * sn[e]; }
        }
        if (!isk) {
#pragma unroll
          for (int e = 0; e < 8; ++e) x[e] *= QSCALE;
          if (isctx) pack8_store(p.QGc + (size_t)tokg * 512 + g * 8, x);
          else pack8_store(p.QGl + (size_t)(tokg - NCTX) * 512 + g * 8, x);
        } else {
          if (isctx) pack8_store(p.KGc + (size_t)(b * 2 + hd) * 16384 + kf_off(tkey, d0), x);
          else pack8_store(p.KGl + ((size_t)((layer * 2 + b) * 2 + hd)) * 98304 + kf_off(tkey, d0), x);
        }
      }
    }
    const int c = tid;
#pragma unroll
    for (int half = 0; half < 2; ++half) {
      float vv[8];
#pragma unroll
      for (int t8 = 0; t8 < 8; ++t8) {
        const int tt = half * 8 + t8, tokn = tok0 + tt;
        const float v = p.PROJ[(size_t)tokn * DIN + 1664 + c];
        vv[t8] = v;
        if (isctx) p.out_nav[((size_t)(b * 4 + layer) * 256 + tpos0 + tt) * 256 + c] = v;
      }
      if (isctx) pack44_store(p.VNtc + (size_t)(b * 4 + (c >> 6)) * 16384, tpos0 + half * 8, c & 63, vv);
      else pack44_store(p.VNtl + ((size_t)((layer * 2 + b) * 4 + (c >> 6))) * 98304, 512 + tpos0 + half * 8, c & 63, vv);
    }
    if (wid >= 2) {
      const int cv = c - 128;
#pragma unroll
      for (int half = 0; half < 2; ++half) {
        float vv[8];
#pragma unroll
        for (int t8 = 0; t8 < 8; ++t8) {
          const int tt = half * 8 + t8, tokn = tok0 + tt;
          const float v = p.PROJ[(size_t)tokn * DIN + 2560 + cv];
          vv[t8] = v;
          if (isctx) p.out_gv[((size_t)(b * 4 + layer) * 256 + tpos0 + tt) * 128 + cv] = v;
        }
        if (isctx) pack44_store(p.VGtc + (size_t)(b * 2 + (cv >> 6)) * 16384, tpos0 + half * 8, cv & 63, vv);
        else pack44_store(p.VGtl + ((size_t)((layer * 2 + b) * 2 + (cv >> 6))) * 98304, 512 + tpos0 + half * 8, cv & 63, vv);
      }
    }
#endif
    }
    __syncthreads();
  }
}

#define ATT_LOAD(KF, VF, CI) { \
    const int ci_ = min((CI), nt - 1); \
    int kb_; \
    if (ci_ < nd) kb_ = ci_ * 32; \
    else { const int e_ = ci_ - nd; const int j_ = (ncc == 2) ? (e_ >> 1) : e_; const int cc_ = cc0 + ((ncc == 2) ? (e_ & 1) : 0); kb_ = 512 + (rb + j_) * 64 + cc_ * 32; } \
    const u16* kp_ = Kb + (size_t)(kb_ >> 4) * 1024 + lane * 8; \
    KF##00 = *reinterpret_cast<const bf16x8*>(kp_); \
    KF##01 = *reinterpret_cast<const bf16x8*>(kp_ + 512); \
    KF##10 = *reinterpret_cast<const bf16x8*>(kp_ + 1024); \
    KF##11 = *reinterpret_cast<const bf16x8*>(kp_ + 1536); \
    const u16* vp_ = Vt + (size_t)(kb_ >> 5) * 2048 + lane * 8; \
    VF##0 = *reinterpret_cast<const bf16x8*>(vp_); \
    VF##1 = *reinterpret_cast<const bf16x8*>(vp_ + 512); \
    VF##2 = *reinterpret_cast<const bf16x8*>(vp_ + 1024); \
    VF##3 = *reinterpret_cast<const bf16x8*>(vp_ + 1536); }

#define ATT_PV(DT, VV) { \
    o[DT][0] *= alpha; o[DT][1] *= alpha; o[DT][2] *= alpha; o[DT][3] *= alpha; \
    o[DT] = __builtin_amdgcn_mfma_f32_16x16x32_bf16(VV, pf.v, o[DT], 0, 0, 0); }

#define ATT_COMPUTE(KF, VF, CI) { \
    const int ci_ = (CI); \
    f32x4 s0 = (f32x4){0.f, 0.f, 0.f, 0.f}, s1 = (f32x4){0.f, 0.f, 0.f, 0.f}; \
    s0 = __builtin_amdgcn_mfma_f32_16x16x32_bf16(KF##00, qf0, s0, 0, 0, 0); \
    s0 = __builtin_amdgcn_mfma_f32_16x16x32_bf16(KF##01, qf1, s0, 0, 0, 0); \
    s1 = __builtin_amdgcn_mfma_f32_16x16x32_bf16(KF##10, qf0, s1, 0, 0, 0); \
    s1 = __builtin_amdgcn_mfma_f32_16x16x32_bf16(KF##11, qf1, s1, 0, 0, 0); \
    float sv[8] = {s0[0], s0[1], s0[2], s0[3], s1[0], s1[1], s1[2], s1[3]}; \
    bool ok[8]; \
    _Pragma("unroll") for (int e = 0; e < 8; ++e) ok[e] = true; \
    if (ci_ >= nd) { \
      const int e_ = ci_ - nd; const int j_ = (ncc == 2) ? (e_ >> 1) : e_; const int cc_ = cc0 + ((ncc == 2) ? (e_ & 1) : 0); \
      const int dr_ = rb + j_ - grow + 7; \
      const int cq = cq0 + fr, c0 = min(max(cq - 8, 0), 48); \
      _Pragma("unroll") for (int e = 0; e < 8; ++e) { \
        const int ck = cc_ * 32 + 16 * (e >> 2) + 4 * fq + (e & 3); \
        ok[e] = (ck >= c0) && (ck < c0 + 16); \
        const int dc = min(max(ck - cq, -15), 15) + 15; \
        const float bias = rpb[dr_ * 31 + dc] * LOG2E; \
        sv[e] = ok[e] ? sv[e] + bias : -1e30f; \
      } \
    } \
    float mx = fmaxf(fmaxf(fmaxf(sv[0], sv[1]), fmaxf(sv[2], sv[3])), fmaxf(fmaxf(sv[4], sv[5]), fmaxf(sv[6], sv[7]))); \
    mx = fmaxf(mx, __shfl_xor(mx, 16)); \
    mx = fmaxf(mx, __shfl_xor(mx, 32)); \
    const float mn = fmaxf(m, mx); \
    const float alpha = __builtin_amdgcn_exp2f(m - mn); \
    m = mn; \
    float ps = 0.f; \
    _Pragma("unroll") for (int e = 0; e < 8; ++e) { sv[e] = ok[e] ? __builtin_amdgcn_exp2f(sv[e] - mn) : 0.f; ps += sv[e]; } \
    l = l * alpha + ps; \
    union { bf16x8 v; unsigned u[4]; } pf; \
    pf.u[0] = pack2(sv[0], sv[1]); pf.u[1] = pack2(sv[2], sv[3]); pf.u[2] = pack2(sv[4], sv[5]); pf.u[3] = pack2(sv[6], sv[7]); \
    ATT_PV(0, VF##0) ATT_PV(1, VF##1) ATT_PV(2, VF##2) ATT_PV(3, VF##3) }

__device__ __forceinline__ void attn_wave(const u16* __restrict__ Q, int ldq, const u16* __restrict__ Kb, int ldk,
                                          const u16* __restrict__ Vt, int ldv, int ndense, const bool NA,
                                          const float* __restrict__ rpb, int grow, int cq0,
                                          u16* __restrict__ out, int ldo, int tidx) {
  const int lane = tidx & 63, fr = lane & 15, fq = lane >> 4;
  const bf16x8 qf0 = *reinterpret_cast<const bf16x8*>(Q + (size_t)fr * ldq + fq * 8);
  const bf16x8 qf1 = *reinterpret_cast<const bf16x8*>(Q + (size_t)fr * ldq + 32 + fq * 8);
  f32x4 o[4];
#pragma unroll
  for (int dt = 0; dt < 4; ++dt) o[dt] = (f32x4){0.f, 0.f, 0.f, 0.f};
  float m = -1e30f, l = 0.f;
  const int nd = ndense >> 5;
  const int rb = min(max(grow - 4, 0), 8);
  const int ulo = min(max(cq0 - 8, 0), 48), uhi = min(max(cq0 + 15 - 8, 0), 48) + 16;
  const bool c0ok = ulo < 32, c1ok = uhi > 32;
  const int ncc = (c0ok && c1ok) ? 2 : 1, cc0 = c0ok ? 0 : 1;
  const int nt = nd + (NA ? 8 * ncc : 0);
  bf16x8 ka00, ka01, ka10, ka11, kb00, kb01, kb10, kb11;
  bf16x8 va0, va1, va2, va3, vb0, vb1, vb2, vb3;
  ATT_LOAD(ka, va, 0)
  for (int ci = 0; ci < nt; ci += 2) {
    ATT_LOAD(kb, vb, ci + 1)
    ATT_COMPUTE(ka, va, ci)
    if (ci + 1 < nt) {
      ATT_LOAD(ka, va, ci + 2)
      ATT_COMPUTE(kb, vb, ci + 1)
    }
  }
  l += __shfl_xor(l, 16);
  l += __shfl_xor(l, 32);
  const float il = 1.f / l;
#pragma unroll
  for (int dt = 0; dt < 4; ++dt) {
    uint2 pk; pk.x = pack2(o[dt][0] * il, o[dt][1] * il); pk.y = pack2(o[dt][2] * il, o[dt][3] * il);
    *reinterpret_cast<uint2*>(out + (size_t)fr * ldo + 16 * dt + 4 * fq) = pk;
  }
}

__device__ void scan_item(const Params& p, int layer, char* smem, bool lat, int b, int h, int dir, int qd, int tidx) {
  const int tid = tidx, lane = tid & 63, wid = tid >> 6, rr = lane >> 4, j = lane & 15;
  const int L = lat ? 1024 : 256, seqbase = lat ? NCTX + b * 1024 : b * 256;
  const int rowl = wid * 4 + rr, row = qd * 16 + rowl;
  float* cbuf = reinterpret_cast<float*>(smem);
  float* obuf = cbuf + 2 * 16 * 6 * 64;
  float4 S = make_float4(0.f, 0.f, 0.f, 0.f);
  if (lat) S = *reinterpret_cast<const float4*>(p.in[2] + ((((size_t)(b * 4 + layer) * 2 + dir) * 4 + h) * 64 + row) * 64 + 4 * j);
  v2f S01 = (v2f){S.x, S.y}, S23 = (v2f){S.z, S.w};
  const int nch = L / 16;
  float* odst = dir == 0 ? p.OF : p.OB;
  float4 pre0, pre1, pre2, pre3, pre4, pre5;
  const ptrdiff_t cstep = (dir == 0 ? 1 : -1) * (ptrdiff_t)(16 * 4 * 9 * 64);
  const float *gp0, *gp1, *gp2, *gp3, *gp4, *gp5;
#define SC_GP(GP, I) { const int idx = tid + 256 * (I), tt_ = idx / 96, rem = idx % 96, vec = rem >> 4, f4 = rem & 15; \
    const int t_ = dir == 0 ? tt_ : L - 1 - tt_; const int svec = vec < 3 ? vec : vec + 3 * dir; \
    GP = p.SC + ((size_t)((seqbase + t_) * 4 + h) * 9 + svec) * 64 + f4 * 4; }
  SC_GP(gp0, 0) SC_GP(gp1, 1) SC_GP(gp2, 2) SC_GP(gp3, 3) SC_GP(gp4, 4) SC_GP(gp5, 5)
#define SC_GL1(PR, GP, CH) PR = *reinterpret_cast<const float4*>(GP + (ptrdiff_t)(CH) * cstep);
#define gload(CH) { SC_GL1(pre0, gp0, CH) SC_GL1(pre1, gp1, CH) SC_GL1(pre2, gp2, CH) SC_GL1(pre3, gp3, CH) SC_GL1(pre4, gp4, CH) SC_GL1(pre5, gp5, CH) }
#define SC_LS1(PR, I, BUF) *reinterpret_cast<float4*>(cbuf + (BUF) * 6144 + (tid + 256 * (I)) * 4) = PR;
#define lstore(BUF) { SC_LS1(pre0, 0, BUF) SC_LS1(pre1, 1, BUF) SC_LS1(pre2, 2, BUF) SC_LS1(pre3, 3, BUF) SC_LS1(pre4, 4, BUF) SC_LS1(pre5, 5, BUF) }
  gload(0); lstore(0);
  __syncthreads();
#define SC_LD(R4, K4, VV, W4, A4, D4, TT) { const float* base_ = cb + (TT) * 384; \
    R4 = *reinterpret_cast<const float4*>(base_ + 4 * j); K4 = *reinterpret_cast<const float4*>(base_ + 64 + 4 * j); \
    VV = base_[128 + row]; W4 = *reinterpret_cast<const float4*>(base_ + 192 + 4 * j); \
    A4 = *reinterpret_cast<const float4*>(base_ + 256 + 4 * j); D4 = *reinterpret_cast<const float4*>(base_ + 320 + 4 * j); }
#if SCANVAR
  for (int pass_ = 0; pass_ < (lat ? 2 : 1); ++pass_) {
  int var_ = pass_ ? SCANVAR : 0;
  asm volatile("" : "+v"(var_)); var_ = __builtin_amdgcn_readfirstlane(var_);
#else
  const int var_ = 0;
#endif
  for (int ch = 0; ch < nch; ++ch) {
    if (ch + 1 < nch && var_ != 3) gload(ch + 1);
    const float* cb = cbuf + (ch & 1) * 6144;
    float osel = 0.f;
    float4 r4, kk4, w4, ak4, kd4; float vv;
    SC_LD(r4, kk4, vv, w4, ak4, kd4, 0)
    if (var_ != 2)
#pragma unroll
    for (int hf = 0; hf < 2; ++hf) {
      float oqA = 0.f, oqB = 0.f, ovp = 0.f;
#pragma unroll
      for (int u = 0; u < 8; ++u) {
        const int tt = hf * 8 + u;
        float4 r4n, kk4n, w4n, ak4n, kd4n; float vvn;
        SC_LD(r4n, kk4n, vvn, w4n, ak4n, kd4n, tt + 1)
        v2f p = S01 * (v2f){kk4.x, kk4.y};
        p = S23 * (v2f){kk4.z, kk4.w} + p;
        float sk = p.x + p.y;
        sk += dpp_mov<0xB1>(sk);  ovp += dpp_mov<0xB1>(ovp);
        sk += dpp_mov<0x4E>(sk);  ovp += dpp_mov<0x4E>(ovp);
        sk += dpp_mov<0x141>(sk);
        sk += dpp_mov<0x140>(sk);
        if (u > 0) {
          if (((u - 1) >> 2) == 0) oqA = ((j & 3) == ((u - 1) & 3)) ? ovp : oqA;
          else oqB = ((j & 3) == ((u - 1) & 3)) ? ovp : oqB;
        }
        const v2f vv2 = (v2f){vv, vv}, sk2 = (v2f){sk, sk};
        v2f t01 = (v2f){kd4.x, kd4.y} * vv2; t01 = t01 - (v2f){ak4.x, ak4.y} * sk2;
        v2f t23 = (v2f){kd4.z, kd4.w} * vv2; t23 = t23 - (v2f){ak4.z, ak4.w} * sk2;
        S01 = S01 * (v2f){w4.x, w4.y} + t01;
        S23 = S23 * (v2f){w4.z, w4.w} + t23;
        v2f q = S01 * (v2f){r4.x, r4.y};
        q = S23 * (v2f){r4.z, r4.w} + q;
        ovp = q.x + q.y;
        r4 = r4n; kk4 = kk4n; w4 = w4n; ak4 = ak4n; kd4 = kd4n; vv = vvn;
      }
      ovp += dpp_mov<0xB1>(ovp); ovp += dpp_mov<0x4E>(ovp);
      oqB = ((j & 3) == 3) ? ovp : oqB;
      oqA += dpp_mov<0x128>(oqA); oqB += dpp_mov<0x128>(oqB);
      oqA += dpp_mov<0x124>(oqA); oqB += dpp_mov<0x124>(oqB);
      if ((j >> 3) == hf) osel = ((j >> 2) & 1) ? oqB : oqA;
    }
    if (var_ == 0) {
      const int st = ch * 16 + j, t = dir == 0 ? st : L - 1 - st;
      odst[(size_t)(seqbase + t) * 256 + h * 64 + row] = osel;
    } else asm volatile("" :: "v"(osel), "v"(S01), "v"(S23));
    if (ch + 1 < nch && var_ != 3) lstore((ch + 1) & 1);
    asm volatile("s_waitcnt lgkmcnt(0)" ::: "memory");
    __builtin_amdgcn_s_barrier();
  }
#if SCANVAR
  }
#endif
  if (!lat) *reinterpret_cast<float4*>(p.out_st + ((((size_t)(b * 4 + layer) * 2 + dir) * 4 + h) * 64 + row) * 64 + 4 * j) = make_float4(S01.x, S01.y, S23.x, S23.y);
  __syncthreads();
}

__device__ void mixer_phase(const Params& p, int layer_wq, char* smem, int tidx0) {
  const int layer = layer_wq & 3;
  int* slot = reinterpret_cast<int*>(smem + 60 * 1024);
  bool first = true;
  for (;;) {
    int tidx = tidx0;
    asm volatile("" : "+v"(tidx));
    const int tid = tidx, wid = tid >> 6;
    __syncthreads();
    if (tid == 0) {
      int nx;
      const int bx = (int)blockIdx.x;
      if (gridDim.x != 512) nx = first ? bx : (int)(gridDim.x + atomicAdd(&p.wq[layer_wq], 1u));
      else if (first) nx = (bx >= 256 && bx < 320) ? 1728 : (bx >= 448 ? 256 + (bx - 448) : bx);
      else nx = 448 + (int)atomicAdd(&p.wq[layer_wq], 1u);
      *slot = nx;
    }
    first = false;
    __syncthreads();
    int it = *slot;
    if (it >= 1728) break;
    const bool is_scan = (it < 64) || (it >= 448 && it < 960);
#if REPMASK
    if ((p.pad == 1 && !is_scan) || (p.pad == 2 && is_scan) || ((p.pad == 3 || p.pad == 5 || p.pad == 6) && !(it < 64)) || (p.pad == 4 && !(it >= 64 && it < 320))) continue;
#endif
    if (is_scan) {
      const bool lat = it < 64;
      const int si = lat ? it : it - 448;
#ifndef NO_SCAN
      scan_item(p, layer, smem, lat, si / 32, (si / 8) % 4, (si / 4) % 2, si % 4, tidx);
#endif
      continue;
    }
    const u16 *Q, *Kb, *Vt; u16* out; int ldq, ldk, ldv, ndense, grow = 0, cq0 = 0; bool na = false;
    const float* rpb = p.in[23];
    if (it < 320) {
      it -= 64;
      const int b = it / 128, qh = (it / 16) % 8, qt = it % 16, kvh = qh >> 2;
      const int q0 = b * 1024 + qt * 64 + wid * 16;
      Q = p.QGl + (size_t)q0 * 512 + qh * 64; ldq = 512;
      Kb = p.KGl + (size_t)((layer * 2 + b) * 2 + kvh) * 98304; ldk = 0;
      Vt = p.VGtl + (size_t)((layer * 2 + b) * 2 + kvh) * 98304; ldv = 0; ndense = 1536;
      out = p.MIX + (size_t)(NCTX + q0) * DM + 512 + qh * 64;
    } else if (it < 448) {
      it -= 320;
      const int b = it / 64, h = (it / 16) % 4, r = it % 16;
      const int q0 = b * 1024 + r * 64 + wid * 16;
      Q = p.QNl + (size_t)q0 * 256 + h * 64; ldq = 256;
      Kb = p.KNl + (size_t)((layer * 2 + b) * 4 + h) * 98304; ldk = 0;
      Vt = p.VNtl + (size_t)((layer * 2 + b) * 4 + h) * 98304; ldv = 0; ndense = 512;
      rpb = p.in[23] + (size_t)(layer * 4 + h) * 15 * 31; grow = r; cq0 = wid * 16; na = true;
      out = p.MIX + (size_t)(NCTX + q0) * DM + 256 + h * 64;
    } else if (it < 1472) {
      it -= 960;
      const int b = it / 32, qh = (it / 4) % 8, qt = it % 4, kvh = qh >> 2;
      const int q0 = b * 256 + qt * 64 + wid * 16;
      Q = p.QGc + (size_t)q0 * 512 + qh * 64; ldq = 512;
      Kb = p.KGc + (size_t)(b * 2 + kvh) * 16384; ldk = 0;
      Vt = p.VGtc + (size_t)(b * 2 + kvh) * 16384; ldv = 0; ndense = 256;
      out = p.MIX + (size_t)q0 * DM + 512 + qh * 64;
    } else {
      it -= 1472;
      const int b = it / 16, h = (it / 4) % 4, qt = it % 4;
      const int q0 = b * 256 + qt * 64 + wid * 16;
      Q = p.QNc + (size_t)q0 * 256 + h * 64; ldq = 256;
      Kb = p.KNc + (size_t)(b * 4 + h) * 16384; ldk = 0;
      Vt = p.VNtc + (size_t)(b * 4 + h) * 16384; ldv = 0; ndense = 256;
      out = p.MIX + (size_t)q0 * DM + 256 + h * 64;
    }
#ifndef NO_ATT
    attn_wave(Q, ldq, Kb, ldk, Vt, ldv, ndense, na, rpb, grow, cq0, out, DM, tidx);
#endif
  }
}

__device__ void rwkv_fin_phase(const Params& p, int layer, int bid, int nblk, int tidx) {
  const int tid = tidx;
  const float lw = p.in[21][(size_t)layer * 256 + tid], lb = p.in[22][(size_t)layer * 256 + tid];
  for (int t4 = bid; t4 < NTOK / 4; t4 += nblk) {
    float of[4], ob[4], bv[4], gg[4];
#pragma unroll
    for (int u = 0; u < 4; ++u) {
      const size_t i = (size_t)(t4 * 4 + u) * 256 + tid;
      of[u] = p.OF[i]; ob[u] = p.OB[i]; bv[u] = p.BV[i]; gg[u] = p.G[i];
    }
#pragma unroll
    for (int u = 0; u < 4; ++u) {
      const float o = of[u] + ob[u];
      const float mu = wave_sum(o) * (1.f / 64.f);
      const float d = o - mu;
      const float var = wave_sum(d * d) * (1.f / 64.f);
      const float y = (d * rsqrtf(var + 64e-5f) * lw + lb + bv[u]) * gg[u];
      p.MIX[(size_t)(t4 * 4 + u) * DM + tid] = f2bf(y);
    }
  }
}

#ifndef ONLY_PH
#define ONLY_PH -1
#endif
#define PH_EN(x) (ONLY_PH < 0 || ONLY_PH == (x))
__device__ __forceinline__ void run_phase(const Params& p, int ph, char* smem, int bid, int nblk, int tidx, int rep = 0) {
  const bool defer = (nblk == 512);
  if (ph == 0) {
    if (PH_EN(0)) { setup_phase(p, smem, bid, nblk, tidx, 0, defer ? 192 : 768, true); weight_convert(p, smem, tidx, bid, nblk, 0, defer ? 2336 : 4 * 3040); }
    return;
  }
  if (ph == 1) { if (PH_EN(1)) modreduce_phase(p, bid, nblk, tidx, 0, defer ? 4608 : 18432); return; }
  if (ph == 2) { if (PH_EN(2)) ln_phase<0>(p, 0, bid, nblk, tidx); return; }
  const int layer = (ph - 3) / 9, s = (ph - 3) % 9;
  switch (s) {
    case 0: if (PH_EN(3)) gemm_phase<EPI_PROJ, 256, 3>(p, layer, p.A, p.winT + (size_t)layer * DIN * DM, DIN, DM, smem, bid, nblk, tidx); break;
    case 1: if (PH_EN(4)) prep_phase(p, layer, smem, bid, nblk, tidx, rep); break;
    case 2: if (PH_EN(5)) mixer_phase(p, layer + 4 * rep, smem, tidx); break;
    case 3: if (PH_EN(6)) rwkv_fin_phase(p, layer, bid, nblk, tidx); break;
    case 4:
      if (PH_EN(7)) {
        if (defer && bid >= 256) {
          if (layer == 0) { setup_phase(p, smem, bid - 256, 256, tidx, 192, 768, false); weight_convert(p, smem, tidx, bid - 256, 256, 2336, 3040); }
        } else gemm_phase<EPI_OUT, 192, 3>(p, layer, p.MIX, p.woutT + (size_t)layer * DM * DM, DM, DM, smem, bid, nblk, tidx);
      }
      break;
    case 5: if (PH_EN(8)) ln_phase<1>(p, layer, bid, nblk, tidx); break;
    case 6: if (PH_EN(9)) gemm_phase<EPI_FFI, 192, 3>(p, layer, p.A, p.wfiT + (size_t)layer * 2 * DFF * DM, 2 * DFF, DM, smem, bid, nblk, tidx); break;
    case 7:
      if (PH_EN(10)) {
        if (defer && bid >= 256) {
          if (layer < 3) weight_convert(p, smem, tidx, bid - 256, 256, 3040 * (layer + 1), 3040 * (layer + 2));
          if (layer == 0) modreduce_phase(p, bid - 256, 256, tidx, 4608, 18432);
        }
        else gemm_phase<EPI_FFO, 192, 3>(p, layer, p.ACT, p.wfoT + (size_t)layer * DM * DFF, DM, DFF, smem, bid, nblk, tidx);
      }
      break;
    default: if (PH_EN(11)) ln_phase<2>(p, layer, bid, nblk, tidx); break;
  }
}

__global__ void __launch_bounds__(256, 2) fwd_kernel(Params p, int ph0, int ph1, int usebar) {
  __shared__ __attribute__((aligned(16))) char smem[73728 + 16];
  const int bid = blockIdx.x, nblk = gridDim.x;
  XcdBarrier xb;
  if (usebar && p.never) cg::this_grid().sync();
  if (usebar) {
    if (threadIdx.x == 0) *reinterpret_cast<uint4*>(smem + 73728) = make_uint4(0u, 0u, 0u, 0u);
    __syncthreads();
    xb = xcd_barrier_post(p.bar, (volatile LAS unsigned*)(smem + 73728));
  }
  int ph = ph0, rep = 0;
  while (ph < ph1) {
    int tidx = threadIdx.x;
    asm volatile("" : "+v"(tidx));
    run_phase(p, ph, smem, bid, nblk, tidx, rep);
#if REPSLOT >= 0
    if (((ph < 3 ? 9 + ph : (ph - 3) % 9) == REPSLOT) && rep == 0) rep = 1; else { rep = 0; ++ph; }
#else
    ++ph;
#endif
    if (usebar && ph < ph1) xcd_barrier(xb);
  }
}

static inline size_t al256(size_t x) { return (x + 255) & ~(size_t)255; }

extern "C" void kernel_launch(void* const* d_in, const int* in_sizes, int n_in, void* d_out, int out_size, void* d_ws, size_t ws_size,
                              hipStream_t stream) {
  Params p;
  memset(&p, 0, sizeof(p));
  for (int i = 0; i < 33; ++i) p.in[i] = (const float*)d_in[i];
  float* o = (float*)d_out;
  p.out_yp = o; o += 4194304;
  p.out_ys = o; o += 2097152;
  p.out_st = o; o += 2097152;
  p.out_nak = o; o += 4194304;
  p.out_nav = o; o += 4194304;
  p.out_gk = o; o += 2097152;
  p.out_gv = o;
  char* w = (char*)d_ws; size_t off = 0;
  auto take = [&](size_t bytes) { char* r = w + off; off += al256(bytes); return r; };
  p.bar = (unsigned*)take(16384);
  p.wq = p.bar + 3584;
  p.modp = (float*)take((size_t)4 * 32 * 3 * 6144 * 4);
  p.mod = (float*)take((size_t)4 * 3 * 6144 * 4);
  p.winT = (u16*)take((size_t)4 * DIN * DM * 2);
  p.woutT = (u16*)take((size_t)4 * DM * DM * 2);
  p.wfiT = (u16*)take((size_t)4 * 2 * DFF * DM * 2);
  p.wfoT = (u16*)take((size_t)4 * DM * DFF * 2);
  p.X = (float*)take((size_t)NTOK * DM * 4);
  p.PROJ = (float*)take((size_t)NTOK * DIN * 4);
  p.X1 = p.PROJ;
  p.Y = p.PROJ + (size_t)NTOK * DM;
  p.SC = (float*)take((size_t)NTOK * 4 * 9 * 64 * 4);
  p.ACT = (u16*)p.SC;
  p.G = (float*)take((size_t)NTOK * 256 * 4);
  p.BV = (float*)take((size_t)NTOK * 256 * 4);
  p.OF = (float*)take((size_t)NTOK * 256 * 4);
  p.OB = (float*)take((size_t)NTOK * 256 * 4);
  p.A = (u16*)take((size_t)NTOK * DM * 2);
  p.MIX = (u16*)take((size_t)NTOK * DM * 2);
  p.QNc = (u16*)take((size_t)NCTX * 256 * 2);
  p.KNc = (u16*)take((size_t)NCTX * 256 * 2);
  p.VNtc = (u16*)take((size_t)NCTX * 256 * 2);
  p.QGc = (u16*)take((size_t)NCTX * 512 * 2);
  p.KGc = (u16*)take((size_t)NCTX * 128 * 2);
  p.VGtc = (u16*)take((size_t)NCTX * 128 * 2);
  p.QNl = (u16*)take((size_t)2048 * 256 * 2);
  p.KNl = (u16*)take((size_t)4 * 2 * 1536 * 256 * 2);
  p.VNtl = (u16*)take((size_t)4 * 2 * 1536 * 256 * 2);
  p.QGl = (u16*)take((size_t)2048 * 512 * 2);
  p.KGl = (u16*)take((size_t)4 * 2 * 1536 * 128 * 2);
  p.VGtl = (u16*)take((size_t)4 * 2 * 1536 * 128 * 2);
  p.loraT = (u16*)take((size_t)4 * 98304 * 2);
  p.rope = (float*)take((size_t)64 * 16 * 2 * 4);
  if (off > ws_size) { fprintf(stderr, "workspace too small: need %zu have %zu\n", off, ws_size); return; }

  (void)hipMemsetAsync(p.bar, 0, 16384, stream);
#if MEGA
  static int grid_blocks = 0;
  if (!grid_blocks) {
    int dev = 0, cus = 0, per_cu = 0;
    hipGetDevice(&dev);
    hipDeviceGetAttribute(&cus, hipDeviceAttributeMultiprocessorCount, dev);
    hipOccupancyMaxActiveBlocksPerMultiprocessor(&per_cu, fwd_kernel, 256, 0);
    if (per_cu > 2) per_cu = 2;
    if (per_cu < 1) per_cu = 1;
    grid_blocks = cus * per_cu;
  }
  int ph0 = 0, ph1 = NPH, ub = 1;
  void* args[] = {&p, &ph0, &ph1, &ub};
  hipError_t e = hipLaunchCooperativeKernel((void*)fwd_kernel, dim3(grid_blocks), dim3(256), args, 0, stream);
  if (e != hipSuccess) fprintf(stderr, "cooperative launch failed: %s (grid %d)\n", hipGetErrorString(e), grid_blocks);
#else
  for (int ph = 0; ph < NPH; ++ph) fwd_kernel<<<512, 256, 0, stream>>>(p, ph, ph + 1, 0);
#endif
}
```
